# Optimizing an MI355X kernel written in HIP

```python
import math
import jax, jax.numpy as jnp
from jax import lax
import numpy as np

D_MODEL = 1024
BATCH = 4
SEQ = 4096
DEPTH = 2

N_EVEN = (DEPTH + 1) // 2
N_ODD = DEPTH // 2

RMS_EPS = 1e-6

S5_WIDTH = D_MODEL // 2
S5_GROUP = 16
S5_GROUPS = S5_WIDTH // S5_GROUP
S5_STATE = 64
DT_MIN = 1e-3
DT_MAX = 1e-1

DIFF_WIDTH = D_MODEL - S5_WIDTH
DIFF_HEAD_DIM = 64
DIFF_VALUE_DIM = 2 * DIFF_HEAD_DIM
DIFF_HEADS = DIFF_WIDTH // DIFF_VALUE_DIM
ROT_DIM = DIFF_HEAD_DIM // 4
ROPE_THETA = 500000.0
Q_BLOCK = 128
EVEN_IN_COLS = S5_WIDTH + 3 * DIFF_WIDTH

RWKV_HEAD = 64
RWKV_HEADS = D_MODEL // RWKV_HEAD
DECAY_LORA = 64
AAA_LORA = 64
GATE_LORA = 128
GN_EPS = 64e-5

FFN_HIDDEN = ((8 * D_MODEL // 3 + 255) // 256) * 256

kernel_name = "hybrid_s5_diffattn_rwkv7_adaln_block"


def rms_norm(x, g, eps=RMS_EPS):
    xf = x.astype(jnp.float32)
    y = xf * lax.rsqrt(jnp.mean(xf * xf, axis=-1, keepdims=True) + eps)
    return (y * g.astype(jnp.float32)).astype(x.dtype)


def apply_partial_rope(x, cos, sin):
    half = ROT_DIM // 2
    xf = x[..., :ROT_DIM].astype(jnp.float32)
    x1, x2 = xf[..., :half], xf[..., half:]
    rot = jnp.concatenate([x1 * cos - x2 * sin, x2 * cos + x1 * sin], axis=-1).astype(x.dtype)
    return jnp.concatenate([rot, x[..., ROT_DIM:]], axis=-1)


def s5_ssm(u, lam_re, lam_im, log_dt, b_re, b_im, c_re, c_im, d_skip):
    uf = u.astype(jnp.float32)
    lr = lam_re.astype(jnp.float32)
    li = lam_im.astype(jnp.float32)
    dt = jnp.exp(log_dt.astype(jnp.float32))[:, None]
    mag = jnp.exp(lr * dt)
    abar_r = mag * jnp.cos(li * dt)
    abar_i = mag * jnp.sin(li * dt)
    den = lr * lr + li * li
    num_r = abar_r - 1.0
    q_r = (num_r * lr + abar_i * li) / den
    q_i = (abar_i * lr - num_r * li) / den
    br = b_re.astype(jnp.float32)
    bi = b_im.astype(jnp.float32)
    bb_r = q_r[..., None] * br - q_i[..., None] * bi
    bb_i = q_r[..., None] * bi + q_i[..., None] * br
    bu_r = jnp.einsum('bsgh,gph->bsgp', uf, bb_r)
    bu_i = jnp.einsum('bsgh,gph->bsgp', uf, bb_i)
    a_r = jnp.broadcast_to(abar_r, bu_r.shape)
    a_i = jnp.broadcast_to(abar_i, bu_i.shape)

    def combine(e1, e2):
        a1r, a1i, b1r, b1i = e1
        a2r, a2i, b2r, b2i = e2
        return (a2r * a1r - a2i * a1i,
                a2r * a1i + a2i * a1r,
                a2r * b1r - a2i * b1i + b2r,
                a2r * b1i + a2i * b1r + b2i)

    _, _, x_r, x_i = lax.associative_scan(combine, (a_r, a_i, bu_r, bu_i), axis=1)
    y = (jnp.einsum('bsgp,ghp->bsgh', x_r, c_re.astype(jnp.float32))
         - jnp.einsum('bsgp,ghp->bsgh', x_i, c_im.astype(jnp.float32))
         + d_skip.astype(jnp.float32) * uf)
    return y.astype(u.dtype)


def diff_attention(q, k, v, lam, lam_init, subln_g):
    seq = q.shape[1]
    scale = DIFF_HEAD_DIM ** -0.5
    qf = q.astype(jnp.float32)
    kf = k.astype(jnp.float32)
    vf = v.astype(jnp.float32)
    outs = []
    for i in range(seq // Q_BLOCK):
        kv_len = (i + 1) * Q_BLOCK
        q_blk = qf[:, i * Q_BLOCK:kv_len]
        s = jnp.einsum('bqhcd,bkhcd->bhcqk', q_blk, kf[:, :kv_len]) * scale
        q_pos = i * Q_BLOCK + jnp.arange(Q_BLOCK)
        k_pos = jnp.arange(kv_len)
        mask = k_pos[None, :] <= q_pos[:, None]
        p = jax.nn.softmax(jnp.where(mask, s, -jnp.inf), axis=-1)
        w = p[:, :, 0] - lam * p[:, :, 1]
        outs.append(jnp.einsum('bhqk,bkhe->bqhe', w, vf[:, :kv_len]))
    o = jnp.concatenate(outs, axis=1)
    o = rms_norm(o, subln_g) * (1.0 - lam_init)
    return o.astype(q.dtype)


def even_mixer(h, cos, sin, w_in, lam_re, lam_im, log_dt, b_re, b_im, c_re, c_im,
               d_skip, w_glu, q_norm, k_norm, lq1, lk1, lq2, lk2, subln, w_out, lam_init):
    bsz, seq, _ = h.shape
    proj = h @ w_in
    u, q, k, v = jnp.split(proj, [S5_WIDTH, S5_WIDTH + DIFF_WIDTH, S5_WIDTH + 2 * DIFF_WIDTH], axis=-1)
    y = s5_ssm(u.reshape(bsz, seq, S5_GROUPS, S5_GROUP), lam_re, lam_im, log_dt,
               b_re, b_im, c_re, c_im, d_skip).reshape(bsz, seq, S5_WIDTH)
    y = jax.nn.gelu(y)
    y = y * jax.nn.sigmoid(y @ w_glu)
    q = q.reshape(bsz, seq, DIFF_HEADS, 2, DIFF_HEAD_DIM)
    k = k.reshape(bsz, seq, DIFF_HEADS, 2, DIFF_HEAD_DIM)
    v = v.reshape(bsz, seq, DIFF_HEADS, DIFF_VALUE_DIM)
    q = apply_partial_rope(rms_norm(q, q_norm), cos, sin)
    k = apply_partial_rope(rms_norm(k, k_norm), cos, sin)
    lam = (jnp.exp(jnp.sum(lq1.astype(jnp.float32) * lk1.astype(jnp.float32)))
           - jnp.exp(jnp.sum(lq2.astype(jnp.float32) * lk2.astype(jnp.float32))) + lam_init)
    o = diff_attention(q, k, v, lam, lam_init, subln).reshape(bsz, seq, DIFF_WIDTH)
    return jnp.concatenate([y, o], axis=-1) @ w_out


def rwkv7_recurrence(r, decay, k, v, kk, a):
    bsz, _, nh, n = r.shape

    def step(state, inp):
        r_t, w_t, k_t, v_t, kk_t, b_t = inp
        sa = jnp.einsum('bhvk,bhk->bhv', state, -kk_t)
        state = (state * w_t[:, :, None, :] + sa[..., None] * b_t[:, :, None, :]
                 + v_t[..., None] * k_t[:, :, None, :])
        return state, jnp.einsum('bhvk,bhk->bhv', state, r_t)

    xs = tuple(jnp.moveaxis(t.astype(jnp.float32), 1, 0) for t in (r, decay, k, v, kk, kk * a))
    s0 = jnp.zeros((bsz, nh, n, n), jnp.float32)
    _, ys = lax.scan(step, s0, xs)
    return jnp.moveaxis(ys, 0, 1)


def rwkv7_mixer(h, mu, w_r, w_k, w_v, w_o, w0, w1, w2, a0, a1, a2, g1, g2,
                k_k, k_a, r_k, ln_g, ln_b):
    bsz, seq, dm = h.shape
    h_prev = jnp.pad(h, ((0, 0), (1, 0), (0, 0)))[:, :-1]
    dx = h_prev - h
    xr = h + dx * mu[0]
    xw = h + dx * mu[1]
    xk = h + dx * mu[2]
    xv = h + dx * mu[3]
    xa = h + dx * mu[4]
    xg = h + dx * mu[5]
    r = xr @ w_r
    w = -jax.nn.softplus(-(w0 + jnp.tanh(xw @ w1) @ w2)) - 0.5
    decay = jnp.exp(-jnp.exp(w.astype(jnp.float32)))
    k = xk @ w_k
    v = xv @ w_v
    a = jax.nn.sigmoid(a0 + (xa @ a1) @ a2)
    g = jax.nn.sigmoid(xg @ g1) @ g2
    hs = (bsz, seq, RWKV_HEADS, RWKV_HEAD)
    kk = (k * k_k).reshape(hs).astype(jnp.float32)
    kk = kk / jnp.maximum(jnp.sqrt(jnp.sum(kk * kk, axis=-1, keepdims=True)), 1e-12)
    k = k * (1.0 + (a - 1.0) * k_a)
    rh = r.reshape(hs).astype(jnp.float32)
    kh = k.reshape(hs).astype(jnp.float32)
    vh = v.reshape(hs).astype(jnp.float32)
    y = rwkv7_recurrence(rh, decay.reshape(hs), kh, vh, kk, a.reshape(hs))
    mean = jnp.mean(y, axis=-1, keepdims=True)
    var = jnp.mean((y - mean) ** 2, axis=-1, keepdims=True)
    y = ((y - mean) * lax.rsqrt(var + GN_EPS)).reshape(bsz, seq, dm)
    y = y * ln_g.astype(jnp.float32) + ln_b.astype(jnp.float32)
    bonus = jnp.sum(rh * kh * r_k.astype(jnp.float32), axis=-1, keepdims=True) * vh
    y = (y + bonus.reshape(bsz, seq, dm)).astype(h.dtype)
    return (y * g) @ w_o


def swiglu(h, w_gate, w_up, w_down):
    return (jax.nn.silu(h @ w_gate) * (h @ w_up)) @ w_down


def setup_inputs(seed: int = 0) -> dict:
    key = jax.random.key(seed)
    ks = iter(jax.random.split(key, 64))
    f32 = jnp.float32

    def nrm(shape, s):
        return jax.random.normal(next(ks), shape, f32) * s

    def unif(shape, lo, hi):
        return jax.random.uniform(next(ks), shape, f32, lo, hi)

    D = D_MODEL
    G, P, H16 = S5_GROUPS, S5_STATE, S5_GROUP
    d = DIFF_HEAD_DIM
    inp = {}
    inp["x"] = nrm((BATCH, SEQ, D), 1.0)
    inp["c"] = nrm((BATCH, D), 1.0)
    inp["positions"] = jnp.broadcast_to(jnp.arange(SEQ, dtype=jnp.int32), (BATCH, SEQ))
    inp["w_ada"] = nrm((DEPTH, D, 6 * D), 0.5 * D ** -0.5)
    inp["b_ada"] = nrm((DEPTH, 6 * D), 0.02)
    inp["norm_mix"] = 1.0 + nrm((DEPTH, D), 0.02)
    inp["norm_ffn"] = 1.0 + nrm((DEPTH, D), 0.02)
    inp["ffn_w_gate"] = nrm((DEPTH, D, FFN_HIDDEN), D ** -0.5)
    inp["ffn_w_up"] = nrm((DEPTH, D, FFN_HIDDEN), D ** -0.5)
    inp["ffn_w_down"] = nrm((DEPTH, FFN_HIDDEN, D), FFN_HIDDEN ** -0.5)
    inp["ev_w_in"] = nrm((N_EVEN, D, EVEN_IN_COLS), D ** -0.5)
    inp["ev_s5_lam_re"] = -0.5 + nrm((N_EVEN, G, P), 0.01)
    inp["ev_s5_lam_im"] = math.pi * jnp.arange(P, dtype=f32) + nrm((N_EVEN, G, P), 0.01)
    inp["ev_s5_log_dt"] = unif((N_EVEN, G), math.log(DT_MIN), math.log(DT_MAX))
    inp["ev_s5_b_re"] = nrm((N_EVEN, G, P, H16), (2 * H16) ** -0.5)
    inp["ev_s5_b_im"] = nrm((N_EVEN, G, P, H16), (2 * H16) ** -0.5)
    inp["ev_s5_c_re"] = nrm((N_EVEN, G, H16, P), (2 * P) ** -0.5)
    inp["ev_s5_c_im"] = nrm((N_EVEN, G, H16, P), (2 * P) ** -0.5)
    inp["ev_s5_d"] = nrm((N_EVEN, G, H16), 1.0)
    inp["ev_s5_w_glu"] = nrm((N_EVEN, S5_WIDTH, S5_WIDTH), S5_WIDTH ** -0.5)
    inp["ev_q_norm"] = 1.0 + nrm((N_EVEN, d), 0.02)
    inp["ev_k_norm"] = 1.0 + nrm((N_EVEN, d), 0.02)
    inp["ev_lambda_q1"] = nrm((N_EVEN, d), 0.1)
    inp["ev_lambda_k1"] = nrm((N_EVEN, d), 0.1)
    inp["ev_lambda_q2"] = nrm((N_EVEN, d), 0.1)
    inp["ev_lambda_k2"] = nrm((N_EVEN, d), 0.1)
    inp["ev_subln"] = 1.0 + nrm((N_EVEN, DIFF_VALUE_DIM), 0.02)
    inp["ev_w_out"] = nrm((N_EVEN, D, D), D ** -0.5)
    inp["od_mu"] = unif((N_ODD, 6, D), 0.0, 1.0)
    inp["od_w_r"] = nrm((N_ODD, D, D), D ** -0.5)
    inp["od_w_k"] = nrm((N_ODD, D, D), D ** -0.5)
    inp["od_w_v"] = nrm((N_ODD, D, D), D ** -0.5)
    inp["od_w_o"] = nrm((N_ODD, D, D), D ** -0.5)
    inp["od_w0"] = unif((N_ODD, D), -6.0, 0.0)
    inp["od_w1"] = nrm((N_ODD, D, DECAY_LORA), D ** -0.5)
    inp["od_w2"] = nrm((N_ODD, DECAY_LORA, D), 0.5 * DECAY_LORA ** -0.5)
    inp["od_a0"] = nrm((N_ODD, D), 0.1)
    inp["od_a1"] = nrm((N_ODD, D, AAA_LORA), D ** -0.5)
    inp["od_a2"] = nrm((N_ODD, AAA_LORA, D), 0.5 * AAA_LORA ** -0.5)
    inp["od_g1"] = nrm((N_ODD, D, GATE_LORA), D ** -0.5)
    inp["od_g2"] = nrm((N_ODD, GATE_LORA, D), GATE_LORA ** -0.5)
    inp["od_k_k"] = 0.85 + nrm((N_ODD, D), 0.02)
    inp["od_k_a"] = 1.0 + nrm((N_ODD, D), 0.02)
    inp["od_r_k"] = nrm((N_ODD, RWKV_HEADS, RWKV_HEAD), 0.1)
    inp["od_ln_g"] = 1.0 + nrm((N_ODD, D), 0.02)
    inp["od_ln_b"] = nrm((N_ODD, D), 0.02)
    return inp


def reference(x, c, positions, w_ada, b_ada, norm_mix, norm_ffn, ffn_w_gate, ffn_w_up,
              ffn_w_down, ev_w_in, ev_s5_lam_re, ev_s5_lam_im, ev_s5_log_dt, ev_s5_b_re,
              ev_s5_b_im, ev_s5_c_re, ev_s5_c_im, ev_s5_d, ev_s5_w_glu, ev_q_norm, ev_k_norm,
              ev_lambda_q1, ev_lambda_k1, ev_lambda_q2, ev_lambda_k2, ev_subln, ev_w_out,
              od_mu, od_w_r, od_w_k, od_w_v, od_w_o, od_w0, od_w1, od_w2, od_a0, od_a1,
              od_a2, od_g1, od_g2, od_k_k, od_k_a, od_r_k, od_ln_g, od_ln_b):
    inv_freq = ROPE_THETA ** (-jnp.arange(0, ROT_DIM, 2, dtype=jnp.float32) / ROT_DIM)
    ang = positions.astype(jnp.float32)[..., None] * inv_freq
    cos = jnp.cos(ang)[:, :, None, None, :]
    sin = jnp.sin(ang)[:, :, None, None, :]
    c_act = jax.nn.silu(c)
    for l in range(DEPTH):
        mod = (c_act @ w_ada[l] + b_ada[l])[:, None, :]
        shift_m, scale_m, gate_m, shift_f, scale_f, gate_f = jnp.split(mod, 6, axis=-1)
        h = rms_norm(x, norm_mix[l]) * (1.0 + scale_m) + shift_m
        if l % 2 == 0:
            e = l // 2
            lam_init = 0.8 - 0.6 * math.exp(-0.3 * l)
            mix = even_mixer(h, cos, sin, ev_w_in[e], ev_s5_lam_re[e], ev_s5_lam_im[e],
                             ev_s5_log_dt[e], ev_s5_b_re[e], ev_s5_b_im[e], ev_s5_c_re[e],
                             ev_s5_c_im[e], ev_s5_d[e], ev_s5_w_glu[e], ev_q_norm[e],
                             ev_k_norm[e], ev_lambda_q1[e], ev_lambda_k1[e], ev_lambda_q2[e],
                             ev_lambda_k2[e], ev_subln[e], ev_w_out[e], lam_init)
        else:
            o = l // 2
            mix = rwkv7_mixer(h, od_mu[o], od_w_r[o], od_w_k[o], od_w_v[o], od_w_o[o],
                              od_w0[o], od_w1[o], od_w2[o], od_a0[o], od_a1[o], od_a2[o],
                              od_g1[o], od_g2[o], od_k_k[o], od_k_a[o], od_r_k[o],
                              od_ln_g[o], od_ln_b[o])
        x = x + gate_m * mix
        h = rms_norm(x, norm_ffn[l]) * (1.0 + scale_f) + shift_f
        x = x + gate_f * swiglu(h, ffn_w_gate[l], ffn_w_up[l], ffn_w_down[l])
    return x
```

```cpp
#include <hip/hip_runtime.h>
#include <hip/hip_cooperative_groups.h>
#include <cstdio>
#include <cstdint>
namespace cg = cooperative_groups;

#define LAS __attribute__((address_space(3)))
typedef unsigned short bf16_t;
typedef short bf16x8 __attribute__((ext_vector_type(8)));
typedef float f32x4 __attribute__((ext_vector_type(4)));
typedef unsigned u32x2 __attribute__((ext_vector_type(2)));
typedef unsigned u32x4 __attribute__((ext_vector_type(4)));

constexpr int MTOK = 16384, DM = 1024, SEQ = 4096, FF = 2816;
constexpr int NTHR = 512;
constexpr int LDS_BYTES = 131072;
constexpr size_t MiB = 1048576;
constexpr size_t OFF_WIN = 0;
constexpr size_t OFF_WGLU = 4194304;
constexpr size_t OFF_WOUT = 4718592;
constexpr size_t OFF_WGU0 = 6815744;
constexpr size_t OFF_WDN0 = 18350080;
constexpr size_t OFF_WGU1 = 24117248;
constexpr size_t OFF_WDN1 = 35651584;
constexpr size_t OFF_WG1 = 41418752;
constexpr size_t OFF_WL2 = 55050240;
constexpr size_t OFF_WO = 56623104;
constexpr size_t OFF_MOD = 58720256;
constexpr size_t ACT = 57 * MiB;
constexpr size_t OFF_HA = ACT;
constexpr size_t OFF_U = ACT + 32 * MiB;
constexpr size_t OFF_QKV = ACT + 64 * MiB;
constexpr size_t OFF_CAT = ACT + 112 * MiB;
constexpr size_t OFF_YG = ACT + 144 * MiB;
constexpr size_t OFF_HID = ACT + 32 * MiB;
constexpr size_t OFF_HD = ACT;
constexpr size_t OFF_RKV = ACT + 64 * MiB;
constexpr size_t OFF_G = ACT + 160 * MiB;
constexpr size_t OFF_L1 = 0;
constexpr size_t OFF_DEC = ACT;
constexpr size_t OFF_AA = ACT + 32 * MiB;
constexpr size_t WS_NEED = ACT + 192 * MiB;

struct Params {
    const float* in[46];
    float* out;
    unsigned char* ws;
    int ph_lo, ph_hi;
};

__device__ __forceinline__ unsigned f2bf(float f) { unsigned u = __float_as_uint(f); return (u + 0x7fffu + ((u >> 16) & 1u)) >> 16; }
__device__ __forceinline__ float bf2f(unsigned h) { return __uint_as_float(h << 16); }
__device__ __forceinline__ unsigned pk2(float lo, float hi) { return f2bf(lo) | (f2bf(hi) << 16); }
__device__ __forceinline__ float bflo(unsigned w) { return __uint_as_float(w << 16); }
__device__ __forceinline__ float bfhi(unsigned w) { return __uint_as_float(w & 0xffff0000u); }
__device__ __forceinline__ float wave_sum(float v) {
#pragma unroll
    for (int o = 32; o > 0; o >>= 1) v += __shfl_xor(v, o);
    return v;
}
__device__ __forceinline__ float sigmoidf_(float x) { return 1.f / (1.f + __expf(-x)); }
#define LWAIT() asm volatile("s_waitcnt lgkmcnt(0)" ::: "memory")

constexpr int HTB = 128 * 64 * 2;
__device__ __forceinline__ int lds_byte(int r, int c) { int st = (r >> 4) * 2 + (c >> 5), rr = r & 15, cc = c & 31, ob = rr * 64 + cc * 2; return st * 1024 + (ob ^ (((ob >> 9) & 1) << 5)); }
__device__ __forceinline__ void stage_rc(int b, int& R, int& C) { int st = b / 1024, sb = b % 1024, swz = sb ^ (((sb >> 9) & 1) << 5); R = (st >> 1) * 16 + swz / 64; C = (st & 1) * 32 + (swz % 64) / 2; }

template <class Epi>
__device__ __forceinline__ void gemm_phase(LAS unsigned char* lds, const bf16_t* A, const bf16_t* Bt, int N, int K, const Epi& E, int bid, int nb) {
    const int tid = threadIdx.x, wid = __builtin_amdgcn_readfirstlane(tid >> 6), lane = tid & 63, wr = wid >> 2, wc = wid & 3, fr = lane & 15, fq = lane >> 4;
    unsigned voff[2];
#pragma unroll
    for (int i = 0; i < 2; ++i) { int R, C; stage_rc(tid * 16 + i * 8192, R, C); voff[i] = (unsigned)(R * K + C) * 2u; }
    const int aoff = lds_byte(wr * 64 + fr, fq * 8), boff = lds_byte(wc * 32 + fr, fq * 8);
    const unsigned ldsw = (unsigned)wid * 1024u;
    const size_t kstep = 128, hstep = (size_t)128 * K * 2;
    const int nt = K / 64;
    const int nN = N / 256, ntiles = 64 * nN;
#define G_SA(b, h) (((b) * 2 + (h)) * HTB)
#define G_SB(b, h) ((4 + (b) * 2 + (h)) * HTB)
#define G_STAGE(bufoff, gptr) do { _Pragma("unroll") for (int _i = 0; _i < 2; ++_i) \
        __builtin_amdgcn_global_load_lds((const unsigned*)((gptr) + voff[_i]), (LAS unsigned*)(lds + (bufoff) + ldsw + _i * 8192), 16, 0, 0); } while (0)
#define G_LDA(dst, b, h) do { _Pragma("unroll") for (int m = 0; m < 4; ++m) _Pragma("unroll") for (int k = 0; k < 2; ++k) dst[m][k] = *(const LAS bf16x8*)(lds + G_SA(b, h) + aoff + m * 2048 + k * 1024); } while (0)
#define G_LDB(dst, b, h) do { _Pragma("unroll") for (int n = 0; n < 2; ++n) _Pragma("unroll") for (int k = 0; k < 2; ++k) dst[n][k] = *(const LAS bf16x8*)(lds + G_SB(b, h) + boff + n * 2048 + k * 1024); } while (0)
#define G_MMA(ai, bj, At, Bx) do { __builtin_amdgcn_s_setprio(1); _Pragma("unroll") for (int m = 0; m < 4; ++m) _Pragma("unroll") for (int n = 0; n < 2; ++n) _Pragma("unroll") for (int k = 0; k < 2; ++k) \
        acc[ai][bj][m][n] = __builtin_amdgcn_mfma_f32_16x16x32_bf16(Bx[n][k], At[m][k], acc[ai][bj][m][n], 0, 0, 0); __builtin_amdgcn_s_setprio(0); } while (0)
#define G_WV(n) asm volatile("s_waitcnt vmcnt(" #n ")" ::: "memory")
#define G_WL(n) asm volatile("s_waitcnt lgkmcnt(" #n ")" ::: "memory")
#define G_BAR __builtin_amdgcn_s_barrier()
#define G_SCHED __builtin_amdgcn_sched_barrier(0)
    for (int tile = bid; tile < ntiles; tile += nb) {
        const int pm = tile & 63, pn = tile >> 6;
        const char* cA = (const char*)A + (size_t)pm * 256 * K * 2;
        const char* cB = (const char*)Bt + (size_t)pn * 256 * K * 2;
        f32x4 acc[2][2][4][2];
#pragma unroll
        for (int a = 0; a < 2; ++a)
#pragma unroll
            for (int b = 0; b < 2; ++b)
#pragma unroll
                for (int m = 0; m < 4; ++m)
#pragma unroll
                    for (int n = 0; n < 2; ++n) acc[a][b][m][n] = (f32x4){0.f, 0.f, 0.f, 0.f};
        bf16x8 At[4][2], B0[2][2], B1[2][2];
        G_WV(0);
        G_STAGE(G_SB(0, 0), cB); G_STAGE(G_SA(0, 0), cA); G_STAGE(G_SB(0, 1), cB + hstep); G_STAGE(G_SA(0, 1), cA + hstep);
        if (wr == 1) G_BAR;
        G_WV(4); G_BAR;
        G_STAGE(G_SB(1, 0), cB + kstep); G_STAGE(G_SA(1, 0), cA + kstep); G_STAGE(G_SB(1, 1), cB + hstep + kstep);
        G_WV(6); G_BAR;
        for (int t = 0; t < nt - 2; t += 2) {
            const char* a1 = cA + (size_t)(t + 1) * kstep; const char* a2 = cA + (size_t)(t + 2) * kstep; const char* a3 = a2 + kstep;
            const char* b2 = cB + (size_t)(t + 2) * kstep; const char* b3 = b2 + kstep;
            G_LDB(B0, 0, 0); G_SCHED; G_LDA(At, 0, 0); G_STAGE(G_SA(1, 1), a1 + hstep);
            G_WL(8); G_BAR; G_WL(0); G_MMA(0, 0, At, B0); G_BAR; G_SCHED;
            G_LDB(B1, 0, 1); G_STAGE(G_SB(0, 0), b2);
            G_BAR; G_WL(0); G_MMA(0, 1, At, B1); G_BAR;
            G_LDA(At, 0, 1); G_STAGE(G_SA(0, 0), a2);
            G_BAR; G_WL(0); G_MMA(1, 0, At, B0); G_BAR; G_SCHED;
            G_STAGE(G_SB(0, 1), b2 + hstep);
            G_WV(6); G_BAR; G_MMA(1, 1, At, B1); G_BAR;
            G_LDB(B0, 1, 0); G_SCHED; G_LDA(At, 1, 0); G_STAGE(G_SA(0, 1), a2 + hstep);
            G_WL(8); G_BAR; G_WL(0); G_MMA(0, 0, At, B0); G_BAR; G_SCHED;
            G_LDB(B1, 1, 1); G_STAGE(G_SB(1, 0), b3);
            G_BAR; G_WL(0); G_MMA(0, 1, At, B1); G_BAR;
            G_LDA(At, 1, 1); G_STAGE(G_SA(1, 0), a3);
            G_BAR; G_WL(0); G_MMA(1, 0, At, B0); G_BAR; G_SCHED;
            G_STAGE(G_SB(1, 1), b3 + hstep);
            G_WV(6); G_BAR; G_MMA(1, 1, At, B1); G_BAR;
        }
        {
            const char* a1 = cA + (size_t)(nt - 1) * kstep;
            G_LDB(B0, 0, 0); G_LDA(At, 0, 0); G_STAGE(G_SA(1, 1), a1 + hstep);
            G_BAR; G_WL(0); G_MMA(0, 0, At, B0); G_BAR;
            G_LDB(B1, 0, 1); G_BAR; G_WL(0); G_MMA(0, 1, At, B1); G_BAR;
            G_LDA(At, 0, 1); G_WV(4); G_BAR; G_WL(0); G_MMA(1, 0, At, B0); G_MMA(1, 1, At, B1); G_BAR;
        }
        {
            G_LDB(B0, 1, 0); G_LDA(At, 1, 0); G_WV(2); G_BAR; G_WL(0); G_MMA(0, 0, At, B0); G_BAR;
            G_LDB(B1, 1, 1); G_WV(0); G_BAR; G_WL(0); G_MMA(0, 1, At, B1); G_BAR;
            G_LDA(At, 1, 1); G_BAR; G_WL(0); G_MMA(1, 0, At, B0); G_MMA(1, 1, At, B1); G_BAR;
        }
        if (wr == 0) G_BAR;
        E(acc, pm, pn, wr, wc, fr, fq);
    }
    G_WV(0);
    __syncthreads();
}

#define EPI_LOOP(body) \
    _Pragma("unroll") for (int ai = 0; ai < 2; ++ai) _Pragma("unroll") for (int m = 0; m < 4; ++m) { const int row = pm * 256 + ai * 128 + wr * 64 + m * 16 + fr; \
    _Pragma("unroll") for (int bj = 0; bj < 2; ++bj) _Pragma("unroll") for (int n = 0; n < 2; ++n) { const int ct = bj * 128 + wc * 32 + n * 16 + fq * 4; const f32x4 v = acc[ai][bj][m][n]; body } }

struct EpiWin {
    float* U; bf16_t* QKV;
    __device__ __forceinline__ void operator()(const f32x4 (&acc)[2][2][4][2], int pm, int pn, int wr, int wc, int fr, int fq) const {
        if (pn < 2) { EPI_LOOP({ *(f32x4*)(U + (size_t)row * 512 + pn * 256 + ct) = v; }) }
        else { bf16_t* base = QKV + (size_t)((pn - 2) >> 1) * ((size_t)MTOK * 512) + (pn & 1) * 256;
            EPI_LOOP({ u32x2 w; w.x = pk2(v[0], v[1]); w.y = pk2(v[2], v[3]); *(u32x2*)(base + (size_t)row * 512 + ct) = w; }) }
    }
};
struct EpiGlu {
    const bf16_t* YG; bf16_t* CAT;
    __device__ __forceinline__ void operator()(const f32x4 (&acc)[2][2][4][2], int pm, int pn, int wr, int wc, int fr, int fq) const {
        EPI_LOOP({ const int col = pn * 256 + ct; const u32x2 y = *(const u32x2*)(YG + (size_t)row * 512 + col);
            u32x2 w; w.x = pk2(bflo(y.x) * sigmoidf_(v[0]), bfhi(y.x) * sigmoidf_(v[1])); w.y = pk2(bflo(y.y) * sigmoidf_(v[2]), bfhi(y.y) * sigmoidf_(v[3]));
            *(u32x2*)(CAT + (size_t)row * 1024 + col) = w; })
    }
};
struct EpiRes {
    const float* res; float* out; const float* gate;
    __device__ __forceinline__ void operator()(const f32x4 (&acc)[2][2][4][2], int pm, int pn, int wr, int wc, int fr, int fq) const {
        const float* gb = gate + (size_t)(pm >> 4) * 6144;
        EPI_LOOP({ const int col = pn * 256 + ct; const f32x4 g = *(const f32x4*)(gb + col); const f32x4 r = *(const f32x4*)(res + (size_t)row * 1024 + col);
            *(f32x4*)(out + (size_t)row * 1024 + col) = r + g * v; })
    }
};
struct EpiSwiglu {
    bf16_t* HID;
    __device__ __forceinline__ void operator()(const f32x4 (&acc)[2][2][4][2], int pm, int pn, int wr, int wc, int fr, int fq) const {
#pragma unroll
        for (int ai = 0; ai < 2; ++ai)
#pragma unroll
            for (int m = 0; m < 4; ++m) { const int row = pm * 256 + ai * 128 + wr * 64 + m * 16 + fr;
#pragma unroll
                for (int n = 0; n < 2; ++n) { const f32x4 g = acc[ai][0][m][n], u = acc[ai][1][m][n]; float o[4];
#pragma unroll
                    for (int j = 0; j < 4; ++j) o[j] = g[j] * sigmoidf_(g[j]) * u[j];
                    u32x2 w; w.x = pk2(o[0], o[1]); w.y = pk2(o[2], o[3]);
                    *(u32x2*)(HID + (size_t)row * FF + pn * 128 + wc * 32 + n * 16 + fq * 4) = w; } }
    }
};
struct EpiG1 {
    bf16_t* RKV; bf16_t* L1;
    __device__ __forceinline__ void operator()(const f32x4 (&acc)[2][2][4][2], int pm, int pn, int wr, int wc, int fr, int fq) const {
        if (pn < 12) { bf16_t* base = RKV + (size_t)(pn >> 2) * ((size_t)MTOK * 1024) + (pn & 3) * 256;
            EPI_LOOP({ u32x2 w; w.x = pk2(v[0], v[1]); w.y = pk2(v[2], v[3]); *(u32x2*)(base + (size_t)row * 1024 + ct) = w; }) }
        else { EPI_LOOP({ float o[4];
                _Pragma("unroll") for (int j = 0; j < 4; ++j) o[j] = (bj == 1) ? sigmoidf_(v[j]) : ((wc < 2) ? tanhf(v[j]) : v[j]);
                u32x2 w; w.x = pk2(o[0], o[1]); w.y = pk2(o[2], o[3]); *(u32x2*)(L1 + (size_t)row * 256 + ct) = w; }) }
    }
};
struct EpiL2 {
    _Float16* DEC; bf16_t* AA; bf16_t* G; const float* w0; const float* a0;
    __device__ __forceinline__ void operator()(const f32x4 (&acc)[2][2][4][2], int pm, int pn, int wr, int wc, int fr, int fq) const {
        const int sel = pn >> 2, cb = (pn & 3) * 256;
        if (sel == 0) { EPI_LOOP({ const int col = cb + ct; const f32x4 w0v = *(const f32x4*)(w0 + col);
                _Pragma("unroll") for (int j = 0; j < 4; ++j) { const float z = w0v[j] + v[j]; const float sp = fmaxf(-z, 0.f) + log1pf(expf(-fabsf(z))); const float e = expf(-sp - 0.5f);
                    DEC[(size_t)row * 1024 + col + j] = (_Float16)(-expm1f(-e)); } }) }
        else if (sel == 1) { EPI_LOOP({ const int col = cb + ct; const f32x4 a0v = *(const f32x4*)(a0 + col);
                u32x2 w; w.x = pk2(sigmoidf_(a0v[0] + v[0]), sigmoidf_(a0v[1] + v[1])); w.y = pk2(sigmoidf_(a0v[2] + v[2]), sigmoidf_(a0v[3] + v[3]));
                *(u32x2*)(AA + (size_t)row * 1024 + col) = w; }) }
        else { EPI_LOOP({ const int col = cb + ct; u32x2 w; w.x = pk2(v[0], v[1]); w.y = pk2(v[2], v[3]); *(u32x2*)(G + (size_t)row * 1024 + col) = w; }) }
    }
};

template <int MODE>
__device__ __forceinline__ void tr_job(const float* src, int K, int N, bf16_t* dst, int ldd, int row_off, int koff, const float* scale, float* lds, int bid, int nb) {
    const int tk = K / 64, tn = N / 64, tid = threadIdx.x;
    for (int t = bid; t < tk * tn; t += nb) {
        const int k0 = (t / tn) * 64, n0 = (t % tn) * 64;
        { const int r = tid >> 3, c = (tid & 7) * 8; const float* p = src + (size_t)(k0 + r) * N + n0 + c;
          const float4 a = *(const float4*)p, b = *(const float4*)(p + 4); const float s = scale ? scale[k0 + r] : 1.f;
          float* l = lds + r * 65 + c; l[0] = a.x * s; l[1] = a.y * s; l[2] = a.z * s; l[3] = a.w * s; l[4] = b.x * s; l[5] = b.y * s; l[6] = b.z * s; l[7] = b.w * s; }
        __syncthreads();
        { const int nl = tid >> 3, kc = (tid & 7) * 8; float v[8];
#pragma unroll
          for (int i = 0; i < 8; ++i) v[i] = lds[(kc + i) * 65 + nl];
          int n = n0 + nl; int rowi = n;
          if (MODE == 1) rowi = (n >> 7) * 256 + (n & 127);
          if (MODE == 2) rowi = (n >> 7) * 256 + 128 + (n & 127);
          u32x4 w; w.x = pk2(v[0], v[1]); w.y = pk2(v[2], v[3]); w.z = pk2(v[4], v[5]); w.w = pk2(v[6], v[7]);
          *(u32x4*)(dst + (size_t)(row_off + rowi) * ldd + koff + k0 + kc) = w; }
        __syncthreads();
    }
}

__device__ __forceinline__ void prep_phase(const Params& p, float* lds, int bid, int nb) {
    unsigned char* ws = p.ws;
    tr_job<0>(p.in[10], 1024, 2048, (bf16_t*)(ws + OFF_WIN), 1024, 0, 0, nullptr, lds, bid, nb);
    tr_job<0>(p.in[19], 512, 512, (bf16_t*)(ws + OFF_WGLU), 512, 0, 0, nullptr, lds, bid, nb);
    tr_job<0>(p.in[27], 1024, 1024, (bf16_t*)(ws + OFF_WOUT), 1024, 0, 0, nullptr, lds, bid, nb);
    for (int l = 0; l < 2; ++l) {
        bf16_t* gu = (bf16_t*)(ws + (l ? OFF_WGU1 : OFF_WGU0)); bf16_t* dn = (bf16_t*)(ws + (l ? OFF_WDN1 : OFF_WDN0));
        tr_job<1>(p.in[7] + (size_t)l * 1024 * FF, 1024, FF, gu, 1024, 0, 0, nullptr, lds, bid, nb);
        tr_job<2>(p.in[8] + (size_t)l * 1024 * FF, 1024, FF, gu, 1024, 0, 0, nullptr, lds, bid, nb);
        tr_job<0>(p.in[9] + (size_t)l * FF * 1024, FF, 1024, dn, FF, 0, 0, nullptr, lds, bid, nb);
    }
    bf16_t* g1 = (bf16_t*)(ws + OFF_WG1); const float* mu = p.in[28];
    tr_job<0>(p.in[29], 1024, 1024, g1, 2048, 0, 0, nullptr, lds, bid, nb);      tr_job<0>(p.in[29], 1024, 1024, g1, 2048, 0, 1024, mu + 0 * 1024, lds, bid, nb);
    tr_job<0>(p.in[30], 1024, 1024, g1, 2048, 1024, 0, nullptr, lds, bid, nb);   tr_job<0>(p.in[30], 1024, 1024, g1, 2048, 1024, 1024, mu + 2 * 1024, lds, bid, nb);
    tr_job<0>(p.in[31], 1024, 1024, g1, 2048, 2048, 0, nullptr, lds, bid, nb);   tr_job<0>(p.in[31], 1024, 1024, g1, 2048, 2048, 1024, mu + 3 * 1024, lds, bid, nb);
    tr_job<0>(p.in[34], 1024, 64, g1, 2048, 3072, 0, nullptr, lds, bid, nb);     tr_job<0>(p.in[34], 1024, 64, g1, 2048, 3072, 1024, mu + 1 * 1024, lds, bid, nb);
    tr_job<0>(p.in[37], 1024, 64, g1, 2048, 3136, 0, nullptr, lds, bid, nb);     tr_job<0>(p.in[37], 1024, 64, g1, 2048, 3136, 1024, mu + 4 * 1024, lds, bid, nb);
    tr_job<0>(p.in[39], 1024, 128, g1, 2048, 3200, 0, nullptr, lds, bid, nb);    tr_job<0>(p.in[39], 1024, 128, g1, 2048, 3200, 1024, mu + 5 * 1024, lds, bid, nb);
    bf16_t* l2 = (bf16_t*)(ws + OFF_WL2);
    tr_job<0>(p.in[35], 64, 1024, l2, 256, 0, 0, nullptr, lds, bid, nb);
    tr_job<0>(p.in[38], 64, 1024, l2, 256, 1024, 64, nullptr, lds, bid, nb);
    tr_job<0>(p.in[40], 128, 1024, l2, 256, 2048, 128, nullptr, lds, bid, nb);
    for (int i = bid * NTHR + threadIdx.x; i < 3072 * 32; i += nb * NTHR) { const int n = i >> 5, kc = (i & 31) * 8; const int sel = n >> 10;
        const bool used = (sel == 0) ? (kc < 64) : (sel == 1) ? (kc >= 64 && kc < 128) : (kc >= 128);
        if (!used) *(u32x4*)(l2 + (size_t)n * 256 + kc) = (u32x4){0u, 0u, 0u, 0u}; }
    tr_job<0>(p.in[32], 1024, 1024, (bf16_t*)(ws + OFF_WO), 1024, 0, 0, nullptr, lds, bid, nb);
    {   const float* c = p.in[1]; const float* wada = p.in[3]; const float* bada = p.in[4]; float* mod = (float*)(ws + OFF_MOD);
        float* cact = lds;
        float* red = lds + 4096;
        for (int i = threadIdx.x; i < 4096; i += NTHR) { const float x = c[i]; cact[i] = x / (1.f + expf(-x)); }
        __syncthreads();
        const int col = threadIdx.x & 63, kg = threadIdx.x >> 6;
        for (int ch = bid; ch < 192; ch += nb) {
            const int l = ch / 96, n0 = (ch % 96) * 64;
            const float* wp = wada + (size_t)l * 1024 * 6144 + n0 + col;
            float a0 = 0.f, a1 = 0.f, a2 = 0.f, a3 = 0.f;
            for (int k = kg * 128; k < kg * 128 + 128; ++k) { const float w = wp[(size_t)k * 6144]; a0 += cact[k] * w; a1 += cact[1024 + k] * w; a2 += cact[2048 + k] * w; a3 += cact[3072 + k] * w; }
            red[(kg * 4 + 0) * 64 + col] = a0; red[(kg * 4 + 1) * 64 + col] = a1; red[(kg * 4 + 2) * 64 + col] = a2; red[(kg * 4 + 3) * 64 + col] = a3;
            __syncthreads();
            if (threadIdx.x < 256) { const int b = threadIdx.x >> 6; float s = 0.f;
#pragma unroll
                for (int g = 0; g < 8; ++g) s += red[(g * 4 + b) * 64 + col];
                mod[(size_t)(l * 4 + b) * 6144 + n0 + col] = s + bada[l * 6144 + n0 + col]; }
            __syncthreads();
        }
    }
}

template <bool RW>
__device__ __forceinline__ void norm_phase(const float* x, const float* g, const float* modl, int shift_off, int scale_off, bf16_t* out, int bid, int nb) {
    const int wave = threadIdx.x >> 6, lane = threadIdx.x & 63;
    for (int row = bid * 8 + wave; row < MTOK; row += nb * 8) {
        const int b = row >> 12; const float* xr = x + (size_t)row * 1024; const float* md = modl + (size_t)b * 6144;
        f32x4 v[4], vp[4]; float ss = 0.f, ssp = 0.f; const bool hasp = RW && ((row & 4095) != 0);
#pragma unroll
        for (int i = 0; i < 4; ++i) { v[i] = *(const f32x4*)(xr + i * 256 + lane * 4); ss += v[i][0] * v[i][0] + v[i][1] * v[i][1] + v[i][2] * v[i][2] + v[i][3] * v[i][3];
            if (RW) { vp[i] = hasp ? *(const f32x4*)(xr - 1024 + i * 256 + lane * 4) : (f32x4){0.f, 0.f, 0.f, 0.f}; ssp += vp[i][0] * vp[i][0] + vp[i][1] * vp[i][1] + vp[i][2] * vp[i][2] + vp[i][3] * vp[i][3]; } }
        ss = wave_sum(ss); const float rstd = rsqrtf(ss * (1.f / 1024.f) + 1e-6f);
        float rstdp = 0.f; if (RW) { ssp = wave_sum(ssp); rstdp = rsqrtf(ssp * (1.f / 1024.f) + 1e-6f); }
#pragma unroll
        for (int i = 0; i < 4; ++i) { const int c = i * 256 + lane * 4; const f32x4 gg = *(const f32x4*)(g + c), sc = *(const f32x4*)(md + scale_off + c), sh = *(const f32x4*)(md + shift_off + c);
            f32x4 h;
#pragma unroll
            for (int j = 0; j < 4; ++j) h[j] = v[i][j] * rstd * gg[j] * (1.f + sc[j]) + sh[j];
            u32x2 w; w.x = pk2(h[0], h[1]); w.y = pk2(h[2], h[3]);
            if (!RW) *(u32x2*)(out + (size_t)row * 1024 + c) = w;
            else { *(u32x2*)(out + (size_t)row * 2048 + c) = w; f32x4 d;
#pragma unroll
                for (int j = 0; j < 4; ++j) { const float hp = hasp ? (vp[i][j] * rstdp * gg[j] * (1.f + sc[j]) + sh[j]) : 0.f; d[j] = hp - h[j]; }
                u32x2 w2; w2.x = pk2(d[0], d[1]); w2.y = pk2(d[2], d[3]); *(u32x2*)(out + (size_t)row * 2048 + 1024 + c) = w2; } }
    }
}

__device__ __forceinline__ void qknorm_phase(bf16_t* Q, bf16_t* Kb, const int* pos, const float* qn, const float* kn, int bid, int nb) {
    const int wave = threadIdx.x >> 6, lane = threadIdx.x & 63, l16 = lane & 15, d0 = l16 * 4;
    float invf[4];
#pragma unroll
    for (int j = 0; j < 4; ++j) invf[j] = powf(500000.f, -(float)((l16 & 1) * 4 + j) / 8.f);
    const f32x4 qw = *(const f32x4*)(qn + d0), kw = *(const f32x4*)(kn + d0);
    for (int tok = bid * 8 + wave; tok < MTOK; tok += nb * 8) {
        const float ps = (float)pos[tok];
        float cs[4], sn[4];
#pragma unroll
        for (int j = 0; j < 4; ++j) { const float ang = ps * invf[j]; cs[j] = cosf(ang); sn[j] = sinf(ang); }
#pragma unroll
        for (int bsel = 0; bsel < 2; ++bsel) { bf16_t* buf = bsel ? Kb : Q; const f32x4 w = bsel ? kw : qw;
#pragma unroll
            for (int it = 0; it < 2; ++it) { const int vec = it * 4 + (lane >> 4); bf16_t* ptr = buf + (size_t)tok * 512 + vec * 64 + d0;
                const u32x2 raw = *(const u32x2*)ptr; float y[4] = {bflo(raw.x), bfhi(raw.x), bflo(raw.y), bfhi(raw.y)};
                float ss = y[0] * y[0] + y[1] * y[1] + y[2] * y[2] + y[3] * y[3];
                ss += __shfl_xor(ss, 1); ss += __shfl_xor(ss, 2); ss += __shfl_xor(ss, 4); ss += __shfl_xor(ss, 8);
                const float rstd = rsqrtf(ss * (1.f / 64.f) + 1e-6f);
#pragma unroll
                for (int j = 0; j < 4; ++j) y[j] = y[j] * rstd * w[j];
                float pr[4];
#pragma unroll
                for (int j = 0; j < 4; ++j) pr[j] = __shfl_xor(y[j], 2);
                if (l16 < 2) {
#pragma unroll
                    for (int j = 0; j < 4; ++j) y[j] = y[j] * cs[j] - pr[j] * sn[j]; }
                else if (l16 < 4) {
#pragma unroll
                    for (int j = 0; j < 4; ++j) y[j] = y[j] * cs[j] + pr[j] * sn[j]; }
                if (!bsel) {
#pragma unroll
                    for (int j = 0; j < 4; ++j) y[j] *= 0.125f * 1.4426950408889634f; }
                u32x2 o; o.x = pk2(y[0], y[1]); o.y = pk2(y[2], y[3]); *(u32x2*)ptr = o; } }
    }
}

__device__ __forceinline__ float gelu_tanh(float x) { const float t = tanhf(0.7978845608028654f * (x + 0.044715f * x * x * x)); return 0.5f * x * (1.f + t); }
__device__ __forceinline__ void s5_naive(const Params& p, const float* U, bf16_t* YG, float* lds, int bid, int nb) {
    const int wave = threadIdx.x >> 6, lane = threadIdx.x & 63;
    float* L = lds + wave * 3328; float* Lxs = L; float* Lcr = L + 1040; float* Lci = L + 2080; float* Lus = L + 3120;
    const float* lam_re = p.in[11]; const float* lam_im = p.in[12]; const float* log_dt = p.in[13]; const float* b_re = p.in[14]; const float* b_im = p.in[15];
    const float* c_re = p.in[16]; const float* c_im = p.in[17]; const float* dsk = p.in[18];
    for (int unit = bid * 8 + wave; unit < 128; unit += nb * 8) {
        const int b = unit >> 5, g = unit & 31;
        const float lr = lam_re[g * 64 + lane], li = lam_im[g * 64 + lane], dt = expf(log_dt[g]);
        const float mag = expf(lr * dt), ar = mag * cosf(li * dt), ai = mag * sinf(li * dt);
        const float den = lr * lr + li * li, nr = ar - 1.f;
        const float qr = (nr * lr + ai * li) / den, qi = (ai * lr - nr * li) / den;
        float bbr[16], bbi[16];
#pragma unroll
        for (int h = 0; h < 16; ++h) { const float br = b_re[(size_t)(g * 64 + lane) * 16 + h], bi = b_im[(size_t)(g * 64 + lane) * 16 + h]; bbr[h] = qr * br - qi * bi; bbi[h] = qr * bi + qi * br; }
#pragma unroll
        for (int h = 0; h < 16; ++h) { Lcr[h * 65 + lane] = c_re[(size_t)(g * 16 + h) * 64 + lane]; Lci[h * 65 + lane] = c_im[(size_t)(g * 16 + h) * 64 + lane]; }
        const int hh = lane & 15, tq = lane >> 4;
        const float dd = dsk[g * 16 + hh];
        float xr = 0.f, xi = 0.f;
        for (int t0 = 0; t0 < SEQ; t0 += 8) {
            { const int idx = lane * 2, tk = idx >> 4, h = idx & 15; const float2 uu = *(const float2*)(U + ((size_t)b * SEQ + t0 + tk) * 512 + g * 16 + h); Lus[idx] = uu.x; Lus[idx + 1] = uu.y; }
            LWAIT();
#pragma unroll
            for (int tt = 0; tt < 8; ++tt) { float bur = 0.f, bui = 0.f;
#pragma unroll
                for (int h = 0; h < 16; ++h) { const float u = Lus[tt * 16 + h]; bur += bbr[h] * u; bui += bbi[h] * u; }
                const float nxr = ar * xr - ai * xi + bur, nxi = ar * xi + ai * xr + bui; xr = nxr; xi = nxi;
                Lxs[tt * 130 + lane] = xr; Lxs[tt * 130 + 64 + lane] = xi; }
            LWAIT();
#pragma unroll
            for (int i = 0; i < 2; ++i) { const int t = tq + 4 * i; float y = 0.f;
                for (int pp = 0; pp < 64; ++pp) y += Lcr[hh * 65 + pp] * Lxs[t * 130 + pp] - Lci[hh * 65 + pp] * Lxs[t * 130 + 64 + pp];
                y += dd * Lus[t * 16 + hh];
                YG[((size_t)b * SEQ + t0 + t) * 512 + g * 16 + hh] = (bf16_t)f2bf(gelu_tanh(y)); }
            LWAIT();
        }
    }
}

__device__ __forceinline__ void attn_naive(const bf16_t* Q, const bf16_t* Kb, const bf16_t* V, bf16_t* CAT, const Params& p, float* lds, int bid, int nb) {
    const int wave = __builtin_amdgcn_readfirstlane(threadIdx.x >> 6), lane = threadIdx.x & 63, head = wave >> 1, c = wave & 1, eh = lane >> 5, rl = lane & 31;
    float lam;
    { float s1 = 0.f, s2 = 0.f; for (int d = 0; d < 64; ++d) { s1 += p.in[22][d] * p.in[23][d]; s2 += p.in[24][d] * p.in[25][d]; } lam = expf(s1) - expf(s2) + 0.2f; }
    const float* subln = p.in[26];
    for (int unit = bid; unit < 512; unit += nb) {
        const int b = unit & 3, qb = 127 - (unit >> 2); const int i = qb * 32 + rl; const size_t tok = (size_t)b * SEQ + i;
        float q[64];
        { const u32x4* qp = (const u32x4*)(Q + tok * 512 + head * 128 + c * 64);
#pragma unroll
          for (int d8 = 0; d8 < 8; ++d8) { const u32x4 w = qp[d8]; q[d8 * 8 + 0] = bflo(w.x); q[d8 * 8 + 1] = bfhi(w.x); q[d8 * 8 + 2] = bflo(w.y); q[d8 * 8 + 3] = bfhi(w.y); q[d8 * 8 + 4] = bflo(w.z); q[d8 * 8 + 5] = bfhi(w.z); q[d8 * 8 + 6] = bflo(w.w); q[d8 * 8 + 7] = bfhi(w.w); } }
        float acc[64];
#pragma unroll
        for (int e = 0; e < 64; ++e) acc[e] = 0.f;
        float mx = -INFINITY, l = 0.f;
        const int jmax = qb * 32 + 31;
        for (int j = 0; j <= jmax; ++j) {
            const u32x4* kp = (const u32x4*)(Kb + ((size_t)b * SEQ + j) * 512 + head * 128 + c * 64);
            float s = 0.f;
#pragma unroll
            for (int d8 = 0; d8 < 8; ++d8) { const u32x4 w = kp[d8]; s += q[d8 * 8 + 0] * bflo(w.x) + q[d8 * 8 + 1] * bfhi(w.x) + q[d8 * 8 + 2] * bflo(w.y) + q[d8 * 8 + 3] * bfhi(w.y) + q[d8 * 8 + 4] * bflo(w.z) + q[d8 * 8 + 5] * bfhi(w.z) + q[d8 * 8 + 6] * bflo(w.w) + q[d8 * 8 + 7] * bfhi(w.w); }
            if (j <= i) {
                if (s > mx) { const float al = exp2f(mx - s); l *= al;
#pragma unroll
                    for (int e = 0; e < 64; ++e) acc[e] *= al;
                    mx = s; }
                const float pe = exp2f(s - mx); l += pe;
                const u32x4* vp = (const u32x4*)(V + ((size_t)b * SEQ + j) * 512 + head * 128 + eh * 64);
#pragma unroll
                for (int e8 = 0; e8 < 8; ++e8) { const u32x4 w = vp[e8]; acc[e8 * 8 + 0] += pe * bflo(w.x); acc[e8 * 8 + 1] += pe * bfhi(w.x); acc[e8 * 8 + 2] += pe * bflo(w.y); acc[e8 * 8 + 3] += pe * bfhi(w.y); acc[e8 * 8 + 4] += pe * bflo(w.z); acc[e8 * 8 + 5] += pe * bfhi(w.z); acc[e8 * 8 + 6] += pe * bflo(w.w); acc[e8 * 8 + 7] += pe * bfhi(w.w); }
            }
        }
        const float inv = 1.f / l;
        if (c == 1) {
#pragma unroll
            for (int e = 0; e < 64; ++e) lds[(head * 128 + eh * 64 + e) * 32 + rl] = acc[e] * inv; }
        __syncthreads();
        if (c == 0) { float ss = 0.f;
#pragma unroll
            for (int e = 0; e < 64; ++e) { const float o = acc[e] * inv - lam * lds[(head * 128 + eh * 64 + e) * 32 + rl]; acc[e] = o; ss += o * o; }
            ss += __shfl_xor(ss, 32);
            const float rstd = rsqrtf(ss * (1.f / 128.f) + 1e-6f) * 0.8f;
            unsigned* op = (unsigned*)(CAT + tok * 1024 + 512 + head * 128 + eh * 64);
#pragma unroll
            for (int e = 0; e < 64; e += 2) op[e >> 1] = pk2(acc[e] * rstd * subln[eh * 64 + e], acc[e + 1] * rstd * subln[eh * 64 + e + 1]); }
        __syncthreads();
    }
}

__device__ __forceinline__ void rwkv_naive(const Params& p, bf16_t* R, const bf16_t* Kk, const bf16_t* Vv, const _Float16* DEC, const bf16_t* AA, const bf16_t* G, float* lds, int bid, int nb) {
    const int wave = threadIdx.x >> 6, lane = threadIdx.x & 63;
    float* L = lds + wave * 1280;
    for (int unit = bid * 8 + wave; unit < 64; unit += nb * 8) {
        const int b = unit >> 4, h = unit & 15;
        float S[64];
#pragma unroll
        for (int j = 0; j < 64; ++j) S[j] = 0.f;
        const float kkw = p.in[41][h * 64 + lane], kaw = p.in[42][h * 64 + lane], rkw = p.in[43][h * 64 + lane], lng = p.in[44][h * 64 + lane], lnb = p.in[45][h * 64 + lane];
        for (int t0 = 0; t0 < SEQ; t0 += 4) {
            float vv[4], gg[4], bon[4];
#pragma unroll
            for (int tt = 0; tt < 4; ++tt) { const size_t off = ((size_t)b * SEQ + t0 + tt) * 1024 + h * 64 + lane;
                const float r = bf2f(R[off]), k = bf2f(Kk[off]), v = bf2f(Vv[off]), dec = 1.f - (float)DEC[off], a = bf2f(AA[off]); gg[tt] = bf2f(G[off]);
                float kk = k * kkw; const float n2 = wave_sum(kk * kk); kk = kk / fmaxf(sqrtf(n2), 1e-12f);
                const float k2 = k * (1.f + (a - 1.f) * kaw); const float bb = kk * a;
                bon[tt] = wave_sum(r * k2 * rkw) * v; vv[tt] = v;
                L[(0 * 4 + tt) * 64 + lane] = dec; L[(1 * 4 + tt) * 64 + lane] = -kk; L[(2 * 4 + tt) * 64 + lane] = bb; L[(3 * 4 + tt) * 64 + lane] = k2; L[(4 * 4 + tt) * 64 + lane] = r; }
            LWAIT();
#pragma unroll
            for (int tt = 0; tt < 4; ++tt) {
                const f32x4* Lw = (const f32x4*)(L + (0 * 4 + tt) * 64); const f32x4* Lk = (const f32x4*)(L + (1 * 4 + tt) * 64); const f32x4* Lb = (const f32x4*)(L + (2 * 4 + tt) * 64);
                const f32x4* Lkk = (const f32x4*)(L + (3 * 4 + tt) * 64); const f32x4* Lr = (const f32x4*)(L + (4 * 4 + tt) * 64);
                float sa = 0.f;
#pragma unroll
                for (int j4 = 0; j4 < 16; ++j4) { const f32x4 a = Lk[j4]; sa += S[j4 * 4 + 0] * a[0] + S[j4 * 4 + 1] * a[1] + S[j4 * 4 + 2] * a[2] + S[j4 * 4 + 3] * a[3]; }
                float y = 0.f; const float v = vv[tt];
#pragma unroll
                for (int j4 = 0; j4 < 16; ++j4) { const f32x4 w = Lw[j4], bb = Lb[j4], k2 = Lkk[j4], r = Lr[j4];
#pragma unroll
                    for (int j = 0; j < 4; ++j) { const float s = S[j4 * 4 + j] * w[j] + sa * bb[j] + v * k2[j]; S[j4 * 4 + j] = s; y += s * r[j]; } }
                const float mean = wave_sum(y) * (1.f / 64.f); const float d = y - mean; const float var = wave_sum(d * d) * (1.f / 64.f);
                const float yn = d * rsqrtf(var + 64e-5f) * lng + lnb + bon[tt];
                R[((size_t)b * SEQ + t0 + tt) * 1024 + h * 64 + lane] = (bf16_t)f2bf(yn * gg[tt]); }
            LWAIT();
        }
    }
}

__global__ void __launch_bounds__(NTHR) fwd_kernel(Params p) {
    extern __shared__ __attribute__((aligned(16))) unsigned char lds_raw[];
    LAS unsigned char* lds = (LAS unsigned char*)lds_raw;
    float* ldsf = (float*)lds_raw;
    const int bid = blockIdx.x, nb = gridDim.x;
    unsigned char* ws = p.ws;
    float* mod = (float*)(ws + OFF_MOD);
    const bool multi = (p.ph_hi - p.ph_lo) > 1;
#ifndef TESTPH
#define TESTPH -1
#endif
#define PH(k) if ((TESTPH < 0 || TESTPH == (k)) && p.ph_lo <= (k) && (k) < p.ph_hi)
#define SYNC(k) if (multi && (k) + 1 < p.ph_hi) { cg::this_grid().sync(); }
    PH(0) { prep_phase(p, ldsf, bid, nb); SYNC(0) }
    PH(1) { norm_phase<false>(p.in[0], p.in[5], mod, 0, 1024, (bf16_t*)(ws + OFF_HA), bid, nb); SYNC(1) }
    PH(2) { EpiWin e{(float*)(ws + OFF_U), (bf16_t*)(ws + OFF_QKV)}; gemm_phase(lds, (const bf16_t*)(ws + OFF_HA), (const bf16_t*)(ws + OFF_WIN), 2048, 1024, e, bid, nb); SYNC(2) }
    PH(3) { bf16_t* q = (bf16_t*)(ws + OFF_QKV); qknorm_phase(q, q + (size_t)MTOK * 512, (const int*)p.in[2], p.in[20], p.in[21], bid, nb); SYNC(3) }
    PH(4) { s5_naive(p, (const float*)(ws + OFF_U), (bf16_t*)(ws + OFF_YG), ldsf, bid, nb); SYNC(4) }
    PH(5) { bf16_t* q = (bf16_t*)(ws + OFF_QKV); attn_naive(q, q + (size_t)MTOK * 512, q + (size_t)MTOK * 1024, (bf16_t*)(ws + OFF_CAT), p, ldsf, bid, nb); SYNC(5) }
    PH(6) { EpiGlu e{(const bf16_t*)(ws + OFF_YG), (bf16_t*)(ws + OFF_CAT)}; gemm_phase(lds, (const bf16_t*)(ws + OFF_YG), (const bf16_t*)(ws + OFF_WGLU), 512, 512, e, bid, nb); SYNC(6) }
    PH(7) { EpiRes e{p.in[0], p.out, mod + 2048}; gemm_phase(lds, (const bf16_t*)(ws + OFF_CAT), (const bf16_t*)(ws + OFF_WOUT), 1024, 1024, e, bid, nb); SYNC(7) }
    PH(8) { norm_phase<false>(p.out, p.in[6], mod, 3072, 4096, (bf16_t*)(ws + OFF_HA), bid, nb); SYNC(8) }
    PH(9) { EpiSwiglu e{(bf16_t*)(ws + OFF_HID)}; gemm_phase(lds, (const bf16_t*)(ws + OFF_HA), (const bf16_t*)(ws + OFF_WGU0), 5632, 1024, e, bid, nb); SYNC(9) }
    PH(10) { EpiRes e{p.out, p.out, mod + 5120}; gemm_phase(lds, (const bf16_t*)(ws + OFF_HID), (const bf16_t*)(ws + OFF_WDN0), 1024, FF, e, bid, nb); SYNC(10) }
    const float* mod1 = mod + 4 * 6144;
    PH(11) { norm_phase<true>(p.out, p.in[5] + 1024, mod1, 0, 1024, (bf16_t*)(ws + OFF_HD), bid, nb); SYNC(11) }
    PH(12) { EpiG1 e{(bf16_t*)(ws + OFF_RKV), (bf16_t*)(ws + OFF_L1)}; gemm_phase(lds, (const bf16_t*)(ws + OFF_HD), (const bf16_t*)(ws + OFF_WG1), 3328, 2048, e, bid, nb); SYNC(12) }
    PH(13) { EpiL2 e{(_Float16*)(ws + OFF_DEC), (bf16_t*)(ws + OFF_AA), (bf16_t*)(ws + OFF_G), p.in[33], p.in[36]}; gemm_phase(lds, (const bf16_t*)(ws + OFF_L1), (const bf16_t*)(ws + OFF_WL2), 3072, 256, e, bid, nb); SYNC(13) }
    PH(14) { bf16_t* r = (bf16_t*)(ws + OFF_RKV); rwkv_naive(p, r, r + (size_t)MTOK * 1024, r + (size_t)MTOK * 2048, (const _Float16*)(ws + OFF_DEC), (const bf16_t*)(ws + OFF_AA), (const bf16_t*)(ws + OFF_G), ldsf, bid, nb); SYNC(14) }
    PH(15) { EpiRes e{p.out, p.out, mod1 + 2048}; gemm_phase(lds, (const bf16_t*)(ws + OFF_RKV), (const bf16_t*)(ws + OFF_WO), 1024, 1024, e, bid, nb); SYNC(15) }
    PH(16) { norm_phase<false>(p.out, p.in[6] + 1024, mod1, 3072, 4096, (bf16_t*)(ws + OFF_HA), bid, nb); SYNC(16) }
    PH(17) { EpiSwiglu e{(bf16_t*)(ws + OFF_HID)}; gemm_phase(lds, (const bf16_t*)(ws + OFF_HA), (const bf16_t*)(ws + OFF_WGU1), 5632, 1024, e, bid, nb); SYNC(17) }
    PH(18) { EpiRes e{p.out, p.out, mod1 + 5120}; gemm_phase(lds, (const bf16_t*)(ws + OFF_HID), (const bf16_t*)(ws + OFF_WDN1), 1024, FF, e, bid, nb); }
}

constexpr int NPHASE = 19;
#ifndef ONE_LAUNCH
#define ONE_LAUNCH 0
#endif

extern "C" void kernel_launch(void* const* d_in, const int* in_sizes, int n_in, void* d_out, int out_size, void* d_ws, size_t ws_size, hipStream_t stream) {
    static int grid = 0;
    if (grid == 0) {
        if (n_in != 46 || ws_size < WS_NEED) { fprintf(stderr, "kernel_launch: unexpected n_in %d / ws_size %zu (need %zu)\n", n_in, ws_size, (size_t)WS_NEED); grid = -1; return; }
        if (hipFuncSetAttribute((const void*)fwd_kernel, hipFuncAttributeMaxDynamicSharedMemorySize, LDS_BYTES) != hipSuccess) { fprintf(stderr, "hipFuncSetAttribute failed\n"); grid = -1; return; }
        int dev = 0, cus = 0, per_cu = 0;
        (void)hipGetDevice(&dev); (void)hipDeviceGetAttribute(&cus, hipDeviceAttributeMultiprocessorCount, dev);
        (void)hipOccupancyMaxActiveBlocksPerMultiprocessor(&per_cu, (const void*)fwd_kernel, NTHR, LDS_BYTES);
        if (per_cu < 1) per_cu = 1;
        grid = cus;
    }
    if (grid < 0) return;
    Params p{};
    for (int i = 0; i < 46; ++i) p.in[i] = (const float*)d_in[i];
    p.out = (float*)d_out; p.ws = (unsigned char*)d_ws;
#if ONE_LAUNCH
    p.ph_lo = 0; p.ph_hi = NPHASE;
    void* args[] = {&p};
    hipError_t e = hipLaunchCooperativeKernel((const void*)fwd_kernel, dim3(grid), dim3(NTHR), args, LDS_BYTES, stream);
    if (e != hipSuccess) fprintf(stderr, "cooperative launch failed: %s (grid %d)\n", hipGetErrorString(e), grid);
#else
    for (int ph = 0; ph < NPHASE; ++ph) { p.ph_lo = ph; p.ph_hi = ph + 1; hipLaunchKernelGGL(fwd_kernel, dim3(grid), dim3(NTHR), LDS_BYTES, stream, p); }
#endif
}
```

```cpp
#include <hip/hip_runtime.h>
#include <hip/hip_cooperative_groups.h>
#include <cstdio>
#include <cstdint>
namespace cg = cooperative_groups;

#define LAS __attribute__((address_space(3)))
typedef unsigned short bf16_t;
typedef short bf16x8 __attribute__((ext_vector_type(8)));
typedef float f32x4 __attribute__((ext_vector_type(4)));
typedef unsigned u32x2 __attribute__((ext_vector_type(2)));
typedef unsigned u32x4 __attribute__((ext_vector_type(4)));

constexpr int MTOK = 16384, DM = 1024, SEQ = 4096, FF = 2816;
constexpr int NTHR = 512;
constexpr int LDS_BYTES = 131072;
constexpr size_t MiB = 1048576;
constexpr size_t OFF_WIN = 0;
constexpr size_t OFF_WGLU = 4194304;
constexpr size_t OFF_WOUT = 4718592;
constexpr size_t OFF_WGU0 = 6815744;
constexpr size_t OFF_WDN0 = 18350080;
constexpr size_t OFF_WGU1 = 24117248;
constexpr size_t OFF_WDN1 = 35651584;
constexpr size_t OFF_WG1 = 41418752;
constexpr size_t OFF_WL2 = 55050240;
constexpr size_t OFF_WO = 56623104;
constexpr size_t OFF_MOD = 58720256;
constexpr size_t ACT = 57 * MiB;
constexpr size_t OFF_HA = ACT;
constexpr size_t OFF_U = ACT + 32 * MiB;
constexpr size_t OFF_QKV = ACT + 64 * MiB;
constexpr size_t OFF_CAT = ACT + 112 * MiB;
constexpr size_t OFF_YG = ACT + 144 * MiB;
constexpr size_t OFF_HID = ACT + 32 * MiB;
constexpr size_t OFF_HD = ACT;
constexpr size_t OFF_RKV = ACT + 64 * MiB;
constexpr size_t OFF_G = ACT + 160 * MiB;
constexpr size_t OFF_L1 = 0;
constexpr size_t OFF_DEC = ACT;
constexpr size_t OFF_AA = ACT + 32 * MiB;
constexpr size_t WS_NEED = ACT + 192 * MiB;

struct Params {
    const float* in[46];
    float* out;
    unsigned char* ws;
    int ph_lo, ph_hi;
};

__device__ __forceinline__ unsigned f2bf(float f) { unsigned u = __float_as_uint(f); return (u + 0x7fffu + ((u >> 16) & 1u)) >> 16; }
__device__ __forceinline__ float bf2f(unsigned h) { return __uint_as_float(h << 16); }
__device__ __forceinline__ unsigned pk2(float lo, float hi) { return f2bf(lo) | (f2bf(hi) << 16); }
__device__ __forceinline__ float bflo(unsigned w) { return __uint_as_float(w << 16); }
__device__ __forceinline__ float bfhi(unsigned w) { return __uint_as_float(w & 0xffff0000u); }
__device__ __forceinline__ float wave_sum(float v) {
#pragma unroll
    for (int o = 32; o > 0; o >>= 1) v += __shfl_xor(v, o);
    return v;
}
__device__ __forceinline__ float sigmoidf_(float x) { return 1.f / (1.f + __expf(-x)); }
#define LWAIT() asm volatile("s_waitcnt lgkmcnt(0)" ::: "memory")

constexpr int HTB = 128 * 64 * 2;
__device__ __forceinline__ int lds_byte(int r, int c) { int st = (r >> 4) * 2 + (c >> 5), rr = r & 15, cc = c & 31, ob = rr * 64 + cc * 2; return st * 1024 + (ob ^ (((ob >> 9) & 1) << 5)); }
__device__ __forceinline__ void stage_rc(int b, int& R, int& C) { int st = b / 1024, sb = b % 1024, swz = sb ^ (((sb >> 9) & 1) << 5); R = (st >> 1) * 16 + swz / 64; C = (st & 1) * 32 + (swz % 64) / 2; }

template <class Epi>
__device__ __forceinline__ void gemm_phase(LAS unsigned char* lds, const bf16_t* A, const bf16_t* Bt, int N, int K, const Epi& E, int bid, int nb) {
    const int tid = threadIdx.x, wid = __builtin_amdgcn_readfirstlane(tid >> 6), lane = tid & 63, wr = wid >> 2, wc = wid & 3, fr = lane & 15, fq = lane >> 4;
    unsigned voff[2];
#pragma unroll
    for (int i = 0; i < 2; ++i) { int R, C; stage_rc(tid * 16 + i * 8192, R, C); voff[i] = (unsigned)(R * K + C) * 2u; }
    const int aoff = lds_byte(wr * 64 + fr, fq * 8), boff = lds_byte(wc * 32 + fr, fq * 8);
    const unsigned ldsw = (unsigned)wid * 1024u;
    const size_t kstep = 128, hstep = (size_t)128 * K * 2;
    const int nt = K / 64;
    const int nN = N / 256, ntiles = 64 * nN;
#define G_SA(b, h) (((b) * 2 + (h)) * HTB)
#define G_SB(b, h) ((4 + (b) * 2 + (h)) * HTB)
#define G_STAGE(bufoff, gptr) do { _Pragma("unroll") for (int _i = 0; _i < 2; ++_i) \
        __builtin_amdgcn_global_load_lds((const unsigned*)((gptr) + voff[_i]), (LAS unsigned*)(lds + (bufoff) + ldsw + _i * 8192), 16, 0, 0); } while (0)
#define G_LDA(dst, b, h) do { _Pragma("unroll") for (int m = 0; m < 4; ++m) _Pragma("unroll") for (int k = 0; k < 2; ++k) dst[m][k] = *(const LAS bf16x8*)(lds + G_SA(b, h) + aoff + m * 2048 + k * 1024); } while (0)
#define G_LDB(dst, b, h) do { _Pragma("unroll") for (int n = 0; n < 2; ++n) _Pragma("unroll") for (int k = 0; k < 2; ++k) dst[n][k] = *(const LAS bf16x8*)(lds + G_SB(b, h) + boff + n * 2048 + k * 1024); } while (0)
#define G_MMA(ai, bj, At, Bx) do { __builtin_amdgcn_s_setprio(1); _Pragma("unroll") for (int m = 0; m < 4; ++m) _Pragma("unroll") for (int n = 0; n < 2; ++n) _Pragma("unroll") for (int k = 0; k < 2; ++k) \
        acc[ai][bj][m][n] = __builtin_amdgcn_mfma_f32_16x16x32_bf16(Bx[n][k], At[m][k], acc[ai][bj][m][n], 0, 0, 0); __builtin_amdgcn_s_setprio(0); } while (0)
#define G_WV(n) asm volatile("s_waitcnt vmcnt(" #n ")" ::: "memory")
#define G_WL(n) asm volatile("s_waitcnt lgkmcnt(" #n ")" ::: "memory")
#define G_BAR __builtin_amdgcn_s_barrier()
#define G_SCHED __builtin_amdgcn_sched_barrier(0)
    for (int tile = bid; tile < ntiles; tile += nb) {
        const int pm = tile & 63, pn = tile >> 6;
        const char* cA = (const char*)A + (size_t)pm * 256 * K * 2;
        const char* cB = (const char*)Bt + (size_t)pn * 256 * K * 2;
        f32x4 acc[2][2][4][2];
#pragma unroll
        for (int a = 0; a < 2; ++a)
#pragma unroll
            for (int b = 0; b < 2; ++b)
#pragma unroll
                for (int m = 0; m < 4; ++m)
#pragma unroll
                    for (int n = 0; n < 2; ++n) acc[a][b][m][n] = (f32x4){0.f, 0.f, 0.f, 0.f};
        bf16x8 At[4][2], B0[2][2], B1[2][2];
        G_WV(0);
        G_STAGE(G_SB(0, 0), cB); G_STAGE(G_SA(0, 0), cA); G_STAGE(G_SB(0, 1), cB + hstep); G_STAGE(G_SA(0, 1), cA + hstep);
        if (wr == 1) G_BAR;
        G_WV(4); G_BAR;
        G_STAGE(G_SB(1, 0), cB + kstep); G_STAGE(G_SA(1, 0), cA + kstep); G_STAGE(G_SB(1, 1), cB + hstep + kstep);
        G_WV(6); G_BAR;
        for (int t = 0; t < nt - 2; t += 2) {
            const char* a1 = cA + (size_t)(t + 1) * kstep; const char* a2 = cA + (size_t)(t + 2) * kstep; const char* a3 = a2 + kstep;
            const char* b2 = cB + (size_t)(t + 2) * kstep; const char* b3 = b2 + kstep;
            G_LDB(B0, 0, 0); G_SCHED; G_LDA(At, 0, 0); G_STAGE(G_SA(1, 1), a1 + hstep);
            G_WL(8); G_BAR; G_WL(0); G_MMA(0, 0, At, B0); G_BAR; G_SCHED;
            G_LDB(B1, 0, 1); G_STAGE(G_SB(0, 0), b2);
            G_BAR; G_WL(0); G_MMA(0, 1, At, B1); G_BAR;
            G_LDA(At, 0, 1); G_STAGE(G_SA(0, 0), a2);
            G_BAR; G_WL(0); G_MMA(1, 0, At, B0); G_BAR; G_SCHED;
            G_STAGE(G_SB(0, 1), b2 + hstep);
            G_WV(6); G_BAR; G_MMA(1, 1, At, B1); G_BAR;
            G_LDB(B0, 1, 0); G_SCHED; G_LDA(At, 1, 0); G_STAGE(G_SA(0, 1), a2 + hstep);
            G_WL(8); G_BAR; G_WL(0); G_MMA(0, 0, At, B0); G_BAR; G_SCHED;
            G_LDB(B1, 1, 1); G_STAGE(G_SB(1, 0), b3);
            G_BAR; G_WL(0); G_MMA(0, 1, At, B1); G_BAR;
            G_LDA(At, 1, 1); G_STAGE(G_SA(1, 0), a3);
            G_BAR; G_WL(0); G_MMA(1, 0, At, B0); G_BAR; G_SCHED;
            G_STAGE(G_SB(1, 1), b3 + hstep);
            G_WV(6); G_BAR; G_MMA(1, 1, At, B1); G_BAR;
        }
        {
            const char* a1 = cA + (size_t)(nt - 1) * kstep;
            G_LDB(B0, 0, 0); G_LDA(At, 0, 0); G_STAGE(G_SA(1, 1), a1 + hstep);
            G_BAR; G_WL(0); G_MMA(0, 0, At, B0); G_BAR;
            G_LDB(B1, 0, 1); G_BAR; G_WL(0); G_MMA(0, 1, At, B1); G_BAR;
            G_LDA(At, 0, 1); G_WV(4); G_BAR; G_WL(0); G_MMA(1, 0, At, B0); G_MMA(1, 1, At, B1); G_BAR;
        }
        {
            G_LDB(B0, 1, 0); G_LDA(At, 1, 0); G_WV(2); G_BAR; G_WL(0); G_MMA(0, 0, At, B0); G_BAR;
            G_LDB(B1, 1, 1); G_WV(0); G_BAR; G_WL(0); G_MMA(0, 1, At, B1); G_BAR;
            G_LDA(At, 1, 1); G_BAR; G_WL(0); G_MMA(1, 0, At, B0); G_MMA(1, 1, At, B1); G_BAR;
        }
        if (wr == 0) G_BAR;
        E(acc, pm, pn, wr, wc, fr, fq);
    }
    G_WV(0);
    __syncthreads();
}

#define EPI_LOOP(body) \
    _Pragma("unroll") for (int ai = 0; ai < 2; ++ai) _Pragma("unroll") for (int m = 0; m < 4; ++m) { const int row = pm * 256 + ai * 128 + wr * 64 + m * 16 + fr; \
    _Pragma("unroll") for (int bj = 0; bj < 2; ++bj) _Pragma("unroll") for (int n = 0; n < 2; ++n) { const int ct = bj * 128 + wc * 32 + n * 16 + fq * 4; const f32x4 v = acc[ai][bj][m][n]; body } }

struct EpiWin {
    float* U; bf16_t* QKV;
    __device__ __forceinline__ void operator()(const f32x4 (&acc)[2][2][4][2], int pm, int pn, int wr, int wc, int fr, int fq) const {
        if (pn < 2) { EPI_LOOP({ *(f32x4*)(U + (size_t)row * 512 + pn * 256 + ct) = v; }) }
        else { bf16_t* base = QKV + (size_t)((pn - 2) >> 1) * ((size_t)MTOK * 512) + (pn & 1) * 256;
            EPI_LOOP({ u32x2 w; w.x = pk2(v[0], v[1]); w.y = pk2(v[2], v[3]); *(u32x2*)(base + (size_t)row * 512 + ct) = w; }) }
    }
};
struct EpiGlu {
    const bf16_t* YG; bf16_t* CAT;
    __device__ __forceinline__ void operator()(const f32x4 (&acc)[2][2][4][2], int pm, int pn, int wr, int wc, int fr, int fq) const {
        EPI_LOOP({ const int col = pn * 256 + ct; const u32x2 y = *(const u32x2*)(YG + (size_t)row * 512 + col);
            u32x2 w; w.x = pk2(bflo(y.x) * sigmoidf_(v[0]), bfhi(y.x) * sigmoidf_(v[1])); w.y = pk2(bflo(y.y) * sigmoidf_(v[2]), bfhi(y.y) * sigmoidf_(v[3]));
            *(u32x2*)(CAT + (size_t)row * 1024 + col) = w; })
    }
};
struct EpiRes {
    const float* res; float* out; const float* gate;
    __device__ __forceinline__ void operator()(const f32x4 (&acc)[2][2][4][2], int pm, int pn, int wr, int wc, int fr, int fq) const {
        const float* gb = gate + (size_t)(pm >> 4) * 6144;
        EPI_LOOP({ const int col = pn * 256 + ct; const f32x4 g = *(const f32x4*)(gb + col); const f32x4 r = *(const f32x4*)(res + (size_t)row * 1024 + col);
            *(f32x4*)(out + (size_t)row * 1024 + col) = r + g * v; })
    }
};
struct EpiSwiglu {
    bf16_t* HID;
    __device__ __forceinline__ void operator()(const f32x4 (&acc)[2][2][4][2], int pm, int pn, int wr, int wc, int fr, int fq) const {
#pragma unroll
        for (int ai = 0; ai < 2; ++ai)
#pragma unroll
            for (int m = 0; m < 4; ++m) { const int row = pm * 256 + ai * 128 + wr * 64 + m * 16 + fr;
#pragma unroll
                for (int n = 0; n < 2; ++n) { const f32x4 g = acc[ai][0][m][n], u = acc[ai][1][m][n]; float o[4];
#pragma unroll
                    for (int j = 0; j < 4; ++j) o[j] = g[j] * sigmoidf_(g[j]) * u[j];
                    u32x2 w; w.x = pk2(o[0], o[1]); w.y = pk2(o[2], o[3]);
                    *(u32x2*)(HID + (size_t)row * FF + pn * 128 + wc * 32 + n * 16 + fq * 4) = w; } }
    }
};
struct EpiG1 {
    bf16_t* RKV; bf16_t* L1;
    __device__ __forceinline__ void operator()(const f32x4 (&acc)[2][2][4][2], int pm, int pn, int wr, int wc, int fr, int fq) const {
        if (pn < 12) { bf16_t* base = RKV + (size_t)(pn >> 2) * ((size_t)MTOK * 1024) + (pn & 3) * 256;
            EPI_LOOP({ u32x2 w; w.x = pk2(v[0], v[1]); w.y = pk2(v[2], v[3]); *(u32x2*)(base + (size_t)row * 1024 + ct) = w; }) }
        else { EPI_LOOP({ float o[4];
                _Pragma("unroll") for (int j = 0; j < 4; ++j) o[j] = (bj == 1) ? sigmoidf_(v[j]) : ((wc < 2) ? tanhf(v[j]) : v[j]);
                u32x2 w; w.x = pk2(o[0], o[1]); w.y = pk2(o[2], o[3]); *(u32x2*)(L1 + (size_t)row * 256 + ct) = w; }) }
    }
};
struct EpiL2 {
    _Float16* DEC; bf16_t* AA; bf16_t* G; const float* w0; const float* a0;
    __device__ __forceinline__ void operator()(const f32x4 (&acc)[2][2][4][2], int pm, int pn, int wr, int wc, int fr, int fq) const {
        const int sel = pn >> 2, cb = (pn & 3) * 256;
        if (sel == 0) { EPI_LOOP({ const int col = cb + ct; const f32x4 w0v = *(const f32x4*)(w0 + col);
                _Pragma("unroll") for (int j = 0; j < 4; ++j) { const float z = w0v[j] + v[j]; const float sp = fmaxf(-z, 0.f) + log1pf(expf(-fabsf(z))); const float e = expf(-sp - 0.5f);
                    DEC[(size_t)row * 1024 + col + j] = (_Float16)(-expm1f(-e)); } }) }
        else if (sel == 1) { EPI_LOOP({ const int col = cb + ct; const f32x4 a0v = *(const f32x4*)(a0 + col);
                u32x2 w; w.x = pk2(sigmoidf_(a0v[0] + v[0]), sigmoidf_(a0v[1] + v[1])); w.y = pk2(sigmoidf_(a0v[2] + v[2]), sigmoidf_(a0v[3] + v[3]));
                *(u32x2*)(AA + (size_t)row * 1024 + col) = w; }) }
        else { EPI_LOOP({ const int col = cb + ct; u32x2 w; w.x = pk2(v[0], v[1]); w.y = pk2(v[2], v[3]); *(u32x2*)(G + (size_t)row * 1024 + col) = w; }) }
    }
};

template <int MODE>
__device__ __forceinline__ void tr_job(const float* src, int K, int N, bf16_t* dst, int ldd, int row_off, int koff, const float* scale, float* lds, int bid, int nb) {
    const int tk = K / 64, tn = N / 64, tid = threadIdx.x;
    for (int t = bid; t < tk * tn; t += nb) {
        const int k0 = (t / tn) * 64, n0 = (t % tn) * 64;
        { const int r = tid >> 3, c = (tid & 7) * 8; const float* p = src + (size_t)(k0 + r) * N + n0 + c;
          const float4 a = *(const float4*)p, b = *(const float4*)(p + 4); const float s = scale ? scale[k0 + r] : 1.f;
          float* l = lds + r * 65 + c; l[0] = a.x * s; l[1] = a.y * s; l[2] = a.z * s; l[3] = a.w * s; l[4] = b.x * s; l[5] = b.y * s; l[6] = b.z * s; l[7] = b.w * s; }
        __syncthreads();
        { const int nl = tid >> 3, kc = (tid & 7) * 8; float v[8];
#pragma unroll
          for (int i = 0; i < 8; ++i) v[i] = lds[(kc + i) * 65 + nl];
          int n = n0 + nl; int rowi = n;
          if (MODE == 1) rowi = (n >> 7) * 256 + (n & 127);
          if (MODE == 2) rowi = (n >> 7) * 256 + 128 + (n & 127);
          u32x4 w; w.x = pk2(v[0], v[1]); w.y = pk2(v[2], v[3]); w.z = pk2(v[4], v[5]); w.w = pk2(v[6], v[7]);
          *(u32x4*)(dst + (size_t)(row_off + rowi) * ldd + koff + k0 + kc) = w; }
        __syncthreads();
    }
}

__device__ __forceinline__ void prep_phase(const Params& p, float* lds, int bid, int nb) {
    unsigned char* ws = p.ws;
    tr_job<0>(p.in[10], 1024, 2048, (bf16_t*)(ws + OFF_WIN), 1024, 0, 0, nullptr, lds, bid, nb);
    tr_job<0>(p.in[19], 512, 512, (bf16_t*)(ws + OFF_WGLU), 512, 0, 0, nullptr, lds, bid, nb);
    tr_job<0>(p.in[27], 1024, 1024, (bf16_t*)(ws + OFF_WOUT), 1024, 0, 0, nullptr, lds, bid, nb);
    for (int l = 0; l < 2; ++l) {
        bf16_t* gu = (bf16_t*)(ws + (l ? OFF_WGU1 : OFF_WGU0)); bf16_t* dn = (bf16_t*)(ws + (l ? OFF_WDN1 : OFF_WDN0));
        tr_job<1>(p.in[7] + (size_t)l * 1024 * FF, 1024, FF, gu, 1024, 0, 0, nullptr, lds, bid, nb);
        tr_job<2>(p.in[8] + (size_t)l * 1024 * FF, 1024, FF, gu, 1024, 0, 0, nullptr, lds, bid, nb);
        tr_job<0>(p.in[9] + (size_t)l * FF * 1024, FF, 1024, dn, FF, 0, 0, nullptr, lds, bid, nb);
    }
    bf16_t* g1 = (bf16_t*)(ws + OFF_WG1); const float* mu = p.in[28];
    tr_job<0>(p.in[29], 1024, 1024, g1, 2048, 0, 0, nullptr, lds, bid, nb);      tr_job<0>(p.in[29], 1024, 1024, g1, 2048, 0, 1024, mu + 0 * 1024, lds, bid, nb);
    tr_job<0>(p.in[30], 1024, 1024, g1, 2048, 1024, 0, nullptr, lds, bid, nb);   tr_job<0>(p.in[30], 1024, 1024, g1, 2048, 1024, 1024, mu + 2 * 1024, lds, bid, nb);
    tr_job<0>(p.in[31], 1024, 1024, g1, 2048, 2048, 0, nullptr, lds, bid, nb);   tr_job<0>(p.in[31], 1024, 1024, g1, 2048, 2048, 1024, mu + 3 * 1024, lds, bid, nb);
    tr_job<0>(p.in[34], 1024, 64, g1, 2048, 3072, 0, nullptr, lds, bid, nb);     tr_job<0>(p.in[34], 1024, 64, g1, 2048, 3072, 1024, mu + 1 * 1024, lds, bid, nb);
    tr_job<0>(p.in[37], 1024, 64, g1, 2048, 3136, 0, nullptr, lds, bid, nb);     tr_job<0>(p.in[37], 1024, 64, g1, 2048, 3136, 1024, mu + 4 * 1024, lds, bid, nb);
    tr_job<0>(p.in[39], 1024, 128, g1, 2048, 3200, 0, nullptr, lds, bid, nb);    tr_job<0>(p.in[39], 1024, 128, g1, 2048, 3200, 1024, mu + 5 * 1024, lds, bid, nb);
    bf16_t* l2 = (bf16_t*)(ws + OFF_WL2);
    tr_job<0>(p.in[35], 64, 1024, l2, 256, 0, 0, nullptr, lds, bid, nb);
    tr_job<0>(p.in[38], 64, 1024, l2, 256, 1024, 64, nullptr, lds, bid, nb);
    tr_job<0>(p.in[40], 128, 1024, l2, 256, 2048, 128, nullptr, lds, bid, nb);
    for (int i = bid * NTHR + threadIdx.x; i < 3072 * 32; i += nb * NTHR) { const int n = i >> 5, kc = (i & 31) * 8; const int sel = n >> 10;
        const bool used = (sel == 0) ? (kc < 64) : (sel == 1) ? (kc >= 64 && kc < 128) : (kc >= 128);
        if (!used) *(u32x4*)(l2 + (size_t)n * 256 + kc) = (u32x4){0u, 0u, 0u, 0u}; }
    tr_job<0>(p.in[32], 1024, 1024, (bf16_t*)(ws + OFF_WO), 1024, 0, 0, nullptr, lds, bid, nb);
    {   const float* c = p.in[1]; const float* wada = p.in[3]; const float* bada = p.in[4]; float* mod = (float*)(ws + OFF_MOD);
        float* cact = lds;
        float* red = lds + 4096;
        for (int i = threadIdx.x; i < 4096; i += NTHR) { const float x = c[i]; cact[i] = x / (1.f + expf(-x)); }
        __syncthreads();
        const int col = threadIdx.x & 63, kg = threadIdx.x >> 6;
        for (int ch = bid; ch < 192; ch += nb) {
            const int l = ch / 96, n0 = (ch % 96) * 64;
            const float* wp = wada + (size_t)l * 1024 * 6144 + n0 + col;
            float a0 = 0.f, a1 = 0.f, a2 = 0.f, a3 = 0.f;
            for (int k = kg * 128; k < kg * 128 + 128; ++k) { const float w = wp[(size_t)k * 6144]; a0 += cact[k] * w; a1 += cact[1024 + k] * w; a2 += cact[2048 + k] * w; a3 += cact[3072 + k] * w; }
            red[(kg * 4 + 0) * 64 + col] = a0; red[(kg * 4 + 1) * 64 + col] = a1; red[(kg * 4 + 2) * 64 + col] = a2; red[(kg * 4 + 3) * 64 + col] = a3;
            __syncthreads();
            if (threadIdx.x < 256) { const int b = threadIdx.x >> 6; float s = 0.f;
#pragma unroll
                for (int g = 0; g < 8; ++g) s += red[(g * 4 + b) * 64 + col];
                mod[(size_t)(l * 4 + b) * 6144 + n0 + col] = s + bada[l * 6144 + n0 + col]; }
            __syncthreads();
        }
    }
}

template <bool RW>
__device__ __forceinline__ void norm_phase(const float* x, const float* g, const float* modl, int shift_off, int scale_off, bf16_t* out, int bid, int nb) {
    const int wave = threadIdx.x >> 6, lane = threadIdx.x & 63;
    for (int row = bid * 8 + wave; row < MTOK; row += nb * 8) {
        const int b = row >> 12; const float* xr = x + (size_t)row * 1024; const float* md = modl + (size_t)b * 6144;
        f32x4 v[4], vp[4]; float ss = 0.f, ssp = 0.f; const bool hasp = RW && ((row & 4095) != 0);
#pragma unroll
        for (int i = 0; i < 4; ++i) { v[i] = *(const f32x4*)(xr + i * 256 + lane * 4); ss += v[i][0] * v[i][0] + v[i][1] * v[i][1] + v[i][2] * v[i][2] + v[i][3] * v[i][3];
            if (RW) { vp[i] = hasp ? *(const f32x4*)(xr - 1024 + i * 256 + lane * 4) : (f32x4){0.f, 0.f, 0.f, 0.f}; ssp += vp[i][0] * vp[i][0] + vp[i][1] * vp[i][1] + vp[i][2] * vp[i][2] + vp[i][3] * vp[i][3]; } }
        ss = wave_sum(ss); const float rstd = rsqrtf(ss * (1.f / 1024.f) + 1e-6f);
        float rstdp = 0.f; if (RW) { ssp = wave_sum(ssp); rstdp = rsqrtf(ssp * (1.f / 1024.f) + 1e-6f); }
#pragma unroll
        for (int i = 0; i < 4; ++i) { const int c = i * 256 + lane * 4; const f32x4 gg = *(const f32x4*)(g + c), sc = *(const f32x4*)(md + scale_off + c), sh = *(const f32x4*)(md + shift_off + c);
            f32x4 h;
#pragma unroll
            for (int j = 0; j < 4; ++j) h[j] = v[i][j] * rstd * gg[j] * (1.f + sc[j]) + sh[j];
            u32x2 w; w.x = pk2(h[0], h[1]); w.y = pk2(h[2], h[3]);
            if (!RW) *(u32x2*)(out + (size_t)row * 1024 + c) = w;
            else { *(u32x2*)(out + (size_t)row * 2048 + c) = w; f32x4 d;
#pragma unroll
                for (int j = 0; j < 4; ++j) { const float hp = hasp ? (vp[i][j] * rstdp * gg[j] * (1.f + sc[j]) + sh[j]) : 0.f; d[j] = hp - h[j]; }
                u32x2 w2; w2.x = pk2(d[0], d[1]); w2.y = pk2(d[2], d[3]); *(u32x2*)(out + (size_t)row * 2048 + 1024 + c) = w2; } }
    }
}

__device__ __forceinline__ void qknorm_phase(bf16_t* Q, bf16_t* Kb, const int* pos, const float* qn, const float* kn, int bid, int nb) {
    const int wave = threadIdx.x >> 6, lane = threadIdx.x & 63, l16 = lane & 15, d0 = l16 * 4;
    float invf[4];
#pragma unroll
    for (int j = 0; j < 4; ++j) invf[j] = powf(500000.f, -(float)((l16 & 1) * 4 + j) / 8.f);
    const f32x4 qw = *(const f32x4*)(qn + d0), kw = *(const f32x4*)(kn + d0);
    for (int tok = bid * 8 + wave; tok < MTOK; tok += nb * 8) {
        const float ps = (float)pos[tok];
        float cs[4], sn[4];
#pragma unroll
        for (int j = 0; j < 4; ++j) { const float ang = ps * invf[j]; cs[j] = cosf(ang); sn[j] = sinf(ang); }
#pragma unroll
        for (int bsel = 0; bsel < 2; ++bsel) { bf16_t* buf = bsel ? Kb : Q; const f32x4 w = bsel ? kw : qw;
#pragma unroll
            for (int it = 0; it < 2; ++it) { const int vec = it * 4 + (lane >> 4); bf16_t* ptr = buf + (size_t)tok * 512 + vec * 64 + d0;
                const u32x2 raw = *(const u32x2*)ptr; float y[4] = {bflo(raw.x), bfhi(raw.x), bflo(raw.y), bfhi(raw.y)};
                float ss = y[0] * y[0] + y[1] * y[1] + y[2] * y[2] + y[3] * y[3];
                ss += __shfl_xor(ss, 1); ss += __shfl_xor(ss, 2); ss += __shfl_xor(ss, 4); ss += __shfl_xor(ss, 8);
                const float rstd = rsqrtf(ss * (1.f / 64.f) + 1e-6f);
#pragma unroll
                for (int j = 0; j < 4; ++j) y[j] = y[j] * rstd * w[j];
                float pr[4];
#pragma unroll
                for (int j = 0; j < 4; ++j) pr[j] = __shfl_xor(y[j], 2);
                if (l16 < 2) {
#pragma unroll
                    for (int j = 0; j < 4; ++j) y[j] = y[j] * cs[j] - pr[j] * sn[j]; }
                else if (l16 < 4) {
#pragma unroll
                    for (int j = 0; j < 4; ++j) y[j] = y[j] * cs[j] + pr[j] * sn[j]; }
                if (!bsel) {
#pragma unroll
                    for (int j = 0; j < 4; ++j) y[j] *= 0.125f * 1.4426950408889634f; }
                u32x2 o; o.x = pk2(y[0], y[1]); o.y = pk2(y[2], y[3]); *(u32x2*)ptr = o; } }
    }
}

__device__ __forceinline__ float gelu_tanh(float x) { const float t = tanhf(0.7978845608028654f * (x + 0.044715f * x * x * x)); return 0.5f * x * (1.f + t); }
__device__ __forceinline__ void s5_naive(const Params& p, const float* U, bf16_t* YG, float* lds, int bid, int nb) {
    const int wave = threadIdx.x >> 6, lane = threadIdx.x & 63;
    float* L = lds + wave * 3328; float* Lxs = L; float* Lcr = L + 1040; float* Lci = L + 2080; float* Lus = L + 3120;
    const float* lam_re = p.in[11]; const float* lam_im = p.in[12]; const float* log_dt = p.in[13]; const float* b_re = p.in[14]; const float* b_im = p.in[15];
    const float* c_re = p.in[16]; const float* c_im = p.in[17]; const float* dsk = p.in[18];
    for (int unit = bid * 8 + wave; unit < 128; unit += nb * 8) {
        const int b = unit >> 5, g = unit & 31;
        const float lr = lam_re[g * 64 + lane], li = lam_im[g * 64 + lane], dt = expf(log_dt[g]);
        const float mag = expf(lr * dt), ar = mag * cosf(li * dt), ai = mag * sinf(li * dt);
        const float den = lr * lr + li * li, nr = ar - 1.f;
        const float qr = (nr * lr + ai * li) / den, qi = (ai * lr - nr * li) / den;
        float bbr[16], bbi[16];
#pragma unroll
        for (int h = 0; h < 16; ++h) { const float br = b_re[(size_t)(g * 64 + lane) * 16 + h], bi = b_im[(size_t)(g * 64 + lane) * 16 + h]; bbr[h] = qr * br - qi * bi; bbi[h] = qr * bi + qi * br; }
#pragma unroll
        for (int h = 0; h < 16; ++h) { Lcr[h * 65 + lane] = c_re[(size_t)(g * 16 + h) * 64 + lane]; Lci[h * 65 + lane] = c_im[(size_t)(g * 16 + h) * 64 + lane]; }
        const int hh = lane & 15, tq = lane >> 4;
        const float dd = dsk[g * 16 + hh];
        float xr = 0.f, xi = 0.f;
        for (int t0 = 0; t0 < SEQ; t0 += 8) {
            { const int idx = lane * 2, tk = idx >> 4, h = idx & 15; const float2 uu = *(const float2*)(U + ((size_t)b * SEQ + t0 + tk) * 512 + g * 16 + h); Lus[idx] = uu.x; Lus[idx + 1] = uu.y; }
            LWAIT();
#pragma unroll
            for (int tt = 0; tt < 8; ++tt) { float bur = 0.f, bui = 0.f;
#pragma unroll
                for (int h = 0; h < 16; ++h) { const float u = Lus[tt * 16 + h]; bur += bbr[h] * u; bui += bbi[h] * u; }
                const float nxr = ar * xr - ai * xi + bur, nxi = ar * xi + ai * xr + bui; xr = nxr; xi = nxi;
                Lxs[tt * 130 + lane] = xr; Lxs[tt * 130 + 64 + lane] = xi; }
            LWAIT();
#pragma unroll
            for (int i = 0; i < 2; ++i) { const int t = tq + 4 * i; float y = 0.f;
                for (int pp = 0; pp < 64; ++pp) y += Lcr[hh * 65 + pp] * Lxs[t * 130 + pp] - Lci[hh * 65 + pp] * Lxs[t * 130 + 64 + pp];
                y += dd * Lus[t * 16 + hh];
                YG[((size_t)b * SEQ + t0 + t) * 512 + g * 16 + hh] = (bf16_t)f2bf(gelu_tanh(y)); }
            LWAIT();
        }
    }
}

__device__ __forceinline__ void attn_naive(const bf16_t* Q, const bf16_t* Kb, const bf16_t* V, bf16_t* CAT, const Params& p, float* lds, int bid, int nb) {
    const int wave = __builtin_amdgcn_readfirstlane(threadIdx.x >> 6), lane = threadIdx.x & 63, head = wave >> 1, c = wave & 1, eh = lane >> 5, rl = lane & 31;
    float lam;
    { float s1 = 0.f, s2 = 0.f; for (int d = 0; d < 64; ++d) { s1 += p.in[22][d] * p.in[23][d]; s2 += p.in[24][d] * p.in[25][d]; } lam = expf(s1) - expf(s2) + 0.2f; }
    const float* subln = p.in[26];
    for (int unit = bid; unit < 512; unit += nb) {
        const int b = unit & 3, qb = 127 - (unit >> 2); const int i = qb * 32 + rl; const size_t tok = (size_t)b * SEQ + i;
        float q[64];
        { const u32x4* qp = (const u32x4*)(Q + tok * 512 + head * 128 + c * 64);
#pragma unroll
          for (int d8 = 0; d8 < 8; ++d8) { const u32x4 w = qp[d8]; q[d8 * 8 + 0] = bflo(w.x); q[d8 * 8 + 1] = bfhi(w.x); q[d8 * 8 + 2] = bflo(w.y); q[d8 * 8 + 3] = bfhi(w.y); q[d8 * 8 + 4] = bflo(w.z); q[d8 * 8 + 5] = bfhi(w.z); q[d8 * 8 + 6] = bflo(w.w); q[d8 * 8 + 7] = bfhi(w.w); } }
        float acc[64];
#pragma unroll
        for (int e = 0; e < 64; ++e) acc[e] = 0.f;
        float mx = -INFINITY, l = 0.f;
        const int jmax = qb * 32 + 31;
        for (int j = 0; j <= jmax; ++j) {
            const u32x4* kp = (const u32x4*)(Kb + ((size_t)b * SEQ + j) * 512 + head * 128 + c * 64);
            float s = 0.f;
#pragma unroll
            for (int d8 = 0; d8 < 8; ++d8) { const u32x4 w = kp[d8]; s += q[d8 * 8 + 0] * bflo(w.x) + q[d8 * 8 + 1] * bfhi(w.x) + q[d8 * 8 + 2] * bflo(w.y) + q[d8 * 8 + 3] * bfhi(w.y) + q[d8 * 8 + 4] * bflo(w.z) + q[d8 * 8 + 5] * bfhi(w.z) + q[d8 * 8 + 6] * bflo(w.w) + q[d8 * 8 + 7] * bfhi(w.w); }
            if (j <= i) {
                if (s > mx) { const float al = exp2f(mx - s); l *= al;
#pragma unroll
                    for (int e = 0; e < 64; ++e) acc[e] *= al;
                    mx = s; }
                const float pe = exp2f(s - mx); l += pe;
                const u32x4* vp = (const u32x4*)(V + ((size_t)b * SEQ + j) * 512 + head * 128 + eh * 64);
#pragma unroll
                for (int e8 = 0; e8 < 8; ++e8) { const u32x4 w = vp[e8]; acc[e8 * 8 + 0] += pe * bflo(w.x); acc[e8 * 8 + 1] += pe * bfhi(w.x); acc[e8 * 8 + 2] += pe * bflo(w.y); acc[e8 * 8 + 3] += pe * bfhi(w.y); acc[e8 * 8 + 4] += pe * bflo(w.z); acc[e8 * 8 + 5] += pe * bfhi(w.z); acc[e8 * 8 + 6] += pe * bflo(w.w); acc[e8 * 8 + 7] += pe * bfhi(w.w); }
            }
        }
        const float inv = 1.f / l;
        if (c == 1) {
#pragma unroll
            for (int e = 0; e < 64; ++e) lds[(head * 128 + eh * 64 + e) * 32 + rl] = acc[e] * inv; }
        __syncthreads();
        if (c == 0) { float ss = 0.f;
#pragma unroll
            for (int e = 0; e < 64; ++e) { const float o = acc[e] * inv - lam * lds[(head * 128 + eh * 64 + e) * 32 + rl]; acc[e] = o; ss += o * o; }
            ss += __shfl_xor(ss, 32);
            const float rstd = rsqrtf(ss * (1.f / 128.f) + 1e-6f) * 0.8f;
            unsigned* op = (unsigned*)(CAT + tok * 1024 + 512 + head * 128 + eh * 64);
#pragma unroll
            for (int e = 0; e < 64; e += 2) op[e >> 1] = pk2(acc[e] * rstd * subln[eh * 64 + e], acc[e + 1] * rstd * subln[eh * 64 + e + 1]); }
        __syncthreads();
    }
}

__device__ __forceinline__ void rwkv_naive(const Params& p, bf16_t* R, const bf16_t* Kk, const bf16_t* Vv, const _Float16* DEC, const bf16_t* AA, const bf16_t* G, float* lds, int bid, int nb) {
    const int wave = threadIdx.x >> 6, lane = threadIdx.x & 63;
    float* L = lds + wave * 1280;
    for (int unit = bid * 8 + wave; unit < 64; unit += nb * 8) {
        const int b = unit >> 4, h = unit & 15;
        float S[64];
#pragma unroll
        for (int j = 0; j < 64; ++j) S[j] = 0.f;
        const float kkw = p.in[41][h * 64 + lane], kaw = p.in[42][h * 64 + lane], rkw = p.in[43][h * 64 + lane], lng = p.in[44][h * 64 + lane], lnb = p.in[45][h * 64 + lane];
        for (int t0 = 0; t0 < SEQ; t0 += 4) {
            float vv[4], gg[4], bon[4];
#pragma unroll
            for (int tt = 0; tt < 4; ++tt) { const size_t off = ((size_t)b * SEQ + t0 + tt) * 1024 + h * 64 + lane;
                const float r = bf2f(R[off]), k = bf2f(Kk[off]), v = bf2f(Vv[off]), dec = 1.f - (float)DEC[off], a = bf2f(AA[off]); gg[tt] = bf2f(G[off]);
                float kk = k * kkw; const float n2 = wave_sum(kk * kk); kk = kk / fmaxf(sqrtf(n2), 1e-12f);
                const float k2 = k * (1.f + (a - 1.f) * kaw); const float bb = kk * a;
                bon[tt] = wave_sum(r * k2 * rkw) * v; vv[tt] = v;
                L[(0 * 4 + tt) * 64 + lane] = dec; L[(1 * 4 + tt) * 64 + lane] = -kk; L[(2 * 4 + tt) * 64 + lane] = bb; L[(3 * 4 + tt) * 64 + lane] = k2; L[(4 * 4 + tt) * 64 + lane] = r; }
            LWAIT();
#pragma unroll
            for (int tt = 0; tt < 4; ++tt) {
                const f32x4* Lw = (const f32x4*)(L + (0 * 4 + tt) * 64); const f32x4* Lk = (const f32x4*)(L + (1 * 4 + tt) * 64); const f32x4* Lb = (const f32x4*)(L + (2 * 4 + tt) * 64);
                const f32x4* Lkk = (const f32x4*)(L + (3 * 4 + tt) * 64); const f32x4* Lr = (const f32x4*)(L + (4 * 4 + tt) * 64);
                float sa = 0.f;
#pragma unroll
                for (int j4 = 0; j4 < 16; ++j4) { const f32x4 a = Lk[j4]; sa += S[j4 * 4 + 0] * a[0] + S[j4 * 4 + 1] * a[1] + S[j4 * 4 + 2] * a[2] + S[j4 * 4 + 3] * a[3]; }
                float y = 0.f; const float v = vv[tt];
#pragma unroll
                for (int j4 = 0; j4 < 16; ++j4) { const f32x4 w = Lw[j4], bb = Lb[j4], k2 = Lkk[j4], r = Lr[j4];
#pragma unroll
                    for (int j = 0; j < 4; ++j) { const float s = S[j4 * 4 + j] * w[j] + sa * bb[j] + v * k2[j]; S[j4 * 4 + j] = s; y += s * r[j]; } }
                const float mean = wave_sum(y) * (1.f / 64.f); const float d = y - mean; const float var = wave_sum(d * d) * (1.f / 64.f);
                const float yn = d * rsqrtf(var + 64e-5f) * lng + lnb + bon[tt];
                R[((size_t)b * SEQ + t0 + tt) * 1024 + h * 64 + lane] = (bf16_t)f2bf(yn * gg[tt]); }
            LWAIT();
        }
    }
}

__global__ void __launch_bounds__(NTHR) fwd_kernel(Params p) {
    extern __shared__ __attribute__((aligned(16))) unsigned char lds_raw[];
    LAS unsigned char* lds = (LAS unsigned char*)lds_raw;
    float* ldsf = (float*)lds_raw;
    const int bid = blockIdx.x, nb = gridDim.x;
    unsigned char* ws = p.ws;
    float* mod = (float*)(ws + OFF_MOD);
    const bool multi = (p.ph_hi - p.ph_lo) > 1;
#ifndef TESTPH
#define TESTPH -1
#endif
#define PH(k) if ((TESTPH < 0 || TESTPH == (k)) && p.ph_lo <= (k) && (k) < p.ph_hi)
#define SYNC(k) if (multi && (k) + 1 < p.ph_hi) { cg::this_grid().sync(); }
    PH(0) { prep_phase(p, ldsf, bid, nb); SYNC(0) }
    PH(1) { norm_phase<false>(p.in[0], p.in[5], mod, 0, 1024, (bf16_t*)(ws + OFF_HA), bid, nb); SYNC(1) }
    PH(2) { EpiWin e{(float*)(ws + OFF_U), (bf16_t*)(ws + OFF_QKV)}; gemm_phase(lds, (const bf16_t*)(ws + OFF_HA), (const bf16_t*)(ws + OFF_WIN), 2048, 1024, e, bid, nb); SYNC(2) }
    PH(3) { bf16_t* q = (bf16_t*)(ws + OFF_QKV); qknorm_phase(q, q + (size_t)MTOK * 512, (const int*)p.in[2], p.in[20], p.in[21], bid, nb); SYNC(3) }
    PH(4) { s5_naive(p, (const float*)(ws + OFF_U), (bf16_t*)(ws + OFF_YG), ldsf, bid, nb); SYNC(4) }
    PH(5) { bf16_t* q = (bf16_t*)(ws + OFF_QKV); attn_naive(q, q + (size_t)MTOK * 512, q + (size_t)MTOK * 1024, (bf16_t*)(ws + OFF_CAT), p, ldsf, bid, nb); SYNC(5) }
    PH(6) { EpiGlu e{(const bf16_t*)(ws + OFF_YG), (bf16_t*)(ws + OFF_CAT)}; gemm_phase(lds, (const bf16_t*)(ws + OFF_YG), (const bf16_t*)(ws + OFF_WGLU), 512, 512, e, bid, nb); SYNC(6) }
    PH(7) { EpiRes e{p.in[0], p.out, mod + 2048}; gemm_phase(lds, (const bf16_t*)(ws + OFF_CAT), (const bf16_t*)(ws + OFF_WOUT), 1024, 1024, e, bid, nb); SYNC(7) }
    PH(8) { norm_phase<false>(p.out, p.in[6], mod, 3072, 4096, (bf16_t*)(ws + OFF_HA), bid, nb); SYNC(8) }
    PH(9) { EpiSwiglu e{(bf16_t*)(ws + OFF_HID)}; gemm_phase(lds, (const bf16_t*)(ws + OFF_HA), (const bf16_t*)(ws + OFF_WGU0), 5632, 1024, e, bid, nb); SYNC(9) }
    PH(10) { EpiRes e{p.out, p.out, mod + 5120}; gemm_phase(lds, (const bf16_t*)(ws + OFF_HID), (const bf16_t*)(ws + OFF_WDN0), 1024, FF, e, bid, nb); SYNC(10) }
    const float* mod1 = mod + 4 * 6144;
    PH(11) { norm_phase<true>(p.out, p.in[5] + 1024, mod1, 0, 1024, (bf16_t*)(ws + OFF_HD), bid, nb); SYNC(11) }
    PH(12) { EpiG1 e{(bf16_t*)(ws + OFF_RKV), (bf16_t*)(ws + OFF_L1)}; gemm_phase(lds, (const bf16_t*)(ws + OFF_HD), (const bf16_t*)(ws + OFF_WG1), 3328, 2048, e, bid, nb); SYNC(12) }
    PH(13) { EpiL2 e{(_Float16*)(ws + OFF_DEC), (bf16_t*)(ws + OFF_AA), (bf16_t*)(ws + OFF_G), p.in[33], p.in[36]}; gemm_phase(lds, (const bf16_t*)(ws + OFF_L1), (const bf16_t*)(ws + OFF_WL2), 3072, 256, e, bid, nb); SYNC(13) }
    PH(14) { bf16_t* r = (bf16_t*)(ws + OFF_RKV); rwkv_naive(p, r, r + (size_t)MTOK * 1024, r + (size_t)MTOK * 2048, (const _Float16*)(ws + OFF_DEC), (const bf16_t*)(ws + OFF_AA), (const bf16_t*)(ws + OFF_G), ldsf, bid, nb); SYNC(14) }
    PH(15) { EpiRes e{p.out, p.out, mod1 + 2048}; gemm_phase(lds, (const bf16_t*)(ws + OFF_RKV), (const bf16_t*)(ws + OFF_WO), 1024, 1024, e, bid, nb); SYNC(15) }
    PH(16) { norm_phase<false>(p.out, p.in[6] + 1024, mod1, 3072, 4096, (bf16_t*)(ws + OFF_HA), bid, nb); SYNC(16) }
    PH(17) { EpiSwiglu e{(bf16_t*)(ws + OFF_HID)}; gemm_phase(lds, (const bf16_t*)(ws + OFF_HA), (const bf16_t*)(ws + OFF_WGU1), 5632, 1024, e, bid, nb); SYNC(17) }
    PH(18) { EpiRes e{p.out, p.out, mod1 + 5120}; gemm_phase(lds, (const bf16_t*)(ws + OFF_HID), (const bf16_t*)(ws + OFF_WDN1), 1024, FF, e, bid, nb); }
}

constexpr int NPHASE = 19;
#ifndef ONE_LAUNCH
#define ONE_LAUNCH 1
#endif

extern "C" void kernel_launch(void* const* d_in, const int* in_sizes, int n_in, void* d_out, int out_size, void* d_ws, size_t ws_size, hipStream_t stream) {
    static int grid = 0;
    if (grid == 0) {
        if (n_in != 46 || ws_size < WS_NEED) { fprintf(stderr, "kernel_launch: unexpected n_in %d / ws_size %zu (need %zu)\n", n_in, ws_size, (size_t)WS_NEED); grid = -1; return; }
        if (hipFuncSetAttribute((const void*)fwd_kernel, hipFuncAttributeMaxDynamicSharedMemorySize, LDS_BYTES) != hipSuccess) { fprintf(stderr, "hipFuncSetAttribute failed\n"); grid = -1; return; }
        int dev = 0, cus = 0, per_cu = 0;
        (void)hipGetDevice(&dev); (void)hipDeviceGetAttribute(&cus, hipDeviceAttributeMultiprocessorCount, dev);
        (void)hipOccupancyMaxActiveBlocksPerMultiprocessor(&per_cu, (const void*)fwd_kernel, NTHR, LDS_BYTES);
        if (per_cu < 1) per_cu = 1;
        grid = cus;
    }
    if (grid < 0) return;
    Params p{};
    for (int i = 0; i < 46; ++i) p.in[i] = (const float*)d_in[i];
    p.out = (float*)d_out; p.ws = (unsigned char*)d_ws;
#if ONE_LAUNCH
    p.ph_lo = 0; p.ph_hi = NPHASE;
    void* args[] = {&p};
    hipError_t e = hipLaunchCooperativeKernel((const void*)fwd_kernel, dim3(grid), dim3(NTHR), args, LDS_BYTES, stream);
    if (e != hipSuccess) fprintf(stderr, "cooperative launch failed: %s (grid %d)\n", hipGetErrorString(e), grid);
#else
    for (int ph = 0; ph < NPHASE; ++ph) { p.ph_lo = ph; p.ph_hi = ph + 1; hipLaunchKernelGGL(fwd_kernel, dim3(grid), dim3(NTHR), LDS_BYTES, stream, p); }
#endif
}
```

```cpp
#include <hip/hip_runtime.h>
#include <hip/hip_cooperative_groups.h>
#include <cstdio>
#include <cstdint>
namespace cg = cooperative_groups;

#define LAS __attribute__((address_space(3)))
typedef unsigned short bf16_t;
typedef short bf16x8 __attribute__((ext_vector_type(8)));
typedef float f32x4 __attribute__((ext_vector_type(4)));
typedef unsigned u32x2 __attribute__((ext_vector_type(2)));
typedef unsigned u32x4 __attribute__((ext_vector_type(4)));

constexpr int MTOK = 16384, DM = 1024, SEQ = 4096, FF = 2816;
constexpr int NTHR = 512;
constexpr int LDS_BYTES = 131072;
constexpr size_t MiB = 1048576;
constexpr size_t OFF_WIN = 0;
constexpr size_t OFF_WGLU = 4194304;
constexpr size_t OFF_WOUT = 4718592;
constexpr size_t OFF_WGU0 = 6815744;
constexpr size_t OFF_WDN0 = 18350080;
constexpr size_t OFF_WGU1 = 24117248;
constexpr size_t OFF_WDN1 = 35651584;
constexpr size_t OFF_WG1 = 41418752;
constexpr size_t OFF_WL2 = 55050240;
constexpr size_t OFF_WO = 56623104;
constexpr size_t OFF_MOD = 58720256;
constexpr size_t ACT = 57 * MiB;
constexpr size_t OFF_HA = ACT;
constexpr size_t OFF_U = ACT + 32 * MiB;
constexpr size_t OFF_QKV = ACT + 64 * MiB;
constexpr size_t OFF_CAT = ACT + 112 * MiB;
constexpr size_t OFF_YG = ACT + 144 * MiB;
constexpr size_t OFF_VT = ACT + 160 * MiB;
constexpr size_t OFF_OC = ACT;
constexpr size_t OFF_HID = ACT + 32 * MiB;
constexpr size_t OFF_HD = ACT;
constexpr size_t OFF_RKV = ACT + 64 * MiB;
constexpr size_t OFF_G = ACT + 160 * MiB;
constexpr size_t OFF_L1 = 0;
constexpr size_t OFF_DEC = ACT;
constexpr size_t OFF_AA = ACT + 32 * MiB;
constexpr size_t WS_NEED = ACT + 192 * MiB;

struct Params {
    const float* in[46];
    float* out;
    unsigned char* ws;
    int ph_lo, ph_hi;
};

__device__ __forceinline__ unsigned f2bf(float f) { unsigned u = __float_as_uint(f); return (u + 0x7fffu + ((u >> 16) & 1u)) >> 16; }
__device__ __forceinline__ float bf2f(unsigned h) { return __uint_as_float(h << 16); }
__device__ __forceinline__ unsigned pk2(float lo, float hi) { return f2bf(lo) | (f2bf(hi) << 16); }
__device__ __forceinline__ float bflo(unsigned w) { return __uint_as_float(w << 16); }
__device__ __forceinline__ float bfhi(unsigned w) { return __uint_as_float(w & 0xffff0000u); }
__device__ __forceinline__ float wave_sum(float v) {
#pragma unroll
    for (int o = 32; o > 0; o >>= 1) v += __shfl_xor(v, o);
    return v;
}
__device__ __forceinline__ float sigmoidf_(float x) { return 1.f / (1.f + __expf(-x)); }
#define LWAIT() asm volatile("s_waitcnt lgkmcnt(0)" ::: "memory")

constexpr int HTB = 128 * 64 * 2;
__device__ __forceinline__ int lds_byte(int r, int c) { int st = (r >> 4) * 2 + (c >> 5), rr = r & 15, cc = c & 31, ob = rr * 64 + cc * 2; return st * 1024 + (ob ^ (((ob >> 9) & 1) << 5)); }
__device__ __forceinline__ void stage_rc(int b, int& R, int& C) { int st = b / 1024, sb = b % 1024, swz = sb ^ (((sb >> 9) & 1) << 5); R = (st >> 1) * 16 + swz / 64; C = (st & 1) * 32 + (swz % 64) / 2; }

template <class Epi>
__device__ __forceinline__ void gemm_phase(LAS unsigned char* lds, const bf16_t* A, const bf16_t* Bt, int N, int K, const Epi& E, int bid, int nb) {
    const int tid = threadIdx.x, wid = __builtin_amdgcn_readfirstlane(tid >> 6), lane = tid & 63, wr = wid >> 2, wc = wid & 3, fr = lane & 15, fq = lane >> 4;
    unsigned voff[2];
#pragma unroll
    for (int i = 0; i < 2; ++i) { int R, C; stage_rc(tid * 16 + i * 8192, R, C); voff[i] = (unsigned)(R * K + C) * 2u; }
    const int aoff = lds_byte(wr * 64 + fr, fq * 8), boff = lds_byte(wc * 32 + fr, fq * 8);
    const unsigned ldsw = (unsigned)wid * 1024u;
    const size_t kstep = 128, hstep = (size_t)128 * K * 2;
    const int nt = K / 64;
    const int nN = N / 256, ntiles = 64 * nN;
#define G_SA(b, h) (((b) * 2 + (h)) * HTB)
#define G_SB(b, h) ((4 + (b) * 2 + (h)) * HTB)
#define G_STAGE(bufoff, gptr) do { _Pragma("unroll") for (int _i = 0; _i < 2; ++_i) \
        __builtin_amdgcn_global_load_lds((const unsigned*)((gptr) + voff[_i]), (LAS unsigned*)(lds + (bufoff) + ldsw + _i * 8192), 16, 0, 0); } while (0)
#define G_LDA(dst, b, h) do { _Pragma("unroll") for (int m = 0; m < 4; ++m) _Pragma("unroll") for (int k = 0; k < 2; ++k) dst[m][k] = *(const LAS bf16x8*)(lds + G_SA(b, h) + aoff + m * 2048 + k * 1024); } while (0)
#define G_LDB(dst, b, h) do { _Pragma("unroll") for (int n = 0; n < 2; ++n) _Pragma("unroll") for (int k = 0; k < 2; ++k) dst[n][k] = *(const LAS bf16x8*)(lds + G_SB(b, h) + boff + n * 2048 + k * 1024); } while (0)
#define G_MMA(ai, bj, At, Bx) do { __builtin_amdgcn_s_setprio(1); _Pragma("unroll") for (int m = 0; m < 4; ++m) _Pragma("unroll") for (int n = 0; n < 2; ++n) _Pragma("unroll") for (int k = 0; k < 2; ++k) \
        acc[ai][bj][m][n] = __builtin_amdgcn_mfma_f32_16x16x32_bf16(Bx[n][k], At[m][k], acc[ai][bj][m][n], 0, 0, 0); __builtin_amdgcn_s_setprio(0); } while (0)
#define G_WV(n) asm volatile("s_waitcnt vmcnt(" #n ")" ::: "memory")
#define G_WL(n) asm volatile("s_waitcnt lgkmcnt(" #n ")" ::: "memory")
#define G_BAR __builtin_amdgcn_s_barrier()
#define G_SCHED __builtin_amdgcn_sched_barrier(0)
    for (int tile = bid; tile < ntiles; tile += nb) {
        const int pm = tile & 63, pn = tile >> 6;
        const char* cA = (const char*)A + (size_t)pm * 256 * K * 2;
        const char* cB = (const char*)Bt + (size_t)pn * 256 * K * 2;
        f32x4 acc[2][2][4][2];
#pragma unroll
        for (int a = 0; a < 2; ++a)
#pragma unroll
            for (int b = 0; b < 2; ++b)
#pragma unroll
                for (int m = 0; m < 4; ++m)
#pragma unroll
                    for (int n = 0; n < 2; ++n) acc[a][b][m][n] = (f32x4){0.f, 0.f, 0.f, 0.f};
        bf16x8 At[4][2], B0[2][2], B1[2][2];
        G_WV(0);
        G_STAGE(G_SB(0, 0), cB); G_STAGE(G_SA(0, 0), cA); G_STAGE(G_SB(0, 1), cB + hstep); G_STAGE(G_SA(0, 1), cA + hstep);
        if (wr == 1) G_BAR;
        G_WV(4); G_BAR;
        G_STAGE(G_SB(1, 0), cB + kstep); G_STAGE(G_SA(1, 0), cA + kstep); G_STAGE(G_SB(1, 1), cB + hstep + kstep);
        G_WV(6); G_BAR;
        for (int t = 0; t < nt - 2; t += 2) {
            const char* a1 = cA + (size_t)(t + 1) * kstep; const char* a2 = cA + (size_t)(t + 2) * kstep; const char* a3 = a2 + kstep;
            const char* b2 = cB + (size_t)(t + 2) * kstep; const char* b3 = b2 + kstep;
            G_LDB(B0, 0, 0); G_SCHED; G_LDA(At, 0, 0); G_STAGE(G_SA(1, 1), a1 + hstep);
            G_WL(8); G_BAR; G_WL(0); G_MMA(0, 0, At, B0); G_BAR; G_SCHED;
            G_LDB(B1, 0, 1); G_STAGE(G_SB(0, 0), b2);
            G_BAR; G_WL(0); G_MMA(0, 1, At, B1); G_BAR;
            G_LDA(At, 0, 1); G_STAGE(G_SA(0, 0), a2);
            G_BAR; G_WL(0); G_MMA(1, 0, At, B0); G_BAR; G_SCHED;
            G_STAGE(G_SB(0, 1), b2 + hstep);
            G_WV(6); G_BAR; G_MMA(1, 1, At, B1); G_BAR;
            G_LDB(B0, 1, 0); G_SCHED; G_LDA(At, 1, 0); G_STAGE(G_SA(0, 1), a2 + hstep);
            G_WL(8); G_BAR; G_WL(0); G_MMA(0, 0, At, B0); G_BAR; G_SCHED;
            G_LDB(B1, 1, 1); G_STAGE(G_SB(1, 0), b3);
            G_BAR; G_WL(0); G_MMA(0, 1, At, B1); G_BAR;
            G_LDA(At, 1, 1); G_STAGE(G_SA(1, 0), a3);
            G_BAR; G_WL(0); G_MMA(1, 0, At, B0); G_BAR; G_SCHED;
            G_STAGE(G_SB(1, 1), b3 + hstep);
            G_WV(6); G_BAR; G_MMA(1, 1, At, B1); G_BAR;
        }
        {
            const char* a1 = cA + (size_t)(nt - 1) * kstep;
            G_LDB(B0, 0, 0); G_LDA(At, 0, 0); G_STAGE(G_SA(1, 1), a1 + hstep);
            G_BAR; G_WL(0); G_MMA(0, 0, At, B0); G_BAR;
            G_LDB(B1, 0, 1); G_BAR; G_WL(0); G_MMA(0, 1, At, B1); G_BAR;
            G_LDA(At, 0, 1); G_WV(4); G_BAR; G_WL(0); G_MMA(1, 0, At, B0); G_MMA(1, 1, At, B1); G_BAR;
        }
        {
            G_LDB(B0, 1, 0); G_LDA(At, 1, 0); G_WV(2); G_BAR; G_WL(0); G_MMA(0, 0, At, B0); G_BAR;
            G_LDB(B1, 1, 1); G_WV(0); G_BAR; G_WL(0); G_MMA(0, 1, At, B1); G_BAR;
            G_LDA(At, 1, 1); G_BAR; G_WL(0); G_MMA(1, 0, At, B0); G_MMA(1, 1, At, B1); G_BAR;
        }
        if (wr == 0) G_BAR;
        E(acc, pm, pn, wr, wc, fr, fq);
    }
    G_WV(0);
    __syncthreads();
}

#define EPI_LOOP(body) \
    _Pragma("unroll") for (int ai = 0; ai < 2; ++ai) _Pragma("unroll") for (int m = 0; m < 4; ++m) { const int row = pm * 256 + ai * 128 + wr * 64 + m * 16 + fr; \
    _Pragma("unroll") for (int bj = 0; bj < 2; ++bj) _Pragma("unroll") for (int n = 0; n < 2; ++n) { const int ct = bj * 128 + wc * 32 + n * 16 + fq * 4; const f32x4 v = acc[ai][bj][m][n]; body } }

struct EpiWin {
    float* U; bf16_t* QKV;
    __device__ __forceinline__ void operator()(const f32x4 (&acc)[2][2][4][2], int pm, int pn, int wr, int wc, int fr, int fq) const {
        if (pn < 2) { EPI_LOOP({ *(f32x4*)(U + (size_t)row * 512 + pn * 256 + ct) = v; }) }
        else { bf16_t* base = QKV + (size_t)((pn - 2) >> 1) * ((size_t)MTOK * 512) + (pn & 1) * 256;
            EPI_LOOP({ u32x2 w; w.x = pk2(v[0], v[1]); w.y = pk2(v[2], v[3]); *(u32x2*)(base + (size_t)row * 512 + ct) = w; }) }
    }
};
struct EpiGlu {
    const bf16_t* YG; bf16_t* CAT;
    __device__ __forceinline__ void operator()(const f32x4 (&acc)[2][2][4][2], int pm, int pn, int wr, int wc, int fr, int fq) const {
        EPI_LOOP({ const int col = pn * 256 + ct; const u32x2 y = *(const u32x2*)(YG + (size_t)row * 512 + col);
            u32x2 w; w.x = pk2(bflo(y.x) * sigmoidf_(v[0]), bfhi(y.x) * sigmoidf_(v[1])); w.y = pk2(bflo(y.y) * sigmoidf_(v[2]), bfhi(y.y) * sigmoidf_(v[3]));
            *(u32x2*)(CAT + (size_t)row * 1024 + col) = w; })
    }
};
struct EpiRes {
    const float* res; float* out; const float* gate;
    __device__ __forceinline__ void operator()(const f32x4 (&acc)[2][2][4][2], int pm, int pn, int wr, int wc, int fr, int fq) const {
        const float* gb = gate + (size_t)(pm >> 4) * 6144;
        EPI_LOOP({ const int col = pn * 256 + ct; const f32x4 g = *(const f32x4*)(gb + col); const f32x4 r = *(const f32x4*)(res + (size_t)row * 1024 + col);
            *(f32x4*)(out + (size_t)row * 1024 + col) = r + g * v; })
    }
};
struct EpiSwiglu {
    bf16_t* HID;
    __device__ __forceinline__ void operator()(const f32x4 (&acc)[2][2][4][2], int pm, int pn, int wr, int wc, int fr, int fq) const {
#pragma unroll
        for (int ai = 0; ai < 2; ++ai)
#pragma unroll
            for (int m = 0; m < 4; ++m) { const int row = pm * 256 + ai * 128 + wr * 64 + m * 16 + fr;
#pragma unroll
                for (int n = 0; n < 2; ++n) { const f32x4 g = acc[ai][0][m][n], u = acc[ai][1][m][n]; float o[4];
#pragma unroll
                    for (int j = 0; j < 4; ++j) o[j] = g[j] * sigmoidf_(g[j]) * u[j];
                    u32x2 w; w.x = pk2(o[0], o[1]); w.y = pk2(o[2], o[3]);
                    *(u32x2*)(HID + (size_t)row * FF + pn * 128 + wc * 32 + n * 16 + fq * 4) = w; } }
    }
};
struct EpiG1 {
    bf16_t* RKV; bf16_t* L1;
    __device__ __forceinline__ void operator()(const f32x4 (&acc)[2][2][4][2], int pm, int pn, int wr, int wc, int fr, int fq) const {
        if (pn < 12) { bf16_t* base = RKV + (size_t)(pn >> 2) * ((size_t)MTOK * 1024) + (pn & 3) * 256;
            EPI_LOOP({ u32x2 w; w.x = pk2(v[0], v[1]); w.y = pk2(v[2], v[3]); *(u32x2*)(base + (size_t)row * 1024 + ct) = w; }) }
        else { EPI_LOOP({ float o[4];
                _Pragma("unroll") for (int j = 0; j < 4; ++j) o[j] = (bj == 1) ? sigmoidf_(v[j]) : ((wc < 2) ? tanhf(v[j]) : v[j]);
                u32x2 w; w.x = pk2(o[0], o[1]); w.y = pk2(o[2], o[3]); *(u32x2*)(L1 + (size_t)row * 256 + ct) = w; }) }
    }
};
struct EpiL2 {
    _Float16* DEC; bf16_t* AA; bf16_t* G; const float* w0; const float* a0;
    __device__ __forceinline__ void operator()(const f32x4 (&acc)[2][2][4][2], int pm, int pn, int wr, int wc, int fr, int fq) const {
        const int sel = pn >> 2, cb = (pn & 3) * 256;
        if (sel == 0) { EPI_LOOP({ const int col = cb + ct; const f32x4 w0v = *(const f32x4*)(w0 + col);
                _Pragma("unroll") for (int j = 0; j < 4; ++j) { const float z = w0v[j] + v[j]; const float sp = fmaxf(-z, 0.f) + log1pf(expf(-fabsf(z))); const float e = expf(-sp - 0.5f);
                    DEC[(size_t)row * 1024 + col + j] = (_Float16)(-expm1f(-e)); } }) }
        else if (sel == 1) { EPI_LOOP({ const int col = cb + ct; const f32x4 a0v = *(const f32x4*)(a0 + col);
                u32x2 w; w.x = pk2(sigmoidf_(a0v[0] + v[0]), sigmoidf_(a0v[1] + v[1])); w.y = pk2(sigmoidf_(a0v[2] + v[2]), sigmoidf_(a0v[3] + v[3]));
                *(u32x2*)(AA + (size_t)row * 1024 + col) = w; }) }
        else { EPI_LOOP({ const int col = cb + ct; u32x2 w; w.x = pk2(v[0], v[1]); w.y = pk2(v[2], v[3]); *(u32x2*)(G + (size_t)row * 1024 + col) = w; }) }
    }
};

template <int MODE>
__device__ __forceinline__ void tr_job(const float* src, int K, int N, bf16_t* dst, int ldd, int row_off, int koff, const float* scale, float* lds, int bid, int nb) {
    const int tk = K / 64, tn = N / 64, tid = threadIdx.x;
    for (int t = bid; t < tk * tn; t += nb) {
        const int k0 = (t / tn) * 64, n0 = (t % tn) * 64;
        { const int r = tid >> 3, c = (tid & 7) * 8; const float* p = src + (size_t)(k0 + r) * N + n0 + c;
          const float4 a = *(const float4*)p, b = *(const float4*)(p + 4); const float s = scale ? scale[k0 + r] : 1.f;
          float* l = lds + r * 65 + c; l[0] = a.x * s; l[1] = a.y * s; l[2] = a.z * s; l[3] = a.w * s; l[4] = b.x * s; l[5] = b.y * s; l[6] = b.z * s; l[7] = b.w * s; }
        __syncthreads();
        { const int nl = tid >> 3, kc = (tid & 7) * 8; float v[8];
#pragma unroll
          for (int i = 0; i < 8; ++i) v[i] = lds[(kc + i) * 65 + nl];
          int n = n0 + nl; int rowi = n;
          if (MODE == 1) rowi = (n >> 7) * 256 + (n & 127);
          if (MODE == 2) rowi = (n >> 7) * 256 + 128 + (n & 127);
          u32x4 w; w.x = pk2(v[0], v[1]); w.y = pk2(v[2], v[3]); w.z = pk2(v[4], v[5]); w.w = pk2(v[6], v[7]);
          *(u32x4*)(dst + (size_t)(row_off + rowi) * ldd + koff + k0 + kc) = w; }
        __syncthreads();
    }
}

__device__ __forceinline__ void prep_phase(const Params& p, float* lds, int bid, int nb) {
    unsigned char* ws = p.ws;
    tr_job<0>(p.in[10], 1024, 2048, (bf16_t*)(ws + OFF_WIN), 1024, 0, 0, nullptr, lds, bid, nb);
    tr_job<0>(p.in[19], 512, 512, (bf16_t*)(ws + OFF_WGLU), 512, 0, 0, nullptr, lds, bid, nb);
    tr_job<0>(p.in[27], 1024, 1024, (bf16_t*)(ws + OFF_WOUT), 1024, 0, 0, nullptr, lds, bid, nb);
    for (int l = 0; l < 2; ++l) {
        bf16_t* gu = (bf16_t*)(ws + (l ? OFF_WGU1 : OFF_WGU0)); bf16_t* dn = (bf16_t*)(ws + (l ? OFF_WDN1 : OFF_WDN0));
        tr_job<1>(p.in[7] + (size_t)l * 1024 * FF, 1024, FF, gu, 1024, 0, 0, nullptr, lds, bid, nb);
        tr_job<2>(p.in[8] + (size_t)l * 1024 * FF, 1024, FF, gu, 1024, 0, 0, nullptr, lds, bid, nb);
        tr_job<0>(p.in[9] + (size_t)l * FF * 1024, FF, 1024, dn, FF, 0, 0, nullptr, lds, bid, nb);
    }
    bf16_t* g1 = (bf16_t*)(ws + OFF_WG1); const float* mu = p.in[28];
    tr_job<0>(p.in[29], 1024, 1024, g1, 2048, 0, 0, nullptr, lds, bid, nb);      tr_job<0>(p.in[29], 1024, 1024, g1, 2048, 0, 1024, mu + 0 * 1024, lds, bid, nb);
    tr_job<0>(p.in[30], 1024, 1024, g1, 2048, 1024, 0, nullptr, lds, bid, nb);   tr_job<0>(p.in[30], 1024, 1024, g1, 2048, 1024, 1024, mu + 2 * 1024, lds, bid, nb);
    tr_job<0>(p.in[31], 1024, 1024, g1, 2048, 2048, 0, nullptr, lds, bid, nb);   tr_job<0>(p.in[31], 1024, 1024, g1, 2048, 2048, 1024, mu + 3 * 1024, lds, bid, nb);
    tr_job<0>(p.in[34], 1024, 64, g1, 2048, 3072, 0, nullptr, lds, bid, nb);     tr_job<0>(p.in[34], 1024, 64, g1, 2048, 3072, 1024, mu + 1 * 1024, lds, bid, nb);
    tr_job<0>(p.in[37], 1024, 64, g1, 2048, 3136, 0, nullptr, lds, bid, nb);     tr_job<0>(p.in[37], 1024, 64, g1, 2048, 3136, 1024, mu + 4 * 1024, lds, bid, nb);
    tr_job<0>(p.in[39], 1024, 128, g1, 2048, 3200, 0, nullptr, lds, bid, nb);    tr_job<0>(p.in[39], 1024, 128, g1, 2048, 3200, 1024, mu + 5 * 1024, lds, bid, nb);
    bf16_t* l2 = (bf16_t*)(ws + OFF_WL2);
    tr_job<0>(p.in[35], 64, 1024, l2, 256, 0, 0, nullptr, lds, bid, nb);
    tr_job<0>(p.in[38], 64, 1024, l2, 256, 1024, 64, nullptr, lds, bid, nb);
    tr_job<0>(p.in[40], 128, 1024, l2, 256, 2048, 128, nullptr, lds, bid, nb);
    for (int i = bid * NTHR + threadIdx.x; i < 3072 * 32; i += nb * NTHR) { const int n = i >> 5, kc = (i & 31) * 8; const int sel = n >> 10;
        const bool used = (sel == 0) ? (kc < 64) : (sel == 1) ? (kc >= 64 && kc < 128) : (kc >= 128);
        if (!used) *(u32x4*)(l2 + (size_t)n * 256 + kc) = (u32x4){0u, 0u, 0u, 0u}; }
    tr_job<0>(p.in[32], 1024, 1024, (bf16_t*)(ws + OFF_WO), 1024, 0, 0, nullptr, lds, bid, nb);
    {   const float* c = p.in[1]; const float* wada = p.in[3]; const float* bada = p.in[4]; float* mod = (float*)(ws + OFF_MOD);
        float* cact = lds;
        float* red = lds + 4096;
        for (int i = threadIdx.x; i < 4096; i += NTHR) { const float x = c[i]; cact[i] = x / (1.f + expf(-x)); }
        __syncthreads();
        const int col = threadIdx.x & 63, kg = threadIdx.x >> 6;
        for (int ch = bid; ch < 192; ch += nb) {
            const int l = ch / 96, n0 = (ch % 96) * 64;
            const float* wp = wada + (size_t)l * 1024 * 6144 + n0 + col;
            float a0 = 0.f, a1 = 0.f, a2 = 0.f, a3 = 0.f;
            for (int k = kg * 128; k < kg * 128 + 128; ++k) { const float w = wp[(size_t)k * 6144]; a0 += cact[k] * w; a1 += cact[1024 + k] * w; a2 += cact[2048 + k] * w; a3 += cact[3072 + k] * w; }
            red[(kg * 4 + 0) * 64 + col] = a0; red[(kg * 4 + 1) * 64 + col] = a1; red[(kg * 4 + 2) * 64 + col] = a2; red[(kg * 4 + 3) * 64 + col] = a3;
            __syncthreads();
            if (threadIdx.x < 256) { const int b = threadIdx.x >> 6; float s = 0.f;
#pragma unroll
                for (int g = 0; g < 8; ++g) s += red[(g * 4 + b) * 64 + col];
                mod[(size_t)(l * 4 + b) * 6144 + n0 + col] = s + bada[l * 6144 + n0 + col]; }
            __syncthreads();
        }
    }
}

template <bool RW>
__device__ __forceinline__ void norm_phase(const float* x, const float* g, const float* modl, int shift_off, int scale_off, bf16_t* out, int bid, int nb) {
    const int wave = threadIdx.x >> 6, lane = threadIdx.x & 63;
    for (int row = bid * 8 + wave; row < MTOK; row += nb * 8) {
        const int b = row >> 12; const float* xr = x + (size_t)row * 1024; const float* md = modl + (size_t)b * 6144;
        f32x4 v[4], vp[4]; float ss = 0.f, ssp = 0.f; const bool hasp = RW && ((row & 4095) != 0);
#pragma unroll
        for (int i = 0; i < 4; ++i) { v[i] = *(const f32x4*)(xr + i * 256 + lane * 4); ss += v[i][0] * v[i][0] + v[i][1] * v[i][1] + v[i][2] * v[i][2] + v[i][3] * v[i][3];
            if (RW) { vp[i] = hasp ? *(const f32x4*)(xr - 1024 + i * 256 + lane * 4) : (f32x4){0.f, 0.f, 0.f, 0.f}; ssp += vp[i][0] * vp[i][0] + vp[i][1] * vp[i][1] + vp[i][2] * vp[i][2] + vp[i][3] * vp[i][3]; } }
        ss = wave_sum(ss); const float rstd = rsqrtf(ss * (1.f / 1024.f) + 1e-6f);
        float rstdp = 0.f; if (RW) { ssp = wave_sum(ssp); rstdp = rsqrtf(ssp * (1.f / 1024.f) + 1e-6f); }
#pragma unroll
        for (int i = 0; i < 4; ++i) { const int c = i * 256 + lane * 4; const f32x4 gg = *(const f32x4*)(g + c), sc = *(const f32x4*)(md + scale_off + c), sh = *(const f32x4*)(md + shift_off + c);
            f32x4 h;
#pragma unroll
            for (int j = 0; j < 4; ++j) h[j] = v[i][j] * rstd * gg[j] * (1.f + sc[j]) + sh[j];
            u32x2 w; w.x = pk2(h[0], h[1]); w.y = pk2(h[2], h[3]);
            if (!RW) *(u32x2*)(out + (size_t)row * 1024 + c) = w;
            else { *(u32x2*)(out + (size_t)row * 2048 + c) = w; f32x4 d;
#pragma unroll
                for (int j = 0; j < 4; ++j) { const float hp = hasp ? (vp[i][j] * rstdp * gg[j] * (1.f + sc[j]) + sh[j]) : 0.f; d[j] = hp - h[j]; }
                u32x2 w2; w2.x = pk2(d[0], d[1]); w2.y = pk2(d[2], d[3]); *(u32x2*)(out + (size_t)row * 2048 + 1024 + c) = w2; } }
    }
}

__device__ __forceinline__ void qknorm_phase(bf16_t* Q, bf16_t* Kb, const int* pos, const float* qn, const float* kn, int bid, int nb) {
    const int wave = threadIdx.x >> 6, lane = threadIdx.x & 63, l16 = lane & 15, d0 = l16 * 4;
    float invf[4];
#pragma unroll
    for (int j = 0; j < 4; ++j) invf[j] = powf(500000.f, -(float)((l16 & 1) * 4 + j) / 8.f);
    const f32x4 qw = *(const f32x4*)(qn + d0), kw = *(const f32x4*)(kn + d0);
    for (int tok = bid * 8 + wave; tok < MTOK; tok += nb * 8) {
        const float ps = (float)pos[tok];
        float cs[4], sn[4];
#pragma unroll
        for (int j = 0; j < 4; ++j) { const float ang = ps * invf[j]; cs[j] = cosf(ang); sn[j] = sinf(ang); }
#pragma unroll
        for (int bsel = 0; bsel < 2; ++bsel) { bf16_t* buf = bsel ? Kb : Q; const f32x4 w = bsel ? kw : qw;
#pragma unroll
            for (int it = 0; it < 2; ++it) { const int vec = it * 4 + (lane >> 4); bf16_t* ptr = buf + (size_t)tok * 512 + vec * 64 + d0;
                const u32x2 raw = *(const u32x2*)ptr; float y[4] = {bflo(raw.x), bfhi(raw.x), bflo(raw.y), bfhi(raw.y)};
                float ss = y[0] * y[0] + y[1] * y[1] + y[2] * y[2] + y[3] * y[3];
                ss += __shfl_xor(ss, 1); ss += __shfl_xor(ss, 2); ss += __shfl_xor(ss, 4); ss += __shfl_xor(ss, 8);
                const float rstd = rsqrtf(ss * (1.f / 64.f) + 1e-6f);
#pragma unroll
                for (int j = 0; j < 4; ++j) y[j] = y[j] * rstd * w[j];
                float pr[4];
#pragma unroll
                for (int j = 0; j < 4; ++j) pr[j] = __shfl_xor(y[j], 2);
                if (l16 < 2) {
#pragma unroll
                    for (int j = 0; j < 4; ++j) y[j] = y[j] * cs[j] - pr[j] * sn[j]; }
                else if (l16 < 4) {
#pragma unroll
                    for (int j = 0; j < 4; ++j) y[j] = y[j] * cs[j] + pr[j] * sn[j]; }
                if (!bsel) {
#pragma unroll
                    for (int j = 0; j < 4; ++j) y[j] *= 0.125f * 1.4426950408889634f; }
                u32x2 o; o.x = pk2(y[0], y[1]); o.y = pk2(y[2], y[3]); *(u32x2*)ptr = o; } }
    }
}

__device__ __forceinline__ float gelu_tanh(float x) { const float t = tanhf(0.7978845608028654f * (x + 0.044715f * x * x * x)); return 0.5f * x * (1.f + t); }
__device__ __forceinline__ void s5_naive(const Params& p, const float* U, bf16_t* YG, float* lds, int bid, int nb) {
    const int wave = threadIdx.x >> 6, lane = threadIdx.x & 63;
    float* L = lds + wave * 3328; float* Lxs = L; float* Lcr = L + 1040; float* Lci = L + 2080; float* Lus = L + 3120;
    const float* lam_re = p.in[11]; const float* lam_im = p.in[12]; const float* log_dt = p.in[13]; const float* b_re = p.in[14]; const float* b_im = p.in[15];
    const float* c_re = p.in[16]; const float* c_im = p.in[17]; const float* dsk = p.in[18];
    for (int unit = bid * 8 + wave; unit < 128; unit += nb * 8) {
        const int b = unit >> 5, g = unit & 31;
        const float lr = lam_re[g * 64 + lane], li = lam_im[g * 64 + lane], dt = expf(log_dt[g]);
        const float mag = expf(lr * dt), ar = mag * cosf(li * dt), ai = mag * sinf(li * dt);
        const float den = lr * lr + li * li, nr = ar - 1.f;
        const float qr = (nr * lr + ai * li) / den, qi = (ai * lr - nr * li) / den;
        float bbr[16], bbi[16];
#pragma unroll
        for (int h = 0; h < 16; ++h) { const float br = b_re[(size_t)(g * 64 + lane) * 16 + h], bi = b_im[(size_t)(g * 64 + lane) * 16 + h]; bbr[h] = qr * br - qi * bi; bbi[h] = qr * bi + qi * br; }
#pragma unroll
        for (int h = 0; h < 16; ++h) { Lcr[h * 65 + lane] = c_re[(size_t)(g * 16 + h) * 64 + lane]; Lci[h * 65 + lane] = c_im[(size_t)(g * 16 + h) * 64 + lane]; }
        const int hh = lane & 15, tq = lane >> 4;
        const float dd = dsk[g * 16 + hh];
        float xr = 0.f, xi = 0.f;
        for (int t0 = 0; t0 < SEQ; t0 += 8) {
            { const int idx = lane * 2, tk = idx >> 4, h = idx & 15; const float2 uu = *(const float2*)(U + ((size_t)b * SEQ + t0 + tk) * 512 + g * 16 + h); Lus[idx] = uu.x; Lus[idx + 1] = uu.y; }
            LWAIT();
#pragma unroll
            for (int tt = 0; tt < 8; ++tt) { float bur = 0.f, bui = 0.f;
#pragma unroll
                for (int h = 0; h < 16; ++h) { const float u = Lus[tt * 16 + h]; bur += bbr[h] * u; bui += bbi[h] * u; }
                const float nxr = ar * xr - ai * xi + bur, nxi = ar * xi + ai * xr + bui; xr = nxr; xi = nxi;
                Lxs[tt * 130 + lane] = xr; Lxs[tt * 130 + 64 + lane] = xi; }
            LWAIT();
#pragma unroll
            for (int i = 0; i < 2; ++i) { const int t = tq + 4 * i; float y = 0.f;
                for (int pp = 0; pp < 64; ++pp) y += Lcr[hh * 65 + pp] * Lxs[t * 130 + pp] - Lci[hh * 65 + pp] * Lxs[t * 130 + 64 + pp];
                y += dd * Lus[t * 16 + hh];
                YG[((size_t)b * SEQ + t0 + t) * 512 + g * 16 + hh] = (bf16_t)f2bf(gelu_tanh(y)); }
            LWAIT();
        }
    }
}

__device__ __forceinline__ void vtrans_phase(const bf16_t* V, bf16_t* Vt, bf16_t* lds, int bid, int nb) {
    const int tid = threadIdx.x;
    for (int unit = bid; unit < 1024; unit += nb) {
        const int head = unit & 3, ch = unit >> 2; const int b = ch >> 6, t0 = (ch & 63) * 64;
#pragma unroll
        for (int i = 0; i < 2; ++i) { const int idx = tid + i * 512, t = idx >> 4, cc = (idx & 15) * 8;
            const u32x4 w = *(const u32x4*)(V + ((size_t)b * SEQ + t0 + t) * 512 + head * 128 + cc);
            unsigned* d = (unsigned*)(lds + t * 130 + cc); d[0] = w.x; d[1] = w.y; d[2] = w.z; d[3] = w.w; }
        __syncthreads();
        { const int e = tid >> 2, tc = (tid & 3) * 16; unsigned o[8];
#pragma unroll
          for (int i = 0; i < 8; ++i) o[i] = (unsigned)lds[(tc + 2 * i) * 130 + e] | ((unsigned)lds[(tc + 2 * i + 1) * 130 + e] << 16);
          u32x4* dst = (u32x4*)(Vt + ((size_t)(b * 4 + head) * 128 + e) * SEQ + t0 + tc);
          dst[0] = (u32x4){o[0], o[1], o[2], o[3]}; dst[1] = (u32x4){o[4], o[5], o[6], o[7]}; }
        __syncthreads();
    }
}

typedef float f32x16 __attribute__((ext_vector_type(16)));
__device__ __forceinline__ unsigned cvt_pk_bf16(float lo, float hi) { unsigned r; asm volatile("v_cvt_pk_bf16_f32 %0, %1, %2" : "=v"(r) : "v"(lo), "v"(hi)); return r; }
__device__ __forceinline__ void attn_phase(const bf16_t* Q, const bf16_t* Kb, const bf16_t* Vt, bf16_t* OC, LAS unsigned char* lds, int bid, int nb) {
    const int tid = threadIdx.x, wave = __builtin_amdgcn_readfirstlane(tid >> 6), lane = tid & 63, c = wave >> 2, wq = wave & 3, l32 = lane & 31, hh = lane >> 5;
    constexpr int KROW = 272, VROW = 72, KBUF = 32 * KROW, VBUF = 128 * VROW, VOFF = 2 * KBUF;
    const int lkey = tid >> 4, lkc = tid & 15, lve = tid >> 2, lvc = tid & 3;
    for (int unit = bid; unit < 256; unit += nb) {
        const int b = unit & 3, head = (unit >> 2) & 3, pr = unit >> 4;
        const bf16_t* kg = Kb + ((size_t)b * SEQ + lkey) * 512 + head * 128 + lkc * 8;
        const bf16_t* vg = Vt + ((size_t)(b * 4 + head) * 128 + lve) * SEQ + lvc * 8;
        for (int half = 0; half < 2; ++half) {
            const int qb = half ? (31 - pr) : pr; const int q0 = qb * 128 + wq * 32; const int ntile = (qb + 1) * 4;
            bf16x8 qf[4];
            { const bf16_t* qp = Q + ((size_t)b * SEQ + q0 + l32) * 512 + head * 128 + c * 64 + hh * 8;
#pragma unroll
              for (int ks = 0; ks < 4; ++ks) qf[ks] = *(const bf16x8*)(qp + ks * 16); }
            f32x16 o[4];
#pragma unroll
            for (int blk = 0; blk < 4; ++blk)
#pragma unroll
                for (int r = 0; r < 16; ++r) o[blk][r] = 0.f;
            float mrow = -INFINITY, lsum = 0.f;
            u32x4 kreg = *(const u32x4*)kg, vreg = *(const u32x4*)vg;
            __syncthreads();
            { *(LAS u32x4*)(lds + lkey * KROW + lkc * 16) = kreg;
              LAS u32x2* vd = (LAS u32x2*)(lds + VOFF + lve * VROW + lvc * 16); vd[0] = (u32x2){vreg.x, vreg.y}; vd[1] = (u32x2){vreg.z, vreg.w}; }
            __syncthreads();
            for (int kt = 0; kt < ntile; ++kt) {
                const int cur = kt & 1, key0 = kt * 32;
                if (kt + 1 < ntile) { kreg = *(const u32x4*)(kg + (size_t)(key0 + 32) * 512); vreg = *(const u32x4*)(vg + key0 + 32); }
                if (key0 <= q0) {
                    LAS unsigned char* kb = lds + cur * KBUF + l32 * KROW + c * 128 + hh * 16;
                    f32x16 sacc;
#pragma unroll
                    for (int r = 0; r < 16; ++r) sacc[r] = 0.f;
#pragma unroll
                    for (int ks = 0; ks < 4; ++ks) { const bf16x8 kf = *(const LAS bf16x8*)(kb + ks * 32); sacc = __builtin_amdgcn_mfma_f32_32x32x16_bf16(kf, qf[ks], sacc, 0, 0, 0); }
                    if (key0 == q0) {
#pragma unroll
                        for (int r = 0; r < 16; ++r) { const int kl = (r & 3) + 8 * (r >> 2) + 4 * hh; if (kl > l32) sacc[r] = -INFINITY; } }
                    float tm = sacc[0];
#pragma unroll
                    for (int r = 1; r < 16; ++r) tm = fmaxf(tm, sacc[r]);
                    tm = fmaxf(tm, __shfl_xor(tm, 32));
                    const float mnew = fmaxf(mrow, tm);
                    if (__any(mnew > mrow)) { const float al = exp2f(mrow - mnew); lsum *= al;
#pragma unroll
                        for (int blk = 0; blk < 4; ++blk)
#pragma unroll
                            for (int r = 0; r < 16; ++r) o[blk][r] *= al;
                        mrow = mnew; }
                    float ps = 0.f;
#pragma unroll
                    for (int r = 0; r < 16; ++r) { sacc[r] = exp2f(sacc[r] - mrow); ps += sacc[r]; }
                    lsum += ps;
                    LAS unsigned char* vb = lds + VOFF + cur * VBUF + l32 * VROW + hh * 8;
#pragma unroll
                    for (int s2 = 0; s2 < 2; ++s2) {
                        u32x4 pw; pw.x = cvt_pk_bf16(sacc[8 * s2 + 0], sacc[8 * s2 + 1]); pw.y = cvt_pk_bf16(sacc[8 * s2 + 2], sacc[8 * s2 + 3]); pw.z = cvt_pk_bf16(sacc[8 * s2 + 4], sacc[8 * s2 + 5]); pw.w = cvt_pk_bf16(sacc[8 * s2 + 6], sacc[8 * s2 + 7]);
                        const bf16x8 pb = __builtin_bit_cast(bf16x8, pw);
#pragma unroll
                        for (int blk = 0; blk < 4; ++blk) { const u32x2 v0 = *(const LAS u32x2*)(vb + blk * 32 * VROW + s2 * 32), v1 = *(const LAS u32x2*)(vb + blk * 32 * VROW + s2 * 32 + 16);
                            const bf16x8 vf = __builtin_bit_cast(bf16x8, (u32x4){v0.x, v0.y, v1.x, v1.y});
                            o[blk] = __builtin_amdgcn_mfma_f32_32x32x16_bf16(vf, pb, o[blk], 0, 0, 0); } }
                }
                if (kt + 1 < ntile) { const int nx = cur ^ 1;
                    *(LAS u32x4*)(lds + nx * KBUF + lkey * KROW + lkc * 16) = kreg;
                    LAS u32x2* vd = (LAS u32x2*)(lds + VOFF + nx * VBUF + lve * VROW + lvc * 16); vd[0] = (u32x2){vreg.x, vreg.y}; vd[1] = (u32x2){vreg.z, vreg.w}; }
                __syncthreads();
            }
            lsum += __shfl_xor(lsum, 32);
            const float inv = 1.f / lsum;
            bf16_t* op = OC + ((size_t)b * SEQ + q0 + l32) * 1024 + (head * 2 + c) * 128 + 4 * hh;
#pragma unroll
            for (int blk = 0; blk < 4; ++blk)
#pragma unroll
                for (int g4 = 0; g4 < 4; ++g4) { u32x2 w; w.x = pk2(o[blk][g4 * 4 + 0] * inv, o[blk][g4 * 4 + 1] * inv); w.y = pk2(o[blk][g4 * 4 + 2] * inv, o[blk][g4 * 4 + 3] * inv);
                    *(u32x2*)(op + blk * 32 + g4 * 8) = w; }
        }
    }
}

__device__ __forceinline__ void attn_combine(const bf16_t* OC, bf16_t* CAT, const Params& p, int bid, int nb) {
    const int wave = threadIdx.x >> 6, lane = threadIdx.x & 63, head = lane >> 4, e0 = (lane & 15) * 8;
    float lam;
    { float s1 = 0.f, s2 = 0.f; for (int d = 0; d < 64; ++d) { s1 += p.in[22][d] * p.in[23][d]; s2 += p.in[24][d] * p.in[25][d]; } lam = expf(s1) - expf(s2) + 0.2f; }
    float sub[8];
#pragma unroll
    for (int i = 0; i < 8; ++i) sub[i] = p.in[26][e0 + i] * 0.8f;
    for (int tok = bid * 8 + wave; tok < MTOK; tok += nb * 8) {
        const u32x4 a = *(const u32x4*)(OC + (size_t)tok * 1024 + (head * 2) * 128 + e0), bb = *(const u32x4*)(OC + (size_t)tok * 1024 + (head * 2 + 1) * 128 + e0);
        float o[8] = {bflo(a.x) - lam * bflo(bb.x), bfhi(a.x) - lam * bfhi(bb.x), bflo(a.y) - lam * bflo(bb.y), bfhi(a.y) - lam * bfhi(bb.y),
                      bflo(a.z) - lam * bflo(bb.z), bfhi(a.z) - lam * bfhi(bb.z), bflo(a.w) - lam * bflo(bb.w), bfhi(a.w) - lam * bfhi(bb.w)};
        float ss = 0.f;
#pragma unroll
        for (int i = 0; i < 8; ++i) ss += o[i] * o[i];
        ss += __shfl_xor(ss, 1); ss += __shfl_xor(ss, 2); ss += __shfl_xor(ss, 4); ss += __shfl_xor(ss, 8);
        const float rstd = rsqrtf(ss * (1.f / 128.f) + 1e-6f);
        u32x4 w; w.x = pk2(o[0] * rstd * sub[0], o[1] * rstd * sub[1]); w.y = pk2(o[2] * rstd * sub[2], o[3] * rstd * sub[3]); w.z = pk2(o[4] * rstd * sub[4], o[5] * rstd * sub[5]); w.w = pk2(o[6] * rstd * sub[6], o[7] * rstd * sub[7]);
        *(u32x4*)(CAT + (size_t)tok * 1024 + 512 + head * 128 + e0) = w;
    }
}

__device__ __forceinline__ void rwkv_naive(const Params& p, bf16_t* R, const bf16_t* Kk, const bf16_t* Vv, const _Float16* DEC, const bf16_t* AA, const bf16_t* G, float* lds, int bid, int nb) {
    const int wave = threadIdx.x >> 6, lane = threadIdx.x & 63;
    float* L = lds + wave * 1280;
    for (int unit = bid * 8 + wave; unit < 64; unit += nb * 8) {
        const int b = unit >> 4, h = unit & 15;
        float S[64];
#pragma unroll
        for (int j = 0; j < 64; ++j) S[j] = 0.f;
        const float kkw = p.in[41][h * 64 + lane], kaw = p.in[42][h * 64 + lane], rkw = p.in[43][h * 64 + lane], lng = p.in[44][h * 64 + lane], lnb = p.in[45][h * 64 + lane];
        for (int t0 = 0; t0 < SEQ; t0 += 4) {
            float vv[4], gg[4], bon[4];
#pragma unroll
            for (int tt = 0; tt < 4; ++tt) { const size_t off = ((size_t)b * SEQ + t0 + tt) * 1024 + h * 64 + lane;
                const float r = bf2f(R[off]), k = bf2f(Kk[off]), v = bf2f(Vv[off]), dec = 1.f - (float)DEC[off], a = bf2f(AA[off]); gg[tt] = bf2f(G[off]);
                float kk = k * kkw; const float n2 = wave_sum(kk * kk); kk = kk / fmaxf(sqrtf(n2), 1e-12f);
                const float k2 = k * (1.f + (a - 1.f) * kaw); const float bb = kk * a;
                bon[tt] = wave_sum(r * k2 * rkw) * v; vv[tt] = v;
                L[(0 * 4 + tt) * 64 + lane] = dec; L[(1 * 4 + tt) * 64 + lane] = -kk; L[(2 * 4 + tt) * 64 + lane] = bb; L[(3 * 4 + tt) * 64 + lane] = k2; L[(4 * 4 + tt) * 64 + lane] = r; }
            LWAIT();
#pragma unroll
            for (int tt = 0; tt < 4; ++tt) {
                const f32x4* Lw = (const f32x4*)(L + (0 * 4 + tt) * 64); const f32x4* Lk = (const f32x4*)(L + (1 * 4 + tt) * 64); const f32x4* Lb = (const f32x4*)(L + (2 * 4 + tt) * 64);
                const f32x4* Lkk = (const f32x4*)(L + (3 * 4 + tt) * 64); const f32x4* Lr = (const f32x4*)(L + (4 * 4 + tt) * 64);
                float sa = 0.f;
#pragma unroll
                for (int j4 = 0; j4 < 16; ++j4) { const f32x4 a = Lk[j4]; sa += S[j4 * 4 + 0] * a[0] + S[j4 * 4 + 1] * a[1] + S[j4 * 4 + 2] * a[2] + S[j4 * 4 + 3] * a[3]; }
                float y = 0.f; const float v = vv[tt];
#pragma unroll
                for (int j4 = 0; j4 < 16; ++j4) { const f32x4 w = Lw[j4], bb = Lb[j4], k2 = Lkk[j4], r = Lr[j4];
#pragma unroll
                    for (int j = 0; j < 4; ++j) { const float s = S[j4 * 4 + j] * w[j] + sa * bb[j] + v * k2[j]; S[j4 * 4 + j] = s; y += s * r[j]; } }
                const float mean = wave_sum(y) * (1.f / 64.f); const float d = y - mean; const float var = wave_sum(d * d) * (1.f / 64.f);
                const float yn = d * rsqrtf(var + 64e-5f) * lng + lnb + bon[tt];
                R[((size_t)b * SEQ + t0 + tt) * 1024 + h * 64 + lane] = (bf16_t)f2bf(yn * gg[tt]); }
            LWAIT();
        }
    }
}

__global__ void __launch_bounds__(NTHR) fwd_kernel(Params p) {
    extern __shared__ __attribute__((aligned(16))) unsigned char lds_raw[];
    LAS unsigned char* lds = (LAS unsigned char*)lds_raw;
    float* ldsf = (float*)lds_raw;
    const int bid = blockIdx.x, nb = gridDim.x;
    unsigned char* ws = p.ws;
    float* mod = (float*)(ws + OFF_MOD);
    const bool multi = (p.ph_hi - p.ph_lo) > 1;
#ifndef TESTPH
#define TESTPH -1
#endif
#define PH(k) if ((TESTPH < 0 || TESTPH == (k)) && p.ph_lo <= (k) && (k) < p.ph_hi)
#define SYNC(k) if (multi && (k) + 1 < p.ph_hi) { cg::this_grid().sync(); }
    PH(0) { prep_phase(p, ldsf, bid, nb); SYNC(0) }
    PH(1) { norm_phase<false>(p.in[0], p.in[5], mod, 0, 1024, (bf16_t*)(ws + OFF_HA), bid, nb); SYNC(1) }
    PH(2) { EpiWin e{(float*)(ws + OFF_U), (bf16_t*)(ws + OFF_QKV)}; gemm_phase(lds, (const bf16_t*)(ws + OFF_HA), (const bf16_t*)(ws + OFF_WIN), 2048, 1024, e, bid, nb); SYNC(2) }
    PH(3) { bf16_t* q = (bf16_t*)(ws + OFF_QKV); qknorm_phase(q, q + (size_t)MTOK * 512, (const int*)p.in[2], p.in[20], p.in[21], bid, nb);
            vtrans_phase(q + (size_t)MTOK * 1024, (bf16_t*)(ws + OFF_VT), (bf16_t*)lds_raw, bid, nb); SYNC(3) }
    PH(4) { s5_naive(p, (const float*)(ws + OFF_U), (bf16_t*)(ws + OFF_YG), ldsf, bid, nb); SYNC(4) }
    PH(5) { bf16_t* q = (bf16_t*)(ws + OFF_QKV); attn_phase(q, q + (size_t)MTOK * 512, (const bf16_t*)(ws + OFF_VT), (bf16_t*)(ws + OFF_OC), lds, bid, nb); SYNC(5) }
    PH(6) { attn_combine((const bf16_t*)(ws + OFF_OC), (bf16_t*)(ws + OFF_CAT), p, bid, nb);
            EpiGlu e{(const bf16_t*)(ws + OFF_YG), (bf16_t*)(ws + OFF_CAT)}; gemm_phase(lds, (const bf16_t*)(ws + OFF_YG), (const bf16_t*)(ws + OFF_WGLU), 512, 512, e, bid, nb); SYNC(6) }
    PH(7) { EpiRes e{p.in[0], p.out, mod + 2048}; gemm_phase(lds, (const bf16_t*)(ws + OFF_CAT), (const bf16_t*)(ws + OFF_WOUT), 1024, 1024, e, bid, nb); SYNC(7) }
    PH(8) { norm_phase<false>(p.out, p.in[6], mod, 3072, 4096, (bf16_t*)(ws + OFF_HA), bid, nb); SYNC(8) }
    PH(9) { EpiSwiglu e{(bf16_t*)(ws + OFF_HID)}; gemm_phase(lds, (const bf16_t*)(ws + OFF_HA), (const bf16_t*)(ws + OFF_WGU0), 5632, 1024, e, bid, nb); SYNC(9) }
    PH(10) { EpiRes e{p.out, p.out, mod + 5120}; gemm_phase(lds, (const bf16_t*)(ws + OFF_HID), (const bf16_t*)(ws + OFF_WDN0), 1024, FF, e, bid, nb); SYNC(10) }
    const float* mod1 = mod + 4 * 6144;
    PH(11) { norm_phase<true>(p.out, p.in[5] + 1024, mod1, 0, 1024, (bf16_t*)(ws + OFF_HD), bid, nb); SYNC(11) }
    PH(12) { EpiG1 e{(bf16_t*)(ws + OFF_RKV), (bf16_t*)(ws + OFF_L1)}; gemm_phase(lds, (const bf16_t*)(ws + OFF_HD), (const bf16_t*)(ws + OFF_WG1), 3328, 2048, e, bid, nb); SYNC(12) }
    PH(13) { EpiL2 e{(_Float16*)(ws + OFF_DEC), (bf16_t*)(ws + OFF_AA), (bf16_t*)(ws + OFF_G), p.in[33], p.in[36]}; gemm_phase(lds, (const bf16_t*)(ws + OFF_L1), (const bf16_t*)(ws + OFF_WL2), 3072, 256, e, bid, nb); SYNC(13) }
    PH(14) { bf16_t* r = (bf16_t*)(ws + OFF_RKV); rwkv_naive(p, r, r + (size_t)MTOK * 1024, r + (size_t)MTOK * 2048, (const _Float16*)(ws + OFF_DEC), (const bf16_t*)(ws + OFF_AA), (const bf16_t*)(ws + OFF_G), ldsf, bid, nb); SYNC(14) }
    PH(15) { EpiRes e{p.out, p.out, mod1 + 2048}; gemm_phase(lds, (const bf16_t*)(ws + OFF_RKV), (const bf16_t*)(ws + OFF_WO), 1024, 1024, e, bid, nb); SYNC(15) }
    PH(16) { norm_phase<false>(p.out, p.in[6] + 1024, mod1, 3072, 4096, (bf16_t*)(ws + OFF_HA), bid, nb); SYNC(16) }
    PH(17) { EpiSwiglu e{(bf16_t*)(ws + OFF_HID)}; gemm_phase(lds, (const bf16_t*)(ws + OFF_HA), (const bf16_t*)(ws + OFF_WGU1), 5632, 1024, e, bid, nb); SYNC(17) }
    PH(18) { EpiRes e{p.out, p.out, mod1 + 5120}; gemm_phase(lds, (const bf16_t*)(ws + OFF_HID), (const bf16_t*)(ws + OFF_WDN1), 1024, FF, e, bid, nb); }
}

constexpr int NPHASE = 19;
#ifndef ONE_LAUNCH
#define ONE_LAUNCH 1
#endif

extern "C" void kernel_launch(void* const* d_in, const int* in_sizes, int n_in, void* d_out, int out_size, void* d_ws, size_t ws_size, hipStream_t stream) {
    static int grid = 0;
    if (grid == 0) {
        if (n_in != 46 || ws_size < WS_NEED) { fprintf(stderr, "kernel_launch: unexpected n_in %d / ws_size %zu (need %zu)\n", n_in, ws_size, (size_t)WS_NEED); grid = -1; return; }
        if (hipFuncSetAttribute((const void*)fwd_kernel, hipFuncAttributeMaxDynamicSharedMemorySize, LDS_BYTES) != hipSuccess) { fprintf(stderr, "hipFuncSetAttribute failed\n"); grid = -1; return; }
        int dev = 0, cus = 0, per_cu = 0;
        (void)hipGetDevice(&dev); (void)hipDeviceGetAttribute(&cus, hipDeviceAttributeMultiprocessorCount, dev);
        (void)hipOccupancyMaxActiveBlocksPerMultiprocessor(&per_cu, (const void*)fwd_kernel, NTHR, LDS_BYTES);
        if (per_cu < 1) per_cu = 1;
        grid = cus;
    }
    if (grid < 0) return;
    Params p{};
    for (int i = 0; i < 46; ++i) p.in[i] = (const float*)d_in[i];
    p.out = (float*)d_out; p.ws = (unsigned char*)d_ws;
#if ONE_LAUNCH
    p.ph_lo = 0; p.ph_hi = NPHASE;
    void* args[] = {&p};
    hipError_t e = hipLaunchCooperativeKernel((const void*)fwd_kernel, dim3(grid), dim3(NTHR), args, LDS_BYTES, stream);
    if (e != hipSuccess) fprintf(stderr, "cooperative launch failed: %s (grid %d)\n", hipGetErrorString(e), grid);
#else
    for (int ph = 0; ph < NPHASE; ++ph) { p.ph_lo = ph; p.ph_hi = ph + 1; hipLaunchKernelGGL(fwd_kernel, dim3(grid), dim3(NTHR), LDS_BYTES, stream, p); }
#endif
}
```

```cpp
#include <hip/hip_runtime.h>
#include <hip/hip_cooperative_groups.h>
#include <cstdio>
#include <cstdint>
namespace cg = cooperative_groups;

#define LAS __attribute__((address_space(3)))
typedef unsigned short bf16_t;
typedef short bf16x8 __attribute__((ext_vector_type(8)));
typedef float f32x4 __attribute__((ext_vector_type(4)));
typedef unsigned u32x2 __attribute__((ext_vector_type(2)));
typedef unsigned u32x4 __attribute__((ext_vector_type(4)));

constexpr int MTOK = 16384, DM = 1024, SEQ = 4096, FF = 2816;
constexpr int NTHR = 512;
constexpr int LDS_BYTES = 131072;
constexpr size_t MiB = 1048576;
constexpr size_t OFF_WIN = 0;
constexpr size_t OFF_WGLU = 4194304;
constexpr size_t OFF_WOUT = 4718592;
constexpr size_t OFF_WGU0 = 6815744;
constexpr size_t OFF_WDN0 = 18350080;
constexpr size_t OFF_WGU1 = 39321600;
constexpr size_t OFF_WDN1 = 50855936;
constexpr size_t OFF_WG1 = 24117248;
constexpr size_t OFF_WL2 = 37748736;
constexpr size_t OFF_WO = 56623104;
constexpr size_t OFF_MOD = 58720256;
constexpr size_t ACT = 57 * MiB;
constexpr size_t OFF_HA = ACT;
constexpr size_t OFF_U = ACT + 32 * MiB;
constexpr size_t OFF_QKV = ACT + 64 * MiB;
constexpr size_t OFF_CAT = ACT + 112 * MiB;
constexpr size_t OFF_YG = ACT + 144 * MiB;
constexpr size_t OFF_VT = ACT + 160 * MiB;
constexpr size_t OFF_OC = ACT;
constexpr size_t OFF_HID = ACT + 32 * MiB;
constexpr size_t OFF_HD = ACT;
constexpr size_t OFF_RKV = ACT + 64 * MiB;
constexpr size_t OFF_G = ACT + 160 * MiB;
constexpr size_t OFF_Y = 0;
constexpr size_t OFF_L1 = 0;
constexpr size_t OFF_DEC = ACT;
constexpr size_t OFF_AA = ACT + 32 * MiB;
constexpr size_t WS_NEED = ACT + 192 * MiB;

struct Params {
    const float* in[46];
    float* out;
    unsigned char* ws;
    int ph_lo, ph_hi;
};

__device__ __forceinline__ unsigned f2bf(float f) { unsigned u = __float_as_uint(f); return (u + 0x7fffu + ((u >> 16) & 1u)) >> 16; }
__device__ __forceinline__ float bf2f(unsigned h) { return __uint_as_float(h << 16); }
__device__ __forceinline__ unsigned pk2(float lo, float hi) { return f2bf(lo) | (f2bf(hi) << 16); }
__device__ __forceinline__ float bflo(unsigned w) { return __uint_as_float(w << 16); }
__device__ __forceinline__ float bfhi(unsigned w) { return __uint_as_float(w & 0xffff0000u); }
__device__ __forceinline__ float wave_sum(float v) {
#pragma unroll
    for (int o = 32; o > 0; o >>= 1) v += __shfl_xor(v, o);
    return v;
}
__device__ __forceinline__ float sigmoidf_(float x) { return 1.f / (1.f + __expf(-x)); }
#define LWAIT() asm volatile("s_waitcnt lgkmcnt(0)" ::: "memory")

constexpr int HTB = 128 * 64 * 2;
__device__ __forceinline__ int lds_byte(int r, int c) { int st = (r >> 4) * 2 + (c >> 5), rr = r & 15, cc = c & 31, ob = rr * 64 + cc * 2; return st * 1024 + (ob ^ (((ob >> 9) & 1) << 5)); }
__device__ __forceinline__ void stage_rc(int b, int& R, int& C) { int st = b / 1024, sb = b % 1024, swz = sb ^ (((sb >> 9) & 1) << 5); R = (st >> 1) * 16 + swz / 64; C = (st & 1) * 32 + (swz % 64) / 2; }

template <class Epi>
__device__ __forceinline__ void gemm_phase(LAS unsigned char* lds, const bf16_t* A, const bf16_t* Bt, int N, int K, const Epi& E, int bid, int nb) {
    const int tid = threadIdx.x, wid = __builtin_amdgcn_readfirstlane(tid >> 6), lane = tid & 63, wr = wid >> 2, wc = wid & 3, fr = lane & 15, fq = lane >> 4;
    unsigned voff[2];
#pragma unroll
    for (int i = 0; i < 2; ++i) { int R, C; stage_rc(tid * 16 + i * 8192, R, C); voff[i] = (unsigned)(R * K + C) * 2u; }
    const int aoff = lds_byte(wr * 64 + fr, fq * 8), boff = lds_byte(wc * 32 + fr, fq * 8);
    const unsigned ldsw = (unsigned)wid * 1024u;
    const size_t kstep = 128, hstep = (size_t)128 * K * 2;
    const int nt = K / 64;
    const int nN = N / 256, ntiles = 64 * nN;
#define G_SA(b, h) (((b) * 2 + (h)) * HTB)
#define G_SB(b, h) ((4 + (b) * 2 + (h)) * HTB)
#define G_STAGE(bufoff, gptr) do { _Pragma("unroll") for (int _i = 0; _i < 2; ++_i) \
        __builtin_amdgcn_global_load_lds((const unsigned*)((gptr) + voff[_i]), (LAS unsigned*)(lds + (bufoff) + ldsw + _i * 8192), 16, 0, 0); } while (0)
#define G_LDA(dst, b, h) do { _Pragma("unroll") for (int m = 0; m < 4; ++m) _Pragma("unroll") for (int k = 0; k < 2; ++k) dst[m][k] = *(const LAS bf16x8*)(lds + G_SA(b, h) + aoff + m * 2048 + k * 1024); } while (0)
#define G_LDB(dst, b, h) do { _Pragma("unroll") for (int n = 0; n < 2; ++n) _Pragma("unroll") for (int k = 0; k < 2; ++k) dst[n][k] = *(const LAS bf16x8*)(lds + G_SB(b, h) + boff + n * 2048 + k * 1024); } while (0)
#define G_MMA(ai, bj, At, Bx) do { __builtin_amdgcn_s_setprio(1); _Pragma("unroll") for (int m = 0; m < 4; ++m) _Pragma("unroll") for (int n = 0; n < 2; ++n) _Pragma("unroll") for (int k = 0; k < 2; ++k) \
        acc[ai][bj][m][n] = __builtin_amdgcn_mfma_f32_16x16x32_bf16(Bx[n][k], At[m][k], acc[ai][bj][m][n], 0, 0, 0); __builtin_amdgcn_s_setprio(0); } while (0)
#define G_WV(n) asm volatile("s_waitcnt vmcnt(" #n ")" ::: "memory")
#define G_WL(n) asm volatile("s_waitcnt lgkmcnt(" #n ")" ::: "memory")
#define G_BAR __builtin_amdgcn_s_barrier()
#define G_SCHED __builtin_amdgcn_sched_barrier(0)
    for (int tile = bid; tile < ntiles; tile += nb) {
        const int pm = tile & 63, pn = tile >> 6;
        const char* cA = (const char*)A + (size_t)pm * 256 * K * 2;
        const char* cB = (const char*)Bt + (size_t)pn * 256 * K * 2;
        f32x4 acc[2][2][4][2];
#pragma unroll
        for (int a = 0; a < 2; ++a)
#pragma unroll
            for (int b = 0; b < 2; ++b)
#pragma unroll
                for (int m = 0; m < 4; ++m)
#pragma unroll
                    for (int n = 0; n < 2; ++n) acc[a][b][m][n] = (f32x4){0.f, 0.f, 0.f, 0.f};
        bf16x8 At[4][2], B0[2][2], B1[2][2];
        G_WV(0);
        G_STAGE(G_SB(0, 0), cB); G_STAGE(G_SA(0, 0), cA); G_STAGE(G_SB(0, 1), cB + hstep); G_STAGE(G_SA(0, 1), cA + hstep);
        if (wr == 1) G_BAR;
        G_WV(4); G_BAR;
        G_STAGE(G_SB(1, 0), cB + kstep); G_STAGE(G_SA(1, 0), cA + kstep); G_STAGE(G_SB(1, 1), cB + hstep + kstep);
        G_WV(6); G_BAR;
        for (int t = 0; t < nt - 2; t += 2) {
            const char* a1 = cA + (size_t)(t + 1) * kstep; const char* a2 = cA + (size_t)(t + 2) * kstep; const char* a3 = a2 + kstep;
            const char* b2 = cB + (size_t)(t + 2) * kstep; const char* b3 = b2 + kstep;
            G_LDB(B0, 0, 0); G_SCHED; G_LDA(At, 0, 0); G_STAGE(G_SA(1, 1), a1 + hstep);
            G_WL(8); G_BAR; G_WL(0); G_MMA(0, 0, At, B0); G_BAR; G_SCHED;
            G_LDB(B1, 0, 1); G_STAGE(G_SB(0, 0), b2);
            G_BAR; G_WL(0); G_MMA(0, 1, At, B1); G_BAR;
            G_LDA(At, 0, 1); G_STAGE(G_SA(0, 0), a2);
            G_BAR; G_WL(0); G_MMA(1, 0, At, B0); G_BAR; G_SCHED;
            G_STAGE(G_SB(0, 1), b2 + hstep);
            G_WV(6); G_BAR; G_MMA(1, 1, At, B1); G_BAR;
            G_LDB(B0, 1, 0); G_SCHED; G_LDA(At, 1, 0); G_STAGE(G_SA(0, 1), a2 + hstep);
            G_WL(8); G_BAR; G_WL(0); G_MMA(0, 0, At, B0); G_BAR; G_SCHED;
            G_LDB(B1, 1, 1); G_STAGE(G_SB(1, 0), b3);
            G_BAR; G_WL(0); G_MMA(0, 1, At, B1); G_BAR;
            G_LDA(At, 1, 1); G_STAGE(G_SA(1, 0), a3);
            G_BAR; G_WL(0); G_MMA(1, 0, At, B0); G_BAR; G_SCHED;
            G_STAGE(G_SB(1, 1), b3 + hstep);
            G_WV(6); G_BAR; G_MMA(1, 1, At, B1); G_BAR;
        }
        {
            const char* a1 = cA + (size_t)(nt - 1) * kstep;
            G_LDB(B0, 0, 0); G_LDA(At, 0, 0); G_STAGE(G_SA(1, 1), a1 + hstep);
            G_BAR; G_WL(0); G_MMA(0, 0, At, B0); G_BAR;
            G_LDB(B1, 0, 1); G_BAR; G_WL(0); G_MMA(0, 1, At, B1); G_BAR;
            G_LDA(At, 0, 1); G_WV(4); G_BAR; G_WL(0); G_MMA(1, 0, At, B0); G_MMA(1, 1, At, B1); G_BAR;
        }
        {
            G_LDB(B0, 1, 0); G_LDA(At, 1, 0); G_WV(2); G_BAR; G_WL(0); G_MMA(0, 0, At, B0); G_BAR;
            G_LDB(B1, 1, 1); G_WV(0); G_BAR; G_WL(0); G_MMA(0, 1, At, B1); G_BAR;
            G_LDA(At, 1, 1); G_BAR; G_WL(0); G_MMA(1, 0, At, B0); G_MMA(1, 1, At, B1); G_BAR;
        }
        if (wr == 0) G_BAR;
        E(acc, pm, pn, wr, wc, fr, fq);
    }
    G_WV(0);
    __syncthreads();
}

#define EPI_LOOP(body) \
    _Pragma("unroll") for (int ai = 0; ai < 2; ++ai) _Pragma("unroll") for (int m = 0; m < 4; ++m) { const int row = pm * 256 + ai * 128 + wr * 64 + m * 16 + fr; \
    _Pragma("unroll") for (int bj = 0; bj < 2; ++bj) _Pragma("unroll") for (int n = 0; n < 2; ++n) { const int ct = bj * 128 + wc * 32 + n * 16 + fq * 4; const f32x4 v = acc[ai][bj][m][n]; body } }

struct EpiWin {
    float* U; bf16_t* QKV;
    __device__ __forceinline__ void operator()(const f32x4 (&acc)[2][2][4][2], int pm, int pn, int wr, int wc, int fr, int fq) const {
        if (pn < 2) { EPI_LOOP({ *(f32x4*)(U + (size_t)row * 512 + pn * 256 + ct) = v; }) }
        else { bf16_t* base = QKV + (size_t)((pn - 2) >> 1) * ((size_t)MTOK * 512) + (pn & 1) * 256;
            EPI_LOOP({ u32x2 w; w.x = pk2(v[0], v[1]); w.y = pk2(v[2], v[3]); *(u32x2*)(base + (size_t)row * 512 + ct) = w; }) }
    }
};
struct EpiGlu {
    const bf16_t* YG; bf16_t* CAT;
    __device__ __forceinline__ void operator()(const f32x4 (&acc)[2][2][4][2], int pm, int pn, int wr, int wc, int fr, int fq) const {
        EPI_LOOP({ const int col = pn * 256 + ct; const u32x2 y = *(const u32x2*)(YG + (size_t)row * 512 + col);
            u32x2 w; w.x = pk2(bflo(y.x) * sigmoidf_(v[0]), bfhi(y.x) * sigmoidf_(v[1])); w.y = pk2(bflo(y.y) * sigmoidf_(v[2]), bfhi(y.y) * sigmoidf_(v[3]));
            *(u32x2*)(CAT + (size_t)row * 1024 + col) = w; })
    }
};
struct EpiRes {
    const float* res; float* out; const float* gate;
    __device__ __forceinline__ void operator()(const f32x4 (&acc)[2][2][4][2], int pm, int pn, int wr, int wc, int fr, int fq) const {
        const float* gb = gate + (size_t)(pm >> 4) * 6144;
        EPI_LOOP({ const int col = pn * 256 + ct; const f32x4 g = *(const f32x4*)(gb + col); const f32x4 r = *(const f32x4*)(res + (size_t)row * 1024 + col);
            *(f32x4*)(out + (size_t)row * 1024 + col) = r + g * v; })
    }
};
struct EpiSwiglu {
    bf16_t* HID;
    __device__ __forceinline__ void operator()(const f32x4 (&acc)[2][2][4][2], int pm, int pn, int wr, int wc, int fr, int fq) const {
#pragma unroll
        for (int ai = 0; ai < 2; ++ai)
#pragma unroll
            for (int m = 0; m < 4; ++m) { const int row = pm * 256 + ai * 128 + wr * 64 + m * 16 + fr;
#pragma unroll
                for (int n = 0; n < 2; ++n) { const f32x4 g = acc[ai][0][m][n], u = acc[ai][1][m][n]; float o[4];
#pragma unroll
                    for (int j = 0; j < 4; ++j) o[j] = g[j] * sigmoidf_(g[j]) * u[j];
                    u32x2 w; w.x = pk2(o[0], o[1]); w.y = pk2(o[2], o[3]);
                    *(u32x2*)(HID + (size_t)row * FF + pn * 128 + wc * 32 + n * 16 + fq * 4) = w; } }
    }
};
struct EpiG1 {
    bf16_t* RKV; bf16_t* L1;
    __device__ __forceinline__ void operator()(const f32x4 (&acc)[2][2][4][2], int pm, int pn, int wr, int wc, int fr, int fq) const {
        if (pn < 12) { bf16_t* base = RKV + (size_t)(pn >> 2) * ((size_t)MTOK * 1024) + (pn & 3) * 256;
            EPI_LOOP({ u32x2 w; w.x = pk2(v[0], v[1]); w.y = pk2(v[2], v[3]); *(u32x2*)(base + (size_t)row * 1024 + ct) = w; }) }
        else { EPI_LOOP({ float o[4];
                _Pragma("unroll") for (int j = 0; j < 4; ++j) o[j] = (bj == 1) ? sigmoidf_(v[j]) : ((wc < 2) ? tanhf(v[j]) : v[j]);
                u32x2 w; w.x = pk2(o[0], o[1]); w.y = pk2(o[2], o[3]); *(u32x2*)(L1 + (size_t)row * 256 + ct) = w; }) }
    }
};
struct EpiL2 {
    _Float16* DEC; bf16_t* AA; bf16_t* G; const float* w0; const float* a0;
    __device__ __forceinline__ void operator()(const f32x4 (&acc)[2][2][4][2], int pm, int pn, int wr, int wc, int fr, int fq) const {
        const int sel = pn >> 2, cb = (pn & 3) * 256;
        if (sel == 0) { EPI_LOOP({ const int col = cb + ct; const f32x4 w0v = *(const f32x4*)(w0 + col);
                _Pragma("unroll") for (int j = 0; j < 4; ++j) { const float z = w0v[j] + v[j]; const float sp = fmaxf(-z, 0.f) + log1pf(expf(-fabsf(z))); const float e = expf(-sp - 0.5f);
                    DEC[(size_t)row * 1024 + col + j] = (_Float16)(-expm1f(-e)); } }) }
        else if (sel == 1) { EPI_LOOP({ const int col = cb + ct; const f32x4 a0v = *(const f32x4*)(a0 + col);
                u32x2 w; w.x = pk2(sigmoidf_(a0v[0] + v[0]), sigmoidf_(a0v[1] + v[1])); w.y = pk2(sigmoidf_(a0v[2] + v[2]), sigmoidf_(a0v[3] + v[3]));
                *(u32x2*)(AA + (size_t)row * 1024 + col) = w; }) }
        else { EPI_LOOP({ const int col = cb + ct; u32x2 w; w.x = pk2(v[0], v[1]); w.y = pk2(v[2], v[3]); *(u32x2*)(G + (size_t)row * 1024 + col) = w; }) }
    }
};

template <int MODE>
__device__ __forceinline__ void tr_job(const float* src, int K, int N, bf16_t* dst, int ldd, int row_off, int koff, const float* scale, float* lds, int bid, int nb) {
    const int tk = K / 64, tn = N / 64, tid = threadIdx.x;
    for (int t = bid; t < tk * tn; t += nb) {
        const int k0 = (t / tn) * 64, n0 = (t % tn) * 64;
        { const int r = tid >> 3, c = (tid & 7) * 8; const float* p = src + (size_t)(k0 + r) * N + n0 + c;
          const float4 a = *(const float4*)p, b = *(const float4*)(p + 4); const float s = scale ? scale[k0 + r] : 1.f;
          float* l = lds + r * 65 + c; l[0] = a.x * s; l[1] = a.y * s; l[2] = a.z * s; l[3] = a.w * s; l[4] = b.x * s; l[5] = b.y * s; l[6] = b.z * s; l[7] = b.w * s; }
        __syncthreads();
        { const int nl = tid >> 3, kc = (tid & 7) * 8; float v[8];
#pragma unroll
          for (int i = 0; i < 8; ++i) v[i] = lds[(kc + i) * 65 + nl];
          int n = n0 + nl; int rowi = n;
          if (MODE == 1) rowi = (n >> 7) * 256 + (n & 127);
          if (MODE == 2) rowi = (n >> 7) * 256 + 128 + (n & 127);
          u32x4 w; w.x = pk2(v[0], v[1]); w.y = pk2(v[2], v[3]); w.z = pk2(v[4], v[5]); w.w = pk2(v[6], v[7]);
          *(u32x4*)(dst + (size_t)(row_off + rowi) * ldd + koff + k0 + kc) = w; }
        __syncthreads();
    }
}

__device__ __forceinline__ void prep_phase(const Params& p, float* lds, int bid, int nb) {
    unsigned char* ws = p.ws;
    tr_job<0>(p.in[10], 1024, 2048, (bf16_t*)(ws + OFF_WIN), 1024, 0, 0, nullptr, lds, bid, nb);
    tr_job<0>(p.in[19], 512, 512, (bf16_t*)(ws + OFF_WGLU), 512, 0, 0, nullptr, lds, bid, nb);
    tr_job<0>(p.in[27], 1024, 1024, (bf16_t*)(ws + OFF_WOUT), 1024, 0, 0, nullptr, lds, bid, nb);
    for (int l = 0; l < 2; ++l) {
        bf16_t* gu = (bf16_t*)(ws + (l ? OFF_WGU1 : OFF_WGU0)); bf16_t* dn = (bf16_t*)(ws + (l ? OFF_WDN1 : OFF_WDN0));
        tr_job<1>(p.in[7] + (size_t)l * 1024 * FF, 1024, FF, gu, 1024, 0, 0, nullptr, lds, bid, nb);
        tr_job<2>(p.in[8] + (size_t)l * 1024 * FF, 1024, FF, gu, 1024, 0, 0, nullptr, lds, bid, nb);
        tr_job<0>(p.in[9] + (size_t)l * FF * 1024, FF, 1024, dn, FF, 0, 0, nullptr, lds, bid, nb);
    }
    bf16_t* g1 = (bf16_t*)(ws + OFF_WG1); const float* mu = p.in[28];
    tr_job<0>(p.in[29], 1024, 1024, g1, 2048, 0, 0, nullptr, lds, bid, nb);      tr_job<0>(p.in[29], 1024, 1024, g1, 2048, 0, 1024, mu + 0 * 1024, lds, bid, nb);
    tr_job<0>(p.in[30], 1024, 1024, g1, 2048, 1024, 0, nullptr, lds, bid, nb);   tr_job<0>(p.in[30], 1024, 1024, g1, 2048, 1024, 1024, mu + 2 * 1024, lds, bid, nb);
    tr_job<0>(p.in[31], 1024, 1024, g1, 2048, 2048, 0, nullptr, lds, bid, nb);   tr_job<0>(p.in[31], 1024, 1024, g1, 2048, 2048, 1024, mu + 3 * 1024, lds, bid, nb);
    tr_job<0>(p.in[34], 1024, 64, g1, 2048, 3072, 0, nullptr, lds, bid, nb);     tr_job<0>(p.in[34], 1024, 64, g1, 2048, 3072, 1024, mu + 1 * 1024, lds, bid, nb);
    tr_job<0>(p.in[37], 1024, 64, g1, 2048, 3136, 0, nullptr, lds, bid, nb);     tr_job<0>(p.in[37], 1024, 64, g1, 2048, 3136, 1024, mu + 4 * 1024, lds, bid, nb);
    tr_job<0>(p.in[39], 1024, 128, g1, 2048, 3200, 0, nullptr, lds, bid, nb);    tr_job<0>(p.in[39], 1024, 128, g1, 2048, 3200, 1024, mu + 5 * 1024, lds, bid, nb);
    bf16_t* l2 = (bf16_t*)(ws + OFF_WL2);
    tr_job<0>(p.in[35], 64, 1024, l2, 256, 0, 0, nullptr, lds, bid, nb);
    tr_job<0>(p.in[38], 64, 1024, l2, 256, 1024, 64, nullptr, lds, bid, nb);
    tr_job<0>(p.in[40], 128, 1024, l2, 256, 2048, 128, nullptr, lds, bid, nb);
    for (int i = bid * NTHR + threadIdx.x; i < 3072 * 32; i += nb * NTHR) { const int n = i >> 5, kc = (i & 31) * 8; const int sel = n >> 10;
        const bool used = (sel == 0) ? (kc < 64) : (sel == 1) ? (kc >= 64 && kc < 128) : (kc >= 128);
        if (!used) *(u32x4*)(l2 + (size_t)n * 256 + kc) = (u32x4){0u, 0u, 0u, 0u}; }
    tr_job<0>(p.in[32], 1024, 1024, (bf16_t*)(ws + OFF_WO), 1024, 0, 0, nullptr, lds, bid, nb);
    {   const float* c = p.in[1]; const float* wada = p.in[3]; const float* bada = p.in[4]; float* mod = (float*)(ws + OFF_MOD);
        float* cact = lds;
        float* red = lds + 4096;
        for (int i = threadIdx.x; i < 4096; i += NTHR) { const float x = c[i]; cact[i] = x / (1.f + expf(-x)); }
        __syncthreads();
        const int col = threadIdx.x & 63, kg = threadIdx.x >> 6;
        for (int ch = bid; ch < 192; ch += nb) {
            const int l = ch / 96, n0 = (ch % 96) * 64;
            const float* wp = wada + (size_t)l * 1024 * 6144 + n0 + col;
            float a0 = 0.f, a1 = 0.f, a2 = 0.f, a3 = 0.f;
            for (int k = kg * 128; k < kg * 128 + 128; ++k) { const float w = wp[(size_t)k * 6144]; a0 += cact[k] * w; a1 += cact[1024 + k] * w; a2 += cact[2048 + k] * w; a3 += cact[3072 + k] * w; }
            red[(kg * 4 + 0) * 64 + col] = a0; red[(kg * 4 + 1) * 64 + col] = a1; red[(kg * 4 + 2) * 64 + col] = a2; red[(kg * 4 + 3) * 64 + col] = a3;
            __syncthreads();
            if (threadIdx.x < 256) { const int b = threadIdx.x >> 6; float s = 0.f;
#pragma unroll
                for (int g = 0; g < 8; ++g) s += red[(g * 4 + b) * 64 + col];
                mod[(size_t)(l * 4 + b) * 6144 + n0 + col] = s + bada[l * 6144 + n0 + col]; }
            __syncthreads();
        }
    }
}

template <bool RW>
__device__ __forceinline__ void norm_phase(const float* x, const float* g, const float* modl, int shift_off, int scale_off, bf16_t* out, int bid, int nb) {
    const int wave = threadIdx.x >> 6, lane = threadIdx.x & 63;
    for (int row = bid * 8 + wave; row < MTOK; row += nb * 8) {
        const int b = row >> 12; const float* xr = x + (size_t)row * 1024; const float* md = modl + (size_t)b * 6144;
        f32x4 v[4], vp[4]; float ss = 0.f, ssp = 0.f; const bool hasp = RW && ((row & 4095) != 0);
#pragma unroll
        for (int i = 0; i < 4; ++i) { v[i] = *(const f32x4*)(xr + i * 256 + lane * 4); ss += v[i][0] * v[i][0] + v[i][1] * v[i][1] + v[i][2] * v[i][2] + v[i][3] * v[i][3];
            if (RW) { vp[i] = hasp ? *(const f32x4*)(xr - 1024 + i * 256 + lane * 4) : (f32x4){0.f, 0.f, 0.f, 0.f}; ssp += vp[i][0] * vp[i][0] + vp[i][1] * vp[i][1] + vp[i][2] * vp[i][2] + vp[i][3] * vp[i][3]; } }
        ss = wave_sum(ss); const float rstd = rsqrtf(ss * (1.f / 1024.f) + 1e-6f);
        float rstdp = 0.f; if (RW) { ssp = wave_sum(ssp); rstdp = rsqrtf(ssp * (1.f / 1024.f) + 1e-6f); }
#pragma unroll
        for (int i = 0; i < 4; ++i) { const int c = i * 256 + lane * 4; const f32x4 gg = *(const f32x4*)(g + c), sc = *(const f32x4*)(md + scale_off + c), sh = *(const f32x4*)(md + shift_off + c);
            f32x4 h;
#pragma unroll
            for (int j = 0; j < 4; ++j) h[j] = v[i][j] * rstd * gg[j] * (1.f + sc[j]) + sh[j];
            u32x2 w; w.x = pk2(h[0], h[1]); w.y = pk2(h[2], h[3]);
            if (!RW) *(u32x2*)(out + (size_t)row * 1024 + c) = w;
            else { *(u32x2*)(out + (size_t)row * 2048 + c) = w; f32x4 d;
#pragma unroll
                for (int j = 0; j < 4; ++j) { const float hp = hasp ? (vp[i][j] * rstdp * gg[j] * (1.f + sc[j]) + sh[j]) : 0.f; d[j] = hp - h[j]; }
                u32x2 w2; w2.x = pk2(d[0], d[1]); w2.y = pk2(d[2], d[3]); *(u32x2*)(out + (size_t)row * 2048 + 1024 + c) = w2; } }
    }
}

__device__ __forceinline__ void qknorm_phase(bf16_t* Q, bf16_t* Kb, const int* pos, const float* qn, const float* kn, int bid, int nb) {
    const int wave = threadIdx.x >> 6, lane = threadIdx.x & 63, l16 = lane & 15, d0 = l16 * 4;
    float invf[4];
#pragma unroll
    for (int j = 0; j < 4; ++j) invf[j] = powf(500000.f, -(float)((l16 & 1) * 4 + j) / 8.f);
    const f32x4 qw = *(const f32x4*)(qn + d0), kw = *(const f32x4*)(kn + d0);
    for (int tok = bid * 8 + wave; tok < MTOK; tok += nb * 8) {
        const float ps = (float)pos[tok];
        float cs[4], sn[4];
#pragma unroll
        for (int j = 0; j < 4; ++j) { const float ang = ps * invf[j]; cs[j] = cosf(ang); sn[j] = sinf(ang); }
#pragma unroll
        for (int bsel = 0; bsel < 2; ++bsel) { bf16_t* buf = bsel ? Kb : Q; const f32x4 w = bsel ? kw : qw;
#pragma unroll
            for (int it = 0; it < 2; ++it) { const int vec = it * 4 + (lane >> 4); bf16_t* ptr = buf + (size_t)tok * 512 + vec * 64 + d0;
                const u32x2 raw = *(const u32x2*)ptr; float y[4] = {bflo(raw.x), bfhi(raw.x), bflo(raw.y), bfhi(raw.y)};
                float ss = y[0] * y[0] + y[1] * y[1] + y[2] * y[2] + y[3] * y[3];
                ss += __shfl_xor(ss, 1); ss += __shfl_xor(ss, 2); ss += __shfl_xor(ss, 4); ss += __shfl_xor(ss, 8);
                const float rstd = rsqrtf(ss * (1.f / 64.f) + 1e-6f);
#pragma unroll
                for (int j = 0; j < 4; ++j) y[j] = y[j] * rstd * w[j];
                float pr[4];
#pragma unroll
                for (int j = 0; j < 4; ++j) pr[j] = __shfl_xor(y[j], 2);
                if (l16 < 2) {
#pragma unroll
                    for (int j = 0; j < 4; ++j) y[j] = y[j] * cs[j] - pr[j] * sn[j]; }
                else if (l16 < 4) {
#pragma unroll
                    for (int j = 0; j < 4; ++j) y[j] = y[j] * cs[j] + pr[j] * sn[j]; }
                if (!bsel) {
#pragma unroll
                    for (int j = 0; j < 4; ++j) y[j] *= 0.125f * 1.4426950408889634f; }
                u32x2 o; o.x = pk2(y[0], y[1]); o.y = pk2(y[2], y[3]); *(u32x2*)ptr = o; } }
    }
}

__device__ __forceinline__ float gelu_tanh(float x) { const float t = tanhf(0.7978845608028654f * (x + 0.044715f * x * x * x)); return 0.5f * x * (1.f + t); }
__device__ __forceinline__ void s5_naive(const Params& p, const float* U, bf16_t* YG, float* lds, int bid, int nb) {
    const int wave = threadIdx.x >> 6, lane = threadIdx.x & 63;
    float* L = lds + wave * 3328; float* Lxs = L; float* Lcr = L + 1040; float* Lci = L + 2080; float* Lus = L + 3120;
    const float* lam_re = p.in[11]; const float* lam_im = p.in[12]; const float* log_dt = p.in[13]; const float* b_re = p.in[14]; const float* b_im = p.in[15];
    const float* c_re = p.in[16]; const float* c_im = p.in[17]; const float* dsk = p.in[18];
    for (int unit = bid * 8 + wave; unit < 128; unit += nb * 8) {
        const int b = unit >> 5, g = unit & 31;
        const float lr = lam_re[g * 64 + lane], li = lam_im[g * 64 + lane], dt = expf(log_dt[g]);
        const float mag = expf(lr * dt), ar = mag * cosf(li * dt), ai = mag * sinf(li * dt);
        const float den = lr * lr + li * li, nr = ar - 1.f;
        const float qr = (nr * lr + ai * li) / den, qi = (ai * lr - nr * li) / den;
        float bbr[16], bbi[16];
#pragma unroll
        for (int h = 0; h < 16; ++h) { const float br = b_re[(size_t)(g * 64 + lane) * 16 + h], bi = b_im[(size_t)(g * 64 + lane) * 16 + h]; bbr[h] = qr * br - qi * bi; bbi[h] = qr * bi + qi * br; }
#pragma unroll
        for (int h = 0; h < 16; ++h) { Lcr[h * 65 + lane] = c_re[(size_t)(g * 16 + h) * 64 + lane]; Lci[h * 65 + lane] = c_im[(size_t)(g * 16 + h) * 64 + lane]; }
        const int hh = lane & 15, tq = lane >> 4;
        const float dd = dsk[g * 16 + hh];
        float xr = 0.f, xi = 0.f;
        for (int t0 = 0; t0 < SEQ; t0 += 8) {
            { const int idx = lane * 2, tk = idx >> 4, h = idx & 15; const float2 uu = *(const float2*)(U + ((size_t)b * SEQ + t0 + tk) * 512 + g * 16 + h); Lus[idx] = uu.x; Lus[idx + 1] = uu.y; }
            LWAIT();
#pragma unroll
            for (int tt = 0; tt < 8; ++tt) { float bur = 0.f, bui = 0.f;
#pragma unroll
                for (int h = 0; h < 16; ++h) { const float u = Lus[tt * 16 + h]; bur += bbr[h] * u; bui += bbi[h] * u; }
                const float nxr = ar * xr - ai * xi + bur, nxi = ar * xi + ai * xr + bui; xr = nxr; xi = nxi;
                Lxs[tt * 130 + lane] = xr; Lxs[tt * 130 + 64 + lane] = xi; }
            LWAIT();
#pragma unroll
            for (int i = 0; i < 2; ++i) { const int t = tq + 4 * i; float y = 0.f;
                for (int pp = 0; pp < 64; ++pp) y += Lcr[hh * 65 + pp] * Lxs[t * 130 + pp] - Lci[hh * 65 + pp] * Lxs[t * 130 + 64 + pp];
                y += dd * Lus[t * 16 + hh];
                YG[((size_t)b * SEQ + t0 + t) * 512 + g * 16 + hh] = (bf16_t)f2bf(gelu_tanh(y)); }
            LWAIT();
        }
    }
}

__device__ __forceinline__ void vtrans_phase(const bf16_t* V, bf16_t* Vt, bf16_t* lds, int bid, int nb) {
    const int tid = threadIdx.x;
    for (int unit = bid; unit < 1024; unit += nb) {
        const int head = unit & 3, ch = unit >> 2; const int b = ch >> 6, t0 = (ch & 63) * 64;
#pragma unroll
        for (int i = 0; i < 2; ++i) { const int idx = tid + i * 512, t = idx >> 4, cc = (idx & 15) * 8;
            const u32x4 w = *(const u32x4*)(V + ((size_t)b * SEQ + t0 + t) * 512 + head * 128 + cc);
            unsigned* d = (unsigned*)(lds + t * 130 + cc); d[0] = w.x; d[1] = w.y; d[2] = w.z; d[3] = w.w; }
        __syncthreads();
        { const int e = tid >> 2, tc = (tid & 3) * 16; unsigned o[8];
#pragma unroll
          for (int i = 0; i < 8; ++i) o[i] = (unsigned)lds[(tc + 2 * i) * 130 + e] | ((unsigned)lds[(tc + 2 * i + 1) * 130 + e] << 16);
          u32x4* dst = (u32x4*)(Vt + ((size_t)(b * 4 + head) * 128 + e) * SEQ + t0 + tc);
          dst[0] = (u32x4){o[0], o[1], o[2], o[3]}; dst[1] = (u32x4){o[4], o[5], o[6], o[7]}; }
        __syncthreads();
    }
}

typedef float f32x16 __attribute__((ext_vector_type(16)));
__device__ __forceinline__ unsigned cvt_pk_bf16(float lo, float hi) { unsigned r; asm volatile("v_cvt_pk_bf16_f32 %0, %1, %2" : "=v"(r) : "v"(lo), "v"(hi)); return r; }
__device__ __forceinline__ void attn_phase(const bf16_t* Q, const bf16_t* Kb, const bf16_t* Vt, bf16_t* OC, LAS unsigned char* lds, int bid, int nb) {
    const int tid = threadIdx.x, wave = __builtin_amdgcn_readfirstlane(tid >> 6), lane = tid & 63, c = wave >> 2, wq = wave & 3, l32 = lane & 31, hh = lane >> 5;
    constexpr int KROW = 272, VROW = 72, KBUF = 32 * KROW, VBUF = 128 * VROW, VOFF = 2 * KBUF;
    const int lkey = tid >> 4, lkc = tid & 15, lve = tid >> 2, lvc = tid & 3;
    for (int unit = bid; unit < 256; unit += nb) {
        const int b = unit & 3, head = (unit >> 2) & 3, pr = unit >> 4;
        const bf16_t* kg = Kb + ((size_t)b * SEQ + lkey) * 512 + head * 128 + lkc * 8;
        const bf16_t* vg = Vt + ((size_t)(b * 4 + head) * 128 + lve) * SEQ + lvc * 8;
        for (int half = 0; half < 2; ++half) {
            const int qb = half ? (31 - pr) : pr; const int q0 = qb * 128 + wq * 32; const int ntile = (qb + 1) * 4;
            bf16x8 qf[4];
            { const bf16_t* qp = Q + ((size_t)b * SEQ + q0 + l32) * 512 + head * 128 + c * 64 + hh * 8;
#pragma unroll
              for (int ks = 0; ks < 4; ++ks) qf[ks] = *(const bf16x8*)(qp + ks * 16); }
            f32x16 o[4];
#pragma unroll
            for (int blk = 0; blk < 4; ++blk)
#pragma unroll
                for (int r = 0; r < 16; ++r) o[blk][r] = 0.f;
            float mrow = -INFINITY, lsum = 0.f;
            u32x4 kreg = *(const u32x4*)kg, vreg = *(const u32x4*)vg;
            __syncthreads();
            { *(LAS u32x4*)(lds + lkey * KROW + lkc * 16) = kreg;
              LAS u32x2* vd = (LAS u32x2*)(lds + VOFF + lve * VROW + lvc * 16); vd[0] = (u32x2){vreg.x, vreg.y}; vd[1] = (u32x2){vreg.z, vreg.w}; }
            __syncthreads();
            for (int kt = 0; kt < ntile; ++kt) {
                const int cur = kt & 1, key0 = kt * 32;
                if (kt + 1 < ntile) { kreg = *(const u32x4*)(kg + (size_t)(key0 + 32) * 512); vreg = *(const u32x4*)(vg + key0 + 32); }
                if (key0 <= q0) {
                    LAS unsigned char* kb = lds + cur * KBUF + l32 * KROW + c * 128 + hh * 16;
                    f32x16 sacc;
#pragma unroll
                    for (int r = 0; r < 16; ++r) sacc[r] = 0.f;
#pragma unroll
                    for (int ks = 0; ks < 4; ++ks) { const bf16x8 kf = *(const LAS bf16x8*)(kb + ks * 32); sacc = __builtin_amdgcn_mfma_f32_32x32x16_bf16(kf, qf[ks], sacc, 0, 0, 0); }
                    if (key0 == q0) {
#pragma unroll
                        for (int r = 0; r < 16; ++r) { const int kl = (r & 3) + 8 * (r >> 2) + 4 * hh; if (kl > l32) sacc[r] = -INFINITY; } }
                    float tm = sacc[0];
#pragma unroll
                    for (int r = 1; r < 16; ++r) tm = fmaxf(tm, sacc[r]);
                    tm = fmaxf(tm, __shfl_xor(tm, 32));
                    const float mnew = fmaxf(mrow, tm);
                    if (__any(mnew > mrow)) { const float al = exp2f(mrow - mnew); lsum *= al;
#pragma unroll
                        for (int blk = 0; blk < 4; ++blk)
#pragma unroll
                            for (int r = 0; r < 16; ++r) o[blk][r] *= al;
                        mrow = mnew; }
                    float ps = 0.f;
#pragma unroll
                    for (int r = 0; r < 16; ++r) { sacc[r] = exp2f(sacc[r] - mrow); ps += sacc[r]; }
                    lsum += ps;
                    LAS unsigned char* vb = lds + VOFF + cur * VBUF + l32 * VROW + hh * 8;
#pragma unroll
                    for (int s2 = 0; s2 < 2; ++s2) {
                        u32x4 pw; pw.x = cvt_pk_bf16(sacc[8 * s2 + 0], sacc[8 * s2 + 1]); pw.y = cvt_pk_bf16(sacc[8 * s2 + 2], sacc[8 * s2 + 3]); pw.z = cvt_pk_bf16(sacc[8 * s2 + 4], sacc[8 * s2 + 5]); pw.w = cvt_pk_bf16(sacc[8 * s2 + 6], sacc[8 * s2 + 7]);
                        const bf16x8 pb = __builtin_bit_cast(bf16x8, pw);
#pragma unroll
                        for (int blk = 0; blk < 4; ++blk) { const u32x2 v0 = *(const LAS u32x2*)(vb + blk * 32 * VROW + s2 * 32), v1 = *(const LAS u32x2*)(vb + blk * 32 * VROW + s2 * 32 + 16);
                            const bf16x8 vf = __builtin_bit_cast(bf16x8, (u32x4){v0.x, v0.y, v1.x, v1.y});
                            o[blk] = __builtin_amdgcn_mfma_f32_32x32x16_bf16(vf, pb, o[blk], 0, 0, 0); } }
                }
                if (kt + 1 < ntile) { const int nx = cur ^ 1;
                    *(LAS u32x4*)(lds + nx * KBUF + lkey * KROW + lkc * 16) = kreg;
                    LAS u32x2* vd = (LAS u32x2*)(lds + VOFF + nx * VBUF + lve * VROW + lvc * 16); vd[0] = (u32x2){vreg.x, vreg.y}; vd[1] = (u32x2){vreg.z, vreg.w}; }
                __syncthreads();
            }
            lsum += __shfl_xor(lsum, 32);
            const float inv = 1.f / lsum;
            bf16_t* op = OC + ((size_t)b * SEQ + q0 + l32) * 1024 + (head * 2 + c) * 128 + 4 * hh;
#pragma unroll
            for (int blk = 0; blk < 4; ++blk)
#pragma unroll
                for (int g4 = 0; g4 < 4; ++g4) { u32x2 w; w.x = pk2(o[blk][g4 * 4 + 0] * inv, o[blk][g4 * 4 + 1] * inv); w.y = pk2(o[blk][g4 * 4 + 2] * inv, o[blk][g4 * 4 + 3] * inv);
                    *(u32x2*)(op + blk * 32 + g4 * 8) = w; }
        }
    }
}

__device__ __forceinline__ void attn_combine(const bf16_t* OC, bf16_t* CAT, const Params& p, int bid, int nb) {
    const int wave = threadIdx.x >> 6, lane = threadIdx.x & 63, head = lane >> 4, e0 = (lane & 15) * 8;
    float lam;
    { float s1 = 0.f, s2 = 0.f; for (int d = 0; d < 64; ++d) { s1 += p.in[22][d] * p.in[23][d]; s2 += p.in[24][d] * p.in[25][d]; } lam = expf(s1) - expf(s2) + 0.2f; }
    float sub[8];
#pragma unroll
    for (int i = 0; i < 8; ++i) sub[i] = p.in[26][e0 + i] * 0.8f;
    for (int tok = bid * 8 + wave; tok < MTOK; tok += nb * 8) {
        const u32x4 a = *(const u32x4*)(OC + (size_t)tok * 1024 + (head * 2) * 128 + e0), bb = *(const u32x4*)(OC + (size_t)tok * 1024 + (head * 2 + 1) * 128 + e0);
        float o[8] = {bflo(a.x) - lam * bflo(bb.x), bfhi(a.x) - lam * bfhi(bb.x), bflo(a.y) - lam * bflo(bb.y), bfhi(a.y) - lam * bfhi(bb.y),
                      bflo(a.z) - lam * bflo(bb.z), bfhi(a.z) - lam * bfhi(bb.z), bflo(a.w) - lam * bflo(bb.w), bfhi(a.w) - lam * bfhi(bb.w)};
        float ss = 0.f;
#pragma unroll
        for (int i = 0; i < 8; ++i) ss += o[i] * o[i];
        ss += __shfl_xor(ss, 1); ss += __shfl_xor(ss, 2); ss += __shfl_xor(ss, 4); ss += __shfl_xor(ss, 8);
        const float rstd = rsqrtf(ss * (1.f / 128.f) + 1e-6f);
        u32x4 w; w.x = pk2(o[0] * rstd * sub[0], o[1] * rstd * sub[1]); w.y = pk2(o[2] * rstd * sub[2], o[3] * rstd * sub[3]); w.z = pk2(o[4] * rstd * sub[4], o[5] * rstd * sub[5]); w.w = pk2(o[6] * rstd * sub[6], o[7] * rstd * sub[7]);
        *(u32x4*)(CAT + (size_t)tok * 1024 + 512 + head * 128 + e0) = w;
    }
}

__device__ __forceinline__ float dpp_sum16(float x) {
    x += __int_as_float(__builtin_amdgcn_update_dpp(0, __float_as_int(x), 0xB1, 0xf, 0xf, true));
    x += __int_as_float(__builtin_amdgcn_update_dpp(0, __float_as_int(x), 0x4E, 0xf, 0xf, true));
    x += __int_as_float(__builtin_amdgcn_update_dpp(0, __float_as_int(x), 0x141, 0xf, 0xf, true));
    x += __int_as_float(__builtin_amdgcn_update_dpp(0, __float_as_int(x), 0x140, 0xf, 0xf, true));
    return x;
}
__device__ __forceinline__ void rwkv_phase(const Params& p, const bf16_t* R, const bf16_t* Kk, const bf16_t* Vv, const _Float16* DEC, const bf16_t* AA, bf16_t* Y, float* lds, int bid, int nb) {
    const int tid = threadIdx.x, wave = __builtin_amdgcn_readfirstlane(tid >> 6), lane = tid & 63;
    constexpr int TCH = 16, BUFF = 5 * TCH * 64 + TCH * 16;
    float* Lout = lds + 2 * BUFF;
    for (int unit = bid; unit < 256; unit += nb) {
        const int b = unit >> 6, h = (unit >> 2) & 15, rq = unit & 3;
        __syncthreads();
        if (wave >= 4) {
            const int pw = wave - 4;
            const float kkw = p.in[41][h * 64 + lane], kaw = p.in[42][h * 64 + lane];
            float rr[4], kr[4], dr[4], ar[4], vr[4];
            auto issue = [&](int ch) {
#pragma unroll
                for (int i = 0; i < 4; ++i) { const size_t off = ((size_t)b * SEQ + ch * TCH + pw * 4 + i) * 1024 + h * 64;
                    rr[i] = bf2f(R[off + lane]); kr[i] = bf2f(Kk[off + lane]); dr[i] = 1.f - (float)DEC[off + lane]; ar[i] = bf2f(AA[off + lane]); vr[i] = bf2f(Vv[off + rq * 16 + (lane & 15)]); } };
            auto stage = [&](int buf) { float* L = lds + buf * BUFF;
#pragma unroll
                for (int i = 0; i < 4; ++i) { const int tt = pw * 4 + i; const float k = kr[i], a = ar[i];
                    float kk = k * kkw; const float n2 = wave_sum(kk * kk); kk = kk / fmaxf(sqrtf(n2), 1e-12f);
                    L[(0 * TCH + tt) * 64 + lane] = dr[i]; L[(1 * TCH + tt) * 64 + lane] = -kk; L[(2 * TCH + tt) * 64 + lane] = kk * a; L[(3 * TCH + tt) * 64 + lane] = k * (1.f + (a - 1.f) * kaw); L[(4 * TCH + tt) * 64 + lane] = rr[i];
                    if (lane < 16) L[5 * TCH * 64 + tt * 16 + lane] = vr[i]; } };
            issue(0); stage(0); issue(1);
            __syncthreads();
            for (int ch = 0; ch < SEQ / TCH; ++ch) {
                if (ch + 1 < SEQ / TCH) stage((ch + 1) & 1);
                if (ch + 2 < SEQ / TCH) issue(ch + 2);
                if (ch > 0) { const int i = tid - 256, tt = i >> 4, row = i & 15; Y[((size_t)b * SEQ + (ch - 1) * TCH + tt) * 1024 + h * 64 + rq * 16 + row] = (bf16_t)f2bf(Lout[((ch - 1) & 1) * (TCH * 16) + i]); }
                __syncthreads();
            }
            { const int ch = SEQ / TCH; const int i = tid - 256, tt = i >> 4, row = i & 15; Y[((size_t)b * SEQ + (ch - 1) * TCH + tt) * 1024 + h * 64 + rq * 16 + row] = (bf16_t)f2bf(Lout[((ch - 1) & 1) * (TCH * 16) + i]); }
        } else {
            const int j = lane & 15, rowl = wave * 4 + (lane >> 4);
            float S0 = 0.f, S1 = 0.f, S2 = 0.f, S3 = 0.f;
            __syncthreads();
            for (int ch = 0; ch < SEQ / TCH; ++ch) {
                const float* L = lds + (ch & 1) * BUFF; float* Lo = Lout + (ch & 1) * (TCH * 16);
#pragma unroll
                for (int tt = 0; tt < TCH; ++tt) {
                    const f32x4 w4 = *(const f32x4*)(L + (0 * TCH + tt) * 64 + j * 4), a4 = *(const f32x4*)(L + (1 * TCH + tt) * 64 + j * 4), b4 = *(const f32x4*)(L + (2 * TCH + tt) * 64 + j * 4),
                                k4 = *(const f32x4*)(L + (3 * TCH + tt) * 64 + j * 4), r4 = *(const f32x4*)(L + (4 * TCH + tt) * 64 + j * 4);
                    const float vv = L[5 * TCH * 64 + tt * 16 + rowl];
                    const float sa = dpp_sum16(S0 * a4[0] + S1 * a4[1] + S2 * a4[2] + S3 * a4[3]);
                    S0 = S0 * w4[0] + (sa * b4[0] + vv * k4[0]); S1 = S1 * w4[1] + (sa * b4[1] + vv * k4[1]); S2 = S2 * w4[2] + (sa * b4[2] + vv * k4[2]); S3 = S3 * w4[3] + (sa * b4[3] + vv * k4[3]);
                    const float y = dpp_sum16(S0 * r4[0] + S1 * r4[1] + S2 * r4[2] + S3 * r4[3]);
                    if (j == 0) Lo[tt * 16 + rowl] = y;
                }
                __syncthreads();
            }
        }
    }
}

__device__ __forceinline__ void rwkv_post(const Params& p, bf16_t* R, const bf16_t* Kk, const bf16_t* Vv, const bf16_t* AA, const bf16_t* G, const bf16_t* Y, int bid, int nb) {
    const int wave = threadIdx.x >> 6, lane = threadIdx.x & 63;
    for (int it = bid * 8 + wave; it < MTOK * 16; it += nb * 8) {
        const int h = it & 15; const size_t off = (size_t)(it >> 4) * 1024 + h * 64 + lane;
        const float y = bf2f(Y[off]), r = bf2f(R[off]), k = bf2f(Kk[off]), v = bf2f(Vv[off]), a = bf2f(AA[off]), g = bf2f(G[off]);
        const float mean = wave_sum(y) * (1.f / 64.f); const float d = y - mean; const float var = wave_sum(d * d) * (1.f / 64.f);
        const float k2 = k * (1.f + (a - 1.f) * p.in[42][h * 64 + lane]);
        const float sb = wave_sum(r * k2 * p.in[43][h * 64 + lane]);
        const float yn = d * rsqrtf(var + 64e-5f) * p.in[44][h * 64 + lane] + p.in[45][h * 64 + lane] + sb * v;
        R[off] = (bf16_t)f2bf(yn * g);
    }
}

__global__ void __launch_bounds__(NTHR) fwd_kernel(Params p) {
    extern __shared__ __attribute__((aligned(16))) unsigned char lds_raw[];
    LAS unsigned char* lds = (LAS unsigned char*)lds_raw;
    float* ldsf = (float*)lds_raw;
    const int bid = blockIdx.x, nb = gridDim.x;
    unsigned char* ws = p.ws;
    float* mod = (float*)(ws + OFF_MOD);
    const bool multi = (p.ph_hi - p.ph_lo) > 1;
#ifndef TESTPH
#define TESTPH -1
#endif
#define PH(k) if ((TESTPH < 0 || TESTPH == (k)) && p.ph_lo <= (k) && (k) < p.ph_hi)
#define SYNC(k) if (multi && (k) + 1 < p.ph_hi) { cg::this_grid().sync(); }
    PH(0) { prep_phase(p, ldsf, bid, nb); SYNC(0) }
    PH(1) { norm_phase<false>(p.in[0], p.in[5], mod, 0, 1024, (bf16_t*)(ws + OFF_HA), bid, nb); SYNC(1) }
    PH(2) { EpiWin e{(float*)(ws + OFF_U), (bf16_t*)(ws + OFF_QKV)}; gemm_phase(lds, (const bf16_t*)(ws + OFF_HA), (const bf16_t*)(ws + OFF_WIN), 2048, 1024, e, bid, nb); SYNC(2) }
    PH(3) { bf16_t* q = (bf16_t*)(ws + OFF_QKV); qknorm_phase(q, q + (size_t)MTOK * 512, (const int*)p.in[2], p.in[20], p.in[21], bid, nb);
            vtrans_phase(q + (size_t)MTOK * 1024, (bf16_t*)(ws + OFF_VT), (bf16_t*)lds_raw, bid, nb); SYNC(3) }
    PH(4) { s5_naive(p, (const float*)(ws + OFF_U), (bf16_t*)(ws + OFF_YG), ldsf, bid, nb); SYNC(4) }
    PH(5) { bf16_t* q = (bf16_t*)(ws + OFF_QKV); attn_phase(q, q + (size_t)MTOK * 512, (const bf16_t*)(ws + OFF_VT), (bf16_t*)(ws + OFF_OC), lds, bid, nb); SYNC(5) }
    PH(6) { attn_combine((const bf16_t*)(ws + OFF_OC), (bf16_t*)(ws + OFF_CAT), p, bid, nb);
            EpiGlu e{(const bf16_t*)(ws + OFF_YG), (bf16_t*)(ws + OFF_CAT)}; gemm_phase(lds, (const bf16_t*)(ws + OFF_YG), (const bf16_t*)(ws + OFF_WGLU), 512, 512, e, bid, nb); SYNC(6) }
    PH(7) { EpiRes e{p.in[0], p.out, mod + 2048}; gemm_phase(lds, (const bf16_t*)(ws + OFF_CAT), (const bf16_t*)(ws + OFF_WOUT), 1024, 1024, e, bid, nb); SYNC(7) }
    PH(8) { norm_phase<false>(p.out, p.in[6], mod, 3072, 4096, (bf16_t*)(ws + OFF_HA), bid, nb); SYNC(8) }
    PH(9) { EpiSwiglu e{(bf16_t*)(ws + OFF_HID)}; gemm_phase(lds, (const bf16_t*)(ws + OFF_HA), (const bf16_t*)(ws + OFF_WGU0), 5632, 1024, e, bid, nb); SYNC(9) }
    PH(10) { EpiRes e{p.out, p.out, mod + 5120}; gemm_phase(lds, (const bf16_t*)(ws + OFF_HID), (const bf16_t*)(ws + OFF_WDN0), 1024, FF, e, bid, nb); SYNC(10) }
    const float* mod1 = mod + 4 * 6144;
    PH(11) { norm_phase<true>(p.out, p.in[5] + 1024, mod1, 0, 1024, (bf16_t*)(ws + OFF_HD), bid, nb); SYNC(11) }
    PH(12) { EpiG1 e{(bf16_t*)(ws + OFF_RKV), (bf16_t*)(ws + OFF_L1)}; gemm_phase(lds, (const bf16_t*)(ws + OFF_HD), (const bf16_t*)(ws + OFF_WG1), 3328, 2048, e, bid, nb); SYNC(12) }
    PH(13) { EpiL2 e{(_Float16*)(ws + OFF_DEC), (bf16_t*)(ws + OFF_AA), (bf16_t*)(ws + OFF_G), p.in[33], p.in[36]}; gemm_phase(lds, (const bf16_t*)(ws + OFF_L1), (const bf16_t*)(ws + OFF_WL2), 3072, 256, e, bid, nb); SYNC(13) }
    PH(14) { const bf16_t* r = (const bf16_t*)(ws + OFF_RKV); rwkv_phase(p, r, r + (size_t)MTOK * 1024, r + (size_t)MTOK * 2048, (const _Float16*)(ws + OFF_DEC), (const bf16_t*)(ws + OFF_AA), (bf16_t*)(ws + OFF_Y), ldsf, bid, nb); SYNC(14) }
    PH(15) { bf16_t* r = (bf16_t*)(ws + OFF_RKV); rwkv_post(p, r, r + (size_t)MTOK * 1024, r + (size_t)MTOK * 2048, (const bf16_t*)(ws + OFF_AA), (const bf16_t*)(ws + OFF_G), (const bf16_t*)(ws + OFF_Y), bid, nb); SYNC(15) }
    PH(16) { EpiRes e{p.out, p.out, mod1 + 2048}; gemm_phase(lds, (const bf16_t*)(ws + OFF_RKV), (const bf16_t*)(ws + OFF_WO), 1024, 1024, e, bid, nb); SYNC(16) }
    PH(17) { norm_phase<false>(p.out, p.in[6] + 1024, mod1, 3072, 4096, (bf16_t*)(ws + OFF_HA), bid, nb); SYNC(17) }
    PH(18) { EpiSwiglu e{(bf16_t*)(ws + OFF_HID)}; gemm_phase(lds, (const bf16_t*)(ws + OFF_HA), (const bf16_t*)(ws + OFF_WGU1), 5632, 1024, e, bid, nb); SYNC(18) }
    PH(19) { EpiRes e{p.out, p.out, mod1 + 5120}; gemm_phase(lds, (const bf16_t*)(ws + OFF_HID), (const bf16_t*)(ws + OFF_WDN1), 1024, FF, e, bid, nb); }
}

constexpr int NPHASE = 20;
#ifndef ONE_LAUNCH
#define ONE_LAUNCH 1
#endif

extern "C" void kernel_launch(void* const* d_in, const int* in_sizes, int n_in, void* d_out, int out_size, void* d_ws, size_t ws_size, hipStream_t stream) {
    static int grid = 0;
    if (grid == 0) {
        if (n_in != 46 || ws_size < WS_NEED) { fprintf(stderr, "kernel_launch: unexpected n_in %d / ws_size %zu (need %zu)\n", n_in, ws_size, (size_t)WS_NEED); grid = -1; return; }
        if (hipFuncSetAttribute((const void*)fwd_kernel, hipFuncAttributeMaxDynamicSharedMemorySize, LDS_BYTES) != hipSuccess) { fprintf(stderr, "hipFuncSetAttribute failed\n"); grid = -1; return; }
        int dev = 0, cus = 0, per_cu = 0;
        (void)hipGetDevice(&dev); (void)hipDeviceGetAttribute(&cus, hipDeviceAttributeMultiprocessorCount, dev);
        (void)hipOccupancyMaxActiveBlocksPerMultiprocessor(&per_cu, (const void*)fwd_kernel, NTHR, LDS_BYTES);
        if (per_cu < 1) per_cu = 1;
        grid = cus;
    }
    if (grid < 0) return;
    Params p{};
    for (int i = 0; i < 46; ++i) p.in[i] = (const float*)d_in[i];
    p.out = (float*)d_out; p.ws = (unsigned char*)d_ws;
#if ONE_LAUNCH
    p.ph_lo = 0; p.ph_hi = NPHASE;
    void* args[] = {&p};
    hipError_t e = hipLaunchCooperativeKernel((const void*)fwd_kernel, dim3(grid), dim3(NTHR), args, LDS_BYTES, stream);
    if (e != hipSuccess) fprintf(stderr, "cooperative launch failed: %s (grid %d)\n", hipGetErrorString(e), grid);
#else
    for (int ph = 0; ph < NPHASE; ++ph) { p.ph_lo = ph; p.ph_hi = ph + 1; hipLaunchKernelGGL(fwd_kernel, dim3(grid), dim3(NTHR), LDS_BYTES, stream, p); }
#endif
}
```

```cpp
#include <hip/hip_runtime.h>
#include <hip/hip_cooperative_groups.h>
#include <cstdio>
#include <cstdint>
namespace cg = cooperative_groups;

#define LAS __attribute__((address_space(3)))
typedef unsigned short bf16_t;
typedef short bf16x8 __attribute__((ext_vector_type(8)));
typedef float f32x4 __attribute__((ext_vector_type(4)));
typedef unsigned u32x2 __attribute__((ext_vector_type(2)));
typedef unsigned u32x4 __attribute__((ext_vector_type(4)));

constexpr int MTOK = 16384, DM = 1024, SEQ = 4096, FF = 2816;
constexpr int NTHR = 512;
constexpr int LDS_BYTES = 131072;
constexpr size_t MiB = 1048576;
constexpr size_t OFF_WIN = 0;
constexpr size_t OFF_WGLU = 4194304;
constexpr size_t OFF_WOUT = 4718592;
constexpr size_t OFF_WGU0 = 6815744;
constexpr size_t OFF_WDN0 = 18350080;
constexpr size_t OFF_WGU1 = 39321600;
constexpr size_t OFF_WDN1 = 50855936;
constexpr size_t OFF_WG1 = 24117248;
constexpr size_t OFF_WL2 = 37748736;
constexpr size_t OFF_WO = 56623104;
constexpr size_t OFF_MOD = 58720256;
constexpr size_t ACT = 57 * MiB;
constexpr size_t OFF_HA = ACT;
constexpr size_t OFF_UX = ACT + 32 * MiB;
constexpr size_t OFF_Z = ACT + 52 * MiB;
constexpr size_t OFF_BTZ = ACT + 112 * MiB;
constexpr size_t OFF_BTY = ACT + 176 * MiB;
constexpr size_t OFF_QKV = ACT + 64 * MiB;
constexpr size_t OFF_CAT = ACT + 112 * MiB;
constexpr size_t OFF_YG = ACT + 144 * MiB;
constexpr size_t OFF_VT = ACT + 160 * MiB;
constexpr size_t OFF_OC = ACT;
constexpr size_t OFF_HID = ACT + 32 * MiB;
constexpr size_t OFF_HD = ACT;
constexpr size_t OFF_RKV = ACT + 64 * MiB;
constexpr size_t OFF_G = ACT + 160 * MiB;
constexpr size_t OFF_Y = 0;
constexpr size_t OFF_L1 = 0;
constexpr size_t OFF_DEC = ACT;
constexpr size_t OFF_AA = ACT + 32 * MiB;
constexpr size_t WS_NEED = ACT + 196 * MiB;

struct Params {
    const float* in[46];
    float* out;
    unsigned char* ws;
    int ph_lo, ph_hi;
};

__device__ __forceinline__ unsigned f2bf(float f) { unsigned u = __float_as_uint(f); return (u + 0x7fffu + ((u >> 16) & 1u)) >> 16; }
__device__ __forceinline__ float bf2f(unsigned h) { return __uint_as_float(h << 16); }
__device__ __forceinline__ unsigned cvt_pk_bf16(float lo, float hi) { unsigned r; asm("v_cvt_pk_bf16_f32 %0, %1, %2" : "=v"(r) : "v"(lo), "v"(hi)); return r; }
__device__ __forceinline__ unsigned pk2(float lo, float hi) { return cvt_pk_bf16(lo, hi); }
__device__ __forceinline__ float bflo(unsigned w) { return __uint_as_float(w << 16); }
__device__ __forceinline__ float bfhi(unsigned w) { return __uint_as_float(w & 0xffff0000u); }
__device__ __forceinline__ float wave_sum(float v) {
#pragma unroll
    for (int o = 32; o > 0; o >>= 1) v += __shfl_xor(v, o);
    return v;
}
__device__ __forceinline__ float sigmoidf_(float x) { return 1.f / (1.f + __expf(-x)); }
#define LWAIT() asm volatile("s_waitcnt lgkmcnt(0)" ::: "memory")
__device__ __forceinline__ float gelu_tanh(float x) { const float t = tanhf(0.7978845608028654f * (x + 0.044715f * x * x * x)); return 0.5f * x * (1.f + t); }

constexpr int HTB = 128 * 64 * 2;
__device__ __forceinline__ int lds_byte(int r, int c) { int st = (r >> 4) * 2 + (c >> 5), rr = r & 15, cc = c & 31, ob = rr * 64 + cc * 2; return st * 1024 + (ob ^ (((ob >> 9) & 1) << 5)); }
__device__ __forceinline__ void stage_rc(int b, int& R, int& C) { int st = b / 1024, sb = b % 1024, swz = sb ^ (((sb >> 9) & 1) << 5); R = (st >> 1) * 16 + swz / 64; C = (st & 1) * 32 + (swz % 64) / 2; }

struct NoPre { __device__ __forceinline__ void operator()(int, int, int) const {} };
template <class Epi, class Pre>
__device__ __forceinline__ void gemm_batched(LAS unsigned char* lds, const bf16_t* A, int lda, size_t strideA, const bf16_t* Bt, size_t strideB, int nMt, int nNt, int nbatch, int K, const Epi& E, const Pre& PRE, int bid, int nb) {
    const int tid = threadIdx.x, wid = __builtin_amdgcn_readfirstlane(tid >> 6), lane = tid & 63, wr = wid >> 2, wc = wid & 3, fr = lane & 15, fq = lane >> 4;
    unsigned voffA[2], voffB[2];
#pragma unroll
    for (int i = 0; i < 2; ++i) { int R, C; stage_rc(tid * 16 + i * 8192, R, C); voffA[i] = (unsigned)(R * lda + C) * 2u; voffB[i] = (unsigned)(R * K + C) * 2u; }
    const int aoff = lds_byte(wr * 64 + fr, fq * 8), boff = lds_byte(wc * 32 + fr, fq * 8);
    const unsigned ldsw = (unsigned)wid * 1024u;
    const size_t kstep = 128, hstepA = (size_t)128 * lda * 2, hstepB = (size_t)128 * K * 2;
    const int nt = K / 64;
    const int ntiles = nMt * nNt * nbatch;
#define G_SA(b, h) (((b) * 2 + (h)) * HTB)
#define G_SB(b, h) ((4 + (b) * 2 + (h)) * HTB)
#define G_STAGEX(bufoff, gptr, vo) do { _Pragma("unroll") for (int _i = 0; _i < 2; ++_i) \
        __builtin_amdgcn_global_load_lds((const unsigned*)((gptr) + vo[_i]), (LAS unsigned*)(lds + (bufoff) + ldsw + _i * 8192), 16, 0, 0); } while (0)
#define G_STA(bufoff, gptr) G_STAGEX(bufoff, gptr, voffA)
#define G_STB(bufoff, gptr) G_STAGEX(bufoff, gptr, voffB)
#define G_LDA(dst, b, h) do { _Pragma("unroll") for (int m = 0; m < 4; ++m) _Pragma("unroll") for (int k = 0; k < 2; ++k) dst[m][k] = *(const LAS bf16x8*)(lds + G_SA(b, h) + aoff + m * 2048 + k * 1024); } while (0)
#define G_LDB(dst, b, h) do { _Pragma("unroll") for (int n = 0; n < 2; ++n) _Pragma("unroll") for (int k = 0; k < 2; ++k) dst[n][k] = *(const LAS bf16x8*)(lds + G_SB(b, h) + boff + n * 2048 + k * 1024); } while (0)
#define G_MMA(ai, bj, At, Bx) do { __builtin_amdgcn_s_setprio(1); _Pragma("unroll") for (int m = 0; m < 4; ++m) _Pragma("unroll") for (int n = 0; n < 2; ++n) _Pragma("unroll") for (int k = 0; k < 2; ++k) \
        acc[ai][bj][m][n] = __builtin_amdgcn_mfma_f32_16x16x32_bf16(Bx[n][k], At[m][k], acc[ai][bj][m][n], 0, 0, 0); __builtin_amdgcn_s_setprio(0); } while (0)
#define G_WV(n) asm volatile("s_waitcnt vmcnt(" #n ")" ::: "memory")
#define G_WL(n) asm volatile("s_waitcnt lgkmcnt(" #n ")" ::: "memory")
#define G_BAR __builtin_amdgcn_s_barrier()
#define G_SCHED __builtin_amdgcn_sched_barrier(0)
    for (int tile = bid; tile < ntiles; tile += nb) {
        const int pm = tile % nMt, tq = tile / nMt, pn = tq % nNt, gb = tq / nNt;
        PRE(gb, pm, pn);
        const char* cA = (const char*)(A + (size_t)gb * strideA) + (size_t)pm * 256 * lda * 2;
        const char* cB = (const char*)(Bt + (size_t)gb * strideB) + (size_t)pn * 256 * K * 2;
        f32x4 acc[2][2][4][2];
#pragma unroll
        for (int a = 0; a < 2; ++a)
#pragma unroll
            for (int b = 0; b < 2; ++b)
#pragma unroll
                for (int m = 0; m < 4; ++m)
#pragma unroll
                    for (int n = 0; n < 2; ++n) acc[a][b][m][n] = (f32x4){0.f, 0.f, 0.f, 0.f};
        bf16x8 At[4][2], B0[2][2], B1[2][2];
        G_WV(0);
        G_STB(G_SB(0, 0), cB); G_STA(G_SA(0, 0), cA); G_STB(G_SB(0, 1), cB + hstepB); G_STA(G_SA(0, 1), cA + hstepA);
        if (wr == 1) G_BAR;
        G_WV(4); G_BAR;
        G_STB(G_SB(1, 0), cB + kstep); G_STA(G_SA(1, 0), cA + kstep); G_STB(G_SB(1, 1), cB + hstepB + kstep);
        G_WV(6); G_BAR;
        for (int t = 0; t < nt - 2; t += 2) {
            const char* a1 = cA + (size_t)(t + 1) * kstep; const char* a2 = cA + (size_t)(t + 2) * kstep; const char* a3 = a2 + kstep;
            const char* b2 = cB + (size_t)(t + 2) * kstep; const char* b3 = b2 + kstep;
            G_LDB(B0, 0, 0); G_SCHED; G_LDA(At, 0, 0); G_STA(G_SA(1, 1), a1 + hstepA);
            G_WL(8); G_BAR; G_WL(0); G_MMA(0, 0, At, B0); G_BAR; G_SCHED;
            G_LDB(B1, 0, 1); G_STB(G_SB(0, 0), b2);
            G_BAR; G_WL(0); G_MMA(0, 1, At, B1); G_BAR;
            G_LDA(At, 0, 1); G_STA(G_SA(0, 0), a2);
            G_BAR; G_WL(0); G_MMA(1, 0, At, B0); G_BAR; G_SCHED;
            G_STB(G_SB(0, 1), b2 + hstepB);
            G_WV(6); G_BAR; G_MMA(1, 1, At, B1); G_BAR;
            G_LDB(B0, 1, 0); G_SCHED; G_LDA(At, 1, 0); G_STA(G_SA(0, 1), a2 + hstepA);
            G_WL(8); G_BAR; G_WL(0); G_MMA(0, 0, At, B0); G_BAR; G_SCHED;
            G_LDB(B1, 1, 1); G_STB(G_SB(1, 0), b3);
            G_BAR; G_WL(0); G_MMA(0, 1, At, B1); G_BAR;
            G_LDA(At, 1, 1); G_STA(G_SA(1, 0), a3);
            G_BAR; G_WL(0); G_MMA(1, 0, At, B0); G_BAR; G_SCHED;
            G_STB(G_SB(1, 1), b3 + hstepB);
            G_WV(6); G_BAR; G_MMA(1, 1, At, B1); G_BAR;
        }
        {
            const char* a1 = cA + (size_t)(nt - 1) * kstep;
            G_LDB(B0, 0, 0); G_LDA(At, 0, 0); G_STA(G_SA(1, 1), a1 + hstepA);
            G_BAR; G_WL(0); G_MMA(0, 0, At, B0); G_BAR;
            G_LDB(B1, 0, 1); G_BAR; G_WL(0); G_MMA(0, 1, At, B1); G_BAR;
            G_LDA(At, 0, 1); G_WV(4); G_BAR; G_WL(0); G_MMA(1, 0, At, B0); G_MMA(1, 1, At, B1); G_BAR;
        }
        {
            G_LDB(B0, 1, 0); G_LDA(At, 1, 0); G_WV(2); G_BAR; G_WL(0); G_MMA(0, 0, At, B0); G_BAR;
            G_LDB(B1, 1, 1); G_WV(0); G_BAR; G_WL(0); G_MMA(0, 1, At, B1); G_BAR;
            G_LDA(At, 1, 1); G_BAR; G_WL(0); G_MMA(1, 0, At, B0); G_MMA(1, 1, At, B1); G_BAR;
        }
        if (wr == 0) G_BAR;
        E(acc, gb, pm, pn, wr, wc, fr, fq);
    }
    G_WV(0);
    __syncthreads();
}

template <class Epi>
__device__ __forceinline__ void gemm_phase(LAS unsigned char* lds, const bf16_t* A, const bf16_t* Bt, int N, int K, const Epi& E, int bid, int nb) {
    gemm_batched(lds, A, K, 0, Bt, 0, 64, N / 256, 1, K, E, NoPre{}, bid, nb);
}

#define EPI_LOOP(...) \
    _Pragma("unroll") for (int ai = 0; ai < 2; ++ai) _Pragma("unroll") for (int m = 0; m < 4; ++m) { asm volatile("" ::: "memory"); const int row = pm * 256 + ai * 128 + wr * 64 + m * 16 + fr; \
    _Pragma("unroll") for (int bj = 0; bj < 2; ++bj) _Pragma("unroll") for (int n = 0; n < 2; ++n) { const int ct = bj * 128 + wc * 32 + n * 16 + fq * 4; const f32x4 v = acc[ai][bj][m][n]; __VA_ARGS__ } }

struct EpiWin {
    bf16_t* UX; bf16_t* QKV;
    __device__ __forceinline__ void operator()(const f32x4 (&acc)[2][2][4][2], int gb, int pm, int pn, int wr, int wc, int fr, int fq) const {
        if (pn < 2) {
            bf16_t* base = UX + ((size_t)(pn * 16 + wc * 2) * 512 + (pm >> 4) * 128 + (pm & 15) * 8 + wr * 2) * 640 + fr * 16 + fq * 4;
#pragma unroll
            for (int ai = 0; ai < 2; ++ai)
#pragma unroll
                for (int m = 0; m < 4; ++m) { bf16_t* rp = base + (ai * 4 + (m >> 1)) * 640 + (m & 1) * 256;
#pragma unroll
                    for (int bj = 0; bj < 2; ++bj)
#pragma unroll
                        for (int n = 0; n < 2; ++n) { const f32x4 v = acc[ai][bj][m][n]; u32x2 w; w.x = pk2(v[0], v[1]); w.y = pk2(v[2], v[3]);
                            *(u32x2*)(rp + (size_t)(bj * 8 + n) * (512 * 640)) = w; }
                    asm volatile("" ::: "memory"); }
        } else { bf16_t* base = QKV + (size_t)((pn - 2) >> 1) * ((size_t)MTOK * 512) + (pn & 1) * 256 + (size_t)(pm * 256 + wr * 64 + fr) * 512 + wc * 32 + fq * 4;
#pragma unroll
            for (int ai = 0; ai < 2; ++ai)
#pragma unroll
                for (int m = 0; m < 4; ++m) { bf16_t* rp = base + (size_t)(ai * 128 + m * 16) * 512;
#pragma unroll
                    for (int bj = 0; bj < 2; ++bj)
#pragma unroll
                        for (int n = 0; n < 2; ++n) { const f32x4 v = acc[ai][bj][m][n]; u32x2 w; w.x = pk2(v[0], v[1]); w.y = pk2(v[2], v[3]);
                            *(u32x2*)(rp + bj * 128 + n * 16) = w; }
                    asm volatile("" ::: "memory"); }
        }
    }
};
struct EpiS5Z {
    float* Z;
    __device__ __forceinline__ void operator()(const f32x4 (&acc)[2][2][4][2], int gb, int pm, int pn, int wr, int wc, int fr, int fq) const {
        EPI_LOOP({ if (bj == 0) *(f32x4*)(Z + ((size_t)gb * 512 + row) * 128 + ct) = v; })
    }
};
struct EpiS5Y {
    const bf16_t* UX; bf16_t* YG; const float* dsk;
    __device__ __forceinline__ void operator()(const f32x4 (&acc)[2][2][4][2], int gb, int pm, int pn, int wr, int wc, int fr, int fq) const {
        EPI_LOOP({ const int col = pn * 256 + ct, t = col >> 4, h = col & 15, bb = row >> 7, cc = row & 127;
            const u32x2 uu = *(const u32x2*)(UX + ((size_t)gb * 512 + row) * 640 + col); const f32x4 dd = *(const f32x4*)(dsk + gb * 16 + h);
            u32x2 w; w.x = pk2(gelu_tanh(v[0] + dd[0] * bflo(uu.x)), gelu_tanh(v[1] + dd[1] * bfhi(uu.x))); w.y = pk2(gelu_tanh(v[2] + dd[2] * bflo(uu.y)), gelu_tanh(v[3] + dd[3] * bfhi(uu.y)));
            *(u32x2*)(YG + ((size_t)bb * SEQ + cc * 32 + t) * 512 + gb * 16 + h) = w; })
    }
};
struct PreS5Y {
    const float* Z; bf16_t* UX; const float* lam_re; const float* lam_im; const float* log_dt;
    __device__ __forceinline__ void operator()(int gb, int pm, int pn) const {
        const int tid = threadIdx.x;
        if (tid < 128) { const int pp = tid & 63, bb = 2 * pm + (tid >> 6);
            const float lr = lam_re[gb * 64 + pp], li = lam_im[gb * 64 + pp], dt = expf(log_dt[gb]);
            const float mag = expf(lr * dt * 32.f), ar = mag * cosf(li * dt * 32.f), ai = mag * sinf(li * dt * 32.f);
            const float* zp = Z + ((size_t)gb * 512 + bb * 128) * 128 + pp; bf16_t* xp = UX + ((size_t)gb * 512 + bb * 128) * 640 + 512 + pp;
            float xr = 0.f, xi = 0.f;
            for (int c0 = 0; c0 < 128; c0 += 16) { float zr[16], zi[16];
#pragma unroll
                for (int i = 0; i < 16; ++i) { zr[i] = zp[(size_t)(c0 + i) * 128]; zi[i] = zp[(size_t)(c0 + i) * 128 + 64]; }
#pragma unroll
                for (int i = 0; i < 16; ++i) { xp[(size_t)(c0 + i) * 640] = (bf16_t)f2bf(xr); xp[(size_t)(c0 + i) * 640 + 64] = (bf16_t)f2bf(xi);
                    const float nr = ar * xr - ai * xi + zr[i], ni = ar * xi + ai * xr + zi[i]; xr = nr; xi = ni; } } }
        __threadfence();
        asm volatile("s_waitcnt vmcnt(0)" ::: "memory");
        __syncthreads();
    }
};
struct EpiGlu {
    const bf16_t* YG; bf16_t* CAT;
    __device__ __forceinline__ void operator()(const f32x4 (&acc)[2][2][4][2], int gb, int pm, int pn, int wr, int wc, int fr, int fq) const {
        EPI_LOOP({ const int col = pn * 256 + ct; const u32x2 y = *(const u32x2*)(YG + (size_t)row * 512 + col);
            u32x2 w; w.x = pk2(bflo(y.x) * sigmoidf_(v[0]), bfhi(y.x) * sigmoidf_(v[1])); w.y = pk2(bflo(y.y) * sigmoidf_(v[2]), bfhi(y.y) * sigmoidf_(v[3]));
            *(u32x2*)(CAT + (size_t)row * 1024 + col) = w; })
    }
};
struct EpiRes {
    const float* res; float* out; const float* gate;
    __device__ __forceinline__ void operator()(const f32x4 (&acc)[2][2][4][2], int gb, int pm, int pn, int wr, int wc, int fr, int fq) const {
        const float* gatep = gate + (size_t)(pm >> 4) * 6144;
        EPI_LOOP({ const int col = pn * 256 + ct; const f32x4 g = *(const f32x4*)(gatep + col); const f32x4 r = *(const f32x4*)(res + (size_t)row * 1024 + col);
            *(f32x4*)(out + (size_t)row * 1024 + col) = r + g * v; })
    }
};
struct EpiSwiglu {
    bf16_t* HID;
    __device__ __forceinline__ void operator()(const f32x4 (&acc)[2][2][4][2], int gb, int pm, int pn, int wr, int wc, int fr, int fq) const {
#pragma unroll
        for (int ai = 0; ai < 2; ++ai)
#pragma unroll
            for (int m = 0; m < 4; ++m) { const int row = pm * 256 + ai * 128 + wr * 64 + m * 16 + fr;
#pragma unroll
                for (int n = 0; n < 2; ++n) { const f32x4 g = acc[ai][0][m][n], u = acc[ai][1][m][n]; float o[4];
#pragma unroll
                    for (int j = 0; j < 4; ++j) o[j] = g[j] * sigmoidf_(g[j]) * u[j];
                    u32x2 w; w.x = pk2(o[0], o[1]); w.y = pk2(o[2], o[3]);
                    *(u32x2*)(HID + (size_t)row * FF + pn * 128 + wc * 32 + n * 16 + fq * 4) = w; } }
    }
};
struct EpiG1 {
    bf16_t* RKV; bf16_t* L1;
    __device__ __forceinline__ void operator()(const f32x4 (&acc)[2][2][4][2], int gb, int pm, int pn, int wr, int wc, int fr, int fq) const {
        if (pn < 12) { bf16_t* base = RKV + (size_t)(pn >> 2) * ((size_t)MTOK * 1024) + (pn & 3) * 256;
            EPI_LOOP({ u32x2 w; w.x = pk2(v[0], v[1]); w.y = pk2(v[2], v[3]); *(u32x2*)(base + (size_t)row * 1024 + ct) = w; }) }
        else { EPI_LOOP({ float o[4];
                _Pragma("unroll") for (int j = 0; j < 4; ++j) o[j] = (bj == 1) ? sigmoidf_(v[j]) : ((wc < 2) ? tanhf(v[j]) : v[j]);
                u32x2 w; w.x = pk2(o[0], o[1]); w.y = pk2(o[2], o[3]); *(u32x2*)(L1 + (size_t)row * 256 + ct) = w; }) }
    }
};
struct EpiL2 {
    _Float16* DEC; bf16_t* AA; bf16_t* G; const float* w0; const float* a0;
    __device__ __forceinline__ void operator()(const f32x4 (&acc)[2][2][4][2], int gb, int pm, int pn, int wr, int wc, int fr, int fq) const {
        const int sel = pn >> 2, cb = (pn & 3) * 256;
        if (sel == 0) { EPI_LOOP({ const int col = cb + ct; const f32x4 w0v = *(const f32x4*)(w0 + col);
                _Pragma("unroll") for (int j = 0; j < 4; ++j) { const float z = w0v[j] + v[j]; const float sp = fmaxf(-z, 0.f) + log1pf(expf(-fabsf(z))); const float e = expf(-sp - 0.5f);
                    DEC[(size_t)row * 1024 + col + j] = (_Float16)(-expm1f(-e)); } }) }
        else if (sel == 1) { EPI_LOOP({ const int col = cb + ct; const f32x4 a0v = *(const f32x4*)(a0 + col);
                u32x2 w; w.x = pk2(sigmoidf_(a0v[0] + v[0]), sigmoidf_(a0v[1] + v[1])); w.y = pk2(sigmoidf_(a0v[2] + v[2]), sigmoidf_(a0v[3] + v[3]));
                *(u32x2*)(AA + (size_t)row * 1024 + col) = w; }) }
        else { EPI_LOOP({ const int col = cb + ct; u32x2 w; w.x = pk2(v[0], v[1]); w.y = pk2(v[2], v[3]); *(u32x2*)(G + (size_t)row * 1024 + col) = w; }) }
    }
};

__device__ __forceinline__ void s5_gen(const Params& p, bf16_t* BtY, bf16_t* BtZ, float* lds, int bid, int nb) {
    float* PWr = lds; float* PWi = lds + 33 * 64; float* BBr = lds + 66 * 64; float* BBi = BBr + 1024; float* Cr = BBi + 1024; float* Ci = Cr + 1024; float* Kt = Ci + 1024;
    const int tid = threadIdx.x;
    for (int unit = bid; unit < 256; unit += nb) {
        const int g = unit >> 3, part = unit & 7;
        __syncthreads();
        if (tid < 64) { const int pp = tid; const float lr = p.in[11][g * 64 + pp], li = p.in[12][g * 64 + pp], dt = expf(p.in[13][g]);
            for (int tau = 0; tau <= 32; ++tau) { const float mag = expf(lr * dt * (float)tau), ang = li * dt * (float)tau; PWr[tau * 64 + pp] = mag * cosf(ang); PWi[tau * 64 + pp] = mag * sinf(ang); }
            const float ar = PWr[64 + pp], ai = PWi[64 + pp], den = lr * lr + li * li, nr = ar - 1.f;
            const float qr = (nr * lr + ai * li) / den, qi = (ai * lr - nr * li) / den;
            for (int h = 0; h < 16; ++h) { const float br = p.in[14][(size_t)(g * 64 + pp) * 16 + h], bi = p.in[15][(size_t)(g * 64 + pp) * 16 + h]; BBr[pp * 16 + h] = qr * br - qi * bi; BBi[pp * 16 + h] = qr * bi + qi * br; } }
        for (int i = tid; i < 1024; i += NTHR) { Cr[i] = p.in[16][(size_t)g * 1024 + i]; Ci[i] = p.in[17][(size_t)g * 1024 + i]; }
        __syncthreads();
        for (int e = tid; e < 8192; e += NTHR) { const int tau = e >> 8, h = (e >> 4) & 15, h2 = e & 15; float acc = 0.f;
            for (int pp = 0; pp < 64; ++pp) { const float cr = Cr[h * 64 + pp], ci = Ci[h * 64 + pp], wr = PWr[tau * 64 + pp], wi = PWi[tau * 64 + pp];
                const float er = cr * wr - ci * wi, ei = cr * wi + ci * wr; acc += er * BBr[pp * 16 + h2] - ei * BBi[pp * 16 + h2]; }
            Kt[e] = acc; }
        __syncthreads();
        for (int ci_ = tid; ci_ < 5120; ci_ += NTHR) { const int nrow = part * 64 + ci_ / 80, kc = (ci_ % 80) * 8, t = nrow >> 4, h = nrow & 15; float v[8];
#pragma unroll
            for (int i = 0; i < 8; ++i) { const int k = kc + i;
                if (k < 512) { const int sidx = k >> 4, h2 = k & 15; v[i] = (sidx <= t) ? Kt[(t - sidx) * 256 + h * 16 + h2] : 0.f; }
                else { const int jj = k - 512, pp = jj & 63; const float cr = Cr[h * 64 + pp], ci = Ci[h * 64 + pp], wr = PWr[(t + 1) * 64 + pp], wi = PWi[(t + 1) * 64 + pp];
                    v[i] = (jj >> 6) ? -(cr * wi + ci * wr) : (cr * wr - ci * wi); } }
            *(u32x4*)(BtY + ((size_t)g * 512 + nrow) * 640 + kc) = (u32x4){pk2(v[0], v[1]), pk2(v[2], v[3]), pk2(v[4], v[5]), pk2(v[6], v[7])}; }
        for (int ci_ = tid; ci_ < 1024; ci_ += NTHR) { const int n = part * 16 + (ci_ >> 6), kc = (ci_ & 63) * 8, pp = n & 63, im = n >> 6; float v[8];
#pragma unroll
            for (int i = 0; i < 8; ++i) { const int k = kc + i, sidx = k >> 4, h2 = k & 15, tau = 31 - sidx; const float wr = PWr[tau * 64 + pp], wi = PWi[tau * 64 + pp], br = BBr[pp * 16 + h2], bi = BBi[pp * 16 + h2];
                v[i] = im ? (wr * bi + wi * br) : (wr * br - wi * bi); }
            *(u32x4*)(BtZ + ((size_t)g * 256 + n) * 512 + kc) = (u32x4){pk2(v[0], v[1]), pk2(v[2], v[3]), pk2(v[4], v[5]), pk2(v[6], v[7])}; }
    }
    __syncthreads();
}

template <int MODE>
__device__ __forceinline__ void tr_job(const float* src, int K, int N, bf16_t* dst, int ldd, int row_off, int koff, const float* scale, float* lds, int bid, int nb) {
    const int tk = K / 64, tn = N / 64, tid = threadIdx.x;
    for (int t = bid; t < tk * tn; t += nb) {
        const int k0 = (t / tn) * 64, n0 = (t % tn) * 64;
        { const int r = tid >> 3, c = (tid & 7) * 8; const float* p = src + (size_t)(k0 + r) * N + n0 + c;
          const float4 a = *(const float4*)p, b = *(const float4*)(p + 4); const float s = scale ? scale[k0 + r] : 1.f;
          float* l = lds + r * 65 + c; l[0] = a.x * s; l[1] = a.y * s; l[2] = a.z * s; l[3] = a.w * s; l[4] = b.x * s; l[5] = b.y * s; l[6] = b.z * s; l[7] = b.w * s; }
        __syncthreads();
        { const int nl = tid >> 3, kc = (tid & 7) * 8; float v[8];
#pragma unroll
          for (int i = 0; i < 8; ++i) v[i] = lds[(kc + i) * 65 + nl];
          int n = n0 + nl; int rowi = n;
          if (MODE == 1) rowi = (n >> 7) * 256 + (n & 127);
          if (MODE == 2) rowi = (n >> 7) * 256 + 128 + (n & 127);
          u32x4 w; w.x = pk2(v[0], v[1]); w.y = pk2(v[2], v[3]); w.z = pk2(v[4], v[5]); w.w = pk2(v[6], v[7]);
          *(u32x4*)(dst + (size_t)(row_off + rowi) * ldd + koff + k0 + kc) = w; }
        __syncthreads();
    }
}

__device__ __forceinline__ void prep_phase(const Params& p, float* lds, int bid, int nb) {
    unsigned char* ws = p.ws;
    s5_gen(p, (bf16_t*)(ws + OFF_BTY), (bf16_t*)(ws + OFF_BTZ), lds, bid, nb);
    tr_job<0>(p.in[10], 1024, 2048, (bf16_t*)(ws + OFF_WIN), 1024, 0, 0, nullptr, lds, bid, nb);
    tr_job<0>(p.in[19], 512, 512, (bf16_t*)(ws + OFF_WGLU), 512, 0, 0, nullptr, lds, bid, nb);
    tr_job<0>(p.in[27], 1024, 1024, (bf16_t*)(ws + OFF_WOUT), 1024, 0, 0, nullptr, lds, bid, nb);
    for (int l = 0; l < 2; ++l) {
        bf16_t* gu = (bf16_t*)(ws + (l ? OFF_WGU1 : OFF_WGU0)); bf16_t* dn = (bf16_t*)(ws + (l ? OFF_WDN1 : OFF_WDN0));
        tr_job<1>(p.in[7] + (size_t)l * 1024 * FF, 1024, FF, gu, 1024, 0, 0, nullptr, lds, bid, nb);
        tr_job<2>(p.in[8] + (size_t)l * 1024 * FF, 1024, FF, gu, 1024, 0, 0, nullptr, lds, bid, nb);
        tr_job<0>(p.in[9] + (size_t)l * FF * 1024, FF, 1024, dn, FF, 0, 0, nullptr, lds, bid, nb);
    }
    bf16_t* g1 = (bf16_t*)(ws + OFF_WG1); const float* mu = p.in[28];
    tr_job<0>(p.in[29], 1024, 1024, g1, 2048, 0, 0, nullptr, lds, bid, nb);      tr_job<0>(p.in[29], 1024, 1024, g1, 2048, 0, 1024, mu + 0 * 1024, lds, bid, nb);
    tr_job<0>(p.in[30], 1024, 1024, g1, 2048, 1024, 0, nullptr, lds, bid, nb);   tr_job<0>(p.in[30], 1024, 1024, g1, 2048, 1024, 1024, mu + 2 * 1024, lds, bid, nb);
    tr_job<0>(p.in[31], 1024, 1024, g1, 2048, 2048, 0, nullptr, lds, bid, nb);   tr_job<0>(p.in[31], 1024, 1024, g1, 2048, 2048, 1024, mu + 3 * 1024, lds, bid, nb);
    tr_job<0>(p.in[34], 1024, 64, g1, 2048, 3072, 0, nullptr, lds, bid, nb);     tr_job<0>(p.in[34], 1024, 64, g1, 2048, 3072, 1024, mu + 1 * 1024, lds, bid, nb);
    tr_job<0>(p.in[37], 1024, 64, g1, 2048, 3136, 0, nullptr, lds, bid, nb);     tr_job<0>(p.in[37], 1024, 64, g1, 2048, 3136, 1024, mu + 4 * 1024, lds, bid, nb);
    tr_job<0>(p.in[39], 1024, 128, g1, 2048, 3200, 0, nullptr, lds, bid, nb);    tr_job<0>(p.in[39], 1024, 128, g1, 2048, 3200, 1024, mu + 5 * 1024, lds, bid, nb);
    bf16_t* l2 = (bf16_t*)(ws + OFF_WL2);
    tr_job<0>(p.in[35], 64, 1024, l2, 256, 0, 0, nullptr, lds, bid, nb);
    tr_job<0>(p.in[38], 64, 1024, l2, 256, 1024, 64, nullptr, lds, bid, nb);
    tr_job<0>(p.in[40], 128, 1024, l2, 256, 2048, 128, nullptr, lds, bid, nb);
    for (int i = bid * NTHR + threadIdx.x; i < 3072 * 32; i += nb * NTHR) { const int n = i >> 5, kc = (i & 31) * 8; const int sel = n >> 10;
        const bool used = (sel == 0) ? (kc < 64) : (sel == 1) ? (kc >= 64 && kc < 128) : (kc >= 128);
        if (!used) *(u32x4*)(l2 + (size_t)n * 256 + kc) = (u32x4){0u, 0u, 0u, 0u}; }
    tr_job<0>(p.in[32], 1024, 1024, (bf16_t*)(ws + OFF_WO), 1024, 0, 0, nullptr, lds, bid, nb);
    {   const float* c = p.in[1]; const float* wada = p.in[3]; const float* bada = p.in[4]; float* mod = (float*)(ws + OFF_MOD);
        float* cact = lds;
        float* red = lds + 4096;
        for (int i = threadIdx.x; i < 4096; i += NTHR) { const float x = c[i]; cact[i] = x / (1.f + expf(-x)); }
        __syncthreads();
        const int col = threadIdx.x & 63, kg = threadIdx.x >> 6;
        for (int ch = bid; ch < 192; ch += nb) {
            const int l = ch / 96, n0 = (ch % 96) * 64;
            const float* wp = wada + (size_t)l * 1024 * 6144 + n0 + col;
            float a0 = 0.f, a1 = 0.f, a2 = 0.f, a3 = 0.f;
            for (int k = kg * 128; k < kg * 128 + 128; ++k) { const float w = wp[(size_t)k * 6144]; a0 += cact[k] * w; a1 += cact[1024 + k] * w; a2 += cact[2048 + k] * w; a3 += cact[3072 + k] * w; }
            red[(kg * 4 + 0) * 64 + col] = a0; red[(kg * 4 + 1) * 64 + col] = a1; red[(kg * 4 + 2) * 64 + col] = a2; red[(kg * 4 + 3) * 64 + col] = a3;
            __syncthreads();
            if (threadIdx.x < 256) { const int b = threadIdx.x >> 6; float s = 0.f;
#pragma unroll
                for (int g = 0; g < 8; ++g) s += red[(g * 4 + b) * 64 + col];
                mod[(size_t)(l * 4 + b) * 6144 + n0 + col] = s + bada[l * 6144 + n0 + col]; }
            __syncthreads();
        }
    }
}

template <bool RW>
__device__ __forceinline__ void norm_phase(const float* x, const float* g, const float* modl, int shift_off, int scale_off, bf16_t* out, int bid, int nb) {
    const int wave = threadIdx.x >> 6, lane = threadIdx.x & 63;
    for (int row = bid * 8 + wave; row < MTOK; row += nb * 8) {
        const int b = row >> 12; const float* xr = x + (size_t)row * 1024; const float* md = modl + (size_t)b * 6144;
        f32x4 v[4], vp[4]; float ss = 0.f, ssp = 0.f; const bool hasp = RW && ((row & 4095) != 0);
#pragma unroll
        for (int i = 0; i < 4; ++i) { v[i] = *(const f32x4*)(xr + i * 256 + lane * 4); ss += v[i][0] * v[i][0] + v[i][1] * v[i][1] + v[i][2] * v[i][2] + v[i][3] * v[i][3];
            if (RW) { vp[i] = hasp ? *(const f32x4*)(xr - 1024 + i * 256 + lane * 4) : (f32x4){0.f, 0.f, 0.f, 0.f}; ssp += vp[i][0] * vp[i][0] + vp[i][1] * vp[i][1] + vp[i][2] * vp[i][2] + vp[i][3] * vp[i][3]; } }
        ss = wave_sum(ss); const float rstd = rsqrtf(ss * (1.f / 1024.f) + 1e-6f);
        float rstdp = 0.f; if (RW) { ssp = wave_sum(ssp); rstdp = rsqrtf(ssp * (1.f / 1024.f) + 1e-6f); }
#pragma unroll
        for (int i = 0; i < 4; ++i) { const int c = i * 256 + lane * 4; const f32x4 gg = *(const f32x4*)(g + c), sc = *(const f32x4*)(md + scale_off + c), sh = *(const f32x4*)(md + shift_off + c);
            f32x4 h;
#pragma unroll
            for (int j = 0; j < 4; ++j) h[j] = v[i][j] * rstd * gg[j] * (1.f + sc[j]) + sh[j];
            u32x2 w; w.x = pk2(h[0], h[1]); w.y = pk2(h[2], h[3]);
            if (!RW) *(u32x2*)(out + (size_t)row * 1024 + c) = w;
            else { *(u32x2*)(out + (size_t)row * 2048 + c) = w; f32x4 d;
#pragma unroll
                for (int j = 0; j < 4; ++j) { const float hp = hasp ? (vp[i][j] * rstdp * gg[j] * (1.f + sc[j]) + sh[j]) : 0.f; d[j] = hp - h[j]; }
                u32x2 w2; w2.x = pk2(d[0], d[1]); w2.y = pk2(d[2], d[3]); *(u32x2*)(out + (size_t)row * 2048 + 1024 + c) = w2; } }
    }
}

__device__ __forceinline__ void qknorm_phase(bf16_t* Q, bf16_t* Kb, const int* pos, const float* qn, const float* kn, int bid, int nb) {
    const int wave = threadIdx.x >> 6, lane = threadIdx.x & 63, l16 = lane & 15, d0 = l16 * 4;
    float invf[4];
#pragma unroll
    for (int j = 0; j < 4; ++j) invf[j] = powf(500000.f, -(float)((l16 & 1) * 4 + j) / 8.f);
    const f32x4 qw = *(const f32x4*)(qn + d0), kw = *(const f32x4*)(kn + d0);
    for (int tok = bid * 8 + wave; tok < MTOK; tok += nb * 8) {
        const float ps = (float)pos[tok];
        float cs[4], sn[4];
#pragma unroll
        for (int j = 0; j < 4; ++j) { const float ang = ps * invf[j]; cs[j] = cosf(ang); sn[j] = sinf(ang); }
#pragma unroll
        for (int bsel = 0; bsel < 2; ++bsel) { bf16_t* buf = bsel ? Kb : Q; const f32x4 w = bsel ? kw : qw;
#pragma unroll
            for (int it = 0; it < 2; ++it) { const int vec = it * 4 + (lane >> 4); bf16_t* ptr = buf + (size_t)tok * 512 + vec * 64 + d0;
                const u32x2 raw = *(const u32x2*)ptr; float y[4] = {bflo(raw.x), bfhi(raw.x), bflo(raw.y), bfhi(raw.y)};
                float ss = y[0] * y[0] + y[1] * y[1] + y[2] * y[2] + y[3] * y[3];
                ss += __shfl_xor(ss, 1); ss += __shfl_xor(ss, 2); ss += __shfl_xor(ss, 4); ss += __shfl_xor(ss, 8);
                const float rstd = rsqrtf(ss * (1.f / 64.f) + 1e-6f);
#pragma unroll
                for (int j = 0; j < 4; ++j) y[j] = y[j] * rstd * w[j];
                float pr[4];
#pragma unroll
                for (int j = 0; j < 4; ++j) pr[j] = __shfl_xor(y[j], 2);
                if (l16 < 2) {
#pragma unroll
                    for (int j = 0; j < 4; ++j) y[j] = y[j] * cs[j] - pr[j] * sn[j]; }
                else if (l16 < 4) {
#pragma unroll
                    for (int j = 0; j < 4; ++j) y[j] = y[j] * cs[j] + pr[j] * sn[j]; }
                if (!bsel) {
#pragma unroll
                    for (int j = 0; j < 4; ++j) y[j] *= 0.125f * 1.4426950408889634f; }
                u32x2 o; o.x = pk2(y[0], y[1]); o.y = pk2(y[2], y[3]); *(u32x2*)ptr = o; } }
    }
}

__device__ __forceinline__ void vtrans_phase(const bf16_t* V, bf16_t* Vt, bf16_t* lds, int bid, int nb) {
    const int tid = threadIdx.x;
    for (int unit = bid; unit < 1024; unit += nb) {
        const int head = unit & 3, ch = unit >> 2; const int b = ch >> 6, t0 = (ch & 63) * 64;
#pragma unroll
        for (int i = 0; i < 2; ++i) { const int idx = tid + i * 512, t = idx >> 4, cc = (idx & 15) * 8;
            const u32x4 w = *(const u32x4*)(V + ((size_t)b * SEQ + t0 + t) * 512 + head * 128 + cc);
            unsigned* d = (unsigned*)(lds + t * 130 + cc); d[0] = w.x; d[1] = w.y; d[2] = w.z; d[3] = w.w; }
        __syncthreads();
        { const int e = tid >> 2, tc = (tid & 3) * 16; unsigned o[8];
#pragma unroll
          for (int i = 0; i < 8; ++i) o[i] = (unsigned)lds[(tc + 2 * i) * 130 + e] | ((unsigned)lds[(tc + 2 * i + 1) * 130 + e] << 16);
          u32x4* dst = (u32x4*)(Vt + ((size_t)(b * 4 + head) * 128 + e) * SEQ + t0 + tc);
          dst[0] = (u32x4){o[0], o[1], o[2], o[3]}; dst[1] = (u32x4){o[4], o[5], o[6], o[7]}; }
        __syncthreads();
    }
}

typedef float f32x16 __attribute__((ext_vector_type(16)));
__device__ __forceinline__ void attn_phase(const bf16_t* Q, const bf16_t* Kb, const bf16_t* Vt, bf16_t* OC, LAS unsigned char* lds, int bid, int nb) {
    const int tid = threadIdx.x, wave = __builtin_amdgcn_readfirstlane(tid >> 6), lane = tid & 63, c = wave >> 2, wq = wave & 3, l32 = lane & 31, hh = lane >> 5;
    constexpr int KROW = 272, VROW = 72, KBUF = 32 * KROW, VBUF = 128 * VROW, VOFF = 2 * KBUF;
    const int lkey = tid >> 4, lkc = tid & 15, lve = tid >> 2, lvc = tid & 3;
    for (int unit = bid; unit < 256; unit += nb) {
        const int b = unit & 3, head = (unit >> 2) & 3, pr = unit >> 4;
        const bf16_t* kg = Kb + ((size_t)b * SEQ + lkey) * 512 + head * 128 + lkc * 8;
        const bf16_t* vg = Vt + ((size_t)(b * 4 + head) * 128 + lve) * SEQ + lvc * 8;
        for (int half = 0; half < 2; ++half) {
            const int qb = half ? (31 - pr) : pr; const int q0 = qb * 128 + wq * 32; const int ntile = (qb + 1) * 4;
            bf16x8 qf[4];
            { const bf16_t* qp = Q + ((size_t)b * SEQ + q0 + l32) * 512 + head * 128 + c * 64 + hh * 8;
#pragma unroll
              for (int ks = 0; ks < 4; ++ks) qf[ks] = *(const bf16x8*)(qp + ks * 16); }
            f32x16 o[4];
#pragma unroll
            for (int blk = 0; blk < 4; ++blk)
#pragma unroll
                for (int r = 0; r < 16; ++r) o[blk][r] = 0.f;
            float mrow = -INFINITY, lsum = 0.f;
            u32x4 kreg = *(const u32x4*)kg, vreg = *(const u32x4*)vg;
            __syncthreads();
            { *(LAS u32x4*)(lds + lkey * KROW + lkc * 16) = kreg;
              LAS u32x2* vd = (LAS u32x2*)(lds + VOFF + lve * VROW + lvc * 16); vd[0] = (u32x2){vreg.x, vreg.y}; vd[1] = (u32x2){vreg.z, vreg.w}; }
            __syncthreads();
            for (int kt = 0; kt < ntile; ++kt) {
                const int cur = kt & 1, key0 = kt * 32;
                if (kt + 1 < ntile) { kreg = *(const u32x4*)(kg + (size_t)(key0 + 32) * 512); vreg = *(const u32x4*)(vg + key0 + 32); }
                if (key0 <= q0) {
                    LAS unsigned char* kb = lds + cur * KBUF + l32 * KROW + c * 128 + hh * 16;
                    f32x16 sacc;
#pragma unroll
                    for (int r = 0; r < 16; ++r) sacc[r] = 0.f;
#pragma unroll
                    for (int ks = 0; ks < 4; ++ks) { const bf16x8 kf = *(const LAS bf16x8*)(kb + ks * 32); sacc = __builtin_amdgcn_mfma_f32_32x32x16_bf16(kf, qf[ks], sacc, 0, 0, 0); }
                    if (key0 == q0) {
#pragma unroll
                        for (int r = 0; r < 16; ++r) { const int kl = (r & 3) + 8 * (r >> 2) + 4 * hh; if (kl > l32) sacc[r] = -INFINITY; } }
                    float tm = sacc[0];
#pragma unroll
                    for (int r = 1; r < 16; ++r) tm = fmaxf(tm, sacc[r]);
                    tm = fmaxf(tm, __shfl_xor(tm, 32));
                    const float mnew = fmaxf(mrow, tm);
                    if (__any(mnew > mrow)) { const float al = exp2f(mrow - mnew); lsum *= al;
#pragma unroll
                        for (int blk = 0; blk < 4; ++blk)
#pragma unroll
                            for (int r = 0; r < 16; ++r) o[blk][r] *= al;
                        mrow = mnew; }
                    float ps = 0.f;
#pragma unroll
                    for (int r = 0; r < 16; ++r) { sacc[r] = exp2f(sacc[r] - mrow); ps += sacc[r]; }
                    lsum += ps;
                    LAS unsigned char* vb = lds + VOFF + cur * VBUF + l32 * VROW + hh * 8;
#pragma unroll
                    for (int s2 = 0; s2 < 2; ++s2) {
                        u32x4 pw; pw.x = cvt_pk_bf16(sacc[8 * s2 + 0], sacc[8 * s2 + 1]); pw.y = cvt_pk_bf16(sacc[8 * s2 + 2], sacc[8 * s2 + 3]); pw.z = cvt_pk_bf16(sacc[8 * s2 + 4], sacc[8 * s2 + 5]); pw.w = cvt_pk_bf16(sacc[8 * s2 + 6], sacc[8 * s2 + 7]);
                        const bf16x8 pb = __builtin_bit_cast(bf16x8, pw);
#pragma unroll
                        for (int blk = 0; blk < 4; ++blk) { const u32x2 v0 = *(const LAS u32x2*)(vb + blk * 32 * VROW + s2 * 32), v1 = *(const LAS u32x2*)(vb + blk * 32 * VROW + s2 * 32 + 16);
                            const bf16x8 vf = __builtin_bit_cast(bf16x8, (u32x4){v0.x, v0.y, v1.x, v1.y});
                            o[blk] = __builtin_amdgcn_mfma_f32_32x32x16_bf16(vf, pb, o[blk], 0, 0, 0); } }
                }
                if (kt + 1 < ntile) { const int nx = cur ^ 1;
                    *(LAS u32x4*)(lds + nx * KBUF + lkey * KROW + lkc * 16) = kreg;
                    LAS u32x2* vd = (LAS u32x2*)(lds + VOFF + nx * VBUF + lve * VROW + lvc * 16); vd[0] = (u32x2){vreg.x, vreg.y}; vd[1] = (u32x2){vreg.z, vreg.w}; }
                __syncthreads();
            }
            lsum += __shfl_xor(lsum, 32);
            const float inv = 1.f / lsum;
            bf16_t* op = OC + ((size_t)b * SEQ + q0 + l32) * 1024 + (head * 2 + c) * 128 + 4 * hh;
#pragma unroll
            for (int blk = 0; blk < 4; ++blk)
#pragma unroll
                for (int g4 = 0; g4 < 4; ++g4) { u32x2 w; w.x = pk2(o[blk][g4 * 4 + 0] * inv, o[blk][g4 * 4 + 1] * inv); w.y = pk2(o[blk][g4 * 4 + 2] * inv, o[blk][g4 * 4 + 3] * inv);
                    *(u32x2*)(op + blk * 32 + g4 * 8) = w; }
        }
    }
}

__device__ __forceinline__ void attn_combine(const bf16_t* OC, bf16_t* CAT, const Params& p, int bid, int nb) {
    const int wave = threadIdx.x >> 6, lane = threadIdx.x & 63, head = lane >> 4, e0 = (lane & 15) * 8;
    float lam;
    { float s1 = 0.f, s2 = 0.f; for (int d = 0; d < 64; ++d) { s1 += p.in[22][d] * p.in[23][d]; s2 += p.in[24][d] * p.in[25][d]; } lam = expf(s1) - expf(s2) + 0.2f; }
    float sub[8];
#pragma unroll
    for (int i = 0; i < 8; ++i) sub[i] = p.in[26][e0 + i] * 0.8f;
    for (int tok = bid * 8 + wave; tok < MTOK; tok += nb * 8) {
        const u32x4 a = *(const u32x4*)(OC + (size_t)tok * 1024 + (head * 2) * 128 + e0), bb = *(const u32x4*)(OC + (size_t)tok * 1024 + (head * 2 + 1) * 128 + e0);
        float o[8] = {bflo(a.x) - lam * bflo(bb.x), bfhi(a.x) - lam * bfhi(bb.x), bflo(a.y) - lam * bflo(bb.y), bfhi(a.y) - lam * bfhi(bb.y),
                      bflo(a.z) - lam * bflo(bb.z), bfhi(a.z) - lam * bfhi(bb.z), bflo(a.w) - lam * bflo(bb.w), bfhi(a.w) - lam * bfhi(bb.w)};
        float ss = 0.f;
#pragma unroll
        for (int i = 0; i < 8; ++i) ss += o[i] * o[i];
        ss += __shfl_xor(ss, 1); ss += __shfl_xor(ss, 2); ss += __shfl_xor(ss, 4); ss += __shfl_xor(ss, 8);
        const float rstd = rsqrtf(ss * (1.f / 128.f) + 1e-6f);
        u32x4 w; w.x = pk2(o[0] * rstd * sub[0], o[1] * rstd * sub[1]); w.y = pk2(o[2] * rstd * sub[2], o[3] * rstd * sub[3]); w.z = pk2(o[4] * rstd * sub[4], o[5] * rstd * sub[5]); w.w = pk2(o[6] * rstd * sub[6], o[7] * rstd * sub[7]);
        *(u32x4*)(CAT + (size_t)tok * 1024 + 512 + head * 128 + e0) = w;
    }
}

__device__ __forceinline__ float dpp_sum16(float x) {
    x += __int_as_float(__builtin_amdgcn_update_dpp(0, __float_as_int(x), 0xB1, 0xf, 0xf, true));
    x += __int_as_float(__builtin_amdgcn_update_dpp(0, __float_as_int(x), 0x4E, 0xf, 0xf, true));
    x += __int_as_float(__builtin_amdgcn_update_dpp(0, __float_as_int(x), 0x141, 0xf, 0xf, true));
    x += __int_as_float(__builtin_amdgcn_update_dpp(0, __float_as_int(x), 0x140, 0xf, 0xf, true));
    return x;
}
__device__ __forceinline__ void rwkv_phase(const Params& p, const bf16_t* R, const bf16_t* Kk, const bf16_t* Vv, const _Float16* DEC, const bf16_t* AA, bf16_t* Y, float* lds, int bid, int nb) {
    const int tid = threadIdx.x, wave = __builtin_amdgcn_readfirstlane(tid >> 6), lane = tid & 63;
    constexpr int TCH = 16, BUFF = 5 * TCH * 64 + TCH * 16;
    float* Lout = lds + 2 * BUFF;
    for (int unit = bid; unit < 256; unit += nb) {
        const int b = unit >> 6, h = (unit >> 2) & 15, rq = unit & 3;
        __syncthreads();
        if (wave >= 4) {
            const int pw = wave - 4;
            const float kkw = p.in[41][h * 64 + lane], kaw = p.in[42][h * 64 + lane];
            float rr[4], kr[4], dr[4], ar[4], vr[4];
            auto issue = [&](int ch) {
#pragma unroll
                for (int i = 0; i < 4; ++i) { const size_t off = ((size_t)b * SEQ + ch * TCH + pw * 4 + i) * 1024 + h * 64;
                    rr[i] = bf2f(R[off + lane]); kr[i] = bf2f(Kk[off + lane]); dr[i] = 1.f - (float)DEC[off + lane]; ar[i] = bf2f(AA[off + lane]); vr[i] = bf2f(Vv[off + rq * 16 + (lane & 15)]); } };
            auto stage = [&](int buf) { float* L = lds + buf * BUFF;
#pragma unroll
                for (int i = 0; i < 4; ++i) { const int tt = pw * 4 + i; const float k = kr[i], a = ar[i];
                    float kk = k * kkw; const float n2 = wave_sum(kk * kk); kk = kk / fmaxf(sqrtf(n2), 1e-12f);
                    L[(0 * TCH + tt) * 64 + lane] = dr[i]; L[(1 * TCH + tt) * 64 + lane] = -kk; L[(2 * TCH + tt) * 64 + lane] = kk * a; L[(3 * TCH + tt) * 64 + lane] = k * (1.f + (a - 1.f) * kaw); L[(4 * TCH + tt) * 64 + lane] = rr[i];
                    if (lane < 16) L[5 * TCH * 64 + tt * 16 + lane] = vr[i]; } };
            issue(0); stage(0); issue(1);
            __syncthreads();
            for (int ch = 0; ch < SEQ / TCH; ++ch) {
                if (ch + 1 < SEQ / TCH) stage((ch + 1) & 1);
                if (ch + 2 < SEQ / TCH) issue(ch + 2);
                if (ch > 0) { const int i = tid - 256, tt = i >> 4, row = i & 15; Y[((size_t)b * SEQ + (ch - 1) * TCH + tt) * 1024 + h * 64 + rq * 16 + row] = (bf16_t)f2bf(Lout[((ch - 1) & 1) * (TCH * 16) + i]); }
                __syncthreads();
            }
            { const int ch = SEQ / TCH; const int i = tid - 256, tt = i >> 4, row = i & 15; Y[((size_t)b * SEQ + (ch - 1) * TCH + tt) * 1024 + h * 64 + rq * 16 + row] = (bf16_t)f2bf(Lout[((ch - 1) & 1) * (TCH * 16) + i]); }
        } else {
            const int j = lane & 15, rowl = wave * 4 + (lane >> 4);
            float S0 = 0.f, S1 = 0.f, S2 = 0.f, S3 = 0.f;
            __syncthreads();
            for (int ch = 0; ch < SEQ / TCH; ++ch) {
                const float* L = lds + (ch & 1) * BUFF; float* Lo = Lout + (ch & 1) * (TCH * 16);
#pragma unroll
                for (int tt = 0; tt < TCH; ++tt) {
                    const f32x4 w4 = *(const f32x4*)(L + (0 * TCH + tt) * 64 + j * 4), a4 = *(const f32x4*)(L + (1 * TCH + tt) * 64 + j * 4), b4 = *(const f32x4*)(L + (2 * TCH + tt) * 64 + j * 4),
                                k4 = *(const f32x4*)(L + (3 * TCH + tt) * 64 + j * 4), r4 = *(const f32x4*)(L + (4 * TCH + tt) * 64 + j * 4);
                    const float vv = L[5 * TCH * 64 + tt * 16 + rowl];
                    const float sa = dpp_sum16(S0 * a4[0] + S1 * a4[1] + S2 * a4[2] + S3 * a4[3]);
                    S0 = S0 * w4[0] + (sa * b4[0] + vv * k4[0]); S1 = S1 * w4[1] + (sa * b4[1] + vv * k4[1]); S2 = S2 * w4[2] + (sa * b4[2] + vv * k4[2]); S3 = S3 * w4[3] + (sa * b4[3] + vv * k4[3]);
                    const float y = dpp_sum16(S0 * r4[0] + S1 * r4[1] + S2 * r4[2] + S3 * r4[3]);
                    if (j == 0) Lo[tt * 16 + rowl] = y;
                }
                __syncthreads();
            }
        }
    }
}

__device__ __forceinline__ void rwkv_post(const Params& p, bf16_t* R, const bf16_t* Kk, const bf16_t* Vv, const bf16_t* AA, const bf16_t* G, const bf16_t* Y, int bid, int nb) {
    const int wave = threadIdx.x >> 6, lane = threadIdx.x & 63;
    for (int it = bid * 8 + wave; it < MTOK * 16; it += nb * 8) {
        const int h = it & 15; const size_t off = (size_t)(it >> 4) * 1024 + h * 64 + lane;
        const float y = bf2f(Y[off]), r = bf2f(R[off]), k = bf2f(Kk[off]), v = bf2f(Vv[off]), a = bf2f(AA[off]), g = bf2f(G[off]);
        const float mean = wave_sum(y) * (1.f / 64.f); const float d = y - mean; const float var = wave_sum(d * d) * (1.f / 64.f);
        const float k2 = k * (1.f + (a - 1.f) * p.in[42][h * 64 + lane]);
        const float sb = wave_sum(r * k2 * p.in[43][h * 64 + lane]);
        const float yn = d * rsqrtf(var + 64e-5f) * p.in[44][h * 64 + lane] + p.in[45][h * 64 + lane] + sb * v;
        R[off] = (bf16_t)f2bf(yn * g);
    }
}

__global__ void __launch_bounds__(NTHR) fwd_kernel(Params p) {
    extern __shared__ __attribute__((aligned(16))) unsigned char lds_raw[];
    LAS unsigned char* lds = (LAS unsigned char*)lds_raw;
    float* ldsf = (float*)lds_raw;
    const int bid = blockIdx.x, nb = gridDim.x;
    unsigned char* ws = p.ws;
    float* mod = (float*)(ws + OFF_MOD);
    const bool multi = (p.ph_hi - p.ph_lo) > 1;
#ifndef TESTPH
#define TESTPH -1
#endif
#define PH(k) if ((TESTPH < 0 || TESTPH == (k)) && p.ph_lo <= (k) && (k) < p.ph_hi)
#define SYNC(k) if (multi && (k) + 1 < p.ph_hi) { cg::this_grid().sync(); }
    PH(0) { prep_phase(p, ldsf, bid, nb); SYNC(0) }
    PH(1) { norm_phase<false>(p.in[0], p.in[5], mod, 0, 1024, (bf16_t*)(ws + OFF_HA), bid, nb); SYNC(1) }
    PH(2) { EpiWin e{(bf16_t*)(ws + OFF_UX), (bf16_t*)(ws + OFF_QKV)}; gemm_phase(lds, (const bf16_t*)(ws + OFF_HA), (const bf16_t*)(ws + OFF_WIN), 2048, 1024, e, bid, nb); SYNC(2) }
    PH(3) { bf16_t* q = (bf16_t*)(ws + OFF_QKV); qknorm_phase(q, q + (size_t)MTOK * 512, (const int*)p.in[2], p.in[20], p.in[21], bid, nb);
            vtrans_phase(q + (size_t)MTOK * 1024, (bf16_t*)(ws + OFF_VT), (bf16_t*)lds_raw, bid, nb); SYNC(3) }
    PH(4) { EpiS5Z e{(float*)(ws + OFF_Z)}; gemm_batched(lds, (const bf16_t*)(ws + OFF_UX), 640, (size_t)512 * 640, (const bf16_t*)(ws + OFF_BTZ), (size_t)256 * 512, 2, 1, 32, 512, e, NoPre{}, bid, nb); SYNC(4) }
    PH(5) { { EpiS5Y e{(const bf16_t*)(ws + OFF_UX), (bf16_t*)(ws + OFF_YG), p.in[18]}; PreS5Y pre{(const float*)(ws + OFF_Z), (bf16_t*)(ws + OFF_UX), p.in[11], p.in[12], p.in[13]};
              gemm_batched(lds, (const bf16_t*)(ws + OFF_UX), 640, (size_t)512 * 640, (const bf16_t*)(ws + OFF_BTY), (size_t)512 * 640, 2, 2, 32, 640, e, pre, bid, nb); }
            bf16_t* q = (bf16_t*)(ws + OFF_QKV); attn_phase(q, q + (size_t)MTOK * 512, (const bf16_t*)(ws + OFF_VT), (bf16_t*)(ws + OFF_OC), lds, bid, nb); SYNC(5) }
    PH(6) { attn_combine((const bf16_t*)(ws + OFF_OC), (bf16_t*)(ws + OFF_CAT), p, bid, nb);
            EpiGlu e{(const bf16_t*)(ws + OFF_YG), (bf16_t*)(ws + OFF_CAT)}; gemm_phase(lds, (const bf16_t*)(ws + OFF_YG), (const bf16_t*)(ws + OFF_WGLU), 512, 512, e, bid, nb); SYNC(6) }
    PH(7) { EpiRes e{p.in[0], p.out, mod + 2048}; gemm_phase(lds, (const bf16_t*)(ws + OFF_CAT), (const bf16_t*)(ws + OFF_WOUT), 1024, 1024, e, bid, nb); SYNC(7) }
    PH(8) { norm_phase<false>(p.out, p.in[6], mod, 3072, 4096, (bf16_t*)(ws + OFF_HA), bid, nb); SYNC(8) }
    PH(9) { EpiSwiglu e{(bf16_t*)(ws + OFF_HID)}; gemm_phase(lds, (const bf16_t*)(ws + OFF_HA), (const bf16_t*)(ws + OFF_WGU0), 5632, 1024, e, bid, nb); SYNC(9) }
    PH(10) { EpiRes e{p.out, p.out, mod + 5120}; gemm_phase(lds, (const bf16_t*)(ws + OFF_HID), (const bf16_t*)(ws + OFF_WDN0), 1024, FF, e, bid, nb); SYNC(10) }
    const float* mod1 = mod + 4 * 6144;
    PH(11) { norm_phase<true>(p.out, p.in[5] + 1024, mod1, 0, 1024, (bf16_t*)(ws + OFF_HD), bid, nb); SYNC(11) }
    PH(12) { EpiG1 e{(bf16_t*)(ws + OFF_RKV), (bf16_t*)(ws + OFF_L1)}; gemm_phase(lds, (const bf16_t*)(ws + OFF_HD), (const bf16_t*)(ws + OFF_WG1), 3328, 2048, e, bid, nb); SYNC(12) }
    PH(13) { EpiL2 e{(_Float16*)(ws + OFF_DEC), (bf16_t*)(ws + OFF_AA), (bf16_t*)(ws + OFF_G), p.in[33], p.in[36]}; gemm_phase(lds, (const bf16_t*)(ws + OFF_L1), (const bf16_t*)(ws + OFF_WL2), 3072, 256, e, bid, nb); SYNC(13) }
    PH(14) { const bf16_t* r = (const bf16_t*)(ws + OFF_RKV); rwkv_phase(p, r, r + (size_t)MTOK * 1024, r + (size_t)MTOK * 2048, (const _Float16*)(ws + OFF_DEC), (const bf16_t*)(ws + OFF_AA), (bf16_t*)(ws + OFF_Y), ldsf, bid, nb); SYNC(14) }
    PH(15) { bf16_t* r = (bf16_t*)(ws + OFF_RKV); rwkv_post(p, r, r + (size_t)MTOK * 1024, r + (size_t)MTOK * 2048, (const bf16_t*)(ws + OFF_AA), (const bf16_t*)(ws + OFF_G), (const bf16_t*)(ws + OFF_Y), bid, nb); SYNC(15) }
    PH(16) { EpiRes e{p.out, p.out, mod1 + 2048}; gemm_phase(lds, (const bf16_t*)(ws + OFF_RKV), (const bf16_t*)(ws + OFF_WO), 1024, 1024, e, bid, nb); SYNC(16) }
    PH(17) { norm_phase<false>(p.out, p.in[6] + 1024, mod1, 3072, 4096, (bf16_t*)(ws + OFF_HA), bid, nb); SYNC(17) }
    PH(18) { EpiSwiglu e{(bf16_t*)(ws + OFF_HID)}; gemm_phase(lds, (const bf16_t*)(ws + OFF_HA), (const bf16_t*)(ws + OFF_WGU1), 5632, 1024, e, bid, nb); SYNC(18) }
    PH(19) { EpiRes e{p.out, p.out, mod1 + 5120}; gemm_phase(lds, (const bf16_t*)(ws + OFF_HID), (const bf16_t*)(ws + OFF_WDN1), 1024, FF, e, bid, nb); }
}

constexpr int NPHASE = 20;
#ifndef ONE_LAUNCH
#define ONE_LAUNCH 1
#endif

extern "C" void kernel_launch(void* const* d_in, const int* in_sizes, int n_in, void* d_out, int out_size, void* d_ws, size_t ws_size, hipStream_t stream) {
    static int grid = 0;
    if (grid == 0) {
        if (n_in != 46 || ws_size < WS_NEED) { fprintf(stderr, "kernel_launch: unexpected n_in %d / ws_size %zu (need %zu)\n", n_in, ws_size, (size_t)WS_NEED); grid = -1; return; }
        if (hipFuncSetAttribute((const void*)fwd_kernel, hipFuncAttributeMaxDynamicSharedMemorySize, LDS_BYTES) != hipSuccess) { fprintf(stderr, "hipFuncSetAttribute failed\n"); grid = -1; return; }
        int dev = 0, cus = 0, per_cu = 0;
        (void)hipGetDevice(&dev); (void)hipDeviceGetAttribute(&cus, hipDeviceAttributeMultiprocessorCount, dev);
        (void)hipOccupancyMaxActiveBlocksPerMultiprocessor(&per_cu, (const void*)fwd_kernel, NTHR, LDS_BYTES);
        if (per_cu < 1) per_cu = 1;
        grid = cus;
    }
    if (grid < 0) return;
    Params p{};
    for (int i = 0; i < 46; ++i) p.in[i] = (const float*)d_in[i];
    p.out = (float*)d_out; p.ws = (unsigned char*)d_ws;
#if ONE_LAUNCH
    p.ph_lo = 0; p.ph_hi = NPHASE;
    void* args[] = {&p};
    hipError_t e = hipLaunchCooperativeKernel((const void*)fwd_kernel, dim3(grid), dim3(NTHR), args, LDS_BYTES, stream);
    if (e != hipSuccess) fprintf(stderr, "cooperative launch failed: %s (grid %d)\n", hipGetErrorString(e), grid);
#else
    for (int ph = 0; ph < NPHASE; ++ph) { p.ph_lo = ph; p.ph_hi = ph + 1; hipLaunchKernelGGL(fwd_kernel, dim3(grid), dim3(NTHR), LDS_BYTES, stream, p); }
#endif
}
```

```cpp
#include <hip/hip_runtime.h>
#include <hip/hip_cooperative_groups.h>
#include <cstdio>
#include <cstdint>
namespace cg = cooperative_groups;

#define LAS __attribute__((address_space(3)))
typedef unsigned short bf16_t;
typedef short bf16x8 __attribute__((ext_vector_type(8)));
typedef float f32x4 __attribute__((ext_vector_type(4)));
typedef unsigned u32x2 __attribute__((ext_vector_type(2)));
typedef unsigned u32x4 __attribute__((ext_vector_type(4)));

constexpr int MTOK = 16384, DM = 1024, SEQ = 4096, FF = 2816;
constexpr int NTHR = 512;
constexpr int LDS_BYTES = 131072;
constexpr size_t MiB = 1048576;
constexpr size_t OFF_WIN = 0;
constexpr size_t OFF_WGLU = 4194304;
constexpr size_t OFF_WOUT = 4718592;
constexpr size_t OFF_WGU0 = 6815744;
constexpr size_t OFF_WDN0 = 18350080;
constexpr size_t OFF_WGU1 = 39321600;
constexpr size_t OFF_WDN1 = 50855936;
constexpr size_t OFF_WG1 = 24117248;
constexpr size_t OFF_WL2 = 37748736;
constexpr size_t OFF_WO = 56623104;
constexpr size_t OFF_MOD = 58720256;
constexpr size_t OFF_BAR = 58916864;
constexpr size_t ACT = 57 * MiB;
constexpr size_t OFF_HA = ACT;
constexpr size_t OFF_UX = ACT + 32 * MiB;
constexpr size_t OFF_Z = ACT + 52 * MiB;
constexpr size_t OFF_BTZ = ACT + 112 * MiB;
constexpr size_t OFF_BTY = ACT + 176 * MiB;
constexpr size_t OFF_QKV = ACT + 64 * MiB;
constexpr size_t OFF_CAT = ACT + 112 * MiB;
constexpr size_t OFF_YG = ACT + 144 * MiB;
constexpr size_t OFF_VT = ACT + 160 * MiB;
constexpr size_t OFF_OC = ACT;
constexpr size_t OFF_HID = ACT + 32 * MiB;
constexpr size_t OFF_HD = ACT;
constexpr size_t OFF_RKV = ACT + 64 * MiB;
constexpr size_t OFF_G = ACT + 160 * MiB;
constexpr size_t OFF_Y = 0;
constexpr size_t OFF_L1 = 0;
constexpr size_t OFF_DEC = ACT;
constexpr size_t OFF_AA = ACT + 32 * MiB;
constexpr size_t WS_NEED = ACT + 196 * MiB;

struct Params {
    const float* in[46];
    float* out;
    unsigned char* ws;
    int ph_lo, ph_hi;
};

__device__ __forceinline__ unsigned f2bf(float f) { unsigned u = __float_as_uint(f); return (u + 0x7fffu + ((u >> 16) & 1u)) >> 16; }
__device__ __forceinline__ float bf2f(unsigned h) { return __uint_as_float(h << 16); }
__device__ __forceinline__ unsigned cvt_pk_bf16(float lo, float hi) { unsigned r; asm("v_cvt_pk_bf16_f32 %0, %1, %2" : "=v"(r) : "v"(lo), "v"(hi)); return r; }
__device__ __forceinline__ unsigned pk2(float lo, float hi) { return cvt_pk_bf16(lo, hi); }
__device__ __forceinline__ float bflo(unsigned w) { return __uint_as_float(w << 16); }
__device__ __forceinline__ float bfhi(unsigned w) { return __uint_as_float(w & 0xffff0000u); }
__device__ __forceinline__ float wave_sum(float v) {
#pragma unroll
    for (int o = 32; o > 0; o >>= 1) v += __shfl_xor(v, o);
    return v;
}
__device__ __forceinline__ float sigmoidf_(float x) { return 1.f / (1.f + __expf(-x)); }
#define LWAIT() asm volatile("s_waitcnt lgkmcnt(0)" ::: "memory")
__device__ __forceinline__ float gelu_tanh(float x) { const float t = tanhf(0.7978845608028654f * (x + 0.044715f * x * x * x)); return 0.5f * x * (1.f + t); }

constexpr int HTB = 128 * 64 * 2;
__device__ __forceinline__ int lds_byte(int r, int c) { int st = (r >> 4) * 2 + (c >> 5), rr = r & 15, cc = c & 31, ob = rr * 64 + cc * 2; return st * 1024 + (ob ^ (((ob >> 9) & 1) << 5)); }
__device__ __forceinline__ void stage_rc(int b, int& R, int& C) { int st = b / 1024, sb = b % 1024, swz = sb ^ (((sb >> 9) & 1) << 5); R = (st >> 1) * 16 + swz / 64; C = (st & 1) * 32 + (swz % 64) / 2; }

struct NoPre { __device__ __forceinline__ void operator()(int, int, int) const {} };
template <class Epi, class Pre>
__device__ __forceinline__ void gemm_batched(LAS unsigned char* lds, const bf16_t* A, int lda, size_t strideA, const bf16_t* Bt, size_t strideB, int nMt, int nNt, int nbatch, int K, const Epi& E, const Pre& PRE, int bid, int nb) {
    const int tid = threadIdx.x, wid = __builtin_amdgcn_readfirstlane(tid >> 6), lane = tid & 63, wr = wid >> 2, wc = wid & 3, fr = lane & 15, fq = lane >> 4;
    unsigned voffA[2], voffB[2];
#pragma unroll
    for (int i = 0; i < 2; ++i) { int R, C; stage_rc(tid * 16 + i * 8192, R, C); voffA[i] = (unsigned)(R * lda + C) * 2u; voffB[i] = (unsigned)(R * K + C) * 2u; }
    const int aoff = lds_byte(wr * 64 + fr, fq * 8), boff = lds_byte(wc * 32 + fr, fq * 8);
    const unsigned ldsw = (unsigned)wid * 1024u;
    const size_t kstep = 128, hstepA = (size_t)128 * lda * 2, hstepB = (size_t)128 * K * 2;
    const int nt = K / 64;
    const int ntiles = nMt * nNt * nbatch;
#define G_SA(b, h) (((b) * 2 + (h)) * HTB)
#define G_SB(b, h) ((4 + (b) * 2 + (h)) * HTB)
#define G_STAGEX(bufoff, gptr, vo) do { _Pragma("unroll") for (int _i = 0; _i < 2; ++_i) \
        __builtin_amdgcn_global_load_lds((const unsigned*)((gptr) + vo[_i]), (LAS unsigned*)(lds + (bufoff) + ldsw + _i * 8192), 16, 0, 0); } while (0)
#define G_STA(bufoff, gptr) G_STAGEX(bufoff, gptr, voffA)
#define G_STB(bufoff, gptr) G_STAGEX(bufoff, gptr, voffB)
#define G_LDA(dst, b, h) do { _Pragma("unroll") for (int m = 0; m < 4; ++m) _Pragma("unroll") for (int k = 0; k < 2; ++k) dst[m][k] = *(const LAS bf16x8*)(lds + G_SA(b, h) + aoff + m * 2048 + k * 1024); } while (0)
#define G_LDB(dst, b, h) do { _Pragma("unroll") for (int n = 0; n < 2; ++n) _Pragma("unroll") for (int k = 0; k < 2; ++k) dst[n][k] = *(const LAS bf16x8*)(lds + G_SB(b, h) + boff + n * 2048 + k * 1024); } while (0)
#define G_MMA(ai, bj, At, Bx) do { __builtin_amdgcn_s_setprio(1); _Pragma("unroll") for (int m = 0; m < 4; ++m) _Pragma("unroll") for (int n = 0; n < 2; ++n) _Pragma("unroll") for (int k = 0; k < 2; ++k) \
        acc[ai][bj][m][n] = __builtin_amdgcn_mfma_f32_16x16x32_bf16(Bx[n][k], At[m][k], acc[ai][bj][m][n], 0, 0, 0); __builtin_amdgcn_s_setprio(0); } while (0)
#define G_WV(n) asm volatile("s_waitcnt vmcnt(" #n ")" ::: "memory")
#define G_WL(n) asm volatile("s_waitcnt lgkmcnt(" #n ")" ::: "memory")
#define G_BAR __builtin_amdgcn_s_barrier()
#define G_SCHED __builtin_amdgcn_sched_barrier(0)
    for (int tile = bid; tile < ntiles; tile += nb) {
        const int pm = tile % nMt, tq = tile / nMt, pn = tq % nNt, gb = tq / nNt;
        PRE(gb, pm, pn);
        const char* cA = (const char*)(A + (size_t)gb * strideA) + (size_t)pm * 256 * lda * 2;
        const char* cB = (const char*)(Bt + (size_t)gb * strideB) + (size_t)pn * 256 * K * 2;
        f32x4 acc[2][2][4][2];
#pragma unroll
        for (int a = 0; a < 2; ++a)
#pragma unroll
            for (int b = 0; b < 2; ++b)
#pragma unroll
                for (int m = 0; m < 4; ++m)
#pragma unroll
                    for (int n = 0; n < 2; ++n) acc[a][b][m][n] = (f32x4){0.f, 0.f, 0.f, 0.f};
        bf16x8 At[4][2], B0[2][2], B1[2][2];
        G_WV(0);
        G_STB(G_SB(0, 0), cB); G_STA(G_SA(0, 0), cA); G_STB(G_SB(0, 1), cB + hstepB); G_STA(G_SA(0, 1), cA + hstepA);
        if (wr == 1) G_BAR;
        G_WV(4); G_BAR;
        G_STB(G_SB(1, 0), cB + kstep); G_STA(G_SA(1, 0), cA + kstep); G_STB(G_SB(1, 1), cB + hstepB + kstep);
        G_WV(6); G_BAR;
        for (int t = 0; t < nt - 2; t += 2) {
            const char* a1 = cA + (size_t)(t + 1) * kstep; const char* a2 = cA + (size_t)(t + 2) * kstep; const char* a3 = a2 + kstep;
            const char* b2 = cB + (size_t)(t + 2) * kstep; const char* b3 = b2 + kstep;
            G_LDB(B0, 0, 0); G_SCHED; G_LDA(At, 0, 0); G_STA(G_SA(1, 1), a1 + hstepA);
            G_WL(8); G_BAR; G_WL(0); G_MMA(0, 0, At, B0); G_BAR; G_SCHED;
            G_LDB(B1, 0, 1); G_STB(G_SB(0, 0), b2);
            G_BAR; G_WL(0); G_MMA(0, 1, At, B1); G_BAR;
            G_LDA(At, 0, 1); G_STA(G_SA(0, 0), a2);
            G_BAR; G_WL(0); G_MMA(1, 0, At, B0); G_BAR; G_SCHED;
            G_STB(G_SB(0, 1), b2 + hstepB);
            G_WV(6); G_BAR; G_MMA(1, 1, At, B1); G_BAR;
            G_LDB(B0, 1, 0); G_SCHED; G_LDA(At, 1, 0); G_STA(G_SA(0, 1), a2 + hstepA);
            G_WL(8); G_BAR; G_WL(0); G_MMA(0, 0, At, B0); G_BAR; G_SCHED;
            G_LDB(B1, 1, 1); G_STB(G_SB(1, 0), b3);
            G_BAR; G_WL(0); G_MMA(0, 1, At, B1); G_BAR;
            G_LDA(At, 1, 1); G_STA(G_SA(1, 0), a3);
            G_BAR; G_WL(0); G_MMA(1, 0, At, B0); G_BAR; G_SCHED;
            G_STB(G_SB(1, 1), b3 + hstepB);
            G_WV(6); G_BAR; G_MMA(1, 1, At, B1); G_BAR;
        }
        {
            const char* a1 = cA + (size_t)(nt - 1) * kstep;
            G_LDB(B0, 0, 0); G_LDA(At, 0, 0); G_STA(G_SA(1, 1), a1 + hstepA);
            G_BAR; G_WL(0); G_MMA(0, 0, At, B0); G_BAR;
            G_LDB(B1, 0, 1); G_BAR; G_WL(0); G_MMA(0, 1, At, B1); G_BAR;
            G_LDA(At, 0, 1); G_WV(4); G_BAR; G_WL(0); G_MMA(1, 0, At, B0); G_MMA(1, 1, At, B1); G_BAR;
        }
        {
            G_LDB(B0, 1, 0); G_LDA(At, 1, 0); G_WV(2); G_BAR; G_WL(0); G_MMA(0, 0, At, B0); G_BAR;
            G_LDB(B1, 1, 1); G_WV(0); G_BAR; G_WL(0); G_MMA(0, 1, At, B1); G_BAR;
            G_LDA(At, 1, 1); G_BAR; G_WL(0); G_MMA(1, 0, At, B0); G_MMA(1, 1, At, B1); G_BAR;
        }
        if (wr == 0) G_BAR;
        E(acc, gb, pm, pn, wr, wc, fr, fq);
    }
    G_WV(0);
    __syncthreads();
}

template <class Epi>
__device__ __forceinline__ void gemm_phase(LAS unsigned char* lds, const bf16_t* A, const bf16_t* Bt, int N, int K, const Epi& E, int bid, int nb) {
    gemm_batched(lds, A, K, 0, Bt, 0, 64, N / 256, 1, K, E, NoPre{}, bid, nb);
}

#define EPI_LOOP(...) \
    _Pragma("unroll") for (int ai = 0; ai < 2; ++ai) _Pragma("unroll") for (int m = 0; m < 4; ++m) { asm volatile("" ::: "memory"); const int row = pm * 256 + ai * 128 + wr * 64 + m * 16 + fr; \
    _Pragma("unroll") for (int bj = 0; bj < 2; ++bj) _Pragma("unroll") for (int n = 0; n < 2; ++n) { const int ct = bj * 128 + wc * 32 + n * 16 + fq * 4; const f32x4 v = acc[ai][bj][m][n]; __VA_ARGS__ } }

struct EpiWin {
    bf16_t* UX; bf16_t* QKV;
    __device__ __forceinline__ void operator()(const f32x4 (&acc)[2][2][4][2], int gb, int pm, int pn, int wr, int wc, int fr, int fq) const {
        if (pn < 2) {
            bf16_t* base = UX + ((size_t)(pn * 16 + wc * 2) * 512 + (pm >> 4) * 128 + (pm & 15) * 8 + wr * 2) * 640 + fr * 16 + fq * 4;
#pragma unroll
            for (int ai = 0; ai < 2; ++ai)
#pragma unroll
                for (int m = 0; m < 4; ++m) { bf16_t* rp = base + (ai * 4 + (m >> 1)) * 640 + (m & 1) * 256;
#pragma unroll
                    for (int bj = 0; bj < 2; ++bj)
#pragma unroll
                        for (int n = 0; n < 2; ++n) { const f32x4 v = acc[ai][bj][m][n]; u32x2 w; w.x = pk2(v[0], v[1]); w.y = pk2(v[2], v[3]);
                            *(u32x2*)(rp + (size_t)(bj * 8 + n) * (512 * 640)) = w; }
                    asm volatile("" ::: "memory"); }
        } else { bf16_t* base = QKV + (size_t)((pn - 2) >> 1) * ((size_t)MTOK * 512) + (pn & 1) * 256 + (size_t)(pm * 256 + wr * 64 + fr) * 512 + wc * 32 + fq * 4;
#pragma unroll
            for (int ai = 0; ai < 2; ++ai)
#pragma unroll
                for (int m = 0; m < 4; ++m) { bf16_t* rp = base + (size_t)(ai * 128 + m * 16) * 512;
#pragma unroll
                    for (int bj = 0; bj < 2; ++bj)
#pragma unroll
                        for (int n = 0; n < 2; ++n) { const f32x4 v = acc[ai][bj][m][n]; u32x2 w; w.x = pk2(v[0], v[1]); w.y = pk2(v[2], v[3]);
                            *(u32x2*)(rp + bj * 128 + n * 16) = w; }
                    asm volatile("" ::: "memory"); }
        }
    }
};
struct EpiS5Z {
    float* Z;
    __device__ __forceinline__ void operator()(const f32x4 (&acc)[2][2][4][2], int gb, int pm, int pn, int wr, int wc, int fr, int fq) const {
        EPI_LOOP({ if (bj == 0) *(f32x4*)(Z + ((size_t)gb * 512 + row) * 128 + ct) = v; })
    }
};
struct EpiS5Y {
    const bf16_t* UX; bf16_t* YG; const float* dsk;
    __device__ __forceinline__ void operator()(const f32x4 (&acc)[2][2][4][2], int gb, int pm, int pn, int wr, int wc, int fr, int fq) const {
        EPI_LOOP({ const int col = pn * 256 + ct, t = col >> 4, h = col & 15, bb = row >> 7, cc = row & 127;
            const u32x2 uu = *(const u32x2*)(UX + ((size_t)gb * 512 + row) * 640 + col); const f32x4 dd = *(const f32x4*)(dsk + gb * 16 + h);
            u32x2 w; w.x = pk2(gelu_tanh(v[0] + dd[0] * bflo(uu.x)), gelu_tanh(v[1] + dd[1] * bfhi(uu.x))); w.y = pk2(gelu_tanh(v[2] + dd[2] * bflo(uu.y)), gelu_tanh(v[3] + dd[3] * bfhi(uu.y)));
            *(u32x2*)(YG + ((size_t)bb * SEQ + cc * 32 + t) * 512 + gb * 16 + h) = w; })
    }
};
struct PreS5Y {
    const float* Z; bf16_t* UX; const float* lam_re; const float* lam_im; const float* log_dt;
    __device__ __forceinline__ void operator()(int gb, int pm, int pn) const {
        const int tid = threadIdx.x;
        if (tid < 128) { const int pp = tid & 63, bb = 2 * pm + (tid >> 6);
            const float lr = lam_re[gb * 64 + pp], li = lam_im[gb * 64 + pp], dt = expf(log_dt[gb]);
            const float mag = expf(lr * dt * 32.f), ar = mag * cosf(li * dt * 32.f), ai = mag * sinf(li * dt * 32.f);
            const float* zp = Z + ((size_t)gb * 512 + bb * 128) * 128 + pp; bf16_t* xp = UX + ((size_t)gb * 512 + bb * 128) * 640 + 512 + pp;
            float xr = 0.f, xi = 0.f;
            for (int c0 = 0; c0 < 128; c0 += 16) { float zr[16], zi[16];
#pragma unroll
                for (int i = 0; i < 16; ++i) { zr[i] = zp[(size_t)(c0 + i) * 128]; zi[i] = zp[(size_t)(c0 + i) * 128 + 64]; }
#pragma unroll
                for (int i = 0; i < 16; ++i) { xp[(size_t)(c0 + i) * 640] = (bf16_t)f2bf(xr); xp[(size_t)(c0 + i) * 640 + 64] = (bf16_t)f2bf(xi);
                    const float nr = ar * xr - ai * xi + zr[i], ni = ar * xi + ai * xr + zi[i]; xr = nr; xi = ni; } } }
        __threadfence();
        asm volatile("s_waitcnt vmcnt(0)" ::: "memory");
        __syncthreads();
    }
};
struct EpiGlu {
    const bf16_t* YG; bf16_t* CAT;
    __device__ __forceinline__ void operator()(const f32x4 (&acc)[2][2][4][2], int gb, int pm, int pn, int wr, int wc, int fr, int fq) const {
        EPI_LOOP({ const int col = pn * 256 + ct; const u32x2 y = *(const u32x2*)(YG + (size_t)row * 512 + col);
            u32x2 w; w.x = pk2(bflo(y.x) * sigmoidf_(v[0]), bfhi(y.x) * sigmoidf_(v[1])); w.y = pk2(bflo(y.y) * sigmoidf_(v[2]), bfhi(y.y) * sigmoidf_(v[3]));
            *(u32x2*)(CAT + (size_t)row * 1024 + col) = w; })
    }
};
struct EpiRes {
    const float* res; float* out; const float* gate;
    __device__ __forceinline__ void operator()(const f32x4 (&acc)[2][2][4][2], int gb, int pm, int pn, int wr, int wc, int fr, int fq) const {
        const float* gatep = gate + (size_t)(pm >> 4) * 6144;
        EPI_LOOP({ const int col = pn * 256 + ct; const f32x4 g = *(const f32x4*)(gatep + col); const f32x4 r = *(const f32x4*)(res + (size_t)row * 1024 + col);
            *(f32x4*)(out + (size_t)row * 1024 + col) = r + g * v; })
    }
};
struct EpiSwiglu {
    bf16_t* HID;
    __device__ __forceinline__ void operator()(const f32x4 (&acc)[2][2][4][2], int gb, int pm, int pn, int wr, int wc, int fr, int fq) const {
#pragma unroll
        for (int ai = 0; ai < 2; ++ai)
#pragma unroll
            for (int m = 0; m < 4; ++m) { const int row = pm * 256 + ai * 128 + wr * 64 + m * 16 + fr;
#pragma unroll
                for (int n = 0; n < 2; ++n) { const f32x4 g = acc[ai][0][m][n], u = acc[ai][1][m][n]; float o[4];
#pragma unroll
                    for (int j = 0; j < 4; ++j) o[j] = g[j] * sigmoidf_(g[j]) * u[j];
                    u32x2 w; w.x = pk2(o[0], o[1]); w.y = pk2(o[2], o[3]);
                    *(u32x2*)(HID + (size_t)row * FF + pn * 128 + wc * 32 + n * 16 + fq * 4) = w; } }
    }
};
struct EpiG1 {
    bf16_t* RKV; bf16_t* L1;
    __device__ __forceinline__ void operator()(const f32x4 (&acc)[2][2][4][2], int gb, int pm, int pn, int wr, int wc, int fr, int fq) const {
        if (pn < 12) { bf16_t* base = RKV + (size_t)(pn >> 2) * ((size_t)MTOK * 1024) + (pn & 3) * 256;
            EPI_LOOP({ u32x2 w; w.x = pk2(v[0], v[1]); w.y = pk2(v[2], v[3]); *(u32x2*)(base + (size_t)row * 1024 + ct) = w; }) }
        else { EPI_LOOP({ float o[4];
                _Pragma("unroll") for (int j = 0; j < 4; ++j) o[j] = (bj == 1) ? sigmoidf_(v[j]) : ((wc < 2) ? tanhf(v[j]) : v[j]);
                u32x2 w; w.x = pk2(o[0], o[1]); w.y = pk2(o[2], o[3]); *(u32x2*)(L1 + (size_t)row * 256 + ct) = w; }) }
    }
};
struct EpiL2 {
    _Float16* DEC; bf16_t* AA; bf16_t* G; const float* w0; const float* a0;
    __device__ __forceinline__ void operator()(const f32x4 (&acc)[2][2][4][2], int gb, int pm, int pn, int wr, int wc, int fr, int fq) const {
        const int sel = pn >> 2, cb = (pn & 3) * 256;
        if (sel == 0) { EPI_LOOP({ const int col = cb + ct; const f32x4 w0v = *(const f32x4*)(w0 + col);
                _Pragma("unroll") for (int j = 0; j < 4; ++j) { const float z = w0v[j] + v[j]; const float sp = fmaxf(-z, 0.f) + log1pf(expf(-fabsf(z))); const float e = expf(-sp - 0.5f);
                    DEC[(size_t)row * 1024 + col + j] = (_Float16)(-expm1f(-e)); } }) }
        else if (sel == 1) { EPI_LOOP({ const int col = cb + ct; const f32x4 a0v = *(const f32x4*)(a0 + col);
                u32x2 w; w.x = pk2(sigmoidf_(a0v[0] + v[0]), sigmoidf_(a0v[1] + v[1])); w.y = pk2(sigmoidf_(a0v[2] + v[2]), sigmoidf_(a0v[3] + v[3]));
                *(u32x2*)(AA + (size_t)row * 1024 + col) = w; }) }
        else { EPI_LOOP({ const int col = cb + ct; u32x2 w; w.x = pk2(v[0], v[1]); w.y = pk2(v[2], v[3]); *(u32x2*)(G + (size_t)row * 1024 + col) = w; }) }
    }
};

__device__ __forceinline__ void s5_gen(const Params& p, bf16_t* BtY, bf16_t* BtZ, float* lds, int bid, int nb) {
    float* PWr = lds; float* PWi = lds + 33 * 64; float* BBr = lds + 66 * 64; float* BBi = BBr + 1024; float* Cr = BBi + 1024; float* Ci = Cr + 1024; float* Kt = Ci + 1024;
    const int tid = threadIdx.x;
    for (int unit = bid; unit < 256; unit += nb) {
        const int g = unit >> 3, part = unit & 7;
        __syncthreads();
        if (tid < 64) { const int pp = tid; const float lr = p.in[11][g * 64 + pp], li = p.in[12][g * 64 + pp], dt = expf(p.in[13][g]);
            for (int tau = 0; tau <= 32; ++tau) { const float mag = expf(lr * dt * (float)tau), ang = li * dt * (float)tau; PWr[tau * 64 + pp] = mag * cosf(ang); PWi[tau * 64 + pp] = mag * sinf(ang); }
            const float ar = PWr[64 + pp], ai = PWi[64 + pp], den = lr * lr + li * li, nr = ar - 1.f;
            const float qr = (nr * lr + ai * li) / den, qi = (ai * lr - nr * li) / den;
            for (int h = 0; h < 16; ++h) { const float br = p.in[14][(size_t)(g * 64 + pp) * 16 + h], bi = p.in[15][(size_t)(g * 64 + pp) * 16 + h]; BBr[pp * 16 + h] = qr * br - qi * bi; BBi[pp * 16 + h] = qr * bi + qi * br; } }
        for (int i = tid; i < 1024; i += NTHR) { Cr[i] = p.in[16][(size_t)g * 1024 + i]; Ci[i] = p.in[17][(size_t)g * 1024 + i]; }
        __syncthreads();
        for (int e = tid; e < 8192; e += NTHR) { const int tau = e >> 8, h = (e >> 4) & 15, h2 = e & 15; float acc = 0.f;
            for (int pp = 0; pp < 64; ++pp) { const float cr = Cr[h * 64 + pp], ci = Ci[h * 64 + pp], wr = PWr[tau * 64 + pp], wi = PWi[tau * 64 + pp];
                const float er = cr * wr - ci * wi, ei = cr * wi + ci * wr; acc += er * BBr[pp * 16 + h2] - ei * BBi[pp * 16 + h2]; }
            Kt[e] = acc; }
        __syncthreads();
        for (int ci_ = tid; ci_ < 5120; ci_ += NTHR) { const int nrow = part * 64 + ci_ / 80, kc = (ci_ % 80) * 8, t = nrow >> 4, h = nrow & 15; float v[8];
#pragma unroll
            for (int i = 0; i < 8; ++i) { const int k = kc + i;
                if (k < 512) { const int sidx = k >> 4, h2 = k & 15; v[i] = (sidx <= t) ? Kt[(t - sidx) * 256 + h * 16 + h2] : 0.f; }
                else { const int jj = k - 512, pp = jj & 63; const float cr = Cr[h * 64 + pp], ci = Ci[h * 64 + pp], wr = PWr[(t + 1) * 64 + pp], wi = PWi[(t + 1) * 64 + pp];
                    v[i] = (jj >> 6) ? -(cr * wi + ci * wr) : (cr * wr - ci * wi); } }
            *(u32x4*)(BtY + ((size_t)g * 512 + nrow) * 640 + kc) = (u32x4){pk2(v[0], v[1]), pk2(v[2], v[3]), pk2(v[4], v[5]), pk2(v[6], v[7])}; }
        for (int ci_ = tid; ci_ < 1024; ci_ += NTHR) { const int n = part * 16 + (ci_ >> 6), kc = (ci_ & 63) * 8, pp = n & 63, im = n >> 6; float v[8];
#pragma unroll
            for (int i = 0; i < 8; ++i) { const int k = kc + i, sidx = k >> 4, h2 = k & 15, tau = 31 - sidx; const float wr = PWr[tau * 64 + pp], wi = PWi[tau * 64 + pp], br = BBr[pp * 16 + h2], bi = BBi[pp * 16 + h2];
                v[i] = im ? (wr * bi + wi * br) : (wr * br - wi * bi); }
            *(u32x4*)(BtZ + ((size_t)g * 256 + n) * 512 + kc) = (u32x4){pk2(v[0], v[1]), pk2(v[2], v[3]), pk2(v[4], v[5]), pk2(v[6], v[7])}; }
    }
    __syncthreads();
}

template <int MODE>
__device__ __forceinline__ void tr_job(const float* src, int K, int N, bf16_t* dst, int ldd, int row_off, int koff, const float* scale, float* lds, int bid, int nb) {
    const int tk = K / 64, tn = N / 64, tid = threadIdx.x;
    for (int t = bid; t < tk * tn; t += nb) {
        const int k0 = (t / tn) * 64, n0 = (t % tn) * 64;
        { const int r = tid >> 3, c = (tid & 7) * 8; const float* p = src + (size_t)(k0 + r) * N + n0 + c;
          const float4 a = *(const float4*)p, b = *(const float4*)(p + 4); const float s = scale ? scale[k0 + r] : 1.f;
          float* l = lds + r * 65 + c; l[0] = a.x * s; l[1] = a.y * s; l[2] = a.z * s; l[3] = a.w * s; l[4] = b.x * s; l[5] = b.y * s; l[6] = b.z * s; l[7] = b.w * s; }
        __syncthreads();
        { const int nl = tid >> 3, kc = (tid & 7) * 8; float v[8];
#pragma unroll
          for (int i = 0; i < 8; ++i) v[i] = lds[(kc + i) * 65 + nl];
          int n = n0 + nl; int rowi = n;
          if (MODE == 1) rowi = (n >> 7) * 256 + (n & 127);
          if (MODE == 2) rowi = (n >> 7) * 256 + 128 + (n & 127);
          u32x4 w; w.x = pk2(v[0], v[1]); w.y = pk2(v[2], v[3]); w.z = pk2(v[4], v[5]); w.w = pk2(v[6], v[7]);
          *(u32x4*)(dst + (size_t)(row_off + rowi) * ldd + koff + k0 + kc) = w; }
        __syncthreads();
    }
}

__device__ __forceinline__ void prep_phase(const Params& p, float* lds, int bid, int nb) {
    unsigned char* ws = p.ws;
    s5_gen(p, (bf16_t*)(ws + OFF_BTY), (bf16_t*)(ws + OFF_BTZ), lds, bid, nb);
    tr_job<0>(p.in[10], 1024, 2048, (bf16_t*)(ws + OFF_WIN), 1024, 0, 0, nullptr, lds, bid, nb);
    tr_job<0>(p.in[19], 512, 512, (bf16_t*)(ws + OFF_WGLU), 512, 0, 0, nullptr, lds, bid, nb);
    tr_job<0>(p.in[27], 1024, 1024, (bf16_t*)(ws + OFF_WOUT), 1024, 0, 0, nullptr, lds, bid, nb);
    for (int l = 0; l < 2; ++l) {
        bf16_t* gu = (bf16_t*)(ws + (l ? OFF_WGU1 : OFF_WGU0)); bf16_t* dn = (bf16_t*)(ws + (l ? OFF_WDN1 : OFF_WDN0));
        tr_job<1>(p.in[7] + (size_t)l * 1024 * FF, 1024, FF, gu, 1024, 0, 0, nullptr, lds, bid, nb);
        tr_job<2>(p.in[8] + (size_t)l * 1024 * FF, 1024, FF, gu, 1024, 0, 0, nullptr, lds, bid, nb);
        tr_job<0>(p.in[9] + (size_t)l * FF * 1024, FF, 1024, dn, FF, 0, 0, nullptr, lds, bid, nb);
    }
    bf16_t* g1 = (bf16_t*)(ws + OFF_WG1); const float* mu = p.in[28];
    tr_job<0>(p.in[29], 1024, 1024, g1, 2048, 0, 0, nullptr, lds, bid, nb);      tr_job<0>(p.in[29], 1024, 1024, g1, 2048, 0, 1024, mu + 0 * 1024, lds, bid, nb);
    tr_job<0>(p.in[30], 1024, 1024, g1, 2048, 1024, 0, nullptr, lds, bid, nb);   tr_job<0>(p.in[30], 1024, 1024, g1, 2048, 1024, 1024, mu + 2 * 1024, lds, bid, nb);
    tr_job<0>(p.in[31], 1024, 1024, g1, 2048, 2048, 0, nullptr, lds, bid, nb);   tr_job<0>(p.in[31], 1024, 1024, g1, 2048, 2048, 1024, mu + 3 * 1024, lds, bid, nb);
    tr_job<0>(p.in[34], 1024, 64, g1, 2048, 3072, 0, nullptr, lds, bid, nb);     tr_job<0>(p.in[34], 1024, 64, g1, 2048, 3072, 1024, mu + 1 * 1024, lds, bid, nb);
    tr_job<0>(p.in[37], 1024, 64, g1, 2048, 3136, 0, nullptr, lds, bid, nb);     tr_job<0>(p.in[37], 1024, 64, g1, 2048, 3136, 1024, mu + 4 * 1024, lds, bid, nb);
    tr_job<0>(p.in[39], 1024, 128, g1, 2048, 3200, 0, nullptr, lds, bid, nb);    tr_job<0>(p.in[39], 1024, 128, g1, 2048, 3200, 1024, mu + 5 * 1024, lds, bid, nb);
    bf16_t* l2 = (bf16_t*)(ws + OFF_WL2);
    tr_job<0>(p.in[35], 64, 1024, l2, 256, 0, 0, nullptr, lds, bid, nb);
    tr_job<0>(p.in[38], 64, 1024, l2, 256, 1024, 64, nullptr, lds, bid, nb);
    tr_job<0>(p.in[40], 128, 1024, l2, 256, 2048, 128, nullptr, lds, bid, nb);
    for (int i = bid * NTHR + threadIdx.x; i < 3072 * 32; i += nb * NTHR) { const int n = i >> 5, kc = (i & 31) * 8; const int sel = n >> 10;
        const bool used = (sel == 0) ? (kc < 64) : (sel == 1) ? (kc >= 64 && kc < 128) : (kc >= 128);
        if (!used) *(u32x4*)(l2 + (size_t)n * 256 + kc) = (u32x4){0u, 0u, 0u, 0u}; }
    tr_job<0>(p.in[32], 1024, 1024, (bf16_t*)(ws + OFF_WO), 1024, 0, 0, nullptr, lds, bid, nb);
    {   const float* c = p.in[1]; const float* wada = p.in[3]; const float* bada = p.in[4]; float* mod = (float*)(ws + OFF_MOD);
        float* cact = lds;
        float* red = lds + 4096;
        for (int i = threadIdx.x; i < 4096; i += NTHR) { const float x = c[i]; cact[i] = x / (1.f + expf(-x)); }
        __syncthreads();
        const int col = threadIdx.x & 63, kg = threadIdx.x >> 6;
        for (int ch = bid; ch < 192; ch += nb) {
            const int l = ch / 96, n0 = (ch % 96) * 64;
            const float* wp = wada + (size_t)l * 1024 * 6144 + n0 + col;
            float a0 = 0.f, a1 = 0.f, a2 = 0.f, a3 = 0.f;
            for (int k = kg * 128; k < kg * 128 + 128; ++k) { const float w = wp[(size_t)k * 6144]; a0 += cact[k] * w; a1 += cact[1024 + k] * w; a2 += cact[2048 + k] * w; a3 += cact[3072 + k] * w; }
            red[(kg * 4 + 0) * 64 + col] = a0; red[(kg * 4 + 1) * 64 + col] = a1; red[(kg * 4 + 2) * 64 + col] = a2; red[(kg * 4 + 3) * 64 + col] = a3;
            __syncthreads();
            if (threadIdx.x < 256) { const int b = threadIdx.x >> 6; float s = 0.f;
#pragma unroll
                for (int g = 0; g < 8; ++g) s += red[(g * 4 + b) * 64 + col];
                mod[(size_t)(l * 4 + b) * 6144 + n0 + col] = s + bada[l * 6144 + n0 + col]; }
            __syncthreads();
        }
    }
}

template <bool RW>
__device__ __forceinline__ void norm_phase(const float* x, const float* g, const float* modl, int shift_off, int scale_off, bf16_t* out, int bid, int nb) {
    const int wave = threadIdx.x >> 6, lane = threadIdx.x & 63;
    for (int row = bid * 8 + wave; row < MTOK; row += nb * 8) {
        const int b = row >> 12; const float* xr = x + (size_t)row * 1024; const float* md = modl + (size_t)b * 6144;
        f32x4 v[4], vp[4]; float ss = 0.f, ssp = 0.f; const bool hasp = RW && ((row & 4095) != 0);
#pragma unroll
        for (int i = 0; i < 4; ++i) { v[i] = *(const f32x4*)(xr + i * 256 + lane * 4); ss += v[i][0] * v[i][0] + v[i][1] * v[i][1] + v[i][2] * v[i][2] + v[i][3] * v[i][3];
            if (RW) { vp[i] = hasp ? *(const f32x4*)(xr - 1024 + i * 256 + lane * 4) : (f32x4){0.f, 0.f, 0.f, 0.f}; ssp += vp[i][0] * vp[i][0] + vp[i][1] * vp[i][1] + vp[i][2] * vp[i][2] + vp[i][3] * vp[i][3]; } }
        ss = wave_sum(ss); const float rstd = rsqrtf(ss * (1.f / 1024.f) + 1e-6f);
        float rstdp = 0.f; if (RW) { ssp = wave_sum(ssp); rstdp = rsqrtf(ssp * (1.f / 1024.f) + 1e-6f); }
#pragma unroll
        for (int i = 0; i < 4; ++i) { const int c = i * 256 + lane * 4; const f32x4 gg = *(const f32x4*)(g + c), sc = *(const f32x4*)(md + scale_off + c), sh = *(const f32x4*)(md + shift_off + c);
            f32x4 h;
#pragma unroll
            for (int j = 0; j < 4; ++j) h[j] = v[i][j] * rstd * gg[j] * (1.f + sc[j]) + sh[j];
            u32x2 w; w.x = pk2(h[0], h[1]); w.y = pk2(h[2], h[3]);
            if (!RW) *(u32x2*)(out + (size_t)row * 1024 + c) = w;
            else { *(u32x2*)(out + (size_t)row * 2048 + c) = w; f32x4 d;
#pragma unroll
                for (int j = 0; j < 4; ++j) { const float hp = hasp ? (vp[i][j] * rstdp * gg[j] * (1.f + sc[j]) + sh[j]) : 0.f; d[j] = hp - h[j]; }
                u32x2 w2; w2.x = pk2(d[0], d[1]); w2.y = pk2(d[2], d[3]); *(u32x2*)(out + (size_t)row * 2048 + 1024 + c) = w2; } }
    }
}

__device__ __forceinline__ void qknorm_phase(bf16_t* Q, bf16_t* Kb, const int* pos, const float* qn, const float* kn, int bid, int nb) {
    const int wave = threadIdx.x >> 6, lane = threadIdx.x & 63, l16 = lane & 15, d0 = l16 * 4;
    float invf[4];
#pragma unroll
    for (int j = 0; j < 4; ++j) invf[j] = powf(500000.f, -(float)((l16 & 1) * 4 + j) / 8.f);
    const f32x4 qw = *(const f32x4*)(qn + d0), kw = *(const f32x4*)(kn + d0);
    for (int tok = bid * 8 + wave; tok < MTOK; tok += nb * 8) {
        const float ps = (float)pos[tok];
        float cs[4], sn[4];
#pragma unroll
        for (int j = 0; j < 4; ++j) { const float ang = ps * invf[j]; cs[j] = cosf(ang); sn[j] = sinf(ang); }
#pragma unroll
        for (int bsel = 0; bsel < 2; ++bsel) { bf16_t* buf = bsel ? Kb : Q; const f32x4 w = bsel ? kw : qw;
#pragma unroll
            for (int it = 0; it < 2; ++it) { const int vec = it * 4 + (lane >> 4); bf16_t* ptr = buf + (size_t)tok * 512 + vec * 64 + d0;
                const u32x2 raw = *(const u32x2*)ptr; float y[4] = {bflo(raw.x), bfhi(raw.x), bflo(raw.y), bfhi(raw.y)};
                float ss = y[0] * y[0] + y[1] * y[1] + y[2] * y[2] + y[3] * y[3];
                ss += __shfl_xor(ss, 1); ss += __shfl_xor(ss, 2); ss += __shfl_xor(ss, 4); ss += __shfl_xor(ss, 8);
                const float rstd = rsqrtf(ss * (1.f / 64.f) + 1e-6f);
#pragma unroll
                for (int j = 0; j < 4; ++j) y[j] = y[j] * rstd * w[j];
                float pr[4];
#pragma unroll
                for (int j = 0; j < 4; ++j) pr[j] = __shfl_xor(y[j], 2);
                if (l16 < 2) {
#pragma unroll
                    for (int j = 0; j < 4; ++j) y[j] = y[j] * cs[j] - pr[j] * sn[j]; }
                else if (l16 < 4) {
#pragma unroll
                    for (int j = 0; j < 4; ++j) y[j] = y[j] * cs[j] + pr[j] * sn[j]; }
                if (!bsel) {
#pragma unroll
                    for (int j = 0; j < 4; ++j) y[j] *= 0.125f * 1.4426950408889634f; }
                u32x2 o; o.x = pk2(y[0], y[1]); o.y = pk2(y[2], y[3]); *(u32x2*)ptr = o; } }
    }
}

__device__ __forceinline__ void vtrans_phase(const bf16_t* V, bf16_t* Vt, bf16_t* lds, int bid, int nb) {
    const int tid = threadIdx.x;
    for (int unit = bid; unit < 1024; unit += nb) {
        const int head = unit & 3, ch = unit >> 2; const int b = ch >> 6, t0 = (ch & 63) * 64;
#pragma unroll
        for (int i = 0; i < 2; ++i) { const int idx = tid + i * 512, t = idx >> 4, cc = (idx & 15) * 8;
            const u32x4 w = *(const u32x4*)(V + ((size_t)b * SEQ + t0 + t) * 512 + head * 128 + cc);
            unsigned* d = (unsigned*)(lds + t * 130 + cc); d[0] = w.x; d[1] = w.y; d[2] = w.z; d[3] = w.w; }
        __syncthreads();
        { const int e = tid >> 2, tc = (tid & 3) * 16; unsigned o[8];
#pragma unroll
          for (int i = 0; i < 8; ++i) o[i] = (unsigned)lds[(tc + 2 * i) * 130 + e] | ((unsigned)lds[(tc + 2 * i + 1) * 130 + e] << 16);
          u32x4* dst = (u32x4*)(Vt + ((size_t)(b * 4 + head) * 128 + e) * SEQ + t0 + tc);
          dst[0] = (u32x4){o[0], o[1], o[2], o[3]}; dst[1] = (u32x4){o[4], o[5], o[6], o[7]}; }
        __syncthreads();
    }
}

typedef float f32x16 __attribute__((ext_vector_type(16)));
__device__ __forceinline__ void attn_phase(const bf16_t* Q, const bf16_t* Kb, const bf16_t* Vt, bf16_t* OC, LAS unsigned char* lds, int bid, int nb) {
    const int tid = threadIdx.x, wave = __builtin_amdgcn_readfirstlane(tid >> 6), lane = tid & 63, c = wave >> 2, wq = wave & 3, l32 = lane & 31, hh = lane >> 5;
    constexpr int KROW = 272, VROW = 72, KBUF = 32 * KROW, VBUF = 128 * VROW, VOFF = 2 * KBUF;
    const int lkey = tid >> 4, lkc = tid & 15, lve = tid >> 2, lvc = tid & 3;
    for (int unit = bid; unit < 256; unit += nb) {
        const int b = unit & 3, head = (unit >> 2) & 3, pr = unit >> 4;
        const bf16_t* kg = Kb + ((size_t)b * SEQ + lkey) * 512 + head * 128 + lkc * 8;
        const bf16_t* vg = Vt + ((size_t)(b * 4 + head) * 128 + lve) * SEQ + lvc * 8;
        for (int half = 0; half < 2; ++half) {
            const int qb = half ? (31 - pr) : pr; const int q0 = qb * 128 + wq * 32; const int ntile = (qb + 1) * 4;
            bf16x8 qf[4];
            { const bf16_t* qp = Q + ((size_t)b * SEQ + q0 + l32) * 512 + head * 128 + c * 64 + hh * 8;
#pragma unroll
              for (int ks = 0; ks < 4; ++ks) qf[ks] = *(const bf16x8*)(qp + ks * 16); }
            f32x16 o[4];
#pragma unroll
            for (int blk = 0; blk < 4; ++blk)
#pragma unroll
                for (int r = 0; r < 16; ++r) o[blk][r] = 0.f;
            float mrow = -INFINITY, lsum = 0.f;
            u32x4 kreg = *(const u32x4*)kg, vreg = *(const u32x4*)vg;
            __syncthreads();
            { *(LAS u32x4*)(lds + lkey * KROW + lkc * 16) = kreg;
              LAS u32x2* vd = (LAS u32x2*)(lds + VOFF + lve * VROW + lvc * 16); vd[0] = (u32x2){vreg.x, vreg.y}; vd[1] = (u32x2){vreg.z, vreg.w}; }
            __syncthreads();
            for (int kt = 0; kt < ntile; ++kt) {
                const int cur = kt & 1, key0 = kt * 32;
                if (kt + 1 < ntile) { kreg = *(const u32x4*)(kg + (size_t)(key0 + 32) * 512); vreg = *(const u32x4*)(vg + key0 + 32); }
                if (key0 <= q0) {
                    LAS unsigned char* kb = lds + cur * KBUF + l32 * KROW + c * 128 + hh * 16;
                    f32x16 sacc;
#pragma unroll
                    for (int r = 0; r < 16; ++r) sacc[r] = 0.f;
#pragma unroll
                    for (int ks = 0; ks < 4; ++ks) { const bf16x8 kf = *(const LAS bf16x8*)(kb + ks * 32); sacc = __builtin_amdgcn_mfma_f32_32x32x16_bf16(kf, qf[ks], sacc, 0, 0, 0); }
                    if (key0 == q0) {
#pragma unroll
                        for (int r = 0; r < 16; ++r) { const int kl = (r & 3) + 8 * (r >> 2) + 4 * hh; if (kl > l32) sacc[r] = -INFINITY; } }
                    float tm = sacc[0];
#pragma unroll
                    for (int r = 1; r < 16; ++r) tm = fmaxf(tm, sacc[r]);
                    tm = fmaxf(tm, __shfl_xor(tm, 32));
                    const float mnew = fmaxf(mrow, tm);
                    if (__any(mnew > mrow)) { const float al = exp2f(mrow - mnew); lsum *= al;
#pragma unroll
                        for (int blk = 0; blk < 4; ++blk)
#pragma unroll
                            for (int r = 0; r < 16; ++r) o[blk][r] *= al;
                        mrow = mnew; }
                    float ps = 0.f;
#pragma unroll
                    for (int r = 0; r < 16; ++r) { sacc[r] = exp2f(sacc[r] - mrow); ps += sacc[r]; }
                    lsum += ps;
                    LAS unsigned char* vb = lds + VOFF + cur * VBUF + l32 * VROW + hh * 8;
#pragma unroll
                    for (int s2 = 0; s2 < 2; ++s2) {
                        u32x4 pw; pw.x = cvt_pk_bf16(sacc[8 * s2 + 0], sacc[8 * s2 + 1]); pw.y = cvt_pk_bf16(sacc[8 * s2 + 2], sacc[8 * s2 + 3]); pw.z = cvt_pk_bf16(sacc[8 * s2 + 4], sacc[8 * s2 + 5]); pw.w = cvt_pk_bf16(sacc[8 * s2 + 6], sacc[8 * s2 + 7]);
                        const bf16x8 pb = __builtin_bit_cast(bf16x8, pw);
#pragma unroll
                        for (int blk = 0; blk < 4; ++blk) { const u32x2 v0 = *(const LAS u32x2*)(vb + blk * 32 * VROW + s2 * 32), v1 = *(const LAS u32x2*)(vb + blk * 32 * VROW + s2 * 32 + 16);
                            const bf16x8 vf = __builtin_bit_cast(bf16x8, (u32x4){v0.x, v0.y, v1.x, v1.y});
                            o[blk] = __builtin_amdgcn_mfma_f32_32x32x16_bf16(vf, pb, o[blk], 0, 0, 0); } }
                }
                if (kt + 1 < ntile) { const int nx = cur ^ 1;
                    *(LAS u32x4*)(lds + nx * KBUF + lkey * KROW + lkc * 16) = kreg;
                    LAS u32x2* vd = (LAS u32x2*)(lds + VOFF + nx * VBUF + lve * VROW + lvc * 16); vd[0] = (u32x2){vreg.x, vreg.y}; vd[1] = (u32x2){vreg.z, vreg.w}; }
                __syncthreads();
            }
            lsum += __shfl_xor(lsum, 32);
            const float inv = 1.f / lsum;
            bf16_t* op = OC + ((size_t)b * SEQ + q0 + l32) * 1024 + (head * 2 + c) * 128 + 4 * hh;
#pragma unroll
            for (int blk = 0; blk < 4; ++blk)
#pragma unroll
                for (int g4 = 0; g4 < 4; ++g4) { u32x2 w; w.x = pk2(o[blk][g4 * 4 + 0] * inv, o[blk][g4 * 4 + 1] * inv); w.y = pk2(o[blk][g4 * 4 + 2] * inv, o[blk][g4 * 4 + 3] * inv);
                    *(u32x2*)(op + blk * 32 + g4 * 8) = w; }
        }
    }
}

__device__ __forceinline__ void attn_combine(const bf16_t* OC, bf16_t* CAT, const Params& p, int bid, int nb) {
    const int wave = threadIdx.x >> 6, lane = threadIdx.x & 63, head = lane >> 4, e0 = (lane & 15) * 8;
    float lam;
    { float s1 = 0.f, s2 = 0.f; for (int d = 0; d < 64; ++d) { s1 += p.in[22][d] * p.in[23][d]; s2 += p.in[24][d] * p.in[25][d]; } lam = expf(s1) - expf(s2) + 0.2f; }
    float sub[8];
#pragma unroll
    for (int i = 0; i < 8; ++i) sub[i] = p.in[26][e0 + i] * 0.8f;
    for (int tok = bid * 8 + wave; tok < MTOK; tok += nb * 8) {
        const u32x4 a = *(const u32x4*)(OC + (size_t)tok * 1024 + (head * 2) * 128 + e0), bb = *(const u32x4*)(OC + (size_t)tok * 1024 + (head * 2 + 1) * 128 + e0);
        float o[8] = {bflo(a.x) - lam * bflo(bb.x), bfhi(a.x) - lam * bfhi(bb.x), bflo(a.y) - lam * bflo(bb.y), bfhi(a.y) - lam * bfhi(bb.y),
                      bflo(a.z) - lam * bflo(bb.z), bfhi(a.z) - lam * bfhi(bb.z), bflo(a.w) - lam * bflo(bb.w), bfhi(a.w) - lam * bfhi(bb.w)};
        float ss = 0.f;
#pragma unroll
        for (int i = 0; i < 8; ++i) ss += o[i] * o[i];
        ss += __shfl_xor(ss, 1); ss += __shfl_xor(ss, 2); ss += __shfl_xor(ss, 4); ss += __shfl_xor(ss, 8);
        const float rstd = rsqrtf(ss * (1.f / 128.f) + 1e-6f);
        u32x4 w; w.x = pk2(o[0] * rstd * sub[0], o[1] * rstd * sub[1]); w.y = pk2(o[2] * rstd * sub[2], o[3] * rstd * sub[3]); w.z = pk2(o[4] * rstd * sub[4], o[5] * rstd * sub[5]); w.w = pk2(o[6] * rstd * sub[6], o[7] * rstd * sub[7]);
        *(u32x4*)(CAT + (size_t)tok * 1024 + 512 + head * 128 + e0) = w;
    }
}

__device__ __forceinline__ float dpp_sum16(float x) {
    x += __int_as_float(__builtin_amdgcn_update_dpp(0, __float_as_int(x), 0xB1, 0xf, 0xf, true));
    x += __int_as_float(__builtin_amdgcn_update_dpp(0, __float_as_int(x), 0x4E, 0xf, 0xf, true));
    x += __int_as_float(__builtin_amdgcn_update_dpp(0, __float_as_int(x), 0x141, 0xf, 0xf, true));
    x += __int_as_float(__builtin_amdgcn_update_dpp(0, __float_as_int(x), 0x140, 0xf, 0xf, true));
    return x;
}
__device__ __forceinline__ void rwkv_phase(const Params& p, const bf16_t* R, const bf16_t* Kk, const bf16_t* Vv, const _Float16* DEC, const bf16_t* AA, bf16_t* Y, float* lds, int bid, int nb) {
    const int tid = threadIdx.x, wave = __builtin_amdgcn_readfirstlane(tid >> 6), lane = tid & 63;
    constexpr int TCH = 16, BUFF = 5 * TCH * 64 + TCH * 16;
    float* Lout = lds + 2 * BUFF;
    for (int unit = bid; unit < 256; unit += nb) {
        const int b = unit >> 6, h = (unit >> 2) & 15, rq = unit & 3;
        __syncthreads();
        if (wave >= 4) {
            const int pw = wave - 4;
            const float kkw = p.in[41][h * 64 + lane], kaw = p.in[42][h * 64 + lane];
            float rr[4], kr[4], dr[4], ar[4], vr[4];
            auto issue = [&](int ch) {
#pragma unroll
                for (int i = 0; i < 4; ++i) { const size_t off = ((size_t)b * SEQ + ch * TCH + pw * 4 + i) * 1024 + h * 64;
                    rr[i] = bf2f(R[off + lane]); kr[i] = bf2f(Kk[off + lane]); dr[i] = 1.f - (float)DEC[off + lane]; ar[i] = bf2f(AA[off + lane]); vr[i] = bf2f(Vv[off + rq * 16 + (lane & 15)]); } };
            auto stage = [&](int buf) { float* L = lds + buf * BUFF;
#pragma unroll
                for (int i = 0; i < 4; ++i) { const int tt = pw * 4 + i; const float k = kr[i], a = ar[i];
                    float kk = k * kkw; const float n2 = wave_sum(kk * kk); kk = kk / fmaxf(sqrtf(n2), 1e-12f);
                    L[(0 * TCH + tt) * 64 + lane] = dr[i]; L[(1 * TCH + tt) * 64 + lane] = -kk; L[(2 * TCH + tt) * 64 + lane] = kk * a; L[(3 * TCH + tt) * 64 + lane] = k * (1.f + (a - 1.f) * kaw); L[(4 * TCH + tt) * 64 + lane] = rr[i];
                    if (lane < 16) L[5 * TCH * 64 + tt * 16 + lane] = vr[i]; } };
            issue(0); stage(0); issue(1);
            __syncthreads();
            for (int ch = 0; ch < SEQ / TCH; ++ch) {
                if (ch + 1 < SEQ / TCH) stage((ch + 1) & 1);
                if (ch + 2 < SEQ / TCH) issue(ch + 2);
                if (ch > 0) { const int i = tid - 256, tt = i >> 4, row = i & 15; Y[((size_t)b * SEQ + (ch - 1) * TCH + tt) * 1024 + h * 64 + rq * 16 + row] = (bf16_t)f2bf(Lout[((ch - 1) & 1) * (TCH * 16) + i]); }
                __syncthreads();
            }
            { const int ch = SEQ / TCH; const int i = tid - 256, tt = i >> 4, row = i & 15; Y[((size_t)b * SEQ + (ch - 1) * TCH + tt) * 1024 + h * 64 + rq * 16 + row] = (bf16_t)f2bf(Lout[((ch - 1) & 1) * (TCH * 16) + i]); }
        } else {
            const int j = lane & 15, rowl = wave * 4 + (lane >> 4);
            float S0 = 0.f, S1 = 0.f, S2 = 0.f, S3 = 0.f;
            __syncthreads();
            for (int ch = 0; ch < SEQ / TCH; ++ch) {
                const float* L = lds + (ch & 1) * BUFF; float* Lo = Lout + (ch & 1) * (TCH * 16);
#pragma unroll
                for (int tt = 0; tt < TCH; ++tt) {
                    const f32x4 w4 = *(const f32x4*)(L + (0 * TCH + tt) * 64 + j * 4), a4 = *(const f32x4*)(L + (1 * TCH + tt) * 64 + j * 4), b4 = *(const f32x4*)(L + (2 * TCH + tt) * 64 + j * 4),
                                k4 = *(const f32x4*)(L + (3 * TCH + tt) * 64 + j * 4), r4 = *(const f32x4*)(L + (4 * TCH + tt) * 64 + j * 4);
                    const float vv = L[5 * TCH * 64 + tt * 16 + rowl];
                    const float sa = dpp_sum16(S0 * a4[0] + S1 * a4[1] + S2 * a4[2] + S3 * a4[3]);
                    S0 = S0 * w4[0] + (sa * b4[0] + vv * k4[0]); S1 = S1 * w4[1] + (sa * b4[1] + vv * k4[1]); S2 = S2 * w4[2] + (sa * b4[2] + vv * k4[2]); S3 = S3 * w4[3] + (sa * b4[3] + vv * k4[3]);
                    const float y = dpp_sum16(S0 * r4[0] + S1 * r4[1] + S2 * r4[2] + S3 * r4[3]);
                    if (j == 0) Lo[tt * 16 + rowl] = y;
                }
                __syncthreads();
            }
        }
    }
}

__device__ __forceinline__ void rwkv_post(const Params& p, bf16_t* R, const bf16_t* Kk, const bf16_t* Vv, const bf16_t* AA, const bf16_t* G, const bf16_t* Y, int bid, int nb) {
    const int wave = threadIdx.x >> 6, lane = threadIdx.x & 63;
    for (int it = bid * 8 + wave; it < MTOK * 16; it += nb * 8) {
        const int h = it & 15; const size_t off = (size_t)(it >> 4) * 1024 + h * 64 + lane;
        const float y = bf2f(Y[off]), r = bf2f(R[off]), k = bf2f(Kk[off]), v = bf2f(Vv[off]), a = bf2f(AA[off]), g = bf2f(G[off]);
        const float mean = wave_sum(y) * (1.f / 64.f); const float d = y - mean; const float var = wave_sum(d * d) * (1.f / 64.f);
        const float k2 = k * (1.f + (a - 1.f) * p.in[42][h * 64 + lane]);
        const float sb = wave_sum(r * k2 * p.in[43][h * 64 + lane]);
        const float yn = d * rsqrtf(var + 64e-5f) * p.in[44][h * 64 + lane] + p.in[45][h * 64 + lane] + sb * v;
        R[off] = (bf16_t)f2bf(yn * g);
    }
}

#define XB_TMO      128
#define XB_XCNT(j)  (256  + 64 * (j))
#define XB_XSUB(j)  (1280 + 64 * (j))
#define XB_XGEN(j)  (2304 + 64 * (j))
#define XB_TOP      3328
#define XB_TOPGEN   3392
#define XCD_BAR_WORDS 3456
#define XB_SPIN_CAP (1u << 18)
__device__ __forceinline__ unsigned xb_ld(unsigned* p)              { return __hip_atomic_load(p, __ATOMIC_RELAXED, __HIP_MEMORY_SCOPE_AGENT); }
__device__ __forceinline__ unsigned xb_add(unsigned* p, unsigned v) { return __hip_atomic_fetch_add(p, v, __ATOMIC_RELAXED, __HIP_MEMORY_SCOPE_AGENT); }
__device__ __forceinline__ unsigned xb_xcc_id() { return (unsigned)__builtin_amdgcn_s_getreg((3 << 11) | 20) & 0xFu; }
#define XB_SPIN(cond, bar) do { unsigned _sp = 0; while (cond) { __builtin_amdgcn_s_sleep(1); \
    if ((++_sp & 255u) == 0u) { if (xb_ld(&(bar)[XB_TMO])) break; if (_sp > XB_SPIN_CAP) { atomicAdd(&(bar)[XB_TMO], 1u); break; } } } } while (0)
struct XcdBarrier { unsigned* bar; unsigned x; volatile LAS unsigned* st; };
__device__ __forceinline__ XcdBarrier xcd_barrier_post(unsigned* bar, volatile LAS unsigned* st) {
    XcdBarrier b; b.bar = bar; b.x = xb_xcc_id(); b.st = st;
    if (threadIdx.x == 0) (void)xb_add(&bar[XB_XCNT(b.x)], 1u);
    return b;
}
__device__ __forceinline__ void xcd_barrier_complete(unsigned* bar, unsigned x, unsigned& nloc, unsigned& nx) {
    const unsigned G = gridDim.x * gridDim.y * gridDim.z;
    unsigned sum, cnt, mine, sp = 0u;
    for (;;) {
        sum = 0u; cnt = 0u; mine = 0u;
#pragma unroll
        for (unsigned j = 0; j < 16; ++j) { const unsigned c = xb_ld(&bar[XB_XCNT(j)]); sum += c; cnt += (c > 0u) ? 1u : 0u; mine = (j == x) ? c : mine; }
        if (sum == G) break;
        __builtin_amdgcn_s_sleep(1);
        if ((++sp & 255u) == 0u) { if (xb_ld(&bar[XB_TMO])) break; if (sp > XB_SPIN_CAP) { atomicAdd(&bar[XB_TMO], 1u); break; } }
    }
    nloc = mine > 0u ? mine : 1u; nx = cnt > 0u ? cnt : 1u;
}
__device__ __forceinline__ void xcd_barrier(const XcdBarrier& b) {
    asm volatile("s_waitcnt vmcnt(0)" ::: "memory");
    __syncthreads();
    if (threadIdx.x == 0) {
        unsigned* bar = b.bar;
        __builtin_amdgcn_s_waitcnt(0);
        unsigned nloc = b.st[0], nx = b.st[1];
        if (nloc == 0u) { xcd_barrier_complete(bar, b.x, nloc, nx); b.st[0] = nloc; b.st[1] = nx; }
        const unsigned old = xb_add(&bar[XB_XSUB(b.x)], 1u);
        const unsigned gen = old / nloc;
        if (old + 1u == (gen + 1u) * nloc) {
            __builtin_amdgcn_fence(__ATOMIC_RELEASE, "agent");
            asm volatile("s_waitcnt vmcnt(0)" ::: "memory");
            const unsigned og = xb_add(&bar[XB_TOP], 1u);
            const unsigned tg = og / nx;
            if (og + 1u == (tg + 1u) * nx) xb_add(&bar[XB_TOPGEN], 1u);
            else XB_SPIN(xb_ld(&bar[XB_TOPGEN]) == tg, bar);
            __builtin_amdgcn_fence(__ATOMIC_ACQUIRE, "agent");
            xb_add(&bar[XB_XGEN(b.x)], 1u);
            asm volatile("s_waitcnt vmcnt(0)" ::: "memory");
        } else {
            XB_SPIN(xb_ld(&bar[XB_XGEN(b.x)]) == gen, bar);
            __builtin_amdgcn_fence(__ATOMIC_ACQUIRE, "agent");
            asm volatile("s_waitcnt vmcnt(0)" ::: "memory");
        }
    }
    __syncthreads();
}

__global__ void __launch_bounds__(NTHR) fwd_kernel(Params p) {
    extern __shared__ __attribute__((aligned(16))) unsigned char lds_raw[];
    LAS unsigned char* lds = (LAS unsigned char*)lds_raw;
    float* ldsf = (float*)lds_raw;
    const int bid = blockIdx.x, nb = gridDim.x;
    unsigned char* ws = p.ws;
    float* mod = (float*)(ws + OFF_MOD);
    const bool multi = (p.ph_hi - p.ph_lo) > 1;
    __shared__ unsigned xb_st[4];
    if (threadIdx.x < 4) xb_st[threadIdx.x] = 0u;
    __syncthreads();
    XcdBarrier xbar; xbar.bar = (unsigned*)(ws + OFF_BAR); xbar.x = 0; xbar.st = (volatile LAS unsigned*)xb_st;
    if (multi) xbar = xcd_barrier_post((unsigned*)(ws + OFF_BAR), (volatile LAS unsigned*)xb_st);
#ifndef TESTPH
#define TESTPH -1
#endif
#ifndef REPEAT_A
#define REPEAT_A -1
#endif
#ifndef REPEAT_B
#define REPEAT_B -1
#endif
#ifndef EXTRA_SYNCS
#define EXTRA_SYNCS 0
#endif
#define PH(k) if ((TESTPH < 0 || TESTPH == (k)) && p.ph_lo <= (k) && (k) < p.ph_hi) for (int rep_ = 0; rep_ < (((k) == REPEAT_A || (k) == REPEAT_B) ? 2 : 1); ++rep_)
#define SYNC(k) if (multi && (k) + 1 < p.ph_hi) { if ((k) == 0) cg::this_grid().sync(); else xcd_barrier(xbar); }
    for (int es_ = 0; es_ < EXTRA_SYNCS; ++es_) cg::this_grid().sync();
    PH(0) { prep_phase(p, ldsf, bid, nb); SYNC(0) }
    PH(1) { norm_phase<false>(p.in[0], p.in[5], mod, 0, 1024, (bf16_t*)(ws + OFF_HA), bid, nb); SYNC(1) }
    PH(2) { EpiWin e{(bf16_t*)(ws + OFF_UX), (bf16_t*)(ws + OFF_QKV)}; gemm_phase(lds, (const bf16_t*)(ws + OFF_HA), (const bf16_t*)(ws + OFF_WIN), 2048, 1024, e, bid, nb); SYNC(2) }
    PH(3) { { EpiS5Z e{(float*)(ws + OFF_Z)}; gemm_batched(lds, (const bf16_t*)(ws + OFF_UX), 640, (size_t)512 * 640, (const bf16_t*)(ws + OFF_BTZ), (size_t)256 * 512, 2, 1, 32, 512, e, NoPre{}, bid, nb); }
            bf16_t* q = (bf16_t*)(ws + OFF_QKV); qknorm_phase(q, q + (size_t)MTOK * 512, (const int*)p.in[2], p.in[20], p.in[21], bid, nb);
            vtrans_phase(q + (size_t)MTOK * 1024, (bf16_t*)(ws + OFF_VT), (bf16_t*)lds_raw, bid, nb); SYNC(3) }
    PH(5) { { EpiS5Y e{(const bf16_t*)(ws + OFF_UX), (bf16_t*)(ws + OFF_YG), p.in[18]}; PreS5Y pre{(const float*)(ws + OFF_Z), (bf16_t*)(ws + OFF_UX), p.in[11], p.in[12], p.in[13]};
              gemm_batched(lds, (const bf16_t*)(ws + OFF_UX), 640, (size_t)512 * 640, (const bf16_t*)(ws + OFF_BTY), (size_t)512 * 640, 2, 2, 32, 640, e, pre, bid, nb); }
            bf16_t* q = (bf16_t*)(ws + OFF_QKV); attn_phase(q, q + (size_t)MTOK * 512, (const bf16_t*)(ws + OFF_VT), (bf16_t*)(ws + OFF_OC), lds, bid, nb); SYNC(5) }
    PH(6) { attn_combine((const bf16_t*)(ws + OFF_OC), (bf16_t*)(ws + OFF_CAT), p, bid, nb);
            EpiGlu e{(const bf16_t*)(ws + OFF_YG), (bf16_t*)(ws + OFF_CAT)}; gemm_phase(lds, (const bf16_t*)(ws + OFF_YG), (const bf16_t*)(ws + OFF_WGLU), 512, 512, e, bid, nb); SYNC(6) }
    PH(7) { EpiRes e{p.in[0], p.out, mod + 2048}; gemm_phase(lds, (const bf16_t*)(ws + OFF_CAT), (const bf16_t*)(ws + OFF_WOUT), 1024, 1024, e, bid, nb); SYNC(7) }
    PH(8) { norm_phase<false>(p.out, p.in[6], mod, 3072, 4096, (bf16_t*)(ws + OFF_HA), bid, nb); SYNC(8) }
    PH(9) { EpiSwiglu e{(bf16_t*)(ws + OFF_HID)}; gemm_phase(lds, (const bf16_t*)(ws + OFF_HA), (const bf16_t*)(ws + OFF_WGU0), 5632, 1024, e, bid, nb); SYNC(9) }
    PH(10) { EpiRes e{p.out, p.out, mod + 5120}; gemm_phase(lds, (const bf16_t*)(ws + OFF_HID), (const bf16_t*)(ws + OFF_WDN0), 1024, FF, e, bid, nb); SYNC(10) }
    const float* mod1 = mod + 4 * 6144;
    PH(11) { norm_phase<true>(p.out, p.in[5] + 1024, mod1, 0, 1024, (bf16_t*)(ws + OFF_HD), bid, nb); SYNC(11) }
    PH(12) { EpiG1 e{(bf16_t*)(ws + OFF_RKV), (bf16_t*)(ws + OFF_L1)}; gemm_phase(lds, (const bf16_t*)(ws + OFF_HD), (const bf16_t*)(ws + OFF_WG1), 3328, 2048, e, bid, nb); SYNC(12) }
    PH(13) { EpiL2 e{(_Float16*)(ws + OFF_DEC), (bf16_t*)(ws + OFF_AA), (bf16_t*)(ws + OFF_G), p.in[33], p.in[36]}; gemm_phase(lds, (const bf16_t*)(ws + OFF_L1), (const bf16_t*)(ws + OFF_WL2), 3072, 256, e, bid, nb); SYNC(13) }
    PH(14) { const bf16_t* r = (const bf16_t*)(ws + OFF_RKV); rwkv_phase(p, r, r + (size_t)MTOK * 1024, r + (size_t)MTOK * 2048, (const _Float16*)(ws + OFF_DEC), (const bf16_t*)(ws + OFF_AA), (bf16_t*)(ws + OFF_Y), ldsf, bid, nb); SYNC(14) }
    PH(15) { bf16_t* r = (bf16_t*)(ws + OFF_RKV); rwkv_post(p, r, r + (size_t)MTOK * 1024, r + (size_t)MTOK * 2048, (const bf16_t*)(ws + OFF_AA), (const bf16_t*)(ws + OFF_G), (const bf16_t*)(ws + OFF_Y), bid, nb); SYNC(15) }
    PH(16) { EpiRes e{p.out, p.out, mod1 + 2048}; gemm_phase(lds, (const bf16_t*)(ws + OFF_RKV), (const bf16_t*)(ws + OFF_WO), 1024, 1024, e, bid, nb); SYNC(16) }
    PH(17) { norm_phase<false>(p.out, p.in[6] + 1024, mod1, 3072, 4096, (bf16_t*)(ws + OFF_HA), bid, nb); SYNC(17) }
    PH(18) { EpiSwiglu e{(bf16_t*)(ws + OFF_HID)}; gemm_phase(lds, (const bf16_t*)(ws + OFF_HA), (const bf16_t*)(ws + OFF_WGU1), 5632, 1024, e, bid, nb); SYNC(18) }
    PH(19) { EpiRes e{p.out, p.out, mod1 + 5120}; gemm_phase(lds, (const bf16_t*)(ws + OFF_HID), (const bf16_t*)(ws + OFF_WDN1), 1024, FF, e, bid, nb); }
}

constexpr int NPHASE = 20;
#ifndef ONE_LAUNCH
#define ONE_LAUNCH 1
#endif

extern "C" void kernel_launch(void* const* d_in, const int* in_sizes, int n_in, void* d_out, int out_size, void* d_ws, size_t ws_size, hipStream_t stream) {
    static int grid = 0;
    if (grid == 0) {
        if (n_in != 46 || ws_size < WS_NEED) { fprintf(stderr, "kernel_launch: unexpected n_in %d / ws_size %zu (need %zu)\n", n_in, ws_size, (size_t)WS_NEED); grid = -1; return; }
        if (hipFuncSetAttribute((const void*)fwd_kernel, hipFuncAttributeMaxDynamicSharedMemorySize, LDS_BYTES) != hipSuccess) { fprintf(stderr, "hipFuncSetAttribute failed\n"); grid = -1; return; }
        int dev = 0, cus = 0, per_cu = 0;
        (void)hipGetDevice(&dev); (void)hipDeviceGetAttribute(&cus, hipDeviceAttributeMultiprocessorCount, dev);
        (void)hipOccupancyMaxActiveBlocksPerMultiprocessor(&per_cu, (const void*)fwd_kernel, NTHR, LDS_BYTES);
        if (per_cu < 1) per_cu = 1;
        grid = cus;
    }
    if (grid < 0) return;
    Params p{};
    for (int i = 0; i < 46; ++i) p.in[i] = (const float*)d_in[i];
    p.out = (float*)d_out; p.ws = (unsigned char*)d_ws;
#if ONE_LAUNCH
    p.ph_lo = 0; p.ph_hi = NPHASE;
    if (hipMemsetAsync((char*)d_ws + OFF_BAR, 0, XCD_BAR_WORDS * 4, stream) != hipSuccess) { fprintf(stderr, "memset failed\n"); return; }
    void* args[] = {&p};
    hipError_t e = hipLaunchCooperativeKernel((const void*)fwd_kernel, dim3(grid), dim3(NTHR), args, LDS_BYTES, stream);
    if (e != hipSuccess) fprintf(stderr, "cooperative launch failed: %s (grid %d)\n", hipGetErrorString(e), grid);
#else
    for (int ph = 0; ph < NPHASE; ++ph) { p.ph_lo = ph; p.ph_hi = ph + 1; hipLaunchKernelGGL(fwd_kernel, dim3(grid), dim3(NTHR), LDS_BYTES, stream, p); }
#endif
}
```

```cpp
#include <hip/hip_runtime.h>
#include <hip/hip_cooperative_groups.h>
#include <cstdio>
#include <cstdint>
namespace cg = cooperative_groups;

#define LAS __attribute__((address_space(3)))
typedef unsigned short bf16_t;
typedef short bf16x8 __attribute__((ext_vector_type(8)));
typedef float f32x4 __attribute__((ext_vector_type(4)));
typedef unsigned u32x2 __attribute__((ext_vector_type(2)));
typedef unsigned u32x4 __attribute__((ext_vector_type(4)));

constexpr int MTOK = 16384, DM = 1024, SEQ = 4096, FF = 2816;
constexpr int NTHR = 512;
constexpr int LDS_BYTES = 131072;
constexpr size_t MiB = 1048576;
constexpr size_t OFF_WIN = 0;
constexpr size_t OFF_WGLU = 4194304;
constexpr size_t OFF_WOUT = 4718592;
constexpr size_t OFF_WGU0 = 6815744;
constexpr size_t OFF_WDN0 = 18350080;
constexpr size_t OFF_WGU1 = 39321600;
constexpr size_t OFF_WDN1 = 50855936;
constexpr size_t OFF_WG1 = 24117248;
constexpr size_t OFF_WL2 = 37748736;
constexpr size_t OFF_WO = 56623104;
constexpr size_t OFF_MOD = 58720256;
constexpr size_t OFF_BAR = 58916864;
constexpr size_t ACT = 57 * MiB;
constexpr size_t OFF_HA = ACT;
constexpr size_t OFF_UX = ACT + 32 * MiB;
constexpr size_t OFF_Z = ACT + 52 * MiB;
constexpr size_t OFF_BTZ = ACT + 112 * MiB;
constexpr size_t OFF_BTY = ACT + 176 * MiB;
constexpr size_t OFF_QKV = ACT + 64 * MiB;
constexpr size_t OFF_CAT = ACT + 112 * MiB;
constexpr size_t OFF_YG = ACT + 144 * MiB;
constexpr size_t OFF_VT = ACT + 160 * MiB;
constexpr size_t OFF_OC = ACT;
constexpr size_t OFF_HID = ACT + 32 * MiB;
constexpr size_t OFF_HD = ACT;
constexpr size_t OFF_RKV = ACT + 64 * MiB;
constexpr size_t OFF_G = ACT + 160 * MiB;
constexpr size_t OFF_Y = 0;
constexpr size_t OFF_L1 = 0;
constexpr size_t OFF_DEC = ACT;
constexpr size_t OFF_AA = ACT + 32 * MiB;
constexpr size_t WS_NEED = ACT + 196 * MiB;

struct Params {
    const float* in[46];
    float* out;
    unsigned char* ws;
    int ph_lo, ph_hi;
};

__device__ __forceinline__ unsigned f2bf(float f) { unsigned u = __float_as_uint(f); return (u + 0x7fffu + ((u >> 16) & 1u)) >> 16; }
__device__ __forceinline__ float bf2f(unsigned h) { return __uint_as_float(h << 16); }
__device__ __forceinline__ unsigned cvt_pk_bf16(float lo, float hi) { unsigned r; asm("v_cvt_pk_bf16_f32 %0, %1, %2" : "=v"(r) : "v"(lo), "v"(hi)); return r; }
__device__ __forceinline__ unsigned pk2(float lo, float hi) { return cvt_pk_bf16(lo, hi); }
__device__ __forceinline__ float bflo(unsigned w) { return __uint_as_float(w << 16); }
__device__ __forceinline__ float bfhi(unsigned w) { return __uint_as_float(w & 0xffff0000u); }
__device__ __forceinline__ float dpp_sum16(float x) {
    x += __int_as_float(__builtin_amdgcn_update_dpp(0, __float_as_int(x), 0xB1, 0xf, 0xf, true));
    x += __int_as_float(__builtin_amdgcn_update_dpp(0, __float_as_int(x), 0x4E, 0xf, 0xf, true));
    x += __int_as_float(__builtin_amdgcn_update_dpp(0, __float_as_int(x), 0x141, 0xf, 0xf, true));
    x += __int_as_float(__builtin_amdgcn_update_dpp(0, __float_as_int(x), 0x140, 0xf, 0xf, true));
    return x;
}
__device__ __forceinline__ float wave_sum(float v) {
    v = dpp_sum16(v);
    const float s0 = __int_as_float(__builtin_amdgcn_readlane(__float_as_int(v), 0)), s1 = __int_as_float(__builtin_amdgcn_readlane(__float_as_int(v), 16));
    const float s2 = __int_as_float(__builtin_amdgcn_readlane(__float_as_int(v), 32)), s3 = __int_as_float(__builtin_amdgcn_readlane(__float_as_int(v), 48));
    return (s0 + s1) + (s2 + s3);
}
__device__ __forceinline__ float sigmoidf_(float x) { return 1.f / (1.f + __expf(-x)); }
#define LWAIT() asm volatile("s_waitcnt lgkmcnt(0)" ::: "memory")
__device__ __forceinline__ float gelu_tanh(float x) { const float t = tanhf(0.7978845608028654f * (x + 0.044715f * x * x * x)); return 0.5f * x * (1.f + t); }

constexpr int HTB = 128 * 64 * 2;
__device__ __forceinline__ int lds_byte(int r, int c) { int st = (r >> 4) * 2 + (c >> 5), rr = r & 15, cc = c & 31, ob = rr * 64 + cc * 2; return st * 1024 + (ob ^ (((ob >> 9) & 1) << 5)); }
__device__ __forceinline__ void stage_rc(int b, int& R, int& C) { int st = b / 1024, sb = b % 1024, swz = sb ^ (((sb >> 9) & 1) << 5); R = (st >> 1) * 16 + swz / 64; C = (st & 1) * 32 + (swz % 64) / 2; }

struct NoPre { __device__ __forceinline__ void operator()(int, int, int) const {} };
template <class Epi, class Pre>
__device__ __forceinline__ void gemm_batched(LAS unsigned char* lds, const bf16_t* A, int lda, size_t strideA, const bf16_t* Bt, size_t strideB, int nMt, int nNt, int nbatch, int K, const Epi& E, const Pre& PRE, int bid, int nb) {
    const int tid = threadIdx.x, wid = __builtin_amdgcn_readfirstlane(tid >> 6), lane = tid & 63, wr = wid >> 2, wc = wid & 3, fr = lane & 15, fq = lane >> 4;
    unsigned voffA[2], voffB[2];
#pragma unroll
    for (int i = 0; i < 2; ++i) { int R, C; stage_rc(tid * 16 + i * 8192, R, C); voffA[i] = (unsigned)(R * lda + C) * 2u; voffB[i] = (unsigned)(R * K + C) * 2u; }
    const int aoff = lds_byte(wr * 64 + fr, fq * 8), boff = lds_byte(wc * 32 + fr, fq * 8);
    const unsigned ldsw = (unsigned)wid * 1024u;
    const size_t kstep = 128, hstepA = (size_t)128 * lda * 2, hstepB = (size_t)128 * K * 2;
    const int nt = K / 64;
    const int ntiles = nMt * nNt * nbatch;
#define G_SA(b, h) (((b) * 2 + (h)) * HTB)
#define G_SB(b, h) ((4 + (b) * 2 + (h)) * HTB)
#define G_STAGEX(bufoff, gptr, vo) do { _Pragma("unroll") for (int _i = 0; _i < 2; ++_i) \
        __builtin_amdgcn_global_load_lds((const unsigned*)((gptr) + vo[_i]), (LAS unsigned*)(lds + (bufoff) + ldsw + _i * 8192), 16, 0, 0); } while (0)
#define G_STA(bufoff, gptr) G_STAGEX(bufoff, gptr, voffA)
#define G_STB(bufoff, gptr) G_STAGEX(bufoff, gptr, voffB)
#define G_LDA(dst, b, h) do { _Pragma("unroll") for (int m = 0; m < 4; ++m) _Pragma("unroll") for (int k = 0; k < 2; ++k) dst[m][k] = *(const LAS bf16x8*)(lds + G_SA(b, h) + aoff + m * 2048 + k * 1024); } while (0)
#define G_LDB(dst, b, h) do { _Pragma("unroll") for (int n = 0; n < 2; ++n) _Pragma("unroll") for (int k = 0; k < 2; ++k) dst[n][k] = *(const LAS bf16x8*)(lds + G_SB(b, h) + boff + n * 2048 + k * 1024); } while (0)
#define G_MMA(ai, bj, At, Bx) do { __builtin_amdgcn_s_setprio(1); _Pragma("unroll") for (int m = 0; m < 4; ++m) _Pragma("unroll") for (int n = 0; n < 2; ++n) _Pragma("unroll") for (int k = 0; k < 2; ++k) \
        acc[ai][bj][m][n] = __builtin_amdgcn_mfma_f32_16x16x32_bf16(Bx[n][k], At[m][k], acc[ai][bj][m][n], 0, 0, 0); __builtin_amdgcn_s_setprio(0); } while (0)
#define G_WV(n) asm volatile("s_waitcnt vmcnt(" #n ")" ::: "memory")
#define G_WL(n) asm volatile("s_waitcnt lgkmcnt(" #n ")" ::: "memory")
#define G_BAR __builtin_amdgcn_s_barrier()
#define G_SCHED __builtin_amdgcn_sched_barrier(0)
    for (int tile = bid; tile < ntiles; tile += nb) {
        const int pm = tile % nMt, tq = tile / nMt, pn = tq % nNt, gb = tq / nNt;
        PRE(gb, pm, pn);
        const char* cA = (const char*)(A + (size_t)gb * strideA) + (size_t)pm * 256 * lda * 2;
        const char* cB = (const char*)(Bt + (size_t)gb * strideB) + (size_t)pn * 256 * K * 2;
        f32x4 acc[2][2][4][2];
#pragma unroll
        for (int a = 0; a < 2; ++a)
#pragma unroll
            for (int b = 0; b < 2; ++b)
#pragma unroll
                for (int m = 0; m < 4; ++m)
#pragma unroll
                    for (int n = 0; n < 2; ++n) acc[a][b][m][n] = (f32x4){0.f, 0.f, 0.f, 0.f};
        bf16x8 At[4][2], B0[2][2], B1[2][2];
        G_WV(0);
        G_STB(G_SB(0, 0), cB); G_STA(G_SA(0, 0), cA); G_STB(G_SB(0, 1), cB + hstepB); G_STA(G_SA(0, 1), cA + hstepA);
        if (wr == 1) G_BAR;
        G_WV(4); G_BAR;
        G_STB(G_SB(1, 0), cB + kstep); G_STA(G_SA(1, 0), cA + kstep); G_STB(G_SB(1, 1), cB + hstepB + kstep);
        G_WV(6); G_BAR;
        for (int t = 0; t < nt - 2; t += 2) {
            const char* a1 = cA + (size_t)(t + 1) * kstep; const char* a2 = cA + (size_t)(t + 2) * kstep; const char* a3 = a2 + kstep;
            const char* b2 = cB + (size_t)(t + 2) * kstep; const char* b3 = b2 + kstep;
            G_LDB(B0, 0, 0); G_SCHED; G_LDA(At, 0, 0); G_STA(G_SA(1, 1), a1 + hstepA);
            G_WL(8); G_BAR; G_WL(0); G_MMA(0, 0, At, B0); G_BAR; G_SCHED;
            G_LDB(B1, 0, 1); G_STB(G_SB(0, 0), b2);
            G_BAR; G_WL(0); G_MMA(0, 1, At, B1); G_BAR;
            G_LDA(At, 0, 1); G_STA(G_SA(0, 0), a2);
            G_BAR; G_WL(0); G_MMA(1, 0, At, B0); G_BAR; G_SCHED;
            G_STB(G_SB(0, 1), b2 + hstepB);
            G_WV(6); G_BAR; G_MMA(1, 1, At, B1); G_BAR;
            G_LDB(B0, 1, 0); G_SCHED; G_LDA(At, 1, 0); G_STA(G_SA(0, 1), a2 + hstepA);
            G_WL(8); G_BAR; G_WL(0); G_MMA(0, 0, At, B0); G_BAR; G_SCHED;
            G_LDB(B1, 1, 1); G_STB(G_SB(1, 0), b3);
            G_BAR; G_WL(0); G_MMA(0, 1, At, B1); G_BAR;
            G_LDA(At, 1, 1); G_STA(G_SA(1, 0), a3);
            G_BAR; G_WL(0); G_MMA(1, 0, At, B0); G_BAR; G_SCHED;
            G_STB(G_SB(1, 1), b3 + hstepB);
            G_WV(6); G_BAR; G_MMA(1, 1, At, B1); G_BAR;
        }
        {
            const char* a1 = cA + (size_t)(nt - 1) * kstep;
            G_LDB(B0, 0, 0); G_LDA(At, 0, 0); G_STA(G_SA(1, 1), a1 + hstepA);
            G_BAR; G_WL(0); G_MMA(0, 0, At, B0); G_BAR;
            G_LDB(B1, 0, 1); G_BAR; G_WL(0); G_MMA(0, 1, At, B1); G_BAR;
            G_LDA(At, 0, 1); G_WV(4); G_BAR; G_WL(0); G_MMA(1, 0, At, B0); G_MMA(1, 1, At, B1); G_BAR;
        }
        {
            G_LDB(B0, 1, 0); G_LDA(At, 1, 0); G_WV(2); G_BAR; G_WL(0); G_MMA(0, 0, At, B0); G_BAR;
            G_LDB(B1, 1, 1); G_WV(0); G_BAR; G_WL(0); G_MMA(0, 1, At, B1); G_BAR;
            G_LDA(At, 1, 1); G_BAR; G_WL(0); G_MMA(1, 0, At, B0); G_MMA(1, 1, At, B1); G_BAR;
        }
        if (wr == 0) G_BAR;
        E(acc, gb, pm, pn, wr, wc, fr, fq);
    }
    G_WV(0);
    __syncthreads();
}

template <class Epi>
__device__ __forceinline__ void gemm_phase(LAS unsigned char* lds, const bf16_t* A, const bf16_t* Bt, int N, int K, const Epi& E, int bid, int nb) {
    gemm_batched(lds, A, K, 0, Bt, 0, 64, N / 256, 1, K, E, NoPre{}, bid, nb);
}

#define EPI_LOOP(...) \
    _Pragma("unroll") for (int ai = 0; ai < 2; ++ai) _Pragma("unroll") for (int m = 0; m < 4; ++m) { asm volatile("" ::: "memory"); const int row = pm * 256 + ai * 128 + wr * 64 + m * 16 + fr; \
    _Pragma("unroll") for (int bj = 0; bj < 2; ++bj) _Pragma("unroll") for (int n = 0; n < 2; ++n) { const int ct = bj * 128 + wc * 32 + n * 16 + fq * 4; const f32x4 v = acc[ai][bj][m][n]; __VA_ARGS__ } }

struct EpiWin {
    bf16_t* UX; bf16_t* QKV;
    __device__ __forceinline__ void operator()(const f32x4 (&acc)[2][2][4][2], int gb, int pm, int pn, int wr, int wc, int fr, int fq) const {
        if (pn < 2) {
            bf16_t* base = UX + ((size_t)(pn * 16 + wc * 2) * 512 + (pm >> 4) * 128 + (pm & 15) * 8 + wr * 2) * 640 + fr * 16 + fq * 4;
#pragma unroll
            for (int ai = 0; ai < 2; ++ai)
#pragma unroll
                for (int m = 0; m < 4; ++m) { bf16_t* rp = base + (ai * 4 + (m >> 1)) * 640 + (m & 1) * 256;
#pragma unroll
                    for (int bj = 0; bj < 2; ++bj)
#pragma unroll
                        for (int n = 0; n < 2; ++n) { const f32x4 v = acc[ai][bj][m][n]; u32x2 w; w.x = pk2(v[0], v[1]); w.y = pk2(v[2], v[3]);
                            *(u32x2*)(rp + (size_t)(bj * 8 + n) * (512 * 640)) = w; }
                    asm volatile("" ::: "memory"); }
        } else { bf16_t* base = QKV + (size_t)((pn - 2) >> 1) * ((size_t)MTOK * 512) + (pn & 1) * 256 + (size_t)(pm * 256 + wr * 64 + fr) * 512 + wc * 32 + fq * 4;
#pragma unroll
            for (int ai = 0; ai < 2; ++ai)
#pragma unroll
                for (int m = 0; m < 4; ++m) { bf16_t* rp = base + (size_t)(ai * 128 + m * 16) * 512;
#pragma unroll
                    for (int bj = 0; bj < 2; ++bj)
#pragma unroll
                        for (int n = 0; n < 2; ++n) { const f32x4 v = acc[ai][bj][m][n]; u32x2 w; w.x = pk2(v[0], v[1]); w.y = pk2(v[2], v[3]);
                            *(u32x2*)(rp + bj * 128 + n * 16) = w; }
                    asm volatile("" ::: "memory"); }
        }
    }
};
struct EpiS5Z {
    float* Z;
    __device__ __forceinline__ void operator()(const f32x4 (&acc)[2][2][4][2], int gb, int pm, int pn, int wr, int wc, int fr, int fq) const {
        EPI_LOOP({ if (bj == 0) *(f32x4*)(Z + ((size_t)gb * 512 + row) * 128 + ct) = v; })
    }
};
struct EpiS5Y {
    const bf16_t* UX; bf16_t* YG; const float* dsk;
    __device__ __forceinline__ void operator()(const f32x4 (&acc)[2][2][4][2], int gb, int pm, int pn, int wr, int wc, int fr, int fq) const {
        EPI_LOOP({ const int col = pn * 256 + ct, t = col >> 4, h = col & 15, bb = row >> 7, cc = row & 127;
            const u32x2 uu = *(const u32x2*)(UX + ((size_t)gb * 512 + row) * 640 + col); const f32x4 dd = *(const f32x4*)(dsk + gb * 16 + h);
            u32x2 w; w.x = pk2(gelu_tanh(v[0] + dd[0] * bflo(uu.x)), gelu_tanh(v[1] + dd[1] * bfhi(uu.x))); w.y = pk2(gelu_tanh(v[2] + dd[2] * bflo(uu.y)), gelu_tanh(v[3] + dd[3] * bfhi(uu.y)));
            *(u32x2*)(YG + ((size_t)bb * SEQ + cc * 32 + t) * 512 + gb * 16 + h) = w; })
    }
};
struct PreS5Y {
    const float* Z; bf16_t* UX; const float* lam_re; const float* lam_im; const float* log_dt;
    __device__ __forceinline__ void operator()(int gb, int pm, int pn) const {
        const int tid = threadIdx.x;
        if (tid < 128) { const int pp = tid & 63, bb = 2 * pm + (tid >> 6);
            const float lr = lam_re[gb * 64 + pp], li = lam_im[gb * 64 + pp], dt = expf(log_dt[gb]);
            const float mag = expf(lr * dt * 32.f), ar = mag * cosf(li * dt * 32.f), ai = mag * sinf(li * dt * 32.f);
            const float* zp = Z + ((size_t)gb * 512 + bb * 128) * 128 + pp; bf16_t* xp = UX + ((size_t)gb * 512 + bb * 128) * 640 + 512 + pp;
            float xr = 0.f, xi = 0.f;
            for (int c0 = 0; c0 < 128; c0 += 16) { float zr[16], zi[16];
#pragma unroll
                for (int i = 0; i < 16; ++i) { zr[i] = zp[(size_t)(c0 + i) * 128]; zi[i] = zp[(size_t)(c0 + i) * 128 + 64]; }
#pragma unroll
                for (int i = 0; i < 16; ++i) { xp[(size_t)(c0 + i) * 640] = (bf16_t)f2bf(xr); xp[(size_t)(c0 + i) * 640 + 64] = (bf16_t)f2bf(xi);
                    const float nr = ar * xr - ai * xi + zr[i], ni = ar * xi + ai * xr + zi[i]; xr = nr; xi = ni; } } }
        __threadfence();
        asm volatile("s_waitcnt vmcnt(0)" ::: "memory");
        __syncthreads();
    }
};
struct EpiGlu {
    const bf16_t* YG; bf16_t* CAT;
    __device__ __forceinline__ void operator()(const f32x4 (&acc)[2][2][4][2], int gb, int pm, int pn, int wr, int wc, int fr, int fq) const {
        EPI_LOOP({ const int col = pn * 256 + ct; const u32x2 y = *(const u32x2*)(YG + (size_t)row * 512 + col);
            u32x2 w; w.x = pk2(bflo(y.x) * sigmoidf_(v[0]), bfhi(y.x) * sigmoidf_(v[1])); w.y = pk2(bflo(y.y) * sigmoidf_(v[2]), bfhi(y.y) * sigmoidf_(v[3]));
            *(u32x2*)(CAT + (size_t)row * 1024 + col) = w; })
    }
};
struct EpiRes {
    const float* res; float* out; const float* gate;
    __device__ __forceinline__ void operator()(const f32x4 (&acc)[2][2][4][2], int gb, int pm, int pn, int wr, int wc, int fr, int fq) const {
        const float* gatep = gate + (size_t)(pm >> 4) * 6144;
        EPI_LOOP({ const int col = pn * 256 + ct; const f32x4 g = *(const f32x4*)(gatep + col); const f32x4 r = *(const f32x4*)(res + (size_t)row * 1024 + col);
            *(f32x4*)(out + (size_t)row * 1024 + col) = r + g * v; })
    }
};
struct EpiSwiglu {
    bf16_t* HID;
    __device__ __forceinline__ void operator()(const f32x4 (&acc)[2][2][4][2], int gb, int pm, int pn, int wr, int wc, int fr, int fq) const {
#pragma unroll
        for (int ai = 0; ai < 2; ++ai)
#pragma unroll
            for (int m = 0; m < 4; ++m) { const int row = pm * 256 + ai * 128 + wr * 64 + m * 16 + fr;
#pragma unroll
                for (int n = 0; n < 2; ++n) { const f32x4 g = acc[ai][0][m][n], u = acc[ai][1][m][n]; float o[4];
#pragma unroll
                    for (int j = 0; j < 4; ++j) o[j] = g[j] * sigmoidf_(g[j]) * u[j];
                    u32x2 w; w.x = pk2(o[0], o[1]); w.y = pk2(o[2], o[3]);
                    *(u32x2*)(HID + (size_t)row * FF + pn * 128 + wc * 32 + n * 16 + fq * 4) = w; } }
    }
};
struct EpiG1 {
    bf16_t* RKV; bf16_t* L1;
    __device__ __forceinline__ void operator()(const f32x4 (&acc)[2][2][4][2], int gb, int pm, int pn, int wr, int wc, int fr, int fq) const {
        if (pn < 12) { bf16_t* base = RKV + (size_t)(pn >> 2) * ((size_t)MTOK * 1024) + (pn & 3) * 256;
            EPI_LOOP({ u32x2 w; w.x = pk2(v[0], v[1]); w.y = pk2(v[2], v[3]); *(u32x2*)(base + (size_t)row * 1024 + ct) = w; }) }
        else { EPI_LOOP({ float o[4];
                _Pragma("unroll") for (int j = 0; j < 4; ++j) o[j] = (bj == 1) ? sigmoidf_(v[j]) : ((wc < 2) ? tanhf(v[j]) : v[j]);
                u32x2 w; w.x = pk2(o[0], o[1]); w.y = pk2(o[2], o[3]); *(u32x2*)(L1 + (size_t)row * 256 + ct) = w; }) }
    }
};
struct EpiL2 {
    _Float16* DEC; bf16_t* AA; bf16_t* G; const float* w0; const float* a0;
    __device__ __forceinline__ void operator()(const f32x4 (&acc)[2][2][4][2], int gb, int pm, int pn, int wr, int wc, int fr, int fq) const {
        const int sel = pn >> 2, cb = (pn & 3) * 256;
        if (sel == 0) { EPI_LOOP({ const int col = cb + ct; const f32x4 w0v = *(const f32x4*)(w0 + col);
                _Pragma("unroll") for (int j = 0; j < 4; ++j) { const float z = w0v[j] + v[j]; const float sp = fmaxf(-z, 0.f) + log1pf(expf(-fabsf(z))); const float e = expf(-sp - 0.5f);
                    DEC[(size_t)row * 1024 + col + j] = (_Float16)(-expm1f(-e)); } }) }
        else if (sel == 1) { EPI_LOOP({ const int col = cb + ct; const f32x4 a0v = *(const f32x4*)(a0 + col);
                u32x2 w; w.x = pk2(sigmoidf_(a0v[0] + v[0]), sigmoidf_(a0v[1] + v[1])); w.y = pk2(sigmoidf_(a0v[2] + v[2]), sigmoidf_(a0v[3] + v[3]));
                *(u32x2*)(AA + (size_t)row * 1024 + col) = w; }) }
        else { EPI_LOOP({ const int col = cb + ct; u32x2 w; w.x = pk2(v[0], v[1]); w.y = pk2(v[2], v[3]); *(u32x2*)(G + (size_t)row * 1024 + col) = w; }) }
    }
};

__device__ __forceinline__ void s5_gen(const Params& p, bf16_t* BtY, bf16_t* BtZ, float* lds, int bid, int nb) {
    float* PWr = lds; float* PWi = lds + 33 * 64; float* BBr = lds + 66 * 64; float* BBi = BBr + 1024; float* Cr = BBi + 1024; float* Ci = Cr + 1024; float* Kt = Ci + 1024;
    const int tid = threadIdx.x;
    for (int unit = bid; unit < 256; unit += nb) {
        const int g = unit >> 3, part = unit & 7;
        __syncthreads();
        if (tid < 64) { const int pp = tid; const float lr = p.in[11][g * 64 + pp], li = p.in[12][g * 64 + pp], dt = expf(p.in[13][g]);
            for (int tau = 0; tau <= 32; ++tau) { const float mag = expf(lr * dt * (float)tau), ang = li * dt * (float)tau; PWr[tau * 64 + pp] = mag * cosf(ang); PWi[tau * 64 + pp] = mag * sinf(ang); }
            const float ar = PWr[64 + pp], ai = PWi[64 + pp], den = lr * lr + li * li, nr = ar - 1.f;
            const float qr = (nr * lr + ai * li) / den, qi = (ai * lr - nr * li) / den;
            for (int h = 0; h < 16; ++h) { const float br = p.in[14][(size_t)(g * 64 + pp) * 16 + h], bi = p.in[15][(size_t)(g * 64 + pp) * 16 + h]; BBr[pp * 16 + h] = qr * br - qi * bi; BBi[pp * 16 + h] = qr * bi + qi * br; } }
        for (int i = tid; i < 1024; i += NTHR) { Cr[i] = p.in[16][(size_t)g * 1024 + i]; Ci[i] = p.in[17][(size_t)g * 1024 + i]; }
        __syncthreads();
        for (int e = tid; e < 8192; e += NTHR) { const int tau = e >> 8, h = (e >> 4) & 15, h2 = e & 15; float acc = 0.f;
            for (int pp = 0; pp < 64; ++pp) { const float cr = Cr[h * 64 + pp], ci = Ci[h * 64 + pp], wr = PWr[tau * 64 + pp], wi = PWi[tau * 64 + pp];
                const float er = cr * wr - ci * wi, ei = cr * wi + ci * wr; acc += er * BBr[pp * 16 + h2] - ei * BBi[pp * 16 + h2]; }
            Kt[e] = acc; }
        __syncthreads();
        for (int ci_ = tid; ci_ < 5120; ci_ += NTHR) { const int nrow = part * 64 + ci_ / 80, kc = (ci_ % 80) * 8, t = nrow >> 4, h = nrow & 15; float v[8];
#pragma unroll
            for (int i = 0; i < 8; ++i) { const int k = kc + i;
                if (k < 512) { const int sidx = k >> 4, h2 = k & 15; v[i] = (sidx <= t) ? Kt[(t - sidx) * 256 + h * 16 + h2] : 0.f; }
                else { const int jj = k - 512, pp = jj & 63; const float cr = Cr[h * 64 + pp], ci = Ci[h * 64 + pp], wr = PWr[(t + 1) * 64 + pp], wi = PWi[(t + 1) * 64 + pp];
                    v[i] = (jj >> 6) ? -(cr * wi + ci * wr) : (cr * wr - ci * wi); } }
            *(u32x4*)(BtY + ((size_t)g * 512 + nrow) * 640 + kc) = (u32x4){pk2(v[0], v[1]), pk2(v[2], v[3]), pk2(v[4], v[5]), pk2(v[6], v[7])}; }
        for (int ci_ = tid; ci_ < 1024; ci_ += NTHR) { const int n = part * 16 + (ci_ >> 6), kc = (ci_ & 63) * 8, pp = n & 63, im = n >> 6; float v[8];
#pragma unroll
            for (int i = 0; i < 8; ++i) { const int k = kc + i, sidx = k >> 4, h2 = k & 15, tau = 31 - sidx; const float wr = PWr[tau * 64 + pp], wi = PWi[tau * 64 + pp], br = BBr[pp * 16 + h2], bi = BBi[pp * 16 + h2];
                v[i] = im ? (wr * bi + wi * br) : (wr * br - wi * bi); }
            *(u32x4*)(BtZ + ((size_t)g * 256 + n) * 512 + kc) = (u32x4){pk2(v[0], v[1]), pk2(v[2], v[3]), pk2(v[4], v[5]), pk2(v[6], v[7])}; }
    }
    __syncthreads();
}

template <int MODE>
__device__ __forceinline__ void tr_job(const float* src, int K, int N, bf16_t* dst, int ldd, int row_off, int koff, const float* scale, float* lds, int bid, int nb) {
    const int tk = K / 64, tn = N / 64, tid = threadIdx.x;
    for (int t = bid; t < tk * tn; t += nb) {
        const int k0 = (t / tn) * 64, n0 = (t % tn) * 64;
        { const int r = tid >> 3, c = (tid & 7) * 8; const float* p = src + (size_t)(k0 + r) * N + n0 + c;
          const float4 a = *(const float4*)p, b = *(const float4*)(p + 4); const float s = scale ? scale[k0 + r] : 1.f;
          float* l = lds + r * 65 + c; l[0] = a.x * s; l[1] = a.y * s; l[2] = a.z * s; l[3] = a.w * s; l[4] = b.x * s; l[5] = b.y * s; l[6] = b.z * s; l[7] = b.w * s; }
        __syncthreads();
        { const int nl = tid >> 3, kc = (tid & 7) * 8; float v[8];
#pragma unroll
          for (int i = 0; i < 8; ++i) v[i] = lds[(kc + i) * 65 + nl];
          int n = n0 + nl; int rowi = n;
          if (MODE == 1) rowi = (n >> 7) * 256 + (n & 127);
          if (MODE == 2) rowi = (n >> 7) * 256 + 128 + (n & 127);
          u32x4 w; w.x = pk2(v[0], v[1]); w.y = pk2(v[2], v[3]); w.z = pk2(v[4], v[5]); w.w = pk2(v[6], v[7]);
          *(u32x4*)(dst + (size_t)(row_off + rowi) * ldd + koff + k0 + kc) = w; }
        __syncthreads();
    }
}

__device__ __forceinline__ void prep_phase(const Params& p, float* lds, int bid, int nb) {
    unsigned char* ws = p.ws;
    s5_gen(p, (bf16_t*)(ws + OFF_BTY), (bf16_t*)(ws + OFF_BTZ), lds, bid, nb);
    tr_job<0>(p.in[10], 1024, 2048, (bf16_t*)(ws + OFF_WIN), 1024, 0, 0, nullptr, lds, bid, nb);
    tr_job<0>(p.in[19], 512, 512, (bf16_t*)(ws + OFF_WGLU), 512, 0, 0, nullptr, lds, bid, nb);
    tr_job<0>(p.in[27], 1024, 1024, (bf16_t*)(ws + OFF_WOUT), 1024, 0, 0, nullptr, lds, bid, nb);
    for (int l = 0; l < 2; ++l) {
        bf16_t* gu = (bf16_t*)(ws + (l ? OFF_WGU1 : OFF_WGU0)); bf16_t* dn = (bf16_t*)(ws + (l ? OFF_WDN1 : OFF_WDN0));
        tr_job<1>(p.in[7] + (size_t)l * 1024 * FF, 1024, FF, gu, 1024, 0, 0, nullptr, lds, bid, nb);
        tr_job<2>(p.in[8] + (size_t)l * 1024 * FF, 1024, FF, gu, 1024, 0, 0, nullptr, lds, bid, nb);
        tr_job<0>(p.in[9] + (size_t)l * FF * 1024, FF, 1024, dn, FF, 0, 0, nullptr, lds, bid, nb);
    }
    bf16_t* g1 = (bf16_t*)(ws + OFF_WG1); const float* mu = p.in[28];
    tr_job<0>(p.in[29], 1024, 1024, g1, 2048, 0, 0, nullptr, lds, bid, nb);      tr_job<0>(p.in[29], 1024, 1024, g1, 2048, 0, 1024, mu + 0 * 1024, lds, bid, nb);
    tr_job<0>(p.in[30], 1024, 1024, g1, 2048, 1024, 0, nullptr, lds, bid, nb);   tr_job<0>(p.in[30], 1024, 1024, g1, 2048, 1024, 1024, mu + 2 * 1024, lds, bid, nb);
    tr_job<0>(p.in[31], 1024, 1024, g1, 2048, 2048, 0, nullptr, lds, bid, nb);   tr_job<0>(p.in[31], 1024, 1024, g1, 2048, 2048, 1024, mu + 3 * 1024, lds, bid, nb);
    tr_job<0>(p.in[34], 1024, 64, g1, 2048, 3072, 0, nullptr, lds, bid, nb);     tr_job<0>(p.in[34], 1024, 64, g1, 2048, 3072, 1024, mu + 1 * 1024, lds, bid, nb);
    tr_job<0>(p.in[37], 1024, 64, g1, 2048, 3136, 0, nullptr, lds, bid, nb);     tr_job<0>(p.in[37], 1024, 64, g1, 2048, 3136, 1024, mu + 4 * 1024, lds, bid, nb);
    tr_job<0>(p.in[39], 1024, 128, g1, 2048, 3200, 0, nullptr, lds, bid, nb);    tr_job<0>(p.in[39], 1024, 128, g1, 2048, 3200, 1024, mu + 5 * 1024, lds, bid, nb);
    bf16_t* l2 = (bf16_t*)(ws + OFF_WL2);
    tr_job<0>(p.in[35], 64, 1024, l2, 256, 0, 0, nullptr, lds, bid, nb);
    tr_job<0>(p.in[38], 64, 1024, l2, 256, 1024, 64, nullptr, lds, bid, nb);
    tr_job<0>(p.in[40], 128, 1024, l2, 256, 2048, 128, nullptr, lds, bid, nb);
    for (int i = bid * NTHR + threadIdx.x; i < 3072 * 32; i += nb * NTHR) { const int n = i >> 5, kc = (i & 31) * 8; const int sel = n >> 10;
        const bool used = (sel == 0) ? (kc < 64) : (sel == 1) ? (kc >= 64 && kc < 128) : (kc >= 128);
        if (!used) *(u32x4*)(l2 + (size_t)n * 256 + kc) = (u32x4){0u, 0u, 0u, 0u}; }
    tr_job<0>(p.in[32], 1024, 1024, (bf16_t*)(ws + OFF_WO), 1024, 0, 0, nullptr, lds, bid, nb);
    {   const float* c = p.in[1]; const float* wada = p.in[3]; const float* bada = p.in[4]; float* mod = (float*)(ws + OFF_MOD);
        float* cact = lds;
        float* red = lds + 4096;
        for (int i = threadIdx.x; i < 4096; i += NTHR) { const float x = c[i]; cact[i] = x / (1.f + expf(-x)); }
        __syncthreads();
        const int col = threadIdx.x & 63, kg = threadIdx.x >> 6;
        for (int ch = bid; ch < 192; ch += nb) {
            const int l = ch / 96, n0 = (ch % 96) * 64;
            const float* wp = wada + (size_t)l * 1024 * 6144 + n0 + col;
            float a0 = 0.f, a1 = 0.f, a2 = 0.f, a3 = 0.f;
            for (int k = kg * 128; k < kg * 128 + 128; ++k) { const float w = wp[(size_t)k * 6144]; a0 += cact[k] * w; a1 += cact[1024 + k] * w; a2 += cact[2048 + k] * w; a3 += cact[3072 + k] * w; }
            red[(kg * 4 + 0) * 64 + col] = a0; red[(kg * 4 + 1) * 64 + col] = a1; red[(kg * 4 + 2) * 64 + col] = a2; red[(kg * 4 + 3) * 64 + col] = a3;
            __syncthreads();
            if (threadIdx.x < 256) { const int b = threadIdx.x >> 6; float s = 0.f;
#pragma unroll
                for (int g = 0; g < 8; ++g) s += red[(g * 4 + b) * 64 + col];
                mod[(size_t)(l * 4 + b) * 6144 + n0 + col] = s + bada[l * 6144 + n0 + col]; }
            __syncthreads();
        }
    }
}

template <bool RW>
__device__ __forceinline__ void norm_phase(const float* x, const float* g, const float* modl, int shift_off, int scale_off, bf16_t* out, int bid, int nb) {
    const int wave = threadIdx.x >> 6, lane = threadIdx.x & 63;
    for (int row = bid * 8 + wave; row < MTOK; row += nb * 8) {
        const int b = row >> 12; const float* xr = x + (size_t)row * 1024; const float* md = modl + (size_t)b * 6144;
        f32x4 v[4], vp[4]; float ss = 0.f, ssp = 0.f; const bool hasp = RW && ((row & 4095) != 0);
#pragma unroll
        for (int i = 0; i < 4; ++i) { v[i] = *(const f32x4*)(xr + i * 256 + lane * 4); ss += v[i][0] * v[i][0] + v[i][1] * v[i][1] + v[i][2] * v[i][2] + v[i][3] * v[i][3];
            if (RW) { vp[i] = hasp ? *(const f32x4*)(xr - 1024 + i * 256 + lane * 4) : (f32x4){0.f, 0.f, 0.f, 0.f}; ssp += vp[i][0] * vp[i][0] + vp[i][1] * vp[i][1] + vp[i][2] * vp[i][2] + vp[i][3] * vp[i][3]; } }
        ss = wave_sum(ss); const float rstd = rsqrtf(ss * (1.f / 1024.f) + 1e-6f);
        float rstdp = 0.f; if (RW) { ssp = wave_sum(ssp); rstdp = rsqrtf(ssp * (1.f / 1024.f) + 1e-6f); }
#pragma unroll
        for (int i = 0; i < 4; ++i) { const int c = i * 256 + lane * 4; const f32x4 gg = *(const f32x4*)(g + c), sc = *(const f32x4*)(md + scale_off + c), sh = *(const f32x4*)(md + shift_off + c);
            f32x4 h;
#pragma unroll
            for (int j = 0; j < 4; ++j) h[j] = v[i][j] * rstd * gg[j] * (1.f + sc[j]) + sh[j];
            u32x2 w; w.x = pk2(h[0], h[1]); w.y = pk2(h[2], h[3]);
            if (!RW) *(u32x2*)(out + (size_t)row * 1024 + c) = w;
            else { *(u32x2*)(out + (size_t)row * 2048 + c) = w; f32x4 d;
#pragma unroll
                for (int j = 0; j < 4; ++j) { const float hp = hasp ? (vp[i][j] * rstdp * gg[j] * (1.f + sc[j]) + sh[j]) : 0.f; d[j] = hp - h[j]; }
                u32x2 w2; w2.x = pk2(d[0], d[1]); w2.y = pk2(d[2], d[3]); *(u32x2*)(out + (size_t)row * 2048 + 1024 + c) = w2; } }
    }
}

__device__ __forceinline__ void qknorm_phase(bf16_t* Q, bf16_t* Kb, const int* pos, const float* qn, const float* kn, int bid, int nb) {
    const int wave = threadIdx.x >> 6, lane = threadIdx.x & 63, l16 = lane & 15, d0 = l16 * 4;
    float invf[4];
#pragma unroll
    for (int j = 0; j < 4; ++j) invf[j] = powf(500000.f, -(float)((l16 & 1) * 4 + j) / 8.f);
    const f32x4 qw = *(const f32x4*)(qn + d0), kw = *(const f32x4*)(kn + d0);
    for (int tok = bid * 8 + wave; tok < MTOK; tok += nb * 8) {
        const float ps = (float)pos[tok];
        float cs[4], sn[4];
#pragma unroll
        for (int j = 0; j < 4; ++j) { const float ang = ps * invf[j]; cs[j] = cosf(ang); sn[j] = sinf(ang); }
#pragma unroll
        for (int bsel = 0; bsel < 2; ++bsel) { bf16_t* buf = bsel ? Kb : Q; const f32x4 w = bsel ? kw : qw;
#pragma unroll
            for (int it = 0; it < 2; ++it) { const int vec = it * 4 + (lane >> 4); bf16_t* ptr = buf + (size_t)tok * 512 + vec * 64 + d0;
                const u32x2 raw = *(const u32x2*)ptr; float y[4] = {bflo(raw.x), bfhi(raw.x), bflo(raw.y), bfhi(raw.y)};
                float ss = y[0] * y[0] + y[1] * y[1] + y[2] * y[2] + y[3] * y[3];
                ss += __shfl_xor(ss, 1); ss += __shfl_xor(ss, 2); ss += __shfl_xor(ss, 4); ss += __shfl_xor(ss, 8);
                const float rstd = rsqrtf(ss * (1.f / 64.f) + 1e-6f);
#pragma unroll
                for (int j = 0; j < 4; ++j) y[j] = y[j] * rstd * w[j];
                float pr[4];
#pragma unroll
                for (int j = 0; j < 4; ++j) pr[j] = __shfl_xor(y[j], 2);
                if (l16 < 2) {
#pragma unroll
                    for (int j = 0; j < 4; ++j) y[j] = y[j] * cs[j] - pr[j] * sn[j]; }
                else if (l16 < 4) {
#pragma unroll
                    for (int j = 0; j < 4; ++j) y[j] = y[j] * cs[j] + pr[j] * sn[j]; }
                if (!bsel) {
#pragma unroll
                    for (int j = 0; j < 4; ++j) y[j] *= 0.125f * 1.4426950408889634f; }
                u32x2 o; o.x = pk2(y[0], y[1]); o.y = pk2(y[2], y[3]); *(u32x2*)ptr = o; } }
    }
}

__device__ __forceinline__ void vtrans_phase(const bf16_t* V, bf16_t* Vt, bf16_t* lds, int bid, int nb) {
    const int tid = threadIdx.x;
    for (int unit = bid; unit < 1024; unit += nb) {
        const int head = unit & 3, ch = unit >> 2; const int b = ch >> 6, t0 = (ch & 63) * 64;
#pragma unroll
        for (int i = 0; i < 2; ++i) { const int idx = tid + i * 512, t = idx >> 4, cc = (idx & 15) * 8;
            const u32x4 w = *(const u32x4*)(V + ((size_t)b * SEQ + t0 + t) * 512 + head * 128 + cc);
            unsigned* d = (unsigned*)(lds + t * 130 + cc); d[0] = w.x; d[1] = w.y; d[2] = w.z; d[3] = w.w; }
        __syncthreads();
        { const int e = tid >> 2, tc = (tid & 3) * 16; unsigned o[8];
#pragma unroll
          for (int i = 0; i < 8; ++i) o[i] = (unsigned)lds[(tc + 2 * i) * 130 + e] | ((unsigned)lds[(tc + 2 * i + 1) * 130 + e] << 16);
          u32x4* dst = (u32x4*)(Vt + ((size_t)(b * 4 + head) * 128 + e) * SEQ + t0 + tc);
          dst[0] = (u32x4){o[0], o[1], o[2], o[3]}; dst[1] = (u32x4){o[4], o[5], o[6], o[7]}; }
        __syncthreads();
    }
}

typedef float f32x16 __attribute__((ext_vector_type(16)));
__device__ __forceinline__ void attn_phase(const bf16_t* Q, const bf16_t* Kb, const bf16_t* Vt, bf16_t* OC, LAS unsigned char* lds, int bid, int nb) {
    const int tid = threadIdx.x, wave = __builtin_amdgcn_readfirstlane(tid >> 6), lane = tid & 63, c = wave >> 2, wq = wave & 3, l32 = lane & 31, hh = lane >> 5;
    constexpr int KROW = 272, VROW = 72, KBUF = 32 * KROW, VBUF = 128 * VROW, VOFF = 2 * KBUF;
    const int lkey = tid >> 4, lkc = tid & 15, lve = tid >> 2, lvc = tid & 3;
    for (int unit = bid; unit < 256; unit += nb) {
        const int b = unit & 3, head = (unit >> 2) & 3, pr = unit >> 4;
        const bf16_t* kg = Kb + ((size_t)b * SEQ + lkey) * 512 + head * 128 + lkc * 8;
        const bf16_t* vg = Vt + ((size_t)(b * 4 + head) * 128 + lve) * SEQ + lvc * 8;
        for (int half = 0; half < 2; ++half) {
            const int qb = half ? (31 - pr) : pr; const int q0 = qb * 128 + wq * 32; const int ntile = (qb + 1) * 4;
            bf16x8 qf[4];
            { const bf16_t* qp = Q + ((size_t)b * SEQ + q0 + l32) * 512 + head * 128 + c * 64 + hh * 8;
#pragma unroll
              for (int ks = 0; ks < 4; ++ks) qf[ks] = *(const bf16x8*)(qp + ks * 16); }
            f32x16 o[4];
#pragma unroll
            for (int blk = 0; blk < 4; ++blk)
#pragma unroll
                for (int r = 0; r < 16; ++r) o[blk][r] = 0.f;
            float mrow = -INFINITY, lsum = 0.f;
            u32x4 kreg = *(const u32x4*)kg, vreg = *(const u32x4*)vg;
            __syncthreads();
            { *(LAS u32x4*)(lds + lkey * KROW + lkc * 16) = kreg;
              LAS u32x2* vd = (LAS u32x2*)(lds + VOFF + lve * VROW + lvc * 16); vd[0] = (u32x2){vreg.x, vreg.y}; vd[1] = (u32x2){vreg.z, vreg.w}; }
            __syncthreads();
            for (int kt = 0; kt < ntile; ++kt) {
                const int cur = kt & 1, key0 = kt * 32;
                if (kt + 1 < ntile) { kreg = *(const u32x4*)(kg + (size_t)(key0 + 32) * 512); vreg = *(const u32x4*)(vg + key0 + 32); }
                if (key0 <= q0) {
                    LAS unsigned char* kb = lds + cur * KBUF + l32 * KROW + c * 128 + hh * 16;
                    f32x16 sacc;
#pragma unroll
                    for (int r = 0; r < 16; ++r) sacc[r] = 0.f;
#pragma unroll
                    for (int ks = 0; ks < 4; ++ks) { const bf16x8 kf = *(const LAS bf16x8*)(kb + ks * 32); sacc = __builtin_amdgcn_mfma_f32_32x32x16_bf16(kf, qf[ks], sacc, 0, 0, 0); }
                    if (key0 == q0) {
#pragma unroll
                        for (int r = 0; r < 16; ++r) { const int kl = (r & 3) + 8 * (r >> 2) + 4 * hh; if (kl > l32) sacc[r] = -INFINITY; } }
                    float tm = sacc[0];
#pragma unroll
                    for (int r = 1; r < 16; ++r) tm = fmaxf(tm, sacc[r]);
                    tm = fmaxf(tm, __shfl_xor(tm, 32));
                    const float mnew = fmaxf(mrow, tm);
                    if (__any(mnew > mrow)) { const float al = exp2f(mrow - mnew); lsum *= al;
#pragma unroll
                        for (int blk = 0; blk < 4; ++blk)
#pragma unroll
                            for (int r = 0; r < 16; ++r) o[blk][r] *= al;
                        mrow = mnew; }
                    float ps = 0.f;
#pragma unroll
                    for (int r = 0; r < 16; ++r) { sacc[r] = exp2f(sacc[r] - mrow); ps += sacc[r]; }
                    lsum += ps;
                    LAS unsigned char* vb = lds + VOFF + cur * VBUF + l32 * VROW + hh * 8;
#pragma unroll
                    for (int s2 = 0; s2 < 2; ++s2) {
                        u32x4 pw; pw.x = cvt_pk_bf16(sacc[8 * s2 + 0], sacc[8 * s2 + 1]); pw.y = cvt_pk_bf16(sacc[8 * s2 + 2], sacc[8 * s2 + 3]); pw.z = cvt_pk_bf16(sacc[8 * s2 + 4], sacc[8 * s2 + 5]); pw.w = cvt_pk_bf16(sacc[8 * s2 + 6], sacc[8 * s2 + 7]);
                        const bf16x8 pb = __builtin_bit_cast(bf16x8, pw);
#pragma unroll
                        for (int blk = 0; blk < 4; ++blk) { const u32x2 v0 = *(const LAS u32x2*)(vb + blk * 32 * VROW + s2 * 32), v1 = *(const LAS u32x2*)(vb + blk * 32 * VROW + s2 * 32 + 16);
                            const bf16x8 vf = __builtin_bit_cast(bf16x8, (u32x4){v0.x, v0.y, v1.x, v1.y});
                            o[blk] = __builtin_amdgcn_mfma_f32_32x32x16_bf16(vf, pb, o[blk], 0, 0, 0); } }
                }
                if (kt + 1 < ntile) { const int nx = cur ^ 1;
                    *(LAS u32x4*)(lds + nx * KBUF + lkey * KROW + lkc * 16) = kreg;
                    LAS u32x2* vd = (LAS u32x2*)(lds + VOFF + nx * VBUF + lve * VROW + lvc * 16); vd[0] = (u32x2){vreg.x, vreg.y}; vd[1] = (u32x2){vreg.z, vreg.w}; }
                __syncthreads();
            }
            lsum += __shfl_xor(lsum, 32);
            const float inv = 1.f / lsum;
            bf16_t* op = OC + ((size_t)b * SEQ + q0 + l32) * 1024 + (head * 2 + c) * 128 + 4 * hh;
#pragma unroll
            for (int blk = 0; blk < 4; ++blk)
#pragma unroll
                for (int g4 = 0; g4 < 4; ++g4) { u32x2 w; w.x = pk2(o[blk][g4 * 4 + 0] * inv, o[blk][g4 * 4 + 1] * inv); w.y = pk2(o[blk][g4 * 4 + 2] * inv, o[blk][g4 * 4 + 3] * inv);
                    *(u32x2*)(op + blk * 32 + g4 * 8) = w; }
        }
    }
}

__device__ __forceinline__ void attn_combine(const bf16_t* OC, bf16_t* CAT, const Params& p, int bid, int nb) {
    const int wave = threadIdx.x >> 6, lane = threadIdx.x & 63, head = lane >> 4, e0 = (lane & 15) * 8;
    float lam;
    { float s1 = 0.f, s2 = 0.f; for (int d = 0; d < 64; ++d) { s1 += p.in[22][d] * p.in[23][d]; s2 += p.in[24][d] * p.in[25][d]; } lam = expf(s1) - expf(s2) + 0.2f; }
    float sub[8];
#pragma unroll
    for (int i = 0; i < 8; ++i) sub[i] = p.in[26][e0 + i] * 0.8f;
    for (int tok = bid * 8 + wave; tok < MTOK; tok += nb * 8) {
        const u32x4 a = *(const u32x4*)(OC + (size_t)tok * 1024 + (head * 2) * 128 + e0), bb = *(const u32x4*)(OC + (size_t)tok * 1024 + (head * 2 + 1) * 128 + e0);
        float o[8] = {bflo(a.x) - lam * bflo(bb.x), bfhi(a.x) - lam * bfhi(bb.x), bflo(a.y) - lam * bflo(bb.y), bfhi(a.y) - lam * bfhi(bb.y),
                      bflo(a.z) - lam * bflo(bb.z), bfhi(a.z) - lam * bfhi(bb.z), bflo(a.w) - lam * bflo(bb.w), bfhi(a.w) - lam * bfhi(bb.w)};
        float ss = 0.f;
#pragma unroll
        for (int i = 0; i < 8; ++i) ss += o[i] * o[i];
        ss += __shfl_xor(ss, 1); ss += __shfl_xor(ss, 2); ss += __shfl_xor(ss, 4); ss += __shfl_xor(ss, 8);
        const float rstd = rsqrtf(ss * (1.f / 128.f) + 1e-6f);
        u32x4 w; w.x = pk2(o[0] * rstd * sub[0], o[1] * rstd * sub[1]); w.y = pk2(o[2] * rstd * sub[2], o[3] * rstd * sub[3]); w.z = pk2(o[4] * rstd * sub[4], o[5] * rstd * sub[5]); w.w = pk2(o[6] * rstd * sub[6], o[7] * rstd * sub[7]);
        *(u32x4*)(CAT + (size_t)tok * 1024 + 512 + head * 128 + e0) = w;
    }
}

typedef float f32x2 __attribute__((ext_vector_type(2)));
__device__ __forceinline__ void rwkv_phase(const Params& p, const bf16_t* R, const bf16_t* Kk, const bf16_t* Vv, const _Float16* DEC, const bf16_t* AA, bf16_t* Y, float* lds, int bid, int nb) {
    const int tid = threadIdx.x, wave = __builtin_amdgcn_readfirstlane(tid >> 6), lane = tid & 63;
    constexpr int TCH = 16, BUFF = 5 * TCH * 64 + TCH * 16;
    constexpr int OBUF = TCH * 16 * 16;
    float* Lout = lds + 2 * BUFF;
    for (int unit = bid; unit < 256; unit += nb) {
        const int b = unit >> 6, h = (unit >> 2) & 15, rq = unit & 3;
        __syncthreads();
        if (wave >= 4) {
            const int pw = wave - 4;
            const float kkw = p.in[41][h * 64 + lane], kaw = p.in[42][h * 64 + lane];
            unsigned rr[4][4], kr[4][4], ar[4][4], vr[4][4]; _Float16 dr[4][4];
#define RW_ISSUE(set, ch) do { _Pragma("unroll") for (int i = 0; i < 4; ++i) { const size_t off = ((size_t)b * SEQ + (ch) * TCH + pw * 4 + i) * 1024 + h * 64; \
                    rr[set][i] = R[off + lane]; kr[set][i] = Kk[off + lane]; dr[set][i] = DEC[off + lane]; ar[set][i] = AA[off + lane]; vr[set][i] = Vv[off + rq * 16 + (lane & 15)]; } } while (0)
#define RW_STAGE(set, buf) do { float* L = lds + (buf) * BUFF; _Pragma("unroll") for (int i = 0; i < 4; ++i) { const int tt = pw * 4 + i; const float k = bf2f(kr[set][i]), a = bf2f(ar[set][i]); \
                    float kk = k * kkw; const float n2 = wave_sum(kk * kk); kk = kk / fmaxf(sqrtf(n2), 1e-12f); \
                    L[(0 * TCH + tt) * 64 + lane] = 1.f - (float)dr[set][i]; L[(1 * TCH + tt) * 64 + lane] = -kk; L[(2 * TCH + tt) * 64 + lane] = kk * a; L[(3 * TCH + tt) * 64 + lane] = k * (1.f + (a - 1.f) * kaw); L[(4 * TCH + tt) * 64 + lane] = bf2f(rr[set][i]); \
                    if (lane < 16) L[5 * TCH * 64 + tt * 16 + lane] = bf2f(vr[set][i]); } } while (0)
            auto flush = [&](int ch) { const int i = tid - 256, tt = i >> 4, row = i & 15; const f32x4* pp = (const f32x4*)(Lout + (ch & 1) * OBUF + i * 16);
                const f32x4 s4 = pp[0] + pp[1] + pp[2] + pp[3];
                Y[((size_t)b * SEQ + ch * TCH + tt) * 1024 + h * 64 + rq * 16 + row] = (bf16_t)f2bf((s4[0] + s4[1]) + (s4[2] + s4[3])); };
            constexpr int NCH = SEQ / TCH;
            RW_ISSUE(0, 0); RW_ISSUE(1, 1); RW_ISSUE(2, 2); RW_ISSUE(3, 3);
            RW_STAGE(0, 0);
            __syncthreads();
            for (int c4 = 0; c4 < NCH; c4 += 4) {
#define RW_ITER(q) do { const int ch = c4 + (q); if (ch + 1 < NCH) RW_STAGE(((q) + 1) & 3, (ch + 1) & 1); if (ch + 4 < NCH) RW_ISSUE((q), ch + 4); if (ch > 0) flush(ch - 1); __syncthreads(); } while (0)
                RW_ITER(0); RW_ITER(1); RW_ITER(2); RW_ITER(3);
            }
            flush(NCH - 1);
        } else {
            const int j = lane & 15, rowl = wave * 4 + (lane >> 4);
            f32x2 S01 = {0.f, 0.f}, S23 = {0.f, 0.f};
            __syncthreads();
            for (int ch = 0; ch < SEQ / TCH; ++ch) {
                const float* L = lds + (ch & 1) * BUFF + j * 4; const float* Lv = lds + (ch & 1) * BUFF + 5 * TCH * 64 + rowl; float* Lo = Lout + (ch & 1) * OBUF + rowl * 16 + j;
                f32x4 w4 = *(const f32x4*)(L), a4 = *(const f32x4*)(L + 1 * TCH * 64), b4 = *(const f32x4*)(L + 2 * TCH * 64), k4 = *(const f32x4*)(L + 3 * TCH * 64), r4 = *(const f32x4*)(L + 4 * TCH * 64);
                float vv = Lv[0];
#pragma unroll
                for (int tt = 0; tt < TCH; ++tt) {
                    f32x4 nw4 = w4, na4 = a4, nb4 = b4, nk4 = k4, nr4 = r4; float nvv = vv;
                    if (tt + 1 < TCH) { const float* Ln = L + (tt + 1) * 64; nw4 = *(const f32x4*)(Ln); na4 = *(const f32x4*)(Ln + 1 * TCH * 64); nb4 = *(const f32x4*)(Ln + 2 * TCH * 64); nk4 = *(const f32x4*)(Ln + 3 * TCH * 64); nr4 = *(const f32x4*)(Ln + 4 * TCH * 64); nvv = Lv[(tt + 1) * 16]; }
                    f32x2 d = S01 * (f32x2){a4[0], a4[1]}; d = S23 * (f32x2){a4[2], a4[3]} + d;
                    const float sa = dpp_sum16(d[0] + d[1]);
                    const f32x2 sa2 = {sa, sa}, v2 = {vv, vv};
                    const f32x2 t01 = sa2 * (f32x2){b4[0], b4[1]} + v2 * (f32x2){k4[0], k4[1]}, t23 = sa2 * (f32x2){b4[2], b4[3]} + v2 * (f32x2){k4[2], k4[3]};
                    S01 = S01 * (f32x2){w4[0], w4[1]} + t01; S23 = S23 * (f32x2){w4[2], w4[3]} + t23;
                    f32x2 y = S01 * (f32x2){r4[0], r4[1]}; y = S23 * (f32x2){r4[2], r4[3]} + y;
                    Lo[tt * 256] = y[0] + y[1];
                    w4 = nw4; a4 = na4; b4 = nb4; k4 = nk4; r4 = nr4; vv = nvv;
                }
                __syncthreads();
            }
        }
    }
}

__device__ __forceinline__ void rwkv_post(const Params& p, bf16_t* R, const bf16_t* Kk, const bf16_t* Vv, const bf16_t* AA, const bf16_t* G, const bf16_t* Y, int bid, int nb) {
    const int wave = threadIdx.x >> 6, lane = threadIdx.x & 63;
    for (int it = bid * 8 + wave; it < MTOK * 16; it += nb * 8) {
        const int h = it & 15; const size_t off = (size_t)(it >> 4) * 1024 + h * 64 + lane;
        const float y = bf2f(Y[off]), r = bf2f(R[off]), k = bf2f(Kk[off]), v = bf2f(Vv[off]), a = bf2f(AA[off]), g = bf2f(G[off]);
        const float mean = wave_sum(y) * (1.f / 64.f); const float d = y - mean; const float var = wave_sum(d * d) * (1.f / 64.f);
        const float k2 = k * (1.f + (a - 1.f) * p.in[42][h * 64 + lane]);
        const float sb = wave_sum(r * k2 * p.in[43][h * 64 + lane]);
        const float yn = d * rsqrtf(var + 64e-5f) * p.in[44][h * 64 + lane] + p.in[45][h * 64 + lane] + sb * v;
        R[off] = (bf16_t)f2bf(yn * g);
    }
}

#define XB_TMO      128
#define XB_XCNT(j)  (256  + 64 * (j))
#define XB_XSUB(j)  (1280 + 64 * (j))
#define XB_XGEN(j)  (2304 + 64 * (j))
#define XB_TOP      3328
#define XB_TOPGEN   3392
#define XCD_BAR_WORDS 3456
#define XB_SPIN_CAP (1u << 18)
__device__ __forceinline__ unsigned xb_ld(unsigned* p)              { return __hip_atomic_load(p, __ATOMIC_RELAXED, __HIP_MEMORY_SCOPE_AGENT); }
__device__ __forceinline__ unsigned xb_add(unsigned* p, unsigned v) { return __hip_atomic_fetch_add(p, v, __ATOMIC_RELAXED, __HIP_MEMORY_SCOPE_AGENT); }
__device__ __forceinline__ unsigned xb_xcc_id() { return (unsigned)__builtin_amdgcn_s_getreg((3 << 11) | 20) & 0xFu; }
#define XB_SPIN(cond, bar) do { unsigned _sp = 0; while (cond) { __builtin_amdgcn_s_sleep(1); \
    if ((++_sp & 255u) == 0u) { if (xb_ld(&(bar)[XB_TMO])) break; if (_sp > XB_SPIN_CAP) { atomicAdd(&(bar)[XB_TMO], 1u); break; } } } } while (0)
struct XcdBarrier { unsigned* bar; unsigned x; volatile LAS unsigned* st; };
__device__ __forceinline__ XcdBarrier xcd_barrier_post(unsigned* bar, volatile LAS unsigned* st) {
    XcdBarrier b; b.bar = bar; b.x = xb_xcc_id(); b.st = st;
    if (threadIdx.x == 0) (void)xb_add(&bar[XB_XCNT(b.x)], 1u);
    return b;
}
__device__ __forceinline__ void xcd_barrier_complete(unsigned* bar, unsigned x, unsigned& nloc, unsigned& nx) {
    const unsigned G = gridDim.x * gridDim.y * gridDim.z;
    unsigned sum, cnt, mine, sp = 0u;
    for (;;) {
        sum = 0u; cnt = 0u; mine = 0u;
#pragma unroll
        for (unsigned j = 0; j < 16; ++j) { const unsigned c = xb_ld(&bar[XB_XCNT(j)]); sum += c; cnt += (c > 0u) ? 1u : 0u; mine = (j == x) ? c : mine; }
        if (sum == G) break;
        __builtin_amdgcn_s_sleep(1);
        if ((++sp & 255u) == 0u) { if (xb_ld(&bar[XB_TMO])) break; if (sp > XB_SPIN_CAP) { atomicAdd(&bar[XB_TMO], 1u); break; } }
    }
    nloc = mine > 0u ? mine : 1u; nx = cnt > 0u ? cnt : 1u;
}
__device__ __forceinline__ void xcd_barrier(const XcdBarrier& b) {
    asm volatile("s_waitcnt vmcnt(0)" ::: "memory");
    __syncthreads();
    if (threadIdx.x == 0) {
        unsigned* bar = b.bar;
        __builtin_amdgcn_s_waitcnt(0);
        unsigned nloc = b.st[0], nx = b.st[1];
        if (nloc == 0u) { xcd_barrier_complete(bar, b.x, nloc, nx); b.st[0] = nloc; b.st[1] = nx; }
        const unsigned old = xb_add(&bar[XB_XSUB(b.x)], 1u);
        const unsigned gen = old / nloc;
        if (old + 1u == (gen + 1u) * nloc) {
            __builtin_amdgcn_fence(__ATOMIC_RELEASE, "agent");
            asm volatile("s_waitcnt vmcnt(0)" ::: "memory");
            const unsigned og = xb_add(&bar[XB_TOP], 1u);
            const unsigned tg = og / nx;
            if (og + 1u == (tg + 1u) * nx) xb_add(&bar[XB_TOPGEN], 1u);
            else XB_SPIN(xb_ld(&bar[XB_TOPGEN]) == tg, bar);
            __builtin_amdgcn_fence(__ATOMIC_ACQUIRE, "agent");
            xb_add(&bar[XB_XGEN(b.x)], 1u);
            asm volatile("s_waitcnt vmcnt(0)" ::: "memory");
        } else {
            XB_SPIN(xb_ld(&bar[XB_XGEN(b.x)]) == gen, bar);
            __builtin_amdgcn_fence(__ATOMIC_ACQUIRE, "agent");
            asm volatile("s_waitcnt vmcnt(0)" ::: "memory");
        }
    }
    __syncthreads();
}

__global__ void __launch_bounds__(NTHR) fwd_kernel(Params p) {
    extern __shared__ __attribute__((aligned(16))) unsigned char lds_raw[];
    LAS unsigned char* lds = (LAS unsigned char*)lds_raw;
    float* ldsf = (float*)lds_raw;
    const int bid = blockIdx.x, nb = gridDim.x;
    unsigned char* ws = p.ws;
    float* mod = (float*)(ws + OFF_MOD);
    const bool multi = (p.ph_hi - p.ph_lo) > 1;
    __shared__ unsigned xb_st[4];
    if (threadIdx.x < 4) xb_st[threadIdx.x] = 0u;
    __syncthreads();
    XcdBarrier xbar; xbar.bar = (unsigned*)(ws + OFF_BAR); xbar.x = 0; xbar.st = (volatile LAS unsigned*)xb_st;
    if (multi) xbar = xcd_barrier_post((unsigned*)(ws + OFF_BAR), (volatile LAS unsigned*)xb_st);
#ifndef TESTPH
#define TESTPH -1
#endif
#ifndef REPEAT_A
#define REPEAT_A -1
#endif
#ifndef REPEAT_B
#define REPEAT_B -1
#endif
#ifndef EXTRA_SYNCS
#define EXTRA_SYNCS 0
#endif
#define PH(k) if ((TESTPH < 0 || TESTPH == (k)) && p.ph_lo <= (k) && (k) < p.ph_hi) for (int rep_ = 0; rep_ < (((k) == REPEAT_A || (k) == REPEAT_B) ? 2 : 1); ++rep_)
#define SYNC(k) if (multi && (k) + 1 < p.ph_hi) { if ((k) == 0) cg::this_grid().sync(); else xcd_barrier(xbar); }
    for (int es_ = 0; es_ < EXTRA_SYNCS; ++es_) cg::this_grid().sync();
    PH(0) { prep_phase(p, ldsf, bid, nb); SYNC(0) }
    PH(1) { norm_phase<false>(p.in[0], p.in[5], mod, 0, 1024, (bf16_t*)(ws + OFF_HA), bid, nb); SYNC(1) }
    PH(2) { EpiWin e{(bf16_t*)(ws + OFF_UX), (bf16_t*)(ws + OFF_QKV)}; gemm_phase(lds, (const bf16_t*)(ws + OFF_HA), (const bf16_t*)(ws + OFF_WIN), 2048, 1024, e, bid, nb); SYNC(2) }
    PH(3) { { EpiS5Z e{(float*)(ws + OFF_Z)}; gemm_batched(lds, (const bf16_t*)(ws + OFF_UX), 640, (size_t)512 * 640, (const bf16_t*)(ws + OFF_BTZ), (size_t)256 * 512, 2, 1, 32, 512, e, NoPre{}, bid, nb); }
            bf16_t* q = (bf16_t*)(ws + OFF_QKV); qknorm_phase(q, q + (size_t)MTOK * 512, (const int*)p.in[2], p.in[20], p.in[21], bid, nb);
            vtrans_phase(q + (size_t)MTOK * 1024, (bf16_t*)(ws + OFF_VT), (bf16_t*)lds_raw, bid, nb); SYNC(3) }
    PH(5) { { EpiS5Y e{(const bf16_t*)(ws + OFF_UX), (bf16_t*)(ws + OFF_YG), p.in[18]}; PreS5Y pre{(const float*)(ws + OFF_Z), (bf16_t*)(ws + OFF_UX), p.in[11], p.in[12], p.in[13]};
              gemm_batched(lds, (const bf16_t*)(ws + OFF_UX), 640, (size_t)512 * 640, (const bf16_t*)(ws + OFF_BTY), (size_t)512 * 640, 2, 2, 32, 640, e, pre, bid, nb); }
            bf16_t* q = (bf16_t*)(ws + OFF_QKV); attn_phase(q, q + (size_t)MTOK * 512, (const bf16_t*)(ws + OFF_VT), (bf16_t*)(ws + OFF_OC), lds, bid, nb); SYNC(5) }
    PH(6) { attn_combine((const bf16_t*)(ws + OFF_OC), (bf16_t*)(ws + OFF_CAT), p, bid, nb);
            EpiGlu e{(const bf16_t*)(ws + OFF_YG), (bf16_t*)(ws + OFF_CAT)}; gemm_phase(lds, (const bf16_t*)(ws + OFF_YG), (const bf16_t*)(ws + OFF_WGLU), 512, 512, e, bid, nb); SYNC(6) }
    PH(7) { EpiRes e{p.in[0], p.out, mod + 2048}; gemm_phase(lds, (const bf16_t*)(ws + OFF_CAT), (const bf16_t*)(ws + OFF_WOUT), 1024, 1024, e, bid, nb); SYNC(7) }
    PH(8) { norm_phase<false>(p.out, p.in[6], mod, 3072, 4096, (bf16_t*)(ws + OFF_HA), bid, nb); SYNC(8) }
    PH(9) { EpiSwiglu e{(bf16_t*)(ws + OFF_HID)}; gemm_phase(lds, (const bf16_t*)(ws + OFF_HA), (const bf16_t*)(ws + OFF_WGU0), 5632, 1024, e, bid, nb); SYNC(9) }
    PH(10) { EpiRes e{p.out, p.out, mod + 5120}; gemm_phase(lds, (const bf16_t*)(ws + OFF_HID), (const bf16_t*)(ws + OFF_WDN0), 1024, FF, e, bid, nb); SYNC(10) }
    const float* mod1 = mod + 4 * 6144;
    PH(11) { norm_phase<true>(p.out, p.in[5] + 1024, mod1, 0, 1024, (bf16_t*)(ws + OFF_HD), bid, nb); SYNC(11) }
    PH(12) { EpiG1 e{(bf16_t*)(ws + OFF_RKV), (bf16_t*)(ws + OFF_L1)}; gemm_phase(lds, (const bf16_t*)(ws + OFF_HD), (const bf16_t*)(ws + OFF_WG1), 3328, 2048, e, bid, nb); SYNC(12) }
    PH(13) { EpiL2 e{(_Float16*)(ws + OFF_DEC), (bf16_t*)(ws + OFF_AA), (bf16_t*)(ws + OFF_G), p.in[33], p.in[36]}; gemm_phase(lds, (const bf16_t*)(ws + OFF_L1), (const bf16_t*)(ws + OFF_WL2), 3072, 256, e, bid, nb); SYNC(13) }
    PH(14) { const bf16_t* r = (const bf16_t*)(ws + OFF_RKV); rwkv_phase(p, r, r + (size_t)MTOK * 1024, r + (size_t)MTOK * 2048, (const _Float16*)(ws + OFF_DEC), (const bf16_t*)(ws + OFF_AA), (bf16_t*)(ws + OFF_Y), ldsf, bid, nb); SYNC(14) }
    PH(15) { bf16_t* r = (bf16_t*)(ws + OFF_RKV); rwkv_post(p, r, r + (size_t)MTOK * 1024, r + (size_t)MTOK * 2048, (const bf16_t*)(ws + OFF_AA), (const bf16_t*)(ws + OFF_G), (const bf16_t*)(ws + OFF_Y), bid, nb); SYNC(15) }
    PH(16) { EpiRes e{p.out, p.out, mod1 + 2048}; gemm_phase(lds, (const bf16_t*)(ws + OFF_RKV), (const bf16_t*)(ws + OFF_WO), 1024, 1024, e, bid, nb); SYNC(16) }
    PH(17) { norm_phase<false>(p.out, p.in[6] + 1024, mod1, 3072, 4096, (bf16_t*)(ws + OFF_HA), bid, nb); SYNC(17) }
    PH(18) { EpiSwiglu e{(bf16_t*)(ws + OFF_HID)}; gemm_phase(lds, (const bf16_t*)(ws + OFF_HA), (const bf16_t*)(ws + OFF_WGU1), 5632, 1024, e, bid, nb); SYNC(18) }
    PH(19) { EpiRes e{p.out, p.out, mod1 + 5120}; gemm_phase(lds, (const bf16_t*)(ws + OFF_HID), (const bf16_t*)(ws + OFF_WDN1), 1024, FF, e, bid, nb); }
}

constexpr int NPHASE = 20;
#ifndef ONE_LAUNCH
#define ONE_LAUNCH 1
#endif

extern "C" void kernel_launch(void* const* d_in, const int* in_sizes, int n_in, void* d_out, int out_size, void* d_ws, size_t ws_size, hipStream_t stream) {
    static int grid = 0;
    if (grid == 0) {
        if (n_in != 46 || ws_size < WS_NEED) { fprintf(stderr, "kernel_launch: unexpected n_in %d / ws_size %zu (need %zu)\n", n_in, ws_size, (size_t)WS_NEED); grid = -1; return; }
        if (hipFuncSetAttribute((const void*)fwd_kernel, hipFuncAttributeMaxDynamicSharedMemorySize, LDS_BYTES) != hipSuccess) { fprintf(stderr, "hipFuncSetAttribute failed\n"); grid = -1; return; }
        int dev = 0, cus = 0, per_cu = 0;
        (void)hipGetDevice(&dev); (void)hipDeviceGetAttribute(&cus, hipDeviceAttributeMultiprocessorCount, dev);
        (void)hipOccupancyMaxActiveBlocksPerMultiprocessor(&per_cu, (const void*)fwd_kernel, NTHR, LDS_BYTES);
        if (per_cu < 1) per_cu = 1;
        grid = cus;
    }
    if (grid < 0) return;
    Params p{};
    for (int i = 0; i < 46; ++i) p.in[i] = (const float*)d_in[i];
    p.out = (float*)d_out; p.ws = (unsigned char*)d_ws;
#if ONE_LAUNCH
    p.ph_lo = 0; p.ph_hi = NPHASE;
    if (hipMemsetAsync((char*)d_ws + OFF_BAR, 0, XCD_BAR_WORDS * 4, stream) != hipSuccess) { fprintf(stderr, "memset failed\n"); return; }
    void* args[] = {&p};
    hipError_t e = hipLaunchCooperativeKernel((const void*)fwd_kernel, dim3(grid), dim3(NTHR), args, LDS_BYTES, stream);
    if (e != hipSuccess) fprintf(stderr, "cooperative launch failed: %s (grid %d)\n", hipGetErrorString(e), grid);
#else
    for (int ph = 0; ph < NPHASE; ++ph) { p.ph_lo = ph; p.ph_hi = ph + 1; hipLaunchKernelGGL(fwd_kernel, dim3(grid), dim3(NTHR), LDS_BYTES, stream, p); }
#endif
}
```

```cpp
#include <hip/hip_runtime.h>
#include <hip/hip_cooperative_groups.h>
#include <cstdio>
#include <cstdint>
namespace cg = cooperative_groups;

#define LAS __attribute__((address_space(3)))
typedef unsigned short bf16_t;
typedef short bf16x8 __attribute__((ext_vector_type(8)));
typedef float f32x4 __attribute__((ext_vector_type(4)));
typedef unsigned u32x2 __attribute__((ext_vector_type(2)));
typedef unsigned u32x4 __attribute__((ext_vector_type(4)));

constexpr int MTOK = 16384, DM = 1024, SEQ = 4096, FF = 2816;
constexpr int NTHR = 512;
constexpr int LDS_BYTES = 131072;
constexpr size_t MiB = 1048576;
constexpr size_t OFF_WIN = 0;
constexpr size_t OFF_WGLU = 4194304;
constexpr size_t OFF_WOUT = 4718592;
constexpr size_t OFF_WGU0 = 6815744;
constexpr size_t OFF_WDN0 = 18350080;
constexpr size_t OFF_WGU1 = 39321600;
constexpr size_t OFF_WDN1 = 50855936;
constexpr size_t OFF_WG1 = 24117248;
constexpr size_t OFF_WL2 = 37748736;
constexpr size_t OFF_WO = 56623104;
constexpr size_t OFF_MOD = 58720256;
constexpr size_t OFF_BAR = 58916864;
constexpr size_t ACT = 57 * MiB;
constexpr size_t OFF_HA = ACT;
constexpr size_t OFF_UX = ACT + 32 * MiB;
constexpr size_t OFF_Z = ACT + 52 * MiB;
constexpr size_t OFF_BTZ = ACT + 112 * MiB;
constexpr size_t OFF_BTY = ACT + 176 * MiB;
constexpr size_t OFF_QKV = ACT + 64 * MiB;
constexpr size_t OFF_CAT = ACT + 112 * MiB;
constexpr size_t OFF_YG = ACT + 144 * MiB;
constexpr size_t OFF_VT = ACT + 160 * MiB;
constexpr size_t OFF_OC = ACT;
constexpr size_t OFF_HID = ACT + 32 * MiB;
constexpr size_t OFF_HD = ACT;
constexpr size_t OFF_RKV = ACT + 64 * MiB;
constexpr size_t OFF_G = ACT + 160 * MiB;
constexpr size_t OFF_Y = 0;
constexpr size_t OFF_L1 = 0;
constexpr size_t OFF_DEC = ACT;
constexpr size_t OFF_AA = ACT + 32 * MiB;
constexpr size_t WS_NEED = ACT + 196 * MiB;

struct Params {
    const float* in[46];
    float* out;
    unsigned char* ws;
    int ph_lo, ph_hi;
};

__device__ __forceinline__ unsigned f2bf(float f) { unsigned u = __float_as_uint(f); return (u + 0x7fffu + ((u >> 16) & 1u)) >> 16; }
__device__ __forceinline__ float bf2f(unsigned h) { return __uint_as_float(h << 16); }
__device__ __forceinline__ unsigned cvt_pk_bf16(float lo, float hi) { unsigned r; asm("v_cvt_pk_bf16_f32 %0, %1, %2" : "=v"(r) : "v"(lo), "v"(hi)); return r; }
__device__ __forceinline__ unsigned pk2(float lo, float hi) { return cvt_pk_bf16(lo, hi); }
__device__ __forceinline__ float bflo(unsigned w) { return __uint_as_float(w << 16); }
__device__ __forceinline__ float bfhi(unsigned w) { return __uint_as_float(w & 0xffff0000u); }
__device__ __forceinline__ float dpp_sum16(float x) {
    x += __int_as_float(__builtin_amdgcn_update_dpp(0, __float_as_int(x), 0xB1, 0xf, 0xf, true));
    x += __int_as_float(__builtin_amdgcn_update_dpp(0, __float_as_int(x), 0x4E, 0xf, 0xf, true));
    x += __int_as_float(__builtin_amdgcn_update_dpp(0, __float_as_int(x), 0x141, 0xf, 0xf, true));
    x += __int_as_float(__builtin_amdgcn_update_dpp(0, __float_as_int(x), 0x140, 0xf, 0xf, true));
    return x;
}
__device__ __forceinline__ float wave_sum(float v) {
    v = dpp_sum16(v);
    const float s0 = __int_as_float(__builtin_amdgcn_readlane(__float_as_int(v), 0)), s1 = __int_as_float(__builtin_amdgcn_readlane(__float_as_int(v), 16));
    const float s2 = __int_as_float(__builtin_amdgcn_readlane(__float_as_int(v), 32)), s3 = __int_as_float(__builtin_amdgcn_readlane(__float_as_int(v), 48));
    return (s0 + s1) + (s2 + s3);
}
__device__ __forceinline__ float sigmoidf_(float x) { return 1.f / (1.f + __expf(-x)); }
#define LWAIT() asm volatile("s_waitcnt lgkmcnt(0)" ::: "memory")
__device__ __forceinline__ float gelu_tanh(float x) { const float t = tanhf(0.7978845608028654f * (x + 0.044715f * x * x * x)); return 0.5f * x * (1.f + t); }

constexpr int HTB = 128 * 64 * 2;
__device__ __forceinline__ int lds_byte(int r, int c) { int st = (r >> 4) * 2 + (c >> 5), rr = r & 15, cc = c & 31, ob = rr * 64 + cc * 2; return st * 1024 + (ob ^ (((ob >> 9) & 1) << 5)); }
__device__ __forceinline__ void stage_rc(int b, int& R, int& C) { int st = b / 1024, sb = b % 1024, swz = sb ^ (((sb >> 9) & 1) << 5); R = (st >> 1) * 16 + swz / 64; C = (st & 1) * 32 + (swz % 64) / 2; }

struct NoPre { static constexpr bool NOP = true; __device__ __forceinline__ void operator()(int, int, int) const {} };
template <class Epi, class Pre>
__device__ __forceinline__ void gemm_batched(LAS unsigned char* lds, const bf16_t* A, int lda, size_t strideA, const bf16_t* Bt, size_t strideB, int nMt, int nNt, int nbatch, int K, const Epi& E, const Pre& PRE, int bid, int nb) {
    const int tid = threadIdx.x, wid = __builtin_amdgcn_readfirstlane(tid >> 6), lane = tid & 63, wr = wid >> 2, wc = wid & 3, fr = lane & 15, fq = lane >> 4;
    unsigned voffA[2], voffB[2];
#pragma unroll
    for (int i = 0; i < 2; ++i) { int R, C; stage_rc(tid * 16 + i * 8192, R, C); voffA[i] = (unsigned)(R * lda + C) * 2u; voffB[i] = (unsigned)(R * K + C) * 2u; }
    const int aoff = lds_byte(wr * 64 + fr, fq * 8), boff = lds_byte(wc * 32 + fr, fq * 8);
    const unsigned ldsw = (unsigned)wid * 1024u;
    const size_t kstep = 128, hstepA = (size_t)128 * lda * 2, hstepB = (size_t)128 * K * 2;
    const int nt = K / 64;
    const int ntiles = nMt * nNt * nbatch;
#define G_SA(b, h) (((b) * 2 + (h)) * HTB)
#define G_SB(b, h) ((4 + (b) * 2 + (h)) * HTB)
#define G_STAGEX(bufoff, gptr, vo) do { _Pragma("unroll") for (int _i = 0; _i < 2; ++_i) \
        __builtin_amdgcn_global_load_lds((const unsigned*)((gptr) + vo[_i]), (LAS unsigned*)(lds + (bufoff) + ldsw + _i * 8192), 16, 0, 0); } while (0)
#define G_STA(bufoff, gptr) G_STAGEX(bufoff, gptr, voffA)
#define G_STB(bufoff, gptr) G_STAGEX(bufoff, gptr, voffB)
#define G_LDA(dst, b, h) do { _Pragma("unroll") for (int m = 0; m < 4; ++m) _Pragma("unroll") for (int k = 0; k < 2; ++k) dst[m][k] = *(const LAS bf16x8*)(lds + G_SA(b, h) + aoff + m * 2048 + k * 1024); } while (0)
#define G_LDB(dst, b, h) do { _Pragma("unroll") for (int n = 0; n < 2; ++n) _Pragma("unroll") for (int k = 0; k < 2; ++k) dst[n][k] = *(const LAS bf16x8*)(lds + G_SB(b, h) + boff + n * 2048 + k * 1024); } while (0)
#define G_MMA(ai, bj, At, Bx) do { __builtin_amdgcn_s_setprio(1); _Pragma("unroll") for (int m = 0; m < 4; ++m) _Pragma("unroll") for (int n = 0; n < 2; ++n) _Pragma("unroll") for (int k = 0; k < 2; ++k) \
        acc[ai][bj][m][n] = __builtin_amdgcn_mfma_f32_16x16x32_bf16(Bx[n][k], At[m][k], acc[ai][bj][m][n], 0, 0, 0); __builtin_amdgcn_s_setprio(0); } while (0)
#define G_WV(n) asm volatile("s_waitcnt vmcnt(" #n ")" ::: "memory")
#define G_WL(n) asm volatile("s_waitcnt lgkmcnt(" #n ")" ::: "memory")
#define G_BAR __builtin_amdgcn_s_barrier()
#define G_SCHED __builtin_amdgcn_sched_barrier(0)
    bool prefetched = false;
    for (int tile = bid; tile < ntiles; tile += nb) {
        const int pm = tile % nMt, tq = tile / nMt, pn = tq % nNt, gb = tq / nNt;
        PRE(gb, pm, pn);
        const char* cA = (const char*)(A + (size_t)gb * strideA) + (size_t)pm * 256 * lda * 2;
        const char* cB = (const char*)(Bt + (size_t)gb * strideB) + (size_t)pn * 256 * K * 2;
        f32x4 acc[2][2][4][2];
#pragma unroll
        for (int a = 0; a < 2; ++a)
#pragma unroll
            for (int b = 0; b < 2; ++b)
#pragma unroll
                for (int m = 0; m < 4; ++m)
#pragma unroll
                    for (int n = 0; n < 2; ++n) acc[a][b][m][n] = (f32x4){0.f, 0.f, 0.f, 0.f};
        bf16x8 At[4][2], B0[2][2], B1[2][2];
        if (!prefetched) { G_WV(0); G_STB(G_SB(0, 0), cB); G_STA(G_SA(0, 0), cA); G_STB(G_SB(0, 1), cB + hstepB); G_STA(G_SA(0, 1), cA + hstepA); }
        if (wr == 1) G_BAR;
        if (prefetched) G_WV(0); else G_WV(4);
        G_BAR;
        G_STB(G_SB(1, 0), cB + kstep); G_STA(G_SA(1, 0), cA + kstep); G_STB(G_SB(1, 1), cB + hstepB + kstep);
        G_WV(6); G_BAR;
        for (int t = 0; t < nt - 2; t += 2) {
            const char* a1 = cA + (size_t)(t + 1) * kstep; const char* a2 = cA + (size_t)(t + 2) * kstep; const char* a3 = a2 + kstep;
            const char* b2 = cB + (size_t)(t + 2) * kstep; const char* b3 = b2 + kstep;
            G_LDB(B0, 0, 0); G_SCHED; G_LDA(At, 0, 0); G_STA(G_SA(1, 1), a1 + hstepA);
            G_WL(8); G_BAR; G_WL(0); G_MMA(0, 0, At, B0); G_BAR; G_SCHED;
            G_LDB(B1, 0, 1); G_STB(G_SB(0, 0), b2);
            G_BAR; G_WL(0); G_MMA(0, 1, At, B1); G_BAR;
            G_LDA(At, 0, 1); G_STA(G_SA(0, 0), a2);
            G_BAR; G_WL(0); G_MMA(1, 0, At, B0); G_BAR; G_SCHED;
            G_STB(G_SB(0, 1), b2 + hstepB);
            G_WV(6); G_BAR; G_MMA(1, 1, At, B1); G_BAR;
            G_LDB(B0, 1, 0); G_SCHED; G_LDA(At, 1, 0); G_STA(G_SA(0, 1), a2 + hstepA);
            G_WL(8); G_BAR; G_WL(0); G_MMA(0, 0, At, B0); G_BAR; G_SCHED;
            G_LDB(B1, 1, 1); G_STB(G_SB(1, 0), b3);
            G_BAR; G_WL(0); G_MMA(0, 1, At, B1); G_BAR;
            G_LDA(At, 1, 1); G_STA(G_SA(1, 0), a3);
            G_BAR; G_WL(0); G_MMA(1, 0, At, B0); G_BAR; G_SCHED;
            G_STB(G_SB(1, 1), b3 + hstepB);
            G_WV(6); G_BAR; G_MMA(1, 1, At, B1); G_BAR;
        }
        {
            const char* a1 = cA + (size_t)(nt - 1) * kstep;
            G_LDB(B0, 0, 0); G_LDA(At, 0, 0); G_STA(G_SA(1, 1), a1 + hstepA);
            G_BAR; G_WL(0); G_MMA(0, 0, At, B0); G_BAR;
            G_LDB(B1, 0, 1); G_BAR; G_WL(0); G_MMA(0, 1, At, B1); G_BAR;
            G_LDA(At, 0, 1); G_WV(4); G_BAR; G_WL(0); G_MMA(1, 0, At, B0); G_MMA(1, 1, At, B1); G_BAR;
        }
        {
            G_LDB(B0, 1, 0); G_LDA(At, 1, 0); G_WV(2); G_BAR; G_WL(0); G_MMA(0, 0, At, B0); G_BAR;
            G_LDB(B1, 1, 1); G_WV(0); G_BAR; G_WL(0); G_MMA(0, 1, At, B1); G_BAR;
            G_LDA(At, 1, 1); G_BAR; G_WL(0); G_MMA(1, 0, At, B0); G_MMA(1, 1, At, B1); G_BAR;
        }
        if (wr == 0) G_BAR;
        prefetched = false;
        if (Pre::NOP && tile + nb < ntiles) {
            const int t2 = tile + nb, pm2 = t2 % nMt, tq2 = t2 / nMt, pn2 = tq2 % nNt, gb2 = tq2 / nNt;
            const char* nA = (const char*)(A + (size_t)gb2 * strideA) + (size_t)pm2 * 256 * lda * 2;
            const char* nB = (const char*)(Bt + (size_t)gb2 * strideB) + (size_t)pn2 * 256 * K * 2;
            G_STB(G_SB(0, 0), nB); G_STA(G_SA(0, 0), nA); G_STB(G_SB(0, 1), nB + hstepB); G_STA(G_SA(0, 1), nA + hstepA);
            prefetched = true; }
        E(acc, gb, pm, pn, wr, wc, fr, fq);
    }
    G_WV(0);
    __syncthreads();
}

template <class Epi>
__device__ __forceinline__ void gemm_phase(LAS unsigned char* lds, const bf16_t* A, const bf16_t* Bt, int N, int K, const Epi& E, int bid, int nb) {
    gemm_batched(lds, A, K, 0, Bt, 0, 64, N / 256, 1, K, E, NoPre{}, bid, nb);
}

#define EPI_LOOP(...) \
    _Pragma("unroll") for (int ai = 0; ai < 2; ++ai) _Pragma("unroll") for (int m = 0; m < 4; ++m) { asm volatile("" ::: "memory"); const int row = pm * 256 + ai * 128 + wr * 64 + m * 16 + fr; \
    _Pragma("unroll") for (int bj = 0; bj < 2; ++bj) _Pragma("unroll") for (int n = 0; n < 2; ++n) { const int ct = bj * 128 + wc * 32 + n * 16 + fq * 4; const f32x4 v = acc[ai][bj][m][n]; __VA_ARGS__ } }

struct EpiWin {
    bf16_t* UX; bf16_t* QKV;
    __device__ __forceinline__ void operator()(const f32x4 (&acc)[2][2][4][2], int gb, int pm, int pn, int wr, int wc, int fr, int fq) const {
        if (pn < 2) {
            bf16_t* base = UX + ((size_t)(pn * 16 + wc * 2) * 512 + (pm >> 4) * 128 + (pm & 15) * 8 + wr * 2) * 640 + fr * 16 + fq * 4;
#pragma unroll
            for (int ai = 0; ai < 2; ++ai)
#pragma unroll
                for (int m = 0; m < 4; ++m) { bf16_t* rp = base + (ai * 4 + (m >> 1)) * 640 + (m & 1) * 256;
#pragma unroll
                    for (int bj = 0; bj < 2; ++bj)
#pragma unroll
                        for (int n = 0; n < 2; ++n) { const f32x4 v = acc[ai][bj][m][n]; u32x2 w; w.x = pk2(v[0], v[1]); w.y = pk2(v[2], v[3]);
                            *(u32x2*)(rp + (size_t)(bj * 8 + n) * (512 * 640)) = w; }
                    asm volatile("" ::: "memory"); }
        } else { bf16_t* base = QKV + (size_t)((pn - 2) >> 1) * ((size_t)MTOK * 512) + (pn & 1) * 256 + (size_t)(pm * 256 + wr * 64 + fr) * 512 + wc * 32 + fq * 4;
#pragma unroll
            for (int ai = 0; ai < 2; ++ai)
#pragma unroll
                for (int m = 0; m < 4; ++m) { bf16_t* rp = base + (size_t)(ai * 128 + m * 16) * 512;
#pragma unroll
                    for (int bj = 0; bj < 2; ++bj)
#pragma unroll
                        for (int n = 0; n < 2; ++n) { const f32x4 v = acc[ai][bj][m][n]; u32x2 w; w.x = pk2(v[0], v[1]); w.y = pk2(v[2], v[3]);
                            *(u32x2*)(rp + bj * 128 + n * 16) = w; }
                    asm volatile("" ::: "memory"); }
        }
    }
};
struct EpiS5Z {
    float* Z;
    __device__ __forceinline__ void operator()(const f32x4 (&acc)[2][2][4][2], int gb, int pm, int pn, int wr, int wc, int fr, int fq) const {
        EPI_LOOP({ if (bj == 0) *(f32x4*)(Z + ((size_t)gb * 512 + row) * 128 + ct) = v; })
    }
};
struct EpiS5Y {
    const bf16_t* UX; bf16_t* YG; const float* dsk;
    __device__ __forceinline__ void operator()(const f32x4 (&acc)[2][2][4][2], int gb, int pm, int pn, int wr, int wc, int fr, int fq) const {
        EPI_LOOP({ const int col = pn * 256 + ct, t = col >> 4, h = col & 15, bb = row >> 7, cc = row & 127;
            const u32x2 uu = *(const u32x2*)(UX + ((size_t)gb * 512 + row) * 640 + col); const f32x4 dd = *(const f32x4*)(dsk + gb * 16 + h);
            u32x2 w; w.x = pk2(gelu_tanh(v[0] + dd[0] * bflo(uu.x)), gelu_tanh(v[1] + dd[1] * bfhi(uu.x))); w.y = pk2(gelu_tanh(v[2] + dd[2] * bflo(uu.y)), gelu_tanh(v[3] + dd[3] * bfhi(uu.y)));
            *(u32x2*)(YG + ((size_t)bb * SEQ + cc * 32 + t) * 512 + gb * 16 + h) = w; })
    }
};
struct PreS5Y {   static constexpr bool NOP = false;
    const float* Z; bf16_t* UX; const float* lam_re; const float* lam_im; const float* log_dt;
    __device__ __forceinline__ void operator()(int gb, int pm, int pn) const {
        const int tid = threadIdx.x;
        if (tid < 128) { const int pp = tid & 63, bb = 2 * pm + (tid >> 6);
            const float lr = lam_re[gb * 64 + pp], li = lam_im[gb * 64 + pp], dt = expf(log_dt[gb]);
            const float mag = expf(lr * dt * 32.f), ar = mag * cosf(li * dt * 32.f), ai = mag * sinf(li * dt * 32.f);
            const float* zp = Z + ((size_t)gb * 512 + bb * 128) * 128 + pp; bf16_t* xp = UX + ((size_t)gb * 512 + bb * 128) * 640 + 512 + pp;
            float xr = 0.f, xi = 0.f;
            for (int c0 = 0; c0 < 128; c0 += 16) { float zr[16], zi[16];
#pragma unroll
                for (int i = 0; i < 16; ++i) { zr[i] = zp[(size_t)(c0 + i) * 128]; zi[i] = zp[(size_t)(c0 + i) * 128 + 64]; }
#pragma unroll
                for (int i = 0; i < 16; ++i) { xp[(size_t)(c0 + i) * 640] = (bf16_t)f2bf(xr); xp[(size_t)(c0 + i) * 640 + 64] = (bf16_t)f2bf(xi);
                    const float nr = ar * xr - ai * xi + zr[i], ni = ar * xi + ai * xr + zi[i]; xr = nr; xi = ni; } } }
        __threadfence();
        asm volatile("s_waitcnt vmcnt(0)" ::: "memory");
        __syncthreads();
    }
};
struct EpiGlu {
    const bf16_t* YG; bf16_t* CAT;
    __device__ __forceinline__ void operator()(const f32x4 (&acc)[2][2][4][2], int gb, int pm, int pn, int wr, int wc, int fr, int fq) const {
        EPI_LOOP({ const int col = pn * 256 + ct; const u32x2 y = *(const u32x2*)(YG + (size_t)row * 512 + col);
            u32x2 w; w.x = pk2(bflo(y.x) * sigmoidf_(v[0]), bfhi(y.x) * sigmoidf_(v[1])); w.y = pk2(bflo(y.y) * sigmoidf_(v[2]), bfhi(y.y) * sigmoidf_(v[3]));
            *(u32x2*)(CAT + (size_t)row * 1024 + col) = w; })
    }
};
struct EpiRes {
    const float* res; float* out; const float* gate;
    __device__ __forceinline__ void operator()(const f32x4 (&acc)[2][2][4][2], int gb, int pm, int pn, int wr, int wc, int fr, int fq) const {
        const float* gatep = gate + (size_t)(pm >> 4) * 6144;
        EPI_LOOP({ const int col = pn * 256 + ct; const f32x4 g = *(const f32x4*)(gatep + col); const f32x4 r = *(const f32x4*)(res + (size_t)row * 1024 + col);
            *(f32x4*)(out + (size_t)row * 1024 + col) = r + g * v; })
    }
};
struct EpiSwiglu {
    bf16_t* HID;
    __device__ __forceinline__ void operator()(const f32x4 (&acc)[2][2][4][2], int gb, int pm, int pn, int wr, int wc, int fr, int fq) const {
#pragma unroll
        for (int ai = 0; ai < 2; ++ai)
#pragma unroll
            for (int m = 0; m < 4; ++m) { const int row = pm * 256 + ai * 128 + wr * 64 + m * 16 + fr;
#pragma unroll
                for (int n = 0; n < 2; ++n) { const f32x4 g = acc[ai][0][m][n], u = acc[ai][1][m][n]; float o[4];
#pragma unroll
                    for (int j = 0; j < 4; ++j) o[j] = g[j] * sigmoidf_(g[j]) * u[j];
                    u32x2 w; w.x = pk2(o[0], o[1]); w.y = pk2(o[2], o[3]);
                    *(u32x2*)(HID + (size_t)row * FF + pn * 128 + wc * 32 + n * 16 + fq * 4) = w; } }
    }
};
struct EpiG1 {
    bf16_t* RKV; bf16_t* L1;
    __device__ __forceinline__ void operator()(const f32x4 (&acc)[2][2][4][2], int gb, int pm, int pn, int wr, int wc, int fr, int fq) const {
        if (pn < 12) { bf16_t* base = RKV + (size_t)(pn >> 2) * ((size_t)MTOK * 1024) + (pn & 3) * 256;
            EPI_LOOP({ u32x2 w; w.x = pk2(v[0], v[1]); w.y = pk2(v[2], v[3]); *(u32x2*)(base + (size_t)row * 1024 + ct) = w; }) }
        else { EPI_LOOP({ float o[4];
                _Pragma("unroll") for (int j = 0; j < 4; ++j) o[j] = (bj == 1) ? sigmoidf_(v[j]) : ((wc < 2) ? tanhf(v[j]) : v[j]);
                u32x2 w; w.x = pk2(o[0], o[1]); w.y = pk2(o[2], o[3]); *(u32x2*)(L1 + (size_t)row * 256 + ct) = w; }) }
    }
};
struct EpiL2 {
    _Float16* DEC; bf16_t* AA; bf16_t* G; const float* w0; const float* a0;
    __device__ __forceinline__ void operator()(const f32x4 (&acc)[2][2][4][2], int gb, int pm, int pn, int wr, int wc, int fr, int fq) const {
        const int sel = pn >> 2, cb = (pn & 3) * 256;
        if (sel == 0) { EPI_LOOP({ const int col = cb + ct; const f32x4 w0v = *(const f32x4*)(w0 + col);
                _Pragma("unroll") for (int j = 0; j < 4; ++j) { const float z = w0v[j] + v[j]; const float sp = fmaxf(-z, 0.f) + log1pf(expf(-fabsf(z))); const float e = expf(-sp - 0.5f);
                    DEC[(size_t)row * 1024 + col + j] = (_Float16)(-expm1f(-e)); } }) }
        else if (sel == 1) { EPI_LOOP({ const int col = cb + ct; const f32x4 a0v = *(const f32x4*)(a0 + col);
                u32x2 w; w.x = pk2(sigmoidf_(a0v[0] + v[0]), sigmoidf_(a0v[1] + v[1])); w.y = pk2(sigmoidf_(a0v[2] + v[2]), sigmoidf_(a0v[3] + v[3]));
                *(u32x2*)(AA + (size_t)row * 1024 + col) = w; }) }
        else { EPI_LOOP({ const int col = cb + ct; u32x2 w; w.x = pk2(v[0], v[1]); w.y = pk2(v[2], v[3]); *(u32x2*)(G + (size_t)row * 1024 + col) = w; }) }
    }
};

__device__ __forceinline__ void s5_gen(const Params& p, bf16_t* BtY, bf16_t* BtZ, float* lds, int bid, int nb) {
    float* PWr = lds; float* PWi = lds + 33 * 64; float* BBr = lds + 66 * 64; float* BBi = BBr + 1024; float* Cr = BBi + 1024; float* Ci = Cr + 1024; float* Kt = Ci + 1024;
    const int tid = threadIdx.x;
    for (int unit = bid; unit < 256; unit += nb) {
        const int g = unit >> 3, part = unit & 7;
        __syncthreads();
        if (tid < 64) { const int pp = tid; const float lr = p.in[11][g * 64 + pp], li = p.in[12][g * 64 + pp], dt = expf(p.in[13][g]);
            for (int tau = 0; tau <= 32; ++tau) { const float mag = expf(lr * dt * (float)tau), ang = li * dt * (float)tau; PWr[tau * 64 + pp] = mag * cosf(ang); PWi[tau * 64 + pp] = mag * sinf(ang); }
            const float ar = PWr[64 + pp], ai = PWi[64 + pp], den = lr * lr + li * li, nr = ar - 1.f;
            const float qr = (nr * lr + ai * li) / den, qi = (ai * lr - nr * li) / den;
            for (int h = 0; h < 16; ++h) { const float br = p.in[14][(size_t)(g * 64 + pp) * 16 + h], bi = p.in[15][(size_t)(g * 64 + pp) * 16 + h]; BBr[pp * 16 + h] = qr * br - qi * bi; BBi[pp * 16 + h] = qr * bi + qi * br; } }
        for (int i = tid; i < 1024; i += NTHR) { Cr[i] = p.in[16][(size_t)g * 1024 + i]; Ci[i] = p.in[17][(size_t)g * 1024 + i]; }
        __syncthreads();
        for (int e = tid; e < 8192; e += NTHR) { const int tau = e >> 8, h = (e >> 4) & 15, h2 = e & 15; float acc = 0.f;
            for (int pp = 0; pp < 64; ++pp) { const float cr = Cr[h * 64 + pp], ci = Ci[h * 64 + pp], wr = PWr[tau * 64 + pp], wi = PWi[tau * 64 + pp];
                const float er = cr * wr - ci * wi, ei = cr * wi + ci * wr; acc += er * BBr[pp * 16 + h2] - ei * BBi[pp * 16 + h2]; }
            Kt[e] = acc; }
        __syncthreads();
        for (int ci_ = tid; ci_ < 5120; ci_ += NTHR) { const int nrow = part * 64 + ci_ / 80, kc = (ci_ % 80) * 8, t = nrow >> 4, h = nrow & 15; float v[8];
#pragma unroll
            for (int i = 0; i < 8; ++i) { const int k = kc + i;
                if (k < 512) { const int sidx = k >> 4, h2 = k & 15; v[i] = (sidx <= t) ? Kt[(t - sidx) * 256 + h * 16 + h2] : 0.f; }
                else { const int jj = k - 512, pp = jj & 63; const float cr = Cr[h * 64 + pp], ci = Ci[h * 64 + pp], wr = PWr[(t + 1) * 64 + pp], wi = PWi[(t + 1) * 64 + pp];
                    v[i] = (jj >> 6) ? -(cr * wi + ci * wr) : (cr * wr - ci * wi); } }
            *(u32x4*)(BtY + ((size_t)g * 512 + nrow) * 640 + kc) = (u32x4){pk2(v[0], v[1]), pk2(v[2], v[3]), pk2(v[4], v[5]), pk2(v[6], v[7])}; }
        for (int ci_ = tid; ci_ < 1024; ci_ += NTHR) { const int n = part * 16 + (ci_ >> 6), kc = (ci_ & 63) * 8, pp = n & 63, im = n >> 6; float v[8];
#pragma unroll
            for (int i = 0; i < 8; ++i) { const int k = kc + i, sidx = k >> 4, h2 = k & 15, tau = 31 - sidx; const float wr = PWr[tau * 64 + pp], wi = PWi[tau * 64 + pp], br = BBr[pp * 16 + h2], bi = BBi[pp * 16 + h2];
                v[i] = im ? (wr * bi + wi * br) : (wr * br - wi * bi); }
            *(u32x4*)(BtZ + ((size_t)g * 256 + n) * 512 + kc) = (u32x4){pk2(v[0], v[1]), pk2(v[2], v[3]), pk2(v[4], v[5]), pk2(v[6], v[7])}; }
    }
    __syncthreads();
}

template <int MODE>
__device__ __forceinline__ void tr_job(const float* src, int K, int N, bf16_t* dst, int ldd, int row_off, int koff, const float* scale, float* lds, int bid, int nb) {
    const int tk = K / 64, tn = N / 64, tid = threadIdx.x, nt_ = tk * tn;
    const int r = tid >> 3, c = (tid & 7) * 8;
    float4 a = {0.f, 0.f, 0.f, 0.f}, b = a; float sc = 1.f;
    if (bid < nt_) { const int k0 = (bid / tn) * 64, n0 = (bid % tn) * 64; const float* p = src + (size_t)(k0 + r) * N + n0 + c; a = *(const float4*)p; b = *(const float4*)(p + 4); sc = scale ? scale[k0 + r] : 1.f; }
    for (int t = bid; t < nt_; t += nb) {
        const int k0 = (t / tn) * 64, n0 = (t % tn) * 64;
        { float* l = lds + r * 65 + c; l[0] = a.x * sc; l[1] = a.y * sc; l[2] = a.z * sc; l[3] = a.w * sc; l[4] = b.x * sc; l[5] = b.y * sc; l[6] = b.z * sc; l[7] = b.w * sc; }
        if (t + nb < nt_) { const int t2 = t + nb, k2 = (t2 / tn) * 64, n2 = (t2 % tn) * 64; const float* p = src + (size_t)(k2 + r) * N + n2 + c; a = *(const float4*)p; b = *(const float4*)(p + 4); sc = scale ? scale[k2 + r] : 1.f; }
        __syncthreads();
        { const int nl = tid >> 3, kc = (tid & 7) * 8; float v[8];
#pragma unroll
          for (int i = 0; i < 8; ++i) v[i] = lds[(kc + i) * 65 + nl];
          int n = n0 + nl; int rowi = n;
          if (MODE == 1) rowi = (n >> 7) * 256 + (n & 127);
          if (MODE == 2) rowi = (n >> 7) * 256 + 128 + (n & 127);
          u32x4 w; w.x = pk2(v[0], v[1]); w.y = pk2(v[2], v[3]); w.z = pk2(v[4], v[5]); w.w = pk2(v[6], v[7]);
          *(u32x4*)(dst + (size_t)(row_off + rowi) * ldd + koff + k0 + kc) = w; }
        __syncthreads();
    }
}

__device__ __forceinline__ void prep_phase(const Params& p, float* lds, int bid, int nb) {
    unsigned char* ws = p.ws;
    s5_gen(p, (bf16_t*)(ws + OFF_BTY), (bf16_t*)(ws + OFF_BTZ), lds, bid, nb);
    tr_job<0>(p.in[10], 1024, 2048, (bf16_t*)(ws + OFF_WIN), 1024, 0, 0, nullptr, lds, bid, nb);
    tr_job<0>(p.in[19], 512, 512, (bf16_t*)(ws + OFF_WGLU), 512, 0, 0, nullptr, lds, bid, nb);
    tr_job<0>(p.in[27], 1024, 1024, (bf16_t*)(ws + OFF_WOUT), 1024, 0, 0, nullptr, lds, bid, nb);
    for (int l = 0; l < 2; ++l) {
        bf16_t* gu = (bf16_t*)(ws + (l ? OFF_WGU1 : OFF_WGU0)); bf16_t* dn = (bf16_t*)(ws + (l ? OFF_WDN1 : OFF_WDN0));
        tr_job<1>(p.in[7] + (size_t)l * 1024 * FF, 1024, FF, gu, 1024, 0, 0, nullptr, lds, bid, nb);
        tr_job<2>(p.in[8] + (size_t)l * 1024 * FF, 1024, FF, gu, 1024, 0, 0, nullptr, lds, bid, nb);
        tr_job<0>(p.in[9] + (size_t)l * FF * 1024, FF, 1024, dn, FF, 0, 0, nullptr, lds, bid, nb);
    }
    bf16_t* g1 = (bf16_t*)(ws + OFF_WG1); const float* mu = p.in[28];
    tr_job<0>(p.in[29], 1024, 1024, g1, 2048, 0, 0, nullptr, lds, bid, nb);      tr_job<0>(p.in[29], 1024, 1024, g1, 2048, 0, 1024, mu + 0 * 1024, lds, bid, nb);
    tr_job<0>(p.in[30], 1024, 1024, g1, 2048, 1024, 0, nullptr, lds, bid, nb);   tr_job<0>(p.in[30], 1024, 1024, g1, 2048, 1024, 1024, mu + 2 * 1024, lds, bid, nb);
    tr_job<0>(p.in[31], 1024, 1024, g1, 2048, 2048, 0, nullptr, lds, bid, nb);   tr_job<0>(p.in[31], 1024, 1024, g1, 2048, 2048, 1024, mu + 3 * 1024, lds, bid, nb);
    tr_job<0>(p.in[34], 1024, 64, g1, 2048, 3072, 0, nullptr, lds, bid, nb);     tr_job<0>(p.in[34], 1024, 64, g1, 2048, 3072, 1024, mu + 1 * 1024, lds, bid, nb);
    tr_job<0>(p.in[37], 1024, 64, g1, 2048, 3136, 0, nullptr, lds, bid, nb);     tr_job<0>(p.in[37], 1024, 64, g1, 2048, 3136, 1024, mu + 4 * 1024, lds, bid, nb);
    tr_job<0>(p.in[39], 1024, 128, g1, 2048, 3200, 0, nullptr, lds, bid, nb);    tr_job<0>(p.in[39], 1024, 128, g1, 2048, 3200, 1024, mu + 5 * 1024, lds, bid, nb);
    bf16_t* l2 = (bf16_t*)(ws + OFF_WL2);
    tr_job<0>(p.in[35], 64, 1024, l2, 256, 0, 0, nullptr, lds, bid, nb);
    tr_job<0>(p.in[38], 64, 1024, l2, 256, 1024, 64, nullptr, lds, bid, nb);
    tr_job<0>(p.in[40], 128, 1024, l2, 256, 2048, 128, nullptr, lds, bid, nb);
    for (int i = bid * NTHR + threadIdx.x; i < 3072 * 32; i += nb * NTHR) { const int n = i >> 5, kc = (i & 31) * 8; const int sel = n >> 10;
        const bool used = (sel == 0) ? (kc < 64) : (sel == 1) ? (kc >= 64 && kc < 128) : (kc >= 128);
        if (!used) *(u32x4*)(l2 + (size_t)n * 256 + kc) = (u32x4){0u, 0u, 0u, 0u}; }
    tr_job<0>(p.in[32], 1024, 1024, (bf16_t*)(ws + OFF_WO), 1024, 0, 0, nullptr, lds, bid, nb);
    {   const float* c = p.in[1]; const float* wada = p.in[3]; const float* bada = p.in[4]; float* mod = (float*)(ws + OFF_MOD);
        float* cact = lds;
        float* red = lds + 4096;
        for (int i = threadIdx.x; i < 4096; i += NTHR) { const float x = c[i]; cact[i] = x / (1.f + expf(-x)); }
        __syncthreads();
        const int col = threadIdx.x & 63, kg = threadIdx.x >> 6;
        for (int ch = bid; ch < 192; ch += nb) {
            const int l = ch / 96, n0 = (ch % 96) * 64;
            const float* wp = wada + (size_t)l * 1024 * 6144 + n0 + col;
            float a0 = 0.f, a1 = 0.f, a2 = 0.f, a3 = 0.f;
            for (int k = kg * 128; k < kg * 128 + 128; ++k) { const float w = wp[(size_t)k * 6144]; a0 += cact[k] * w; a1 += cact[1024 + k] * w; a2 += cact[2048 + k] * w; a3 += cact[3072 + k] * w; }
            red[(kg * 4 + 0) * 64 + col] = a0; red[(kg * 4 + 1) * 64 + col] = a1; red[(kg * 4 + 2) * 64 + col] = a2; red[(kg * 4 + 3) * 64 + col] = a3;
            __syncthreads();
            if (threadIdx.x < 256) { const int b = threadIdx.x >> 6; float s = 0.f;
#pragma unroll
                for (int g = 0; g < 8; ++g) s += red[(g * 4 + b) * 64 + col];
                mod[(size_t)(l * 4 + b) * 6144 + n0 + col] = s + bada[l * 6144 + n0 + col]; }
            __syncthreads();
        }
    }
}

template <bool RW>
__device__ __forceinline__ void norm_phase(const float* x, const float* g, const float* modl, int shift_off, int scale_off, bf16_t* out, int bid, int nb) {
    const int wave = threadIdx.x >> 6, lane = threadIdx.x & 63;
    for (int row = bid * 8 + wave; row < MTOK; row += nb * 8) {
        const int b = row >> 12; const float* xr = x + (size_t)row * 1024; const float* md = modl + (size_t)b * 6144;
        f32x4 v[4], vp[4]; float ss = 0.f, ssp = 0.f; const bool hasp = RW && ((row & 4095) != 0);
#pragma unroll
        for (int i = 0; i < 4; ++i) { v[i] = *(const f32x4*)(xr + i * 256 + lane * 4); ss += v[i][0] * v[i][0] + v[i][1] * v[i][1] + v[i][2] * v[i][2] + v[i][3] * v[i][3];
            if (RW) { vp[i] = hasp ? *(const f32x4*)(xr - 1024 + i * 256 + lane * 4) : (f32x4){0.f, 0.f, 0.f, 0.f}; ssp += vp[i][0] * vp[i][0] + vp[i][1] * vp[i][1] + vp[i][2] * vp[i][2] + vp[i][3] * vp[i][3]; } }
        ss = wave_sum(ss); const float rstd = rsqrtf(ss * (1.f / 1024.f) + 1e-6f);
        float rstdp = 0.f; if (RW) { ssp = wave_sum(ssp); rstdp = rsqrtf(ssp * (1.f / 1024.f) + 1e-6f); }
#pragma unroll
        for (int i = 0; i < 4; ++i) { const int c = i * 256 + lane * 4; const f32x4 gg = *(const f32x4*)(g + c), sc = *(const f32x4*)(md + scale_off + c), sh = *(const f32x4*)(md + shift_off + c);
            f32x4 h;
#pragma unroll
            for (int j = 0; j < 4; ++j) h[j] = v[i][j] * rstd * gg[j] * (1.f + sc[j]) + sh[j];
            u32x2 w; w.x = pk2(h[0], h[1]); w.y = pk2(h[2], h[3]);
            if (!RW) *(u32x2*)(out + (size_t)row * 1024 + c) = w;
            else { *(u32x2*)(out + (size_t)row * 2048 + c) = w; f32x4 d;
#pragma unroll
                for (int j = 0; j < 4; ++j) { const float hp = hasp ? (vp[i][j] * rstdp * gg[j] * (1.f + sc[j]) + sh[j]) : 0.f; d[j] = hp - h[j]; }
                u32x2 w2; w2.x = pk2(d[0], d[1]); w2.y = pk2(d[2], d[3]); *(u32x2*)(out + (size_t)row * 2048 + 1024 + c) = w2; } }
    }
}

__device__ __forceinline__ void qknorm_phase(bf16_t* Q, bf16_t* Kb, const int* pos, const float* qn, const float* kn, int bid, int nb) {
    const int wave = threadIdx.x >> 6, lane = threadIdx.x & 63, l16 = lane & 15, d0 = l16 * 4;
    float invf[4];
#pragma unroll
    for (int j = 0; j < 4; ++j) invf[j] = powf(500000.f, -(float)((l16 & 1) * 4 + j) / 8.f);
    const f32x4 qw = *(const f32x4*)(qn + d0), kw = *(const f32x4*)(kn + d0);
    for (int tok = bid * 8 + wave; tok < MTOK; tok += nb * 8) {
        const float ps = (float)pos[tok];
        float cs[4], sn[4];
#pragma unroll
        for (int j = 0; j < 4; ++j) { const float ang = ps * invf[j]; cs[j] = cosf(ang); sn[j] = sinf(ang); }
#pragma unroll
        for (int bsel = 0; bsel < 2; ++bsel) { bf16_t* buf = bsel ? Kb : Q; const f32x4 w = bsel ? kw : qw;
#pragma unroll
            for (int it = 0; it < 2; ++it) { const int vec = it * 4 + (lane >> 4); bf16_t* ptr = buf + (size_t)tok * 512 + vec * 64 + d0;
                const u32x2 raw = *(const u32x2*)ptr; float y[4] = {bflo(raw.x), bfhi(raw.x), bflo(raw.y), bfhi(raw.y)};
                float ss = y[0] * y[0] + y[1] * y[1] + y[2] * y[2] + y[3] * y[3];
                ss += __shfl_xor(ss, 1); ss += __shfl_xor(ss, 2); ss += __shfl_xor(ss, 4); ss += __shfl_xor(ss, 8);
                const float rstd = rsqrtf(ss * (1.f / 64.f) + 1e-6f);
#pragma unroll
                for (int j = 0; j < 4; ++j) y[j] = y[j] * rstd * w[j];
                float pr[4];
#pragma unroll
                for (int j = 0; j < 4; ++j) pr[j] = __shfl_xor(y[j], 2);
                if (l16 < 2) {
#pragma unroll
                    for (int j = 0; j < 4; ++j) y[j] = y[j] * cs[j] - pr[j] * sn[j]; }
                else if (l16 < 4) {
#pragma unroll
                    for (int j = 0; j < 4; ++j) y[j] = y[j] * cs[j] + pr[j] * sn[j]; }
                if (!bsel) {
#pragma unroll
                    for (int j = 0; j < 4; ++j) y[j] *= 0.125f * 1.4426950408889634f; }
                u32x2 o; o.x = pk2(y[0], y[1]); o.y = pk2(y[2], y[3]); *(u32x2*)ptr = o; } }
    }
}

__device__ __forceinline__ void vtrans_phase(const bf16_t* V, bf16_t* Vt, bf16_t* lds, int bid, int nb) {
    const int tid = threadIdx.x;
    for (int unit = bid; unit < 1024; unit += nb) {
        const int head = unit & 3, ch = unit >> 2; const int b = ch >> 6, t0 = (ch & 63) * 64;
#pragma unroll
        for (int i = 0; i < 2; ++i) { const int idx = tid + i * 512, t = idx >> 4, cc = (idx & 15) * 8;
            const u32x4 w = *(const u32x4*)(V + ((size_t)b * SEQ + t0 + t) * 512 + head * 128 + cc);
            unsigned* d = (unsigned*)(lds + t * 130 + cc); d[0] = w.x; d[1] = w.y; d[2] = w.z; d[3] = w.w; }
        __syncthreads();
        { const int e = tid >> 2, tc = (tid & 3) * 16; unsigned o[8];
#pragma unroll
          for (int i = 0; i < 8; ++i) o[i] = (unsigned)lds[(tc + 2 * i) * 130 + e] | ((unsigned)lds[(tc + 2 * i + 1) * 130 + e] << 16);
          u32x4* dst = (u32x4*)(Vt + ((size_t)(b * 4 + head) * 128 + e) * SEQ + t0 + tc);
          dst[0] = (u32x4){o[0], o[1], o[2], o[3]}; dst[1] = (u32x4){o[4], o[5], o[6], o[7]}; }
        __syncthreads();
    }
}

typedef float f32x16 __attribute__((ext_vector_type(16)));
__device__ __forceinline__ void attn_phase(const bf16_t* Q, const bf16_t* Kb, const bf16_t* Vt, bf16_t* OC, LAS unsigned char* lds, int bid, int nb) {
    const int tid = threadIdx.x, wave = __builtin_amdgcn_readfirstlane(tid >> 6), lane = tid & 63, c = wave >> 2, wq = wave & 3, l32 = lane & 31, hh = lane >> 5;
    constexpr int KROW = 272, VROW = 72, KBUF = 32 * KROW, VBUF = 128 * VROW, VOFF = 2 * KBUF;
    const int lkey = tid >> 4, lkc = tid & 15, lve = tid >> 2, lvc = tid & 3;
    for (int unit = bid; unit < 256; unit += nb) {
        const int b = unit & 3, head = (unit >> 2) & 3, pr = unit >> 4;
        const bf16_t* kg = Kb + ((size_t)b * SEQ + lkey) * 512 + head * 128 + lkc * 8;
        const bf16_t* vg = Vt + ((size_t)(b * 4 + head) * 128 + lve) * SEQ + lvc * 8;
        for (int half = 0; half < 2; ++half) {
            const int qb = half ? (31 - pr) : pr; const int q0 = qb * 128 + wq * 32; const int ntile = (qb + 1) * 4;
            bf16x8 qf[4];
            { const bf16_t* qp = Q + ((size_t)b * SEQ + q0 + l32) * 512 + head * 128 + c * 64 + hh * 8;
#pragma unroll
              for (int ks = 0; ks < 4; ++ks) qf[ks] = *(const bf16x8*)(qp + ks * 16); }
            f32x16 o[4];
#pragma unroll
            for (int blk = 0; blk < 4; ++blk)
#pragma unroll
                for (int r = 0; r < 16; ++r) o[blk][r] = 0.f;
            float mrow = -INFINITY, lsum = 0.f;
            u32x4 kreg = *(const u32x4*)kg, vreg = *(const u32x4*)vg;
            __syncthreads();
            { *(LAS u32x4*)(lds + lkey * KROW + lkc * 16) = kreg;
              LAS u32x2* vd = (LAS u32x2*)(lds + VOFF + lve * VROW + lvc * 16); vd[0] = (u32x2){vreg.x, vreg.y}; vd[1] = (u32x2){vreg.z, vreg.w}; }
            __syncthreads();
            for (int kt = 0; kt < ntile; ++kt) {
                const int cur = kt & 1, key0 = kt * 32;
                if (kt + 1 < ntile) { kreg = *(const u32x4*)(kg + (size_t)(key0 + 32) * 512); vreg = *(const u32x4*)(vg + key0 + 32); }
                if (key0 <= q0) {
                    LAS unsigned char* kb = lds + cur * KBUF + l32 * KROW + c * 128 + hh * 16;
                    f32x16 sacc;
#pragma unroll
                    for (int r = 0; r < 16; ++r) sacc[r] = 0.f;
#pragma unroll
                    for (int ks = 0; ks < 4; ++ks) { const bf16x8 kf = *(const LAS bf16x8*)(kb + ks * 32); sacc = __builtin_amdgcn_mfma_f32_32x32x16_bf16(kf, qf[ks], sacc, 0, 0, 0); }
                    if (key0 == q0) {
#pragma unroll
                        for (int r = 0; r < 16; ++r) { const int kl = (r & 3) + 8 * (r >> 2) + 4 * hh; if (kl > l32) sacc[r] = -INFINITY; } }
                    float tm = sacc[0];
#pragma unroll
                    for (int r = 1; r < 16; ++r) tm = fmaxf(tm, sacc[r]);
                    tm = fmaxf(tm, __shfl_xor(tm, 32));
                    const float mnew = fmaxf(mrow, tm);
                    if (__any(mnew > mrow)) { const float al = exp2f(mrow - mnew); lsum *= al;
#pragma unroll
                        for (int blk = 0; blk < 4; ++blk)
#pragma unroll
                            for (int r = 0; r < 16; ++r) o[blk][r] *= al;
                        mrow = mnew; }
                    float ps = 0.f;
#pragma unroll
                    for (int r = 0; r < 16; ++r) { sacc[r] = exp2f(sacc[r] - mrow); ps += sacc[r]; }
                    lsum += ps;
                    LAS unsigned char* vb = lds + VOFF + cur * VBUF + l32 * VROW + hh * 8;
#pragma unroll
                    for (int s2 = 0; s2 < 2; ++s2) {
                        u32x4 pw; pw.x = cvt_pk_bf16(sacc[8 * s2 + 0], sacc[8 * s2 + 1]); pw.y = cvt_pk_bf16(sacc[8 * s2 + 2], sacc[8 * s2 + 3]); pw.z = cvt_pk_bf16(sacc[8 * s2 + 4], sacc[8 * s2 + 5]); pw.w = cvt_pk_bf16(sacc[8 * s2 + 6], sacc[8 * s2 + 7]);
                        const bf16x8 pb = __builtin_bit_cast(bf16x8, pw);
#pragma unroll
                        for (int blk = 0; blk < 4; ++blk) { const u32x2 v0 = *(const LAS u32x2*)(vb + blk * 32 * VROW + s2 * 32), v1 = *(const LAS u32x2*)(vb + blk * 32 * VROW + s2 * 32 + 16);
                            const bf16x8 vf = __builtin_bit_cast(bf16x8, (u32x4){v0.x, v0.y, v1.x, v1.y});
                            o[blk] = __builtin_amdgcn_mfma_f32_32x32x16_bf16(vf, pb, o[blk], 0, 0, 0); } }
                }
                if (kt + 1 < ntile) { const int nx = cur ^ 1;
                    *(LAS u32x4*)(lds + nx * KBUF + lkey * KROW + lkc * 16) = kreg;
                    LAS u32x2* vd = (LAS u32x2*)(lds + VOFF + nx * VBUF + lve * VROW + lvc * 16); vd[0] = (u32x2){vreg.x, vreg.y}; vd[1] = (u32x2){vreg.z, vreg.w}; }
                __syncthreads();
            }
            lsum += __shfl_xor(lsum, 32);
            const float inv = 1.f / lsum;
            bf16_t* op = OC + ((size_t)b * SEQ + q0 + l32) * 1024 + (head * 2 + c) * 128 + 4 * hh;
#pragma unroll
            for (int blk = 0; blk < 4; ++blk)
#pragma unroll
                for (int g4 = 0; g4 < 4; ++g4) { u32x2 w; w.x = pk2(o[blk][g4 * 4 + 0] * inv, o[blk][g4 * 4 + 1] * inv); w.y = pk2(o[blk][g4 * 4 + 2] * inv, o[blk][g4 * 4 + 3] * inv);
                    *(u32x2*)(op + blk * 32 + g4 * 8) = w; }
        }
    }
}

__device__ __forceinline__ void attn_combine(const bf16_t* OC, bf16_t* CAT, const Params& p, int bid, int nb) {
    const int wave = threadIdx.x >> 6, lane = threadIdx.x & 63, head = lane >> 4, e0 = (lane & 15) * 8;
    float lam;
    { float s1 = 0.f, s2 = 0.f; for (int d = 0; d < 64; ++d) { s1 += p.in[22][d] * p.in[23][d]; s2 += p.in[24][d] * p.in[25][d]; } lam = expf(s1) - expf(s2) + 0.2f; }
    float sub[8];
#pragma unroll
    for (int i = 0; i < 8; ++i) sub[i] = p.in[26][e0 + i] * 0.8f;
    for (int tok = bid * 8 + wave; tok < MTOK; tok += nb * 8) {
        const u32x4 a = *(const u32x4*)(OC + (size_t)tok * 1024 + (head * 2) * 128 + e0), bb = *(const u32x4*)(OC + (size_t)tok * 1024 + (head * 2 + 1) * 128 + e0);
        float o[8] = {bflo(a.x) - lam * bflo(bb.x), bfhi(a.x) - lam * bfhi(bb.x), bflo(a.y) - lam * bflo(bb.y), bfhi(a.y) - lam * bfhi(bb.y),
                      bflo(a.z) - lam * bflo(bb.z), bfhi(a.z) - lam * bfhi(bb.z), bflo(a.w) - lam * bflo(bb.w), bfhi(a.w) - lam * bfhi(bb.w)};
        float ss = 0.f;
#pragma unroll
        for (int i = 0; i < 8; ++i) ss += o[i] * o[i];
        ss += __shfl_xor(ss, 1); ss += __shfl_xor(ss, 2); ss += __shfl_xor(ss, 4); ss += __shfl_xor(ss, 8);
        const float rstd = rsqrtf(ss * (1.f / 128.f) + 1e-6f);
        u32x4 w; w.x = pk2(o[0] * rstd * sub[0], o[1] * rstd * sub[1]); w.y = pk2(o[2] * rstd * sub[2], o[3] * rstd * sub[3]); w.z = pk2(o[4] * rstd * sub[4], o[5] * rstd * sub[5]); w.w = pk2(o[6] * rstd * sub[6], o[7] * rstd * sub[7]);
        *(u32x4*)(CAT + (size_t)tok * 1024 + 512 + head * 128 + e0) = w;
    }
}

typedef float f32x2 __attribute__((ext_vector_type(2)));
__device__ __forceinline__ float h2f_(unsigned bits) { return (float)__builtin_bit_cast(_Float16, (unsigned short)bits); }
__device__ __forceinline__ void rwkv_phase(const Params& p, const bf16_t* R, const bf16_t* Kk, const bf16_t* Vv, const _Float16* DEC, const bf16_t* AA, bf16_t* Y, float* lds, int bid, int nb) {
    const int tid = threadIdx.x, wave = __builtin_amdgcn_readfirstlane(tid >> 6), lane = tid & 63;
    constexpr int TCH = 16, BUFF = 5 * TCH * 64 + TCH * 16;
    constexpr int OBUF = TCH * 16 * 16;
    float* Lout = lds + 2 * BUFF;
    for (int unit = bid; unit < 256; unit += nb) {
        const int b = unit >> 6, h = (unit >> 2) & 15, rq = unit & 3;
        __syncthreads();
        if (wave >= 4) {
            const int pw = wave - 4, tl = lane >> 4, c4 = (lane & 15) * 4;
            const f32x4 kkw = *(const f32x4*)(p.in[41] + h * 64 + c4), kaw = *(const f32x4*)(p.in[42] + h * 64 + c4);
            u32x2 rr[4], kr[4], ar[4], dr[4], vr[4];
            const unsigned lofs = (unsigned)((pw * 4 + tl) * 1024 + h * 64 + c4), vofs = (unsigned)((pw * 4 + tl) * 1024 + h * 64 + rq * 16 + (lane & 3) * 4);
            const bf16_t* Rb = R + (size_t)b * SEQ * 1024; const bf16_t* Kb_ = Kk + (size_t)b * SEQ * 1024; const bf16_t* Vb = Vv + (size_t)b * SEQ * 1024;
            const bf16_t* Ab = AA + (size_t)b * SEQ * 1024; const _Float16* Db = DEC + (size_t)b * SEQ * 1024;
#define RW_ISSUE(set, ch) do { const unsigned o_ = (unsigned)(ch) * (TCH * 1024) + lofs; rr[set] = *(const u32x2*)(Rb + o_); kr[set] = *(const u32x2*)(Kb_ + o_); dr[set] = *(const u32x2*)(Db + o_); ar[set] = *(const u32x2*)(Ab + o_); \
                    vr[set] = *(const u32x2*)(Vb + (unsigned)(ch) * (TCH * 1024) + vofs); } while (0)
#define RW_STAGE(set, buf) do { float* L = lds + (buf) * BUFF + (pw * 4 + tl) * 64 + c4; \
                    const f32x4 k = {bflo(kr[set].x), bfhi(kr[set].x), bflo(kr[set].y), bfhi(kr[set].y)}, a = {bflo(ar[set].x), bfhi(ar[set].x), bflo(ar[set].y), bfhi(ar[set].y)}; \
                    const f32x4 r = {bflo(rr[set].x), bfhi(rr[set].x), bflo(rr[set].y), bfhi(rr[set].y)}; \
                    const f32x4 w = {1.f - h2f_(dr[set].x & 0xffffu), 1.f - h2f_(dr[set].x >> 16), 1.f - h2f_(dr[set].y & 0xffffu), 1.f - h2f_(dr[set].y >> 16)}; \
                    f32x4 kk = k * kkw; const float n2 = dpp_sum16((kk[0] * kk[0] + kk[1] * kk[1]) + (kk[2] * kk[2] + kk[3] * kk[3])); kk = kk * (1.f / fmaxf(sqrtf(n2), 1e-12f)); \
                    *(f32x4*)(L) = w; *(f32x4*)(L + 1 * TCH * 64) = -kk; *(f32x4*)(L + 2 * TCH * 64) = kk * a; *(f32x4*)(L + 3 * TCH * 64) = k * (1.f + (a - 1.f) * kaw); *(f32x4*)(L + 4 * TCH * 64) = r; \
                    if ((lane & 15) < 4) *(f32x4*)(lds + (buf) * BUFF + 5 * TCH * 64 + (pw * 4 + tl) * 16 + (lane & 3) * 4) = (f32x4){bflo(vr[set].x), bfhi(vr[set].x), bflo(vr[set].y), bfhi(vr[set].y)}; } while (0)
            auto flush = [&](int ch) { const int i = tid - 256, tt = i >> 4, row = i & 15; const f32x4* pp = (const f32x4*)(Lout + (ch & 1) * OBUF + i * 16);
                const f32x4 s4 = pp[0] + pp[1] + pp[2] + pp[3];
                Y[((size_t)b * SEQ + ch * TCH + tt) * 1024 + h * 64 + rq * 16 + row] = (bf16_t)f2bf((s4[0] + s4[1]) + (s4[2] + s4[3])); };
            constexpr int NCH = SEQ / TCH;
            RW_ISSUE(0, 0); RW_ISSUE(1, 1); RW_ISSUE(2, 2); RW_ISSUE(3, 3);
            RW_STAGE(0, 0);
            __syncthreads();
            for (int c4_ = 0; c4_ < NCH; c4_ += 4) {
#define RW_ITER(q) do { const int ch = c4_ + (q); RW_STAGE(((q) + 1) & 3, (ch + 1) & 1); { const int chn = (ch + 4 < NCH) ? ch + 4 : NCH - 1; RW_ISSUE((q), chn); } flush(ch > 0 ? ch - 1 : 0); __syncthreads(); } while (0)
                RW_ITER(0); RW_ITER(1); RW_ITER(2); RW_ITER(3);
            }
            flush(NCH - 1);
        } else {
            const int j = lane & 15, rowl = wave * 4 + (lane >> 4);
            f32x2 S01 = {0.f, 0.f}, S23 = {0.f, 0.f};
            __syncthreads();
            for (int ch = 0; ch < SEQ / TCH; ++ch) {
                const float* L = lds + (ch & 1) * BUFF + j * 4; const float* Lv = lds + (ch & 1) * BUFF + 5 * TCH * 64 + rowl; float* Lo = Lout + (ch & 1) * OBUF + rowl * 16 + j;
                f32x4 w4 = *(const f32x4*)(L), a4 = *(const f32x4*)(L + 1 * TCH * 64), b4 = *(const f32x4*)(L + 2 * TCH * 64), k4 = *(const f32x4*)(L + 3 * TCH * 64), r4 = *(const f32x4*)(L + 4 * TCH * 64);
                float vv = Lv[0];
#pragma unroll
                for (int tt = 0; tt < TCH; ++tt) {
                    f32x4 nw4 = w4, na4 = a4, nb4 = b4, nk4 = k4, nr4 = r4; float nvv = vv;
                    if (tt + 1 < TCH) { const float* Ln = L + (tt + 1) * 64; nw4 = *(const f32x4*)(Ln); na4 = *(const f32x4*)(Ln + 1 * TCH * 64); nb4 = *(const f32x4*)(Ln + 2 * TCH * 64); nk4 = *(const f32x4*)(Ln + 3 * TCH * 64); nr4 = *(const f32x4*)(Ln + 4 * TCH * 64); nvv = Lv[(tt + 1) * 16]; }
                    f32x2 d = S01 * (f32x2){a4[0], a4[1]}; d = S23 * (f32x2){a4[2], a4[3]} + d;
                    const float sa = dpp_sum16(d[0] + d[1]);
                    const f32x2 sa2 = {sa, sa}, v2 = {vv, vv};
                    const f32x2 t01 = sa2 * (f32x2){b4[0], b4[1]} + v2 * (f32x2){k4[0], k4[1]}, t23 = sa2 * (f32x2){b4[2], b4[3]} + v2 * (f32x2){k4[2], k4[3]};
                    S01 = S01 * (f32x2){w4[0], w4[1]} + t01; S23 = S23 * (f32x2){w4[2], w4[3]} + t23;
                    f32x2 y = S01 * (f32x2){r4[0], r4[1]}; y = S23 * (f32x2){r4[2], r4[3]} + y;
                    Lo[tt * 256] = y[0] + y[1];
                    w4 = nw4; a4 = na4; b4 = nb4; k4 = nk4; r4 = nr4; vv = nvv;
                }
                __syncthreads();
            }
        }
    }
}

__device__ __forceinline__ void rwkv_post(const Params& p, bf16_t* R, const bf16_t* Kk, const bf16_t* Vv, const bf16_t* AA, const bf16_t* G, const bf16_t* Y, int bid, int nb) {
    const int wave = threadIdx.x >> 6, lane = threadIdx.x & 63;
    for (int it = bid * 8 + wave; it < MTOK * 16; it += nb * 8) {
        const int h = it & 15; const size_t off = (size_t)(it >> 4) * 1024 + h * 64 + lane;
        const float y = bf2f(Y[off]), r = bf2f(R[off]), k = bf2f(Kk[off]), v = bf2f(Vv[off]), a = bf2f(AA[off]), g = bf2f(G[off]);
        const float mean = wave_sum(y) * (1.f / 64.f); const float d = y - mean; const float var = wave_sum(d * d) * (1.f / 64.f);
        const float k2 = k * (1.f + (a - 1.f) * p.in[42][h * 64 + lane]);
        const float sb = wave_sum(r * k2 * p.in[43][h * 64 + lane]);
        const float yn = d * rsqrtf(var + 64e-5f) * p.in[44][h * 64 + lane] + p.in[45][h * 64 + lane] + sb * v;
        R[off] = (bf16_t)f2bf(yn * g);
    }
}

#define XB_TMO      128
#define XB_XCNT(j)  (256  + 64 * (j))
#define XB_XSUB(j)  (1280 + 64 * (j))
#define XB_XGEN(j)  (2304 + 64 * (j))
#define XB_TOP      3328
#define XB_TOPGEN   3392
#define XCD_BAR_WORDS 3456
#define XB_SPIN_CAP (1u << 18)
__device__ __forceinline__ unsigned xb_ld(unsigned* p)              { return __hip_atomic_load(p, __ATOMIC_RELAXED, __HIP_MEMORY_SCOPE_AGENT); }
__device__ __forceinline__ unsigned xb_add(unsigned* p, unsigned v) { return __hip_atomic_fetch_add(p, v, __ATOMIC_RELAXED, __HIP_MEMORY_SCOPE_AGENT); }
__device__ __forceinline__ unsigned xb_xcc_id() { return (unsigned)__builtin_amdgcn_s_getreg((3 << 11) | 20) & 0xFu; }
#define XB_SPIN(cond, bar) do { unsigned _sp = 0; while (cond) { __builtin_amdgcn_s_sleep(1); \
    if ((++_sp & 255u) == 0u) { if (xb_ld(&(bar)[XB_TMO])) break; if (_sp > XB_SPIN_CAP) { atomicAdd(&(bar)[XB_TMO], 1u); break; } } } } while (0)
struct XcdBarrier { unsigned* bar; unsigned x; volatile LAS unsigned* st; };
__device__ __forceinline__ XcdBarrier xcd_barrier_post(unsigned* bar, volatile LAS unsigned* st) {
    XcdBarrier b; b.bar = bar; b.x = xb_xcc_id(); b.st = st;
    if (threadIdx.x == 0) (void)xb_add(&bar[XB_XCNT(b.x)], 1u);
    return b;
}
__device__ __forceinline__ void xcd_barrier_complete(unsigned* bar, unsigned x, unsigned& nloc, unsigned& nx) {
    const unsigned G = gridDim.x * gridDim.y * gridDim.z;
    unsigned sum, cnt, mine, sp = 0u;
    for (;;) {
        sum = 0u; cnt = 0u; mine = 0u;
#pragma unroll
        for (unsigned j = 0; j < 16; ++j) { const unsigned c = xb_ld(&bar[XB_XCNT(j)]); sum += c; cnt += (c > 0u) ? 1u : 0u; mine = (j == x) ? c : mine; }
        if (sum == G) break;
        __builtin_amdgcn_s_sleep(1);
        if ((++sp & 255u) == 0u) { if (xb_ld(&bar[XB_TMO])) break; if (sp > XB_SPIN_CAP) { atomicAdd(&bar[XB_TMO], 1u); break; } }
    }
    nloc = mine > 0u ? mine : 1u; nx = cnt > 0u ? cnt : 1u;
}
__device__ __forceinline__ void xcd_barrier(const XcdBarrier& b) {
    asm volatile("s_waitcnt vmcnt(0)" ::: "memory");
    __syncthreads();
    if (threadIdx.x == 0) {
        unsigned* bar = b.bar;
        __builtin_amdgcn_s_waitcnt(0);
        unsigned nloc = b.st[0], nx = b.st[1];
        if (nloc == 0u) { xcd_barrier_complete(bar, b.x, nloc, nx); b.st[0] = nloc; b.st[1] = nx; }
        const unsigned old = xb_add(&bar[XB_XSUB(b.x)], 1u);
        const unsigned gen = old / nloc;
        if (old + 1u == (gen + 1u) * nloc) {
            __builtin_amdgcn_fence(__ATOMIC_RELEASE, "agent");
            asm volatile("s_waitcnt vmcnt(0)" ::: "memory");
            const unsigned og = xb_add(&bar[XB_TOP], 1u);
            const unsigned tg = og / nx;
            if (og + 1u == (tg + 1u) * nx) xb_add(&bar[XB_TOPGEN], 1u);
            else XB_SPIN(xb_ld(&bar[XB_TOPGEN]) == tg, bar);
            __builtin_amdgcn_fence(__ATOMIC_ACQUIRE, "agent");
            xb_add(&bar[XB_XGEN(b.x)], 1u);
            asm volatile("s_waitcnt vmcnt(0)" ::: "memory");
        } else {
            XB_SPIN(xb_ld(&bar[XB_XGEN(b.x)]) == gen, bar);
            __builtin_amdgcn_fence(__ATOMIC_ACQUIRE, "agent");
            asm volatile("s_waitcnt vmcnt(0)" ::: "memory");
        }
    }
    __syncthreads();
}

__global__ void __launch_bounds__(NTHR) fwd_kernel(Params p) {
    extern __shared__ __attribute__((aligned(16))) unsigned char lds_raw[];
    LAS unsigned char* lds = (LAS unsigned char*)lds_raw;
    float* ldsf = (float*)lds_raw;
    const int bid = blockIdx.x, nb = gridDim.x;
    unsigned char* ws = p.ws;
    float* mod = (float*)(ws + OFF_MOD);
    const bool multi = (p.ph_hi - p.ph_lo) > 1;
    __shared__ unsigned xb_st[4];
    if (threadIdx.x < 4) xb_st[threadIdx.x] = 0u;
    __syncthreads();
    XcdBarrier xbar; xbar.bar = (unsigned*)(ws + OFF_BAR); xbar.x = 0; xbar.st = (volatile LAS unsigned*)xb_st;
    if (multi) xbar = xcd_barrier_post((unsigned*)(ws + OFF_BAR), (volatile LAS unsigned*)xb_st);
#ifndef TESTPH
#define TESTPH -1
#endif
#ifndef REPEAT_A
#define REPEAT_A -1
#endif
#ifndef REPEAT_B
#define REPEAT_B -1
#endif
#ifndef EXTRA_SYNCS
#define EXTRA_SYNCS 0
#endif
#define PH(k) if ((TESTPH < 0 || TESTPH == (k)) && p.ph_lo <= (k) && (k) < p.ph_hi) for (int rep_ = 0; rep_ < (((k) == REPEAT_A || (k) == REPEAT_B) ? 2 : 1); ++rep_)
#define SYNC(k) if (multi && (k) + 1 < p.ph_hi) { xcd_barrier(xbar); }
    for (int es_ = 0; es_ < EXTRA_SYNCS; ++es_) cg::this_grid().sync();
    if (p.ph_lo < -1000) cg::this_grid().sync();
    PH(0) { prep_phase(p, ldsf, bid, nb); SYNC(0) }
    PH(1) { norm_phase<false>(p.in[0], p.in[5], mod, 0, 1024, (bf16_t*)(ws + OFF_HA), bid, nb); SYNC(1) }
    PH(2) { EpiWin e{(bf16_t*)(ws + OFF_UX), (bf16_t*)(ws + OFF_QKV)}; gemm_phase(lds, (const bf16_t*)(ws + OFF_HA), (const bf16_t*)(ws + OFF_WIN), 2048, 1024, e, bid, nb); SYNC(2) }
    PH(3) { { EpiS5Z e{(float*)(ws + OFF_Z)}; gemm_batched(lds, (const bf16_t*)(ws + OFF_UX), 640, (size_t)512 * 640, (const bf16_t*)(ws + OFF_BTZ), (size_t)256 * 512, 2, 1, 32, 512, e, NoPre{}, bid, nb); }
            bf16_t* q = (bf16_t*)(ws + OFF_QKV); qknorm_phase(q, q + (size_t)MTOK * 512, (const int*)p.in[2], p.in[20], p.in[21], bid, nb);
            vtrans_phase(q + (size_t)MTOK * 1024, (bf16_t*)(ws + OFF_VT), (bf16_t*)lds_raw, bid, nb); SYNC(3) }
    PH(5) { { EpiS5Y e{(const bf16_t*)(ws + OFF_UX), (bf16_t*)(ws + OFF_YG), p.in[18]}; PreS5Y pre{(const float*)(ws + OFF_Z), (bf16_t*)(ws + OFF_UX), p.in[11], p.in[12], p.in[13]};
              gemm_batched(lds, (const bf16_t*)(ws + OFF_UX), 640, (size_t)512 * 640, (const bf16_t*)(ws + OFF_BTY), (size_t)512 * 640, 2, 2, 32, 640, e, pre, bid, nb); }
            bf16_t* q = (bf16_t*)(ws + OFF_QKV); attn_phase(q, q + (size_t)MTOK * 512, (const bf16_t*)(ws + OFF_VT), (bf16_t*)(ws + OFF_OC), lds, bid, nb); SYNC(5) }
    PH(6) { attn_combine((const bf16_t*)(ws + OFF_OC), (bf16_t*)(ws + OFF_CAT), p, bid, nb);
            EpiGlu e{(const bf16_t*)(ws + OFF_YG), (bf16_t*)(ws + OFF_CAT)}; gemm_phase(lds, (const bf16_t*)(ws + OFF_YG), (const bf16_t*)(ws + OFF_WGLU), 512, 512, e, bid, nb); SYNC(6) }
    PH(7) { EpiRes e{p.in[0], p.out, mod + 2048}; gemm_phase(lds, (const bf16_t*)(ws + OFF_CAT), (const bf16_t*)(ws + OFF_WOUT), 1024, 1024, e, bid, nb); SYNC(7) }
    PH(8) { norm_phase<false>(p.out, p.in[6], mod, 3072, 4096, (bf16_t*)(ws + OFF_HA), bid, nb); SYNC(8) }
    PH(9) { EpiSwiglu e{(bf16_t*)(ws + OFF_HID)}; gemm_phase(lds, (const bf16_t*)(ws + OFF_HA), (const bf16_t*)(ws + OFF_WGU0), 5632, 1024, e, bid, nb); SYNC(9) }
    PH(10) { EpiRes e{p.out, p.out, mod + 5120}; gemm_phase(lds, (const bf16_t*)(ws + OFF_HID), (const bf16_t*)(ws + OFF_WDN0), 1024, FF, e, bid, nb); SYNC(10) }
    const float* mod1 = mod + 4 * 6144;
    PH(11) { norm_phase<true>(p.out, p.in[5] + 1024, mod1, 0, 1024, (bf16_t*)(ws + OFF_HD), bid, nb); SYNC(11) }
    PH(12) { EpiG1 e{(bf16_t*)(ws + OFF_RKV), (bf16_t*)(ws + OFF_L1)}; gemm_phase(lds, (const bf16_t*)(ws + OFF_HD), (const bf16_t*)(ws + OFF_WG1), 3328, 2048, e, bid, nb); SYNC(12) }
    PH(13) { EpiL2 e{(_Float16*)(ws + OFF_DEC), (bf16_t*)(ws + OFF_AA), (bf16_t*)(ws + OFF_G), p.in[33], p.in[36]}; gemm_phase(lds, (const bf16_t*)(ws + OFF_L1), (const bf16_t*)(ws + OFF_WL2), 3072, 256, e, bid, nb); SYNC(13) }
    PH(14) { const bf16_t* r = (const bf16_t*)(ws + OFF_RKV); rwkv_phase(p, r, r + (size_t)MTOK * 1024, r + (size_t)MTOK * 2048, (const _Float16*)(ws + OFF_DEC), (const bf16_t*)(ws + OFF_AA), (bf16_t*)(ws + OFF_Y), ldsf, bid, nb); SYNC(14) }
    PH(15) { bf16_t* r = (bf16_t*)(ws + OFF_RKV); rwkv_post(p, r, r + (size_t)MTOK * 1024, r + (size_t)MTOK * 2048, (const bf16_t*)(ws + OFF_AA), (const bf16_t*)(ws + OFF_G), (const bf16_t*)(ws + OFF_Y), bid, nb); SYNC(15) }
    PH(16) { EpiRes e{p.out, p.out, mod1 + 2048}; gemm_phase(lds, (const bf16_t*)(ws + OFF_RKV), (const bf16_t*)(ws + OFF_WO), 1024, 1024, e, bid, nb); SYNC(16) }
    PH(17) { norm_phase<false>(p.out, p.in[6] + 1024, mod1, 3072, 4096, (bf16_t*)(ws + OFF_HA), bid, nb); SYNC(17) }
    PH(18) { EpiSwiglu e{(bf16_t*)(ws + OFF_HID)}; gemm_phase(lds, (const bf16_t*)(ws + OFF_HA), (const bf16_t*)(ws + OFF_WGU1), 5632, 1024, e, bid, nb); SYNC(18) }
    PH(19) { EpiRes e{p.out, p.out, mod1 + 5120}; gemm_phase(lds, (const bf16_t*)(ws + OFF_HID), (const bf16_t*)(ws + OFF_WDN1), 1024, FF, e, bid, nb); }
}

constexpr int NPHASE = 20;
#ifndef ONE_LAUNCH
#define ONE_LAUNCH 1
#endif

extern "C" void kernel_launch(void* const* d_in, const int* in_sizes, int n_in, void* d_out, int out_size, void* d_ws, size_t ws_size, hipStream_t stream) {
    static int grid = 0;
    if (grid == 0) {
        if (n_in != 46 || ws_size < WS_NEED) { fprintf(stderr, "kernel_launch: unexpected n_in %d / ws_size %zu (need %zu)\n", n_in, ws_size, (size_t)WS_NEED); grid = -1; return; }
        if (hipFuncSetAttribute((const void*)fwd_kernel, hipFuncAttributeMaxDynamicSharedMemorySize, LDS_BYTES) != hipSuccess) { fprintf(stderr, "hipFuncSetAttribute failed\n"); grid = -1; return; }
        int dev = 0, cus = 0, per_cu = 0;
        (void)hipGetDevice(&dev); (void)hipDeviceGetAttribute(&cus, hipDeviceAttributeMultiprocessorCount, dev);
        (void)hipOccupancyMaxActiveBlocksPerMultiprocessor(&per_cu, (const void*)fwd_kernel, NTHR, LDS_BYTES);
        if (per_cu < 1) per_cu = 1;
        grid = cus;
    }
    if (grid < 0) return;
    Params p{};
    for (int i = 0; i < 46; ++i) p.in[i] = (const float*)d_in[i];
    p.out = (float*)d_out; p.ws = (unsigned char*)d_ws;
#if ONE_LAUNCH
    p.ph_lo = 0; p.ph_hi = NPHASE;
    if (hipMemsetAsync((char*)d_ws + OFF_BAR, 0, XCD_BAR_WORDS * 4, stream) != hipSuccess) { fprintf(stderr, "memset failed\n"); return; }
    void* args[] = {&p};
    hipError_t e = hipLaunchCooperativeKernel((const void*)fwd_kernel, dim3(grid), dim3(NTHR), args, LDS_BYTES, stream);
    if (e != hipSuccess) fprintf(stderr, "cooperative launch failed: %s (grid %d)\n", hipGetErrorString(e), grid);
#else
    for (int ph = 0; ph < NPHASE; ++ph) { p.ph_lo = ph; p.ph_hi = ph + 1; hipLaunchKernelGGL(fwd_kernel, dim3(grid), dim3(NTHR), LDS_BYTES, stream, p); }
#endif
}
```

```cpp
#include <hip/hip_runtime.h>
#include <hip/hip_cooperative_groups.h>
#include <cstdio>
#include <cstdint>
namespace cg = cooperative_groups;

#define LAS __attribute__((address_space(3)))
typedef unsigned short bf16_t;
typedef short bf16x8 __attribute__((ext_vector_type(8)));
typedef float f32x4 __attribute__((ext_vector_type(4)));
typedef unsigned u32x2 __attribute__((ext_vector_type(2)));
typedef unsigned u32x4 __attribute__((ext_vector_type(4)));

constexpr int MTOK = 16384, DM = 1024, SEQ = 4096, FF = 2816;
constexpr int NTHR = 512;
constexpr int LDS_BYTES = 131072;
constexpr size_t MiB = 1048576;
constexpr size_t OFF_WIN = 0;
constexpr size_t OFF_WGLU = 4194304;
constexpr size_t OFF_WOUT = 4718592;
constexpr size_t OFF_WGU0 = 6815744;
constexpr size_t OFF_WDN0 = 18350080;
constexpr size_t OFF_WGU1 = 39321600;
constexpr size_t OFF_WDN1 = 50855936;
constexpr size_t OFF_WG1 = 24117248;
constexpr size_t OFF_WL2 = 37748736;
constexpr size_t OFF_WO = 56623104;
constexpr size_t OFF_MOD = 58720256;
constexpr size_t OFF_BAR = 58916864;
constexpr size_t ACT = 57 * MiB;
constexpr size_t OFF_HA = ACT;
constexpr size_t OFF_UX = ACT + 32 * MiB;
constexpr size_t OFF_Z = ACT + 52 * MiB;
constexpr size_t OFF_BTZ = ACT + 112 * MiB;
constexpr size_t OFF_BTY = ACT + 176 * MiB;
constexpr size_t OFF_QKV = ACT + 64 * MiB;
constexpr size_t OFF_CAT = ACT + 112 * MiB;
constexpr size_t OFF_YG = ACT + 144 * MiB;
constexpr size_t OFF_VT = ACT + 160 * MiB;
constexpr size_t OFF_OC = ACT;
constexpr size_t OFF_HID = ACT + 32 * MiB;
constexpr size_t OFF_HD = ACT;
constexpr size_t OFF_RKV = ACT + 64 * MiB;
constexpr size_t OFF_G = ACT + 160 * MiB;
constexpr size_t OFF_Y = 0;
constexpr size_t OFF_L1 = 0;
constexpr size_t OFF_DEC = ACT;
constexpr size_t OFF_AA = ACT + 32 * MiB;
constexpr size_t WS_NEED = ACT + 196 * MiB;

struct Params {
    const float* in[46];
    float* out;
    unsigned char* ws;
    int ph_lo, ph_hi;
};

__device__ __forceinline__ unsigned f2bf(float f) { unsigned u = __float_as_uint(f); return (u + 0x7fffu + ((u >> 16) & 1u)) >> 16; }
__device__ __forceinline__ float bf2f(unsigned h) { return __uint_as_float(h << 16); }
__device__ __forceinline__ unsigned cvt_pk_bf16(float lo, float hi) { unsigned r; asm("v_cvt_pk_bf16_f32 %0, %1, %2" : "=v"(r) : "v"(lo), "v"(hi)); return r; }
__device__ __forceinline__ unsigned pk2(float lo, float hi) { return cvt_pk_bf16(lo, hi); }
__device__ __forceinline__ float bflo(unsigned w) { return __uint_as_float(w << 16); }
__device__ __forceinline__ float bfhi(unsigned w) { return __uint_as_float(w & 0xffff0000u); }
__device__ __forceinline__ float dpp_sum16(float x) {
    x += __int_as_float(__builtin_amdgcn_update_dpp(0, __float_as_int(x), 0xB1, 0xf, 0xf, true));
    x += __int_as_float(__builtin_amdgcn_update_dpp(0, __float_as_int(x), 0x4E, 0xf, 0xf, true));
    x += __int_as_float(__builtin_amdgcn_update_dpp(0, __float_as_int(x), 0x141, 0xf, 0xf, true));
    x += __int_as_float(__builtin_amdgcn_update_dpp(0, __float_as_int(x), 0x140, 0xf, 0xf, true));
    return x;
}
__device__ __forceinline__ float wave_sum(float v) {
    v = dpp_sum16(v);
    const float s0 = __int_as_float(__builtin_amdgcn_readlane(__float_as_int(v), 0)), s1 = __int_as_float(__builtin_amdgcn_readlane(__float_as_int(v), 16));
    const float s2 = __int_as_float(__builtin_amdgcn_readlane(__float_as_int(v), 32)), s3 = __int_as_float(__builtin_amdgcn_readlane(__float_as_int(v), 48));
    return (s0 + s1) + (s2 + s3);
}
__device__ __forceinline__ float sigmoidf_(float x) { return 1.f / (1.f + __expf(-x)); }
#define LWAIT() asm volatile("s_waitcnt lgkmcnt(0)" ::: "memory")
__device__ __forceinline__ float gelu_tanh(float x) { const float t = tanhf(0.7978845608028654f * (x + 0.044715f * x * x * x)); return 0.5f * x * (1.f + t); }

constexpr int HTB = 128 * 64 * 2;
__device__ __forceinline__ int lds_byte(int r, int c) { int st = (r >> 4) * 2 + (c >> 5), rr = r & 15, cc = c & 31, ob = rr * 64 + cc * 2; return st * 1024 + (ob ^ (((ob >> 9) & 1) << 5)); }
__device__ __forceinline__ void stage_rc(int b, int& R, int& C) { int st = b / 1024, sb = b % 1024, swz = sb ^ (((sb >> 9) & 1) << 5); R = (st >> 1) * 16 + swz / 64; C = (st & 1) * 32 + (swz % 64) / 2; }

struct NoPre { static constexpr bool NOP = true; __device__ __forceinline__ void operator()(int, int, int) const {} };
template <class Epi, class Pre>
__device__ __forceinline__ void gemm_batched(LAS unsigned char* lds, const bf16_t* A, int lda, size_t strideA, const bf16_t* Bt, size_t strideB, int nMt, int nNt, int nbatch, int K, const Epi& E, const Pre& PRE, int bid, int nb) {
    const int tid = threadIdx.x, wid = __builtin_amdgcn_readfirstlane(tid >> 6), lane = tid & 63, wr = wid >> 2, wc = wid & 3, fr = lane & 15, fq = lane >> 4;
    unsigned voffA[2], voffB[2];
#pragma unroll
    for (int i = 0; i < 2; ++i) { int R, C; stage_rc(tid * 16 + i * 8192, R, C); voffA[i] = (unsigned)(R * lda + C) * 2u; voffB[i] = (unsigned)(R * K + C) * 2u; }
    const int aoff = lds_byte(wr * 64 + fr, fq * 8), boff = lds_byte(wc * 32 + fr, fq * 8);
    const unsigned ldsw = (unsigned)wid * 1024u;
    const size_t kstep = 128, hstepA = (size_t)128 * lda * 2, hstepB = (size_t)128 * K * 2;
    const int nt = K / 64;
    const int ntiles = nMt * nNt * nbatch;
#define G_SA(b, h) (((b) * 2 + (h)) * HTB)
#define G_SB(b, h) ((4 + (b) * 2 + (h)) * HTB)
#define G_STAGEX(bufoff, gptr, vo) do { _Pragma("unroll") for (int _i = 0; _i < 2; ++_i) \
        __builtin_amdgcn_global_load_lds((const unsigned*)((gptr) + vo[_i]), (LAS unsigned*)(lds + (bufoff) + ldsw + _i * 8192), 16, 0, 0); } while (0)
#define G_STA(bufoff, gptr) G_STAGEX(bufoff, gptr, voffA)
#define G_STB(bufoff, gptr) G_STAGEX(bufoff, gptr, voffB)
#define G_LDA(dst, b, h) do { _Pragma("unroll") for (int m = 0; m < 4; ++m) _Pragma("unroll") for (int k = 0; k < 2; ++k) dst[m][k] = *(const LAS bf16x8*)(lds + G_SA(b, h) + aoff + m * 2048 + k * 1024); } while (0)
#define G_LDB(dst, b, h) do { _Pragma("unroll") for (int n = 0; n < 2; ++n) _Pragma("unroll") for (int k = 0; k < 2; ++k) dst[n][k] = *(const LAS bf16x8*)(lds + G_SB(b, h) + boff + n * 2048 + k * 1024); } while (0)
#define G_MMA(ai, bj, At, Bx) do { __builtin_amdgcn_s_setprio(1); _Pragma("unroll") for (int m = 0; m < 4; ++m) _Pragma("unroll") for (int n = 0; n < 2; ++n) _Pragma("unroll") for (int k = 0; k < 2; ++k) \
        acc[ai][bj][m][n] = __builtin_amdgcn_mfma_f32_16x16x32_bf16(Bx[n][k], At[m][k], acc[ai][bj][m][n], 0, 0, 0); __builtin_amdgcn_s_setprio(0); } while (0)
#define G_WV(n) asm volatile("s_waitcnt vmcnt(" #n ")" ::: "memory")
#define G_WL(n) asm volatile("s_waitcnt lgkmcnt(" #n ")" ::: "memory")
#define G_BAR __builtin_amdgcn_s_barrier()
#define G_SCHED __builtin_amdgcn_sched_barrier(0)
    bool prefetched = false;
    for (int tile = bid; tile < ntiles; tile += nb) {
        const int pm = tile % nMt, tq = tile / nMt, pn = tq % nNt, gb = tq / nNt;
        PRE(gb, pm, pn);
        const char* cA = (const char*)(A + (size_t)gb * strideA) + (size_t)pm * 256 * lda * 2;
        const char* cB = (const char*)(Bt + (size_t)gb * strideB) + (size_t)pn * 256 * K * 2;
        f32x4 acc[2][2][4][2];
#pragma unroll
        for (int a = 0; a < 2; ++a)
#pragma unroll
            for (int b = 0; b < 2; ++b)
#pragma unroll
                for (int m = 0; m < 4; ++m)
#pragma unroll
                    for (int n = 0; n < 2; ++n) acc[a][b][m][n] = (f32x4){0.f, 0.f, 0.f, 0.f};
        bf16x8 At[4][2], B0[2][2], B1[2][2];
        if (!prefetched) { G_WV(0); G_STB(G_SB(0, 0), cB); G_STA(G_SA(0, 0), cA); G_STB(G_SB(0, 1), cB + hstepB); G_STA(G_SA(0, 1), cA + hstepA); }
        if (wr == 1) G_BAR;
        if (prefetched) G_WV(0); else G_WV(4);
        G_BAR;
        G_STB(G_SB(1, 0), cB + kstep); G_STA(G_SA(1, 0), cA + kstep); G_STB(G_SB(1, 1), cB + hstepB + kstep);
        G_WV(6); G_BAR;
        for (int t = 0; t < nt - 2; t += 2) {
            const char* a1 = cA + (size_t)(t + 1) * kstep; const char* a2 = cA + (size_t)(t + 2) * kstep; const char* a3 = a2 + kstep;
            const char* b2 = cB + (size_t)(t + 2) * kstep; const char* b3 = b2 + kstep;
            G_LDB(B0, 0, 0); G_SCHED; G_LDA(At, 0, 0); G_STA(G_SA(1, 1), a1 + hstepA);
            G_WL(8); G_BAR; G_WL(0); G_MMA(0, 0, At, B0); G_BAR; G_SCHED;
            G_LDB(B1, 0, 1); G_STB(G_SB(0, 0), b2);
            G_BAR; G_WL(0); G_MMA(0, 1, At, B1); G_BAR;
            G_LDA(At, 0, 1); G_STA(G_SA(0, 0), a2);
            G_BAR; G_WL(0); G_MMA(1, 0, At, B0); G_BAR; G_SCHED;
            G_STB(G_SB(0, 1), b2 + hstepB);
            G_WV(6); G_BAR; G_MMA(1, 1, At, B1); G_BAR;
            G_LDB(B0, 1, 0); G_SCHED; G_LDA(At, 1, 0); G_STA(G_SA(0, 1), a2 + hstepA);
            G_WL(8); G_BAR; G_WL(0); G_MMA(0, 0, At, B0); G_BAR; G_SCHED;
            G_LDB(B1, 1, 1); G_STB(G_SB(1, 0), b3);
            G_BAR; G_WL(0); G_MMA(0, 1, At, B1); G_BAR;
            G_LDA(At, 1, 1); G_STA(G_SA(1, 0), a3);
            G_BAR; G_WL(0); G_MMA(1, 0, At, B0); G_BAR; G_SCHED;
            G_STB(G_SB(1, 1), b3 + hstepB);
            G_WV(6); G_BAR; G_MMA(1, 1, At, B1); G_BAR;
        }
        {
            const char* a1 = cA + (size_t)(nt - 1) * kstep;
            G_LDB(B0, 0, 0); G_LDA(At, 0, 0); G_STA(G_SA(1, 1), a1 + hstepA);
            G_BAR; G_WL(0); G_MMA(0, 0, At, B0); G_BAR;
            G_LDB(B1, 0, 1); G_BAR; G_WL(0); G_MMA(0, 1, At, B1); G_BAR;
            G_LDA(At, 0, 1); G_WV(4); G_BAR; G_WL(0); G_MMA(1, 0, At, B0); G_MMA(1, 1, At, B1); G_BAR;
        }
        {
            G_LDB(B0, 1, 0); G_LDA(At, 1, 0); G_WV(2); G_BAR; G_WL(0); G_MMA(0, 0, At, B0); G_BAR;
            G_LDB(B1, 1, 1); G_WV(0); G_BAR; G_WL(0); G_MMA(0, 1, At, B1); G_BAR;
            G_LDA(At, 1, 1); G_BAR; G_WL(0); G_MMA(1, 0, At, B0); G_MMA(1, 1, At, B1); G_BAR;
        }
        if (wr == 0) G_BAR;
        prefetched = false;
        if (Pre::NOP && tile + nb < ntiles) {
            const int t2 = tile + nb, pm2 = t2 % nMt, tq2 = t2 / nMt, pn2 = tq2 % nNt, gb2 = tq2 / nNt;
            const char* nA = (const char*)(A + (size_t)gb2 * strideA) + (size_t)pm2 * 256 * lda * 2;
            const char* nB = (const char*)(Bt + (size_t)gb2 * strideB) + (size_t)pn2 * 256 * K * 2;
            G_STB(G_SB(0, 0), nB); G_STA(G_SA(0, 0), nA); G_STB(G_SB(0, 1), nB + hstepB); G_STA(G_SA(0, 1), nA + hstepA);
            prefetched = true; }
        E(acc, gb, pm, pn, wr, wc, fr, fq);
    }
    G_WV(0);
    __syncthreads();
}

template <class Epi>
__device__ __forceinline__ void gemm_phase(LAS unsigned char* lds, const bf16_t* A, const bf16_t* Bt, int N, int K, const Epi& E, int bid, int nb) {
    gemm_batched(lds, A, K, 0, Bt, 0, 64, N / 256, 1, K, E, NoPre{}, bid, nb);
}

namespace pg8 {
#define PG8_LAS __attribute__((address_space(3)))
typedef unsigned short bf16_t;
typedef short bf16x8 __attribute__((ext_vector_type(8)));
typedef float f32x4 __attribute__((ext_vector_type(4)));
typedef unsigned u32x4 __attribute__((ext_vector_type(4)));
constexpr int BM = 256, BK = 64, HALF = 128, HTB = HALF * BK * 2  , STAGE_BYTES = 8 * HTB, NXCD = 8, WGM = 8;

__host__ __device__ __forceinline__ int lds_byte(int r, int c) { const int st = (r >> 4) * 2 + (c >> 5), rr = r & 15, cc = c & 31, ob = rr * 64 + cc * 2; return st * 1024 + (ob ^ (((ob >> 9) & 1) << 5)); }
__host__ __device__ __forceinline__ void stage_rc(int b, int& R, int& C) { const int st = b / 1024, sb = b % 1024, swz = sb ^ (((sb >> 9) & 1) << 5); R = (st >> 1) * 16 + swz / 64; C = (st & 1) * 32 + (swz % 64) / 2; }
__host__ __device__ __forceinline__ int perm32(int rho) { const int n = rho >> 4, i = rho & 15; return 8 * (i >> 2) + 4 * n + (i & 3); }

struct Unit { int pm, pn; };
struct Gemm { const bf16_t* A; const bf16_t* Bt; int M, N, K; };

struct StaticOrder {
    int nM, nN, nwg, G, c;
    __host__ __device__ void init(int M, int N, int G_, int c_) { nM = M / BM; nN = N / BM; nwg = nM * nN; G = G_; c = c_; }
    __host__ __device__ bool next(int i, Unit& u) const {
        const long L = (long)i * G + c; if (L >= nwg) return false;
        int wgid = (int)L; { const int q = nwg / NXCD, r = nwg % NXCD, xcd = wgid % NXCD, off = wgid / NXCD; wgid = (xcd < r ? xcd * (q + 1) : r * (q + 1) + (xcd - r) * q) + off; }
        const int nig = WGM * nN, gid = wgid / nig, fm = gid * WGM, gsz = (nM - fm) < WGM ? (nM - fm) : WGM;
        u.pm = fm + ((wgid % nig) % gsz); u.pn = (wgid % nig) / gsz; return true;
    }
    __device__ __forceinline__ void a_ready(const Unit&) const {}
    __device__ __forceinline__ void done(const Unit&) const {}
};
template <class Epi, class Sched, bool ALIGN_EPI = false, bool SP2 = false>
__device__ __forceinline__ void gemm_phase(PG8_LAS unsigned char* lds, const Gemm g, const Sched& S, const Epi& E) {
    const int tid = threadIdx.x, wid = __builtin_amdgcn_readfirstlane(tid >> 6), lane = tid & 63, wr = wid >> 2, wc = wid & 3, fr = lane & 15, fq = lane >> 4;
    const int K = g.K, nt = K / BK;
    unsigned voffA[2], voffB[2];
#pragma unroll
    for (int i = 0; i < 2; ++i) { int R, C; stage_rc(tid * 16 + i * 8192, R, C); const int Rb = Epi::PERM ? ((R & ~31) + perm32(R & 31)) : R;
        voffA[i] = (unsigned)(R * K + C) * 2u; voffB[i] = (unsigned)(Rb * K + C) * 2u; }
    const size_t kstep = (size_t)(BK * 2);
    const size_t hstep = (size_t)HALF * K * 2;
    const size_t tstep = 2 * hstep;
    const unsigned ldsw = (unsigned)wid * 1024u;
    const int aoff = lds_byte(wr * 64 + fr, fq * 8), boff = lds_byte(wc * 32 + fr, fq * 8);
#define PG8_SA(b, h) (((b) * 2 + (h)) * HTB)
#define PG8_SB(b, h) ((4 + (b) * 2 + (h)) * HTB)
#define PG8_STAGE(bufoff, gbase, voff) do { _Pragma("unroll") for (int _i = 0; _i < 2; ++_i) \
        __builtin_amdgcn_global_load_lds((const unsigned*)((const char*)(gbase) + (voff)[_i]), (PG8_LAS unsigned*)(lds + (bufoff) + ldsw + _i * 8192), 16, 0, 0); } while (0)
#define PG8_LDA(dst, b, h) do { _Pragma("unroll") for (int m = 0; m < 4; ++m) _Pragma("unroll") for (int k = 0; k < 2; ++k) dst[m][k] = *(const PG8_LAS bf16x8*)(lds + PG8_SA(b, h) + aoff + m * 2048 + k * 1024); } while (0)
#define PG8_LDB(dst, b, h) do { _Pragma("unroll") for (int n = 0; n < 2; ++n) _Pragma("unroll") for (int k = 0; k < 2; ++k) dst[n][k] = *(const PG8_LAS bf16x8*)(lds + PG8_SB(b, h) + boff + n * 2048 + k * 1024); } while (0)
#define PG8_MMA(ai, bj, At, Bt) do { __builtin_amdgcn_s_setprio(1); _Pragma("unroll") for (int m = 0; m < 4; ++m) _Pragma("unroll") for (int n = 0; n < 2; ++n) _Pragma("unroll") for (int k = 0; k < 2; ++k) \
        acc[ai][bj][m][n] = __builtin_amdgcn_mfma_f32_16x16x32_bf16(Bt[n][k], At[m][k], acc[ai][bj][m][n], 0, 0, 0); __builtin_amdgcn_s_setprio(0); } while (0)
#define PG8_WAIT_V(n) asm volatile("s_waitcnt vmcnt(" #n ")" ::: "memory")
#define PG8_WAIT_L(n) asm volatile("s_waitcnt lgkmcnt(" #n ")" ::: "memory")
#define PG8_BAR __builtin_amdgcn_s_barrier()
#define PG8_SCHED __builtin_amdgcn_sched_barrier(0)
    Unit cur, nxt; int ui = 0;
    if (!S.next(0, cur)) return;
    f32x4 acc[2][2][4][2];
#pragma unroll
    for (int a = 0; a < 2; ++a)
#pragma unroll
        for (int b = 0; b < 2; ++b)
#pragma unroll
            for (int m = 0; m < 4; ++m)
#pragma unroll
                for (int n = 0; n < 2; ++n) acc[a][b][m][n] = (f32x4){0.f, 0.f, 0.f, 0.f};
    bf16x8 At[4][2], B0[2][2], B1[2][2];
    const char* cA = (const char*)g.A + (size_t)cur.pm * tstep; const char* cB = (const char*)g.Bt + (size_t)cur.pn * tstep;
    S.a_ready(cur);
    if constexpr (SP2) {
        PG8_STAGE(PG8_SB(0, 0), cB, voffB); PG8_STAGE(PG8_SB(0, 1), cB + hstep, voffB); PG8_STAGE(PG8_SA(0, 0), cA, voffA); PG8_STAGE(PG8_SA(0, 1), cA + hstep, voffA);
        if (wr == 1) PG8_BAR;
        PG8_WAIT_V(2); PG8_BAR;
        PG8_STAGE(PG8_SB(1, 0), cB + kstep, voffB); PG8_STAGE(PG8_SA(1, 0), cA + kstep, voffA); PG8_STAGE(PG8_SB(1, 1), cB + hstep + kstep, voffB);
        PG8_WAIT_V(6); PG8_BAR;
    } else {
        PG8_STAGE(PG8_SB(0, 0), cB, voffB); PG8_STAGE(PG8_SA(0, 0), cA, voffA); PG8_STAGE(PG8_SB(0, 1), cB + hstep, voffB); PG8_STAGE(PG8_SA(0, 1), cA + hstep, voffA);
        if (wr == 1) PG8_BAR;
        PG8_WAIT_V(4); PG8_BAR;
        PG8_STAGE(PG8_SB(1, 0), cB + kstep, voffB); PG8_STAGE(PG8_SA(1, 0), cA + kstep, voffA); PG8_STAGE(PG8_SB(1, 1), cB + hstep + kstep, voffB);
        PG8_WAIT_V(6); PG8_BAR;
    }
    for (;;) {
        const bool has_next = S.next(ui + 1, nxt);
        const char* nA = has_next ? (const char*)g.A + (size_t)nxt.pm * tstep : cA; const char* nB = has_next ? (const char*)g.Bt + (size_t)nxt.pn * tstep : cB;
        for (int t = 0; t < nt; t += 2) {
            const bool last = (t == nt - 2);
            const char* a1 = cA + (size_t)(t + 1) * kstep;
            const char* a2 = last ? nA : cA + (size_t)(t + 2) * kstep; const char* b2 = last ? nB : cB + (size_t)(t + 2) * kstep;
            const char* a3 = a2 + kstep; const char* b3 = b2 + kstep;
            if (last && has_next) S.a_ready(nxt);
            if constexpr (SP2) {
            PG8_LDB(B0, 0, 0); PG8_LDB(B1, 0, 1); PG8_SCHED; PG8_LDA(At, 0, 0); PG8_STAGE(PG8_SA(1, 1), a1 + hstep, voffA);
            PG8_WAIT_V(8); PG8_WAIT_L(0); PG8_BAR; PG8_MMA(0, 0, At, B0); PG8_MMA(0, 1, At, B1); PG8_BAR; PG8_SCHED;
            PG8_LDA(At, 0, 1); PG8_STAGE(PG8_SB(0, 0), b2, voffB); PG8_STAGE(PG8_SB(0, 1), b2 + hstep, voffB); PG8_STAGE(PG8_SA(0, 0), a2, voffA);
            PG8_WAIT_V(8); PG8_WAIT_L(0); PG8_BAR; PG8_MMA(1, 0, At, B0); PG8_MMA(1, 1, At, B1); PG8_BAR; PG8_SCHED;
            PG8_LDB(B0, 1, 0); PG8_LDB(B1, 1, 1); PG8_SCHED; PG8_LDA(At, 1, 0); PG8_STAGE(PG8_SA(0, 1), a2 + hstep, voffA);
            PG8_WAIT_V(8); PG8_WAIT_L(0); PG8_BAR; PG8_MMA(0, 0, At, B0); PG8_MMA(0, 1, At, B1); PG8_BAR; PG8_SCHED;
            PG8_LDA(At, 1, 1); PG8_STAGE(PG8_SB(1, 0), b3, voffB); PG8_STAGE(PG8_SB(1, 1), b3 + hstep, voffB); PG8_STAGE(PG8_SA(1, 0), a3, voffA);
            PG8_WAIT_V(8); PG8_WAIT_L(0); PG8_BAR; PG8_MMA(1, 0, At, B0); PG8_MMA(1, 1, At, B1); PG8_BAR; PG8_SCHED;
            } else {
            PG8_LDB(B0, 0, 0); PG8_SCHED; PG8_LDA(At, 0, 0); PG8_STAGE(PG8_SA(1, 1), a1 + hstep, voffA);
            PG8_WAIT_L(8); PG8_BAR; PG8_WAIT_L(0); PG8_MMA(0, 0, At, B0); PG8_BAR; PG8_SCHED;
            PG8_LDB(B1, 0, 1); PG8_STAGE(PG8_SB(0, 0), b2, voffB);
            PG8_BAR; PG8_WAIT_L(0); PG8_MMA(0, 1, At, B1); PG8_BAR;
            PG8_LDA(At, 0, 1); PG8_STAGE(PG8_SA(0, 0), a2, voffA);
            PG8_BAR; PG8_WAIT_L(0); PG8_MMA(1, 0, At, B0); PG8_BAR; PG8_SCHED;
            PG8_STAGE(PG8_SB(0, 1), b2 + hstep, voffB);
            PG8_WAIT_V(6); PG8_BAR; PG8_MMA(1, 1, At, B1); PG8_BAR;
            PG8_LDB(B0, 1, 0); PG8_SCHED; PG8_LDA(At, 1, 0); PG8_STAGE(PG8_SA(0, 1), a2 + hstep, voffA);
            PG8_WAIT_L(8); PG8_BAR; PG8_WAIT_L(0); PG8_MMA(0, 0, At, B0); PG8_BAR; PG8_SCHED;
            PG8_LDB(B1, 1, 1); PG8_STAGE(PG8_SB(1, 0), b3, voffB);
            PG8_BAR; PG8_WAIT_L(0); PG8_MMA(0, 1, At, B1); PG8_BAR;
            PG8_LDA(At, 1, 1); PG8_STAGE(PG8_SA(1, 0), a3, voffA);
            PG8_BAR; PG8_WAIT_L(0); PG8_MMA(1, 0, At, B0); PG8_BAR; PG8_SCHED;
            PG8_STAGE(PG8_SB(1, 1), b3 + hstep, voffB);
            PG8_WAIT_V(6); PG8_BAR; PG8_MMA(1, 1, At, B1); PG8_BAR;
            }
        }
        if constexpr (ALIGN_EPI) { if (wr == 0) PG8_BAR; }
        if constexpr (!Epi::AFTER_DRAIN) { E(acc, cur, wr, wc, fr, fq); S.done(cur); }
        if (!has_next) break;
#pragma unroll
        for (int a = 0; a < 2; ++a)
#pragma unroll
            for (int b = 0; b < 2; ++b)
#pragma unroll
                for (int m = 0; m < 4; ++m)
#pragma unroll
                    for (int n = 0; n < 2; ++n) acc[a][b][m][n] = (f32x4){0.f, 0.f, 0.f, 0.f};
        cur = nxt; cA = nA; cB = nB; ++ui;
        if constexpr (ALIGN_EPI) { if (wr == 1) PG8_BAR; }
    }
    PG8_WAIT_V(0);
    if constexpr (!ALIGN_EPI) { if (wr == 0) PG8_BAR; }
    PG8_BAR;
    if constexpr (Epi::AFTER_DRAIN) { E.fused(acc, cur, wr, wc, fr, fq, lds, wid, lane); S.done(cur); }
#undef PG8_SA
#undef PG8_SB
#undef PG8_STAGE
#undef PG8_LDA
#undef PG8_LDB
#undef PG8_MMA
#undef PG8_WAIT_V
#undef PG8_WAIT_L
#undef PG8_BAR
#undef PG8_SCHED
}
}

template <class E> struct EpiAdapt { static constexpr bool PERM = false, AFTER_DRAIN = false; E e;
    __device__ __forceinline__ void operator()(const pg8::f32x4 (&acc)[2][2][4][2], const pg8::Unit& u, int wr, int wc, int fr, int fq) const { e(acc, 0, u.pm, u.pn, wr, wc, fr, fq); } };
template <class Epi>
__device__ __forceinline__ void gemm_stream(LAS unsigned char* lds, const bf16_t* A, const bf16_t* Bt, int N, int K, const Epi& E, int bid, int nb) {
    pg8::Gemm g{A, Bt, MTOK, N, K}; pg8::StaticOrder S; S.init(MTOK, N, nb, bid);
    EpiAdapt<Epi> ea{E};
    pg8::gemm_phase<EpiAdapt<Epi>, pg8::StaticOrder, true, true>(lds, g, S, ea);
}

#define EPI_LOOP(...) \
    _Pragma("unroll") for (int ai = 0; ai < 2; ++ai) _Pragma("unroll") for (int m = 0; m < 4; ++m) { asm volatile("" ::: "memory"); const int row = pm * 256 + ai * 128 + wr * 64 + m * 16 + fr; \
    _Pragma("unroll") for (int bj = 0; bj < 2; ++bj) _Pragma("unroll") for (int n = 0; n < 2; ++n) { const int ct = bj * 128 + wc * 32 + n * 16 + fq * 4; const f32x4 v = acc[ai][bj][m][n]; __VA_ARGS__ } }

struct EpiWin {
    bf16_t* UX; bf16_t* QKV;
    __device__ __forceinline__ void operator()(const f32x4 (&acc)[2][2][4][2], int gb, int pm, int pn, int wr, int wc, int fr, int fq) const {
        if (pn < 2) {
            bf16_t* base = UX + ((size_t)(pn * 16 + wc * 2) * 512 + (pm >> 4) * 128 + (pm & 15) * 8 + wr * 2) * 640 + fr * 16 + fq * 4;
#pragma unroll
            for (int ai = 0; ai < 2; ++ai)
#pragma unroll
                for (int m = 0; m < 4; ++m) { bf16_t* rp = base + (ai * 4 + (m >> 1)) * 640 + (m & 1) * 256;
#pragma unroll
                    for (int bj = 0; bj < 2; ++bj)
#pragma unroll
                        for (int n = 0; n < 2; ++n) { const f32x4 v = acc[ai][bj][m][n]; u32x2 w; w.x = pk2(v[0], v[1]); w.y = pk2(v[2], v[3]);
                            *(u32x2*)(rp + (size_t)(bj * 8 + n) * (512 * 640)) = w; }
                    asm volatile("" ::: "memory"); }
        } else { bf16_t* base = QKV + (size_t)((pn - 2) >> 1) * ((size_t)MTOK * 512) + (pn & 1) * 256 + (size_t)(pm * 256 + wr * 64 + fr) * 512 + wc * 32 + fq * 4;
#pragma unroll
            for (int ai = 0; ai < 2; ++ai)
#pragma unroll
                for (int m = 0; m < 4; ++m) { bf16_t* rp = base + (size_t)(ai * 128 + m * 16) * 512;
#pragma unroll
                    for (int bj = 0; bj < 2; ++bj)
#pragma unroll
                        for (int n = 0; n < 2; ++n) { const f32x4 v = acc[ai][bj][m][n]; u32x2 w; w.x = pk2(v[0], v[1]); w.y = pk2(v[2], v[3]);
                            *(u32x2*)(rp + bj * 128 + n * 16) = w; }
                    asm volatile("" ::: "memory"); }
        }
    }
};
struct EpiS5Z {
    float* Z;
    __device__ __forceinline__ void operator()(const f32x4 (&acc)[2][2][4][2], int gb, int pm, int pn, int wr, int wc, int fr, int fq) const {
        EPI_LOOP({ if (bj == 0) *(f32x4*)(Z + ((size_t)gb * 512 + row) * 128 + ct) = v; })
    }
};
struct EpiS5Y {
    const bf16_t* UX; bf16_t* YG; const float* dsk;
    __device__ __forceinline__ void operator()(const f32x4 (&acc)[2][2][4][2], int gb, int pm, int pn, int wr, int wc, int fr, int fq) const {
        EPI_LOOP({ const int col = pn * 256 + ct, t = col >> 4, h = col & 15, bb = row >> 7, cc = row & 127;
            const u32x2 uu = *(const u32x2*)(UX + ((size_t)gb * 512 + row) * 640 + col); const f32x4 dd = *(const f32x4*)(dsk + gb * 16 + h);
            u32x2 w; w.x = pk2(gelu_tanh(v[0] + dd[0] * bflo(uu.x)), gelu_tanh(v[1] + dd[1] * bfhi(uu.x))); w.y = pk2(gelu_tanh(v[2] + dd[2] * bflo(uu.y)), gelu_tanh(v[3] + dd[3] * bfhi(uu.y)));
            *(u32x2*)(YG + ((size_t)bb * SEQ + cc * 32 + t) * 512 + gb * 16 + h) = w; })
    }
};
struct PreS5Y {   static constexpr bool NOP = false;
    const float* Z; bf16_t* UX; const float* lam_re; const float* lam_im; const float* log_dt;
    __device__ __forceinline__ void operator()(int gb, int pm, int pn) const {
        const int tid = threadIdx.x;
        if (tid < 128) { const int pp = tid & 63, bb = 2 * pm + (tid >> 6);
            const float lr = lam_re[gb * 64 + pp], li = lam_im[gb * 64 + pp], dt = expf(log_dt[gb]);
            const float mag = expf(lr * dt * 32.f), ar = mag * cosf(li * dt * 32.f), ai = mag * sinf(li * dt * 32.f);
            const float* zp = Z + ((size_t)gb * 512 + bb * 128) * 128 + pp; bf16_t* xp = UX + ((size_t)gb * 512 + bb * 128) * 640 + 512 + pp;
            float xr = 0.f, xi = 0.f;
            for (int c0 = 0; c0 < 128; c0 += 16) { float zr[16], zi[16];
#pragma unroll
                for (int i = 0; i < 16; ++i) { zr[i] = zp[(size_t)(c0 + i) * 128]; zi[i] = zp[(size_t)(c0 + i) * 128 + 64]; }
#pragma unroll
                for (int i = 0; i < 16; ++i) { xp[(size_t)(c0 + i) * 640] = (bf16_t)f2bf(xr); xp[(size_t)(c0 + i) * 640 + 64] = (bf16_t)f2bf(xi);
                    const float nr = ar * xr - ai * xi + zr[i], ni = ar * xi + ai * xr + zi[i]; xr = nr; xi = ni; } } }
        __threadfence();
        asm volatile("s_waitcnt vmcnt(0)" ::: "memory");
        __syncthreads();
    }
};
struct EpiGlu {
    const bf16_t* YG; bf16_t* CAT;
    __device__ __forceinline__ void operator()(const f32x4 (&acc)[2][2][4][2], int gb, int pm, int pn, int wr, int wc, int fr, int fq) const {
        EPI_LOOP({ const int col = pn * 256 + ct; const u32x2 y = *(const u32x2*)(YG + (size_t)row * 512 + col);
            u32x2 w; w.x = pk2(bflo(y.x) * sigmoidf_(v[0]), bfhi(y.x) * sigmoidf_(v[1])); w.y = pk2(bflo(y.y) * sigmoidf_(v[2]), bfhi(y.y) * sigmoidf_(v[3]));
            *(u32x2*)(CAT + (size_t)row * 1024 + col) = w; })
    }
};
struct EpiRes {
    const float* res; float* out; const float* gate;
    __device__ __forceinline__ void operator()(const f32x4 (&acc)[2][2][4][2], int gb, int pm, int pn, int wr, int wc, int fr, int fq) const {
        const float* gatep = gate + (size_t)(pm >> 4) * 6144;
        EPI_LOOP({ const int col = pn * 256 + ct; const f32x4 g = *(const f32x4*)(gatep + col); const f32x4 r = *(const f32x4*)(res + (size_t)row * 1024 + col);
            *(f32x4*)(out + (size_t)row * 1024 + col) = r + g * v; })
    }
};
struct EpiSwiglu {
    bf16_t* HID;
    __device__ __forceinline__ void operator()(const f32x4 (&acc)[2][2][4][2], int gb, int pm, int pn, int wr, int wc, int fr, int fq) const {
#pragma unroll
        for (int ai = 0; ai < 2; ++ai)
#pragma unroll
            for (int m = 0; m < 4; ++m) { const int row = pm * 256 + ai * 128 + wr * 64 + m * 16 + fr;
#pragma unroll
                for (int n = 0; n < 2; ++n) { const f32x4 g = acc[ai][0][m][n], u = acc[ai][1][m][n]; float o[4];
#pragma unroll
                    for (int j = 0; j < 4; ++j) o[j] = g[j] * sigmoidf_(g[j]) * u[j];
                    u32x2 w; w.x = pk2(o[0], o[1]); w.y = pk2(o[2], o[3]);
                    *(u32x2*)(HID + (size_t)row * FF + pn * 128 + wc * 32 + n * 16 + fq * 4) = w; } }
    }
};
struct EpiG1 {
    bf16_t* RKV; bf16_t* L1;
    __device__ __forceinline__ void operator()(const f32x4 (&acc)[2][2][4][2], int gb, int pm, int pn, int wr, int wc, int fr, int fq) const {
        if (pn < 12) { bf16_t* base = RKV + (size_t)(pn >> 2) * ((size_t)MTOK * 1024) + (pn & 3) * 256;
            EPI_LOOP({ u32x2 w; w.x = pk2(v[0], v[1]); w.y = pk2(v[2], v[3]); *(u32x2*)(base + (size_t)row * 1024 + ct) = w; }) }
        else { EPI_LOOP({ float o[4];
                _Pragma("unroll") for (int j = 0; j < 4; ++j) o[j] = (bj == 1) ? sigmoidf_(v[j]) : ((wc < 2) ? tanhf(v[j]) : v[j]);
                u32x2 w; w.x = pk2(o[0], o[1]); w.y = pk2(o[2], o[3]); *(u32x2*)(L1 + (size_t)row * 256 + ct) = w; }) }
    }
};
struct EpiL2 {
    _Float16* DEC; bf16_t* AA; bf16_t* G; const float* w0; const float* a0;
    __device__ __forceinline__ void operator()(const f32x4 (&acc)[2][2][4][2], int gb, int pm, int pn, int wr, int wc, int fr, int fq) const {
        const int sel = pn >> 2, cb = (pn & 3) * 256;
        if (sel == 0) { EPI_LOOP({ const int col = cb + ct; const f32x4 w0v = *(const f32x4*)(w0 + col);
                _Pragma("unroll") for (int j = 0; j < 4; ++j) { const float z = w0v[j] + v[j]; const float sp = fmaxf(-z, 0.f) + log1pf(expf(-fabsf(z))); const float e = expf(-sp - 0.5f);
                    DEC[(size_t)row * 1024 + col + j] = (_Float16)(-expm1f(-e)); } }) }
        else if (sel == 1) { EPI_LOOP({ const int col = cb + ct; const f32x4 a0v = *(const f32x4*)(a0 + col);
                u32x2 w; w.x = pk2(sigmoidf_(a0v[0] + v[0]), sigmoidf_(a0v[1] + v[1])); w.y = pk2(sigmoidf_(a0v[2] + v[2]), sigmoidf_(a0v[3] + v[3]));
                *(u32x2*)(AA + (size_t)row * 1024 + col) = w; }) }
        else { EPI_LOOP({ const int col = cb + ct; u32x2 w; w.x = pk2(v[0], v[1]); w.y = pk2(v[2], v[3]); *(u32x2*)(G + (size_t)row * 1024 + col) = w; }) }
    }
};

__device__ __forceinline__ void s5_gen(const Params& p, bf16_t* BtY, bf16_t* BtZ, float* lds, int bid, int nb) {
    float* PWr = lds; float* PWi = lds + 33 * 64; float* BBr = lds + 66 * 64; float* BBi = BBr + 1024; float* Cr = BBi + 1024; float* Ci = Cr + 1024; float* Kt = Ci + 1024;
    const int tid = threadIdx.x;
    for (int unit = bid; unit < 256; unit += nb) {
        const int g = unit >> 3, part = unit & 7;
        __syncthreads();
        if (tid < 64) { const int pp = tid; const float lr = p.in[11][g * 64 + pp], li = p.in[12][g * 64 + pp], dt = expf(p.in[13][g]);
            for (int tau = 0; tau <= 32; ++tau) { const float mag = expf(lr * dt * (float)tau), ang = li * dt * (float)tau; PWr[tau * 64 + pp] = mag * cosf(ang); PWi[tau * 64 + pp] = mag * sinf(ang); }
            const float ar = PWr[64 + pp], ai = PWi[64 + pp], den = lr * lr + li * li, nr = ar - 1.f;
            const float qr = (nr * lr + ai * li) / den, qi = (ai * lr - nr * li) / den;
            for (int h = 0; h < 16; ++h) { const float br = p.in[14][(size_t)(g * 64 + pp) * 16 + h], bi = p.in[15][(size_t)(g * 64 + pp) * 16 + h]; BBr[pp * 16 + h] = qr * br - qi * bi; BBi[pp * 16 + h] = qr * bi + qi * br; } }
        for (int i = tid; i < 1024; i += NTHR) { Cr[i] = p.in[16][(size_t)g * 1024 + i]; Ci[i] = p.in[17][(size_t)g * 1024 + i]; }
        __syncthreads();
        for (int e = tid; e < 8192; e += NTHR) { const int tau = e >> 8, h = (e >> 4) & 15, h2 = e & 15; float acc = 0.f;
            for (int pp = 0; pp < 64; ++pp) { const float cr = Cr[h * 64 + pp], ci = Ci[h * 64 + pp], wr = PWr[tau * 64 + pp], wi = PWi[tau * 64 + pp];
                const float er = cr * wr - ci * wi, ei = cr * wi + ci * wr; acc += er * BBr[pp * 16 + h2] - ei * BBi[pp * 16 + h2]; }
            Kt[e] = acc; }
        __syncthreads();
        for (int ci_ = tid; ci_ < 5120; ci_ += NTHR) { const int nrow = part * 64 + ci_ / 80, kc = (ci_ % 80) * 8, t = nrow >> 4, h = nrow & 15; float v[8];
#pragma unroll
            for (int i = 0; i < 8; ++i) { const int k = kc + i;
                if (k < 512) { const int sidx = k >> 4, h2 = k & 15; v[i] = (sidx <= t) ? Kt[(t - sidx) * 256 + h * 16 + h2] : 0.f; }
                else { const int jj = k - 512, pp = jj & 63; const float cr = Cr[h * 64 + pp], ci = Ci[h * 64 + pp], wr = PWr[(t + 1) * 64 + pp], wi = PWi[(t + 1) * 64 + pp];
                    v[i] = (jj >> 6) ? -(cr * wi + ci * wr) : (cr * wr - ci * wi); } }
            *(u32x4*)(BtY + ((size_t)g * 512 + nrow) * 640 + kc) = (u32x4){pk2(v[0], v[1]), pk2(v[2], v[3]), pk2(v[4], v[5]), pk2(v[6], v[7])}; }
        for (int ci_ = tid; ci_ < 1024; ci_ += NTHR) { const int n = part * 16 + (ci_ >> 6), kc = (ci_ & 63) * 8, pp = n & 63, im = n >> 6; float v[8];
#pragma unroll
            for (int i = 0; i < 8; ++i) { const int k = kc + i, sidx = k >> 4, h2 = k & 15, tau = 31 - sidx; const float wr = PWr[tau * 64 + pp], wi = PWi[tau * 64 + pp], br = BBr[pp * 16 + h2], bi = BBi[pp * 16 + h2];
                v[i] = im ? (wr * bi + wi * br) : (wr * br - wi * bi); }
            *(u32x4*)(BtZ + ((size_t)g * 256 + n) * 512 + kc) = (u32x4){pk2(v[0], v[1]), pk2(v[2], v[3]), pk2(v[4], v[5]), pk2(v[6], v[7])}; }
    }
    __syncthreads();
}

template <int MODE>
__device__ __forceinline__ void tr_job(const float* src, int K, int N, bf16_t* dst, int ldd, int row_off, int koff, const float* scale, float* lds, int bid, int nb) {
    const int tk = K / 64, tn = N / 64, tid = threadIdx.x, nt_ = tk * tn;
    const int r = tid >> 3, c = (tid & 7) * 8;
    float4 a = {0.f, 0.f, 0.f, 0.f}, b = a; float sc = 1.f;
    if (bid < nt_) { const int k0 = (bid / tn) * 64, n0 = (bid % tn) * 64; const float* p = src + (size_t)(k0 + r) * N + n0 + c; a = *(const float4*)p; b = *(const float4*)(p + 4); sc = scale ? scale[k0 + r] : 1.f; }
    for (int t = bid; t < nt_; t += nb) {
        const int k0 = (t / tn) * 64, n0 = (t % tn) * 64;
        { float* l = lds + r * 65 + c; l[0] = a.x * sc; l[1] = a.y * sc; l[2] = a.z * sc; l[3] = a.w * sc; l[4] = b.x * sc; l[5] = b.y * sc; l[6] = b.z * sc; l[7] = b.w * sc; }
        if (t + nb < nt_) { const int t2 = t + nb, k2 = (t2 / tn) * 64, n2 = (t2 % tn) * 64; const float* p = src + (size_t)(k2 + r) * N + n2 + c; a = *(const float4*)p; b = *(const float4*)(p + 4); sc = scale ? scale[k2 + r] : 1.f; }
        __syncthreads();
        { const int nl = tid >> 3, kc = (tid & 7) * 8; float v[8];
#pragma unroll
          for (int i = 0; i < 8; ++i) v[i] = lds[(kc + i) * 65 + nl];
          int n = n0 + nl; int rowi = n;
          if (MODE == 1) rowi = (n >> 7) * 256 + (n & 127);
          if (MODE == 2) rowi = (n >> 7) * 256 + 128 + (n & 127);
          u32x4 w; w.x = pk2(v[0], v[1]); w.y = pk2(v[2], v[3]); w.z = pk2(v[4], v[5]); w.w = pk2(v[6], v[7]);
          *(u32x4*)(dst + (size_t)(row_off + rowi) * ldd + koff + k0 + kc) = w; }
        __syncthreads();
    }
}

__device__ __forceinline__ void prep_phase(const Params& p, float* lds, int bid, int nb) {
    unsigned char* ws = p.ws;
    s5_gen(p, (bf16_t*)(ws + OFF_BTY), (bf16_t*)(ws + OFF_BTZ), lds, bid, nb);
    tr_job<0>(p.in[10], 1024, 2048, (bf16_t*)(ws + OFF_WIN), 1024, 0, 0, nullptr, lds, bid, nb);
    tr_job<0>(p.in[19], 512, 512, (bf16_t*)(ws + OFF_WGLU), 512, 0, 0, nullptr, lds, bid, nb);
    tr_job<0>(p.in[27], 1024, 1024, (bf16_t*)(ws + OFF_WOUT), 1024, 0, 0, nullptr, lds, bid, nb);
    for (int l = 0; l < 2; ++l) {
        bf16_t* gu = (bf16_t*)(ws + (l ? OFF_WGU1 : OFF_WGU0)); bf16_t* dn = (bf16_t*)(ws + (l ? OFF_WDN1 : OFF_WDN0));
        tr_job<1>(p.in[7] + (size_t)l * 1024 * FF, 1024, FF, gu, 1024, 0, 0, nullptr, lds, bid, nb);
        tr_job<2>(p.in[8] + (size_t)l * 1024 * FF, 1024, FF, gu, 1024, 0, 0, nullptr, lds, bid, nb);
        tr_job<0>(p.in[9] + (size_t)l * FF * 1024, FF, 1024, dn, FF, 0, 0, nullptr, lds, bid, nb);
    }
    bf16_t* g1 = (bf16_t*)(ws + OFF_WG1); const float* mu = p.in[28];
    tr_job<0>(p.in[29], 1024, 1024, g1, 2048, 0, 0, nullptr, lds, bid, nb);      tr_job<0>(p.in[29], 1024, 1024, g1, 2048, 0, 1024, mu + 0 * 1024, lds, bid, nb);
    tr_job<0>(p.in[30], 1024, 1024, g1, 2048, 1024, 0, nullptr, lds, bid, nb);   tr_job<0>(p.in[30], 1024, 1024, g1, 2048, 1024, 1024, mu + 2 * 1024, lds, bid, nb);
    tr_job<0>(p.in[31], 1024, 1024, g1, 2048, 2048, 0, nullptr, lds, bid, nb);   tr_job<0>(p.in[31], 1024, 1024, g1, 2048, 2048, 1024, mu + 3 * 1024, lds, bid, nb);
    tr_job<0>(p.in[34], 1024, 64, g1, 2048, 3072, 0, nullptr, lds, bid, nb);     tr_job<0>(p.in[34], 1024, 64, g1, 2048, 3072, 1024, mu + 1 * 1024, lds, bid, nb);
    tr_job<0>(p.in[37], 1024, 64, g1, 2048, 3136, 0, nullptr, lds, bid, nb);     tr_job<0>(p.in[37], 1024, 64, g1, 2048, 3136, 1024, mu + 4 * 1024, lds, bid, nb);
    tr_job<0>(p.in[39], 1024, 128, g1, 2048, 3200, 0, nullptr, lds, bid, nb);    tr_job<0>(p.in[39], 1024, 128, g1, 2048, 3200, 1024, mu + 5 * 1024, lds, bid, nb);
    bf16_t* l2 = (bf16_t*)(ws + OFF_WL2);
    tr_job<0>(p.in[35], 64, 1024, l2, 256, 0, 0, nullptr, lds, bid, nb);
    tr_job<0>(p.in[38], 64, 1024, l2, 256, 1024, 64, nullptr, lds, bid, nb);
    tr_job<0>(p.in[40], 128, 1024, l2, 256, 2048, 128, nullptr, lds, bid, nb);
    for (int i = bid * NTHR + threadIdx.x; i < 3072 * 32; i += nb * NTHR) { const int n = i >> 5, kc = (i & 31) * 8; const int sel = n >> 10;
        const bool used = (sel == 0) ? (kc < 64) : (sel == 1) ? (kc >= 64 && kc < 128) : (kc >= 128);
        if (!used) *(u32x4*)(l2 + (size_t)n * 256 + kc) = (u32x4){0u, 0u, 0u, 0u}; }
    tr_job<0>(p.in[32], 1024, 1024, (bf16_t*)(ws + OFF_WO), 1024, 0, 0, nullptr, lds, bid, nb);
    {   const float* c = p.in[1]; const float* wada = p.in[3]; const float* bada = p.in[4]; float* mod = (float*)(ws + OFF_MOD);
        float* cact = lds;
        float* red = lds + 4096;
        for (int i = threadIdx.x; i < 4096; i += NTHR) { const float x = c[i]; cact[i] = x / (1.f + expf(-x)); }
        __syncthreads();
        const int col = threadIdx.x & 63, kg = threadIdx.x >> 6;
        for (int ch = bid; ch < 192; ch += nb) {
            const int l = ch / 96, n0 = (ch % 96) * 64;
            const float* wp = wada + (size_t)l * 1024 * 6144 + n0 + col;
            float a0 = 0.f, a1 = 0.f, a2 = 0.f, a3 = 0.f;
            for (int k = kg * 128; k < kg * 128 + 128; ++k) { const float w = wp[(size_t)k * 6144]; a0 += cact[k] * w; a1 += cact[1024 + k] * w; a2 += cact[2048 + k] * w; a3 += cact[3072 + k] * w; }
            red[(kg * 4 + 0) * 64 + col] = a0; red[(kg * 4 + 1) * 64 + col] = a1; red[(kg * 4 + 2) * 64 + col] = a2; red[(kg * 4 + 3) * 64 + col] = a3;
            __syncthreads();
            if (threadIdx.x < 256) { const int b = threadIdx.x >> 6; float s = 0.f;
#pragma unroll
                for (int g = 0; g < 8; ++g) s += red[(g * 4 + b) * 64 + col];
                mod[(size_t)(l * 4 + b) * 6144 + n0 + col] = s + bada[l * 6144 + n0 + col]; }
            __syncthreads();
        }
    }
}

template <bool RW>
__device__ __forceinline__ void norm_phase(const float* x, const float* g, const float* modl, int shift_off, int scale_off, bf16_t* out, int bid, int nb) {
    const int wave = threadIdx.x >> 6, lane = threadIdx.x & 63;
    for (int row = bid * 8 + wave; row < MTOK; row += nb * 8) {
        const int b = row >> 12; const float* xr = x + (size_t)row * 1024; const float* md = modl + (size_t)b * 6144;
        f32x4 v[4], vp[4]; float ss = 0.f, ssp = 0.f; const bool hasp = RW && ((row & 4095) != 0);
#pragma unroll
        for (int i = 0; i < 4; ++i) { v[i] = *(const f32x4*)(xr + i * 256 + lane * 4); ss += v[i][0] * v[i][0] + v[i][1] * v[i][1] + v[i][2] * v[i][2] + v[i][3] * v[i][3];
            if (RW) { vp[i] = hasp ? *(const f32x4*)(xr - 1024 + i * 256 + lane * 4) : (f32x4){0.f, 0.f, 0.f, 0.f}; ssp += vp[i][0] * vp[i][0] + vp[i][1] * vp[i][1] + vp[i][2] * vp[i][2] + vp[i][3] * vp[i][3]; } }
        ss = wave_sum(ss); const float rstd = rsqrtf(ss * (1.f / 1024.f) + 1e-6f);
        float rstdp = 0.f; if (RW) { ssp = wave_sum(ssp); rstdp = rsqrtf(ssp * (1.f / 1024.f) + 1e-6f); }
#pragma unroll
        for (int i = 0; i < 4; ++i) { const int c = i * 256 + lane * 4; const f32x4 gg = *(const f32x4*)(g + c), sc = *(const f32x4*)(md + scale_off + c), sh = *(const f32x4*)(md + shift_off + c);
            f32x4 h;
#pragma unroll
            for (int j = 0; j < 4; ++j) h[j] = v[i][j] * rstd * gg[j] * (1.f + sc[j]) + sh[j];
            u32x2 w; w.x = pk2(h[0], h[1]); w.y = pk2(h[2], h[3]);
            if (!RW) *(u32x2*)(out + (size_t)row * 1024 + c) = w;
            else { *(u32x2*)(out + (size_t)row * 2048 + c) = w; f32x4 d;
#pragma unroll
                for (int j = 0; j < 4; ++j) { const float hp = hasp ? (vp[i][j] * rstdp * gg[j] * (1.f + sc[j]) + sh[j]) : 0.f; d[j] = hp - h[j]; }
                u32x2 w2; w2.x = pk2(d[0], d[1]); w2.y = pk2(d[2], d[3]); *(u32x2*)(out + (size_t)row * 2048 + 1024 + c) = w2; } }
    }
}

__device__ __forceinline__ void qknorm_phase(bf16_t* Q, bf16_t* Kb, const int* pos, const float* qn, const float* kn, int bid, int nb) {
    const int wave = threadIdx.x >> 6, lane = threadIdx.x & 63, l16 = lane & 15, d0 = l16 * 4;
    float invf[4];
#pragma unroll
    for (int j = 0; j < 4; ++j) invf[j] = powf(500000.f, -(float)((l16 & 1) * 4 + j) / 8.f);
    const f32x4 qw = *(const f32x4*)(qn + d0), kw = *(const f32x4*)(kn + d0);
    for (int tok = bid * 8 + wave; tok < MTOK; tok += nb * 8) {
        const float ps = (float)pos[tok];
        float cs[4], sn[4];
#pragma unroll
        for (int j = 0; j < 4; ++j) { const float ang = ps * invf[j]; cs[j] = cosf(ang); sn[j] = sinf(ang); }
#pragma unroll
        for (int bsel = 0; bsel < 2; ++bsel) { bf16_t* buf = bsel ? Kb : Q; const f32x4 w = bsel ? kw : qw;
#pragma unroll
            for (int it = 0; it < 2; ++it) { const int vec = it * 4 + (lane >> 4); bf16_t* ptr = buf + (size_t)tok * 512 + vec * 64 + d0;
                const u32x2 raw = *(const u32x2*)ptr; float y[4] = {bflo(raw.x), bfhi(raw.x), bflo(raw.y), bfhi(raw.y)};
                float ss = y[0] * y[0] + y[1] * y[1] + y[2] * y[2] + y[3] * y[3];
                ss += __shfl_xor(ss, 1); ss += __shfl_xor(ss, 2); ss += __shfl_xor(ss, 4); ss += __shfl_xor(ss, 8);
                const float rstd = rsqrtf(ss * (1.f / 64.f) + 1e-6f);
#pragma unroll
                for (int j = 0; j < 4; ++j) y[j] = y[j] * rstd * w[j];
                float pr[4];
#pragma unroll
                for (int j = 0; j < 4; ++j) pr[j] = __shfl_xor(y[j], 2);
                if (l16 < 2) {
#pragma unroll
                    for (int j = 0; j < 4; ++j) y[j] = y[j] * cs[j] - pr[j] * sn[j]; }
                else if (l16 < 4) {
#pragma unroll
                    for (int j = 0; j < 4; ++j) y[j] = y[j] * cs[j] + pr[j] * sn[j]; }
                if (!bsel) {
#pragma unroll
                    for (int j = 0; j < 4; ++j) y[j] *= 0.125f * 1.4426950408889634f; }
                u32x2 o; o.x = pk2(y[0], y[1]); o.y = pk2(y[2], y[3]); *(u32x2*)ptr = o; } }
    }
}

__device__ __forceinline__ void vtrans_phase(const bf16_t* V, bf16_t* Vt, bf16_t* lds, int bid, int nb) {
    const int tid = threadIdx.x;
    for (int unit = bid; unit < 1024; unit += nb) {
        const int head = unit & 3, ch = unit >> 2; const int b = ch >> 6, t0 = (ch & 63) * 64;
#pragma unroll
        for (int i = 0; i < 2; ++i) { const int idx = tid + i * 512, t = idx >> 4, cc = (idx & 15) * 8;
            const u32x4 w = *(const u32x4*)(V + ((size_t)b * SEQ + t0 + t) * 512 + head * 128 + cc);
            unsigned* d = (unsigned*)(lds + t * 130 + cc); d[0] = w.x; d[1] = w.y; d[2] = w.z; d[3] = w.w; }
        __syncthreads();
        { const int e = tid >> 2, tc = (tid & 3) * 16; unsigned o[8];
#pragma unroll
          for (int i = 0; i < 8; ++i) o[i] = (unsigned)lds[(tc + 2 * i) * 130 + e] | ((unsigned)lds[(tc + 2 * i + 1) * 130 + e] << 16);
          u32x4* dst = (u32x4*)(Vt + ((size_t)(b * 4 + head) * 128 + e) * SEQ + t0 + tc);
          dst[0] = (u32x4){o[0], o[1], o[2], o[3]}; dst[1] = (u32x4){o[4], o[5], o[6], o[7]}; }
        __syncthreads();
    }
}

typedef float f32x16 __attribute__((ext_vector_type(16)));
__device__ __forceinline__ void attn_phase(const bf16_t* Q, const bf16_t* Kb, const bf16_t* Vt, bf16_t* OC, LAS unsigned char* lds, int bid, int nb) {
    const int tid = threadIdx.x, wave = __builtin_amdgcn_readfirstlane(tid >> 6), lane = tid & 63, c = wave >> 2, wq = wave & 3, l32 = lane & 31, hh = lane >> 5;
    constexpr int KROW = 272, VROW = 72, KBUF = 32 * KROW, VBUF = 128 * VROW, VOFF = 2 * KBUF;
    const int lkey = tid >> 4, lkc = tid & 15, lve = tid >> 2, lvc = tid & 3;
    for (int unit = bid; unit < 256; unit += nb) {
        const int b = unit & 3, head = (unit >> 2) & 3, pr = unit >> 4;
        const bf16_t* kg = Kb + ((size_t)b * SEQ + lkey) * 512 + head * 128 + lkc * 8;
        const bf16_t* vg = Vt + ((size_t)(b * 4 + head) * 128 + lve) * SEQ + lvc * 8;
        for (int half = 0; half < 2; ++half) {
            const int qb = half ? (31 - pr) : pr; const int q0 = qb * 128 + wq * 32; const int ntile = (qb + 1) * 4;
            bf16x8 qf[4];
            { const bf16_t* qp = Q + ((size_t)b * SEQ + q0 + l32) * 512 + head * 128 + c * 64 + hh * 8;
#pragma unroll
              for (int ks = 0; ks < 4; ++ks) qf[ks] = *(const bf16x8*)(qp + ks * 16); }
            f32x16 o[4];
#pragma unroll
            for (int blk = 0; blk < 4; ++blk)
#pragma unroll
                for (int r = 0; r < 16; ++r) o[blk][r] = 0.f;
            float mrow = -INFINITY, lsum = 0.f;
            u32x4 kreg = *(const u32x4*)kg, vreg = *(const u32x4*)vg;
            __syncthreads();
            { *(LAS u32x4*)(lds + lkey * KROW + lkc * 16) = kreg;
              LAS u32x2* vd = (LAS u32x2*)(lds + VOFF + lve * VROW + lvc * 16); vd[0] = (u32x2){vreg.x, vreg.y}; vd[1] = (u32x2){vreg.z, vreg.w}; }
            __syncthreads();
            for (int kt = 0; kt < ntile; ++kt) {
                const int cur = kt & 1, key0 = kt * 32;
                if (kt + 1 < ntile) { kreg = *(const u32x4*)(kg + (size_t)(key0 + 32) * 512); vreg = *(const u32x4*)(vg + key0 + 32); }
                if (key0 <= q0) {
                    LAS unsigned char* kb = lds + cur * KBUF + l32 * KROW + c * 128 + hh * 16;
                    f32x16 sacc;
#pragma unroll
                    for (int r = 0; r < 16; ++r) sacc[r] = 0.f;
#pragma unroll
                    for (int ks = 0; ks < 4; ++ks) { const bf16x8 kf = *(const LAS bf16x8*)(kb + ks * 32); sacc = __builtin_amdgcn_mfma_f32_32x32x16_bf16(kf, qf[ks], sacc, 0, 0, 0); }
                    if (key0 == q0) {
#pragma unroll
                        for (int r = 0; r < 16; ++r) { const int kl = (r & 3) + 8 * (r >> 2) + 4 * hh; if (kl > l32) sacc[r] = -INFINITY; } }
                    float tm = sacc[0];
#pragma unroll
                    for (int r = 1; r < 16; ++r) tm = fmaxf(tm, sacc[r]);
                    tm = fmaxf(tm, __shfl_xor(tm, 32));
                    const float mnew = fmaxf(mrow, tm);
                    if (__any(mnew > mrow)) { const float al = exp2f(mrow - mnew); lsum *= al;
#pragma unroll
                        for (int blk = 0; blk < 4; ++blk)
#pragma unroll
                            for (int r = 0; r < 16; ++r) o[blk][r] *= al;
                        mrow = mnew; }
                    float ps = 0.f;
#pragma unroll
                    for (int r = 0; r < 16; ++r) { sacc[r] = exp2f(sacc[r] - mrow); ps += sacc[r]; }
                    lsum += ps;
                    LAS unsigned char* vb = lds + VOFF + cur * VBUF + l32 * VROW + hh * 8;
#pragma unroll
                    for (int s2 = 0; s2 < 2; ++s2) {
                        u32x4 pw; pw.x = cvt_pk_bf16(sacc[8 * s2 + 0], sacc[8 * s2 + 1]); pw.y = cvt_pk_bf16(sacc[8 * s2 + 2], sacc[8 * s2 + 3]); pw.z = cvt_pk_bf16(sacc[8 * s2 + 4], sacc[8 * s2 + 5]); pw.w = cvt_pk_bf16(sacc[8 * s2 + 6], sacc[8 * s2 + 7]);
                        const bf16x8 pb = __builtin_bit_cast(bf16x8, pw);
#pragma unroll
                        for (int blk = 0; blk < 4; ++blk) { const u32x2 v0 = *(const LAS u32x2*)(vb + blk * 32 * VROW + s2 * 32), v1 = *(const LAS u32x2*)(vb + blk * 32 * VROW + s2 * 32 + 16);
                            const bf16x8 vf = __builtin_bit_cast(bf16x8, (u32x4){v0.x, v0.y, v1.x, v1.y});
                            o[blk] = __builtin_amdgcn_mfma_f32_32x32x16_bf16(vf, pb, o[blk], 0, 0, 0); } }
                }
                if (kt + 1 < ntile) { const int nx = cur ^ 1;
                    *(LAS u32x4*)(lds + nx * KBUF + lkey * KROW + lkc * 16) = kreg;
                    LAS u32x2* vd = (LAS u32x2*)(lds + VOFF + nx * VBUF + lve * VROW + lvc * 16); vd[0] = (u32x2){vreg.x, vreg.y}; vd[1] = (u32x2){vreg.z, vreg.w}; }
                __syncthreads();
            }
            lsum += __shfl_xor(lsum, 32);
            const float inv = 1.f / lsum;
            bf16_t* op = OC + ((size_t)b * SEQ + q0 + l32) * 1024 + (head * 2 + c) * 128 + 4 * hh;
#pragma unroll
            for (int blk = 0; blk < 4; ++blk)
#pragma unroll
                for (int g4 = 0; g4 < 4; ++g4) { u32x2 w; w.x = pk2(o[blk][g4 * 4 + 0] * inv, o[blk][g4 * 4 + 1] * inv); w.y = pk2(o[blk][g4 * 4 + 2] * inv, o[blk][g4 * 4 + 3] * inv);
                    *(u32x2*)(op + blk * 32 + g4 * 8) = w; }
        }
    }
}

__device__ __forceinline__ void attn_combine(const bf16_t* OC, bf16_t* CAT, const Params& p, int bid, int nb) {
    const int wave = threadIdx.x >> 6, lane = threadIdx.x & 63, head = lane >> 4, e0 = (lane & 15) * 8;
    float lam;
    { float s1 = 0.f, s2 = 0.f; for (int d = 0; d < 64; ++d) { s1 += p.in[22][d] * p.in[23][d]; s2 += p.in[24][d] * p.in[25][d]; } lam = expf(s1) - expf(s2) + 0.2f; }
    float sub[8];
#pragma unroll
    for (int i = 0; i < 8; ++i) sub[i] = p.in[26][e0 + i] * 0.8f;
    for (int tok = bid * 8 + wave; tok < MTOK; tok += nb * 8) {
        const u32x4 a = *(const u32x4*)(OC + (size_t)tok * 1024 + (head * 2) * 128 + e0), bb = *(const u32x4*)(OC + (size_t)tok * 1024 + (head * 2 + 1) * 128 + e0);
        float o[8] = {bflo(a.x) - lam * bflo(bb.x), bfhi(a.x) - lam * bfhi(bb.x), bflo(a.y) - lam * bflo(bb.y), bfhi(a.y) - lam * bfhi(bb.y),
                      bflo(a.z) - lam * bflo(bb.z), bfhi(a.z) - lam * bfhi(bb.z), bflo(a.w) - lam * bflo(bb.w), bfhi(a.w) - lam * bfhi(bb.w)};
        float ss = 0.f;
#pragma unroll
        for (int i = 0; i < 8; ++i) ss += o[i] * o[i];
        ss += __shfl_xor(ss, 1); ss += __shfl_xor(ss, 2); ss += __shfl_xor(ss, 4); ss += __shfl_xor(ss, 8);
        const float rstd = rsqrtf(ss * (1.f / 128.f) + 1e-6f);
        u32x4 w; w.x = pk2(o[0] * rstd * sub[0], o[1] * rstd * sub[1]); w.y = pk2(o[2] * rstd * sub[2], o[3] * rstd * sub[3]); w.z = pk2(o[4] * rstd * sub[4], o[5] * rstd * sub[5]); w.w = pk2(o[6] * rstd * sub[6], o[7] * rstd * sub[7]);
        *(u32x4*)(CAT + (size_t)tok * 1024 + 512 + head * 128 + e0) = w;
    }
}

typedef float f32x2 __attribute__((ext_vector_type(2)));
__device__ __forceinline__ float h2f_(unsigned bits) { return (float)__builtin_bit_cast(_Float16, (unsigned short)bits); }
__device__ __forceinline__ void rwkv_phase(const Params& p, const bf16_t* R, const bf16_t* Kk, const bf16_t* Vv, const _Float16* DEC, const bf16_t* AA, bf16_t* Y, float* lds, int bid, int nb) {
    const int tid = threadIdx.x, wave = __builtin_amdgcn_readfirstlane(tid >> 6), lane = tid & 63;
    constexpr int TCH = 16, BUFF = 5 * TCH * 64 + TCH * 16;
    constexpr int OBUF = TCH * 16 * 16;
    float* Lout = lds + 2 * BUFF;
    for (int unit = bid; unit < 256; unit += nb) {
        const int b = unit >> 6, h = (unit >> 2) & 15, rq = unit & 3;
        __syncthreads();
        if (wave >= 4) {
            const int pw = wave - 4, tl = lane >> 4, c4 = (lane & 15) * 4;
            const f32x4 kkw = *(const f32x4*)(p.in[41] + h * 64 + c4), kaw = *(const f32x4*)(p.in[42] + h * 64 + c4);
            u32x2 rr[4], kr[4], ar[4], dr[4], vr[4];
            const unsigned lofs = (unsigned)((pw * 4 + tl) * 1024 + h * 64 + c4), vofs = (unsigned)((pw * 4 + tl) * 1024 + h * 64 + rq * 16 + (lane & 3) * 4);
            const bf16_t* Rb = R + (size_t)b * SEQ * 1024; const bf16_t* Kb_ = Kk + (size_t)b * SEQ * 1024; const bf16_t* Vb = Vv + (size_t)b * SEQ * 1024;
            const bf16_t* Ab = AA + (size_t)b * SEQ * 1024; const _Float16* Db = DEC + (size_t)b * SEQ * 1024;
#define RW_ISSUE(set, ch) do { const unsigned o_ = (unsigned)(ch) * (TCH * 1024) + lofs; rr[set] = *(const u32x2*)(Rb + o_); kr[set] = *(const u32x2*)(Kb_ + o_); dr[set] = *(const u32x2*)(Db + o_); ar[set] = *(const u32x2*)(Ab + o_); \
                    vr[set] = *(const u32x2*)(Vb + (unsigned)(ch) * (TCH * 1024) + vofs); } while (0)
#define RW_STAGE(set, buf) do { float* L = lds + (buf) * BUFF + (pw * 4 + tl) * 64 + c4; \
                    const f32x4 k = {bflo(kr[set].x), bfhi(kr[set].x), bflo(kr[set].y), bfhi(kr[set].y)}, a = {bflo(ar[set].x), bfhi(ar[set].x), bflo(ar[set].y), bfhi(ar[set].y)}; \
                    const f32x4 r = {bflo(rr[set].x), bfhi(rr[set].x), bflo(rr[set].y), bfhi(rr[set].y)}; \
                    const f32x4 w = {1.f - h2f_(dr[set].x & 0xffffu), 1.f - h2f_(dr[set].x >> 16), 1.f - h2f_(dr[set].y & 0xffffu), 1.f - h2f_(dr[set].y >> 16)}; \
                    f32x4 kk = k * kkw; const float n2 = dpp_sum16((kk[0] * kk[0] + kk[1] * kk[1]) + (kk[2] * kk[2] + kk[3] * kk[3])); kk = kk * (1.f / fmaxf(sqrtf(n2), 1e-12f)); \
                    *(f32x4*)(L) = w; *(f32x4*)(L + 1 * TCH * 64) = -kk; *(f32x4*)(L + 2 * TCH * 64) = kk * a; *(f32x4*)(L + 3 * TCH * 64) = k * (1.f + (a - 1.f) * kaw); *(f32x4*)(L + 4 * TCH * 64) = r; \
                    if ((lane & 15) < 4) *(f32x4*)(lds + (buf) * BUFF + 5 * TCH * 64 + (pw * 4 + tl) * 16 + (lane & 3) * 4) = (f32x4){bflo(vr[set].x), bfhi(vr[set].x), bflo(vr[set].y), bfhi(vr[set].y)}; } while (0)
            auto flush = [&](int ch) { const int i = tid - 256, tt = i >> 4, row = i & 15; const f32x4* pp = (const f32x4*)(Lout + (ch & 1) * OBUF + i * 16);
                const f32x4 s4 = pp[0] + pp[1] + pp[2] + pp[3];
                Y[((size_t)b * SEQ + ch * TCH + tt) * 1024 + h * 64 + rq * 16 + row] = (bf16_t)f2bf((s4[0] + s4[1]) + (s4[2] + s4[3])); };
            constexpr int NCH = SEQ / TCH;
            RW_ISSUE(0, 0); RW_ISSUE(1, 1); RW_ISSUE(2, 2); RW_ISSUE(3, 3);
            RW_STAGE(0, 0);
            __syncthreads();
            for (int c4_ = 0; c4_ < NCH; c4_ += 4) {
#define RW_ITER(q) do { const int ch = c4_ + (q); RW_STAGE(((q) + 1) & 3, (ch + 1) & 1); { const int chn = (ch + 4 < NCH) ? ch + 4 : NCH - 1; RW_ISSUE((q), chn); } flush(ch > 0 ? ch - 1 : 0); __syncthreads(); } while (0)
                RW_ITER(0); RW_ITER(1); RW_ITER(2); RW_ITER(3);
            }
            flush(NCH - 1);
        } else {
            const int j = lane & 15, rowl = wave * 4 + (lane >> 4);
            f32x2 S01 = {0.f, 0.f}, S23 = {0.f, 0.f};
            __syncthreads();
            for (int ch = 0; ch < SEQ / TCH; ++ch) {
                const float* L = lds + (ch & 1) * BUFF + j * 4; const float* Lv = lds + (ch & 1) * BUFF + 5 * TCH * 64 + rowl; float* Lo = Lout + (ch & 1) * OBUF + rowl * 16 + j;
                f32x4 w4 = *(const f32x4*)(L), a4 = *(const f32x4*)(L + 1 * TCH * 64), b4 = *(const f32x4*)(L + 2 * TCH * 64), k4 = *(const f32x4*)(L + 3 * TCH * 64), r4 = *(const f32x4*)(L + 4 * TCH * 64);
                float vv = Lv[0];
#pragma unroll
                for (int tt = 0; tt < TCH; ++tt) {
                    f32x4 nw4 = w4, na4 = a4, nb4 = b4, nk4 = k4, nr4 = r4; float nvv = vv;
                    if (tt + 1 < TCH) { const float* Ln = L + (tt + 1) * 64; nw4 = *(const f32x4*)(Ln); na4 = *(const f32x4*)(Ln + 1 * TCH * 64); nb4 = *(const f32x4*)(Ln + 2 * TCH * 64); nk4 = *(const f32x4*)(Ln + 3 * TCH * 64); nr4 = *(const f32x4*)(Ln + 4 * TCH * 64); nvv = Lv[(tt + 1) * 16]; }
                    f32x2 d = S01 * (f32x2){a4[0], a4[1]}; d = S23 * (f32x2){a4[2], a4[3]} + d;
                    const float sa = dpp_sum16(d[0] + d[1]);
                    const f32x2 sa2 = {sa, sa}, v2 = {vv, vv};
                    const f32x2 t01 = sa2 * (f32x2){b4[0], b4[1]} + v2 * (f32x2){k4[0], k4[1]}, t23 = sa2 * (f32x2){b4[2], b4[3]} + v2 * (f32x2){k4[2], k4[3]};
                    S01 = S01 * (f32x2){w4[0], w4[1]} + t01; S23 = S23 * (f32x2){w4[2], w4[3]} + t23;
                    f32x2 y = S01 * (f32x2){r4[0], r4[1]}; y = S23 * (f32x2){r4[2], r4[3]} + y;
                    Lo[tt * 256] = y[0] + y[1];
                    w4 = nw4; a4 = na4; b4 = nb4; k4 = nk4; r4 = nr4; vv = nvv;
                }
                __syncthreads();
            }
        }
    }
}

__device__ __forceinline__ void rwkv_post(const Params& p, bf16_t* R, const bf16_t* Kk, const bf16_t* Vv, const bf16_t* AA, const bf16_t* G, const bf16_t* Y, int bid, int nb) {
    const int wave = threadIdx.x >> 6, lane = threadIdx.x & 63;
    for (int it = bid * 8 + wave; it < MTOK * 16; it += nb * 8) {
        const int h = it & 15; const size_t off = (size_t)(it >> 4) * 1024 + h * 64 + lane;
        const float y = bf2f(Y[off]), r = bf2f(R[off]), k = bf2f(Kk[off]), v = bf2f(Vv[off]), a = bf2f(AA[off]), g = bf2f(G[off]);
        const float mean = wave_sum(y) * (1.f / 64.f); const float d = y - mean; const float var = wave_sum(d * d) * (1.f / 64.f);
        const float k2 = k * (1.f + (a - 1.f) * p.in[42][h * 64 + lane]);
        const float sb = wave_sum(r * k2 * p.in[43][h * 64 + lane]);
        const float yn = d * rsqrtf(var + 64e-5f) * p.in[44][h * 64 + lane] + p.in[45][h * 64 + lane] + sb * v;
        R[off] = (bf16_t)f2bf(yn * g);
    }
}

#define XB_TMO      128
#define XB_XCNT(j)  (256  + 64 * (j))
#define XB_XSUB(j)  (1280 + 64 * (j))
#define XB_XGEN(j)  (2304 + 64 * (j))
#define XB_TOP      3328
#define XB_TOPGEN   3392
#define XCD_BAR_WORDS 3456
#define XB_SPIN_CAP (1u << 18)
__device__ __forceinline__ unsigned xb_ld(unsigned* p)              { return __hip_atomic_load(p, __ATOMIC_RELAXED, __HIP_MEMORY_SCOPE_AGENT); }
__device__ __forceinline__ unsigned xb_add(unsigned* p, unsigned v) { return __hip_atomic_fetch_add(p, v, __ATOMIC_RELAXED, __HIP_MEMORY_SCOPE_AGENT); }
__device__ __forceinline__ unsigned xb_xcc_id() { return (unsigned)__builtin_amdgcn_s_getreg((3 << 11) | 20) & 0xFu; }
#define XB_SPIN(cond, bar) do { unsigned _sp = 0; while (cond) { __builtin_amdgcn_s_sleep(1); \
    if ((++_sp & 255u) == 0u) { if (xb_ld(&(bar)[XB_TMO])) break; if (_sp > XB_SPIN_CAP) { atomicAdd(&(bar)[XB_TMO], 1u); break; } } } } while (0)
struct XcdBarrier { unsigned* bar; unsigned x; volatile LAS unsigned* st; };
__device__ __forceinline__ XcdBarrier xcd_barrier_post(unsigned* bar, volatile LAS unsigned* st) {
    XcdBarrier b; b.bar = bar; b.x = xb_xcc_id(); b.st = st;
    if (threadIdx.x == 0) (void)xb_add(&bar[XB_XCNT(b.x)], 1u);
    return b;
}
__device__ __forceinline__ void xcd_barrier_complete(unsigned* bar, unsigned x, unsigned& nloc, unsigned& nx) {
    const unsigned G = gridDim.x * gridDim.y * gridDim.z;
    unsigned sum, cnt, mine, sp = 0u;
    for (;;) {
        sum = 0u; cnt = 0u; mine = 0u;
#pragma unroll
        for (unsigned j = 0; j < 16; ++j) { const unsigned c = xb_ld(&bar[XB_XCNT(j)]); sum += c; cnt += (c > 0u) ? 1u : 0u; mine = (j == x) ? c : mine; }
        if (sum == G) break;
        __builtin_amdgcn_s_sleep(1);
        if ((++sp & 255u) == 0u) { if (xb_ld(&bar[XB_TMO])) break; if (sp > XB_SPIN_CAP) { atomicAdd(&bar[XB_TMO], 1u); break; } }
    }
    nloc = mine > 0u ? mine : 1u; nx = cnt > 0u ? cnt : 1u;
}
__device__ __forceinline__ void xcd_barrier(const XcdBarrier& b) {
    asm volatile("s_waitcnt vmcnt(0)" ::: "memory");
    __syncthreads();
    if (threadIdx.x == 0) {
        unsigned* bar = b.bar;
        __builtin_amdgcn_s_waitcnt(0);
        unsigned nloc = b.st[0], nx = b.st[1];
        if (nloc == 0u) { xcd_barrier_complete(bar, b.x, nloc, nx); b.st[0] = nloc; b.st[1] = nx; }
        const unsigned old = xb_add(&bar[XB_XSUB(b.x)], 1u);
        const unsigned gen = old / nloc;
        if (old + 1u == (gen + 1u) * nloc) {
            __builtin_amdgcn_fence(__ATOMIC_RELEASE, "agent");
            asm volatile("s_waitcnt vmcnt(0)" ::: "memory");
            const unsigned og = xb_add(&bar[XB_TOP], 1u);
            const unsigned tg = og / nx;
            if (og + 1u == (tg + 1u) * nx) xb_add(&bar[XB_TOPGEN], 1u);
            else XB_SPIN(xb_ld(&bar[XB_TOPGEN]) == tg, bar);
            __builtin_amdgcn_fence(__ATOMIC_ACQUIRE, "agent");
            xb_add(&bar[XB_XGEN(b.x)], 1u);
            asm volatile("s_waitcnt vmcnt(0)" ::: "memory");
        } else {
            XB_SPIN(xb_ld(&bar[XB_XGEN(b.x)]) == gen, bar);
            __builtin_amdgcn_fence(__ATOMIC_ACQUIRE, "agent");
            asm volatile("s_waitcnt vmcnt(0)" ::: "memory");
        }
    }
    __syncthreads();
}

__global__ void __launch_bounds__(NTHR) fwd_kernel(Params p) {
    extern __shared__ __attribute__((aligned(16))) unsigned char lds_raw[];
    LAS unsigned char* lds = (LAS unsigned char*)lds_raw;
    float* ldsf = (float*)lds_raw;
    const int bid = blockIdx.x, nb = gridDim.x;
    unsigned char* ws = p.ws;
    float* mod = (float*)(ws + OFF_MOD);
    const bool multi = (p.ph_hi - p.ph_lo) > 1;
    __shared__ unsigned xb_st[4];
    if (threadIdx.x < 4) xb_st[threadIdx.x] = 0u;
    __syncthreads();
    XcdBarrier xbar; xbar.bar = (unsigned*)(ws + OFF_BAR); xbar.x = 0; xbar.st = (volatile LAS unsigned*)xb_st;
    if (multi) xbar = xcd_barrier_post((unsigned*)(ws + OFF_BAR), (volatile LAS unsigned*)xb_st);
#ifndef TESTPH
#define TESTPH -1
#endif
#ifndef REPEAT_A
#define REPEAT_A -1
#endif
#ifndef REPEAT_B
#define REPEAT_B -1
#endif
#ifndef EXTRA_SYNCS
#define EXTRA_SYNCS 0
#endif
#define PH(k) if ((TESTPH < 0 || TESTPH == (k)) && p.ph_lo <= (k) && (k) < p.ph_hi) for (int rep_ = 0; rep_ < (((k) == REPEAT_A || (k) == REPEAT_B) ? 2 : 1); ++rep_)
#define SYNC(k) if (multi && (k) + 1 < p.ph_hi) { xcd_barrier(xbar); }
    for (int es_ = 0; es_ < EXTRA_SYNCS; ++es_) cg::this_grid().sync();
    if (p.ph_lo < -1000) cg::this_grid().sync();
    PH(0) { prep_phase(p, ldsf, bid, nb); SYNC(0) }
    PH(1) { norm_phase<false>(p.in[0], p.in[5], mod, 0, 1024, (bf16_t*)(ws + OFF_HA), bid, nb); SYNC(1) }
    PH(2) { EpiWin e{(bf16_t*)(ws + OFF_UX), (bf16_t*)(ws + OFF_QKV)}; gemm_stream(lds, (const bf16_t*)(ws + OFF_HA), (const bf16_t*)(ws + OFF_WIN), 2048, 1024, e, bid, nb); SYNC(2) }
    PH(3) { { EpiS5Z e{(float*)(ws + OFF_Z)}; gemm_batched(lds, (const bf16_t*)(ws + OFF_UX), 640, (size_t)512 * 640, (const bf16_t*)(ws + OFF_BTZ), (size_t)256 * 512, 2, 1, 32, 512, e, NoPre{}, bid, nb); }
            bf16_t* q = (bf16_t*)(ws + OFF_QKV); qknorm_phase(q, q + (size_t)MTOK * 512, (const int*)p.in[2], p.in[20], p.in[21], bid, nb);
            vtrans_phase(q + (size_t)MTOK * 1024, (bf16_t*)(ws + OFF_VT), (bf16_t*)lds_raw, bid, nb); SYNC(3) }
    PH(5) { { EpiS5Y e{(const bf16_t*)(ws + OFF_UX), (bf16_t*)(ws + OFF_YG), p.in[18]}; PreS5Y pre{(const float*)(ws + OFF_Z), (bf16_t*)(ws + OFF_UX), p.in[11], p.in[12], p.in[13]};
              gemm_batched(lds, (const bf16_t*)(ws + OFF_UX), 640, (size_t)512 * 640, (const bf16_t*)(ws + OFF_BTY), (size_t)512 * 640, 2, 2, 32, 640, e, pre, bid, nb); }
            bf16_t* q = (bf16_t*)(ws + OFF_QKV); attn_phase(q, q + (size_t)MTOK * 512, (const bf16_t*)(ws + OFF_VT), (bf16_t*)(ws + OFF_OC), lds, bid, nb); SYNC(5) }
    PH(6) { attn_combine((const bf16_t*)(ws + OFF_OC), (bf16_t*)(ws + OFF_CAT), p, bid, nb);
            EpiGlu e{(const bf16_t*)(ws + OFF_YG), (bf16_t*)(ws + OFF_CAT)}; gemm_phase(lds, (const bf16_t*)(ws + OFF_YG), (const bf16_t*)(ws + OFF_WGLU), 512, 512, e, bid, nb); SYNC(6) }
    PH(7) { EpiRes e{p.in[0], p.out, mod + 2048}; gemm_stream(lds, (const bf16_t*)(ws + OFF_CAT), (const bf16_t*)(ws + OFF_WOUT), 1024, 1024, e, bid, nb); SYNC(7) }
    PH(8) { norm_phase<false>(p.out, p.in[6], mod, 3072, 4096, (bf16_t*)(ws + OFF_HA), bid, nb); SYNC(8) }
    PH(9) { EpiSwiglu e{(bf16_t*)(ws + OFF_HID)}; gemm_stream(lds, (const bf16_t*)(ws + OFF_HA), (const bf16_t*)(ws + OFF_WGU0), 5632, 1024, e, bid, nb); SYNC(9) }
    PH(10) { EpiRes e{p.out, p.out, mod + 5120}; gemm_stream(lds, (const bf16_t*)(ws + OFF_HID), (const bf16_t*)(ws + OFF_WDN0), 1024, FF, e, bid, nb); SYNC(10) }
    const float* mod1 = mod + 4 * 6144;
    PH(11) { norm_phase<true>(p.out, p.in[5] + 1024, mod1, 0, 1024, (bf16_t*)(ws + OFF_HD), bid, nb); SYNC(11) }
    PH(12) { EpiG1 e{(bf16_t*)(ws + OFF_RKV), (bf16_t*)(ws + OFF_L1)}; gemm_stream(lds, (const bf16_t*)(ws + OFF_HD), (const bf16_t*)(ws + OFF_WG1), 3328, 2048, e, bid, nb); SYNC(12) }
    PH(13) { EpiL2 e{(_Float16*)(ws + OFF_DEC), (bf16_t*)(ws + OFF_AA), (bf16_t*)(ws + OFF_G), p.in[33], p.in[36]}; gemm_phase(lds, (const bf16_t*)(ws + OFF_L1), (const bf16_t*)(ws + OFF_WL2), 3072, 256, e, bid, nb); SYNC(13) }
    PH(14) { const bf16_t* r = (const bf16_t*)(ws + OFF_RKV); rwkv_phase(p, r, r + (size_t)MTOK * 1024, r + (size_t)MTOK * 2048, (const _Float16*)(ws + OFF_DEC), (const bf16_t*)(ws + OFF_AA), (bf16_t*)(ws + OFF_Y), ldsf, bid, nb); SYNC(14) }
    PH(15) { bf16_t* r = (bf16_t*)(ws + OFF_RKV); rwkv_post(p, r, r + (size_t)MTOK * 1024, r + (size_t)MTOK * 2048, (const bf16_t*)(ws + OFF_AA), (const bf16_t*)(ws + OFF_G), (const bf16_t*)(ws + OFF_Y), bid, nb); SYNC(15) }
    PH(16) { EpiRes e{p.out, p.out, mod1 + 2048}; gemm_stream(lds, (const bf16_t*)(ws + OFF_RKV), (const bf16_t*)(ws + OFF_WO), 1024, 1024, e, bid, nb); SYNC(16) }
    PH(17) { norm_phase<false>(p.out, p.in[6] + 1024, mod1, 3072, 4096, (bf16_t*)(ws + OFF_HA), bid, nb); SYNC(17) }
    PH(18) { EpiSwiglu e{(bf16_t*)(ws + OFF_HID)}; gemm_stream(lds, (const bf16_t*)(ws + OFF_HA), (const bf16_t*)(ws + OFF_WGU1), 5632, 1024, e, bid, nb); SYNC(18) }
    PH(19) { EpiRes e{p.out, p.out, mod1 + 5120}; gemm_stream(lds, (const bf16_t*)(ws + OFF_HID), (const bf16_t*)(ws + OFF_WDN1), 1024, FF, e, bid, nb); }
}

constexpr int NPHASE = 20;
#ifndef ONE_LAUNCH
#define ONE_LAUNCH 1
#endif

extern "C" void kernel_launch(void* const* d_in, const int* in_sizes, int n_in, void* d_out, int out_size, void* d_ws, size_t ws_size, hipStream_t stream) {
    static int grid = 0;
    if (grid == 0) {
        if (n_in != 46 || ws_size < WS_NEED) { fprintf(stderr, "kernel_launch: unexpected n_in %d / ws_size %zu (need %zu)\n", n_in, ws_size, (size_t)WS_NEED); grid = -1; return; }
        if (hipFuncSetAttribute((const void*)fwd_kernel, hipFuncAttributeMaxDynamicSharedMemorySize, LDS_BYTES) != hipSuccess) { fprintf(stderr, "hipFuncSetAttribute failed\n"); grid = -1; return; }
        int dev = 0, cus = 0, per_cu = 0;
        (void)hipGetDevice(&dev); (void)hipDeviceGetAttribute(&cus, hipDeviceAttributeMultiprocessorCount, dev);
        (void)hipOccupancyMaxActiveBlocksPerMultiprocessor(&per_cu, (const void*)fwd_kernel, NTHR, LDS_BYTES);
        if (per_cu < 1) per_cu = 1;
        grid = cus;
    }
    if (grid < 0) return;
    Params p{};
    for (int i = 0; i < 46; ++i) p.in[i] = (const float*)d_in[i];
    p.out = (float*)d_out; p.ws = (unsigned char*)d_ws;
#if ONE_LAUNCH
    p.ph_lo = 0; p.ph_hi = NPHASE;
    if (hipMemsetAsync((char*)d_ws + OFF_BAR, 0, XCD_BAR_WORDS * 4, stream) != hipSuccess) { fprintf(stderr, "memset failed\n"); return; }
    void* args[] = {&p};
    hipError_t e = hipLaunchCooperativeKernel((const void*)fwd_kernel, dim3(grid), dim3(NTHR), args, LDS_BYTES, stream);
    if (e != hipSuccess) fprintf(stderr, "cooperative launch failed: %s (grid %d)\n", hipGetErrorString(e), grid);
#else
    for (int ph = 0; ph < NPHASE; ++ph) { p.ph_lo = ph; p.ph_hi = ph + 1; hipLaunchKernelGGL(fwd_kernel, dim3(grid), dim3(NTHR), LDS_BYTES, stream, p); }
#endif
}
```

```cpp
#include <hip/hip_runtime.h>
#include <hip/hip_cooperative_groups.h>
#include <cstdio>
#include <cstdint>
namespace cg = cooperative_groups;

#define LAS __attribute__((address_space(3)))
typedef unsigned short bf16_t;
typedef short bf16x8 __attribute__((ext_vector_type(8)));
typedef float f32x4 __attribute__((ext_vector_type(4)));
typedef unsigned u32x2 __attribute__((ext_vector_type(2)));
typedef unsigned u32x4 __attribute__((ext_vector_type(4)));

constexpr int MTOK = 16384, DM = 1024, SEQ = 4096, FF = 2816;
constexpr int NTHR = 512;
constexpr int LDS_BYTES = 131072;
constexpr size_t MiB = 1048576;
constexpr size_t OFF_WIN = 0;
constexpr size_t OFF_WGLU = 4194304;
constexpr size_t OFF_WOUT = 4718592;
constexpr size_t OFF_WGU0 = 6815744;
constexpr size_t OFF_WDN0 = 18350080;
constexpr size_t OFF_WGU1 = 39321600;
constexpr size_t OFF_WDN1 = 50855936;
constexpr size_t OFF_WG1 = 24117248;
constexpr size_t OFF_WL1 = 24117248 + 6291456;
constexpr size_t OFF_WL2 = 37748736;
constexpr size_t OFF_WO = 56623104;
constexpr size_t OFF_MOD = 58720256;
constexpr size_t OFF_BAR = 58916864;
constexpr size_t ACT = 57 * MiB;
constexpr size_t OFF_HA = ACT;
constexpr size_t OFF_UX = ACT + 32 * MiB;
constexpr size_t OFF_Z = ACT + 52 * MiB;
constexpr size_t OFF_BTZ = ACT + 112 * MiB;
constexpr size_t OFF_BTY = ACT + 176 * MiB;
constexpr size_t OFF_QKV = ACT + 64 * MiB;
constexpr size_t OFF_CAT = ACT + 112 * MiB;
constexpr size_t OFF_YG = ACT + 144 * MiB;
constexpr size_t OFF_VT = ACT + 160 * MiB;
constexpr size_t OFF_OC = ACT;
constexpr size_t OFF_HID = ACT + 32 * MiB;
constexpr size_t OFF_HD = ACT;
constexpr size_t OFF_RKV = ACT + 64 * MiB;
constexpr size_t OFF_G = ACT + 160 * MiB;
constexpr size_t OFF_Y = 0;
constexpr size_t OFF_L1 = 0;
constexpr size_t OFF_DEC = ACT;
constexpr size_t OFF_AA = ACT + 32 * MiB;
constexpr size_t WS_NEED = ACT + 196 * MiB;

struct Params {
    const float* in[46];
    float* out;
    unsigned char* ws;
    int ph_lo, ph_hi;
};

__device__ __forceinline__ unsigned f2bf(float f) { unsigned u = __float_as_uint(f); return (u + 0x7fffu + ((u >> 16) & 1u)) >> 16; }
__device__ __forceinline__ float bf2f(unsigned h) { return __uint_as_float(h << 16); }
__device__ __forceinline__ unsigned cvt_pk_bf16(float lo, float hi) { unsigned r; asm("v_cvt_pk_bf16_f32 %0, %1, %2" : "=v"(r) : "v"(lo), "v"(hi)); return r; }
__device__ __forceinline__ unsigned pk2(float lo, float hi) { return cvt_pk_bf16(lo, hi); }
__device__ __forceinline__ float bflo(unsigned w) { return __uint_as_float(w << 16); }
__device__ __forceinline__ float bfhi(unsigned w) { return __uint_as_float(w & 0xffff0000u); }
__device__ __forceinline__ float dpp_sum16(float x) {
    x += __int_as_float(__builtin_amdgcn_update_dpp(0, __float_as_int(x), 0xB1, 0xf, 0xf, true));
    x += __int_as_float(__builtin_amdgcn_update_dpp(0, __float_as_int(x), 0x4E, 0xf, 0xf, true));
    x += __int_as_float(__builtin_amdgcn_update_dpp(0, __float_as_int(x), 0x141, 0xf, 0xf, true));
    x += __int_as_float(__builtin_amdgcn_update_dpp(0, __float_as_int(x), 0x140, 0xf, 0xf, true));
    return x;
}
__device__ __forceinline__ float wave_sum(float v) {
    v = dpp_sum16(v);
    const float s0 = __int_as_float(__builtin_amdgcn_readlane(__float_as_int(v), 0)), s1 = __int_as_float(__builtin_amdgcn_readlane(__float_as_int(v), 16));
    const float s2 = __int_as_float(__builtin_amdgcn_readlane(__float_as_int(v), 32)), s3 = __int_as_float(__builtin_amdgcn_readlane(__float_as_int(v), 48));
    return (s0 + s1) + (s2 + s3);
}
__device__ __forceinline__ float sigmoidf_(float x) { return 1.f / (1.f + __expf(-x)); }
__device__ __forceinline__ float tanh_fast(float x) { const float t = __expf(2.f * fminf(fmaxf(x, -15.f), 15.f)); return (t - 1.f) / (t + 1.f); }
#define LWAIT() asm volatile("s_waitcnt lgkmcnt(0)" ::: "memory")
__device__ __forceinline__ float gelu_tanh(float x) { const float t = tanhf(0.7978845608028654f * (x + 0.044715f * x * x * x)); return 0.5f * x * (1.f + t); }

constexpr int HTB = 128 * 64 * 2;
__device__ __forceinline__ int lds_byte(int r, int c) { int st = (r >> 4) * 2 + (c >> 5), rr = r & 15, cc = c & 31, ob = rr * 64 + cc * 2; return st * 1024 + (ob ^ (((ob >> 9) & 1) << 5)); }
__device__ __forceinline__ void stage_rc(int b, int& R, int& C) { int st = b / 1024, sb = b % 1024, swz = sb ^ (((sb >> 9) & 1) << 5); R = (st >> 1) * 16 + swz / 64; C = (st & 1) * 32 + (swz % 64) / 2; }

struct NoPre { static constexpr bool NOP = true; __device__ __forceinline__ void operator()(int, int, int) const {} };
template <class Epi, class Pre, bool PF = true>
__device__ __forceinline__ void gemm_batched(LAS unsigned char* lds, const bf16_t* A, int lda, size_t strideA, const bf16_t* Bt, size_t strideB, int nMt, int nNt, int nbatch, int K, const Epi& E, const Pre& PRE, int bid, int nb) {
    const int tid = threadIdx.x, wid = __builtin_amdgcn_readfirstlane(tid >> 6), lane = tid & 63, wr = wid >> 2, wc = wid & 3, fr = lane & 15, fq = lane >> 4;
    unsigned voffA[2], voffB[2];
#pragma unroll
    for (int i = 0; i < 2; ++i) { int R, C; stage_rc(tid * 16 + i * 8192, R, C); voffA[i] = (unsigned)(R * lda + C) * 2u; voffB[i] = (unsigned)(R * K + C) * 2u; }
    const int aoff = lds_byte(wr * 64 + fr, fq * 8), boff = lds_byte(wc * 32 + fr, fq * 8);
    const unsigned ldsw = (unsigned)wid * 1024u;
    const size_t kstep = 128, hstepA = (size_t)128 * lda * 2, hstepB = (size_t)128 * K * 2;
    const int nt = K / 64;
    const int ntiles = nMt * nNt * nbatch;
#define G_SA(b, h) (((b) * 2 + (h)) * HTB)
#define G_SB(b, h) ((4 + (b) * 2 + (h)) * HTB)
#define G_STAGEX(bufoff, gptr, vo) do { _Pragma("unroll") for (int _i = 0; _i < 2; ++_i) \
        __builtin_amdgcn_global_load_lds((const unsigned*)((gptr) + vo[_i]), (LAS unsigned*)(lds + (bufoff) + ldsw + _i * 8192), 16, 0, 0); } while (0)
#define G_STA(bufoff, gptr) G_STAGEX(bufoff, gptr, voffA)
#define G_STB(bufoff, gptr) G_STAGEX(bufoff, gptr, voffB)
#define G_LDA(dst, b, h) do { _Pragma("unroll") for (int m = 0; m < 4; ++m) _Pragma("unroll") for (int k = 0; k < 2; ++k) dst[m][k] = *(const LAS bf16x8*)(lds + G_SA(b, h) + aoff + m * 2048 + k * 1024); } while (0)
#define G_LDB(dst, b, h) do { _Pragma("unroll") for (int n = 0; n < 2; ++n) _Pragma("unroll") for (int k = 0; k < 2; ++k) dst[n][k] = *(const LAS bf16x8*)(lds + G_SB(b, h) + boff + n * 2048 + k * 1024); } while (0)
#define G_MMA(ai, bj, At, Bx) do { __builtin_amdgcn_s_setprio(1); _Pragma("unroll") for (int m = 0; m < 4; ++m) _Pragma("unroll") for (int n = 0; n < 2; ++n) _Pragma("unroll") for (int k = 0; k < 2; ++k) \
        acc[ai][bj][m][n] = __builtin_amdgcn_mfma_f32_16x16x32_bf16(Bx[n][k], At[m][k], acc[ai][bj][m][n], 0, 0, 0); __builtin_amdgcn_s_setprio(0); } while (0)
#define G_WV(n) asm volatile("s_waitcnt vmcnt(" #n ")" ::: "memory")
#define G_WL(n) asm volatile("s_waitcnt lgkmcnt(" #n ")" ::: "memory")
#define G_BAR __builtin_amdgcn_s_barrier()
#define G_SCHED __builtin_amdgcn_sched_barrier(0)
    bool prefetched = false;
    for (int tile = bid; tile < ntiles; tile += nb) {
        const int pm = tile % nMt, tq = tile / nMt, pn = tq % nNt, gb = tq / nNt;
        PRE(gb, pm, pn);
        const char* cA = (const char*)(A + (size_t)gb * strideA) + (size_t)pm * 256 * lda * 2;
        const char* cB = (const char*)(Bt + (size_t)gb * strideB) + (size_t)pn * 256 * K * 2;
        f32x4 acc[2][2][4][2];
#pragma unroll
        for (int a = 0; a < 2; ++a)
#pragma unroll
            for (int b = 0; b < 2; ++b)
#pragma unroll
                for (int m = 0; m < 4; ++m)
#pragma unroll
                    for (int n = 0; n < 2; ++n) acc[a][b][m][n] = (f32x4){0.f, 0.f, 0.f, 0.f};
        bf16x8 At[4][2], B0[2][2], B1[2][2];
        if (!prefetched) { G_WV(0); G_STB(G_SB(0, 0), cB); G_STA(G_SA(0, 0), cA); G_STB(G_SB(0, 1), cB + hstepB); G_STA(G_SA(0, 1), cA + hstepA); }
        if (wr == 1) G_BAR;
        if (prefetched) G_WV(0); else G_WV(4);
        G_BAR;
        G_STB(G_SB(1, 0), cB + kstep); G_STA(G_SA(1, 0), cA + kstep); G_STB(G_SB(1, 1), cB + hstepB + kstep);
        G_WV(6); G_BAR;
        for (int t = 0; t < nt - 2; t += 2) {
            const char* a1 = cA + (size_t)(t + 1) * kstep; const char* a2 = cA + (size_t)(t + 2) * kstep; const char* a3 = a2 + kstep;
            const char* b2 = cB + (size_t)(t + 2) * kstep; const char* b3 = b2 + kstep;
            G_LDB(B0, 0, 0); G_SCHED; G_LDA(At, 0, 0); G_STA(G_SA(1, 1), a1 + hstepA);
            G_WL(8); G_BAR; G_WL(0); G_MMA(0, 0, At, B0); G_BAR; G_SCHED;
            G_LDB(B1, 0, 1); G_STB(G_SB(0, 0), b2);
            G_BAR; G_WL(0); G_MMA(0, 1, At, B1); G_BAR;
            G_LDA(At, 0, 1); G_STA(G_SA(0, 0), a2);
            G_BAR; G_WL(0); G_MMA(1, 0, At, B0); G_BAR; G_SCHED;
            G_STB(G_SB(0, 1), b2 + hstepB);
            G_WV(6); G_BAR; G_MMA(1, 1, At, B1); G_BAR;
            G_LDB(B0, 1, 0); G_SCHED; G_LDA(At, 1, 0); G_STA(G_SA(0, 1), a2 + hstepA);
            G_WL(8); G_BAR; G_WL(0); G_MMA(0, 0, At, B0); G_BAR; G_SCHED;
            G_LDB(B1, 1, 1); G_STB(G_SB(1, 0), b3);
            G_BAR; G_WL(0); G_MMA(0, 1, At, B1); G_BAR;
            G_LDA(At, 1, 1); G_STA(G_SA(1, 0), a3);
            G_BAR; G_WL(0); G_MMA(1, 0, At, B0); G_BAR; G_SCHED;
            G_STB(G_SB(1, 1), b3 + hstepB);
            G_WV(6); G_BAR; G_MMA(1, 1, At, B1); G_BAR;
        }
        {
            const char* a1 = cA + (size_t)(nt - 1) * kstep;
            G_LDB(B0, 0, 0); G_LDA(At, 0, 0); G_STA(G_SA(1, 1), a1 + hstepA);
            G_BAR; G_WL(0); G_MMA(0, 0, At, B0); G_BAR;
            G_LDB(B1, 0, 1); G_BAR; G_WL(0); G_MMA(0, 1, At, B1); G_BAR;
            G_LDA(At, 0, 1); G_WV(4); G_BAR; G_WL(0); G_MMA(1, 0, At, B0); G_MMA(1, 1, At, B1); G_BAR;
        }
        {
            G_LDB(B0, 1, 0); G_LDA(At, 1, 0); G_WV(2); G_BAR; G_WL(0); G_MMA(0, 0, At, B0); G_BAR;
            G_LDB(B1, 1, 1); G_WV(0); G_BAR; G_WL(0); G_MMA(0, 1, At, B1); G_BAR;
            G_LDA(At, 1, 1); G_BAR; G_WL(0); G_MMA(1, 0, At, B0); G_MMA(1, 1, At, B1); G_BAR;
        }
        if (wr == 0) G_BAR;
        prefetched = false;
        if (PF && Pre::NOP && tile + nb < ntiles) {
            const int t2 = tile + nb, pm2 = t2 % nMt, tq2 = t2 / nMt, pn2 = tq2 % nNt, gb2 = tq2 / nNt;
            const char* nA = (const char*)(A + (size_t)gb2 * strideA) + (size_t)pm2 * 256 * lda * 2;
            const char* nB = (const char*)(Bt + (size_t)gb2 * strideB) + (size_t)pn2 * 256 * K * 2;
            G_STB(G_SB(0, 0), nB); G_STA(G_SA(0, 0), nA); G_STB(G_SB(0, 1), nB + hstepB); G_STA(G_SA(0, 1), nA + hstepA);
            prefetched = true; }
        E(acc, gb, pm, pn, wr, wc, fr, fq);
    }
    G_WV(0);
    __syncthreads();
}

template <class Epi>
__device__ __forceinline__ void gemm_phase(LAS unsigned char* lds, const bf16_t* A, const bf16_t* Bt, int N, int K, const Epi& E, int bid, int nb) {
    gemm_batched(lds, A, K, 0, Bt, 0, 64, N / 256, 1, K, E, NoPre{}, bid, nb);
}

namespace pg8 {
#define PG8_LAS __attribute__((address_space(3)))
typedef unsigned short bf16_t;
typedef short bf16x8 __attribute__((ext_vector_type(8)));
typedef float f32x4 __attribute__((ext_vector_type(4)));
typedef unsigned u32x4 __attribute__((ext_vector_type(4)));
constexpr int BM = 256, BK = 64, HALF = 128, HTB = HALF * BK * 2  , STAGE_BYTES = 8 * HTB, NXCD = 8, WGM = 8;

__host__ __device__ __forceinline__ int lds_byte(int r, int c) { const int st = (r >> 4) * 2 + (c >> 5), rr = r & 15, cc = c & 31, ob = rr * 64 + cc * 2; return st * 1024 + (ob ^ (((ob >> 9) & 1) << 5)); }
__host__ __device__ __forceinline__ void stage_rc(int b, int& R, int& C) { const int st = b / 1024, sb = b % 1024, swz = sb ^ (((sb >> 9) & 1) << 5); R = (st >> 1) * 16 + swz / 64; C = (st & 1) * 32 + (swz % 64) / 2; }
__host__ __device__ __forceinline__ int perm32(int rho) { const int n = rho >> 4, i = rho & 15; return 8 * (i >> 2) + 4 * n + (i & 3); }

struct Unit { int pm, pn; int ao = 0; };
struct Gemm { const bf16_t* A; const bf16_t* Bt; int M, N, K; int lda; };

struct StaticOrder {
    int nM, nN, nwg, G, c;
    __host__ __device__ void init(int M, int N, int G_, int c_) { nM = M / BM; nN = N / BM; nwg = nM * nN; G = G_; c = c_; }
    __host__ __device__ bool next(int i, Unit& u) const {
        const long L = (long)i * G + c; if (L >= nwg) return false;
        int wgid = (int)L; { const int q = nwg / NXCD, r = nwg % NXCD, xcd = wgid % NXCD, off = wgid / NXCD; wgid = (xcd < r ? xcd * (q + 1) : r * (q + 1) + (xcd - r) * q) + off; }
        const int nig = WGM * nN, gid = wgid / nig, fm = gid * WGM, gsz = (nM - fm) < WGM ? (nM - fm) : WGM;
        u.pm = fm + ((wgid % nig) % gsz); u.pn = (wgid % nig) / gsz; return true;
    }
    __device__ __forceinline__ void a_ready(const Unit&) const {}
    __device__ __forceinline__ void done(const Unit&) const {}
};
template <class Epi, class Sched, bool ALIGN_EPI = false, bool SP2 = false>
__device__ __forceinline__ void gemm_phase(PG8_LAS unsigned char* lds, const Gemm g, const Sched& S, const Epi& E) {
    const int tid = threadIdx.x, wid = __builtin_amdgcn_readfirstlane(tid >> 6), lane = tid & 63, wr = wid >> 2, wc = wid & 3, fr = lane & 15, fq = lane >> 4;
    const int K = g.K, nt = K / BK;
    unsigned voffA[2], voffB[2];
#pragma unroll
    for (int i = 0; i < 2; ++i) { int R, C; stage_rc(tid * 16 + i * 8192, R, C); const int Rb = Epi::PERM ? ((R & ~31) + perm32(R & 31)) : R;
        voffA[i] = (unsigned)(R * g.lda + C) * 2u; voffB[i] = (unsigned)(Rb * K + C) * 2u; }
    const size_t kstep = (size_t)(BK * 2);
    const size_t hstep = (size_t)HALF * K * 2;
    const size_t tstep = 2 * hstep;
    const size_t hstepA = (size_t)HALF * g.lda * 2, tstepA = 2 * hstepA;
    const unsigned ldsw = (unsigned)wid * 1024u;
    const int aoff = lds_byte(wr * 64 + fr, fq * 8), boff = lds_byte(wc * 32 + fr, fq * 8);
#define PG8_SA(b, h) (((b) * 2 + (h)) * HTB)
#define PG8_SB(b, h) ((4 + (b) * 2 + (h)) * HTB)
#define PG8_STAGE(bufoff, gbase, voff) do { _Pragma("unroll") for (int _i = 0; _i < 2; ++_i) \
        __builtin_amdgcn_global_load_lds((const unsigned*)((const char*)(gbase) + (voff)[_i]), (PG8_LAS unsigned*)(lds + (bufoff) + ldsw + _i * 8192), 16, 0, 0); } while (0)
#define PG8_LDA(dst, b, h) do { _Pragma("unroll") for (int m = 0; m < 4; ++m) _Pragma("unroll") for (int k = 0; k < 2; ++k) dst[m][k] = *(const PG8_LAS bf16x8*)(lds + PG8_SA(b, h) + aoff + m * 2048 + k * 1024); } while (0)
#define PG8_LDB(dst, b, h) do { _Pragma("unroll") for (int n = 0; n < 2; ++n) _Pragma("unroll") for (int k = 0; k < 2; ++k) dst[n][k] = *(const PG8_LAS bf16x8*)(lds + PG8_SB(b, h) + boff + n * 2048 + k * 1024); } while (0)
#define PG8_MMA(ai, bj, At, Bt) do { __builtin_amdgcn_s_setprio(1); _Pragma("unroll") for (int m = 0; m < 4; ++m) _Pragma("unroll") for (int n = 0; n < 2; ++n) _Pragma("unroll") for (int k = 0; k < 2; ++k) \
        acc[ai][bj][m][n] = __builtin_amdgcn_mfma_f32_16x16x32_bf16(Bt[n][k], At[m][k], acc[ai][bj][m][n], 0, 0, 0); __builtin_amdgcn_s_setprio(0); } while (0)
#define PG8_WAIT_V(n) asm volatile("s_waitcnt vmcnt(" #n ")" ::: "memory")
#define PG8_WAIT_L(n) asm volatile("s_waitcnt lgkmcnt(" #n ")" ::: "memory")
#define PG8_BAR __builtin_amdgcn_s_barrier()
#define PG8_SCHED __builtin_amdgcn_sched_barrier(0)
    Unit cur, nxt; int ui = 0;
    if (!S.next(0, cur)) return;
    f32x4 acc[2][2][4][2];
#pragma unroll
    for (int a = 0; a < 2; ++a)
#pragma unroll
        for (int b = 0; b < 2; ++b)
#pragma unroll
            for (int m = 0; m < 4; ++m)
#pragma unroll
                for (int n = 0; n < 2; ++n) acc[a][b][m][n] = (f32x4){0.f, 0.f, 0.f, 0.f};
    bf16x8 At[4][2], B0[2][2], B1[2][2];
    const char* cA = (const char*)g.A + (size_t)cur.pm * tstepA + cur.ao; const char* cB = (const char*)g.Bt + (size_t)cur.pn * tstep;
    S.a_ready(cur);
    if constexpr (SP2) {
        PG8_STAGE(PG8_SB(0, 0), cB, voffB); PG8_STAGE(PG8_SB(0, 1), cB + hstep, voffB); PG8_STAGE(PG8_SA(0, 0), cA, voffA); PG8_STAGE(PG8_SA(0, 1), cA + hstepA, voffA);
        if (wr == 1) PG8_BAR;
        PG8_WAIT_V(2); PG8_BAR;
        PG8_STAGE(PG8_SB(1, 0), cB + kstep, voffB); PG8_STAGE(PG8_SA(1, 0), cA + kstep, voffA); PG8_STAGE(PG8_SB(1, 1), cB + hstep + kstep, voffB);
        PG8_WAIT_V(6); PG8_BAR;
    } else {
        PG8_STAGE(PG8_SB(0, 0), cB, voffB); PG8_STAGE(PG8_SA(0, 0), cA, voffA); PG8_STAGE(PG8_SB(0, 1), cB + hstep, voffB); PG8_STAGE(PG8_SA(0, 1), cA + hstepA, voffA);
        if (wr == 1) PG8_BAR;
        PG8_WAIT_V(4); PG8_BAR;
        PG8_STAGE(PG8_SB(1, 0), cB + kstep, voffB); PG8_STAGE(PG8_SA(1, 0), cA + kstep, voffA); PG8_STAGE(PG8_SB(1, 1), cB + hstep + kstep, voffB);
        PG8_WAIT_V(6); PG8_BAR;
    }
    for (;;) {
        const bool has_next = S.next(ui + 1, nxt);
        const char* nA = has_next ? (const char*)g.A + (size_t)nxt.pm * tstepA + nxt.ao : cA; const char* nB = has_next ? (const char*)g.Bt + (size_t)nxt.pn * tstep : cB;
        for (int t = 0; t < nt; t += 2) {
            const bool last = (t == nt - 2);
            const char* a1 = cA + (size_t)(t + 1) * kstep;
            const char* a2 = last ? nA : cA + (size_t)(t + 2) * kstep; const char* b2 = last ? nB : cB + (size_t)(t + 2) * kstep;
            const char* a3 = a2 + kstep; const char* b3 = b2 + kstep;
            if (last && has_next) S.a_ready(nxt);
            if constexpr (SP2) {
            PG8_LDB(B0, 0, 0); PG8_LDB(B1, 0, 1); PG8_SCHED; PG8_LDA(At, 0, 0); PG8_STAGE(PG8_SA(1, 1), a1 + hstepA, voffA);
            PG8_WAIT_V(8); PG8_WAIT_L(0); PG8_BAR; PG8_MMA(0, 0, At, B0); PG8_MMA(0, 1, At, B1); PG8_BAR; PG8_SCHED;
            PG8_LDA(At, 0, 1); PG8_STAGE(PG8_SB(0, 0), b2, voffB); PG8_STAGE(PG8_SB(0, 1), b2 + hstep, voffB); PG8_STAGE(PG8_SA(0, 0), a2, voffA);
            PG8_WAIT_V(8); PG8_WAIT_L(0); PG8_BAR; PG8_MMA(1, 0, At, B0); PG8_MMA(1, 1, At, B1); PG8_BAR; PG8_SCHED;
            PG8_LDB(B0, 1, 0); PG8_LDB(B1, 1, 1); PG8_SCHED; PG8_LDA(At, 1, 0); PG8_STAGE(PG8_SA(0, 1), a2 + hstepA, voffA);
            PG8_WAIT_V(8); PG8_WAIT_L(0); PG8_BAR; PG8_MMA(0, 0, At, B0); PG8_MMA(0, 1, At, B1); PG8_BAR; PG8_SCHED;
            PG8_LDA(At, 1, 1); PG8_STAGE(PG8_SB(1, 0), b3, voffB); PG8_STAGE(PG8_SB(1, 1), b3 + hstep, voffB); PG8_STAGE(PG8_SA(1, 0), a3, voffA);
            PG8_WAIT_V(8); PG8_WAIT_L(0); PG8_BAR; PG8_MMA(1, 0, At, B0); PG8_MMA(1, 1, At, B1); PG8_BAR; PG8_SCHED;
            } else {
            PG8_LDB(B0, 0, 0); PG8_SCHED; PG8_LDA(At, 0, 0); PG8_STAGE(PG8_SA(1, 1), a1 + hstepA, voffA);
            PG8_WAIT_L(8); PG8_BAR; PG8_WAIT_L(0); PG8_MMA(0, 0, At, B0); PG8_BAR; PG8_SCHED;
            PG8_LDB(B1, 0, 1); PG8_STAGE(PG8_SB(0, 0), b2, voffB);
            PG8_BAR; PG8_WAIT_L(0); PG8_MMA(0, 1, At, B1); PG8_BAR;
            PG8_LDA(At, 0, 1); PG8_STAGE(PG8_SA(0, 0), a2, voffA);
            PG8_BAR; PG8_WAIT_L(0); PG8_MMA(1, 0, At, B0); PG8_BAR; PG8_SCHED;
            PG8_STAGE(PG8_SB(0, 1), b2 + hstep, voffB);
            PG8_WAIT_V(6); PG8_BAR; PG8_MMA(1, 1, At, B1); PG8_BAR;
            PG8_LDB(B0, 1, 0); PG8_SCHED; PG8_LDA(At, 1, 0); PG8_STAGE(PG8_SA(0, 1), a2 + hstepA, voffA);
            PG8_WAIT_L(8); PG8_BAR; PG8_WAIT_L(0); PG8_MMA(0, 0, At, B0); PG8_BAR; PG8_SCHED;
            PG8_LDB(B1, 1, 1); PG8_STAGE(PG8_SB(1, 0), b3, voffB);
            PG8_BAR; PG8_WAIT_L(0); PG8_MMA(0, 1, At, B1); PG8_BAR;
            PG8_LDA(At, 1, 1); PG8_STAGE(PG8_SA(1, 0), a3, voffA);
            PG8_BAR; PG8_WAIT_L(0); PG8_MMA(1, 0, At, B0); PG8_BAR; PG8_SCHED;
            PG8_STAGE(PG8_SB(1, 1), b3 + hstep, voffB);
            PG8_WAIT_V(6); PG8_BAR; PG8_MMA(1, 1, At, B1); PG8_BAR;
            }
        }
        if constexpr (ALIGN_EPI) { if (wr == 0) PG8_BAR; }
        if constexpr (!Epi::AFTER_DRAIN) { E(acc, cur, wr, wc, fr, fq); S.done(cur); }
        if (!has_next) break;
#pragma unroll
        for (int a = 0; a < 2; ++a)
#pragma unroll
            for (int b = 0; b < 2; ++b)
#pragma unroll
                for (int m = 0; m < 4; ++m)
#pragma unroll
                    for (int n = 0; n < 2; ++n) acc[a][b][m][n] = (f32x4){0.f, 0.f, 0.f, 0.f};
        cur = nxt; cA = nA; cB = nB; ++ui;
        if constexpr (ALIGN_EPI) { if (wr == 1) PG8_BAR; }
    }
    PG8_WAIT_V(0);
    if constexpr (!ALIGN_EPI) { if (wr == 0) PG8_BAR; }
    PG8_BAR;
    if constexpr (Epi::AFTER_DRAIN) { E.fused(acc, cur, wr, wc, fr, fq, lds, wid, lane); S.done(cur); }
#undef PG8_SA
#undef PG8_SB
#undef PG8_STAGE
#undef PG8_LDA
#undef PG8_LDB
#undef PG8_MMA
#undef PG8_WAIT_V
#undef PG8_WAIT_L
#undef PG8_BAR
#undef PG8_SCHED
}
}

template <class E> struct EpiAdapt { static constexpr bool PERM = false, AFTER_DRAIN = false; E e;
    __device__ __forceinline__ void operator()(const pg8::f32x4 (&acc)[2][2][4][2], const pg8::Unit& u, int wr, int wc, int fr, int fq) const { e(acc, 0, u.pm, u.pn, wr, wc, fr, fq); } };
template <class Epi>
__device__ __forceinline__ void gemm_stream(LAS unsigned char* lds, const bf16_t* A, const bf16_t* Bt, int N, int K, const Epi& E, int bid, int nb) {
    pg8::Gemm g{A, Bt, MTOK, N, K, K}; pg8::StaticOrder S; S.init(MTOK, N, nb, bid);
    EpiAdapt<Epi> ea{E};
    pg8::gemm_phase<EpiAdapt<Epi>, pg8::StaticOrder, true, true>(lds, g, S, ea);
}

#define EPI_LOOP(...) \
    _Pragma("unroll") for (int ai = 0; ai < 2; ++ai) _Pragma("unroll") for (int m = 0; m < 4; ++m) { asm volatile("" ::: "memory"); const int row = pm * 256 + ai * 128 + wr * 64 + m * 16 + fr; \
    _Pragma("unroll") for (int bj = 0; bj < 2; ++bj) _Pragma("unroll") for (int n = 0; n < 2; ++n) { const int ct = bj * 128 + wc * 32 + n * 16 + fq * 4; const f32x4 v = acc[ai][bj][m][n]; __VA_ARGS__ } }

struct EpiWin {
    bf16_t* UX; bf16_t* QKV;
    __device__ __forceinline__ void operator()(const f32x4 (&acc)[2][2][4][2], int gb, int pm, int pn, int wr, int wc, int fr, int fq) const {
        if (pn < 2) {
            bf16_t* base = UX + ((size_t)(pn * 16 + wc * 2) * 512 + (pm >> 4) * 128 + (pm & 15) * 8 + wr * 2) * 640 + fr * 16 + fq * 4;
#pragma unroll
            for (int ai = 0; ai < 2; ++ai)
#pragma unroll
                for (int m = 0; m < 4; ++m) { bf16_t* rp = base + (ai * 4 + (m >> 1)) * 640 + (m & 1) * 256;
#pragma unroll
                    for (int bj = 0; bj < 2; ++bj)
#pragma unroll
                        for (int n = 0; n < 2; ++n) { const f32x4 v = acc[ai][bj][m][n]; u32x2 w; w.x = pk2(v[0], v[1]); w.y = pk2(v[2], v[3]);
                            *(u32x2*)(rp + (size_t)(bj * 8 + n) * (512 * 640)) = w; }
                    asm volatile("" ::: "memory"); }
        } else { bf16_t* base = QKV + (size_t)((pn - 2) >> 1) * ((size_t)MTOK * 512) + (pn & 1) * 256 + (size_t)(pm * 256 + wr * 64 + fr) * 512 + wc * 32 + fq * 4;
#pragma unroll
            for (int ai = 0; ai < 2; ++ai)
#pragma unroll
                for (int m = 0; m < 4; ++m) { bf16_t* rp = base + (size_t)(ai * 128 + m * 16) * 512;
#pragma unroll
                    for (int bj = 0; bj < 2; ++bj)
#pragma unroll
                        for (int n = 0; n < 2; ++n) { const f32x4 v = acc[ai][bj][m][n]; u32x2 w; w.x = pk2(v[0], v[1]); w.y = pk2(v[2], v[3]);
                            *(u32x2*)(rp + bj * 128 + n * 16) = w; }
                    asm volatile("" ::: "memory"); }
        }
    }
};
struct EpiS5Z {
    float* Z;
    __device__ __forceinline__ void operator()(const f32x4 (&acc)[2][2][4][2], int gb, int pm, int pn, int wr, int wc, int fr, int fq) const {
        EPI_LOOP({ if (bj == 0) *(f32x4*)(Z + ((size_t)gb * 512 + row) * 128 + ct) = v; })
    }
};
struct EpiS5Y {
    const bf16_t* UX; bf16_t* YG; const float* dsk;
    __device__ __forceinline__ void operator()(const f32x4 (&acc)[2][2][4][2], int gb, int pm, int pn, int wr, int wc, int fr, int fq) const {
        EPI_LOOP({ const int col = pn * 256 + ct, t = col >> 4, h = col & 15, bb = row >> 7, cc = row & 127;
            const u32x2 uu = *(const u32x2*)(UX + ((size_t)gb * 512 + row) * 640 + col); const f32x4 dd = *(const f32x4*)(dsk + gb * 16 + h);
            u32x2 w; w.x = pk2(gelu_tanh(v[0] + dd[0] * bflo(uu.x)), gelu_tanh(v[1] + dd[1] * bfhi(uu.x))); w.y = pk2(gelu_tanh(v[2] + dd[2] * bflo(uu.y)), gelu_tanh(v[3] + dd[3] * bfhi(uu.y)));
            *(u32x2*)(YG + ((size_t)bb * SEQ + cc * 32 + t) * 512 + gb * 16 + h) = w; })
    }
};
struct PreS5Y {   static constexpr bool NOP = false;
    const float* Z; bf16_t* UX; const float* lam_re; const float* lam_im; const float* log_dt;
    __device__ __forceinline__ void operator()(int gb, int pm, int pn) const {
        const int tid = threadIdx.x;
        if (tid < 128) { const int pp = tid & 63, bb = 2 * pm + (tid >> 6);
            const float lr = lam_re[gb * 64 + pp], li = lam_im[gb * 64 + pp], dt = expf(log_dt[gb]);
            const float mag = expf(lr * dt * 32.f), ar = mag * cosf(li * dt * 32.f), ai = mag * sinf(li * dt * 32.f);
            const float* zp = Z + ((size_t)gb * 512 + bb * 128) * 128 + pp; bf16_t* xp = UX + ((size_t)gb * 512 + bb * 128) * 640 + 512 + pp;
            float xr = 0.f, xi = 0.f;
            for (int c0 = 0; c0 < 128; c0 += 16) { float zr[16], zi[16];
#pragma unroll
                for (int i = 0; i < 16; ++i) { zr[i] = zp[(size_t)(c0 + i) * 128]; zi[i] = zp[(size_t)(c0 + i) * 128 + 64]; }
#pragma unroll
                for (int i = 0; i < 16; ++i) { xp[(size_t)(c0 + i) * 640] = (bf16_t)f2bf(xr); xp[(size_t)(c0 + i) * 640 + 64] = (bf16_t)f2bf(xi);
                    const float nr = ar * xr - ai * xi + zr[i], ni = ar * xi + ai * xr + zi[i]; xr = nr; xi = ni; } } }
        __threadfence();
        asm volatile("s_waitcnt vmcnt(0)" ::: "memory");
        __syncthreads();
    }
};
struct EpiGlu {
    const bf16_t* YG; bf16_t* CAT;
    __device__ __forceinline__ void operator()(const f32x4 (&acc)[2][2][4][2], int gb, int pm, int pn, int wr, int wc, int fr, int fq) const {
        EPI_LOOP({ const int col = pn * 256 + ct; const u32x2 y = *(const u32x2*)(YG + (size_t)row * 512 + col);
            u32x2 w; w.x = pk2(bflo(y.x) * sigmoidf_(v[0]), bfhi(y.x) * sigmoidf_(v[1])); w.y = pk2(bflo(y.y) * sigmoidf_(v[2]), bfhi(y.y) * sigmoidf_(v[3]));
            *(u32x2*)(CAT + (size_t)row * 1024 + col) = w; })
    }
};
struct EpiRes {
    const float* res; float* out; const float* gate;
    __device__ __forceinline__ void operator()(const f32x4 (&acc)[2][2][4][2], int gb, int pm, int pn, int wr, int wc, int fr, int fq) const {
        const float* gatep = gate + (size_t)(pm >> 4) * 6144;
        EPI_LOOP({ const int col = pn * 256 + ct; const f32x4 g = *(const f32x4*)(gatep + col); const f32x4 r = *(const f32x4*)(res + (size_t)row * 1024 + col);
            *(f32x4*)(out + (size_t)row * 1024 + col) = r + g * v; })
    }
};
struct EpiSwiglu {
    bf16_t* HID;
    __device__ __forceinline__ void operator()(const f32x4 (&acc)[2][2][4][2], int gb, int pm, int pn, int wr, int wc, int fr, int fq) const {
#pragma unroll
        for (int ai = 0; ai < 2; ++ai)
#pragma unroll
            for (int m = 0; m < 4; ++m) { const int row = pm * 256 + ai * 128 + wr * 64 + m * 16 + fr;
#pragma unroll
                for (int n = 0; n < 2; ++n) { const f32x4 g = acc[ai][0][m][n], u = acc[ai][1][m][n]; float o[4];
#pragma unroll
                    for (int j = 0; j < 4; ++j) o[j] = g[j] * sigmoidf_(g[j]) * u[j];
                    u32x2 w; w.x = pk2(o[0], o[1]); w.y = pk2(o[2], o[3]);
                    *(u32x2*)(HID + (size_t)row * FF + pn * 128 + wc * 32 + n * 16 + fq * 4) = w; } }
    }
};
struct EpiRKV {
    bf16_t* RKV; int row0;
    __device__ __forceinline__ void operator()(const f32x4 (&acc)[2][2][4][2], int gb, int pm, int pn, int wr, int wc, int fr, int fq) const {
        bf16_t* base = RKV + (size_t)gb * ((size_t)MTOK * 1024) + (size_t)row0 * 1024 + pn * 256;
        EPI_LOOP({ u32x2 w; w.x = pk2(v[0], v[1]); w.y = pk2(v[2], v[3]); *(u32x2*)(base + (size_t)row * 1024 + ct) = w; })
    }
};
struct EpiL1 {
    bf16_t* L1; int row0;
    __device__ __forceinline__ void operator()(const f32x4 (&acc)[2][2][4][2], int gb, int pm, int pn, int wr, int wc, int fr, int fq) const {
        bf16_t* base = L1 + (size_t)(row0 + pm * 256 + wr * 64 + fr) * 256 + wc * 32 + fq * 4;
        const bool ident = (wc >= 2);
#pragma unroll
        for (int ai = 0; ai < 2; ++ai)
#pragma unroll
            for (int m = 0; m < 4; ++m) { bf16_t* rp = base + (size_t)(ai * 128 + m * 16) * 256;
#pragma unroll
                for (int bj = 0; bj < 2; ++bj) { const float sc = bj ? 1.f : 2.f, of = bj ? 0.f : -1.f;
#pragma unroll
                    for (int n = 0; n < 2; ++n) { const f32x4 v = acc[ai][bj][m][n]; float o[4];
#pragma unroll
                        for (int j = 0; j < 4; ++j) { const float sg = sc * __builtin_amdgcn_rcpf(1.f + __expf(-sc * v[j])) + of; o[j] = (bj == 0 && ident) ? v[j] : sg; }
                        u32x2 w; w.x = pk2(o[0], o[1]); w.y = pk2(o[2], o[3]); *(u32x2*)(rp + bj * 128 + n * 16) = w; } }
                asm volatile("" ::: "memory"); }
    }
};
struct EpiL2 {
    _Float16* DEC; bf16_t* AA; bf16_t* G; const float* w0; const float* a0;
    __device__ __forceinline__ void operator()(const f32x4 (&acc)[2][2][4][2], int gb, int pm, int pn, int wr, int wc, int fr, int fq) const {
        const int sel = pn >> 2, cb = (pn & 3) * 256;
        if (sel == 0) { EPI_LOOP({ const int col = cb + ct; const f32x4 w0v = *(const f32x4*)(w0 + col);
                _Pragma("unroll") for (int j = 0; j < 4; ++j) { const float z = w0v[j] + v[j]; const float sp = fmaxf(-z, 0.f) + log1pf(expf(-fabsf(z))); const float e = expf(-sp - 0.5f);
                    DEC[(size_t)row * 1024 + col + j] = (_Float16)(-expm1f(-e)); } }) }
        else if (sel == 1) { EPI_LOOP({ const int col = cb + ct; const f32x4 a0v = *(const f32x4*)(a0 + col);
                u32x2 w; w.x = pk2(sigmoidf_(a0v[0] + v[0]), sigmoidf_(a0v[1] + v[1])); w.y = pk2(sigmoidf_(a0v[2] + v[2]), sigmoidf_(a0v[3] + v[3]));
                *(u32x2*)(AA + (size_t)row * 1024 + col) = w; }) }
        else { EPI_LOOP({ const int col = cb + ct; u32x2 w; w.x = pk2(v[0], v[1]); w.y = pk2(v[2], v[3]); *(u32x2*)(G + (size_t)row * 1024 + col) = w; }) }
    }
};


struct SchedRKV { int vb, vn;
    __device__ bool next(int i, pg8::Unit& u) const { const int t = vb + i * vn; if (vb < 0 || t >= 384) return false; u.pm = t & 31; u.pn = t >> 5; u.ao = (u.pn >> 2) * 2048; return true; }
    __device__ __forceinline__ void a_ready(const pg8::Unit&) const {}
    __device__ __forceinline__ void done(const pg8::Unit&) const {} };
struct SchedOne { int pm;
    __device__ bool next(int i, pg8::Unit& u) const { if (i > 0 || pm < 0) return false; u.pm = pm; u.pn = 0; u.ao = 0; return true; }
    __device__ __forceinline__ void a_ready(const pg8::Unit&) const {}
    __device__ __forceinline__ void done(const pg8::Unit&) const {} };
struct EpiAdaptRKV { static constexpr bool PERM = false, AFTER_DRAIN = false; EpiRKV e;
    __device__ __forceinline__ void operator()(const pg8::f32x4 (&acc)[2][2][4][2], const pg8::Unit& u, int wr, int wc, int fr, int fq) const { e(acc, u.pn >> 2, u.pm, u.pn & 3, wr, wc, fr, fq); } };
__device__ __forceinline__ void s5_gen(const Params& p, bf16_t* BtY, bf16_t* BtZ, float* lds, int bid, int nb) {
    float* PWr = lds; float* PWi = lds + 33 * 64; float* BBr = lds + 66 * 64; float* BBi = BBr + 1024; float* Cr = BBi + 1024; float* Ci = Cr + 1024; float* Kt = Ci + 1024;
    const int tid = threadIdx.x;
    for (int unit = bid; unit < 256; unit += nb) {
        const int g = unit >> 3, part = unit & 7;
        __syncthreads();
        if (tid < 64) { const int pp = tid; const float lr = p.in[11][g * 64 + pp], li = p.in[12][g * 64 + pp], dt = expf(p.in[13][g]);
            for (int tau = 0; tau <= 32; ++tau) { const float mag = expf(lr * dt * (float)tau), ang = li * dt * (float)tau; PWr[tau * 64 + pp] = mag * cosf(ang); PWi[tau * 64 + pp] = mag * sinf(ang); }
            const float ar = PWr[64 + pp], ai = PWi[64 + pp], den = lr * lr + li * li, nr = ar - 1.f;
            const float qr = (nr * lr + ai * li) / den, qi = (ai * lr - nr * li) / den;
            for (int h = 0; h < 16; ++h) { const float br = p.in[14][(size_t)(g * 64 + pp) * 16 + h], bi = p.in[15][(size_t)(g * 64 + pp) * 16 + h]; BBr[pp * 16 + h] = qr * br - qi * bi; BBi[pp * 16 + h] = qr * bi + qi * br; } }
        for (int i = tid; i < 1024; i += NTHR) { Cr[i] = p.in[16][(size_t)g * 1024 + i]; Ci[i] = p.in[17][(size_t)g * 1024 + i]; }
        __syncthreads();
        for (int e = tid; e < 8192; e += NTHR) { const int tau = e >> 8, h = (e >> 4) & 15, h2 = e & 15; float acc = 0.f;
            for (int pp = 0; pp < 64; ++pp) { const float cr = Cr[h * 64 + pp], ci = Ci[h * 64 + pp], wr = PWr[tau * 64 + pp], wi = PWi[tau * 64 + pp];
                const float er = cr * wr - ci * wi, ei = cr * wi + ci * wr; acc += er * BBr[pp * 16 + h2] - ei * BBi[pp * 16 + h2]; }
            Kt[e] = acc; }
        __syncthreads();
        for (int ci_ = tid; ci_ < 5120; ci_ += NTHR) { const int nrow = part * 64 + ci_ / 80, kc = (ci_ % 80) * 8, t = nrow >> 4, h = nrow & 15; float v[8];
#pragma unroll
            for (int i = 0; i < 8; ++i) { const int k = kc + i;
                if (k < 512) { const int sidx = k >> 4, h2 = k & 15; v[i] = (sidx <= t) ? Kt[(t - sidx) * 256 + h * 16 + h2] : 0.f; }
                else { const int jj = k - 512, pp = jj & 63; const float cr = Cr[h * 64 + pp], ci = Ci[h * 64 + pp], wr = PWr[(t + 1) * 64 + pp], wi = PWi[(t + 1) * 64 + pp];
                    v[i] = (jj >> 6) ? -(cr * wi + ci * wr) : (cr * wr - ci * wi); } }
            *(u32x4*)(BtY + ((size_t)g * 512 + nrow) * 640 + kc) = (u32x4){pk2(v[0], v[1]), pk2(v[2], v[3]), pk2(v[4], v[5]), pk2(v[6], v[7])}; }
        for (int ci_ = tid; ci_ < 1024; ci_ += NTHR) { const int n = part * 16 + (ci_ >> 6), kc = (ci_ & 63) * 8, pp = n & 63, im = n >> 6; float v[8];
#pragma unroll
            for (int i = 0; i < 8; ++i) { const int k = kc + i, sidx = k >> 4, h2 = k & 15, tau = 31 - sidx; const float wr = PWr[tau * 64 + pp], wi = PWi[tau * 64 + pp], br = BBr[pp * 16 + h2], bi = BBi[pp * 16 + h2];
                v[i] = im ? (wr * bi + wi * br) : (wr * br - wi * bi); }
            *(u32x4*)(BtZ + ((size_t)g * 256 + n) * 512 + kc) = (u32x4){pk2(v[0], v[1]), pk2(v[2], v[3]), pk2(v[4], v[5]), pk2(v[6], v[7])}; }
    }
    __syncthreads();
}

template <int MODE>
__device__ __forceinline__ void tr_job(const float* src, int K, int N, bf16_t* dst, int ldd, int row_off, int koff, const float* scale, float* lds, int bid, int nb, const float* scale2 = nullptr) {
    const int tk = K / 64, tn = N / 64, tid = threadIdx.x, nt_ = tk * tn;
    const int r = tid >> 3, c = (tid & 7) * 8;
    float4 a = {0.f, 0.f, 0.f, 0.f}, b = a; float sc = 1.f;
    if (bid < nt_) { const int k0 = (bid / tn) * 64, n0 = (bid % tn) * 64; const float* p = src + (size_t)(k0 + r) * N + n0 + c; a = *(const float4*)p; b = *(const float4*)(p + 4); sc = scale ? scale[k0 + r] - (scale2 ? scale2[k0 + r] : 0.f) : 1.f; }
    for (int t = bid; t < nt_; t += nb) {
        const int k0 = (t / tn) * 64, n0 = (t % tn) * 64;
        { float* l = lds + r * 65 + c; l[0] = a.x * sc; l[1] = a.y * sc; l[2] = a.z * sc; l[3] = a.w * sc; l[4] = b.x * sc; l[5] = b.y * sc; l[6] = b.z * sc; l[7] = b.w * sc; }
        if (t + nb < nt_) { const int t2 = t + nb, k2 = (t2 / tn) * 64, n2 = (t2 % tn) * 64; const float* p = src + (size_t)(k2 + r) * N + n2 + c; a = *(const float4*)p; b = *(const float4*)(p + 4); sc = scale ? scale[k2 + r] - (scale2 ? scale2[k2 + r] : 0.f) : 1.f; }
        __syncthreads();
        { const int nl = tid >> 3, kc = (tid & 7) * 8; float v[8];
#pragma unroll
          for (int i = 0; i < 8; ++i) v[i] = lds[(kc + i) * 65 + nl];
          int n = n0 + nl; int rowi = n;
          if (MODE == 1) rowi = (n >> 7) * 256 + (n & 127);
          if (MODE == 2) rowi = (n >> 7) * 256 + 128 + (n & 127);
          u32x4 w; w.x = pk2(v[0], v[1]); w.y = pk2(v[2], v[3]); w.z = pk2(v[4], v[5]); w.w = pk2(v[6], v[7]);
          *(u32x4*)(dst + (size_t)(row_off + rowi) * ldd + koff + k0 + kc) = w; }
        __syncthreads();
    }
}

__device__ __forceinline__ void prep_phase(const Params& p, float* lds, int bid, int nb) {
    unsigned char* ws = p.ws;
    s5_gen(p, (bf16_t*)(ws + OFF_BTY), (bf16_t*)(ws + OFF_BTZ), lds, bid, nb);
    tr_job<0>(p.in[10], 1024, 2048, (bf16_t*)(ws + OFF_WIN), 1024, 0, 0, nullptr, lds, bid, nb);
    tr_job<0>(p.in[19], 512, 512, (bf16_t*)(ws + OFF_WGLU), 512, 0, 0, nullptr, lds, bid, nb);
    tr_job<0>(p.in[27], 1024, 1024, (bf16_t*)(ws + OFF_WOUT), 1024, 0, 0, nullptr, lds, bid, nb);
    for (int l = 0; l < 2; ++l) {
        bf16_t* gu = (bf16_t*)(ws + (l ? OFF_WGU1 : OFF_WGU0)); bf16_t* dn = (bf16_t*)(ws + (l ? OFF_WDN1 : OFF_WDN0));
        tr_job<1>(p.in[7] + (size_t)l * 1024 * FF, 1024, FF, gu, 1024, 0, 0, nullptr, lds, bid, nb);
        tr_job<2>(p.in[8] + (size_t)l * 1024 * FF, 1024, FF, gu, 1024, 0, 0, nullptr, lds, bid, nb);
        tr_job<0>(p.in[9] + (size_t)l * FF * 1024, FF, 1024, dn, FF, 0, 0, nullptr, lds, bid, nb);
    }
    bf16_t* wrkv = (bf16_t*)(ws + OFF_WG1); bf16_t* wl1 = (bf16_t*)(ws + OFF_WL1); const float* mu = p.in[28];
    tr_job<0>(p.in[29], 1024, 1024, wrkv, 1024, 0, 0, nullptr, lds, bid, nb);
    tr_job<0>(p.in[30], 1024, 1024, wrkv, 1024, 1024, 0, nullptr, lds, bid, nb);
    tr_job<0>(p.in[31], 1024, 1024, wrkv, 1024, 2048, 0, nullptr, lds, bid, nb);
    tr_job<0>(p.in[34], 1024, 64, wl1, 2048, 0, 0, nullptr, lds, bid, nb);      tr_job<0>(p.in[34], 1024, 64, wl1, 2048, 0, 1024, mu + 1 * 1024, lds, bid, nb, mu + 3 * 1024);
    tr_job<0>(p.in[37], 1024, 64, wl1, 2048, 64, 0, nullptr, lds, bid, nb);     tr_job<0>(p.in[37], 1024, 64, wl1, 2048, 64, 1024, mu + 4 * 1024, lds, bid, nb, mu + 3 * 1024);
    tr_job<0>(p.in[39], 1024, 128, wl1, 2048, 128, 0, nullptr, lds, bid, nb);   tr_job<0>(p.in[39], 1024, 128, wl1, 2048, 128, 1024, mu + 5 * 1024, lds, bid, nb, mu + 3 * 1024);
    bf16_t* l2 = (bf16_t*)(ws + OFF_WL2);
    tr_job<0>(p.in[35], 64, 1024, l2, 256, 0, 0, nullptr, lds, bid, nb);
    tr_job<0>(p.in[38], 64, 1024, l2, 256, 1024, 64, nullptr, lds, bid, nb);
    tr_job<0>(p.in[40], 128, 1024, l2, 256, 2048, 128, nullptr, lds, bid, nb);
    for (int i = bid * NTHR + threadIdx.x; i < 3072 * 32; i += nb * NTHR) { const int n = i >> 5, kc = (i & 31) * 8; const int sel = n >> 10;
        const bool used = (sel == 0) ? (kc < 64) : (sel == 1) ? (kc >= 64 && kc < 128) : (kc >= 128);
        if (!used) *(u32x4*)(l2 + (size_t)n * 256 + kc) = (u32x4){0u, 0u, 0u, 0u}; }
    tr_job<0>(p.in[32], 1024, 1024, (bf16_t*)(ws + OFF_WO), 1024, 0, 0, nullptr, lds, bid, nb);
    {   const float* c = p.in[1]; const float* wada = p.in[3]; const float* bada = p.in[4]; float* mod = (float*)(ws + OFF_MOD);
        float* cact = lds;
        float* red = lds + 4096;
        for (int i = threadIdx.x; i < 4096; i += NTHR) { const float x = c[i]; cact[i] = x / (1.f + expf(-x)); }
        __syncthreads();
        const int col = threadIdx.x & 63, kg = threadIdx.x >> 6;
        for (int ch = bid; ch < 192; ch += nb) {
            const int l = ch / 96, n0 = (ch % 96) * 64;
            const float* wp = wada + (size_t)l * 1024 * 6144 + n0 + col;
            float a0 = 0.f, a1 = 0.f, a2 = 0.f, a3 = 0.f;
            for (int k = kg * 128; k < kg * 128 + 128; ++k) { const float w = wp[(size_t)k * 6144]; a0 += cact[k] * w; a1 += cact[1024 + k] * w; a2 += cact[2048 + k] * w; a3 += cact[3072 + k] * w; }
            red[(kg * 4 + 0) * 64 + col] = a0; red[(kg * 4 + 1) * 64 + col] = a1; red[(kg * 4 + 2) * 64 + col] = a2; red[(kg * 4 + 3) * 64 + col] = a3;
            __syncthreads();
            if (threadIdx.x < 256) { const int b = threadIdx.x >> 6; float s = 0.f;
#pragma unroll
                for (int g = 0; g < 8; ++g) s += red[(g * 4 + b) * 64 + col];
                mod[(size_t)(l * 4 + b) * 6144 + n0 + col] = s + bada[l * 6144 + n0 + col]; }
            __syncthreads();
        }
    }
}

template <bool RW>
__device__ __forceinline__ void norm_phase(const float* x, const float* g, const float* modl, int shift_off, int scale_off, bf16_t* out, int bid, int nb, int row0 = 0, int nrows = MTOK, const float* mu = nullptr) {
    const int wave = threadIdx.x >> 6, lane = threadIdx.x & 63;
    for (int row = row0 + bid * 8 + wave; row < row0 + nrows; row += nb * 8) {
        const int b = row >> 12; const float* xr = x + (size_t)row * 1024; const float* md = modl + (size_t)b * 6144;
        f32x4 v[4], vp[4]; float ss = 0.f, ssp = 0.f; const bool hasp = RW && ((row & 4095) != 0);
#pragma unroll
        for (int i = 0; i < 4; ++i) { v[i] = *(const f32x4*)(xr + i * 256 + lane * 4); ss += v[i][0] * v[i][0] + v[i][1] * v[i][1] + v[i][2] * v[i][2] + v[i][3] * v[i][3];
            if (RW) { vp[i] = hasp ? *(const f32x4*)(xr - 1024 + i * 256 + lane * 4) : (f32x4){0.f, 0.f, 0.f, 0.f}; ssp += vp[i][0] * vp[i][0] + vp[i][1] * vp[i][1] + vp[i][2] * vp[i][2] + vp[i][3] * vp[i][3]; } }
        ss = wave_sum(ss); const float rstd = rsqrtf(ss * (1.f / 1024.f) + 1e-6f);
        float rstdp = 0.f; if (RW) { ssp = wave_sum(ssp); rstdp = rsqrtf(ssp * (1.f / 1024.f) + 1e-6f); }
#pragma unroll
        for (int i = 0; i < 4; ++i) { const int c = i * 256 + lane * 4; const f32x4 gg = *(const f32x4*)(g + c), sc = *(const f32x4*)(md + scale_off + c), sh = *(const f32x4*)(md + shift_off + c);
            f32x4 h;
#pragma unroll
            for (int j = 0; j < 4; ++j) h[j] = v[i][j] * rstd * gg[j] * (1.f + sc[j]) + sh[j];
            if (!RW) { u32x2 w; w.x = pk2(h[0], h[1]); w.y = pk2(h[2], h[3]); *(u32x2*)(out + (size_t)row * 1024 + c) = w; }
            else { f32x4 d;
#pragma unroll
                for (int j = 0; j < 4; ++j) { const float hp = hasp ? (vp[i][j] * rstdp * gg[j] * (1.f + sc[j]) + sh[j]) : 0.f; d[j] = hp - h[j]; }
                const f32x4 mr = *(const f32x4*)(mu + c), mk = *(const f32x4*)(mu + 2048 + c), mv = *(const f32x4*)(mu + 3072 + c);
                const f32x4 xr_ = h + d * mr, xk_ = h + d * mk, xv_ = h + d * mv;
                bf16_t* o = out + (size_t)(row - row0) * 4096 + c;
                u32x2 w; w.x = pk2(xr_[0], xr_[1]); w.y = pk2(xr_[2], xr_[3]); *(u32x2*)(o) = w;
                w.x = pk2(xk_[0], xk_[1]); w.y = pk2(xk_[2], xk_[3]); *(u32x2*)(o + 1024) = w;
                w.x = pk2(xv_[0], xv_[1]); w.y = pk2(xv_[2], xv_[3]); *(u32x2*)(o + 2048) = w;
                w.x = pk2(d[0], d[1]); w.y = pk2(d[2], d[3]); *(u32x2*)(o + 3072) = w; } }
    }
}

__device__ __forceinline__ void qknorm_phase(bf16_t* Q, bf16_t* Kb, const int* pos, const float* qn, const float* kn, int bid, int nb) {
    const int wave = threadIdx.x >> 6, lane = threadIdx.x & 63, l16 = lane & 15, d0 = l16 * 4;
    float invf[4];
#pragma unroll
    for (int j = 0; j < 4; ++j) invf[j] = powf(500000.f, -(float)((l16 & 1) * 4 + j) / 8.f);
    const f32x4 qw = *(const f32x4*)(qn + d0), kw = *(const f32x4*)(kn + d0);
    for (int tok = bid * 8 + wave; tok < MTOK; tok += nb * 8) {
        const float ps = (float)pos[tok];
        float cs[4], sn[4];
#pragma unroll
        for (int j = 0; j < 4; ++j) { const float ang = ps * invf[j]; cs[j] = cosf(ang); sn[j] = sinf(ang); }
#pragma unroll
        for (int bsel = 0; bsel < 2; ++bsel) { bf16_t* buf = bsel ? Kb : Q; const f32x4 w = bsel ? kw : qw;
#pragma unroll
            for (int it = 0; it < 2; ++it) { const int vec = it * 4 + (lane >> 4); bf16_t* ptr = buf + (size_t)tok * 512 + vec * 64 + d0;
                const u32x2 raw = *(const u32x2*)ptr; float y[4] = {bflo(raw.x), bfhi(raw.x), bflo(raw.y), bfhi(raw.y)};
                float ss = y[0] * y[0] + y[1] * y[1] + y[2] * y[2] + y[3] * y[3];
                ss += __shfl_xor(ss, 1); ss += __shfl_xor(ss, 2); ss += __shfl_xor(ss, 4); ss += __shfl_xor(ss, 8);
                const float rstd = rsqrtf(ss * (1.f / 64.f) + 1e-6f);
#pragma unroll
                for (int j = 0; j < 4; ++j) y[j] = y[j] * rstd * w[j];
                float pr[4];
#pragma unroll
                for (int j = 0; j < 4; ++j) pr[j] = __shfl_xor(y[j], 2);
                if (l16 < 2) {
#pragma unroll
                    for (int j = 0; j < 4; ++j) y[j] = y[j] * cs[j] - pr[j] * sn[j]; }
                else if (l16 < 4) {
#pragma unroll
                    for (int j = 0; j < 4; ++j) y[j] = y[j] * cs[j] + pr[j] * sn[j]; }
                if (!bsel) {
#pragma unroll
                    for (int j = 0; j < 4; ++j) y[j] *= 0.125f * 1.4426950408889634f; }
                u32x2 o; o.x = pk2(y[0], y[1]); o.y = pk2(y[2], y[3]); *(u32x2*)ptr = o; } }
    }
}

__device__ __forceinline__ void vtrans_phase(const bf16_t* V, bf16_t* Vt, bf16_t* lds, int bid, int nb) {
    const int tid = threadIdx.x;
    for (int unit = bid; unit < 1024; unit += nb) {
        const int head = unit & 3, ch = unit >> 2; const int b = ch >> 6, t0 = (ch & 63) * 64;
#pragma unroll
        for (int i = 0; i < 2; ++i) { const int idx = tid + i * 512, t = idx >> 4, cc = (idx & 15) * 8;
            const u32x4 w = *(const u32x4*)(V + ((size_t)b * SEQ + t0 + t) * 512 + head * 128 + cc);
            unsigned* d = (unsigned*)(lds + t * 130 + cc); d[0] = w.x; d[1] = w.y; d[2] = w.z; d[3] = w.w; }
        __syncthreads();
        { const int e = tid >> 2, tc = (tid & 3) * 16; unsigned o[8];
#pragma unroll
          for (int i = 0; i < 8; ++i) o[i] = (unsigned)lds[(tc + 2 * i) * 130 + e] | ((unsigned)lds[(tc + 2 * i + 1) * 130 + e] << 16);
          u32x4* dst = (u32x4*)(Vt + ((size_t)(b * 4 + head) * 128 + e) * SEQ + t0 + tc);
          dst[0] = (u32x4){o[0], o[1], o[2], o[3]}; dst[1] = (u32x4){o[4], o[5], o[6], o[7]}; }
        __syncthreads();
    }
}

typedef float f32x16 __attribute__((ext_vector_type(16)));
__device__ __forceinline__ void attn_phase(const bf16_t* Q, const bf16_t* Kb, const bf16_t* Vt, bf16_t* OC, LAS unsigned char* lds, int bid, int nb) {
    const int tid = threadIdx.x, wave = __builtin_amdgcn_readfirstlane(tid >> 6), lane = tid & 63, c = wave >> 2, wq = wave & 3, l32 = lane & 31, hh = lane >> 5;
    constexpr int KROW = 272, VROW = 72, KBUF = 32 * KROW, VBUF = 128 * VROW, VOFF = 2 * KBUF;
    const int lkey = tid >> 4, lkc = tid & 15, lve = tid >> 2, lvc = tid & 3;
    for (int unit = bid; unit < 256; unit += nb) {
        const int b = unit & 3, head = (unit >> 2) & 3, pr = unit >> 4;
        const bf16_t* kg = Kb + ((size_t)b * SEQ + lkey) * 512 + head * 128 + lkc * 8;
        const bf16_t* vg = Vt + ((size_t)(b * 4 + head) * 128 + lve) * SEQ + lvc * 8;
        for (int half = 0; half < 2; ++half) {
            const int qb = half ? (31 - pr) : pr; const int q0 = qb * 128 + wq * 32; const int ntile = (qb + 1) * 4;
            bf16x8 qf[4];
            { const bf16_t* qp = Q + ((size_t)b * SEQ + q0 + l32) * 512 + head * 128 + c * 64 + hh * 8;
#pragma unroll
              for (int ks = 0; ks < 4; ++ks) qf[ks] = *(const bf16x8*)(qp + ks * 16); }
            f32x16 o[4];
#pragma unroll
            for (int blk = 0; blk < 4; ++blk)
#pragma unroll
                for (int r = 0; r < 16; ++r) o[blk][r] = 0.f;
            float mrow = -INFINITY, lsum = 0.f;
            u32x4 kreg = *(const u32x4*)kg, vreg = *(const u32x4*)vg;
            __syncthreads();
            { *(LAS u32x4*)(lds + lkey * KROW + lkc * 16) = kreg;
              LAS u32x2* vd = (LAS u32x2*)(lds + VOFF + lve * VROW + lvc * 16); vd[0] = (u32x2){vreg.x, vreg.y}; vd[1] = (u32x2){vreg.z, vreg.w}; }
            __syncthreads();
            for (int kt = 0; kt < ntile; ++kt) {
                const int cur = kt & 1, key0 = kt * 32;
                if (kt + 1 < ntile) { kreg = *(const u32x4*)(kg + (size_t)(key0 + 32) * 512); vreg = *(const u32x4*)(vg + key0 + 32); }
                if (key0 <= q0) {
                    LAS unsigned char* kb = lds + cur * KBUF + l32 * KROW + c * 128 + hh * 16;
                    f32x16 sacc;
#pragma unroll
                    for (int r = 0; r < 16; ++r) sacc[r] = 0.f;
#pragma unroll
                    for (int ks = 0; ks < 4; ++ks) { const bf16x8 kf = *(const LAS bf16x8*)(kb + ks * 32); sacc = __builtin_amdgcn_mfma_f32_32x32x16_bf16(kf, qf[ks], sacc, 0, 0, 0); }
                    if (key0 == q0) {
#pragma unroll
                        for (int r = 0; r < 16; ++r) { const int kl = (r & 3) + 8 * (r >> 2) + 4 * hh; if (kl > l32) sacc[r] = -INFINITY; } }
                    float tm = sacc[0];
#pragma unroll
                    for (int r = 1; r < 16; ++r) tm = fmaxf(tm, sacc[r]);
                    tm = fmaxf(tm, __shfl_xor(tm, 32));
                    const float mnew = fmaxf(mrow, tm);
                    if (__any(mnew > mrow)) { const float al = exp2f(mrow - mnew); lsum *= al;
#pragma unroll
                        for (int blk = 0; blk < 4; ++blk)
#pragma unroll
                            for (int r = 0; r < 16; ++r) o[blk][r] *= al;
                        mrow = mnew; }
                    float ps = 0.f;
#pragma unroll
                    for (int r = 0; r < 16; ++r) { sacc[r] = exp2f(sacc[r] - mrow); ps += sacc[r]; }
                    lsum += ps;
                    LAS unsigned char* vb = lds + VOFF + cur * VBUF + l32 * VROW + hh * 8;
#pragma unroll
                    for (int s2 = 0; s2 < 2; ++s2) {
                        u32x4 pw; pw.x = cvt_pk_bf16(sacc[8 * s2 + 0], sacc[8 * s2 + 1]); pw.y = cvt_pk_bf16(sacc[8 * s2 + 2], sacc[8 * s2 + 3]); pw.z = cvt_pk_bf16(sacc[8 * s2 + 4], sacc[8 * s2 + 5]); pw.w = cvt_pk_bf16(sacc[8 * s2 + 6], sacc[8 * s2 + 7]);
                        const bf16x8 pb = __builtin_bit_cast(bf16x8, pw);
#pragma unroll
                        for (int blk = 0; blk < 4; ++blk) { const u32x2 v0 = *(const LAS u32x2*)(vb + blk * 32 * VROW + s2 * 32), v1 = *(const LAS u32x2*)(vb + blk * 32 * VROW + s2 * 32 + 16);
                            const bf16x8 vf = __builtin_bit_cast(bf16x8, (u32x4){v0.x, v0.y, v1.x, v1.y});
                            o[blk] = __builtin_amdgcn_mfma_f32_32x32x16_bf16(vf, pb, o[blk], 0, 0, 0); } }
                }
                if (kt + 1 < ntile) { const int nx = cur ^ 1;
                    *(LAS u32x4*)(lds + nx * KBUF + lkey * KROW + lkc * 16) = kreg;
                    LAS u32x2* vd = (LAS u32x2*)(lds + VOFF + nx * VBUF + lve * VROW + lvc * 16); vd[0] = (u32x2){vreg.x, vreg.y}; vd[1] = (u32x2){vreg.z, vreg.w}; }
                __syncthreads();
            }
            lsum += __shfl_xor(lsum, 32);
            const float inv = 1.f / lsum;
            bf16_t* op = OC + ((size_t)b * SEQ + q0 + l32) * 1024 + (head * 2 + c) * 128 + 4 * hh;
#pragma unroll
            for (int blk = 0; blk < 4; ++blk)
#pragma unroll
                for (int g4 = 0; g4 < 4; ++g4) { u32x2 w; w.x = pk2(o[blk][g4 * 4 + 0] * inv, o[blk][g4 * 4 + 1] * inv); w.y = pk2(o[blk][g4 * 4 + 2] * inv, o[blk][g4 * 4 + 3] * inv);
                    *(u32x2*)(op + blk * 32 + g4 * 8) = w; }
        }
    }
}

__device__ __forceinline__ void attn_combine(const bf16_t* OC, bf16_t* CAT, const Params& p, int bid, int nb) {
    const int wave = threadIdx.x >> 6, lane = threadIdx.x & 63, head = lane >> 4, e0 = (lane & 15) * 8;
    float lam;
    { float s1 = 0.f, s2 = 0.f; for (int d = 0; d < 64; ++d) { s1 += p.in[22][d] * p.in[23][d]; s2 += p.in[24][d] * p.in[25][d]; } lam = expf(s1) - expf(s2) + 0.2f; }
    float sub[8];
#pragma unroll
    for (int i = 0; i < 8; ++i) sub[i] = p.in[26][e0 + i] * 0.8f;
    for (int tok = bid * 8 + wave; tok < MTOK; tok += nb * 8) {
        const u32x4 a = *(const u32x4*)(OC + (size_t)tok * 1024 + (head * 2) * 128 + e0), bb = *(const u32x4*)(OC + (size_t)tok * 1024 + (head * 2 + 1) * 128 + e0);
        float o[8] = {bflo(a.x) - lam * bflo(bb.x), bfhi(a.x) - lam * bfhi(bb.x), bflo(a.y) - lam * bflo(bb.y), bfhi(a.y) - lam * bfhi(bb.y),
                      bflo(a.z) - lam * bflo(bb.z), bfhi(a.z) - lam * bfhi(bb.z), bflo(a.w) - lam * bflo(bb.w), bfhi(a.w) - lam * bfhi(bb.w)};
        float ss = 0.f;
#pragma unroll
        for (int i = 0; i < 8; ++i) ss += o[i] * o[i];
        ss += __shfl_xor(ss, 1); ss += __shfl_xor(ss, 2); ss += __shfl_xor(ss, 4); ss += __shfl_xor(ss, 8);
        const float rstd = rsqrtf(ss * (1.f / 128.f) + 1e-6f);
        u32x4 w; w.x = pk2(o[0] * rstd * sub[0], o[1] * rstd * sub[1]); w.y = pk2(o[2] * rstd * sub[2], o[3] * rstd * sub[3]); w.z = pk2(o[4] * rstd * sub[4], o[5] * rstd * sub[5]); w.w = pk2(o[6] * rstd * sub[6], o[7] * rstd * sub[7]);
        *(u32x4*)(CAT + (size_t)tok * 1024 + 512 + head * 128 + e0) = w;
    }
}

typedef float f32x2 __attribute__((ext_vector_type(2)));
__device__ __forceinline__ float h2f_(unsigned bits) { return (float)__builtin_bit_cast(_Float16, (unsigned short)bits); }
__device__ __forceinline__ void rwkv_phase(const Params& p, const bf16_t* R, const bf16_t* Kk, const bf16_t* Vv, const _Float16* DEC, const bf16_t* AA, bf16_t* Y, float* lds, int bid, int nb) {
    const int tid = threadIdx.x, wave = __builtin_amdgcn_readfirstlane(tid >> 6), lane = tid & 63;
    constexpr int TCH = 16, BUFF = 5 * TCH * 64 + TCH * 16;
    constexpr int OBUF = TCH * 16 * 16;
    float* Lout = lds + 2 * BUFF;
    for (int unit = bid; unit < 256; unit += nb) {
        const int b = unit >> 6, h = (unit >> 2) & 15, rq = unit & 3;
        __syncthreads();
        if (wave >= 4) {
            const int pw = wave - 4, tl = lane >> 4, c4 = (lane & 15) * 4;
            const f32x4 kkw = *(const f32x4*)(p.in[41] + h * 64 + c4), kaw = *(const f32x4*)(p.in[42] + h * 64 + c4);
            u32x2 rr[4], kr[4], ar[4], dr[4], vr[4];
            const unsigned lofs = (unsigned)((pw * 4 + tl) * 1024 + h * 64 + c4), vofs = (unsigned)((pw * 4 + tl) * 1024 + h * 64 + rq * 16 + (lane & 3) * 4);
            const bf16_t* Rb = R + (size_t)b * SEQ * 1024; const bf16_t* Kb_ = Kk + (size_t)b * SEQ * 1024; const bf16_t* Vb = Vv + (size_t)b * SEQ * 1024;
            const bf16_t* Ab = AA + (size_t)b * SEQ * 1024; const _Float16* Db = DEC + (size_t)b * SEQ * 1024;
#define RW_ISSUE(set, ch) do { const unsigned o_ = (unsigned)(ch) * (TCH * 1024) + lofs; rr[set] = *(const u32x2*)(Rb + o_); kr[set] = *(const u32x2*)(Kb_ + o_); dr[set] = *(const u32x2*)(Db + o_); ar[set] = *(const u32x2*)(Ab + o_); \
                    vr[set] = *(const u32x2*)(Vb + (unsigned)(ch) * (TCH * 1024) + vofs); } while (0)
#define RW_STAGE(set, buf) do { float* L = lds + (buf) * BUFF + (pw * 4 + tl) * 64 + c4; \
                    const f32x4 k = {bflo(kr[set].x), bfhi(kr[set].x), bflo(kr[set].y), bfhi(kr[set].y)}, a = {bflo(ar[set].x), bfhi(ar[set].x), bflo(ar[set].y), bfhi(ar[set].y)}; \
                    const f32x4 r = {bflo(rr[set].x), bfhi(rr[set].x), bflo(rr[set].y), bfhi(rr[set].y)}; \
                    const f32x4 w = {1.f - h2f_(dr[set].x & 0xffffu), 1.f - h2f_(dr[set].x >> 16), 1.f - h2f_(dr[set].y & 0xffffu), 1.f - h2f_(dr[set].y >> 16)}; \
                    f32x4 kk = k * kkw; const float n2 = dpp_sum16((kk[0] * kk[0] + kk[1] * kk[1]) + (kk[2] * kk[2] + kk[3] * kk[3])); kk = kk * (1.f / fmaxf(sqrtf(n2), 1e-12f)); \
                    *(f32x4*)(L) = w; *(f32x4*)(L + 1 * TCH * 64) = -kk; *(f32x4*)(L + 2 * TCH * 64) = kk * a; *(f32x4*)(L + 3 * TCH * 64) = k * (1.f + (a - 1.f) * kaw); *(f32x4*)(L + 4 * TCH * 64) = r; \
                    if ((lane & 15) < 4) *(f32x4*)(lds + (buf) * BUFF + 5 * TCH * 64 + (pw * 4 + tl) * 16 + (lane & 3) * 4) = (f32x4){bflo(vr[set].x), bfhi(vr[set].x), bflo(vr[set].y), bfhi(vr[set].y)}; } while (0)
            auto flush = [&](int ch) { const int i = tid - 256, tt = i >> 4, row = i & 15; const f32x4* pp = (const f32x4*)(Lout + (ch & 1) * OBUF + i * 16);
                const f32x4 s4 = pp[0] + pp[1] + pp[2] + pp[3];
                Y[((size_t)b * SEQ + ch * TCH + tt) * 1024 + h * 64 + rq * 16 + row] = (bf16_t)f2bf((s4[0] + s4[1]) + (s4[2] + s4[3])); };
            constexpr int NCH = SEQ / TCH;
            RW_ISSUE(0, 0); RW_ISSUE(1, 1); RW_ISSUE(2, 2); RW_ISSUE(3, 3);
            RW_STAGE(0, 0);
            __syncthreads();
            for (int c4_ = 0; c4_ < NCH; c4_ += 4) {
#define RW_ITER(q) do { const int ch = c4_ + (q); RW_STAGE(((q) + 1) & 3, (ch + 1) & 1); { const int chn = (ch + 4 < NCH) ? ch + 4 : NCH - 1; RW_ISSUE((q), chn); } flush(ch > 0 ? ch - 1 : 0); __syncthreads(); } while (0)
                RW_ITER(0); RW_ITER(1); RW_ITER(2); RW_ITER(3);
            }
            flush(NCH - 1);
        } else {
            const int j = lane & 15, rowl = wave * 4 + (lane >> 4);
            f32x2 S01 = {0.f, 0.f}, S23 = {0.f, 0.f};
            __syncthreads();
            for (int ch = 0; ch < SEQ / TCH; ++ch) {
                const float* L = lds + (ch & 1) * BUFF + j * 4; const float* Lv = lds + (ch & 1) * BUFF + 5 * TCH * 64 + rowl; float* Lo = Lout + (ch & 1) * OBUF + rowl * 16 + j;
                f32x4 w4 = *(const f32x4*)(L), a4 = *(const f32x4*)(L + 1 * TCH * 64), b4 = *(const f32x4*)(L + 2 * TCH * 64), k4 = *(const f32x4*)(L + 3 * TCH * 64), r4 = *(const f32x4*)(L + 4 * TCH * 64);
                float vv = Lv[0];
#pragma unroll
                for (int tt = 0; tt < TCH; ++tt) {
                    f32x4 nw4 = w4, na4 = a4, nb4 = b4, nk4 = k4, nr4 = r4; float nvv = vv;
                    if (tt + 1 < TCH) { const float* Ln = L + (tt + 1) * 64; nw4 = *(const f32x4*)(Ln); na4 = *(const f32x4*)(Ln + 1 * TCH * 64); nb4 = *(const f32x4*)(Ln + 2 * TCH * 64); nk4 = *(const f32x4*)(Ln + 3 * TCH * 64); nr4 = *(const f32x4*)(Ln + 4 * TCH * 64); nvv = Lv[(tt + 1) * 16]; }
                    f32x2 d = S01 * (f32x2){a4[0], a4[1]}; d = S23 * (f32x2){a4[2], a4[3]} + d;
                    const float sa = dpp_sum16(d[0] + d[1]);
                    const f32x2 sa2 = {sa, sa}, v2 = {vv, vv};
                    const f32x2 t01 = sa2 * (f32x2){b4[0], b4[1]} + v2 * (f32x2){k4[0], k4[1]}, t23 = sa2 * (f32x2){b4[2], b4[3]} + v2 * (f32x2){k4[2], k4[3]};
                    S01 = S01 * (f32x2){w4[0], w4[1]} + t01; S23 = S23 * (f32x2){w4[2], w4[3]} + t23;
                    f32x2 y = S01 * (f32x2){r4[0], r4[1]}; y = S23 * (f32x2){r4[2], r4[3]} + y;
                    Lo[tt * 256] = y[0] + y[1];
                    w4 = nw4; a4 = na4; b4 = nb4; k4 = nk4; r4 = nr4; vv = nvv;
                }
                __syncthreads();
            }
        }
    }
}

__device__ __forceinline__ void rwkv_post(const Params& p, bf16_t* R, const bf16_t* Kk, const bf16_t* Vv, const bf16_t* AA, const bf16_t* G, const bf16_t* Y, int bid, int nb) {
    const int wave = threadIdx.x >> 6, lane = threadIdx.x & 63;
    for (int it = bid * 8 + wave; it < MTOK * 16; it += nb * 8) {
        const int h = it & 15; const size_t off = (size_t)(it >> 4) * 1024 + h * 64 + lane;
        const float y = bf2f(Y[off]), r = bf2f(R[off]), k = bf2f(Kk[off]), v = bf2f(Vv[off]), a = bf2f(AA[off]), g = bf2f(G[off]);
        const float mean = wave_sum(y) * (1.f / 64.f); const float d = y - mean; const float var = wave_sum(d * d) * (1.f / 64.f);
        const float k2 = k * (1.f + (a - 1.f) * p.in[42][h * 64 + lane]);
        const float sb = wave_sum(r * k2 * p.in[43][h * 64 + lane]);
        const float yn = d * rsqrtf(var + 64e-5f) * p.in[44][h * 64 + lane] + p.in[45][h * 64 + lane] + sb * v;
        R[off] = (bf16_t)f2bf(yn * g);
    }
}

#define XB_TMO      128
#define XB_XCNT(j)  (256  + 64 * (j))
#define XB_XSUB(j)  (1280 + 64 * (j))
#define XB_XGEN(j)  (2304 + 64 * (j))
#define XB_TOP      3328
#define XB_TOPGEN   3392
#define XCD_BAR_WORDS 3456
#define XB_SPIN_CAP (1u << 18)
__device__ __forceinline__ unsigned xb_ld(unsigned* p)              { return __hip_atomic_load(p, __ATOMIC_RELAXED, __HIP_MEMORY_SCOPE_AGENT); }
__device__ __forceinline__ unsigned xb_add(unsigned* p, unsigned v) { return __hip_atomic_fetch_add(p, v, __ATOMIC_RELAXED, __HIP_MEMORY_SCOPE_AGENT); }
__device__ __forceinline__ unsigned xb_xcc_id() { return (unsigned)__builtin_amdgcn_s_getreg((3 << 11) | 20) & 0xFu; }
#define XB_SPIN(cond, bar) do { unsigned _sp = 0; while (cond) { __builtin_amdgcn_s_sleep(1); \
    if ((++_sp & 255u) == 0u) { if (xb_ld(&(bar)[XB_TMO])) break; if (_sp > XB_SPIN_CAP) { atomicAdd(&(bar)[XB_TMO], 1u); break; } } } } while (0)
struct XcdBarrier { unsigned* bar; unsigned x; volatile LAS unsigned* st; };
__device__ __forceinline__ XcdBarrier xcd_barrier_post(unsigned* bar, volatile LAS unsigned* st) {
    XcdBarrier b; b.bar = bar; b.x = xb_xcc_id(); b.st = st;
    if (threadIdx.x == 0) (void)xb_add(&bar[XB_XCNT(b.x)], 1u);
    return b;
}
__device__ __forceinline__ void xcd_barrier_complete(unsigned* bar, unsigned x, unsigned& nloc, unsigned& nx) {
    const unsigned G = gridDim.x * gridDim.y * gridDim.z;
    unsigned sum, cnt, mine, sp = 0u;
    for (;;) {
        sum = 0u; cnt = 0u; mine = 0u;
#pragma unroll
        for (unsigned j = 0; j < 16; ++j) { const unsigned c = xb_ld(&bar[XB_XCNT(j)]); sum += c; cnt += (c > 0u) ? 1u : 0u; mine = (j == x) ? c : mine; }
        if (sum == G) break;
        __builtin_amdgcn_s_sleep(1);
        if ((++sp & 255u) == 0u) { if (xb_ld(&bar[XB_TMO])) break; if (sp > XB_SPIN_CAP) { atomicAdd(&bar[XB_TMO], 1u); break; } }
    }
    nloc = mine > 0u ? mine : 1u; nx = cnt > 0u ? cnt : 1u;
}
__device__ __forceinline__ void xcd_barrier(const XcdBarrier& b) {
    asm volatile("s_waitcnt vmcnt(0)" ::: "memory");
    __syncthreads();
    if (threadIdx.x == 0) {
        unsigned* bar = b.bar;
        __builtin_amdgcn_s_waitcnt(0);
        unsigned nloc = b.st[0], nx = b.st[1];
        if (nloc == 0u) { xcd_barrier_complete(bar, b.x, nloc, nx); b.st[0] = nloc; b.st[1] = nx; }
        const unsigned old = xb_add(&bar[XB_XSUB(b.x)], 1u);
        const unsigned gen = old / nloc;
        if (old + 1u == (gen + 1u) * nloc) {
            __builtin_amdgcn_fence(__ATOMIC_RELEASE, "agent");
            asm volatile("s_waitcnt vmcnt(0)" ::: "memory");
            const unsigned og = xb_add(&bar[XB_TOP], 1u);
            const unsigned tg = og / nx;
            if (og + 1u == (tg + 1u) * nx) xb_add(&bar[XB_TOPGEN], 1u);
            else XB_SPIN(xb_ld(&bar[XB_TOPGEN]) == tg, bar);
            __builtin_amdgcn_fence(__ATOMIC_ACQUIRE, "agent");
            xb_add(&bar[XB_XGEN(b.x)], 1u);
            asm volatile("s_waitcnt vmcnt(0)" ::: "memory");
        } else {
            XB_SPIN(xb_ld(&bar[XB_XGEN(b.x)]) == gen, bar);
            __builtin_amdgcn_fence(__ATOMIC_ACQUIRE, "agent");
            asm volatile("s_waitcnt vmcnt(0)" ::: "memory");
        }
    }
    __syncthreads();
}

__global__ void __launch_bounds__(NTHR) fwd_kernel(Params p) {
    extern __shared__ __attribute__((aligned(16))) unsigned char lds_raw[];
    LAS unsigned char* lds = (LAS unsigned char*)lds_raw;
    float* ldsf = (float*)lds_raw;
    const int bid = blockIdx.x, nb = gridDim.x;
    unsigned char* ws = p.ws;
    float* mod = (float*)(ws + OFF_MOD);
    const bool multi = (p.ph_hi - p.ph_lo) > 1;
    __shared__ unsigned xb_st[4];
    if (threadIdx.x < 4) xb_st[threadIdx.x] = 0u;
    __syncthreads();
    XcdBarrier xbar; xbar.bar = (unsigned*)(ws + OFF_BAR); xbar.x = 0; xbar.st = (volatile LAS unsigned*)xb_st;
    if (multi) xbar = xcd_barrier_post((unsigned*)(ws + OFF_BAR), (volatile LAS unsigned*)xb_st);
#ifndef TESTPH
#define TESTPH -1
#endif
#ifndef REPEAT_A
#define REPEAT_A -1
#endif
#ifndef REPEAT_B
#define REPEAT_B -1
#endif
#ifndef EXTRA_SYNCS
#define EXTRA_SYNCS 0
#endif
#define PH(k) if ((TESTPH < 0 || TESTPH == (k)) && p.ph_lo <= (k) && (k) < p.ph_hi) for (int rep_ = 0; rep_ < (((k) == REPEAT_A || (k) == REPEAT_B) ? 2 : 1); ++rep_)
#define SYNC(k) if (multi) { xcd_barrier(xbar); }
    for (int es_ = 0; es_ < EXTRA_SYNCS; ++es_) cg::this_grid().sync();
    if (p.ph_lo < -1000) cg::this_grid().sync();
    PH(0) { prep_phase(p, ldsf, bid, nb); SYNC(0) }
    PH(1) { norm_phase<false>(p.in[0], p.in[5], mod, 0, 1024, (bf16_t*)(ws + OFF_HA), bid, nb); SYNC(1) }
    PH(2) { EpiWin e{(bf16_t*)(ws + OFF_UX), (bf16_t*)(ws + OFF_QKV)}; gemm_stream(lds, (const bf16_t*)(ws + OFF_HA), (const bf16_t*)(ws + OFF_WIN), 2048, 1024, e, bid, nb); SYNC(2) }
    PH(3) { { EpiS5Z e{(float*)(ws + OFF_Z)}; gemm_batched(lds, (const bf16_t*)(ws + OFF_UX), 640, (size_t)512 * 640, (const bf16_t*)(ws + OFF_BTZ), (size_t)256 * 512, 2, 1, 32, 512, e, NoPre{}, bid, nb); }
            bf16_t* q = (bf16_t*)(ws + OFF_QKV); qknorm_phase(q, q + (size_t)MTOK * 512, (const int*)p.in[2], p.in[20], p.in[21], bid, nb);
            vtrans_phase(q + (size_t)MTOK * 1024, (bf16_t*)(ws + OFF_VT), (bf16_t*)lds_raw, bid, nb); SYNC(3) }
    PH(5) { { EpiS5Y e{(const bf16_t*)(ws + OFF_UX), (bf16_t*)(ws + OFF_YG), p.in[18]}; PreS5Y pre{(const float*)(ws + OFF_Z), (bf16_t*)(ws + OFF_UX), p.in[11], p.in[12], p.in[13]};
              gemm_batched(lds, (const bf16_t*)(ws + OFF_UX), 640, (size_t)512 * 640, (const bf16_t*)(ws + OFF_BTY), (size_t)512 * 640, 2, 2, 32, 640, e, pre, bid, nb); }
            bf16_t* q = (bf16_t*)(ws + OFF_QKV); attn_phase(q, q + (size_t)MTOK * 512, (const bf16_t*)(ws + OFF_VT), (bf16_t*)(ws + OFF_OC), lds, bid, nb); SYNC(5) }
    PH(6) { attn_combine((const bf16_t*)(ws + OFF_OC), (bf16_t*)(ws + OFF_CAT), p, bid, nb);
            EpiGlu e{(const bf16_t*)(ws + OFF_YG), (bf16_t*)(ws + OFF_CAT)}; gemm_phase(lds, (const bf16_t*)(ws + OFF_YG), (const bf16_t*)(ws + OFF_WGLU), 512, 512, e, bid, nb); SYNC(6) }
    PH(7) { EpiRes e{p.in[0], p.out, mod + 2048}; gemm_stream(lds, (const bf16_t*)(ws + OFF_CAT), (const bf16_t*)(ws + OFF_WOUT), 1024, 1024, e, bid, nb); SYNC(7) }
    PH(8) { norm_phase<false>(p.out, p.in[6], mod, 3072, 4096, (bf16_t*)(ws + OFF_HA), bid, nb); SYNC(8) }
    PH(9) { EpiSwiglu e{(bf16_t*)(ws + OFF_HID)}; gemm_stream(lds, (const bf16_t*)(ws + OFF_HA), (const bf16_t*)(ws + OFF_WGU0), 5632, 1024, e, bid, nb); SYNC(9) }
    PH(10) { EpiRes e{p.out, p.out, mod + 5120}; gemm_stream(lds, (const bf16_t*)(ws + OFF_HID), (const bf16_t*)(ws + OFF_WDN0), 1024, FF, e, bid, nb); SYNC(10) }
    const float* mod1 = mod + 4 * 6144;
#define RWKV_FRONT(PA, PB, ROW0) \
    PH(PA) { norm_phase<true>(p.out, p.in[5] + 1024, mod1, 0, 1024, (bf16_t*)(ws + OFF_HD), bid, nb, (ROW0), 8192, p.in[28]); SYNC(PA) } \
    PH(PB) { const bf16_t* xall = (const bf16_t*)(ws + OFF_HD); const bool split = (nb == 256); \
               \
             { pg8::Gemm g{xall + 2048, (const bf16_t*)(ws + OFF_WL1), 8192, 256, 2048, 4096}; SchedOne S{(bid < 32) ? bid : -1}; EpiAdapt<EpiL1> ea{EpiL1{(bf16_t*)(ws + OFF_L1), (ROW0)}}; \
               pg8::gemm_phase<EpiAdapt<EpiL1>, SchedOne, false, true>(lds, g, S, ea); } \
             { pg8::Gemm g{xall, (const bf16_t*)(ws + OFF_WG1), 8192, 3072, 1024, 4096}; SchedRKV S{split ? bid - 32 : bid, split ? 224 : nb}; EpiAdaptRKV ea{EpiRKV{(bf16_t*)(ws + OFF_RKV), (ROW0)}}; \
               pg8::gemm_phase<EpiAdaptRKV, SchedRKV, true, true>(lds, g, S, ea); } \
             SYNC(PB) }
    RWKV_FRONT(11, 12, 0)
    RWKV_FRONT(20, 21, 8192)
    PH(13) { EpiL2 e{(_Float16*)(ws + OFF_DEC), (bf16_t*)(ws + OFF_AA), (bf16_t*)(ws + OFF_G), p.in[33], p.in[36]}; gemm_phase(lds, (const bf16_t*)(ws + OFF_L1), (const bf16_t*)(ws + OFF_WL2), 3072, 256, e, bid, nb); SYNC(13) }
    PH(14) { const bf16_t* r = (const bf16_t*)(ws + OFF_RKV); rwkv_phase(p, r, r + (size_t)MTOK * 1024, r + (size_t)MTOK * 2048, (const _Float16*)(ws + OFF_DEC), (const bf16_t*)(ws + OFF_AA), (bf16_t*)(ws + OFF_Y), ldsf, bid, nb); SYNC(14) }
    PH(15) { bf16_t* r = (bf16_t*)(ws + OFF_RKV); rwkv_post(p, r, r + (size_t)MTOK * 1024, r + (size_t)MTOK * 2048, (const bf16_t*)(ws + OFF_AA), (const bf16_t*)(ws + OFF_G), (const bf16_t*)(ws + OFF_Y), bid, nb); SYNC(15) }
    PH(16) { EpiRes e{p.out, p.out, mod1 + 2048}; gemm_stream(lds, (const bf16_t*)(ws + OFF_RKV), (const bf16_t*)(ws + OFF_WO), 1024, 1024, e, bid, nb); SYNC(16) }
    PH(17) { norm_phase<false>(p.out, p.in[6] + 1024, mod1, 3072, 4096, (bf16_t*)(ws + OFF_HA), bid, nb); SYNC(17) }
    PH(18) { EpiSwiglu e{(bf16_t*)(ws + OFF_HID)}; gemm_stream(lds, (const bf16_t*)(ws + OFF_HA), (const bf16_t*)(ws + OFF_WGU1), 5632, 1024, e, bid, nb); SYNC(18) }
    PH(19) { EpiRes e{p.out, p.out, mod1 + 5120}; gemm_stream(lds, (const bf16_t*)(ws + OFF_HID), (const bf16_t*)(ws + OFF_WDN1), 1024, FF, e, bid, nb); }
}

constexpr int NPHASE = 22;
#ifndef ONE_LAUNCH
#define ONE_LAUNCH 1
#endif

extern "C" void kernel_launch(void* const* d_in, const int* in_sizes, int n_in, void* d_out, int out_size, void* d_ws, size_t ws_size, hipStream_t stream) {
    static int grid = 0;
    if (grid == 0) {
        if (n_in != 46 || ws_size < WS_NEED) { fprintf(stderr, "kernel_launch: unexpected n_in %d / ws_size %zu (need %zu)\n", n_in, ws_size, (size_t)WS_NEED); grid = -1; return; }
        if (hipFuncSetAttribute((const void*)fwd_kernel, hipFuncAttributeMaxDynamicSharedMemorySize, LDS_BYTES) != hipSuccess) { fprintf(stderr, "hipFuncSetAttribute failed\n"); grid = -1; return; }
        int dev = 0, cus = 0, per_cu = 0;
        (void)hipGetDevice(&dev); (void)hipDeviceGetAttribute(&cus, hipDeviceAttributeMultiprocessorCount, dev);
        (void)hipOccupancyMaxActiveBlocksPerMultiprocessor(&per_cu, (const void*)fwd_kernel, NTHR, LDS_BYTES);
        if (per_cu < 1) per_cu = 1;
        grid = cus;
    }
    if (grid < 0) return;
    Params p{};
    for (int i = 0; i < 46; ++i) p.in[i] = (const float*)d_in[i];
    p.out = (float*)d_out; p.ws = (unsigned char*)d_ws;
#if ONE_LAUNCH
    p.ph_lo = 0; p.ph_hi = NPHASE;
    if (hipMemsetAsync((char*)d_ws + OFF_BAR, 0, XCD_BAR_WORDS * 4, stream) != hipSuccess) { fprintf(stderr, "memset failed\n"); return; }
    void* args[] = {&p};
    hipError_t e = hipLaunchCooperativeKernel((const void*)fwd_kernel, dim3(grid), dim3(NTHR), args, LDS_BYTES, stream);
    if (e != hipSuccess) fprintf(stderr, "cooperative launch failed: %s (grid %d)\n", hipGetErrorString(e), grid);
#else
    for (int ph = 0; ph < NPHASE; ++ph) { p.ph_lo = ph; p.ph_hi = ph + 1; hipLaunchKernelGGL(fwd_kernel, dim3(grid), dim3(NTHR), LDS_BYTES, stream, p); }
#endif
}
```

```cpp
#include <hip/hip_runtime.h>
#include <hip/hip_cooperative_groups.h>
#include <cstdio>
#include <cstdint>
namespace cg = cooperative_groups;

#define LAS __attribute__((address_space(3)))
typedef unsigned short bf16_t;
typedef short bf16x8 __attribute__((ext_vector_type(8)));
typedef float f32x4 __attribute__((ext_vector_type(4)));
typedef unsigned u32x2 __attribute__((ext_vector_type(2)));
typedef unsigned u32x4 __attribute__((ext_vector_type(4)));

constexpr int MTOK = 16384, DM = 1024, SEQ = 4096, FF = 2816;
constexpr int NTHR = 512;
constexpr int LDS_BYTES = 131072;
constexpr size_t MiB = 1048576;
constexpr size_t OFF_WIN = 0;
constexpr size_t OFF_WGLU = 4194304;
constexpr size_t OFF_WOUT = 4718592;
constexpr size_t OFF_WGU0 = 6815744;
constexpr size_t OFF_WDN0 = 18350080;
constexpr size_t OFF_WGU1 = 39321600;
constexpr size_t OFF_WDN1 = 50855936;
constexpr size_t OFF_WG1 = 24117248;
constexpr size_t OFF_WL1 = 24117248 + 6291456;
constexpr size_t OFF_WL2 = 37748736;
constexpr size_t OFF_WO = 56623104;
constexpr size_t OFF_MOD = 58720256;
constexpr size_t OFF_BAR = 58916864;
constexpr size_t ACT = 57 * MiB;
constexpr size_t OFF_HA = ACT;
constexpr size_t OFF_UX = ACT + 32 * MiB;
constexpr size_t OFF_Z = ACT + 52 * MiB;
constexpr size_t OFF_BTZ = ACT + 112 * MiB;
constexpr size_t OFF_BTY = ACT + 176 * MiB;
constexpr size_t OFF_QKV = ACT + 64 * MiB;
constexpr size_t OFF_CAT = ACT + 112 * MiB;
constexpr size_t OFF_YG = ACT + 144 * MiB;
constexpr size_t OFF_VT = ACT + 160 * MiB;
constexpr size_t OFF_OC = ACT;
constexpr size_t OFF_HID = ACT + 32 * MiB;
constexpr size_t OFF_HD = ACT;
constexpr size_t OFF_RKV = ACT + 64 * MiB;
constexpr size_t OFF_G = ACT + 160 * MiB;
constexpr size_t OFF_Y = 0;
constexpr size_t OFF_L1 = 0;
constexpr size_t OFF_DEC = ACT;
constexpr size_t OFF_AA = ACT + 32 * MiB;
constexpr size_t WS_NEED = ACT + 196 * MiB;

struct Params {
    const float* in[46];
    float* out;
    unsigned char* ws;
    int ph_lo, ph_hi;
};

__device__ __forceinline__ unsigned f2bf(float f) { unsigned u = __float_as_uint(f); return (u + 0x7fffu + ((u >> 16) & 1u)) >> 16; }
__device__ __forceinline__ float bf2f(unsigned h) { return __uint_as_float(h << 16); }
__device__ __forceinline__ unsigned cvt_pk_bf16(float lo, float hi) { unsigned r; asm("v_cvt_pk_bf16_f32 %0, %1, %2" : "=v"(r) : "v"(lo), "v"(hi)); return r; }
__device__ __forceinline__ unsigned pk2(float lo, float hi) { return cvt_pk_bf16(lo, hi); }
__device__ __forceinline__ float bflo(unsigned w) { return __uint_as_float(w << 16); }
__device__ __forceinline__ float bfhi(unsigned w) { return __uint_as_float(w & 0xffff0000u); }
__device__ __forceinline__ float dpp_sum16(float x) {
    x += __int_as_float(__builtin_amdgcn_update_dpp(0, __float_as_int(x), 0xB1, 0xf, 0xf, true));
    x += __int_as_float(__builtin_amdgcn_update_dpp(0, __float_as_int(x), 0x4E, 0xf, 0xf, true));
    x += __int_as_float(__builtin_amdgcn_update_dpp(0, __float_as_int(x), 0x141, 0xf, 0xf, true));
    x += __int_as_float(__builtin_amdgcn_update_dpp(0, __float_as_int(x), 0x140, 0xf, 0xf, true));
    return x;
}
__device__ __forceinline__ float wave_sum(float v) {
    v = dpp_sum16(v);
    const float s0 = __int_as_float(__builtin_amdgcn_readlane(__float_as_int(v), 0)), s1 = __int_as_float(__builtin_amdgcn_readlane(__float_as_int(v), 16));
    const float s2 = __int_as_float(__builtin_amdgcn_readlane(__float_as_int(v), 32)), s3 = __int_as_float(__builtin_amdgcn_readlane(__float_as_int(v), 48));
    return (s0 + s1) + (s2 + s3);
}
__device__ __forceinline__ float sigmoidf_(float x) { return 1.f / (1.f + __expf(-x)); }
__device__ __forceinline__ float tanh_fast(float x) { const float t = __expf(2.f * fminf(fmaxf(x, -15.f), 15.f)); return (t - 1.f) / (t + 1.f); }
#define LWAIT() asm volatile("s_waitcnt lgkmcnt(0)" ::: "memory")
__device__ __forceinline__ float gelu_tanh(float x) { const float t = tanhf(0.7978845608028654f * (x + 0.044715f * x * x * x)); return 0.5f * x * (1.f + t); }

constexpr int HTB = 128 * 64 * 2;
__device__ __forceinline__ int lds_byte(int r, int c) { int st = (r >> 4) * 2 + (c >> 5), rr = r & 15, cc = c & 31, ob = rr * 64 + cc * 2; return st * 1024 + (ob ^ (((ob >> 9) & 1) << 5)); }
__device__ __forceinline__ void stage_rc(int b, int& R, int& C) { int st = b / 1024, sb = b % 1024, swz = sb ^ (((sb >> 9) & 1) << 5); R = (st >> 1) * 16 + swz / 64; C = (st & 1) * 32 + (swz % 64) / 2; }

struct NoPre { static constexpr bool NOP = true; __device__ __forceinline__ void operator()(int, int, int) const {} };
template <class Epi, class Pre, bool PF = true>
__device__ __forceinline__ void gemm_batched(LAS unsigned char* lds, const bf16_t* A, int lda, size_t strideA, const bf16_t* Bt, size_t strideB, int nMt, int nNt, int nbatch, int K, const Epi& E, const Pre& PRE, int bid, int nb) {
    const int tid = threadIdx.x, wid = __builtin_amdgcn_readfirstlane(tid >> 6), lane = tid & 63, wr = wid >> 2, wc = wid & 3, fr = lane & 15, fq = lane >> 4;
    unsigned voffA[2], voffB[2];
#pragma unroll
    for (int i = 0; i < 2; ++i) { int R, C; stage_rc(tid * 16 + i * 8192, R, C); voffA[i] = (unsigned)(R * lda + C) * 2u; voffB[i] = (unsigned)(R * K + C) * 2u; }
    const int aoff = lds_byte(wr * 64 + fr, fq * 8), boff = lds_byte(wc * 32 + fr, fq * 8);
    const unsigned ldsw = (unsigned)wid * 1024u;
    const size_t kstep = 128, hstepA = (size_t)128 * lda * 2, hstepB = (size_t)128 * K * 2;
    const int nt = K / 64;
    const int ntiles = nMt * nNt * nbatch;
#define G_SA(b, h) (((b) * 2 + (h)) * HTB)
#define G_SB(b, h) ((4 + (b) * 2 + (h)) * HTB)
#define G_STAGEX(bufoff, gptr, vo) do { _Pragma("unroll") for (int _i = 0; _i < 2; ++_i) \
        __builtin_amdgcn_global_load_lds((const unsigned*)((gptr) + vo[_i]), (LAS unsigned*)(lds + (bufoff) + ldsw + _i * 8192), 16, 0, 0); } while (0)
#define G_STA(bufoff, gptr) G_STAGEX(bufoff, gptr, voffA)
#define G_STB(bufoff, gptr) G_STAGEX(bufoff, gptr, voffB)
#define G_LDA(dst, b, h) do { _Pragma("unroll") for (int m = 0; m < 4; ++m) _Pragma("unroll") for (int k = 0; k < 2; ++k) dst[m][k] = *(const LAS bf16x8*)(lds + G_SA(b, h) + aoff + m * 2048 + k * 1024); } while (0)
#define G_LDB(dst, b, h) do { _Pragma("unroll") for (int n = 0; n < 2; ++n) _Pragma("unroll") for (int k = 0; k < 2; ++k) dst[n][k] = *(const LAS bf16x8*)(lds + G_SB(b, h) + boff + n * 2048 + k * 1024); } while (0)
#define G_MMA(ai, bj, At, Bx) do { __builtin_amdgcn_s_setprio(1); _Pragma("unroll") for (int m = 0; m < 4; ++m) _Pragma("unroll") for (int n = 0; n < 2; ++n) _Pragma("unroll") for (int k = 0; k < 2; ++k) \
        acc[ai][bj][m][n] = __builtin_amdgcn_mfma_f32_16x16x32_bf16(Bx[n][k], At[m][k], acc[ai][bj][m][n], 0, 0, 0); __builtin_amdgcn_s_setprio(0); } while (0)
#define G_WV(n) asm volatile("s_waitcnt vmcnt(" #n ")" ::: "memory")
#define G_WL(n) asm volatile("s_waitcnt lgkmcnt(" #n ")" ::: "memory")
#define G_BAR __builtin_amdgcn_s_barrier()
#define G_SCHED __builtin_amdgcn_sched_barrier(0)
    bool prefetched = false;
    for (int tile = bid; tile < ntiles; tile += nb) {
        const int pm = tile % nMt, tq = tile / nMt, pn = tq % nNt, gb = tq / nNt;
        PRE(gb, pm, pn);
        const char* cA = (const char*)(A + (size_t)gb * strideA) + (size_t)pm * 256 * lda * 2;
        const char* cB = (const char*)(Bt + (size_t)gb * strideB) + (size_t)pn * 256 * K * 2;
        f32x4 acc[2][2][4][2];
#pragma unroll
        for (int a = 0; a < 2; ++a)
#pragma unroll
            for (int b = 0; b < 2; ++b)
#pragma unroll
                for (int m = 0; m < 4; ++m)
#pragma unroll
                    for (int n = 0; n < 2; ++n) acc[a][b][m][n] = (f32x4){0.f, 0.f, 0.f, 0.f};
        bf16x8 At[4][2], B0[2][2], B1[2][2];
        if (!prefetched) { G_WV(0); G_STB(G_SB(0, 0), cB); G_STA(G_SA(0, 0), cA); G_STB(G_SB(0, 1), cB + hstepB); G_STA(G_SA(0, 1), cA + hstepA); }
        if (wr == 1) G_BAR;
        if (prefetched) G_WV(0); else G_WV(4);
        G_BAR;
        G_STB(G_SB(1, 0), cB + kstep); G_STA(G_SA(1, 0), cA + kstep); G_STB(G_SB(1, 1), cB + hstepB + kstep);
        G_WV(6); G_BAR;
        for (int t = 0; t < nt - 2; t += 2) {
            const char* a1 = cA + (size_t)(t + 1) * kstep; const char* a2 = cA + (size_t)(t + 2) * kstep; const char* a3 = a2 + kstep;
            const char* b2 = cB + (size_t)(t + 2) * kstep; const char* b3 = b2 + kstep;
            G_LDB(B0, 0, 0); G_SCHED; G_LDA(At, 0, 0); G_STA(G_SA(1, 1), a1 + hstepA);
            G_WL(8); G_BAR; G_WL(0); G_MMA(0, 0, At, B0); G_BAR; G_SCHED;
            G_LDB(B1, 0, 1); G_STB(G_SB(0, 0), b2);
            G_BAR; G_WL(0); G_MMA(0, 1, At, B1); G_BAR;
            G_LDA(At, 0, 1); G_STA(G_SA(0, 0), a2);
            G_BAR; G_WL(0); G_MMA(1, 0, At, B0); G_BAR; G_SCHED;
            G_STB(G_SB(0, 1), b2 + hstepB);
            G_WV(6); G_BAR; G_MMA(1, 1, At, B1); G_BAR;
            G_LDB(B0, 1, 0); G_SCHED; G_LDA(At, 1, 0); G_STA(G_SA(0, 1), a2 + hstepA);
            G_WL(8); G_BAR; G_WL(0); G_MMA(0, 0, At, B0); G_BAR; G_SCHED;
            G_LDB(B1, 1, 1); G_STB(G_SB(1, 0), b3);
            G_BAR; G_WL(0); G_MMA(0, 1, At, B1); G_BAR;
            G_LDA(At, 1, 1); G_STA(G_SA(1, 0), a3);
            G_BAR; G_WL(0); G_MMA(1, 0, At, B0); G_BAR; G_SCHED;
            G_STB(G_SB(1, 1), b3 + hstepB);
            G_WV(6); G_BAR; G_MMA(1, 1, At, B1); G_BAR;
        }
        {
            const char* a1 = cA + (size_t)(nt - 1) * kstep;
            G_LDB(B0, 0, 0); G_LDA(At, 0, 0); G_STA(G_SA(1, 1), a1 + hstepA);
            G_BAR; G_WL(0); G_MMA(0, 0, At, B0); G_BAR;
            G_LDB(B1, 0, 1); G_BAR; G_WL(0); G_MMA(0, 1, At, B1); G_BAR;
            G_LDA(At, 0, 1); G_WV(4); G_BAR; G_WL(0); G_MMA(1, 0, At, B0); G_MMA(1, 1, At, B1); G_BAR;
        }
        {
            G_LDB(B0, 1, 0); G_LDA(At, 1, 0); G_WV(2); G_BAR; G_WL(0); G_MMA(0, 0, At, B0); G_BAR;
            G_LDB(B1, 1, 1); G_WV(0); G_BAR; G_WL(0); G_MMA(0, 1, At, B1); G_BAR;
            G_LDA(At, 1, 1); G_BAR; G_WL(0); G_MMA(1, 0, At, B0); G_MMA(1, 1, At, B1); G_BAR;
        }
        if (wr == 0) G_BAR;
        prefetched = false;
        if (PF && Pre::NOP && tile + nb < ntiles) {
            const int t2 = tile + nb, pm2 = t2 % nMt, tq2 = t2 / nMt, pn2 = tq2 % nNt, gb2 = tq2 / nNt;
            const char* nA = (const char*)(A + (size_t)gb2 * strideA) + (size_t)pm2 * 256 * lda * 2;
            const char* nB = (const char*)(Bt + (size_t)gb2 * strideB) + (size_t)pn2 * 256 * K * 2;
            G_STB(G_SB(0, 0), nB); G_STA(G_SA(0, 0), nA); G_STB(G_SB(0, 1), nB + hstepB); G_STA(G_SA(0, 1), nA + hstepA);
            prefetched = true; }
        E(acc, gb, pm, pn, wr, wc, fr, fq);
    }
    G_WV(0);
    __syncthreads();
}

template <class Epi>
__device__ __forceinline__ void gemm_phase(LAS unsigned char* lds, const bf16_t* A, const bf16_t* Bt, int N, int K, const Epi& E, int bid, int nb) {
    gemm_batched(lds, A, K, 0, Bt, 0, 64, N / 256, 1, K, E, NoPre{}, bid, nb);
}

namespace pg8 {
#define PG8_LAS __attribute__((address_space(3)))
typedef unsigned short bf16_t;
typedef short bf16x8 __attribute__((ext_vector_type(8)));
typedef float f32x4 __attribute__((ext_vector_type(4)));
typedef unsigned u32x4 __attribute__((ext_vector_type(4)));
constexpr int BM = 256, BK = 64, HALF = 128, HTB = HALF * BK * 2  , STAGE_BYTES = 8 * HTB, NXCD = 8, WGM = 8;

__host__ __device__ __forceinline__ int lds_byte(int r, int c) { const int st = (r >> 4) * 2 + (c >> 5), rr = r & 15, cc = c & 31, ob = rr * 64 + cc * 2; return st * 1024 + (ob ^ (((ob >> 9) & 1) << 5)); }
__host__ __device__ __forceinline__ void stage_rc(int b, int& R, int& C) { const int st = b / 1024, sb = b % 1024, swz = sb ^ (((sb >> 9) & 1) << 5); R = (st >> 1) * 16 + swz / 64; C = (st & 1) * 32 + (swz % 64) / 2; }
__host__ __device__ __forceinline__ int perm32(int rho) { const int n = rho >> 4, i = rho & 15; return 8 * (i >> 2) + 4 * n + (i & 3); }

struct Unit { int pm, pn; int ao = 0; };
struct Gemm { const bf16_t* A; const bf16_t* Bt; int M, N, K; int lda; };

struct StaticOrder {
    int nM, nN, nwg, G, c;
    __host__ __device__ void init(int M, int N, int G_, int c_) { nM = M / BM; nN = N / BM; nwg = nM * nN; G = G_; c = c_; }
    __host__ __device__ bool next(int i, Unit& u) const {
        const long L = (long)i * G + c; if (L >= nwg) return false;
        int wgid = (int)L; { const int q = nwg / NXCD, r = nwg % NXCD, xcd = wgid % NXCD, off = wgid / NXCD; wgid = (xcd < r ? xcd * (q + 1) : r * (q + 1) + (xcd - r) * q) + off; }
        const int nig = WGM * nN, gid = wgid / nig, fm = gid * WGM, gsz = (nM - fm) < WGM ? (nM - fm) : WGM;
        u.pm = fm + ((wgid % nig) % gsz); u.pn = (wgid % nig) / gsz; return true;
    }
    __device__ __forceinline__ void a_ready(const Unit&) const {}
    __device__ __forceinline__ void done(const Unit&) const {}
};
template <class Epi, class Sched, bool ALIGN_EPI = false, bool SP2 = false>
__device__ __forceinline__ void gemm_phase(PG8_LAS unsigned char* lds, const Gemm g, const Sched& S, const Epi& E) {
    const int tid = threadIdx.x, wid = __builtin_amdgcn_readfirstlane(tid >> 6), lane = tid & 63, wr = wid >> 2, wc = wid & 3, fr = lane & 15, fq = lane >> 4;
    const int K = g.K, nt = K / BK;
    unsigned voffA[2], voffB[2];
#pragma unroll
    for (int i = 0; i < 2; ++i) { int R, C; stage_rc(tid * 16 + i * 8192, R, C); const int Rb = Epi::PERM ? ((R & ~31) + perm32(R & 31)) : R;
        voffA[i] = (unsigned)(R * g.lda + C) * 2u; voffB[i] = (unsigned)(Rb * K + C) * 2u; }
    const size_t kstep = (size_t)(BK * 2);
    const size_t hstep = (size_t)HALF * K * 2;
    const size_t tstep = 2 * hstep;
    const size_t hstepA = (size_t)HALF * g.lda * 2, tstepA = 2 * hstepA;
    const unsigned ldsw = (unsigned)wid * 1024u;
    const int aoff = lds_byte(wr * 64 + fr, fq * 8), boff = lds_byte(wc * 32 + fr, fq * 8);
#define PG8_SA(b, h) (((b) * 2 + (h)) * HTB)
#define PG8_SB(b, h) ((4 + (b) * 2 + (h)) * HTB)
#define PG8_STAGE(bufoff, gbase, voff) do { _Pragma("unroll") for (int _i = 0; _i < 2; ++_i) \
        __builtin_amdgcn_global_load_lds((const unsigned*)((const char*)(gbase) + (voff)[_i]), (PG8_LAS unsigned*)(lds + (bufoff) + ldsw + _i * 8192), 16, 0, 0); } while (0)
#define PG8_LDA(dst, b, h) do { _Pragma("unroll") for (int m = 0; m < 4; ++m) _Pragma("unroll") for (int k = 0; k < 2; ++k) dst[m][k] = *(const PG8_LAS bf16x8*)(lds + PG8_SA(b, h) + aoff + m * 2048 + k * 1024); } while (0)
#define PG8_LDB(dst, b, h) do { _Pragma("unroll") for (int n = 0; n < 2; ++n) _Pragma("unroll") for (int k = 0; k < 2; ++k) dst[n][k] = *(const PG8_LAS bf16x8*)(lds + PG8_SB(b, h) + boff + n * 2048 + k * 1024); } while (0)
#define PG8_MMA(ai, bj, At, Bt) do { __builtin_amdgcn_s_setprio(1); _Pragma("unroll") for (int m = 0; m < 4; ++m) _Pragma("unroll") for (int n = 0; n < 2; ++n) _Pragma("unroll") for (int k = 0; k < 2; ++k) \
        acc[ai][bj][m][n] = __builtin_amdgcn_mfma_f32_16x16x32_bf16(Bt[n][k], At[m][k], acc[ai][bj][m][n], 0, 0, 0); __builtin_amdgcn_s_setprio(0); } while (0)
#define PG8_WAIT_V(n) asm volatile("s_waitcnt vmcnt(" #n ")" ::: "memory")
#define PG8_WAIT_L(n) asm volatile("s_waitcnt lgkmcnt(" #n ")" ::: "memory")
#define PG8_BAR __builtin_amdgcn_s_barrier()
#define PG8_SCHED __builtin_amdgcn_sched_barrier(0)
    Unit cur, nxt; int ui = 0;
    if (!S.next(0, cur)) return;
    f32x4 acc[2][2][4][2];
#pragma unroll
    for (int a = 0; a < 2; ++a)
#pragma unroll
        for (int b = 0; b < 2; ++b)
#pragma unroll
            for (int m = 0; m < 4; ++m)
#pragma unroll
                for (int n = 0; n < 2; ++n) acc[a][b][m][n] = (f32x4){0.f, 0.f, 0.f, 0.f};
    bf16x8 At[4][2], B0[2][2], B1[2][2];
    const char* cA = (const char*)g.A + (size_t)cur.pm * tstepA + cur.ao; const char* cB = (const char*)g.Bt + (size_t)cur.pn * tstep;
    S.a_ready(cur);
    if constexpr (SP2) {
        PG8_STAGE(PG8_SB(0, 0), cB, voffB); PG8_STAGE(PG8_SB(0, 1), cB + hstep, voffB); PG8_STAGE(PG8_SA(0, 0), cA, voffA); PG8_STAGE(PG8_SA(0, 1), cA + hstepA, voffA);
        if (wr == 1) PG8_BAR;
        PG8_WAIT_V(2); PG8_BAR;
        PG8_STAGE(PG8_SB(1, 0), cB + kstep, voffB); PG8_STAGE(PG8_SA(1, 0), cA + kstep, voffA); PG8_STAGE(PG8_SB(1, 1), cB + hstep + kstep, voffB);
        PG8_WAIT_V(6); PG8_BAR;
    } else {
        PG8_STAGE(PG8_SB(0, 0), cB, voffB); PG8_STAGE(PG8_SA(0, 0), cA, voffA); PG8_STAGE(PG8_SB(0, 1), cB + hstep, voffB); PG8_STAGE(PG8_SA(0, 1), cA + hstepA, voffA);
        if (wr == 1) PG8_BAR;
        PG8_WAIT_V(4); PG8_BAR;
        PG8_STAGE(PG8_SB(1, 0), cB + kstep, voffB); PG8_STAGE(PG8_SA(1, 0), cA + kstep, voffA); PG8_STAGE(PG8_SB(1, 1), cB + hstep + kstep, voffB);
        PG8_WAIT_V(6); PG8_BAR;
    }
    for (;;) {
        const bool has_next = S.next(ui + 1, nxt);
        const char* nA = has_next ? (const char*)g.A + (size_t)nxt.pm * tstepA + nxt.ao : cA; const char* nB = has_next ? (const char*)g.Bt + (size_t)nxt.pn * tstep : cB;
        for (int t = 0; t < nt; t += 2) {
            const bool last = (t == nt - 2);
            const char* a1 = cA + (size_t)(t + 1) * kstep;
            const char* a2 = last ? nA : cA + (size_t)(t + 2) * kstep; const char* b2 = last ? nB : cB + (size_t)(t + 2) * kstep;
            const char* a3 = a2 + kstep; const char* b3 = b2 + kstep;
            if (last && has_next) S.a_ready(nxt);
            if constexpr (SP2) {
            PG8_LDB(B0, 0, 0); PG8_LDB(B1, 0, 1); PG8_SCHED; PG8_LDA(At, 0, 0); PG8_STAGE(PG8_SA(1, 1), a1 + hstepA, voffA);
            PG8_WAIT_V(8); PG8_WAIT_L(0); PG8_BAR; PG8_MMA(0, 0, At, B0); PG8_MMA(0, 1, At, B1); PG8_BAR; PG8_SCHED;
            PG8_LDA(At, 0, 1); PG8_STAGE(PG8_SB(0, 0), b2, voffB); PG8_STAGE(PG8_SB(0, 1), b2 + hstep, voffB); PG8_STAGE(PG8_SA(0, 0), a2, voffA);
            PG8_WAIT_V(8); PG8_WAIT_L(0); PG8_BAR; PG8_MMA(1, 0, At, B0); PG8_MMA(1, 1, At, B1); PG8_BAR; PG8_SCHED;
            PG8_LDB(B0, 1, 0); PG8_LDB(B1, 1, 1); PG8_SCHED; PG8_LDA(At, 1, 0); PG8_STAGE(PG8_SA(0, 1), a2 + hstepA, voffA);
            PG8_WAIT_V(8); PG8_WAIT_L(0); PG8_BAR; PG8_MMA(0, 0, At, B0); PG8_MMA(0, 1, At, B1); PG8_BAR; PG8_SCHED;
            PG8_LDA(At, 1, 1); PG8_STAGE(PG8_SB(1, 0), b3, voffB); PG8_STAGE(PG8_SB(1, 1), b3 + hstep, voffB); PG8_STAGE(PG8_SA(1, 0), a3, voffA);
            PG8_WAIT_V(8); PG8_WAIT_L(0); PG8_BAR; PG8_MMA(1, 0, At, B0); PG8_MMA(1, 1, At, B1); PG8_BAR; PG8_SCHED;
            } else {
            PG8_LDB(B0, 0, 0); PG8_SCHED; PG8_LDA(At, 0, 0); PG8_STAGE(PG8_SA(1, 1), a1 + hstepA, voffA);
            PG8_WAIT_L(8); PG8_BAR; PG8_WAIT_L(0); PG8_MMA(0, 0, At, B0); PG8_BAR; PG8_SCHED;
            PG8_LDB(B1, 0, 1); PG8_STAGE(PG8_SB(0, 0), b2, voffB);
            PG8_BAR; PG8_WAIT_L(0); PG8_MMA(0, 1, At, B1); PG8_BAR;
            PG8_LDA(At, 0, 1); PG8_STAGE(PG8_SA(0, 0), a2, voffA);
            PG8_BAR; PG8_WAIT_L(0); PG8_MMA(1, 0, At, B0); PG8_BAR; PG8_SCHED;
            PG8_STAGE(PG8_SB(0, 1), b2 + hstep, voffB);
            PG8_WAIT_V(6); PG8_BAR; PG8_MMA(1, 1, At, B1); PG8_BAR;
            PG8_LDB(B0, 1, 0); PG8_SCHED; PG8_LDA(At, 1, 0); PG8_STAGE(PG8_SA(0, 1), a2 + hstepA, voffA);
            PG8_WAIT_L(8); PG8_BAR; PG8_WAIT_L(0); PG8_MMA(0, 0, At, B0); PG8_BAR; PG8_SCHED;
            PG8_LDB(B1, 1, 1); PG8_STAGE(PG8_SB(1, 0), b3, voffB);
            PG8_BAR; PG8_WAIT_L(0); PG8_MMA(0, 1, At, B1); PG8_BAR;
            PG8_LDA(At, 1, 1); PG8_STAGE(PG8_SA(1, 0), a3, voffA);
            PG8_BAR; PG8_WAIT_L(0); PG8_MMA(1, 0, At, B0); PG8_BAR; PG8_SCHED;
            PG8_STAGE(PG8_SB(1, 1), b3 + hstep, voffB);
            PG8_WAIT_V(6); PG8_BAR; PG8_MMA(1, 1, At, B1); PG8_BAR;
            }
        }
        if constexpr (ALIGN_EPI) { if (wr == 0) PG8_BAR; }
        if constexpr (!Epi::AFTER_DRAIN) { E(acc, cur, wr, wc, fr, fq); S.done(cur); }
        if (!has_next) break;
#pragma unroll
        for (int a = 0; a < 2; ++a)
#pragma unroll
            for (int b = 0; b < 2; ++b)
#pragma unroll
                for (int m = 0; m < 4; ++m)
#pragma unroll
                    for (int n = 0; n < 2; ++n) acc[a][b][m][n] = (f32x4){0.f, 0.f, 0.f, 0.f};
        cur = nxt; cA = nA; cB = nB; ++ui;
        if constexpr (ALIGN_EPI) { if (wr == 1) PG8_BAR; }
    }
    PG8_WAIT_V(0);
    if constexpr (!ALIGN_EPI) { if (wr == 0) PG8_BAR; }
    PG8_BAR;
    if constexpr (Epi::AFTER_DRAIN) { E.fused(acc, cur, wr, wc, fr, fq, lds, wid, lane); S.done(cur); }
#undef PG8_SA
#undef PG8_SB
#undef PG8_STAGE
#undef PG8_LDA
#undef PG8_LDB
#undef PG8_MMA
#undef PG8_WAIT_V
#undef PG8_WAIT_L
#undef PG8_BAR
#undef PG8_SCHED
}
}

template <class E> struct EpiAdapt { static constexpr bool PERM = false, AFTER_DRAIN = false; E e;
    __device__ __forceinline__ void operator()(const pg8::f32x4 (&acc)[2][2][4][2], const pg8::Unit& u, int wr, int wc, int fr, int fq) const { e(acc, 0, u.pm, u.pn, wr, wc, fr, fq); } };
template <class Epi>
__device__ __forceinline__ void gemm_stream(LAS unsigned char* lds, const bf16_t* A, const bf16_t* Bt, int N, int K, const Epi& E, int bid, int nb) {
    pg8::Gemm g{A, Bt, MTOK, N, K, K}; pg8::StaticOrder S; S.init(MTOK, N, nb, bid);
    EpiAdapt<Epi> ea{E};
    pg8::gemm_phase<EpiAdapt<Epi>, pg8::StaticOrder, true, true>(lds, g, S, ea);
}

#define EPI_LOOP(...) \
    _Pragma("unroll") for (int ai = 0; ai < 2; ++ai) _Pragma("unroll") for (int m = 0; m < 4; ++m) { asm volatile("" ::: "memory"); const int row = pm * 256 + ai * 128 + wr * 64 + m * 16 + fr; \
    _Pragma("unroll") for (int bj = 0; bj < 2; ++bj) _Pragma("unroll") for (int n = 0; n < 2; ++n) { const int ct = bj * 128 + wc * 32 + n * 16 + fq * 4; const f32x4 v = acc[ai][bj][m][n]; __VA_ARGS__ } }

struct EpiWin {
    bf16_t* UX; bf16_t* QKV;
    __device__ __forceinline__ void operator()(const f32x4 (&acc)[2][2][4][2], int gb, int pm, int pn, int wr, int wc, int fr, int fq) const {
        if (pn < 2) {
            bf16_t* base = UX + ((size_t)(pn * 16 + wc * 2) * 512 + (pm >> 4) * 128 + (pm & 15) * 8 + wr * 2) * 640 + fr * 16 + fq * 4;
#pragma unroll
            for (int ai = 0; ai < 2; ++ai)
#pragma unroll
                for (int m = 0; m < 4; ++m) { bf16_t* rp = base + (ai * 4 + (m >> 1)) * 640 + (m & 1) * 256;
#pragma unroll
                    for (int bj = 0; bj < 2; ++bj)
#pragma unroll
                        for (int n = 0; n < 2; ++n) { const f32x4 v = acc[ai][bj][m][n]; u32x2 w; w.x = pk2(v[0], v[1]); w.y = pk2(v[2], v[3]);
                            *(u32x2*)(rp + (size_t)(bj * 8 + n) * (512 * 640)) = w; }
                    asm volatile("" ::: "memory"); }
        } else { bf16_t* base = QKV + (size_t)((pn - 2) >> 1) * ((size_t)MTOK * 512) + (pn & 1) * 256 + (size_t)(pm * 256 + wr * 64 + fr) * 512 + wc * 32 + fq * 4;
#pragma unroll
            for (int ai = 0; ai < 2; ++ai)
#pragma unroll
                for (int m = 0; m < 4; ++m) { bf16_t* rp = base + (size_t)(ai * 128 + m * 16) * 512;
#pragma unroll
                    for (int bj = 0; bj < 2; ++bj)
#pragma unroll
                        for (int n = 0; n < 2; ++n) { const f32x4 v = acc[ai][bj][m][n]; u32x2 w; w.x = pk2(v[0], v[1]); w.y = pk2(v[2], v[3]);
                            *(u32x2*)(rp + bj * 128 + n * 16) = w; }
                    asm volatile("" ::: "memory"); }
        }
    }
};
struct EpiS5Z {
    float* Z;
    __device__ __forceinline__ void operator()(const f32x4 (&acc)[2][2][4][2], int gb, int pm, int pn, int wr, int wc, int fr, int fq) const {
        EPI_LOOP({ if (bj == 0) *(f32x4*)(Z + ((size_t)gb * 512 + row) * 128 + ct) = v; })
    }
};
struct EpiS5Y {
    const bf16_t* UX; bf16_t* YG; const float* dsk;
    __device__ __forceinline__ void operator()(const f32x4 (&acc)[2][2][4][2], int gb, int pm, int pn, int wr, int wc, int fr, int fq) const {
        EPI_LOOP({ const int col = pn * 256 + ct, t = col >> 4, h = col & 15, bb = row >> 7, cc = row & 127;
            const u32x2 uu = *(const u32x2*)(UX + ((size_t)gb * 512 + row) * 640 + col); const f32x4 dd = *(const f32x4*)(dsk + gb * 16 + h);
            u32x2 w; w.x = pk2(gelu_tanh(v[0] + dd[0] * bflo(uu.x)), gelu_tanh(v[1] + dd[1] * bfhi(uu.x))); w.y = pk2(gelu_tanh(v[2] + dd[2] * bflo(uu.y)), gelu_tanh(v[3] + dd[3] * bfhi(uu.y)));
            *(u32x2*)(YG + ((size_t)bb * SEQ + cc * 32 + t) * 512 + gb * 16 + h) = w; })
    }
};
struct PreS5Y {   static constexpr bool NOP = false;
    const float* Z; bf16_t* UX; const float* lam_re; const float* lam_im; const float* log_dt;
    __device__ __forceinline__ void operator()(int gb, int pm, int pn) const {
        const int tid = threadIdx.x;
        if (tid < 128) { const int pp = tid & 63, bb = 2 * pm + (tid >> 6);
            const float lr = lam_re[gb * 64 + pp], li = lam_im[gb * 64 + pp], dt = expf(log_dt[gb]);
            const float mag = expf(lr * dt * 32.f), ar = mag * cosf(li * dt * 32.f), ai = mag * sinf(li * dt * 32.f);
            const float* zp = Z + ((size_t)gb * 512 + bb * 128) * 128 + pp; bf16_t* xp = UX + ((size_t)gb * 512 + bb * 128) * 640 + 512 + pp;
            float xr = 0.f, xi = 0.f;
            for (int c0 = 0; c0 < 128; c0 += 16) { float zr[16], zi[16];
#pragma unroll
                for (int i = 0; i < 16; ++i) { zr[i] = zp[(size_t)(c0 + i) * 128]; zi[i] = zp[(size_t)(c0 + i) * 128 + 64]; }
#pragma unroll
                for (int i = 0; i < 16; ++i) { xp[(size_t)(c0 + i) * 640] = (bf16_t)f2bf(xr); xp[(size_t)(c0 + i) * 640 + 64] = (bf16_t)f2bf(xi);
                    const float nr = ar * xr - ai * xi + zr[i], ni = ar * xi + ai * xr + zi[i]; xr = nr; xi = ni; } } }
        __threadfence();
        asm volatile("s_waitcnt vmcnt(0)" ::: "memory");
        __syncthreads();
    }
};
struct EpiGlu {
    const bf16_t* YG; bf16_t* CAT;
    __device__ __forceinline__ void operator()(const f32x4 (&acc)[2][2][4][2], int gb, int pm, int pn, int wr, int wc, int fr, int fq) const {
        EPI_LOOP({ const int col = pn * 256 + ct; const u32x2 y = *(const u32x2*)(YG + (size_t)row * 512 + col);
            u32x2 w; w.x = pk2(bflo(y.x) * sigmoidf_(v[0]), bfhi(y.x) * sigmoidf_(v[1])); w.y = pk2(bflo(y.y) * sigmoidf_(v[2]), bfhi(y.y) * sigmoidf_(v[3]));
            *(u32x2*)(CAT + (size_t)row * 1024 + col) = w; })
    }
};
struct EpiRes {
    const float* res; float* out; const float* gate;
    __device__ __forceinline__ void operator()(const f32x4 (&acc)[2][2][4][2], int gb, int pm, int pn, int wr, int wc, int fr, int fq) const {
        const float* gatep = gate + (size_t)(pm >> 4) * 6144;
        EPI_LOOP({ const int col = pn * 256 + ct; const f32x4 g = *(const f32x4*)(gatep + col); const f32x4 r = *(const f32x4*)(res + (size_t)row * 1024 + col);
            *(f32x4*)(out + (size_t)row * 1024 + col) = r + g * v; })
    }
};
struct EpiSwiglu {
    bf16_t* HID;
    __device__ __forceinline__ void operator()(const f32x4 (&acc)[2][2][4][2], int gb, int pm, int pn, int wr, int wc, int fr, int fq) const {
#pragma unroll
        for (int ai = 0; ai < 2; ++ai)
#pragma unroll
            for (int m = 0; m < 4; ++m) { const int row = pm * 256 + ai * 128 + wr * 64 + m * 16 + fr;
#pragma unroll
                for (int n = 0; n < 2; ++n) { const f32x4 g = acc[ai][0][m][n], u = acc[ai][1][m][n]; float o[4];
#pragma unroll
                    for (int j = 0; j < 4; ++j) o[j] = g[j] * sigmoidf_(g[j]) * u[j];
                    u32x2 w; w.x = pk2(o[0], o[1]); w.y = pk2(o[2], o[3]);
                    *(u32x2*)(HID + (size_t)row * FF + pn * 128 + wc * 32 + n * 16 + fq * 4) = w; } }
    }
};
struct EpiRKV {
    bf16_t* RKV; int row0;
    __device__ __forceinline__ void operator()(const f32x4 (&acc)[2][2][4][2], int gb, int pm, int pn, int wr, int wc, int fr, int fq) const {
        bf16_t* base = RKV + (size_t)gb * ((size_t)MTOK * 1024) + (size_t)row0 * 1024 + pn * 256;
        EPI_LOOP({ u32x2 w; w.x = pk2(v[0], v[1]); w.y = pk2(v[2], v[3]); *(u32x2*)(base + (size_t)row * 1024 + ct) = w; })
    }
};
struct EpiL1 {
    bf16_t* L1; int row0;
    __device__ __forceinline__ void operator()(const f32x4 (&acc)[2][2][4][2], int gb, int pm, int pn, int wr, int wc, int fr, int fq) const {
        bf16_t* base = L1 + (size_t)(row0 + pm * 256 + wr * 64 + fr) * 256 + wc * 32 + fq * 4;
        const bool ident = (wc >= 2);
#pragma unroll
        for (int ai = 0; ai < 2; ++ai)
#pragma unroll
            for (int m = 0; m < 4; ++m) { bf16_t* rp = base + (size_t)(ai * 128 + m * 16) * 256;
#pragma unroll
                for (int bj = 0; bj < 2; ++bj) { const float sc = bj ? 1.f : 2.f, of = bj ? 0.f : -1.f;
#pragma unroll
                    for (int n = 0; n < 2; ++n) { const f32x4 v = acc[ai][bj][m][n]; float o[4];
#pragma unroll
                        for (int j = 0; j < 4; ++j) { const float sg = sc * __builtin_amdgcn_rcpf(1.f + __expf(-sc * v[j])) + of; o[j] = (bj == 0 && ident) ? v[j] : sg; }
                        u32x2 w; w.x = pk2(o[0], o[1]); w.y = pk2(o[2], o[3]); *(u32x2*)(rp + bj * 128 + n * 16) = w; } }
                asm volatile("" ::: "memory"); }
    }
};
struct EpiL2 {
    _Float16* DEC; bf16_t* AA; bf16_t* G; const float* w0; const float* a0;
    __device__ __forceinline__ void operator()(const f32x4 (&acc)[2][2][4][2], int gb, int pm, int pn, int wr, int wc, int fr, int fq) const {
        const int sel = pn >> 2, cb = (pn & 3) * 256;
        if (sel == 0) { EPI_LOOP({ const int col = cb + ct; const f32x4 w0v = *(const f32x4*)(w0 + col);
                _Pragma("unroll") for (int j = 0; j < 4; ++j) { const float z = w0v[j] + v[j]; const float sp = fmaxf(-z, 0.f) + log1pf(expf(-fabsf(z))); const float e = expf(-sp - 0.5f);
                    DEC[(size_t)row * 1024 + col + j] = (_Float16)(-expm1f(-e)); } }) }
        else if (sel == 1) { EPI_LOOP({ const int col = cb + ct; const f32x4 a0v = *(const f32x4*)(a0 + col);
                u32x2 w; w.x = pk2(sigmoidf_(a0v[0] + v[0]), sigmoidf_(a0v[1] + v[1])); w.y = pk2(sigmoidf_(a0v[2] + v[2]), sigmoidf_(a0v[3] + v[3]));
                *(u32x2*)(AA + (size_t)row * 1024 + col) = w; }) }
        else { EPI_LOOP({ const int col = cb + ct; u32x2 w; w.x = pk2(v[0], v[1]); w.y = pk2(v[2], v[3]); *(u32x2*)(G + (size_t)row * 1024 + col) = w; }) }
    }
};


struct SchedRKV { int vb, vn;
    __device__ bool next(int i, pg8::Unit& u) const { const int t = vb + i * vn; if (vb < 0 || t >= 384) return false; u.pm = t & 31; u.pn = t >> 5; u.ao = (u.pn >> 2) * 2048; return true; }
    __device__ __forceinline__ void a_ready(const pg8::Unit&) const {}
    __device__ __forceinline__ void done(const pg8::Unit&) const {} };
struct SchedOne { int pm;
    __device__ bool next(int i, pg8::Unit& u) const { if (i > 0 || pm < 0) return false; u.pm = pm; u.pn = 0; u.ao = 0; return true; }
    __device__ __forceinline__ void a_ready(const pg8::Unit&) const {}
    __device__ __forceinline__ void done(const pg8::Unit&) const {} };
struct EpiAdaptRKV { static constexpr bool PERM = false, AFTER_DRAIN = false; EpiRKV e;
    __device__ __forceinline__ void operator()(const pg8::f32x4 (&acc)[2][2][4][2], const pg8::Unit& u, int wr, int wc, int fr, int fq) const { e(acc, u.pn >> 2, u.pm, u.pn & 3, wr, wc, fr, fq); } };
__device__ __forceinline__ void s5_gen(const Params& p, bf16_t* BtY, bf16_t* BtZ, float* lds, int bid, int nb) {
    float* PWr = lds; float* PWi = lds + 33 * 64; float* BBr = lds + 66 * 64; float* BBi = BBr + 1024; float* Cr = BBi + 1024; float* Ci = Cr + 1024; float* Kt = Ci + 1024;
    const int tid = threadIdx.x;
    for (int unit = bid; unit < 256; unit += nb) {
        const int g = unit >> 3, part = unit & 7;
        __syncthreads();
        if (tid < 64) { const int pp = tid; const float lr = p.in[11][g * 64 + pp], li = p.in[12][g * 64 + pp], dt = expf(p.in[13][g]);
            for (int tau = 0; tau <= 32; ++tau) { const float mag = expf(lr * dt * (float)tau), ang = li * dt * (float)tau; PWr[tau * 64 + pp] = mag * cosf(ang); PWi[tau * 64 + pp] = mag * sinf(ang); }
            const float ar = PWr[64 + pp], ai = PWi[64 + pp], den = lr * lr + li * li, nr = ar - 1.f;
            const float qr = (nr * lr + ai * li) / den, qi = (ai * lr - nr * li) / den;
            for (int h = 0; h < 16; ++h) { const float br = p.in[14][(size_t)(g * 64 + pp) * 16 + h], bi = p.in[15][(size_t)(g * 64 + pp) * 16 + h]; BBr[pp * 16 + h] = qr * br - qi * bi; BBi[pp * 16 + h] = qr * bi + qi * br; } }
        for (int i = tid; i < 1024; i += NTHR) { Cr[i] = p.in[16][(size_t)g * 1024 + i]; Ci[i] = p.in[17][(size_t)g * 1024 + i]; }
        __syncthreads();
        for (int e = tid; e < 8192; e += NTHR) { const int tau = e >> 8, h = (e >> 4) & 15, h2 = e & 15; float acc = 0.f;
            for (int pp = 0; pp < 64; ++pp) { const float cr = Cr[h * 64 + pp], ci = Ci[h * 64 + pp], wr = PWr[tau * 64 + pp], wi = PWi[tau * 64 + pp];
                const float er = cr * wr - ci * wi, ei = cr * wi + ci * wr; acc += er * BBr[pp * 16 + h2] - ei * BBi[pp * 16 + h2]; }
            Kt[e] = acc; }
        __syncthreads();
        for (int ci_ = tid; ci_ < 5120; ci_ += NTHR) { const int nrow = part * 64 + ci_ / 80, kc = (ci_ % 80) * 8, t = nrow >> 4, h = nrow & 15; float v[8];
#pragma unroll
            for (int i = 0; i < 8; ++i) { const int k = kc + i;
                if (k < 512) { const int sidx = k >> 4, h2 = k & 15; v[i] = (sidx <= t) ? Kt[(t - sidx) * 256 + h * 16 + h2] : 0.f; }
                else { const int jj = k - 512, pp = jj & 63; const float cr = Cr[h * 64 + pp], ci = Ci[h * 64 + pp], wr = PWr[(t + 1) * 64 + pp], wi = PWi[(t + 1) * 64 + pp];
                    v[i] = (jj >> 6) ? -(cr * wi + ci * wr) : (cr * wr - ci * wi); } }
            *(u32x4*)(BtY + ((size_t)g * 512 + nrow) * 640 + kc) = (u32x4){pk2(v[0], v[1]), pk2(v[2], v[3]), pk2(v[4], v[5]), pk2(v[6], v[7])}; }
        for (int ci_ = tid; ci_ < 1024; ci_ += NTHR) { const int n = part * 16 + (ci_ >> 6), kc = (ci_ & 63) * 8, pp = n & 63, im = n >> 6; float v[8];
#pragma unroll
            for (int i = 0; i < 8; ++i) { const int k = kc + i, sidx = k >> 4, h2 = k & 15, tau = 31 - sidx; const float wr = PWr[tau * 64 + pp], wi = PWi[tau * 64 + pp], br = BBr[pp * 16 + h2], bi = BBi[pp * 16 + h2];
                v[i] = im ? (wr * bi + wi * br) : (wr * br - wi * bi); }
            *(u32x4*)(BtZ + ((size_t)g * 256 + n) * 512 + kc) = (u32x4){pk2(v[0], v[1]), pk2(v[2], v[3]), pk2(v[4], v[5]), pk2(v[6], v[7])}; }
    }
    __syncthreads();
}

template <int MODE>
__device__ __forceinline__ void tr_job(const float* src, int K, int N, bf16_t* dst, int ldd, int row_off, int koff, const float* scale, float* lds, int bid, int nb, const float* scale2 = nullptr) {
    const int tk = K / 64, tn = N / 64, tid = threadIdx.x, nt_ = tk * tn;
    const int r = tid >> 3, c = (tid & 7) * 8;
    float4 a = {0.f, 0.f, 0.f, 0.f}, b = a; float sc = 1.f;
    if (bid < nt_) { const int k0 = (bid / tn) * 64, n0 = (bid % tn) * 64; const float* p = src + (size_t)(k0 + r) * N + n0 + c; a = *(const float4*)p; b = *(const float4*)(p + 4); sc = scale ? scale[k0 + r] - (scale2 ? scale2[k0 + r] : 0.f) : 1.f; }
    for (int t = bid; t < nt_; t += nb) {
        const int k0 = (t / tn) * 64, n0 = (t % tn) * 64;
        { float* l = lds + r * 65 + c; l[0] = a.x * sc; l[1] = a.y * sc; l[2] = a.z * sc; l[3] = a.w * sc; l[4] = b.x * sc; l[5] = b.y * sc; l[6] = b.z * sc; l[7] = b.w * sc; }
        if (t + nb < nt_) { const int t2 = t + nb, k2 = (t2 / tn) * 64, n2 = (t2 % tn) * 64; const float* p = src + (size_t)(k2 + r) * N + n2 + c; a = *(const float4*)p; b = *(const float4*)(p + 4); sc = scale ? scale[k2 + r] - (scale2 ? scale2[k2 + r] : 0.f) : 1.f; }
        __syncthreads();
        { const int nl = tid >> 3, kc = (tid & 7) * 8; float v[8];
#pragma unroll
          for (int i = 0; i < 8; ++i) v[i] = lds[(kc + i) * 65 + nl];
          int n = n0 + nl; int rowi = n;
          if (MODE == 1) rowi = (n >> 7) * 256 + (n & 127);
          if (MODE == 2) rowi = (n >> 7) * 256 + 128 + (n & 127);
          u32x4 w; w.x = pk2(v[0], v[1]); w.y = pk2(v[2], v[3]); w.z = pk2(v[4], v[5]); w.w = pk2(v[6], v[7]);
          *(u32x4*)(dst + (size_t)(row_off + rowi) * ldd + koff + k0 + kc) = w; }
        __syncthreads();
    }
}

__device__ __forceinline__ void prep_phase(const Params& p, float* lds, int bid, int nb) {
    unsigned char* ws = p.ws;
    s5_gen(p, (bf16_t*)(ws + OFF_BTY), (bf16_t*)(ws + OFF_BTZ), lds, bid, nb);
    tr_job<0>(p.in[10], 1024, 2048, (bf16_t*)(ws + OFF_WIN), 1024, 0, 0, nullptr, lds, bid, nb);
    tr_job<0>(p.in[19], 512, 512, (bf16_t*)(ws + OFF_WGLU), 512, 0, 0, nullptr, lds, bid, nb);
    tr_job<0>(p.in[27], 1024, 1024, (bf16_t*)(ws + OFF_WOUT), 1024, 0, 0, nullptr, lds, bid, nb);
    for (int l = 0; l < 2; ++l) {
        bf16_t* gu = (bf16_t*)(ws + (l ? OFF_WGU1 : OFF_WGU0)); bf16_t* dn = (bf16_t*)(ws + (l ? OFF_WDN1 : OFF_WDN0));
        tr_job<1>(p.in[7] + (size_t)l * 1024 * FF, 1024, FF, gu, 1024, 0, 0, nullptr, lds, bid, nb);
        tr_job<2>(p.in[8] + (size_t)l * 1024 * FF, 1024, FF, gu, 1024, 0, 0, nullptr, lds, bid, nb);
        tr_job<0>(p.in[9] + (size_t)l * FF * 1024, FF, 1024, dn, FF, 0, 0, nullptr, lds, bid, nb);
    }
    bf16_t* wrkv = (bf16_t*)(ws + OFF_WG1); bf16_t* wl1 = (bf16_t*)(ws + OFF_WL1); const float* mu = p.in[28];
    tr_job<0>(p.in[29], 1024, 1024, wrkv, 1024, 0, 0, nullptr, lds, bid, nb);
    tr_job<0>(p.in[30], 1024, 1024, wrkv, 1024, 1024, 0, nullptr, lds, bid, nb);
    tr_job<0>(p.in[31], 1024, 1024, wrkv, 1024, 2048, 0, nullptr, lds, bid, nb);
    tr_job<0>(p.in[34], 1024, 64, wl1, 2048, 0, 0, nullptr, lds, bid, nb);      tr_job<0>(p.in[34], 1024, 64, wl1, 2048, 0, 1024, mu + 1 * 1024, lds, bid, nb, mu + 3 * 1024);
    tr_job<0>(p.in[37], 1024, 64, wl1, 2048, 64, 0, nullptr, lds, bid, nb);     tr_job<0>(p.in[37], 1024, 64, wl1, 2048, 64, 1024, mu + 4 * 1024, lds, bid, nb, mu + 3 * 1024);
    tr_job<0>(p.in[39], 1024, 128, wl1, 2048, 128, 0, nullptr, lds, bid, nb);   tr_job<0>(p.in[39], 1024, 128, wl1, 2048, 128, 1024, mu + 5 * 1024, lds, bid, nb, mu + 3 * 1024);
    bf16_t* l2 = (bf16_t*)(ws + OFF_WL2);
    tr_job<0>(p.in[35], 64, 1024, l2, 256, 0, 0, nullptr, lds, bid, nb);
    tr_job<0>(p.in[38], 64, 1024, l2, 256, 1024, 64, nullptr, lds, bid, nb);
    tr_job<0>(p.in[40], 128, 1024, l2, 256, 2048, 128, nullptr, lds, bid, nb);
    for (int i = bid * NTHR + threadIdx.x; i < 3072 * 32; i += nb * NTHR) { const int n = i >> 5, kc = (i & 31) * 8; const int sel = n >> 10;
        const bool used = (sel == 0) ? (kc < 64) : (sel == 1) ? (kc >= 64 && kc < 128) : (kc >= 128);
        if (!used) *(u32x4*)(l2 + (size_t)n * 256 + kc) = (u32x4){0u, 0u, 0u, 0u}; }
    tr_job<0>(p.in[32], 1024, 1024, (bf16_t*)(ws + OFF_WO), 1024, 0, 0, nullptr, lds, bid, nb);
    {   const float* c = p.in[1]; const float* wada = p.in[3]; const float* bada = p.in[4]; float* mod = (float*)(ws + OFF_MOD);
        float* cact = lds;
        float* red = lds + 4096;
        for (int i = threadIdx.x; i < 4096; i += NTHR) { const float x = c[i]; cact[i] = x / (1.f + expf(-x)); }
        __syncthreads();
        const int col = threadIdx.x & 63, kg = threadIdx.x >> 6;
        for (int ch = bid; ch < 192; ch += nb) {
            const int l = ch / 96, n0 = (ch % 96) * 64;
            const float* wp = wada + (size_t)l * 1024 * 6144 + n0 + col;
            float a0 = 0.f, a1 = 0.f, a2 = 0.f, a3 = 0.f;
            for (int k = kg * 128; k < kg * 128 + 128; ++k) { const float w = wp[(size_t)k * 6144]; a0 += cact[k] * w; a1 += cact[1024 + k] * w; a2 += cact[2048 + k] * w; a3 += cact[3072 + k] * w; }
            red[(kg * 4 + 0) * 64 + col] = a0; red[(kg * 4 + 1) * 64 + col] = a1; red[(kg * 4 + 2) * 64 + col] = a2; red[(kg * 4 + 3) * 64 + col] = a3;
            __syncthreads();
            if (threadIdx.x < 256) { const int b = threadIdx.x >> 6; float s = 0.f;
#pragma unroll
                for (int g = 0; g < 8; ++g) s += red[(g * 4 + b) * 64 + col];
                mod[(size_t)(l * 4 + b) * 6144 + n0 + col] = s + bada[l * 6144 + n0 + col]; }
            __syncthreads();
        }
    }
}

template <bool RW>
__device__ __forceinline__ void norm_phase(const float* x, const float* g, const float* modl, int shift_off, int scale_off, bf16_t* out, int bid, int nb, int row0 = 0, int nrows = MTOK, const float* mu = nullptr) {
    const int wave = threadIdx.x >> 6, lane = threadIdx.x & 63;
    for (int row = row0 + bid * 8 + wave; row < row0 + nrows; row += nb * 8) {
        const int b = row >> 12; const float* xr = x + (size_t)row * 1024; const float* md = modl + (size_t)b * 6144;
        f32x4 v[4], vp[4]; float ss = 0.f, ssp = 0.f; const bool hasp = RW && ((row & 4095) != 0);
#pragma unroll
        for (int i = 0; i < 4; ++i) { v[i] = *(const f32x4*)(xr + i * 256 + lane * 4); ss += v[i][0] * v[i][0] + v[i][1] * v[i][1] + v[i][2] * v[i][2] + v[i][3] * v[i][3];
            if (RW) { vp[i] = hasp ? *(const f32x4*)(xr - 1024 + i * 256 + lane * 4) : (f32x4){0.f, 0.f, 0.f, 0.f}; ssp += vp[i][0] * vp[i][0] + vp[i][1] * vp[i][1] + vp[i][2] * vp[i][2] + vp[i][3] * vp[i][3]; } }
        ss = wave_sum(ss); const float rstd = rsqrtf(ss * (1.f / 1024.f) + 1e-6f);
        float rstdp = 0.f; if (RW) { ssp = wave_sum(ssp); rstdp = rsqrtf(ssp * (1.f / 1024.f) + 1e-6f); }
#pragma unroll
        for (int i = 0; i < 4; ++i) { const int c = i * 256 + lane * 4; const f32x4 gg = *(const f32x4*)(g + c), sc = *(const f32x4*)(md + scale_off + c), sh = *(const f32x4*)(md + shift_off + c);
            f32x4 h;
#pragma unroll
            for (int j = 0; j < 4; ++j) h[j] = v[i][j] * rstd * gg[j] * (1.f + sc[j]) + sh[j];
            if (!RW) { u32x2 w; w.x = pk2(h[0], h[1]); w.y = pk2(h[2], h[3]); *(u32x2*)(out + (size_t)row * 1024 + c) = w; }
            else { f32x4 d;
#pragma unroll
                for (int j = 0; j < 4; ++j) { const float hp = hasp ? (vp[i][j] * rstdp * gg[j] * (1.f + sc[j]) + sh[j]) : 0.f; d[j] = hp - h[j]; }
                const f32x4 mr = *(const f32x4*)(mu + c), mk = *(const f32x4*)(mu + 2048 + c), mv = *(const f32x4*)(mu + 3072 + c);
                const f32x4 xr_ = h + d * mr, xk_ = h + d * mk, xv_ = h + d * mv;
                bf16_t* o = out + (size_t)(row - row0) * 4096 + c;
                u32x2 w; w.x = pk2(xr_[0], xr_[1]); w.y = pk2(xr_[2], xr_[3]); *(u32x2*)(o) = w;
                w.x = pk2(xk_[0], xk_[1]); w.y = pk2(xk_[2], xk_[3]); *(u32x2*)(o + 1024) = w;
                w.x = pk2(xv_[0], xv_[1]); w.y = pk2(xv_[2], xv_[3]); *(u32x2*)(o + 2048) = w;
                w.x = pk2(d[0], d[1]); w.y = pk2(d[2], d[3]); *(u32x2*)(o + 3072) = w; } }
    }
}

__device__ __forceinline__ void qknorm_phase(bf16_t* Q, bf16_t* Kb, const int* pos, const float* qn, const float* kn, int bid, int nb) {
    const int wave = threadIdx.x >> 6, lane = threadIdx.x & 63, l16 = lane & 15, d0 = l16 * 4;
    float invf[4];
#pragma unroll
    for (int j = 0; j < 4; ++j) invf[j] = powf(500000.f, -(float)((l16 & 1) * 4 + j) / 8.f);
    const f32x4 qw = *(const f32x4*)(qn + d0), kw = *(const f32x4*)(kn + d0);
    for (int tok = bid * 8 + wave; tok < MTOK; tok += nb * 8) {
        const float ps = (float)pos[tok];
        float cs[4], sn[4];
#pragma unroll
        for (int j = 0; j < 4; ++j) { const float ang = ps * invf[j]; cs[j] = cosf(ang); sn[j] = sinf(ang); }
#pragma unroll
        for (int bsel = 0; bsel < 2; ++bsel) { bf16_t* buf = bsel ? Kb : Q; const f32x4 w = bsel ? kw : qw;
#pragma unroll
            for (int it = 0; it < 2; ++it) { const int vec = it * 4 + (lane >> 4); bf16_t* ptr = buf + (size_t)tok * 512 + vec * 64 + d0;
                const u32x2 raw = *(const u32x2*)ptr; float y[4] = {bflo(raw.x), bfhi(raw.x), bflo(raw.y), bfhi(raw.y)};
                float ss = y[0] * y[0] + y[1] * y[1] + y[2] * y[2] + y[3] * y[3];
                ss += __shfl_xor(ss, 1); ss += __shfl_xor(ss, 2); ss += __shfl_xor(ss, 4); ss += __shfl_xor(ss, 8);
                const float rstd = rsqrtf(ss * (1.f / 64.f) + 1e-6f);
#pragma unroll
                for (int j = 0; j < 4; ++j) y[j] = y[j] * rstd * w[j];
                float pr[4];
#pragma unroll
                for (int j = 0; j < 4; ++j) pr[j] = __shfl_xor(y[j], 2);
                if (l16 < 2) {
#pragma unroll
                    for (int j = 0; j < 4; ++j) y[j] = y[j] * cs[j] - pr[j] * sn[j]; }
                else if (l16 < 4) {
#pragma unroll
                    for (int j = 0; j < 4; ++j) y[j] = y[j] * cs[j] + pr[j] * sn[j]; }
                if (!bsel) {
#pragma unroll
                    for (int j = 0; j < 4; ++j) y[j] *= 0.125f * 1.4426950408889634f; }
                u32x2 o; o.x = pk2(y[0], y[1]); o.y = pk2(y[2], y[3]); *(u32x2*)ptr = o; } }
    }
}

__device__ __forceinline__ void vtrans_phase(const bf16_t* V, bf16_t* Vt, bf16_t* lds, int bid, int nb) {
    const int tid = threadIdx.x;
    for (int unit = bid; unit < 1024; unit += nb) {
        const int head = unit & 3, ch = unit >> 2; const int b = ch >> 6, t0 = (ch & 63) * 64;
#pragma unroll
        for (int i = 0; i < 2; ++i) { const int idx = tid + i * 512, t = idx >> 4, cc = (idx & 15) * 8;
            const u32x4 w = *(const u32x4*)(V + ((size_t)b * SEQ + t0 + t) * 512 + head * 128 + cc);
            unsigned* d = (unsigned*)(lds + t * 130 + cc); d[0] = w.x; d[1] = w.y; d[2] = w.z; d[3] = w.w; }
        __syncthreads();
        { const int e = tid >> 2, tc = (tid & 3) * 16; unsigned o[8];
#pragma unroll
          for (int i = 0; i < 8; ++i) o[i] = (unsigned)lds[(tc + 2 * i) * 130 + e] | ((unsigned)lds[(tc + 2 * i + 1) * 130 + e] << 16);
          u32x4* dst = (u32x4*)(Vt + ((size_t)(b * 4 + head) * 128 + e) * SEQ + t0 + tc);
          dst[0] = (u32x4){o[0], o[1], o[2], o[3]}; dst[1] = (u32x4){o[4], o[5], o[6], o[7]}; }
        __syncthreads();
    }
}

typedef float f32x16 __attribute__((ext_vector_type(16)));
__device__ __forceinline__ void attn_phase(const bf16_t* Q, const bf16_t* Kb, const bf16_t* Vt, bf16_t* OC, LAS unsigned char* lds, int bid, int nb) {
    const int tid = threadIdx.x, wave = __builtin_amdgcn_readfirstlane(tid >> 6), lane = tid & 63, c = wave >> 2, wq = wave & 3, l32 = lane & 31, hh = lane >> 5;
    constexpr int KROW = 272, VROW = 136, KBUF = 64 * KROW, VBUF = 128 * VROW, VOFF = 2 * KBUF;
    const int lkey = tid >> 4, lkc = tid & 15, lve = tid >> 3, lvc = tid & 7;
    for (int unit = bid; unit < 256; unit += nb) {
        const int b = unit & 3, head = (unit >> 2) & 3, pr = unit >> 4;
        const bf16_t* kg = Kb + ((size_t)b * SEQ + lkey) * 512 + head * 128 + lkc * 8;
        const bf16_t* vg = Vt + ((size_t)(b * 4 + head) * 128 + lve) * SEQ + lvc * 8;
        for (int half = 0; half < 2; ++half) {
            const int qb = half ? (31 - pr) : pr; const int q0 = qb * 128 + wq * 32; const int nst = (qb + 1) * 2;
            bf16x8 qf[4];
            { const bf16_t* qp = Q + ((size_t)b * SEQ + q0 + l32) * 512 + head * 128 + c * 64 + hh * 8;
#pragma unroll
              for (int ks = 0; ks < 4; ++ks) qf[ks] = *(const bf16x8*)(qp + ks * 16); }
            f32x16 o[4];
#pragma unroll
            for (int blk = 0; blk < 4; ++blk)
#pragma unroll
                for (int r = 0; r < 16; ++r) o[blk][r] = 0.f;
            float mrow = -INFINITY, lsum = 0.f;
            u32x4 kreg[2][2], vreg[2][2];
#define AT_ISSUE(set, st) do { const int st_ = ((st) < nst) ? (st) : nst - 1; kreg[set][0] = *(const u32x4*)(kg + (size_t)(st_ * 64) * 512); kreg[set][1] = *(const u32x4*)(kg + (size_t)(st_ * 64 + 32) * 512); \
                               vreg[set][0] = *(const u32x4*)(vg + st_ * 64); vreg[set][1] = *(const u32x4*)(vg + (size_t)64 * SEQ + st_ * 64); } while (0)
#define AT_WRITE(set, slot) do { *(LAS u32x4*)(lds + (slot) * KBUF + lkey * KROW + lkc * 16) = kreg[set][0]; *(LAS u32x4*)(lds + (slot) * KBUF + (lkey + 32) * KROW + lkc * 16) = kreg[set][1]; \
                                 LAS u32x2* vd0 = (LAS u32x2*)(lds + VOFF + (slot) * VBUF + lve * VROW + lvc * 16); vd0[0] = (u32x2){vreg[set][0].x, vreg[set][0].y}; vd0[1] = (u32x2){vreg[set][0].z, vreg[set][0].w}; \
                                 LAS u32x2* vd1 = (LAS u32x2*)(lds + VOFF + (slot) * VBUF + (lve + 64) * VROW + lvc * 16); vd1[0] = (u32x2){vreg[set][1].x, vreg[set][1].y}; vd1[1] = (u32x2){vreg[set][1].z, vreg[set][1].w}; } while (0)
#define AT_COMPUTE(slot, st) do { const int key0 = (st) * 64; \
                if (key0 <= q0 + 31) { \
                    LAS unsigned char* kb = lds + (slot) * KBUF + l32 * KROW + c * 128 + hh * 16; \
                    f32x16 s0, s1; _Pragma("unroll") for (int r = 0; r < 16; ++r) { s0[r] = 0.f; s1[r] = 0.f; } \
                    _Pragma("unroll") for (int ks = 0; ks < 4; ++ks) { const bf16x8 kf0 = *(const LAS bf16x8*)(kb + ks * 32), kf1 = *(const LAS bf16x8*)(kb + 32 * KROW + ks * 32); \
                        s0 = __builtin_amdgcn_mfma_f32_32x32x16_bf16(kf0, qf[ks], s0, 0, 0, 0); s1 = __builtin_amdgcn_mfma_f32_32x32x16_bf16(kf1, qf[ks], s1, 0, 0, 0); } \
                    if (key0 + 63 > q0) { const int qrel = q0 + l32 - key0; \
                        _Pragma("unroll") for (int r = 0; r < 16; ++r) { const int kl = (r & 3) + 8 * (r >> 2) + 4 * hh; if (kl > qrel) s0[r] = -INFINITY; if (kl + 32 > qrel) s1[r] = -INFINITY; } } \
                    float tm = fmaxf(s0[0], s1[0]); _Pragma("unroll") for (int r = 1; r < 16; ++r) tm = fmaxf(tm, fmaxf(s0[r], s1[r])); \
                    tm = fmaxf(tm, __shfl_xor(tm, 32)); \
                    const float mnew = fmaxf(mrow, tm); \
                    if (__any(mnew > mrow)) { const float al = __builtin_amdgcn_exp2f(mrow - mnew); lsum *= al; \
                        _Pragma("unroll") for (int blk = 0; blk < 4; ++blk) _Pragma("unroll") for (int r = 0; r < 16; ++r) o[blk][r] *= al; \
                        mrow = mnew; } \
                    float ps = 0.f; _Pragma("unroll") for (int r = 0; r < 16; ++r) { s0[r] = __builtin_amdgcn_exp2f(s0[r] - mrow); s1[r] = __builtin_amdgcn_exp2f(s1[r] - mrow); ps += s0[r] + s1[r]; } \
                    lsum += ps; \
                    LAS unsigned char* vb = lds + VOFF + (slot) * VBUF + l32 * VROW + hh * 8; \
                    _Pragma("unroll") for (int s2 = 0; s2 < 4; ++s2) { \
                        u32x4 pw; \
                        if (s2 < 2) { pw.x = cvt_pk_bf16(s0[8 * s2 + 0], s0[8 * s2 + 1]); pw.y = cvt_pk_bf16(s0[8 * s2 + 2], s0[8 * s2 + 3]); pw.z = cvt_pk_bf16(s0[8 * s2 + 4], s0[8 * s2 + 5]); pw.w = cvt_pk_bf16(s0[8 * s2 + 6], s0[8 * s2 + 7]); } \
                        else { pw.x = cvt_pk_bf16(s1[8 * (s2 - 2) + 0], s1[8 * (s2 - 2) + 1]); pw.y = cvt_pk_bf16(s1[8 * (s2 - 2) + 2], s1[8 * (s2 - 2) + 3]); pw.z = cvt_pk_bf16(s1[8 * (s2 - 2) + 4], s1[8 * (s2 - 2) + 5]); pw.w = cvt_pk_bf16(s1[8 * (s2 - 2) + 6], s1[8 * (s2 - 2) + 7]); } \
                        const bf16x8 pb = __builtin_bit_cast(bf16x8, pw); \
                        _Pragma("unroll") for (int blk = 0; blk < 4; ++blk) { const u32x2 v0 = *(const LAS u32x2*)(vb + blk * 32 * VROW + s2 * 32), v1 = *(const LAS u32x2*)(vb + blk * 32 * VROW + s2 * 32 + 16); \
                            const bf16x8 vf = __builtin_bit_cast(bf16x8, (u32x4){v0.x, v0.y, v1.x, v1.y}); \
                            o[blk] = __builtin_amdgcn_mfma_f32_32x32x16_bf16(vf, pb, o[blk], 0, 0, 0); } } } } while (0)
            AT_ISSUE(0, 0); AT_ISSUE(1, 1);
            __syncthreads();
            AT_WRITE(0, 0);
            __syncthreads();
            for (int st = 0; st < nst; st += 2) {
                AT_ISSUE(0, st + 2);
                AT_COMPUTE(0, st);
                AT_WRITE(1, 1);
                __syncthreads();
                AT_ISSUE(1, st + 3);
                AT_COMPUTE(1, st + 1);
                AT_WRITE(0, 0);
                __syncthreads();
            }
            lsum += __shfl_xor(lsum, 32);
            const float inv = 1.f / lsum;
            bf16_t* op = OC + ((size_t)b * SEQ + q0 + l32) * 1024 + (head * 2 + c) * 128 + 4 * hh;
#pragma unroll
            for (int blk = 0; blk < 4; ++blk)
#pragma unroll
                for (int g4 = 0; g4 < 4; ++g4) { u32x2 w; w.x = pk2(o[blk][g4 * 4 + 0] * inv, o[blk][g4 * 4 + 1] * inv); w.y = pk2(o[blk][g4 * 4 + 2] * inv, o[blk][g4 * 4 + 3] * inv);
                    *(u32x2*)(op + blk * 32 + g4 * 8) = w; }
        }
    }
}

__device__ __forceinline__ void attn_combine(const bf16_t* OC, bf16_t* CAT, const Params& p, int bid, int nb) {
    const int wave = threadIdx.x >> 6, lane = threadIdx.x & 63, head = lane >> 4, e0 = (lane & 15) * 8;
    float lam;
    { float s1 = 0.f, s2 = 0.f; for (int d = 0; d < 64; ++d) { s1 += p.in[22][d] * p.in[23][d]; s2 += p.in[24][d] * p.in[25][d]; } lam = expf(s1) - expf(s2) + 0.2f; }
    float sub[8];
#pragma unroll
    for (int i = 0; i < 8; ++i) sub[i] = p.in[26][e0 + i] * 0.8f;
    for (int tok = bid * 8 + wave; tok < MTOK; tok += nb * 8) {
        const u32x4 a = *(const u32x4*)(OC + (size_t)tok * 1024 + (head * 2) * 128 + e0), bb = *(const u32x4*)(OC + (size_t)tok * 1024 + (head * 2 + 1) * 128 + e0);
        float o[8] = {bflo(a.x) - lam * bflo(bb.x), bfhi(a.x) - lam * bfhi(bb.x), bflo(a.y) - lam * bflo(bb.y), bfhi(a.y) - lam * bfhi(bb.y),
                      bflo(a.z) - lam * bflo(bb.z), bfhi(a.z) - lam * bfhi(bb.z), bflo(a.w) - lam * bflo(bb.w), bfhi(a.w) - lam * bfhi(bb.w)};
        float ss = 0.f;
#pragma unroll
        for (int i = 0; i < 8; ++i) ss += o[i] * o[i];
        ss += __shfl_xor(ss, 1); ss += __shfl_xor(ss, 2); ss += __shfl_xor(ss, 4); ss += __shfl_xor(ss, 8);
        const float rstd = rsqrtf(ss * (1.f / 128.f) + 1e-6f);
        u32x4 w; w.x = pk2(o[0] * rstd * sub[0], o[1] * rstd * sub[1]); w.y = pk2(o[2] * rstd * sub[2], o[3] * rstd * sub[3]); w.z = pk2(o[4] * rstd * sub[4], o[5] * rstd * sub[5]); w.w = pk2(o[6] * rstd * sub[6], o[7] * rstd * sub[7]);
        *(u32x4*)(CAT + (size_t)tok * 1024 + 512 + head * 128 + e0) = w;
    }
}

typedef float f32x2 __attribute__((ext_vector_type(2)));
__device__ __forceinline__ float h2f_(unsigned bits) { return (float)__builtin_bit_cast(_Float16, (unsigned short)bits); }
__device__ __forceinline__ void rwkv_phase(const Params& p, const bf16_t* R, const bf16_t* Kk, const bf16_t* Vv, const _Float16* DEC, const bf16_t* AA, bf16_t* Y, float* lds, int bid, int nb) {
    const int tid = threadIdx.x, wave = __builtin_amdgcn_readfirstlane(tid >> 6), lane = tid & 63;
    constexpr int TCH = 16, BUFF = 5 * TCH * 64 + TCH * 16;
    constexpr int OBUF = TCH * 16 * 16;
    float* Lout = lds + 2 * BUFF;
    for (int unit = bid; unit < 256; unit += nb) {
        const int b = unit >> 6, h = (unit >> 2) & 15, rq = unit & 3;
        __syncthreads();
        if (wave >= 4) {
            const int pw = wave - 4, tl = lane >> 4, c4 = (lane & 15) * 4;
            const f32x4 kkw = *(const f32x4*)(p.in[41] + h * 64 + c4), kaw = *(const f32x4*)(p.in[42] + h * 64 + c4);
            u32x2 rr[4], kr[4], ar[4], dr[4], vr[4];
            const unsigned lofs = (unsigned)((pw * 4 + tl) * 1024 + h * 64 + c4), vofs = (unsigned)((pw * 4 + tl) * 1024 + h * 64 + rq * 16 + (lane & 3) * 4);
            const bf16_t* Rb = R + (size_t)b * SEQ * 1024; const bf16_t* Kb_ = Kk + (size_t)b * SEQ * 1024; const bf16_t* Vb = Vv + (size_t)b * SEQ * 1024;
            const bf16_t* Ab = AA + (size_t)b * SEQ * 1024; const _Float16* Db = DEC + (size_t)b * SEQ * 1024;
#define RW_ISSUE(set, ch) do { const unsigned o_ = (unsigned)(ch) * (TCH * 1024) + lofs; rr[set] = *(const u32x2*)(Rb + o_); kr[set] = *(const u32x2*)(Kb_ + o_); dr[set] = *(const u32x2*)(Db + o_); ar[set] = *(const u32x2*)(Ab + o_); \
                    vr[set] = *(const u32x2*)(Vb + (unsigned)(ch) * (TCH * 1024) + vofs); } while (0)
#define RW_STAGE(set, buf) do { float* L = lds + (buf) * BUFF + (pw * 4 + tl) * 64 + c4; \
                    const f32x4 k = {bflo(kr[set].x), bfhi(kr[set].x), bflo(kr[set].y), bfhi(kr[set].y)}, a = {bflo(ar[set].x), bfhi(ar[set].x), bflo(ar[set].y), bfhi(ar[set].y)}; \
                    const f32x4 r = {bflo(rr[set].x), bfhi(rr[set].x), bflo(rr[set].y), bfhi(rr[set].y)}; \
                    const f32x4 w = {1.f - h2f_(dr[set].x & 0xffffu), 1.f - h2f_(dr[set].x >> 16), 1.f - h2f_(dr[set].y & 0xffffu), 1.f - h2f_(dr[set].y >> 16)}; \
                    f32x4 kk = k * kkw; const float n2 = dpp_sum16((kk[0] * kk[0] + kk[1] * kk[1]) + (kk[2] * kk[2] + kk[3] * kk[3])); kk = kk * (1.f / fmaxf(sqrtf(n2), 1e-12f)); \
                    *(f32x4*)(L) = w; *(f32x4*)(L + 1 * TCH * 64) = -kk; *(f32x4*)(L + 2 * TCH * 64) = kk * a; *(f32x4*)(L + 3 * TCH * 64) = k * (1.f + (a - 1.f) * kaw); *(f32x4*)(L + 4 * TCH * 64) = r; \
                    if ((lane & 15) < 4) *(f32x4*)(lds + (buf) * BUFF + 5 * TCH * 64 + (pw * 4 + tl) * 16 + (lane & 3) * 4) = (f32x4){bflo(vr[set].x), bfhi(vr[set].x), bflo(vr[set].y), bfhi(vr[set].y)}; } while (0)
            auto flush = [&](int ch) { const int i = tid - 256, tt = i >> 4, row = i & 15; const f32x4* pp = (const f32x4*)(Lout + (ch & 1) * OBUF + i * 16);
                const f32x4 s4 = pp[0] + pp[1] + pp[2] + pp[3];
                Y[((size_t)b * SEQ + ch * TCH + tt) * 1024 + h * 64 + rq * 16 + row] = (bf16_t)f2bf((s4[0] + s4[1]) + (s4[2] + s4[3])); };
            constexpr int NCH = SEQ / TCH;
            RW_ISSUE(0, 0); RW_ISSUE(1, 1); RW_ISSUE(2, 2); RW_ISSUE(3, 3);
            RW_STAGE(0, 0);
            __syncthreads();
            for (int c4_ = 0; c4_ < NCH; c4_ += 4) {
#define RW_ITER(q) do { const int ch = c4_ + (q); RW_STAGE(((q) + 1) & 3, (ch + 1) & 1); { const int chn = (ch + 4 < NCH) ? ch + 4 : NCH - 1; RW_ISSUE((q), chn); } flush(ch > 0 ? ch - 1 : 0); __syncthreads(); } while (0)
                RW_ITER(0); RW_ITER(1); RW_ITER(2); RW_ITER(3);
            }
            flush(NCH - 1);
        } else {
            const int j = lane & 15, rowl = wave * 4 + (lane >> 4);
            f32x2 S01 = {0.f, 0.f}, S23 = {0.f, 0.f};
            __syncthreads();
            for (int ch = 0; ch < SEQ / TCH; ++ch) {
                const float* L = lds + (ch & 1) * BUFF + j * 4; const float* Lv = lds + (ch & 1) * BUFF + 5 * TCH * 64 + rowl; float* Lo = Lout + (ch & 1) * OBUF + rowl * 16 + j;
                f32x4 w4 = *(const f32x4*)(L), a4 = *(const f32x4*)(L + 1 * TCH * 64), b4 = *(const f32x4*)(L + 2 * TCH * 64), k4 = *(const f32x4*)(L + 3 * TCH * 64), r4 = *(const f32x4*)(L + 4 * TCH * 64);
                float vv = Lv[0];
#pragma unroll
                for (int tt = 0; tt < TCH; ++tt) {
                    f32x4 nw4 = w4, na4 = a4, nb4 = b4, nk4 = k4, nr4 = r4; float nvv = vv;
                    if (tt + 1 < TCH) { const float* Ln = L + (tt + 1) * 64; nw4 = *(const f32x4*)(Ln); na4 = *(const f32x4*)(Ln + 1 * TCH * 64); nb4 = *(const f32x4*)(Ln + 2 * TCH * 64); nk4 = *(const f32x4*)(Ln + 3 * TCH * 64); nr4 = *(const f32x4*)(Ln + 4 * TCH * 64); nvv = Lv[(tt + 1) * 16]; }
                    f32x2 d = S01 * (f32x2){a4[0], a4[1]}; d = S23 * (f32x2){a4[2], a4[3]} + d;
                    const float sa = dpp_sum16(d[0] + d[1]);
                    const f32x2 sa2 = {sa, sa}, v2 = {vv, vv};
                    const f32x2 t01 = sa2 * (f32x2){b4[0], b4[1]} + v2 * (f32x2){k4[0], k4[1]}, t23 = sa2 * (f32x2){b4[2], b4[3]} + v2 * (f32x2){k4[2], k4[3]};
                    S01 = S01 * (f32x2){w4[0], w4[1]} + t01; S23 = S23 * (f32x2){w4[2], w4[3]} + t23;
                    f32x2 y = S01 * (f32x2){r4[0], r4[1]}; y = S23 * (f32x2){r4[2], r4[3]} + y;
                    Lo[tt * 256] = y[0] + y[1];
                    w4 = nw4; a4 = na4; b4 = nb4; k4 = nk4; r4 = nr4; vv = nvv;
                }
                __syncthreads();
            }
        }
    }
}

__device__ __forceinline__ void rwkv_post(const Params& p, bf16_t* R, const bf16_t* Kk, const bf16_t* Vv, const bf16_t* AA, const bf16_t* G, const bf16_t* Y, int bid, int nb) {
    const int wave = threadIdx.x >> 6, lane = threadIdx.x & 63;
    for (int it = bid * 8 + wave; it < MTOK * 16; it += nb * 8) {
        const int h = it & 15; const size_t off = (size_t)(it >> 4) * 1024 + h * 64 + lane;
        const float y = bf2f(Y[off]), r = bf2f(R[off]), k = bf2f(Kk[off]), v = bf2f(Vv[off]), a = bf2f(AA[off]), g = bf2f(G[off]);
        const float mean = wave_sum(y) * (1.f / 64.f); const float d = y - mean; const float var = wave_sum(d * d) * (1.f / 64.f);
        const float k2 = k * (1.f + (a - 1.f) * p.in[42][h * 64 + lane]);
        const float sb = wave_sum(r * k2 * p.in[43][h * 64 + lane]);
        const float yn = d * rsqrtf(var + 64e-5f) * p.in[44][h * 64 + lane] + p.in[45][h * 64 + lane] + sb * v;
        R[off] = (bf16_t)f2bf(yn * g);
    }
}

#define XB_TMO      128
#define XB_XCNT(j)  (256  + 64 * (j))
#define XB_XSUB(j)  (1280 + 64 * (j))
#define XB_XGEN(j)  (2304 + 64 * (j))
#define XB_TOP      3328
#define XB_TOPGEN   3392
#define XCD_BAR_WORDS 3456
#define XB_SPIN_CAP (1u << 18)
__device__ __forceinline__ unsigned xb_ld(unsigned* p)              { return __hip_atomic_load(p, __ATOMIC_RELAXED, __HIP_MEMORY_SCOPE_AGENT); }
__device__ __forceinline__ unsigned xb_add(unsigned* p, unsigned v) { return __hip_atomic_fetch_add(p, v, __ATOMIC_RELAXED, __HIP_MEMORY_SCOPE_AGENT); }
__device__ __forceinline__ unsigned xb_xcc_id() { return (unsigned)__builtin_amdgcn_s_getreg((3 << 11) | 20) & 0xFu; }
#define XB_SPIN(cond, bar) do { unsigned _sp = 0; while (cond) { __builtin_amdgcn_s_sleep(1); \
    if ((++_sp & 255u) == 0u) { if (xb_ld(&(bar)[XB_TMO])) break; if (_sp > XB_SPIN_CAP) { atomicAdd(&(bar)[XB_TMO], 1u); break; } } } } while (0)
struct XcdBarrier { unsigned* bar; unsigned x; volatile LAS unsigned* st; };
__device__ __forceinline__ XcdBarrier xcd_barrier_post(unsigned* bar, volatile LAS unsigned* st) {
    XcdBarrier b; b.bar = bar; b.x = xb_xcc_id(); b.st = st;
    if (threadIdx.x == 0) (void)xb_add(&bar[XB_XCNT(b.x)], 1u);
    return b;
}
__device__ __forceinline__ void xcd_barrier_complete(unsigned* bar, unsigned x, unsigned& nloc, unsigned& nx) {
    const unsigned G = gridDim.x * gridDim.y * gridDim.z;
    unsigned sum, cnt, mine, sp = 0u;
    for (;;) {
        sum = 0u; cnt = 0u; mine = 0u;
#pragma unroll
        for (unsigned j = 0; j < 16; ++j) { const unsigned c = xb_ld(&bar[XB_XCNT(j)]); sum += c; cnt += (c > 0u) ? 1u : 0u; mine = (j == x) ? c : mine; }
        if (sum == G) break;
        __builtin_amdgcn_s_sleep(1);
        if ((++sp & 255u) == 0u) { if (xb_ld(&bar[XB_TMO])) break; if (sp > XB_SPIN_CAP) { atomicAdd(&bar[XB_TMO], 1u); break; } }
    }
    nloc = mine > 0u ? mine : 1u; nx = cnt > 0u ? cnt : 1u;
}
__device__ __forceinline__ void xcd_barrier(const XcdBarrier& b) {
    asm volatile("s_waitcnt vmcnt(0)" ::: "memory");
    __syncthreads();
    if (threadIdx.x == 0) {
        unsigned* bar = b.bar;
        __builtin_amdgcn_s_waitcnt(0);
        unsigned nloc = b.st[0], nx = b.st[1];
        if (nloc == 0u) { xcd_barrier_complete(bar, b.x, nloc, nx); b.st[0] = nloc; b.st[1] = nx; }
        const unsigned old = xb_add(&bar[XB_XSUB(b.x)], 1u);
        const unsigned gen = old / nloc;
        if (old + 1u == (gen + 1u) * nloc) {
            __builtin_amdgcn_fence(__ATOMIC_RELEASE, "agent");
            asm volatile("s_waitcnt vmcnt(0)" ::: "memory");
            const unsigned og = xb_add(&bar[XB_TOP], 1u);
            const unsigned tg = og / nx;
            if (og + 1u == (tg + 1u) * nx) xb_add(&bar[XB_TOPGEN], 1u);
            else XB_SPIN(xb_ld(&bar[XB_TOPGEN]) == tg, bar);
            __builtin_amdgcn_fence(__ATOMIC_ACQUIRE, "agent");
            xb_add(&bar[XB_XGEN(b.x)], 1u);
            asm volatile("s_waitcnt vmcnt(0)" ::: "memory");
        } else {
            XB_SPIN(xb_ld(&bar[XB_XGEN(b.x)]) == gen, bar);
            __builtin_amdgcn_fence(__ATOMIC_ACQUIRE, "agent");
            asm volatile("s_waitcnt vmcnt(0)" ::: "memory");
        }
    }
    __syncthreads();
}

__global__ void __launch_bounds__(NTHR) fwd_kernel(Params p) {
    extern __shared__ __attribute__((aligned(16))) unsigned char lds_raw[];
    LAS unsigned char* lds = (LAS unsigned char*)lds_raw;
    float* ldsf = (float*)lds_raw;
    const int bid = blockIdx.x, nb = gridDim.x;
    unsigned char* ws = p.ws;
    float* mod = (float*)(ws + OFF_MOD);
    const bool multi = (p.ph_hi - p.ph_lo) > 1;
    __shared__ unsigned xb_st[4];
    if (threadIdx.x < 4) xb_st[threadIdx.x] = 0u;
    __syncthreads();
    XcdBarrier xbar; xbar.bar = (unsigned*)(ws + OFF_BAR); xbar.x = 0; xbar.st = (volatile LAS unsigned*)xb_st;
    if (multi) xbar = xcd_barrier_post((unsigned*)(ws + OFF_BAR), (volatile LAS unsigned*)xb_st);
#ifndef TESTPH
#define TESTPH -1
#endif
#ifndef REPEAT_A
#define REPEAT_A -1
#endif
#ifndef REPEAT_B
#define REPEAT_B -1
#endif
#ifndef EXTRA_SYNCS
#define EXTRA_SYNCS 0
#endif
#define PH(k) if ((TESTPH < 0 || TESTPH == (k)) && p.ph_lo <= (k) && (k) < p.ph_hi) for (int rep_ = 0; rep_ < (((k) == REPEAT_A || (k) == REPEAT_B) ? 2 : 1); ++rep_)
#define SYNC(k) if (multi) { xcd_barrier(xbar); }
    for (int es_ = 0; es_ < EXTRA_SYNCS; ++es_) cg::this_grid().sync();
    if (p.ph_lo < -1000) cg::this_grid().sync();
    PH(0) { prep_phase(p, ldsf, bid, nb); SYNC(0) }
    PH(1) { norm_phase<false>(p.in[0], p.in[5], mod, 0, 1024, (bf16_t*)(ws + OFF_HA), bid, nb); SYNC(1) }
    PH(2) { EpiWin e{(bf16_t*)(ws + OFF_UX), (bf16_t*)(ws + OFF_QKV)}; gemm_stream(lds, (const bf16_t*)(ws + OFF_HA), (const bf16_t*)(ws + OFF_WIN), 2048, 1024, e, bid, nb); SYNC(2) }
    PH(3) { { EpiS5Z e{(float*)(ws + OFF_Z)}; gemm_batched(lds, (const bf16_t*)(ws + OFF_UX), 640, (size_t)512 * 640, (const bf16_t*)(ws + OFF_BTZ), (size_t)256 * 512, 2, 1, 32, 512, e, NoPre{}, bid, nb); }
            bf16_t* q = (bf16_t*)(ws + OFF_QKV); qknorm_phase(q, q + (size_t)MTOK * 512, (const int*)p.in[2], p.in[20], p.in[21], bid, nb);
            vtrans_phase(q + (size_t)MTOK * 1024, (bf16_t*)(ws + OFF_VT), (bf16_t*)lds_raw, bid, nb); SYNC(3) }
    PH(5) { { EpiS5Y e{(const bf16_t*)(ws + OFF_UX), (bf16_t*)(ws + OFF_YG), p.in[18]}; PreS5Y pre{(const float*)(ws + OFF_Z), (bf16_t*)(ws + OFF_UX), p.in[11], p.in[12], p.in[13]};
              gemm_batched(lds, (const bf16_t*)(ws + OFF_UX), 640, (size_t)512 * 640, (const bf16_t*)(ws + OFF_BTY), (size_t)512 * 640, 2, 2, 32, 640, e, pre, bid, nb); }
            bf16_t* q = (bf16_t*)(ws + OFF_QKV); attn_phase(q, q + (size_t)MTOK * 512, (const bf16_t*)(ws + OFF_VT), (bf16_t*)(ws + OFF_OC), lds, bid, nb); SYNC(5) }
    PH(6) { attn_combine((const bf16_t*)(ws + OFF_OC), (bf16_t*)(ws + OFF_CAT), p, bid, nb);
            EpiGlu e{(const bf16_t*)(ws + OFF_YG), (bf16_t*)(ws + OFF_CAT)}; gemm_phase(lds, (const bf16_t*)(ws + OFF_YG), (const bf16_t*)(ws + OFF_WGLU), 512, 512, e, bid, nb); SYNC(6) }
    PH(7) { EpiRes e{p.in[0], p.out, mod + 2048}; gemm_stream(lds, (const bf16_t*)(ws + OFF_CAT), (const bf16_t*)(ws + OFF_WOUT), 1024, 1024, e, bid, nb); SYNC(7) }
    PH(8) { norm_phase<false>(p.out, p.in[6], mod, 3072, 4096, (bf16_t*)(ws + OFF_HA), bid, nb); SYNC(8) }
    PH(9) { EpiSwiglu e{(bf16_t*)(ws + OFF_HID)}; gemm_stream(lds, (const bf16_t*)(ws + OFF_HA), (const bf16_t*)(ws + OFF_WGU0), 5632, 1024, e, bid, nb); SYNC(9) }
    PH(10) { EpiRes e{p.out, p.out, mod + 5120}; gemm_stream(lds, (const bf16_t*)(ws + OFF_HID), (const bf16_t*)(ws + OFF_WDN0), 1024, FF, e, bid, nb); SYNC(10) }
    const float* mod1 = mod + 4 * 6144;
#define RWKV_FRONT(PA, PB, ROW0) \
    PH(PA) { norm_phase<true>(p.out, p.in[5] + 1024, mod1, 0, 1024, (bf16_t*)(ws + OFF_HD), bid, nb, (ROW0), 8192, p.in[28]); SYNC(PA) } \
    PH(PB) { const bf16_t* xall = (const bf16_t*)(ws + OFF_HD); const bool split = (nb == 256); \
               \
             { pg8::Gemm g{xall + 2048, (const bf16_t*)(ws + OFF_WL1), 8192, 256, 2048, 4096}; SchedOne S{(bid < 32) ? bid : -1}; EpiAdapt<EpiL1> ea{EpiL1{(bf16_t*)(ws + OFF_L1), (ROW0)}}; \
               pg8::gemm_phase<EpiAdapt<EpiL1>, SchedOne, false, true>(lds, g, S, ea); } \
             { pg8::Gemm g{xall, (const bf16_t*)(ws + OFF_WG1), 8192, 3072, 1024, 4096}; SchedRKV S{split ? bid - 32 : bid, split ? 224 : nb}; EpiAdaptRKV ea{EpiRKV{(bf16_t*)(ws + OFF_RKV), (ROW0)}}; \
               pg8::gemm_phase<EpiAdaptRKV, SchedRKV, true, true>(lds, g, S, ea); } \
             SYNC(PB) }
    RWKV_FRONT(11, 12, 0)
    RWKV_FRONT(20, 21, 8192)
    PH(13) { EpiL2 e{(_Float16*)(ws + OFF_DEC), (bf16_t*)(ws + OFF_AA), (bf16_t*)(ws + OFF_G), p.in[33], p.in[36]}; gemm_phase(lds, (const bf16_t*)(ws + OFF_L1), (const bf16_t*)(ws + OFF_WL2), 3072, 256, e, bid, nb); SYNC(13) }
    PH(14) { const bf16_t* r = (const bf16_t*)(ws + OFF_RKV); rwkv_phase(p, r, r + (size_t)MTOK * 1024, r + (size_t)MTOK * 2048, (const _Float16*)(ws + OFF_DEC), (const bf16_t*)(ws + OFF_AA), (bf16_t*)(ws + OFF_Y), ldsf, bid, nb); SYNC(14) }
    PH(15) { bf16_t* r = (bf16_t*)(ws + OFF_RKV); rwkv_post(p, r, r + (size_t)MTOK * 1024, r + (size_t)MTOK * 2048, (const bf16_t*)(ws + OFF_AA), (const bf16_t*)(ws + OFF_G), (const bf16_t*)(ws + OFF_Y), bid, nb); SYNC(15) }
    PH(16) { EpiRes e{p.out, p.out, mod1 + 2048}; gemm_stream(lds, (const bf16_t*)(ws + OFF_RKV), (const bf16_t*)(ws + OFF_WO), 1024, 1024, e, bid, nb); SYNC(16) }
    PH(17) { norm_phase<false>(p.out, p.in[6] + 1024, mod1, 3072, 4096, (bf16_t*)(ws + OFF_HA), bid, nb); SYNC(17) }
    PH(18) { EpiSwiglu e{(bf16_t*)(ws + OFF_HID)}; gemm_stream(lds, (const bf16_t*)(ws + OFF_HA), (const bf16_t*)(ws + OFF_WGU1), 5632, 1024, e, bid, nb); SYNC(18) }
    PH(19) { EpiRes e{p.out, p.out, mod1 + 5120}; gemm_stream(lds, (const bf16_t*)(ws + OFF_HID), (const bf16_t*)(ws + OFF_WDN1), 1024, FF, e, bid, nb); }
}

constexpr int NPHASE = 22;
#ifndef ONE_LAUNCH
#define ONE_LAUNCH 1
#endif

extern "C" void kernel_launch(void* const* d_in, const int* in_sizes, int n_in, void* d_out, int out_size, void* d_ws, size_t ws_size, hipStream_t stream) {
    static int grid = 0;
    if (grid == 0) {
        if (n_in != 46 || ws_size < WS_NEED) { fprintf(stderr, "kernel_launch: unexpected n_in %d / ws_size %zu (need %zu)\n", n_in, ws_size, (size_t)WS_NEED); grid = -1; return; }
        if (hipFuncSetAttribute((const void*)fwd_kernel, hipFuncAttributeMaxDynamicSharedMemorySize, LDS_BYTES) != hipSuccess) { fprintf(stderr, "hipFuncSetAttribute failed\n"); grid = -1; return; }
        int dev = 0, cus = 0, per_cu = 0;
        (void)hipGetDevice(&dev); (void)hipDeviceGetAttribute(&cus, hipDeviceAttributeMultiprocessorCount, dev);
        (void)hipOccupancyMaxActiveBlocksPerMultiprocessor(&per_cu, (const void*)fwd_kernel, NTHR, LDS_BYTES);
        if (per_cu < 1) per_cu = 1;
        grid = cus;
    }
    if (grid < 0) return;
    Params p{};
    for (int i = 0; i < 46; ++i) p.in[i] = (const float*)d_in[i];
    p.out = (float*)d_out; p.ws = (unsigned char*)d_ws;
#if ONE_LAUNCH
    p.ph_lo = 0; p.ph_hi = NPHASE;
    if (hipMemsetAsync((char*)d_ws + OFF_BAR, 0, XCD_BAR_WORDS * 4, stream) != hipSuccess) { fprintf(stderr, "memset failed\n"); return; }
    void* args[] = {&p};
    hipError_t e = hipLaunchCooperativeKernel((const void*)fwd_kernel, dim3(grid), dim3(NTHR), args, LDS_BYTES, stream);
    if (e != hipSuccess) fprintf(stderr, "cooperative launch failed: %s (grid %d)\n", hipGetErrorString(e), grid);
#else
    for (int ph = 0; ph < NPHASE; ++ph) { p.ph_lo = ph; p.ph_hi = ph + 1; hipLaunchKernelGGL(fwd_kernel, dim3(grid), dim3(NTHR), LDS_BYTES, stream, p); }
#endif
}
```

```cpp
#include <hip/hip_runtime.h>
#include <hip/hip_cooperative_groups.h>
#include <cstdio>
#include <cstdint>
namespace cg = cooperative_groups;

#define LAS __attribute__((address_space(3)))
typedef unsigned short bf16_t;
typedef short bf16x8 __attribute__((ext_vector_type(8)));
typedef float f32x4 __attribute__((ext_vector_type(4)));
typedef unsigned u32x2 __attribute__((ext_vector_type(2)));
typedef unsigned u32x4 __attribute__((ext_vector_type(4)));

constexpr int MTOK = 16384, DM = 1024, SEQ = 4096, FF = 2816;
constexpr int NTHR = 512;
constexpr int LDS_BYTES = 131072;
constexpr size_t MiB = 1048576;
constexpr size_t OFF_WIN = 0;
constexpr size_t OFF_WGLU = 4194304;
constexpr size_t OFF_WOUT = 4718592;
constexpr size_t OFF_WGU0 = 6815744;
constexpr size_t OFF_WDN0 = 18350080;
constexpr size_t OFF_WGU1 = 39321600;
constexpr size_t OFF_WDN1 = 50855936;
constexpr size_t OFF_WG1 = 24117248;
constexpr size_t OFF_WL1 = 24117248 + 6291456;
constexpr size_t OFF_WL2 = 37748736;
constexpr size_t OFF_WO = 56623104;
constexpr size_t OFF_MOD = 58720256;
constexpr size_t OFF_BAR = 58916864;
constexpr size_t ACT = 57 * MiB;
constexpr size_t OFF_HA = ACT;
constexpr size_t OFF_UX = ACT + 32 * MiB;
constexpr size_t OFF_Z = ACT + 52 * MiB;
constexpr size_t OFF_BTZ = ACT + 112 * MiB;
constexpr size_t OFF_BTY = ACT + 176 * MiB;
constexpr size_t OFF_QKV = ACT + 64 * MiB;
constexpr size_t OFF_CAT = ACT + 112 * MiB;
constexpr size_t OFF_YG = ACT + 144 * MiB;
constexpr size_t OFF_VT = ACT + 160 * MiB;
constexpr size_t OFF_OC = ACT;
constexpr size_t OFF_HID = ACT + 32 * MiB;
constexpr size_t OFF_HD = ACT;
constexpr size_t OFF_RKV = ACT + 64 * MiB;
constexpr size_t OFF_G = ACT + 160 * MiB;
constexpr size_t OFF_Y = 0;
constexpr size_t OFF_L1 = 0;
constexpr size_t OFF_DEC = ACT;
constexpr size_t OFF_AA = ACT + 32 * MiB;
constexpr size_t WS_NEED = ACT + 196 * MiB;

struct Params {
    const float* in[46];
    float* out;
    unsigned char* ws;
    int ph_lo, ph_hi;
};

__device__ __forceinline__ unsigned f2bf(float f) { unsigned u = __float_as_uint(f); return (u + 0x7fffu + ((u >> 16) & 1u)) >> 16; }
__device__ __forceinline__ float bf2f(unsigned h) { return __uint_as_float(h << 16); }
__device__ __forceinline__ unsigned cvt_pk_bf16(float lo, float hi) { unsigned r; asm("v_cvt_pk_bf16_f32 %0, %1, %2" : "=v"(r) : "v"(lo), "v"(hi)); return r; }
__device__ __forceinline__ unsigned pk2(float lo, float hi) { return cvt_pk_bf16(lo, hi); }
__device__ __forceinline__ float bflo(unsigned w) { return __uint_as_float(w << 16); }
__device__ __forceinline__ float bfhi(unsigned w) { return __uint_as_float(w & 0xffff0000u); }
__device__ __forceinline__ float dpp_sum16(float x) {
    x += __int_as_float(__builtin_amdgcn_update_dpp(0, __float_as_int(x), 0xB1, 0xf, 0xf, true));
    x += __int_as_float(__builtin_amdgcn_update_dpp(0, __float_as_int(x), 0x4E, 0xf, 0xf, true));
    x += __int_as_float(__builtin_amdgcn_update_dpp(0, __float_as_int(x), 0x141, 0xf, 0xf, true));
    x += __int_as_float(__builtin_amdgcn_update_dpp(0, __float_as_int(x), 0x140, 0xf, 0xf, true));
    return x;
}
__device__ __forceinline__ float wave_sum(float v) {
    v = dpp_sum16(v);
    const float s0 = __int_as_float(__builtin_amdgcn_readlane(__float_as_int(v), 0)), s1 = __int_as_float(__builtin_amdgcn_readlane(__float_as_int(v), 16));
    const float s2 = __int_as_float(__builtin_amdgcn_readlane(__float_as_int(v), 32)), s3 = __int_as_float(__builtin_amdgcn_readlane(__float_as_int(v), 48));
    return (s0 + s1) + (s2 + s3);
}
__device__ __forceinline__ float sigmoidf_(float x) { return __fdividef(1.f, 1.f + __expf(-x)); }
__device__ __forceinline__ float tanh_fast(float x) { const float t = __expf(2.f * fminf(fmaxf(x, -15.f), 15.f)); return __fdividef(t - 1.f, t + 1.f); }
#define LWAIT() asm volatile("s_waitcnt lgkmcnt(0)" ::: "memory")
__device__ __forceinline__ float gelu_tanh(float x) { const float u = 0.7978845608028654f * (x + 0.044715f * x * x * x); const float t = __expf(2.f * fminf(fmaxf(u, -15.f), 15.f)); return __fdividef(x * t, t + 1.f); }

constexpr int HTB = 128 * 64 * 2;
__device__ __forceinline__ int lds_byte(int r, int c) { int st = (r >> 4) * 2 + (c >> 5), rr = r & 15, cc = c & 31, ob = rr * 64 + cc * 2; return st * 1024 + (ob ^ (((ob >> 9) & 1) << 5)); }
__device__ __forceinline__ void stage_rc(int b, int& R, int& C) { int st = b / 1024, sb = b % 1024, swz = sb ^ (((sb >> 9) & 1) << 5); R = (st >> 1) * 16 + swz / 64; C = (st & 1) * 32 + (swz % 64) / 2; }

struct NoPre { static constexpr bool NOP = true; __device__ __forceinline__ void operator()(int, int, int) const {} };
template <class Epi, class Pre, bool PF = true>
__device__ __forceinline__ void gemm_batched(LAS unsigned char* lds, const bf16_t* A, int lda, size_t strideA, const bf16_t* Bt, size_t strideB, int nMt, int nNt, int nbatch, int K, const Epi& E, const Pre& PRE, int bid, int nb) {
    const int tid = threadIdx.x, wid = __builtin_amdgcn_readfirstlane(tid >> 6), lane = tid & 63, wr = wid >> 2, wc = wid & 3, fr = lane & 15, fq = lane >> 4;
    unsigned voffA[2], voffB[2];
#pragma unroll
    for (int i = 0; i < 2; ++i) { int R, C; stage_rc(tid * 16 + i * 8192, R, C); voffA[i] = (unsigned)(R * lda + C) * 2u; voffB[i] = (unsigned)(R * K + C) * 2u; }
    const int aoff = lds_byte(wr * 64 + fr, fq * 8), boff = lds_byte(wc * 32 + fr, fq * 8);
    const unsigned ldsw = (unsigned)wid * 1024u;
    const size_t kstep = 128, hstepA = (size_t)128 * lda * 2, hstepB = (size_t)128 * K * 2;
    const int nt = K / 64;
    const int ntiles = nMt * nNt * nbatch;
#define G_SA(b, h) (((b) * 2 + (h)) * HTB)
#define G_SB(b, h) ((4 + (b) * 2 + (h)) * HTB)
#define G_STAGEX(bufoff, gptr, vo) do { _Pragma("unroll") for (int _i = 0; _i < 2; ++_i) \
        __builtin_amdgcn_global_load_lds((const unsigned*)((gptr) + vo[_i]), (LAS unsigned*)(lds + (bufoff) + ldsw + _i * 8192), 16, 0, 0); } while (0)
#define G_STA(bufoff, gptr) G_STAGEX(bufoff, gptr, voffA)
#define G_STB(bufoff, gptr) G_STAGEX(bufoff, gptr, voffB)
#define G_LDA(dst, b, h) do { _Pragma("unroll") for (int m = 0; m < 4; ++m) _Pragma("unroll") for (int k = 0; k < 2; ++k) dst[m][k] = *(const LAS bf16x8*)(lds + G_SA(b, h) + aoff + m * 2048 + k * 1024); } while (0)
#define G_LDB(dst, b, h) do { _Pragma("unroll") for (int n = 0; n < 2; ++n) _Pragma("unroll") for (int k = 0; k < 2; ++k) dst[n][k] = *(const LAS bf16x8*)(lds + G_SB(b, h) + boff + n * 2048 + k * 1024); } while (0)
#define G_MMA(ai, bj, At, Bx) do { __builtin_amdgcn_s_setprio(1); _Pragma("unroll") for (int m = 0; m < 4; ++m) _Pragma("unroll") for (int n = 0; n < 2; ++n) _Pragma("unroll") for (int k = 0; k < 2; ++k) \
        acc[ai][bj][m][n] = __builtin_amdgcn_mfma_f32_16x16x32_bf16(Bx[n][k], At[m][k], acc[ai][bj][m][n], 0, 0, 0); __builtin_amdgcn_s_setprio(0); } while (0)
#define G_WV(n) asm volatile("s_waitcnt vmcnt(" #n ")" ::: "memory")
#define G_WL(n) asm volatile("s_waitcnt lgkmcnt(" #n ")" ::: "memory")
#define G_BAR __builtin_amdgcn_s_barrier()
#define G_SCHED __builtin_amdgcn_sched_barrier(0)
    bool prefetched = false;
    for (int tile = bid; tile < ntiles; tile += nb) {
        const int pm = tile % nMt, tq = tile / nMt, pn = tq % nNt, gb = tq / nNt;
        PRE(gb, pm, pn);
        const char* cA = (const char*)(A + (size_t)gb * strideA) + (size_t)pm * 256 * lda * 2;
        const char* cB = (const char*)(Bt + (size_t)gb * strideB) + (size_t)pn * 256 * K * 2;
        f32x4 acc[2][2][4][2];
#pragma unroll
        for (int a = 0; a < 2; ++a)
#pragma unroll
            for (int b = 0; b < 2; ++b)
#pragma unroll
                for (int m = 0; m < 4; ++m)
#pragma unroll
                    for (int n = 0; n < 2; ++n) acc[a][b][m][n] = (f32x4){0.f, 0.f, 0.f, 0.f};
        bf16x8 At[4][2], B0[2][2], B1[2][2];
        if (!prefetched) { G_WV(0); G_STB(G_SB(0, 0), cB); G_STA(G_SA(0, 0), cA); G_STB(G_SB(0, 1), cB + hstepB); G_STA(G_SA(0, 1), cA + hstepA); }
        if (wr == 1) G_BAR;
        if (prefetched) G_WV(0); else G_WV(4);
        G_BAR;
        G_STB(G_SB(1, 0), cB + kstep); G_STA(G_SA(1, 0), cA + kstep); G_STB(G_SB(1, 1), cB + hstepB + kstep);
        G_WV(6); G_BAR;
        for (int t = 0; t < nt - 2; t += 2) {
            const char* a1 = cA + (size_t)(t + 1) * kstep; const char* a2 = cA + (size_t)(t + 2) * kstep; const char* a3 = a2 + kstep;
            const char* b2 = cB + (size_t)(t + 2) * kstep; const char* b3 = b2 + kstep;
            G_LDB(B0, 0, 0); G_SCHED; G_LDA(At, 0, 0); G_STA(G_SA(1, 1), a1 + hstepA);
            G_WL(8); G_BAR; G_WL(0); G_MMA(0, 0, At, B0); G_BAR; G_SCHED;
            G_LDB(B1, 0, 1); G_STB(G_SB(0, 0), b2);
            G_BAR; G_WL(0); G_MMA(0, 1, At, B1); G_BAR;
            G_LDA(At, 0, 1); G_STA(G_SA(0, 0), a2);
            G_BAR; G_WL(0); G_MMA(1, 0, At, B0); G_BAR; G_SCHED;
            G_STB(G_SB(0, 1), b2 + hstepB);
            G_WV(6); G_BAR; G_MMA(1, 1, At, B1); G_BAR;
            G_LDB(B0, 1, 0); G_SCHED; G_LDA(At, 1, 0); G_STA(G_SA(0, 1), a2 + hstepA);
            G_WL(8); G_BAR; G_WL(0); G_MMA(0, 0, At, B0); G_BAR; G_SCHED;
            G_LDB(B1, 1, 1); G_STB(G_SB(1, 0), b3);
            G_BAR; G_WL(0); G_MMA(0, 1, At, B1); G_BAR;
            G_LDA(At, 1, 1); G_STA(G_SA(1, 0), a3);
            G_BAR; G_WL(0); G_MMA(1, 0, At, B0); G_BAR; G_SCHED;
            G_STB(G_SB(1, 1), b3 + hstepB);
            G_WV(6); G_BAR; G_MMA(1, 1, At, B1); G_BAR;
        }
        {
            const char* a1 = cA + (size_t)(nt - 1) * kstep;
            G_LDB(B0, 0, 0); G_LDA(At, 0, 0); G_STA(G_SA(1, 1), a1 + hstepA);
            G_BAR; G_WL(0); G_MMA(0, 0, At, B0); G_BAR;
            G_LDB(B1, 0, 1); G_BAR; G_WL(0); G_MMA(0, 1, At, B1); G_BAR;
            G_LDA(At, 0, 1); G_WV(4); G_BAR; G_WL(0); G_MMA(1, 0, At, B0); G_MMA(1, 1, At, B1); G_BAR;
        }
        {
            G_LDB(B0, 1, 0); G_LDA(At, 1, 0); G_WV(2); G_BAR; G_WL(0); G_MMA(0, 0, At, B0); G_BAR;
            G_LDB(B1, 1, 1); G_WV(0); G_BAR; G_WL(0); G_MMA(0, 1, At, B1); G_BAR;
            G_LDA(At, 1, 1); G_BAR; G_WL(0); G_MMA(1, 0, At, B0); G_MMA(1, 1, At, B1); G_BAR;
        }
        if (wr == 0) G_BAR;
        prefetched = false;
        if (PF && Pre::NOP && tile + nb < ntiles) {
            const int t2 = tile + nb, pm2 = t2 % nMt, tq2 = t2 / nMt, pn2 = tq2 % nNt, gb2 = tq2 / nNt;
            const char* nA = (const char*)(A + (size_t)gb2 * strideA) + (size_t)pm2 * 256 * lda * 2;
            const char* nB = (const char*)(Bt + (size_t)gb2 * strideB) + (size_t)pn2 * 256 * K * 2;
            G_STB(G_SB(0, 0), nB); G_STA(G_SA(0, 0), nA); G_STB(G_SB(0, 1), nB + hstepB); G_STA(G_SA(0, 1), nA + hstepA);
            prefetched = true; }
        E(acc, gb, pm, pn, wr, wc, fr, fq);
    }
    G_WV(0);
    __syncthreads();
}

template <class Epi>
__device__ __forceinline__ void gemm_phase(LAS unsigned char* lds, const bf16_t* A, const bf16_t* Bt, int N, int K, const Epi& E, int bid, int nb) {
    gemm_batched(lds, A, K, 0, Bt, 0, 64, N / 256, 1, K, E, NoPre{}, bid, nb);
}

namespace pg8 {
#define PG8_LAS __attribute__((address_space(3)))
typedef unsigned short bf16_t;
typedef short bf16x8 __attribute__((ext_vector_type(8)));
typedef float f32x4 __attribute__((ext_vector_type(4)));
typedef unsigned u32x4 __attribute__((ext_vector_type(4)));
constexpr int BM = 256, BK = 64, HALF = 128, HTB = HALF * BK * 2  , STAGE_BYTES = 8 * HTB, NXCD = 8, WGM = 8;

__host__ __device__ __forceinline__ int lds_byte(int r, int c) { const int st = (r >> 4) * 2 + (c >> 5), rr = r & 15, cc = c & 31, ob = rr * 64 + cc * 2; return st * 1024 + (ob ^ (((ob >> 9) & 1) << 5)); }
__host__ __device__ __forceinline__ void stage_rc(int b, int& R, int& C) { const int st = b / 1024, sb = b % 1024, swz = sb ^ (((sb >> 9) & 1) << 5); R = (st >> 1) * 16 + swz / 64; C = (st & 1) * 32 + (swz % 64) / 2; }
__host__ __device__ __forceinline__ int perm32(int rho) { const int n = rho >> 4, i = rho & 15; return 8 * (i >> 2) + 4 * n + (i & 3); }

struct Unit { int pm, pn; int ao = 0; };
struct Gemm { const bf16_t* A; const bf16_t* Bt; int M, N, K; int lda; };

struct StaticOrder {
    int nM, nN, nwg, G, c;
    __host__ __device__ void init(int M, int N, int G_, int c_) { nM = M / BM; nN = N / BM; nwg = nM * nN; G = G_; c = c_; }
    __host__ __device__ bool next(int i, Unit& u) const {
        const long L = (long)i * G + c; if (L >= nwg) return false;
        int wgid = (int)L; { const int q = nwg / NXCD, r = nwg % NXCD, xcd = wgid % NXCD, off = wgid / NXCD; wgid = (xcd < r ? xcd * (q + 1) : r * (q + 1) + (xcd - r) * q) + off; }
        const int nig = WGM * nN, gid = wgid / nig, fm = gid * WGM, gsz = (nM - fm) < WGM ? (nM - fm) : WGM;
        u.pm = fm + ((wgid % nig) % gsz); u.pn = (wgid % nig) / gsz; return true;
    }
    __device__ __forceinline__ void a_ready(const Unit&) const {}
    __device__ __forceinline__ void done(const Unit&) const {}
};
template <class Epi, class Sched, bool ALIGN_EPI = false, bool SP2 = false>
__device__ __forceinline__ void gemm_phase(PG8_LAS unsigned char* lds, const Gemm g, const Sched& S, const Epi& E) {
    const int tid = threadIdx.x, wid = __builtin_amdgcn_readfirstlane(tid >> 6), lane = tid & 63, wr = wid >> 2, wc = wid & 3, fr = lane & 15, fq = lane >> 4;
    const int K = g.K, nt = K / BK;
    unsigned voffA[2], voffB[2];
#pragma unroll
    for (int i = 0; i < 2; ++i) { int R, C; stage_rc(tid * 16 + i * 8192, R, C); const int Rb = Epi::PERM ? ((R & ~31) + perm32(R & 31)) : R;
        voffA[i] = (unsigned)(R * g.lda + C) * 2u; voffB[i] = (unsigned)(Rb * K + C) * 2u; }
    const size_t kstep = (size_t)(BK * 2);
    const size_t hstep = (size_t)HALF * K * 2;
    const size_t tstep = 2 * hstep;
    const size_t hstepA = (size_t)HALF * g.lda * 2, tstepA = 2 * hstepA;
    const unsigned ldsw = (unsigned)wid * 1024u;
    const int aoff = lds_byte(wr * 64 + fr, fq * 8), boff = lds_byte(wc * 32 + fr, fq * 8);
#define PG8_SA(b, h) (((b) * 2 + (h)) * HTB)
#define PG8_SB(b, h) ((4 + (b) * 2 + (h)) * HTB)
#define PG8_STAGE(bufoff, gbase, voff) do { _Pragma("unroll") for (int _i = 0; _i < 2; ++_i) \
        __builtin_amdgcn_global_load_lds((const unsigned*)((const char*)(gbase) + (voff)[_i]), (PG8_LAS unsigned*)(lds + (bufoff) + ldsw + _i * 8192), 16, 0, 0); } while (0)
#define PG8_LDA(dst, b, h) do { _Pragma("unroll") for (int m = 0; m < 4; ++m) _Pragma("unroll") for (int k = 0; k < 2; ++k) dst[m][k] = *(const PG8_LAS bf16x8*)(lds + PG8_SA(b, h) + aoff + m * 2048 + k * 1024); } while (0)
#define PG8_LDB(dst, b, h) do { _Pragma("unroll") for (int n = 0; n < 2; ++n) _Pragma("unroll") for (int k = 0; k < 2; ++k) dst[n][k] = *(const PG8_LAS bf16x8*)(lds + PG8_SB(b, h) + boff + n * 2048 + k * 1024); } while (0)
#define PG8_MMA(ai, bj, At, Bt) do { __builtin_amdgcn_s_setprio(1); _Pragma("unroll") for (int m = 0; m < 4; ++m) _Pragma("unroll") for (int n = 0; n < 2; ++n) _Pragma("unroll") for (int k = 0; k < 2; ++k) \
        acc[ai][bj][m][n] = __builtin_amdgcn_mfma_f32_16x16x32_bf16(Bt[n][k], At[m][k], acc[ai][bj][m][n], 0, 0, 0); __builtin_amdgcn_s_setprio(0); } while (0)
#define PG8_WAIT_V(n) asm volatile("s_waitcnt vmcnt(" #n ")" ::: "memory")
#define PG8_WAIT_L(n) asm volatile("s_waitcnt lgkmcnt(" #n ")" ::: "memory")
#define PG8_BAR __builtin_amdgcn_s_barrier()
#define PG8_SCHED __builtin_amdgcn_sched_barrier(0)
    Unit cur, nxt; int ui = 0;
    if (!S.next(0, cur)) return;
    f32x4 acc[2][2][4][2];
#pragma unroll
    for (int a = 0; a < 2; ++a)
#pragma unroll
        for (int b = 0; b < 2; ++b)
#pragma unroll
            for (int m = 0; m < 4; ++m)
#pragma unroll
                for (int n = 0; n < 2; ++n) acc[a][b][m][n] = (f32x4){0.f, 0.f, 0.f, 0.f};
    bf16x8 At[4][2], B0[2][2], B1[2][2];
    const char* cA = (const char*)g.A + (size_t)cur.pm * tstepA + cur.ao; const char* cB = (const char*)g.Bt + (size_t)cur.pn * tstep;
    S.a_ready(cur);
    if constexpr (SP2) {
        PG8_STAGE(PG8_SB(0, 0), cB, voffB); PG8_STAGE(PG8_SB(0, 1), cB + hstep, voffB); PG8_STAGE(PG8_SA(0, 0), cA, voffA); PG8_STAGE(PG8_SA(0, 1), cA + hstepA, voffA);
        if (wr == 1) PG8_BAR;
        PG8_WAIT_V(2); PG8_BAR;
        PG8_STAGE(PG8_SB(1, 0), cB + kstep, voffB); PG8_STAGE(PG8_SA(1, 0), cA + kstep, voffA); PG8_STAGE(PG8_SB(1, 1), cB + hstep + kstep, voffB);
        PG8_WAIT_V(6); PG8_BAR;
    } else {
        PG8_STAGE(PG8_SB(0, 0), cB, voffB); PG8_STAGE(PG8_SA(0, 0), cA, voffA); PG8_STAGE(PG8_SB(0, 1), cB + hstep, voffB); PG8_STAGE(PG8_SA(0, 1), cA + hstepA, voffA);
        if (wr == 1) PG8_BAR;
        PG8_WAIT_V(4); PG8_BAR;
        PG8_STAGE(PG8_SB(1, 0), cB + kstep, voffB); PG8_STAGE(PG8_SA(1, 0), cA + kstep, voffA); PG8_STAGE(PG8_SB(1, 1), cB + hstep + kstep, voffB);
        PG8_WAIT_V(6); PG8_BAR;
    }
    for (;;) {
        const bool has_next = S.next(ui + 1, nxt);
        const char* nA = has_next ? (const char*)g.A + (size_t)nxt.pm * tstepA + nxt.ao : cA; const char* nB = has_next ? (const char*)g.Bt + (size_t)nxt.pn * tstep : cB;
        for (int t = 0; t < nt; t += 2) {
            const bool last = (t == nt - 2);
            const char* a1 = cA + (size_t)(t + 1) * kstep;
            const char* a2 = last ? nA : cA + (size_t)(t + 2) * kstep; const char* b2 = last ? nB : cB + (size_t)(t + 2) * kstep;
            const char* a3 = a2 + kstep; const char* b3 = b2 + kstep;
            if (last && has_next) S.a_ready(nxt);
            if constexpr (SP2) {
            PG8_LDB(B0, 0, 0); PG8_LDB(B1, 0, 1); PG8_SCHED; PG8_LDA(At, 0, 0); PG8_STAGE(PG8_SA(1, 1), a1 + hstepA, voffA);
            PG8_WAIT_V(8); PG8_WAIT_L(0); PG8_BAR; PG8_MMA(0, 0, At, B0); PG8_MMA(0, 1, At, B1); PG8_BAR; PG8_SCHED;
            PG8_LDA(At, 0, 1); PG8_STAGE(PG8_SB(0, 0), b2, voffB); PG8_STAGE(PG8_SB(0, 1), b2 + hstep, voffB); PG8_STAGE(PG8_SA(0, 0), a2, voffA);
            PG8_WAIT_V(8); PG8_WAIT_L(0); PG8_BAR; PG8_MMA(1, 0, At, B0); PG8_MMA(1, 1, At, B1); PG8_BAR; PG8_SCHED;
            PG8_LDB(B0, 1, 0); PG8_LDB(B1, 1, 1); PG8_SCHED; PG8_LDA(At, 1, 0); PG8_STAGE(PG8_SA(0, 1), a2 + hstepA, voffA);
            PG8_WAIT_V(8); PG8_WAIT_L(0); PG8_BAR; PG8_MMA(0, 0, At, B0); PG8_MMA(0, 1, At, B1); PG8_BAR; PG8_SCHED;
            PG8_LDA(At, 1, 1); PG8_STAGE(PG8_SB(1, 0), b3, voffB); PG8_STAGE(PG8_SB(1, 1), b3 + hstep, voffB); PG8_STAGE(PG8_SA(1, 0), a3, voffA);
            PG8_WAIT_V(8); PG8_WAIT_L(0); PG8_BAR; PG8_MMA(1, 0, At, B0); PG8_MMA(1, 1, At, B1); PG8_BAR; PG8_SCHED;
            } else {
            PG8_LDB(B0, 0, 0); PG8_SCHED; PG8_LDA(At, 0, 0); PG8_STAGE(PG8_SA(1, 1), a1 + hstepA, voffA);
            PG8_WAIT_L(8); PG8_BAR; PG8_WAIT_L(0); PG8_MMA(0, 0, At, B0); PG8_BAR; PG8_SCHED;
            PG8_LDB(B1, 0, 1); PG8_STAGE(PG8_SB(0, 0), b2, voffB);
            PG8_BAR; PG8_WAIT_L(0); PG8_MMA(0, 1, At, B1); PG8_BAR;
            PG8_LDA(At, 0, 1); PG8_STAGE(PG8_SA(0, 0), a2, voffA);
            PG8_BAR; PG8_WAIT_L(0); PG8_MMA(1, 0, At, B0); PG8_BAR; PG8_SCHED;
            PG8_STAGE(PG8_SB(0, 1), b2 + hstep, voffB);
            PG8_WAIT_V(6); PG8_BAR; PG8_MMA(1, 1, At, B1); PG8_BAR;
            PG8_LDB(B0, 1, 0); PG8_SCHED; PG8_LDA(At, 1, 0); PG8_STAGE(PG8_SA(0, 1), a2 + hstepA, voffA);
            PG8_WAIT_L(8); PG8_BAR; PG8_WAIT_L(0); PG8_MMA(0, 0, At, B0); PG8_BAR; PG8_SCHED;
            PG8_LDB(B1, 1, 1); PG8_STAGE(PG8_SB(1, 0), b3, voffB);
            PG8_BAR; PG8_WAIT_L(0); PG8_MMA(0, 1, At, B1); PG8_BAR;
            PG8_LDA(At, 1, 1); PG8_STAGE(PG8_SA(1, 0), a3, voffA);
            PG8_BAR; PG8_WAIT_L(0); PG8_MMA(1, 0, At, B0); PG8_BAR; PG8_SCHED;
            PG8_STAGE(PG8_SB(1, 1), b3 + hstep, voffB);
            PG8_WAIT_V(6); PG8_BAR; PG8_MMA(1, 1, At, B1); PG8_BAR;
            }
        }
        if constexpr (ALIGN_EPI) { if (wr == 0) PG8_BAR; }
        if constexpr (!Epi::AFTER_DRAIN) { E(acc, cur, wr, wc, fr, fq); S.done(cur); }
        if (!has_next) break;
#pragma unroll
        for (int a = 0; a < 2; ++a)
#pragma unroll
            for (int b = 0; b < 2; ++b)
#pragma unroll
                for (int m = 0; m < 4; ++m)
#pragma unroll
                    for (int n = 0; n < 2; ++n) acc[a][b][m][n] = (f32x4){0.f, 0.f, 0.f, 0.f};
        cur = nxt; cA = nA; cB = nB; ++ui;
        if constexpr (ALIGN_EPI) { if (wr == 1) PG8_BAR; }
    }
    PG8_WAIT_V(0);
    if constexpr (!ALIGN_EPI) { if (wr == 0) PG8_BAR; }
    PG8_BAR;
    if constexpr (Epi::AFTER_DRAIN) { E.fused(acc, cur, wr, wc, fr, fq, lds, wid, lane); S.done(cur); }
#undef PG8_SA
#undef PG8_SB
#undef PG8_STAGE
#undef PG8_LDA
#undef PG8_LDB
#undef PG8_MMA
#undef PG8_WAIT_V
#undef PG8_WAIT_L
#undef PG8_BAR
#undef PG8_SCHED
}
}

template <class E> struct EpiAdapt { static constexpr bool PERM = false, AFTER_DRAIN = false; E e;
    __device__ __forceinline__ void operator()(const pg8::f32x4 (&acc)[2][2][4][2], const pg8::Unit& u, int wr, int wc, int fr, int fq) const { e(acc, 0, u.pm, u.pn, wr, wc, fr, fq); } };
template <class Epi>
__device__ __forceinline__ void gemm_stream(LAS unsigned char* lds, const bf16_t* A, const bf16_t* Bt, int N, int K, const Epi& E, int bid, int nb) {
    pg8::Gemm g{A, Bt, MTOK, N, K, K}; pg8::StaticOrder S; S.init(MTOK, N, nb, bid);
    EpiAdapt<Epi> ea{E};
    pg8::gemm_phase<EpiAdapt<Epi>, pg8::StaticOrder, true, true>(lds, g, S, ea);
}

#define EPI_LOOP(...) \
    _Pragma("unroll") for (int ai = 0; ai < 2; ++ai) _Pragma("unroll") for (int m = 0; m < 4; ++m) { asm volatile("" ::: "memory"); const int row = pm * 256 + ai * 128 + wr * 64 + m * 16 + fr; \
    _Pragma("unroll") for (int bj = 0; bj < 2; ++bj) _Pragma("unroll") for (int n = 0; n < 2; ++n) { const int ct = bj * 128 + wc * 32 + n * 16 + fq * 4; const f32x4 v = acc[ai][bj][m][n]; __VA_ARGS__ } }

struct EpiWin {
    bf16_t* UX; bf16_t* QKV;
    __device__ __forceinline__ void operator()(const f32x4 (&acc)[2][2][4][2], int gb, int pm, int pn, int wr, int wc, int fr, int fq) const {
        if (pn < 2) {
            bf16_t* base = UX + ((size_t)(pn * 16 + wc * 2) * 512 + (pm >> 4) * 128 + (pm & 15) * 8 + wr * 2) * 640 + fr * 16 + fq * 4;
#pragma unroll
            for (int ai = 0; ai < 2; ++ai)
#pragma unroll
                for (int m = 0; m < 4; ++m) { bf16_t* rp = base + (ai * 4 + (m >> 1)) * 640 + (m & 1) * 256;
#pragma unroll
                    for (int bj = 0; bj < 2; ++bj)
#pragma unroll
                        for (int n = 0; n < 2; ++n) { const f32x4 v = acc[ai][bj][m][n]; u32x2 w; w.x = pk2(v[0], v[1]); w.y = pk2(v[2], v[3]);
                            *(u32x2*)(rp + (size_t)(bj * 8 + n) * (512 * 640)) = w; }
                    asm volatile("" ::: "memory"); }
        } else { bf16_t* base = QKV + (size_t)((pn - 2) >> 1) * ((size_t)MTOK * 512) + (pn & 1) * 256 + (size_t)(pm * 256 + wr * 64 + fr) * 512 + wc * 32 + fq * 4;
#pragma unroll
            for (int ai = 0; ai < 2; ++ai)
#pragma unroll
                for (int m = 0; m < 4; ++m) { bf16_t* rp = base + (size_t)(ai * 128 + m * 16) * 512;
#pragma unroll
                    for (int bj = 0; bj < 2; ++bj)
#pragma unroll
                        for (int n = 0; n < 2; ++n) { const f32x4 v = acc[ai][bj][m][n]; u32x2 w; w.x = pk2(v[0], v[1]); w.y = pk2(v[2], v[3]);
                            *(u32x2*)(rp + bj * 128 + n * 16) = w; }
                    asm volatile("" ::: "memory"); }
        }
    }
};
struct EpiS5Z {
    float* Z;
    __device__ __forceinline__ void operator()(const f32x4 (&acc)[2][2][4][2], int gb, int pm, int pn, int wr, int wc, int fr, int fq) const {
        EPI_LOOP({ if (bj == 0) *(f32x4*)(Z + ((size_t)gb * 512 + row) * 128 + ct) = v; })
    }
};
struct EpiS5Y {
    const bf16_t* UX; bf16_t* YG; const float* dsk;
    __device__ __forceinline__ void operator()(const f32x4 (&acc)[2][2][4][2], int gb, int pm, int pn, int wr, int wc, int fr, int fq) const {
        EPI_LOOP({ const int col = pn * 256 + ct, t = col >> 4, h = col & 15, bb = row >> 7, cc = row & 127;
            const u32x2 uu = *(const u32x2*)(UX + ((size_t)gb * 512 + row) * 640 + col); const f32x4 dd = *(const f32x4*)(dsk + gb * 16 + h);
            u32x2 w; w.x = pk2(gelu_tanh(v[0] + dd[0] * bflo(uu.x)), gelu_tanh(v[1] + dd[1] * bfhi(uu.x))); w.y = pk2(gelu_tanh(v[2] + dd[2] * bflo(uu.y)), gelu_tanh(v[3] + dd[3] * bfhi(uu.y)));
            *(u32x2*)(YG + ((size_t)bb * SEQ + cc * 32 + t) * 512 + gb * 16 + h) = w; })
    }
};
struct PreS5Y {   static constexpr bool NOP = false;
    const float* Z; bf16_t* UX; const float* lam_re; const float* lam_im; const float* log_dt;
    __device__ __forceinline__ void operator()(int gb, int pm, int pn) const {
        const int tid = threadIdx.x;
        if (tid < 128) { const int pp = tid & 63, bb = 2 * pm + (tid >> 6);
            const float lr = lam_re[gb * 64 + pp], li = lam_im[gb * 64 + pp], dt = expf(log_dt[gb]);
            const float mag = expf(lr * dt * 32.f), ar = mag * cosf(li * dt * 32.f), ai = mag * sinf(li * dt * 32.f);
            const float* zp = Z + ((size_t)gb * 512 + bb * 128) * 128 + pp; bf16_t* xp = UX + ((size_t)gb * 512 + bb * 128) * 640 + 512 + pp;
            float xr = 0.f, xi = 0.f;
            for (int c0 = 0; c0 < 128; c0 += 16) { float zr[16], zi[16];
#pragma unroll
                for (int i = 0; i < 16; ++i) { zr[i] = zp[(size_t)(c0 + i) * 128]; zi[i] = zp[(size_t)(c0 + i) * 128 + 64]; }
#pragma unroll
                for (int i = 0; i < 16; ++i) { xp[(size_t)(c0 + i) * 640] = (bf16_t)f2bf(xr); xp[(size_t)(c0 + i) * 640 + 64] = (bf16_t)f2bf(xi);
                    const float nr = ar * xr - ai * xi + zr[i], ni = ar * xi + ai * xr + zi[i]; xr = nr; xi = ni; } } }
        __threadfence();
        asm volatile("s_waitcnt vmcnt(0)" ::: "memory");
        __syncthreads();
    }
};
struct EpiGlu {
    const bf16_t* YG; bf16_t* CAT;
    __device__ __forceinline__ void operator()(const f32x4 (&acc)[2][2][4][2], int gb, int pm, int pn, int wr, int wc, int fr, int fq) const {
        EPI_LOOP({ const int col = pn * 256 + ct; const u32x2 y = *(const u32x2*)(YG + (size_t)row * 512 + col);
            u32x2 w; w.x = pk2(bflo(y.x) * sigmoidf_(v[0]), bfhi(y.x) * sigmoidf_(v[1])); w.y = pk2(bflo(y.y) * sigmoidf_(v[2]), bfhi(y.y) * sigmoidf_(v[3]));
            *(u32x2*)(CAT + (size_t)row * 1024 + col) = w; })
    }
};
struct EpiRes {
    const float* res; float* out; const float* gate;
    __device__ __forceinline__ void operator()(const f32x4 (&acc)[2][2][4][2], int gb, int pm, int pn, int wr, int wc, int fr, int fq) const {
        const float* gatep = gate + (size_t)(pm >> 4) * 6144;
        EPI_LOOP({ const int col = pn * 256 + ct; const f32x4 g = *(const f32x4*)(gatep + col); const f32x4 r = *(const f32x4*)(res + (size_t)row * 1024 + col);
            *(f32x4*)(out + (size_t)row * 1024 + col) = r + g * v; })
    }
};
struct EpiSwiglu {
    bf16_t* HID;
    __device__ __forceinline__ void operator()(const f32x4 (&acc)[2][2][4][2], int gb, int pm, int pn, int wr, int wc, int fr, int fq) const {
#pragma unroll
        for (int ai = 0; ai < 2; ++ai)
#pragma unroll
            for (int m = 0; m < 4; ++m) { const int row = pm * 256 + ai * 128 + wr * 64 + m * 16 + fr;
#pragma unroll
                for (int n = 0; n < 2; ++n) { const f32x4 g = acc[ai][0][m][n], u = acc[ai][1][m][n]; float o[4];
#pragma unroll
                    for (int j = 0; j < 4; ++j) o[j] = g[j] * sigmoidf_(g[j]) * u[j];
                    u32x2 w; w.x = pk2(o[0], o[1]); w.y = pk2(o[2], o[3]);
                    *(u32x2*)(HID + (size_t)row * FF + pn * 128 + wc * 32 + n * 16 + fq * 4) = w; } }
    }
};
struct EpiRKV {
    bf16_t* RKV; int row0;
    __device__ __forceinline__ void operator()(const f32x4 (&acc)[2][2][4][2], int gb, int pm, int pn, int wr, int wc, int fr, int fq) const {
        bf16_t* base = RKV + (size_t)gb * ((size_t)MTOK * 1024) + (size_t)row0 * 1024 + pn * 256;
        EPI_LOOP({ u32x2 w; w.x = pk2(v[0], v[1]); w.y = pk2(v[2], v[3]); *(u32x2*)(base + (size_t)row * 1024 + ct) = w; })
    }
};
struct EpiL1 {
    bf16_t* L1; int row0;
    __device__ __forceinline__ void operator()(const f32x4 (&acc)[2][2][4][2], int gb, int pm, int pn, int wr, int wc, int fr, int fq) const {
        bf16_t* base = L1 + (size_t)(row0 + pm * 256 + wr * 64 + fr) * 256 + wc * 32 + fq * 4;
        const bool ident = (wc >= 2);
#pragma unroll
        for (int ai = 0; ai < 2; ++ai)
#pragma unroll
            for (int m = 0; m < 4; ++m) { bf16_t* rp = base + (size_t)(ai * 128 + m * 16) * 256;
#pragma unroll
                for (int bj = 0; bj < 2; ++bj) { const float sc = bj ? 1.f : 2.f, of = bj ? 0.f : -1.f;
#pragma unroll
                    for (int n = 0; n < 2; ++n) { const f32x4 v = acc[ai][bj][m][n]; float o[4];
#pragma unroll
                        for (int j = 0; j < 4; ++j) { const float sg = sc * __builtin_amdgcn_rcpf(1.f + __expf(-sc * v[j])) + of; o[j] = (bj == 0 && ident) ? v[j] : sg; }
                        u32x2 w; w.x = pk2(o[0], o[1]); w.y = pk2(o[2], o[3]); *(u32x2*)(rp + bj * 128 + n * 16) = w; } }
                asm volatile("" ::: "memory"); }
    }
};
struct EpiL2 {
    _Float16* DEC; bf16_t* AA; bf16_t* G; const float* w0; const float* a0;
    __device__ __forceinline__ void operator()(const f32x4 (&acc)[2][2][4][2], int gb, int pm, int pn, int wr, int wc, int fr, int fq) const {
        const int sel = pn >> 2, cb = (pn & 3) * 256;
        if (sel == 0) { EPI_LOOP({ const int col = cb + ct; const f32x4 w0v = *(const f32x4*)(w0 + col);
                _Pragma("unroll") for (int j = 0; j < 4; ++j) { const float z = w0v[j] + v[j]; const float sp = fmaxf(-z, 0.f) + __logf(1.f + __expf(-fabsf(z))); const float e = __expf(-sp - 0.5f);
                    const float omd = (e < 0.125f) ? e * (1.f - e * (0.5f - e * (0.16666667f - e * (0.041666668f - e * 0.0083333338f)))) : 1.f - __expf(-e);
                    DEC[(size_t)row * 1024 + col + j] = (_Float16)omd; } }) }
        else if (sel == 1) { EPI_LOOP({ const int col = cb + ct; const f32x4 a0v = *(const f32x4*)(a0 + col);
                u32x2 w; w.x = pk2(sigmoidf_(a0v[0] + v[0]), sigmoidf_(a0v[1] + v[1])); w.y = pk2(sigmoidf_(a0v[2] + v[2]), sigmoidf_(a0v[3] + v[3]));
                *(u32x2*)(AA + (size_t)row * 1024 + col) = w; }) }
        else { EPI_LOOP({ const int col = cb + ct; u32x2 w; w.x = pk2(v[0], v[1]); w.y = pk2(v[2], v[3]); *(u32x2*)(G + (size_t)row * 1024 + col) = w; }) }
    }
};


struct SchedRKV { int vb, vn;
    __device__ bool next(int i, pg8::Unit& u) const { const int t = vb + i * vn; if (vb < 0 || t >= 384) return false; u.pm = t & 31; u.pn = t >> 5; u.ao = (u.pn >> 2) * 2048; return true; }
    __device__ __forceinline__ void a_ready(const pg8::Unit&) const {}
    __device__ __forceinline__ void done(const pg8::Unit&) const {} };
struct SchedOne { int pm;
    __device__ bool next(int i, pg8::Unit& u) const { if (i > 0 || pm < 0) return false; u.pm = pm; u.pn = 0; u.ao = 0; return true; }
    __device__ __forceinline__ void a_ready(const pg8::Unit&) const {}
    __device__ __forceinline__ void done(const pg8::Unit&) const {} };
struct EpiAdaptRKV { static constexpr bool PERM = false, AFTER_DRAIN = false; EpiRKV e;
    __device__ __forceinline__ void operator()(const pg8::f32x4 (&acc)[2][2][4][2], const pg8::Unit& u, int wr, int wc, int fr, int fq) const { e(acc, u.pn >> 2, u.pm, u.pn & 3, wr, wc, fr, fq); } };
__device__ __forceinline__ void s5_gen(const Params& p, bf16_t* BtY, bf16_t* BtZ, float* lds, int bid, int nb) {
    float* PWr = lds; float* PWi = lds + 33 * 64; float* BBr = lds + 66 * 64; float* BBi = BBr + 1024; float* Cr = BBi + 1024; float* Ci = Cr + 1024; float* Kt = Ci + 1024;
    const int tid = threadIdx.x;
    for (int unit = bid; unit < 256; unit += nb) {
        const int g = unit >> 3, part = unit & 7;
        __syncthreads();
        { const float dt = expf(p.in[13][g]);
          for (int e = tid; e < 33 * 64; e += NTHR) { const int tau = e >> 6, pp = e & 63; const float lr = p.in[11][g * 64 + pp], li = p.in[12][g * 64 + pp];
              const float mag = expf(lr * dt * (float)tau), ang = li * dt * (float)tau; PWr[e] = mag * cosf(ang); PWi[e] = mag * sinf(ang); }
          __syncthreads();
          if (tid < 64) { const int pp = tid; const float lr = p.in[11][g * 64 + pp], li = p.in[12][g * 64 + pp];
              const float ar = PWr[64 + pp], ai = PWi[64 + pp], den = lr * lr + li * li, nr = ar - 1.f;
              const float qr = (nr * lr + ai * li) / den, qi = (ai * lr - nr * li) / den;
              for (int h = 0; h < 16; ++h) { const float br = p.in[14][(size_t)(g * 64 + pp) * 16 + h], bi = p.in[15][(size_t)(g * 64 + pp) * 16 + h]; BBr[pp * 16 + h] = qr * br - qi * bi; BBi[pp * 16 + h] = qr * bi + qi * br; } } }
        for (int i = tid; i < 1024; i += NTHR) { Cr[i] = p.in[16][(size_t)g * 1024 + i]; Ci[i] = p.in[17][(size_t)g * 1024 + i]; }
        __syncthreads();
        { const int tau = tid >> 4, h = tid & 15;
          float acc[16];
#pragma unroll
          for (int i = 0; i < 16; ++i) acc[i] = 0.f;
          for (int pp = 0; pp < 64; ++pp) { const float cr = Cr[h * 64 + pp], ci = Ci[h * 64 + pp], wr = PWr[tau * 64 + pp], wi = PWi[tau * 64 + pp];
              const float er = cr * wr - ci * wi, ei = cr * wi + ci * wr;
#pragma unroll
              for (int q = 0; q < 4; ++q) { const f32x4 br = *(const f32x4*)(BBr + pp * 16 + q * 4), bi = *(const f32x4*)(BBi + pp * 16 + q * 4);
#pragma unroll
                  for (int j = 0; j < 4; ++j) acc[q * 4 + j] += er * br[j] - ei * bi[j]; } }
#pragma unroll
          for (int q = 0; q < 4; ++q) *(f32x4*)(Kt + tau * 256 + h * 16 + q * 4) = (f32x4){acc[q * 4], acc[q * 4 + 1], acc[q * 4 + 2], acc[q * 4 + 3]}; }
        __syncthreads();
        for (int ci_ = tid; ci_ < 5120; ci_ += NTHR) { const int nrow = part * 64 + ci_ / 80, kc = (ci_ % 80) * 8, t = nrow >> 4, h = nrow & 15; float v[8];
#pragma unroll
            for (int i = 0; i < 8; ++i) { const int k = kc + i;
                if (k < 512) { const int sidx = k >> 4, h2 = k & 15; v[i] = (sidx <= t) ? Kt[(t - sidx) * 256 + h * 16 + h2] : 0.f; }
                else { const int jj = k - 512, pp = jj & 63; const float cr = Cr[h * 64 + pp], ci = Ci[h * 64 + pp], wr = PWr[(t + 1) * 64 + pp], wi = PWi[(t + 1) * 64 + pp];
                    v[i] = (jj >> 6) ? -(cr * wi + ci * wr) : (cr * wr - ci * wi); } }
            *(u32x4*)(BtY + ((size_t)g * 512 + nrow) * 640 + kc) = (u32x4){pk2(v[0], v[1]), pk2(v[2], v[3]), pk2(v[4], v[5]), pk2(v[6], v[7])}; }
        for (int ci_ = tid; ci_ < 1024; ci_ += NTHR) { const int n = part * 16 + (ci_ >> 6), kc = (ci_ & 63) * 8, pp = n & 63, im = n >> 6; float v[8];
#pragma unroll
            for (int i = 0; i < 8; ++i) { const int k = kc + i, sidx = k >> 4, h2 = k & 15, tau = 31 - sidx; const float wr = PWr[tau * 64 + pp], wi = PWi[tau * 64 + pp], br = BBr[pp * 16 + h2], bi = BBi[pp * 16 + h2];
                v[i] = im ? (wr * bi + wi * br) : (wr * br - wi * bi); }
            *(u32x4*)(BtZ + ((size_t)g * 256 + n) * 512 + kc) = (u32x4){pk2(v[0], v[1]), pk2(v[2], v[3]), pk2(v[4], v[5]), pk2(v[6], v[7])}; }
    }
    __syncthreads();
}

template <int MODE>
__device__ __forceinline__ void tr_job(const float* src, int K, int N, bf16_t* dst, int ldd, int row_off, int koff, const float* scale, float* lds, int bid, int nb, const float* scale2 = nullptr) {
    const int tk = K / 64, tn = N / 64, tid = threadIdx.x, nt_ = tk * tn;
    const int r = tid >> 3, c = (tid & 7) * 8;
    float4 a = {0.f, 0.f, 0.f, 0.f}, b = a; float sc = 1.f;
    if (bid < nt_) { const int k0 = (bid / tn) * 64, n0 = (bid % tn) * 64; const float* p = src + (size_t)(k0 + r) * N + n0 + c; a = *(const float4*)p; b = *(const float4*)(p + 4); sc = scale ? scale[k0 + r] - (scale2 ? scale2[k0 + r] : 0.f) : 1.f; }
    for (int t = bid; t < nt_; t += nb) {
        const int k0 = (t / tn) * 64, n0 = (t % tn) * 64;
        { float* l = lds + r * 65 + c; l[0] = a.x * sc; l[1] = a.y * sc; l[2] = a.z * sc; l[3] = a.w * sc; l[4] = b.x * sc; l[5] = b.y * sc; l[6] = b.z * sc; l[7] = b.w * sc; }
        if (t + nb < nt_) { const int t2 = t + nb, k2 = (t2 / tn) * 64, n2 = (t2 % tn) * 64; const float* p = src + (size_t)(k2 + r) * N + n2 + c; a = *(const float4*)p; b = *(const float4*)(p + 4); sc = scale ? scale[k2 + r] - (scale2 ? scale2[k2 + r] : 0.f) : 1.f; }
        __syncthreads();
        { const int nl = tid >> 3, kc = (tid & 7) * 8; float v[8];
#pragma unroll
          for (int i = 0; i < 8; ++i) v[i] = lds[(kc + i) * 65 + nl];
          int n = n0 + nl; int rowi = n;
          if (MODE == 1) rowi = (n >> 7) * 256 + (n & 127);
          if (MODE == 2) rowi = (n >> 7) * 256 + 128 + (n & 127);
          u32x4 w; w.x = pk2(v[0], v[1]); w.y = pk2(v[2], v[3]); w.z = pk2(v[4], v[5]); w.w = pk2(v[6], v[7]);
          *(u32x4*)(dst + (size_t)(row_off + rowi) * ldd + koff + k0 + kc) = w; }
        __syncthreads();
    }
}

__device__ __forceinline__ void prep_phase(const Params& p, float* lds, int bid, int nb) {
    unsigned char* ws = p.ws;
    s5_gen(p, (bf16_t*)(ws + OFF_BTY), (bf16_t*)(ws + OFF_BTZ), lds, bid, nb);
    tr_job<0>(p.in[10], 1024, 2048, (bf16_t*)(ws + OFF_WIN), 1024, 0, 0, nullptr, lds, bid, nb);
    tr_job<0>(p.in[19], 512, 512, (bf16_t*)(ws + OFF_WGLU), 512, 0, 0, nullptr, lds, bid, nb);
    tr_job<0>(p.in[27], 1024, 1024, (bf16_t*)(ws + OFF_WOUT), 1024, 0, 0, nullptr, lds, bid, nb);
    for (int l = 0; l < 2; ++l) {
        bf16_t* gu = (bf16_t*)(ws + (l ? OFF_WGU1 : OFF_WGU0)); bf16_t* dn = (bf16_t*)(ws + (l ? OFF_WDN1 : OFF_WDN0));
        tr_job<1>(p.in[7] + (size_t)l * 1024 * FF, 1024, FF, gu, 1024, 0, 0, nullptr, lds, bid, nb);
        tr_job<2>(p.in[8] + (size_t)l * 1024 * FF, 1024, FF, gu, 1024, 0, 0, nullptr, lds, bid, nb);
        tr_job<0>(p.in[9] + (size_t)l * FF * 1024, FF, 1024, dn, FF, 0, 0, nullptr, lds, bid, nb);
    }
    bf16_t* wrkv = (bf16_t*)(ws + OFF_WG1); bf16_t* wl1 = (bf16_t*)(ws + OFF_WL1); const float* mu = p.in[28];
    tr_job<0>(p.in[29], 1024, 1024, wrkv, 1024, 0, 0, nullptr, lds, bid, nb);
    tr_job<0>(p.in[30], 1024, 1024, wrkv, 1024, 1024, 0, nullptr, lds, bid, nb);
    tr_job<0>(p.in[31], 1024, 1024, wrkv, 1024, 2048, 0, nullptr, lds, bid, nb);
    tr_job<0>(p.in[34], 1024, 64, wl1, 2048, 0, 0, nullptr, lds, bid, nb);      tr_job<0>(p.in[34], 1024, 64, wl1, 2048, 0, 1024, mu + 1 * 1024, lds, bid, nb, mu + 3 * 1024);
    tr_job<0>(p.in[37], 1024, 64, wl1, 2048, 64, 0, nullptr, lds, bid, nb);     tr_job<0>(p.in[37], 1024, 64, wl1, 2048, 64, 1024, mu + 4 * 1024, lds, bid, nb, mu + 3 * 1024);
    tr_job<0>(p.in[39], 1024, 128, wl1, 2048, 128, 0, nullptr, lds, bid, nb);   tr_job<0>(p.in[39], 1024, 128, wl1, 2048, 128, 1024, mu + 5 * 1024, lds, bid, nb, mu + 3 * 1024);
    bf16_t* l2 = (bf16_t*)(ws + OFF_WL2);
    tr_job<0>(p.in[35], 64, 1024, l2, 256, 0, 0, nullptr, lds, bid, nb);
    tr_job<0>(p.in[38], 64, 1024, l2, 256, 1024, 64, nullptr, lds, bid, nb);
    tr_job<0>(p.in[40], 128, 1024, l2, 256, 2048, 128, nullptr, lds, bid, nb);
    for (int i = bid * NTHR + threadIdx.x; i < 3072 * 32; i += nb * NTHR) { const int n = i >> 5, kc = (i & 31) * 8; const int sel = n >> 10;
        const bool used = (sel == 0) ? (kc < 64) : (sel == 1) ? (kc >= 64 && kc < 128) : (kc >= 128);
        if (!used) *(u32x4*)(l2 + (size_t)n * 256 + kc) = (u32x4){0u, 0u, 0u, 0u}; }
    tr_job<0>(p.in[32], 1024, 1024, (bf16_t*)(ws + OFF_WO), 1024, 0, 0, nullptr, lds, bid, nb);
    {   const float* c = p.in[1]; const float* wada = p.in[3]; const float* bada = p.in[4]; float* mod = (float*)(ws + OFF_MOD);
        float* cact = lds;
        float* red = lds + 4096;
        for (int i = threadIdx.x; i < 4096; i += NTHR) { const float x = c[i]; cact[i] = x / (1.f + expf(-x)); }
        __syncthreads();
        const int col = threadIdx.x & 63, kg = threadIdx.x >> 6;
        for (int ch = bid; ch < 192; ch += nb) {
            const int l = ch / 96, n0 = (ch % 96) * 64;
            const float* wp = wada + (size_t)l * 1024 * 6144 + n0 + col;
            float a0 = 0.f, a1 = 0.f, a2 = 0.f, a3 = 0.f;
            for (int k = kg * 128; k < kg * 128 + 128; ++k) { const float w = wp[(size_t)k * 6144]; a0 += cact[k] * w; a1 += cact[1024 + k] * w; a2 += cact[2048 + k] * w; a3 += cact[3072 + k] * w; }
            red[(kg * 4 + 0) * 64 + col] = a0; red[(kg * 4 + 1) * 64 + col] = a1; red[(kg * 4 + 2) * 64 + col] = a2; red[(kg * 4 + 3) * 64 + col] = a3;
            __syncthreads();
            if (threadIdx.x < 256) { const int b = threadIdx.x >> 6; float s = 0.f;
#pragma unroll
                for (int g = 0; g < 8; ++g) s += red[(g * 4 + b) * 64 + col];
                mod[(size_t)(l * 4 + b) * 6144 + n0 + col] = s + bada[l * 6144 + n0 + col]; }
            __syncthreads();
        }
    }
}

template <bool RW>
__device__ __forceinline__ void norm_phase(const float* x, const float* g, const float* modl, int shift_off, int scale_off, bf16_t* out, int bid, int nb, int row0 = 0, int nrows = MTOK, const float* mu = nullptr) {
    const int wave = threadIdx.x >> 6, lane = threadIdx.x & 63;
    for (int row = row0 + bid * 8 + wave; row < row0 + nrows; row += nb * 8) {
        const int b = row >> 12; const float* xr = x + (size_t)row * 1024; const float* md = modl + (size_t)b * 6144;
        f32x4 v[4], vp[4]; float ss = 0.f, ssp = 0.f; const bool hasp = RW && ((row & 4095) != 0);
#pragma unroll
        for (int i = 0; i < 4; ++i) { v[i] = *(const f32x4*)(xr + i * 256 + lane * 4); ss += v[i][0] * v[i][0] + v[i][1] * v[i][1] + v[i][2] * v[i][2] + v[i][3] * v[i][3];
            if (RW) { vp[i] = hasp ? *(const f32x4*)(xr - 1024 + i * 256 + lane * 4) : (f32x4){0.f, 0.f, 0.f, 0.f}; ssp += vp[i][0] * vp[i][0] + vp[i][1] * vp[i][1] + vp[i][2] * vp[i][2] + vp[i][3] * vp[i][3]; } }
        ss = wave_sum(ss); const float rstd = rsqrtf(ss * (1.f / 1024.f) + 1e-6f);
        float rstdp = 0.f; if (RW) { ssp = wave_sum(ssp); rstdp = rsqrtf(ssp * (1.f / 1024.f) + 1e-6f); }
#pragma unroll
        for (int i = 0; i < 4; ++i) { const int c = i * 256 + lane * 4; const f32x4 gg = *(const f32x4*)(g + c), sc = *(const f32x4*)(md + scale_off + c), sh = *(const f32x4*)(md + shift_off + c);
            f32x4 h;
#pragma unroll
            for (int j = 0; j < 4; ++j) h[j] = v[i][j] * rstd * gg[j] * (1.f + sc[j]) + sh[j];
            if (!RW) { u32x2 w; w.x = pk2(h[0], h[1]); w.y = pk2(h[2], h[3]); *(u32x2*)(out + (size_t)row * 1024 + c) = w; }
            else { f32x4 d;
#pragma unroll
                for (int j = 0; j < 4; ++j) { const float hp = hasp ? (vp[i][j] * rstdp * gg[j] * (1.f + sc[j]) + sh[j]) : 0.f; d[j] = hp - h[j]; }
                const f32x4 mr = *(const f32x4*)(mu + c), mk = *(const f32x4*)(mu + 2048 + c), mv = *(const f32x4*)(mu + 3072 + c);
                const f32x4 xr_ = h + d * mr, xk_ = h + d * mk, xv_ = h + d * mv;
                bf16_t* o = out + (size_t)(row - row0) * 4096 + c;
                u32x2 w; w.x = pk2(xr_[0], xr_[1]); w.y = pk2(xr_[2], xr_[3]); *(u32x2*)(o) = w;
                w.x = pk2(xk_[0], xk_[1]); w.y = pk2(xk_[2], xk_[3]); *(u32x2*)(o + 1024) = w;
                w.x = pk2(xv_[0], xv_[1]); w.y = pk2(xv_[2], xv_[3]); *(u32x2*)(o + 2048) = w;
                w.x = pk2(d[0], d[1]); w.y = pk2(d[2], d[3]); *(u32x2*)(o + 3072) = w; } }
    }
}

__device__ __forceinline__ void qknorm_phase(bf16_t* Q, bf16_t* Kb, const int* pos, const float* qn, const float* kn, int bid, int nb) {
    const int wave = threadIdx.x >> 6, lane = threadIdx.x & 63, l16 = lane & 15, d0 = l16 * 4;
    float invf[4];
#pragma unroll
    for (int j = 0; j < 4; ++j) invf[j] = powf(500000.f, -(float)((l16 & 1) * 4 + j) / 8.f);
    const f32x4 qw = *(const f32x4*)(qn + d0), kw = *(const f32x4*)(kn + d0);
    for (int tok = bid * 8 + wave; tok < MTOK; tok += nb * 8) {
        const float ps = (float)pos[tok];
        float cs[4], sn[4];
#pragma unroll
        for (int j = 0; j < 4; ++j) { const float ang = ps * invf[j]; float rv = ang * 0.15915494309189535f; rv -= floorf(rv); cs[j] = __builtin_amdgcn_cosf(rv); sn[j] = __builtin_amdgcn_sinf(rv); }
#pragma unroll
        for (int bsel = 0; bsel < 2; ++bsel) { bf16_t* buf = bsel ? Kb : Q; const f32x4 w = bsel ? kw : qw;
#pragma unroll
            for (int it = 0; it < 2; ++it) { const int vec = it * 4 + (lane >> 4); bf16_t* ptr = buf + (size_t)tok * 512 + vec * 64 + d0;
                const u32x2 raw = *(const u32x2*)ptr; float y[4] = {bflo(raw.x), bfhi(raw.x), bflo(raw.y), bfhi(raw.y)};
                float ss = y[0] * y[0] + y[1] * y[1] + y[2] * y[2] + y[3] * y[3];
                ss = dpp_sum16(ss);
                const float rstd = rsqrtf(ss * (1.f / 64.f) + 1e-6f);
#pragma unroll
                for (int j = 0; j < 4; ++j) y[j] = y[j] * rstd * w[j];
                float pr[4];
#pragma unroll
                for (int j = 0; j < 4; ++j) pr[j] = __int_as_float(__builtin_amdgcn_update_dpp(0, __float_as_int(y[j]), 0x4E, 0xf, 0xf, true));
                if (l16 < 2) {
#pragma unroll
                    for (int j = 0; j < 4; ++j) y[j] = y[j] * cs[j] - pr[j] * sn[j]; }
                else if (l16 < 4) {
#pragma unroll
                    for (int j = 0; j < 4; ++j) y[j] = y[j] * cs[j] + pr[j] * sn[j]; }
                if (!bsel) {
#pragma unroll
                    for (int j = 0; j < 4; ++j) y[j] *= 0.125f * 1.4426950408889634f; }
                u32x2 o; o.x = pk2(y[0], y[1]); o.y = pk2(y[2], y[3]); *(u32x2*)ptr = o; } }
    }
}

__device__ __forceinline__ void vtrans_phase(const bf16_t* V, bf16_t* Vt, bf16_t* lds, int bid, int nb) {
    const int tid = threadIdx.x;
    for (int unit = bid; unit < 1024; unit += nb) {
        const int head = unit & 3, ch = unit >> 2; const int b = ch >> 6, t0 = (ch & 63) * 64;
#pragma unroll
        for (int i = 0; i < 2; ++i) { const int idx = tid + i * 512, t = idx >> 4, cc = (idx & 15) * 8;
            const u32x4 w = *(const u32x4*)(V + ((size_t)b * SEQ + t0 + t) * 512 + head * 128 + cc);
            unsigned* d = (unsigned*)(lds + t * 130 + cc); d[0] = w.x; d[1] = w.y; d[2] = w.z; d[3] = w.w; }
        __syncthreads();
        { const int e = tid >> 2, tc = (tid & 3) * 16; unsigned o[8];
#pragma unroll
          for (int i = 0; i < 8; ++i) o[i] = (unsigned)lds[(tc + 2 * i) * 130 + e] | ((unsigned)lds[(tc + 2 * i + 1) * 130 + e] << 16);
          u32x4* dst = (u32x4*)(Vt + ((size_t)(b * 4 + head) * 128 + e) * SEQ + t0 + tc);
          dst[0] = (u32x4){o[0], o[1], o[2], o[3]}; dst[1] = (u32x4){o[4], o[5], o[6], o[7]}; }
        __syncthreads();
    }
}

typedef float f32x16 __attribute__((ext_vector_type(16)));
__device__ __forceinline__ void attn_phase(const bf16_t* Q, const bf16_t* Kb, const bf16_t* Vt, bf16_t* OC, LAS unsigned char* lds, int bid, int nb) {
    const int tid = threadIdx.x, wave = __builtin_amdgcn_readfirstlane(tid >> 6), lane = tid & 63, c = wave >> 2, wq = wave & 3, l32 = lane & 31, hh = lane >> 5;
    constexpr int KROW = 272, VROW = 144, KBUF = 64 * KROW, VBUF = 128 * VROW, VOFF = 2 * KBUF;
    const int lkey = tid >> 4, lkc = tid & 15, lve = tid >> 3, lvc = tid & 7;
    for (int unit = bid; unit < 256; unit += nb) {
        const int b = unit & 3, head = (unit >> 2) & 3, pr = unit >> 4;
        const bf16_t* kg = Kb + ((size_t)b * SEQ + lkey) * 512 + head * 128 + lkc * 8;
        const bf16_t* vg = Vt + ((size_t)(b * 4 + head) * 128 + lve) * SEQ + lvc * 8;
        for (int half = 0; half < 2; ++half) {
            const int qb = half ? (31 - pr) : pr; const int q0 = qb * 128 + wq * 32; const int nst = (qb + 1) * 2;
            bf16x8 qf[4];
            { const bf16_t* qp = Q + ((size_t)b * SEQ + q0 + l32) * 512 + head * 128 + c * 64 + hh * 8;
#pragma unroll
              for (int ks = 0; ks < 4; ++ks) qf[ks] = *(const bf16x8*)(qp + ks * 16); }
            f32x16 o[4];
#pragma unroll
            for (int blk = 0; blk < 4; ++blk)
#pragma unroll
                for (int r = 0; r < 16; ++r) o[blk][r] = 0.f;
            float mrow = -INFINITY, lsum = 0.f;
            u32x4 kreg[2][2], vreg[2][2];
#define AT_ISSUE(set, st) do { const int st_ = ((st) < nst) ? (st) : nst - 1; kreg[set][0] = *(const u32x4*)(kg + (size_t)(st_ * 64) * 512); kreg[set][1] = *(const u32x4*)(kg + (size_t)(st_ * 64 + 32) * 512); \
                               vreg[set][0] = *(const u32x4*)(vg + st_ * 64); vreg[set][1] = *(const u32x4*)(vg + (size_t)64 * SEQ + st_ * 64); } while (0)
#define AT_WRITE(set, slot) do { *(LAS u32x4*)(lds + (slot) * KBUF + lkey * KROW + lkc * 16) = kreg[set][0]; *(LAS u32x4*)(lds + (slot) * KBUF + (lkey + 32) * KROW + lkc * 16) = kreg[set][1]; \
                                 LAS u32x2* vd0 = (LAS u32x2*)(lds + VOFF + (slot) * VBUF + lve * VROW + (lvc >> 1) * 32 + (lvc & 1) * 8); vd0[0] = (u32x2){vreg[set][0].x, vreg[set][0].y}; vd0[2] = (u32x2){vreg[set][0].z, vreg[set][0].w}; \
                                 LAS u32x2* vd1 = (LAS u32x2*)(lds + VOFF + (slot) * VBUF + (lve + 64) * VROW + (lvc >> 1) * 32 + (lvc & 1) * 8); vd1[0] = (u32x2){vreg[set][1].x, vreg[set][1].y}; vd1[2] = (u32x2){vreg[set][1].z, vreg[set][1].w}; } while (0)
#define AT_PACK(dst, sv, base) do { u32x4 pw_; pw_.x = cvt_pk_bf16(sv[(base) + 0], sv[(base) + 1]); pw_.y = cvt_pk_bf16(sv[(base) + 2], sv[(base) + 3]); pw_.z = cvt_pk_bf16(sv[(base) + 4], sv[(base) + 5]); pw_.w = cvt_pk_bf16(sv[(base) + 6], sv[(base) + 7]); dst = __builtin_bit_cast(bf16x8, pw_); } while (0)
#define AT_COMPUTE(slot, st) do { const int key0 = (st) * 64; \
                if (key0 <= q0 + 31) { \
                    LAS unsigned char* kb = lds + (slot) * KBUF + l32 * KROW + c * 128 + hh * 16; \
                    LAS unsigned char* vb = lds + VOFF + (slot) * VBUF + l32 * VROW + hh * 16; \
                    bf16x8 kfa[4], kfb[4], vfa[4], vfb[4]; \
                    f32x16 s0, s1; _Pragma("unroll") for (int r = 0; r < 16; ++r) { s0[r] = 0.f; s1[r] = 0.f; } \
                    kfa[0] = *(const LAS bf16x8*)(kb); kfa[1] = *(const LAS bf16x8*)(kb + 32 * KROW); kfa[2] = *(const LAS bf16x8*)(kb + 32); kfa[3] = *(const LAS bf16x8*)(kb + 32 * KROW + 32); \
                    kfb[0] = *(const LAS bf16x8*)(kb + 64); kfb[1] = *(const LAS bf16x8*)(kb + 32 * KROW + 64); kfb[2] = *(const LAS bf16x8*)(kb + 96); kfb[3] = *(const LAS bf16x8*)(kb + 32 * KROW + 96); \
                    __builtin_amdgcn_sched_barrier(0); \
                    s0 = __builtin_amdgcn_mfma_f32_32x32x16_bf16(kfa[0], qf[0], s0, 0, 0, 0); s1 = __builtin_amdgcn_mfma_f32_32x32x16_bf16(kfa[1], qf[0], s1, 0, 0, 0); \
                    s0 = __builtin_amdgcn_mfma_f32_32x32x16_bf16(kfa[2], qf[1], s0, 0, 0, 0); s1 = __builtin_amdgcn_mfma_f32_32x32x16_bf16(kfa[3], qf[1], s1, 0, 0, 0); \
                    s0 = __builtin_amdgcn_mfma_f32_32x32x16_bf16(kfb[0], qf[2], s0, 0, 0, 0); s1 = __builtin_amdgcn_mfma_f32_32x32x16_bf16(kfb[1], qf[2], s1, 0, 0, 0); \
                    s0 = __builtin_amdgcn_mfma_f32_32x32x16_bf16(kfb[2], qf[3], s0, 0, 0, 0); s1 = __builtin_amdgcn_mfma_f32_32x32x16_bf16(kfb[3], qf[3], s1, 0, 0, 0); \
                    _Pragma("unroll") for (int blk = 0; blk < 4; ++blk) vfa[blk] = *(const LAS bf16x8*)(vb + blk * 32 * VROW); \
                    _Pragma("unroll") for (int blk = 0; blk < 4; ++blk) vfb[blk] = *(const LAS bf16x8*)(vb + blk * 32 * VROW + 32); \
                    __builtin_amdgcn_sched_barrier(0); \
                    if (key0 + 63 > q0) { const int qrel = q0 + l32 - key0; \
                        _Pragma("unroll") for (int r = 0; r < 16; ++r) { const int kl = (r & 3) + 8 * (r >> 2) + 4 * hh; if (kl > qrel) s0[r] = -INFINITY; if (kl + 32 > qrel) s1[r] = -INFINITY; } } \
                    float tm = fmaxf(s0[0], s1[0]); _Pragma("unroll") for (int r = 1; r < 16; ++r) tm = fmaxf(tm, fmaxf(s0[r], s1[r])); \
                    tm = fmaxf(tm, __shfl_xor(tm, 32)); \
                    const float mnew = fmaxf(mrow, tm); \
                    if (__any(mnew > mrow + 6.f)) { const float al = __builtin_amdgcn_exp2f(mrow - mnew); lsum *= al; \
                        _Pragma("unroll") for (int blk = 0; blk < 4; ++blk) _Pragma("unroll") for (int r = 0; r < 16; ++r) o[blk][r] *= al; \
                        mrow = mnew; } \
                    float ps = 0.f; _Pragma("unroll") for (int r = 0; r < 16; ++r) { s0[r] = __builtin_amdgcn_exp2f(s0[r] - mrow); s1[r] = __builtin_amdgcn_exp2f(s1[r] - mrow); ps += s0[r] + s1[r]; } \
                    lsum += ps; \
                    bf16x8 pb0, pb1, pb2, pb3; AT_PACK(pb0, s0, 0); AT_PACK(pb1, s0, 8); AT_PACK(pb2, s1, 0); AT_PACK(pb3, s1, 8); \
                    __builtin_amdgcn_sched_barrier(0); \
                    _Pragma("unroll") for (int blk = 0; blk < 4; ++blk) o[blk] = __builtin_amdgcn_mfma_f32_32x32x16_bf16(vfa[blk], pb0, o[blk], 0, 0, 0); \
                    _Pragma("unroll") for (int blk = 0; blk < 4; ++blk) o[blk] = __builtin_amdgcn_mfma_f32_32x32x16_bf16(vfb[blk], pb1, o[blk], 0, 0, 0); \
                    __builtin_amdgcn_sched_barrier(0); \
                    _Pragma("unroll") for (int blk = 0; blk < 4; ++blk) kfa[blk] = *(const LAS bf16x8*)(vb + blk * 32 * VROW + 64); \
                    _Pragma("unroll") for (int blk = 0; blk < 4; ++blk) kfb[blk] = *(const LAS bf16x8*)(vb + blk * 32 * VROW + 96); \
                    __builtin_amdgcn_sched_barrier(0); \
                    _Pragma("unroll") for (int blk = 0; blk < 4; ++blk) o[blk] = __builtin_amdgcn_mfma_f32_32x32x16_bf16(kfa[blk], pb2, o[blk], 0, 0, 0); \
                    _Pragma("unroll") for (int blk = 0; blk < 4; ++blk) o[blk] = __builtin_amdgcn_mfma_f32_32x32x16_bf16(kfb[blk], pb3, o[blk], 0, 0, 0); \
                } } while (0)
            AT_ISSUE(0, 0); AT_ISSUE(1, 1);
            __syncthreads();
            AT_WRITE(0, 0);
            __syncthreads();
            for (int st = 0; st < nst; st += 2) {
                AT_ISSUE(0, st + 2);
                AT_COMPUTE(0, st);
                AT_WRITE(1, 1);
                __syncthreads();
                AT_ISSUE(1, st + 3);
                AT_COMPUTE(1, st + 1);
                AT_WRITE(0, 0);
                __syncthreads();
            }
            lsum += __shfl_xor(lsum, 32);
            const float inv = 1.f / lsum;
            bf16_t* op = OC + ((size_t)b * SEQ + q0 + l32) * 1024 + (head * 2 + c) * 128 + 4 * hh;
#pragma unroll
            for (int blk = 0; blk < 4; ++blk)
#pragma unroll
                for (int g4 = 0; g4 < 4; ++g4) { u32x2 w; w.x = pk2(o[blk][g4 * 4 + 0] * inv, o[blk][g4 * 4 + 1] * inv); w.y = pk2(o[blk][g4 * 4 + 2] * inv, o[blk][g4 * 4 + 3] * inv);
                    *(u32x2*)(op + blk * 32 + g4 * 8) = w; }
        }
    }
}

__device__ __forceinline__ void attn_combine(const bf16_t* OC, bf16_t* CAT, const Params& p, int bid, int nb) {
    const int wave = threadIdx.x >> 6, lane = threadIdx.x & 63, head = lane >> 4, e0 = (lane & 15) * 8;
    float lam;
    { float s1 = 0.f, s2 = 0.f; for (int d = 0; d < 64; ++d) { s1 += p.in[22][d] * p.in[23][d]; s2 += p.in[24][d] * p.in[25][d]; } lam = expf(s1) - expf(s2) + 0.2f; }
    float sub[8];
#pragma unroll
    for (int i = 0; i < 8; ++i) sub[i] = p.in[26][e0 + i] * 0.8f;
    for (int tok = bid * 8 + wave; tok < MTOK; tok += nb * 8) {
        const u32x4 a = *(const u32x4*)(OC + (size_t)tok * 1024 + (head * 2) * 128 + e0), bb = *(const u32x4*)(OC + (size_t)tok * 1024 + (head * 2 + 1) * 128 + e0);
        float o[8] = {bflo(a.x) - lam * bflo(bb.x), bfhi(a.x) - lam * bfhi(bb.x), bflo(a.y) - lam * bflo(bb.y), bfhi(a.y) - lam * bfhi(bb.y),
                      bflo(a.z) - lam * bflo(bb.z), bfhi(a.z) - lam * bfhi(bb.z), bflo(a.w) - lam * bflo(bb.w), bfhi(a.w) - lam * bfhi(bb.w)};
        float ss = 0.f;
#pragma unroll
        for (int i = 0; i < 8; ++i) ss += o[i] * o[i];
        ss = dpp_sum16(ss);
        const float rstd = rsqrtf(ss * (1.f / 128.f) + 1e-6f);
        u32x4 w; w.x = pk2(o[0] * rstd * sub[0], o[1] * rstd * sub[1]); w.y = pk2(o[2] * rstd * sub[2], o[3] * rstd * sub[3]); w.z = pk2(o[4] * rstd * sub[4], o[5] * rstd * sub[5]); w.w = pk2(o[6] * rstd * sub[6], o[7] * rstd * sub[7]);
        *(u32x4*)(CAT + (size_t)tok * 1024 + 512 + head * 128 + e0) = w;
    }
}

typedef float f32x2 __attribute__((ext_vector_type(2)));
__device__ __forceinline__ float h2f_(unsigned bits) { return (float)__builtin_bit_cast(_Float16, (unsigned short)bits); }
__device__ __forceinline__ void rwkv_phase(const Params& p, const bf16_t* R, const bf16_t* Kk, const bf16_t* Vv, const _Float16* DEC, const bf16_t* AA, bf16_t* Y, float* lds, int bid, int nb) {
    const int tid = threadIdx.x, wave = __builtin_amdgcn_readfirstlane(tid >> 6), lane = tid & 63;
    constexpr int TCH = 16, BUFF = 5 * TCH * 64 + TCH * 16;
    constexpr int OBUF = TCH * 16 * 16;
    float* Lout = lds + 2 * BUFF;
    for (int unit = bid; unit < 256; unit += nb) {
        const int b = unit >> 6, h = (unit >> 2) & 15, rq = unit & 3;
        __syncthreads();
        if (wave >= 4) {
            const int pw = wave - 4, tl = lane >> 4, c4 = (lane & 15) * 4;
            const f32x4 kkw = *(const f32x4*)(p.in[41] + h * 64 + c4), kaw = *(const f32x4*)(p.in[42] + h * 64 + c4);
            u32x2 rr[4], kr[4], ar[4], dr[4], vr[4];
            const unsigned lofs = (unsigned)((pw * 4 + tl) * 1024 + h * 64 + c4), vofs = (unsigned)((pw * 4 + tl) * 1024 + h * 64 + rq * 16 + (lane & 3) * 4);
            const bf16_t* Rb = R + (size_t)b * SEQ * 1024; const bf16_t* Kb_ = Kk + (size_t)b * SEQ * 1024; const bf16_t* Vb = Vv + (size_t)b * SEQ * 1024;
            const bf16_t* Ab = AA + (size_t)b * SEQ * 1024; const _Float16* Db = DEC + (size_t)b * SEQ * 1024;
#define RW_ISSUE(set, ch) do { const unsigned o_ = (unsigned)(ch) * (TCH * 1024) + lofs; rr[set] = *(const u32x2*)(Rb + o_); kr[set] = *(const u32x2*)(Kb_ + o_); dr[set] = *(const u32x2*)(Db + o_); ar[set] = *(const u32x2*)(Ab + o_); \
                    vr[set] = *(const u32x2*)(Vb + (unsigned)(ch) * (TCH * 1024) + vofs); } while (0)
#define RW_STAGE(set, buf) do { float* L = lds + (buf) * BUFF + (pw * 4 + tl) * 64 + c4; \
                    const f32x4 k = {bflo(kr[set].x), bfhi(kr[set].x), bflo(kr[set].y), bfhi(kr[set].y)}, a = {bflo(ar[set].x), bfhi(ar[set].x), bflo(ar[set].y), bfhi(ar[set].y)}; \
                    const f32x4 r = {bflo(rr[set].x), bfhi(rr[set].x), bflo(rr[set].y), bfhi(rr[set].y)}; \
                    const f32x4 w = {1.f - h2f_(dr[set].x & 0xffffu), 1.f - h2f_(dr[set].x >> 16), 1.f - h2f_(dr[set].y & 0xffffu), 1.f - h2f_(dr[set].y >> 16)}; \
                    f32x4 kk = k * kkw; const float n2 = dpp_sum16((kk[0] * kk[0] + kk[1] * kk[1]) + (kk[2] * kk[2] + kk[3] * kk[3])); kk = kk * __frsqrt_rn(fmaxf(n2, 1e-24f)); \
                    *(f32x4*)(L) = w; *(f32x4*)(L + 1 * TCH * 64) = -kk; *(f32x4*)(L + 2 * TCH * 64) = kk * a; *(f32x4*)(L + 3 * TCH * 64) = k * (1.f + (a - 1.f) * kaw); *(f32x4*)(L + 4 * TCH * 64) = r; \
                    if ((lane & 15) < 4) *(f32x4*)(lds + (buf) * BUFF + 5 * TCH * 64 + (pw * 4 + tl) * 16 + (lane & 3) * 4) = (f32x4){bflo(vr[set].x), bfhi(vr[set].x), bflo(vr[set].y), bfhi(vr[set].y)}; } while (0)
            auto flush = [&](int ch) { const int i = tid - 256, tt = i >> 4, row = i & 15; const f32x4* pp = (const f32x4*)(Lout + (ch & 1) * OBUF + i * 16);
                const f32x4 s4 = pp[0] + pp[1] + pp[2] + pp[3];
                Y[((size_t)b * SEQ + ch * TCH + tt) * 1024 + h * 64 + rq * 16 + row] = (bf16_t)f2bf((s4[0] + s4[1]) + (s4[2] + s4[3])); };
            constexpr int NCH = SEQ / TCH;
            RW_ISSUE(0, 0); RW_ISSUE(1, 1); RW_ISSUE(2, 2); RW_ISSUE(3, 3);
            RW_STAGE(0, 0);
            __syncthreads();
            for (int c4_ = 0; c4_ < NCH; c4_ += 4) {
#define RW_ITER(q) do { const int ch = c4_ + (q); RW_STAGE(((q) + 1) & 3, (ch + 1) & 1); { const int chn = (ch + 4 < NCH) ? ch + 4 : NCH - 1; RW_ISSUE((q), chn); } flush(ch > 0 ? ch - 1 : 0); __syncthreads(); } while (0)
                RW_ITER(0); RW_ITER(1); RW_ITER(2); RW_ITER(3);
            }
            flush(NCH - 1);
        } else {
            const int j = lane & 15, rowl = wave * 4 + (lane >> 4);
            f32x2 S01 = {0.f, 0.f}, S23 = {0.f, 0.f};
            __syncthreads();
            for (int ch = 0; ch < SEQ / TCH; ++ch) {
                const float* L = lds + (ch & 1) * BUFF + j * 4; const float* Lv = lds + (ch & 1) * BUFF + 5 * TCH * 64 + rowl; float* Lo = Lout + (ch & 1) * OBUF + rowl * 16 + j;
                f32x4 w4 = *(const f32x4*)(L), a4 = *(const f32x4*)(L + 1 * TCH * 64), b4 = *(const f32x4*)(L + 2 * TCH * 64), k4 = *(const f32x4*)(L + 3 * TCH * 64), r4 = *(const f32x4*)(L + 4 * TCH * 64);
                float vv = Lv[0];
#pragma unroll
                for (int tt = 0; tt < TCH; ++tt) {
                    f32x4 nw4 = w4, na4 = a4, nb4 = b4, nk4 = k4, nr4 = r4; float nvv = vv;
                    if (tt + 1 < TCH) { const float* Ln = L + (tt + 1) * 64; nw4 = *(const f32x4*)(Ln); na4 = *(const f32x4*)(Ln + 1 * TCH * 64); nb4 = *(const f32x4*)(Ln + 2 * TCH * 64); nk4 = *(const f32x4*)(Ln + 3 * TCH * 64); nr4 = *(const f32x4*)(Ln + 4 * TCH * 64); nvv = Lv[(tt + 1) * 16]; }
                    f32x2 d = S01 * (f32x2){a4[0], a4[1]}; d = S23 * (f32x2){a4[2], a4[3]} + d;
                    const float sa = dpp_sum16(d[0] + d[1]);
                    const f32x2 sa2 = {sa, sa}, v2 = {vv, vv};
                    const f32x2 t01 = sa2 * (f32x2){b4[0], b4[1]} + v2 * (f32x2){k4[0], k4[1]}, t23 = sa2 * (f32x2){b4[2], b4[3]} + v2 * (f32x2){k4[2], k4[3]};
                    S01 = S01 * (f32x2){w4[0], w4[1]} + t01; S23 = S23 * (f32x2){w4[2], w4[3]} + t23;
                    f32x2 y = S01 * (f32x2){r4[0], r4[1]}; y = S23 * (f32x2){r4[2], r4[3]} + y;
                    Lo[tt * 256] = y[0] + y[1];
                    w4 = nw4; a4 = na4; b4 = nb4; k4 = nk4; r4 = nr4; vv = nvv;
                }
                __syncthreads();
            }
        }
    }
}

__device__ __forceinline__ void rwkv_post(const Params& p, bf16_t* R, const bf16_t* Kk, const bf16_t* Vv, const bf16_t* AA, const bf16_t* G, const bf16_t* Y, int bid, int nb) {
    const int wave = threadIdx.x >> 6, lane = threadIdx.x & 63;
    for (int it = bid * 8 + wave; it < MTOK * 16; it += nb * 8) {
        const int h = it & 15; const size_t off = (size_t)(it >> 4) * 1024 + h * 64 + lane;
        const float y = bf2f(Y[off]), r = bf2f(R[off]), k = bf2f(Kk[off]), v = bf2f(Vv[off]), a = bf2f(AA[off]), g = bf2f(G[off]);
        const float mean = wave_sum(y) * (1.f / 64.f); const float d = y - mean; const float var = wave_sum(d * d) * (1.f / 64.f);
        const float k2 = k * (1.f + (a - 1.f) * p.in[42][h * 64 + lane]);
        const float sb = wave_sum(r * k2 * p.in[43][h * 64 + lane]);
        const float yn = d * rsqrtf(var + 64e-5f) * p.in[44][h * 64 + lane] + p.in[45][h * 64 + lane] + sb * v;
        R[off] = (bf16_t)f2bf(yn * g);
    }
}

#define XB_TMO      128
#define XB_XCNT(j)  (256  + 64 * (j))
#define XB_XSUB(j)  (1280 + 64 * (j))
#define XB_XGEN(j)  (2304 + 64 * (j))
#define XB_TOP      3328
#define XB_TOPGEN   3392
#define XCD_BAR_WORDS 3456
#define XB_SPIN_CAP (1u << 18)
__device__ __forceinline__ unsigned xb_ld(unsigned* p)              { return __hip_atomic_load(p, __ATOMIC_RELAXED, __HIP_MEMORY_SCOPE_AGENT); }
__device__ __forceinline__ unsigned xb_add(unsigned* p, unsigned v) { return __hip_atomic_fetch_add(p, v, __ATOMIC_RELAXED, __HIP_MEMORY_SCOPE_AGENT); }
__device__ __forceinline__ unsigned xb_xcc_id() { return (unsigned)__builtin_amdgcn_s_getreg((3 << 11) | 20) & 0xFu; }
#define XB_SPIN(cond, bar) do { unsigned _sp = 0; while (cond) { __builtin_amdgcn_s_sleep(1); \
    if ((++_sp & 255u) == 0u) { if (xb_ld(&(bar)[XB_TMO])) break; if (_sp > XB_SPIN_CAP) { atomicAdd(&(bar)[XB_TMO], 1u); break; } } } } while (0)
struct XcdBarrier { unsigned* bar; unsigned x; volatile LAS unsigned* st; };
__device__ __forceinline__ XcdBarrier xcd_barrier_post(unsigned* bar, volatile LAS unsigned* st) {
    XcdBarrier b; b.bar = bar; b.x = xb_xcc_id(); b.st = st;
    if (threadIdx.x == 0) (void)xb_add(&bar[XB_XCNT(b.x)], 1u);
    return b;
}
__device__ __forceinline__ void xcd_barrier_complete(unsigned* bar, unsigned x, unsigned& nloc, unsigned& nx) {
    const unsigned G = gridDim.x * gridDim.y * gridDim.z;
    unsigned sum, cnt, mine, sp = 0u;
    for (;;) {
        sum = 0u; cnt = 0u; mine = 0u;
#pragma unroll
        for (unsigned j = 0; j < 16; ++j) { const unsigned c = xb_ld(&bar[XB_XCNT(j)]); sum += c; cnt += (c > 0u) ? 1u : 0u; mine = (j == x) ? c : mine; }
        if (sum == G) break;
        __builtin_amdgcn_s_sleep(1);
        if ((++sp & 255u) == 0u) { if (xb_ld(&bar[XB_TMO])) break; if (sp > XB_SPIN_CAP) { atomicAdd(&bar[XB_TMO], 1u); break; } }
    }
    nloc = mine > 0u ? mine : 1u; nx = cnt > 0u ? cnt : 1u;
}
__device__ __forceinline__ void xcd_barrier(const XcdBarrier& b) {
    asm volatile("s_waitcnt vmcnt(0)" ::: "memory");
    __syncthreads();
    if (threadIdx.x == 0) {
        unsigned* bar = b.bar;
        __builtin_amdgcn_s_waitcnt(0);
        unsigned nloc = b.st[0], nx = b.st[1];
        if (nloc == 0u) { xcd_barrier_complete(bar, b.x, nloc, nx); b.st[0] = nloc; b.st[1] = nx; }
        const unsigned old = xb_add(&bar[XB_XSUB(b.x)], 1u);
        const unsigned gen = old / nloc;
        if (old + 1u == (gen + 1u) * nloc) {
            __builtin_amdgcn_fence(__ATOMIC_RELEASE, "agent");
            asm volatile("s_waitcnt vmcnt(0)" ::: "memory");
            const unsigned og = xb_add(&bar[XB_TOP], 1u);
            const unsigned tg = og / nx;
            if (og + 1u == (tg + 1u) * nx) xb_add(&bar[XB_TOPGEN], 1u);
            else XB_SPIN(xb_ld(&bar[XB_TOPGEN]) == tg, bar);
            __builtin_amdgcn_fence(__ATOMIC_ACQUIRE, "agent");
            xb_add(&bar[XB_XGEN(b.x)], 1u);
            asm volatile("s_waitcnt vmcnt(0)" ::: "memory");
        } else {
            XB_SPIN(xb_ld(&bar[XB_XGEN(b.x)]) == gen, bar);
            __builtin_amdgcn_fence(__ATOMIC_ACQUIRE, "agent");
            asm volatile("s_waitcnt vmcnt(0)" ::: "memory");
        }
    }
    __syncthreads();
}

__global__ void __launch_bounds__(NTHR) fwd_kernel(Params p) {
    extern __shared__ __attribute__((aligned(16))) unsigned char lds_raw[];
    LAS unsigned char* lds = (LAS unsigned char*)lds_raw;
    float* ldsf = (float*)lds_raw;
    const int bid = blockIdx.x, nb = gridDim.x;
    unsigned char* ws = p.ws;
    float* mod = (float*)(ws + OFF_MOD);
    const bool multi = (p.ph_hi - p.ph_lo) > 1;
    __shared__ unsigned xb_st[4];
    if (threadIdx.x < 4) xb_st[threadIdx.x] = 0u;
    __syncthreads();
    XcdBarrier xbar; xbar.bar = (unsigned*)(ws + OFF_BAR); xbar.x = 0; xbar.st = (volatile LAS unsigned*)xb_st;
    if (multi) xbar = xcd_barrier_post((unsigned*)(ws + OFF_BAR), (volatile LAS unsigned*)xb_st);
#ifndef TESTPH
#define TESTPH -1
#endif
#ifndef REPEAT_A
#define REPEAT_A -1
#endif
#ifndef REPEAT_B
#define REPEAT_B -1
#endif
#ifndef EXTRA_SYNCS
#define EXTRA_SYNCS 0
#endif
#define PH(k) if ((TESTPH < 0 || TESTPH == (k)) && p.ph_lo <= (k) && (k) < p.ph_hi) for (int rep_ = 0; rep_ < (((k) == REPEAT_A || (k) == REPEAT_B) ? 2 : 1); ++rep_)
#define SYNC(k) if (multi) { xcd_barrier(xbar); }
    for (int es_ = 0; es_ < EXTRA_SYNCS; ++es_) cg::this_grid().sync();
    if (p.ph_lo < -1000) cg::this_grid().sync();
    PH(0) { prep_phase(p, ldsf, bid, nb); SYNC(0) }
    PH(1) { norm_phase<false>(p.in[0], p.in[5], mod, 0, 1024, (bf16_t*)(ws + OFF_HA), bid, nb); SYNC(1) }
    PH(2) { EpiWin e{(bf16_t*)(ws + OFF_UX), (bf16_t*)(ws + OFF_QKV)}; gemm_stream(lds, (const bf16_t*)(ws + OFF_HA), (const bf16_t*)(ws + OFF_WIN), 2048, 1024, e, bid, nb); SYNC(2) }
    PH(3) { { EpiS5Z e{(float*)(ws + OFF_Z)}; gemm_batched(lds, (const bf16_t*)(ws + OFF_UX), 640, (size_t)512 * 640, (const bf16_t*)(ws + OFF_BTZ), (size_t)256 * 512, 2, 1, 32, 512, e, NoPre{}, bid, nb); }
            bf16_t* q = (bf16_t*)(ws + OFF_QKV); qknorm_phase(q, q + (size_t)MTOK * 512, (const int*)p.in[2], p.in[20], p.in[21], bid, nb);
            vtrans_phase(q + (size_t)MTOK * 1024, (bf16_t*)(ws + OFF_VT), (bf16_t*)lds_raw, bid, nb); SYNC(3) }
    PH(5) { { EpiS5Y e{(const bf16_t*)(ws + OFF_UX), (bf16_t*)(ws + OFF_YG), p.in[18]}; PreS5Y pre{(const float*)(ws + OFF_Z), (bf16_t*)(ws + OFF_UX), p.in[11], p.in[12], p.in[13]};
              gemm_batched(lds, (const bf16_t*)(ws + OFF_UX), 640, (size_t)512 * 640, (const bf16_t*)(ws + OFF_BTY), (size_t)512 * 640, 2, 2, 32, 640, e, pre, bid, nb); }
            bf16_t* q = (bf16_t*)(ws + OFF_QKV); attn_phase(q, q + (size_t)MTOK * 512, (const bf16_t*)(ws + OFF_VT), (bf16_t*)(ws + OFF_OC), lds, bid, nb); SYNC(5) }
    PH(6) { attn_combine((const bf16_t*)(ws + OFF_OC), (bf16_t*)(ws + OFF_CAT), p, bid, nb);
            EpiGlu e{(const bf16_t*)(ws + OFF_YG), (bf16_t*)(ws + OFF_CAT)}; gemm_phase(lds, (const bf16_t*)(ws + OFF_YG), (const bf16_t*)(ws + OFF_WGLU), 512, 512, e, bid, nb); SYNC(6) }
    PH(7) { EpiRes e{p.in[0], p.out, mod + 2048}; gemm_stream(lds, (const bf16_t*)(ws + OFF_CAT), (const bf16_t*)(ws + OFF_WOUT), 1024, 1024, e, bid, nb); SYNC(7) }
    PH(8) { norm_phase<false>(p.out, p.in[6], mod, 3072, 4096, (bf16_t*)(ws + OFF_HA), bid, nb); SYNC(8) }
    PH(9) { EpiSwiglu e{(bf16_t*)(ws + OFF_HID)}; gemm_stream(lds, (const bf16_t*)(ws + OFF_HA), (const bf16_t*)(ws + OFF_WGU0), 5632, 1024, e, bid, nb); SYNC(9) }
    PH(10) { EpiRes e{p.out, p.out, mod + 5120}; gemm_stream(lds, (const bf16_t*)(ws + OFF_HID), (const bf16_t*)(ws + OFF_WDN0), 1024, FF, e, bid, nb); SYNC(10) }
    const float* mod1 = mod + 4 * 6144;
#define RWKV_FRONT(PA, PB, ROW0) \
    PH(PA) { norm_phase<true>(p.out, p.in[5] + 1024, mod1, 0, 1024, (bf16_t*)(ws + OFF_HD), bid, nb, (ROW0), 8192, p.in[28]); SYNC(PA) } \
    PH(PB) { const bf16_t* xall = (const bf16_t*)(ws + OFF_HD); const bool split = (nb == 256); \
               \
             { pg8::Gemm g{xall + 2048, (const bf16_t*)(ws + OFF_WL1), 8192, 256, 2048, 4096}; SchedOne S{(bid < 32) ? bid : -1}; EpiAdapt<EpiL1> ea{EpiL1{(bf16_t*)(ws + OFF_L1), (ROW0)}}; \
               pg8::gemm_phase<EpiAdapt<EpiL1>, SchedOne, false, true>(lds, g, S, ea); } \
             { pg8::Gemm g{xall, (const bf16_t*)(ws + OFF_WG1), 8192, 3072, 1024, 4096}; SchedRKV S{split ? bid - 32 : bid, split ? 224 : nb}; EpiAdaptRKV ea{EpiRKV{(bf16_t*)(ws + OFF_RKV), (ROW0)}}; \
               pg8::gemm_phase<EpiAdaptRKV, SchedRKV, true, true>(lds, g, S, ea); } \
             SYNC(PB) }
    RWKV_FRONT(11, 12, 0)
    RWKV_FRONT(20, 21, 8192)
    PH(13) { EpiL2 e{(_Float16*)(ws + OFF_DEC), (bf16_t*)(ws + OFF_AA), (bf16_t*)(ws + OFF_G), p.in[33], p.in[36]}; gemm_phase(lds, (const bf16_t*)(ws + OFF_L1), (const bf16_t*)(ws + OFF_WL2), 3072, 256, e, bid, nb); SYNC(13) }
    PH(14) { const bf16_t* r = (const bf16_t*)(ws + OFF_RKV); rwkv_phase(p, r, r + (size_t)MTOK * 1024, r + (size_t)MTOK * 2048, (const _Float16*)(ws + OFF_DEC), (const bf16_t*)(ws + OFF_AA), (bf16_t*)(ws + OFF_Y), ldsf, bid, nb); SYNC(14) }
    PH(15) { bf16_t* r = (bf16_t*)(ws + OFF_RKV); rwkv_post(p, r, r + (size_t)MTOK * 1024, r + (size_t)MTOK * 2048, (const bf16_t*)(ws + OFF_AA), (const bf16_t*)(ws + OFF_G), (const bf16_t*)(ws + OFF_Y), bid, nb); SYNC(15) }
    PH(16) { EpiRes e{p.out, p.out, mod1 + 2048}; gemm_stream(lds, (const bf16_t*)(ws + OFF_RKV), (const bf16_t*)(ws + OFF_WO), 1024, 1024, e, bid, nb); SYNC(16) }
    PH(17) { norm_phase<false>(p.out, p.in[6] + 1024, mod1, 3072, 4096, (bf16_t*)(ws + OFF_HA), bid, nb); SYNC(17) }
    PH(18) { EpiSwiglu e{(bf16_t*)(ws + OFF_HID)}; gemm_stream(lds, (const bf16_t*)(ws + OFF_HA), (const bf16_t*)(ws + OFF_WGU1), 5632, 1024, e, bid, nb); SYNC(18) }
    PH(19) { EpiRes e{p.out, p.out, mod1 + 5120}; gemm_stream(lds, (const bf16_t*)(ws + OFF_HID), (const bf16_t*)(ws + OFF_WDN1), 1024, FF, e, bid, nb); }
}

constexpr int NPHASE = 22;
#ifndef ONE_LAUNCH
#define ONE_LAUNCH 1
#endif

extern "C" void kernel_launch(void* const* d_in, const int* in_sizes, int n_in, void* d_out, int out_size, void* d_ws, size_t ws_size, hipStream_t stream) {
    static int grid = 0;
    if (grid == 0) {
        if (n_in != 46 || ws_size < WS_NEED) { fprintf(stderr, "kernel_launch: unexpected n_in %d / ws_size %zu (need %zu)\n", n_in, ws_size, (size_t)WS_NEED); grid = -1; return; }
        if (hipFuncSetAttribute((const void*)fwd_kernel, hipFuncAttributeMaxDynamicSharedMemorySize, LDS_BYTES) != hipSuccess) { fprintf(stderr, "hipFuncSetAttribute failed\n"); grid = -1; return; }
        int dev = 0, cus = 0, per_cu = 0;
        (void)hipGetDevice(&dev); (void)hipDeviceGetAttribute(&cus, hipDeviceAttributeMultiprocessorCount, dev);
        (void)hipOccupancyMaxActiveBlocksPerMultiprocessor(&per_cu, (const void*)fwd_kernel, NTHR, LDS_BYTES);
        if (per_cu < 1) per_cu = 1;
        grid = cus;
    }
    if (grid < 0) return;
    Params p{};
    for (int i = 0; i < 46; ++i) p.in[i] = (const float*)d_in[i];
    p.out = (float*)d_out; p.ws = (unsigned char*)d_ws;
#if ONE_LAUNCH
    p.ph_lo = 0; p.ph_hi = NPHASE;
    if (hipMemsetAsync((char*)d_ws + OFF_BAR, 0, XCD_BAR_WORDS * 4, stream) != hipSuccess) { fprintf(stderr, "memset failed\n"); return; }
    void* args[] = {&p};
    hipError_t e = hipLaunchCooperativeKernel((const void*)fwd_kernel, dim3(grid), dim3(NTHR), args, LDS_BYTES, stream);
    if (e != hipSuccess) fprintf(stderr, "cooperative launch failed: %s (grid %d)\n", hipGetErrorString(e), grid);
#else
    for (int ph = 0; ph < NPHASE; ++ph) { p.ph_lo = ph; p.ph_hi = ph + 1; hipLaunchKernelGGL(fwd_kernel, dim3(grid), dim3(NTHR), LDS_BYTES, stream, p); }
#endif
}
```

```cpp
#include <hip/hip_runtime.h>
#include <hip/hip_cooperative_groups.h>
#include <cstdio>
#include <cstdint>
namespace cg = cooperative_groups;

#define LAS __attribute__((address_space(3)))
typedef unsigned short bf16_t;
typedef short bf16x8 __attribute__((ext_vector_type(8)));
typedef float f32x4 __attribute__((ext_vector_type(4)));
typedef unsigned u32x2 __attribute__((ext_vector_type(2)));
typedef unsigned u32x4 __attribute__((ext_vector_type(4)));

constexpr int MTOK = 16384, DM = 1024, SEQ = 4096, FF = 2816;
constexpr int NTHR = 512;
constexpr int LDS_BYTES = 131072;
constexpr size_t MiB = 1048576;
constexpr size_t OFF_WIN = 0;
constexpr size_t OFF_WGLU = 4194304;
constexpr size_t OFF_WOUT = 4718592;
constexpr size_t OFF_WGU0 = 6815744;
constexpr size_t OFF_WDN0 = 18350080;
constexpr size_t OFF_WGU1 = 39321600;
constexpr size_t OFF_WDN1 = 50855936;
constexpr size_t OFF_WG1 = 24117248;
constexpr size_t OFF_WL1 = 24117248 + 6291456;
constexpr size_t OFF_WL2 = 37748736;
constexpr size_t OFF_WO = 56623104;
constexpr size_t OFF_MOD = 58720256;
constexpr size_t OFF_BAR = 58916864;
constexpr size_t ACT = 57 * MiB;
constexpr size_t OFF_HA = ACT;
constexpr size_t OFF_UX = ACT + 32 * MiB;
constexpr size_t OFF_Z = ACT + 52 * MiB;
constexpr size_t OFF_BTZ = ACT + 112 * MiB;
constexpr size_t OFF_BTY = ACT + 176 * MiB;
constexpr size_t OFF_QKV = ACT + 64 * MiB;
constexpr size_t OFF_CAT = ACT + 112 * MiB;
constexpr size_t OFF_YG = ACT + 144 * MiB;
constexpr size_t OFF_VT = ACT + 160 * MiB;
constexpr size_t OFF_OC = ACT;
constexpr size_t OFF_HID = ACT + 32 * MiB;
constexpr size_t OFF_HD = ACT;
constexpr size_t OFF_RKV = ACT + 64 * MiB;
constexpr size_t OFF_G = ACT + 160 * MiB;
constexpr size_t OFF_Y = 0;
constexpr size_t OFF_L1 = 0;
constexpr size_t OFF_DEC = ACT;
constexpr size_t OFF_AA = ACT + 32 * MiB;
constexpr size_t WS_NEED = ACT + 196 * MiB;

struct Params {
    const float* in[46];
    float* out;
    unsigned char* ws;
    int ph_lo, ph_hi;
};

__device__ __forceinline__ unsigned f2bf(float f) { unsigned u = __float_as_uint(f); return (u + 0x7fffu + ((u >> 16) & 1u)) >> 16; }
__device__ __forceinline__ float bf2f(unsigned h) { return __uint_as_float(h << 16); }
__device__ __forceinline__ unsigned cvt_pk_bf16(float lo, float hi) { unsigned r; asm("v_cvt_pk_bf16_f32 %0, %1, %2" : "=v"(r) : "v"(lo), "v"(hi)); return r; }
__device__ __forceinline__ unsigned pk2(float lo, float hi) { return cvt_pk_bf16(lo, hi); }
__device__ __forceinline__ float bflo(unsigned w) { return __uint_as_float(w << 16); }
__device__ __forceinline__ float bfhi(unsigned w) { return __uint_as_float(w & 0xffff0000u); }
__device__ __forceinline__ float dpp_sum16(float x) {
    x += __int_as_float(__builtin_amdgcn_update_dpp(0, __float_as_int(x), 0xB1, 0xf, 0xf, true));
    x += __int_as_float(__builtin_amdgcn_update_dpp(0, __float_as_int(x), 0x4E, 0xf, 0xf, true));
    x += __int_as_float(__builtin_amdgcn_update_dpp(0, __float_as_int(x), 0x141, 0xf, 0xf, true));
    x += __int_as_float(__builtin_amdgcn_update_dpp(0, __float_as_int(x), 0x140, 0xf, 0xf, true));
    return x;
}
__device__ __forceinline__ float wave_sum(float v) {
    v = dpp_sum16(v);
    const float s0 = __int_as_float(__builtin_amdgcn_readlane(__float_as_int(v), 0)), s1 = __int_as_float(__builtin_amdgcn_readlane(__float_as_int(v), 16));
    const float s2 = __int_as_float(__builtin_amdgcn_readlane(__float_as_int(v), 32)), s3 = __int_as_float(__builtin_amdgcn_readlane(__float_as_int(v), 48));
    return (s0 + s1) + (s2 + s3);
}
__device__ __forceinline__ float sigmoidf_(float x) { return __fdividef(1.f, 1.f + __expf(-x)); }
__device__ __forceinline__ float tanh_fast(float x) { const float t = __expf(2.f * fminf(fmaxf(x, -15.f), 15.f)); return __fdividef(t - 1.f, t + 1.f); }
#define LWAIT() asm volatile("s_waitcnt lgkmcnt(0)" ::: "memory")
__device__ __forceinline__ float gelu_tanh(float x) { const float u = 0.7978845608028654f * (x + 0.044715f * x * x * x); const float t = __expf(2.f * fminf(fmaxf(u, -15.f), 15.f)); return __fdividef(x * t, t + 1.f); }

constexpr int HTB = 128 * 64 * 2;
__device__ __forceinline__ int lds_byte(int r, int c) { int st = (r >> 4) * 2 + (c >> 5), rr = r & 15, cc = c & 31, ob = rr * 64 + cc * 2; return st * 1024 + (ob ^ (((ob >> 9) & 1) << 5)); }
__device__ __forceinline__ void stage_rc(int b, int& R, int& C) { int st = b / 1024, sb = b % 1024, swz = sb ^ (((sb >> 9) & 1) << 5); R = (st >> 1) * 16 + swz / 64; C = (st & 1) * 32 + (swz % 64) / 2; }

struct NoPre { static constexpr bool NOP = true; __device__ __forceinline__ void operator()(int, int, int) const {} };
template <class Epi, class Pre, bool PF = true>
__device__ __forceinline__ void gemm_batched(LAS unsigned char* lds, const bf16_t* A, int lda, size_t strideA, const bf16_t* Bt, size_t strideB, int nMt, int nNt, int nbatch, int K, const Epi& E, const Pre& PRE, int bid, int nb) {
    const int tid = threadIdx.x, wid = __builtin_amdgcn_readfirstlane(tid >> 6), lane = tid & 63, wr = wid >> 2, wc = wid & 3, fr = lane & 15, fq = lane >> 4;
    unsigned voffA[2], voffB[2];
#pragma unroll
    for (int i = 0; i < 2; ++i) { int R, C; stage_rc(tid * 16 + i * 8192, R, C); voffA[i] = (unsigned)(R * lda + C) * 2u; voffB[i] = (unsigned)(R * K + C) * 2u; }
    const int aoff = lds_byte(wr * 64 + fr, fq * 8), boff = lds_byte(wc * 32 + fr, fq * 8);
    const unsigned ldsw = (unsigned)wid * 1024u;
    const size_t kstep = 128, hstepA = (size_t)128 * lda * 2, hstepB = (size_t)128 * K * 2;
    const int nt = K / 64;
    const int ntiles = nMt * nNt * nbatch;
#define G_SA(b, h) (((b) * 2 + (h)) * HTB)
#define G_SB(b, h) ((4 + (b) * 2 + (h)) * HTB)
#define G_STAGEX(bufoff, gptr, vo) do { _Pragma("unroll") for (int _i = 0; _i < 2; ++_i) \
        __builtin_amdgcn_global_load_lds((const unsigned*)((gptr) + vo[_i]), (LAS unsigned*)(lds + (bufoff) + ldsw + _i * 8192), 16, 0, 0); } while (0)
#define G_STA(bufoff, gptr) G_STAGEX(bufoff, gptr, voffA)
#define G_STB(bufoff, gptr) G_STAGEX(bufoff, gptr, voffB)
#define G_LDA(dst, b, h) do { _Pragma("unroll") for (int m = 0; m < 4; ++m) _Pragma("unroll") for (int k = 0; k < 2; ++k) dst[m][k] = *(const LAS bf16x8*)(lds + G_SA(b, h) + aoff + m * 2048 + k * 1024); } while (0)
#define G_LDB(dst, b, h) do { _Pragma("unroll") for (int n = 0; n < 2; ++n) _Pragma("unroll") for (int k = 0; k < 2; ++k) dst[n][k] = *(const LAS bf16x8*)(lds + G_SB(b, h) + boff + n * 2048 + k * 1024); } while (0)
#define G_MMA(ai, bj, At, Bx) do { __builtin_amdgcn_s_setprio(1); _Pragma("unroll") for (int m = 0; m < 4; ++m) _Pragma("unroll") for (int n = 0; n < 2; ++n) _Pragma("unroll") for (int k = 0; k < 2; ++k) \
        acc[ai][bj][m][n] = __builtin_amdgcn_mfma_f32_16x16x32_bf16(Bx[n][k], At[m][k], acc[ai][bj][m][n], 0, 0, 0); __builtin_amdgcn_s_setprio(0); } while (0)
#define G_WV(n) asm volatile("s_waitcnt vmcnt(" #n ")" ::: "memory")
#define G_WL(n) asm volatile("s_waitcnt lgkmcnt(" #n ")" ::: "memory")
#define G_BAR __builtin_amdgcn_s_barrier()
#define G_SCHED __builtin_amdgcn_sched_barrier(0)
    bool prefetched = false;
    for (int tile = bid; tile < ntiles; tile += nb) {
        const int pm = tile % nMt, tq = tile / nMt, pn = tq % nNt, gb = tq / nNt;
        PRE(gb, pm, pn);
        const char* cA = (const char*)(A + (size_t)gb * strideA) + (size_t)pm * 256 * lda * 2;
        const char* cB = (const char*)(Bt + (size_t)gb * strideB) + (size_t)pn * 256 * K * 2;
        f32x4 acc[2][2][4][2];
#pragma unroll
        for (int a = 0; a < 2; ++a)
#pragma unroll
            for (int b = 0; b < 2; ++b)
#pragma unroll
                for (int m = 0; m < 4; ++m)
#pragma unroll
                    for (int n = 0; n < 2; ++n) acc[a][b][m][n] = (f32x4){0.f, 0.f, 0.f, 0.f};
        bf16x8 At[4][2], B0[2][2], B1[2][2];
        if (!prefetched) { G_WV(0); G_STB(G_SB(0, 0), cB); G_STA(G_SA(0, 0), cA); G_STB(G_SB(0, 1), cB + hstepB); G_STA(G_SA(0, 1), cA + hstepA); }
        if (wr == 1) G_BAR;
        if (prefetched) G_WV(0); else G_WV(4);
        G_BAR;
        G_STB(G_SB(1, 0), cB + kstep); G_STA(G_SA(1, 0), cA + kstep); G_STB(G_SB(1, 1), cB + hstepB + kstep);
        G_WV(6); G_BAR;
        for (int t = 0; t < nt - 2; t += 2) {
            const char* a1 = cA + (size_t)(t + 1) * kstep; const char* a2 = cA + (size_t)(t + 2) * kstep; const char* a3 = a2 + kstep;
            const char* b2 = cB + (size_t)(t + 2) * kstep; const char* b3 = b2 + kstep;
            G_LDB(B0, 0, 0); G_SCHED; G_LDA(At, 0, 0); G_STA(G_SA(1, 1), a1 + hstepA);
            G_WL(8); G_BAR; G_WL(0); G_MMA(0, 0, At, B0); G_BAR; G_SCHED;
            G_LDB(B1, 0, 1); G_STB(G_SB(0, 0), b2);
            G_BAR; G_WL(0); G_MMA(0, 1, At, B1); G_BAR;
            G_LDA(At, 0, 1); G_STA(G_SA(0, 0), a2);
            G_BAR; G_WL(0); G_MMA(1, 0, At, B0); G_BAR; G_SCHED;
            G_STB(G_SB(0, 1), b2 + hstepB);
            G_WV(6); G_BAR; G_MMA(1, 1, At, B1); G_BAR;
            G_LDB(B0, 1, 0); G_SCHED; G_LDA(At, 1, 0); G_STA(G_SA(0, 1), a2 + hstepA);
            G_WL(8); G_BAR; G_WL(0); G_MMA(0, 0, At, B0); G_BAR; G_SCHED;
            G_LDB(B1, 1, 1); G_STB(G_SB(1, 0), b3);
            G_BAR; G_WL(0); G_MMA(0, 1, At, B1); G_BAR;
            G_LDA(At, 1, 1); G_STA(G_SA(1, 0), a3);
            G_BAR; G_WL(0); G_MMA(1, 0, At, B0); G_BAR; G_SCHED;
            G_STB(G_SB(1, 1), b3 + hstepB);
            G_WV(6); G_BAR; G_MMA(1, 1, At, B1); G_BAR;
        }
        {
            const char* a1 = cA + (size_t)(nt - 1) * kstep;
            G_LDB(B0, 0, 0); G_LDA(At, 0, 0); G_STA(G_SA(1, 1), a1 + hstepA);
            G_BAR; G_WL(0); G_MMA(0, 0, At, B0); G_BAR;
            G_LDB(B1, 0, 1); G_BAR; G_WL(0); G_MMA(0, 1, At, B1); G_BAR;
            G_LDA(At, 0, 1); G_WV(4); G_BAR; G_WL(0); G_MMA(1, 0, At, B0); G_MMA(1, 1, At, B1); G_BAR;
        }
        {
            G_LDB(B0, 1, 0); G_LDA(At, 1, 0); G_WV(2); G_BAR; G_WL(0); G_MMA(0, 0, At, B0); G_BAR;
            G_LDB(B1, 1, 1); G_WV(0); G_BAR; G_WL(0); G_MMA(0, 1, At, B1); G_BAR;
            G_LDA(At, 1, 1); G_BAR; G_WL(0); G_MMA(1, 0, At, B0); G_MMA(1, 1, At, B1); G_BAR;
        }
        if (wr == 0) G_BAR;
        prefetched = false;
        if (PF && Pre::NOP && tile + nb < ntiles) {
            const int t2 = tile + nb, pm2 = t2 % nMt, tq2 = t2 / nMt, pn2 = tq2 % nNt, gb2 = tq2 / nNt;
            const char* nA = (const char*)(A + (size_t)gb2 * strideA) + (size_t)pm2 * 256 * lda * 2;
            const char* nB = (const char*)(Bt + (size_t)gb2 * strideB) + (size_t)pn2 * 256 * K * 2;
            G_STB(G_SB(0, 0), nB); G_STA(G_SA(0, 0), nA); G_STB(G_SB(0, 1), nB + hstepB); G_STA(G_SA(0, 1), nA + hstepA);
            prefetched = true; }
        E(acc, gb, pm, pn, wr, wc, fr, fq);
    }
    G_WV(0);
    __syncthreads();
}

template <class Epi>
__device__ __forceinline__ void gemm_phase(LAS unsigned char* lds, const bf16_t* A, const bf16_t* Bt, int N, int K, const Epi& E, int bid, int nb) {
    gemm_batched(lds, A, K, 0, Bt, 0, 64, N / 256, 1, K, E, NoPre{}, bid, nb);
}

namespace pg8 {
#define PG8_LAS __attribute__((address_space(3)))
typedef unsigned short bf16_t;
typedef short bf16x8 __attribute__((ext_vector_type(8)));
typedef float f32x4 __attribute__((ext_vector_type(4)));
typedef unsigned u32x4 __attribute__((ext_vector_type(4)));
constexpr int BM = 256, BK = 64, HALF = 128, HTB = HALF * BK * 2  , STAGE_BYTES = 8 * HTB, NXCD = 8, WGM = 8;

__host__ __device__ __forceinline__ int lds_byte(int r, int c) { const int st = (r >> 4) * 2 + (c >> 5), rr = r & 15, cc = c & 31, ob = rr * 64 + cc * 2; return st * 1024 + (ob ^ (((ob >> 9) & 1) << 5)); }
__host__ __device__ __forceinline__ void stage_rc(int b, int& R, int& C) { const int st = b / 1024, sb = b % 1024, swz = sb ^ (((sb >> 9) & 1) << 5); R = (st >> 1) * 16 + swz / 64; C = (st & 1) * 32 + (swz % 64) / 2; }
__host__ __device__ __forceinline__ int perm32(int rho) { const int n = rho >> 4, i = rho & 15; return 8 * (i >> 2) + 4 * n + (i & 3); }

struct Unit { int pm, pn; int ao = 0; };
struct Gemm { const bf16_t* A; const bf16_t* Bt; int M, N, K; int lda; };

struct StaticOrder {
    int nM, nN, nwg, G, c;
    __host__ __device__ void init(int M, int N, int G_, int c_) { nM = M / BM; nN = N / BM; nwg = nM * nN; G = G_; c = c_; }
    __host__ __device__ bool next(int i, Unit& u) const {
        const long L = (long)i * G + c; if (L >= nwg) return false;
        int wgid = (int)L; { const int q = nwg / NXCD, r = nwg % NXCD, xcd = wgid % NXCD, off = wgid / NXCD; wgid = (xcd < r ? xcd * (q + 1) : r * (q + 1) + (xcd - r) * q) + off; }
        const int nig = WGM * nN, gid = wgid / nig, fm = gid * WGM, gsz = (nM - fm) < WGM ? (nM - fm) : WGM;
        u.pm = fm + ((wgid % nig) % gsz); u.pn = (wgid % nig) / gsz; return true;
    }
    __device__ __forceinline__ void a_ready(const Unit&) const {}
    __device__ __forceinline__ void done(const Unit&) const {}
};
template <class Epi, class Sched, bool ALIGN_EPI = false, bool SP2 = false>
__device__ __forceinline__ void gemm_phase(PG8_LAS unsigned char* lds, const Gemm g, const Sched& S, const Epi& E) {
    const int tid = threadIdx.x, wid = __builtin_amdgcn_readfirstlane(tid >> 6), lane = tid & 63, wr = wid >> 2, wc = wid & 3, fr = lane & 15, fq = lane >> 4;
    const int K = g.K, nt = K / BK;
    unsigned voffA[2], voffB[2];
#pragma unroll
    for (int i = 0; i < 2; ++i) { int R, C; stage_rc(tid * 16 + i * 8192, R, C); const int Rb = Epi::PERM ? ((R & ~31) + perm32(R & 31)) : R;
        voffA[i] = (unsigned)(R * g.lda + C) * 2u; voffB[i] = (unsigned)(Rb * K + C) * 2u; }
    const size_t kstep = (size_t)(BK * 2);
    const size_t hstep = (size_t)HALF * K * 2;
    const size_t tstep = 2 * hstep;
    const size_t hstepA = (size_t)HALF * g.lda * 2, tstepA = 2 * hstepA;
    const unsigned ldsw = (unsigned)wid * 1024u;
    const int aoff = lds_byte(wr * 64 + fr, fq * 8), boff = lds_byte(wc * 32 + fr, fq * 8);
#define PG8_SA(b, h) (((b) * 2 + (h)) * HTB)
#define PG8_SB(b, h) ((4 + (b) * 2 + (h)) * HTB)
#define PG8_STAGE(bufoff, gbase, voff) do { _Pragma("unroll") for (int _i = 0; _i < 2; ++_i) \
        __builtin_amdgcn_global_load_lds((const unsigned*)((const char*)(gbase) + (voff)[_i]), (PG8_LAS unsigned*)(lds + (bufoff) + ldsw + _i * 8192), 16, 0, 0); } while (0)
#define PG8_LDA(dst, b, h) do { _Pragma("unroll") for (int m = 0; m < 4; ++m) _Pragma("unroll") for (int k = 0; k < 2; ++k) dst[m][k] = *(const PG8_LAS bf16x8*)(lds + PG8_SA(b, h) + aoff + m * 2048 + k * 1024); } while (0)
#define PG8_LDB(dst, b, h) do { _Pragma("unroll") for (int n = 0; n < 2; ++n) _Pragma("unroll") for (int k = 0; k < 2; ++k) dst[n][k] = *(const PG8_LAS bf16x8*)(lds + PG8_SB(b, h) + boff + n * 2048 + k * 1024); } while (0)
#define PG8_MMA(ai, bj, At, Bt) do { __builtin_amdgcn_s_setprio(1); _Pragma("unroll") for (int m = 0; m < 4; ++m) _Pragma("unroll") for (int n = 0; n < 2; ++n) _Pragma("unroll") for (int k = 0; k < 2; ++k) \
        acc[ai][bj][m][n] = __builtin_amdgcn_mfma_f32_16x16x32_bf16(Bt[n][k], At[m][k], acc[ai][bj][m][n], 0, 0, 0); __builtin_amdgcn_s_setprio(0); } while (0)
#define PG8_WAIT_V(n) asm volatile("s_waitcnt vmcnt(" #n ")" ::: "memory")
#define PG8_WAIT_L(n) asm volatile("s_waitcnt lgkmcnt(" #n ")" ::: "memory")
#define PG8_BAR __builtin_amdgcn_s_barrier()
#define PG8_SCHED __builtin_amdgcn_sched_barrier(0)
    Unit cur, nxt; int ui = 0;
    if (!S.next(0, cur)) return;
    f32x4 acc[2][2][4][2];
#pragma unroll
    for (int a = 0; a < 2; ++a)
#pragma unroll
        for (int b = 0; b < 2; ++b)
#pragma unroll
            for (int m = 0; m < 4; ++m)
#pragma unroll
                for (int n = 0; n < 2; ++n) acc[a][b][m][n] = (f32x4){0.f, 0.f, 0.f, 0.f};
    bf16x8 At[4][2], B0[2][2], B1[2][2];
    const char* cA = (const char*)g.A + (size_t)cur.pm * tstepA + cur.ao; const char* cB = (const char*)g.Bt + (size_t)cur.pn * tstep;
    S.a_ready(cur);
    if constexpr (SP2) {
        PG8_STAGE(PG8_SB(0, 0), cB, voffB); PG8_STAGE(PG8_SB(0, 1), cB + hstep, voffB); PG8_STAGE(PG8_SA(0, 0), cA, voffA); PG8_STAGE(PG8_SA(0, 1), cA + hstepA, voffA);
        if (wr == 1) PG8_BAR;
        PG8_WAIT_V(2); PG8_BAR;
        PG8_STAGE(PG8_SB(1, 0), cB + kstep, voffB); PG8_STAGE(PG8_SA(1, 0), cA + kstep, voffA); PG8_STAGE(PG8_SB(1, 1), cB + hstep + kstep, voffB);
        PG8_WAIT_V(6); PG8_BAR;
    } else {
        PG8_STAGE(PG8_SB(0, 0), cB, voffB); PG8_STAGE(PG8_SA(0, 0), cA, voffA); PG8_STAGE(PG8_SB(0, 1), cB + hstep, voffB); PG8_STAGE(PG8_SA(0, 1), cA + hstepA, voffA);
        if (wr == 1) PG8_BAR;
        PG8_WAIT_V(4); PG8_BAR;
        PG8_STAGE(PG8_SB(1, 0), cB + kstep, voffB); PG8_STAGE(PG8_SA(1, 0), cA + kstep, voffA); PG8_STAGE(PG8_SB(1, 1), cB + hstep + kstep, voffB);
        PG8_WAIT_V(6); PG8_BAR;
    }
    for (;;) {
        const bool has_next = S.next(ui + 1, nxt);
        const char* nA = has_next ? (const char*)g.A + (size_t)nxt.pm * tstepA + nxt.ao : cA; const char* nB = has_next ? (const char*)g.Bt + (size_t)nxt.pn * tstep : cB;
        for (int t = 0; t < nt; t += 2) {
            const bool last = (t == nt - 2);
            const char* a1 = cA + (size_t)(t + 1) * kstep;
            const char* a2 = last ? nA : cA + (size_t)(t + 2) * kstep; const char* b2 = last ? nB : cB + (size_t)(t + 2) * kstep;
            const char* a3 = a2 + kstep; const char* b3 = b2 + kstep;
            if (last && has_next) S.a_ready(nxt);
            if constexpr (SP2) {
            PG8_LDB(B0, 0, 0); PG8_LDB(B1, 0, 1); PG8_SCHED; PG8_LDA(At, 0, 0); PG8_STAGE(PG8_SA(1, 1), a1 + hstepA, voffA);
            PG8_WAIT_V(8); PG8_WAIT_L(0); PG8_BAR; PG8_MMA(0, 0, At, B0); PG8_MMA(0, 1, At, B1); PG8_BAR; PG8_SCHED;
            PG8_LDA(At, 0, 1); PG8_STAGE(PG8_SB(0, 0), b2, voffB); PG8_STAGE(PG8_SB(0, 1), b2 + hstep, voffB); PG8_STAGE(PG8_SA(0, 0), a2, voffA);
            PG8_WAIT_V(8); PG8_WAIT_L(0); PG8_BAR; PG8_MMA(1, 0, At, B0); PG8_MMA(1, 1, At, B1); PG8_BAR; PG8_SCHED;
            PG8_LDB(B0, 1, 0); PG8_LDB(B1, 1, 1); PG8_SCHED; PG8_LDA(At, 1, 0); PG8_STAGE(PG8_SA(0, 1), a2 + hstepA, voffA);
            PG8_WAIT_V(8); PG8_WAIT_L(0); PG8_BAR; PG8_MMA(0, 0, At, B0); PG8_MMA(0, 1, At, B1); PG8_BAR; PG8_SCHED;
            PG8_LDA(At, 1, 1); PG8_STAGE(PG8_SB(1, 0), b3, voffB); PG8_STAGE(PG8_SB(1, 1), b3 + hstep, voffB); PG8_STAGE(PG8_SA(1, 0), a3, voffA);
            PG8_WAIT_V(8); PG8_WAIT_L(0); PG8_BAR; PG8_MMA(1, 0, At, B0); PG8_MMA(1, 1, At, B1); PG8_BAR; PG8_SCHED;
            } else {
            PG8_LDB(B0, 0, 0); PG8_SCHED; PG8_LDA(At, 0, 0); PG8_STAGE(PG8_SA(1, 1), a1 + hstepA, voffA);
            PG8_WAIT_L(8); PG8_BAR; PG8_WAIT_L(0); PG8_MMA(0, 0, At, B0); PG8_BAR; PG8_SCHED;
            PG8_LDB(B1, 0, 1); PG8_STAGE(PG8_SB(0, 0), b2, voffB);
            PG8_BAR; PG8_WAIT_L(0); PG8_MMA(0, 1, At, B1); PG8_BAR;
            PG8_LDA(At, 0, 1); PG8_STAGE(PG8_SA(0, 0), a2, voffA);
            PG8_BAR; PG8_WAIT_L(0); PG8_MMA(1, 0, At, B0); PG8_BAR; PG8_SCHED;
            PG8_STAGE(PG8_SB(0, 1), b2 + hstep, voffB);
            PG8_WAIT_V(6); PG8_BAR; PG8_MMA(1, 1, At, B1); PG8_BAR;
            PG8_LDB(B0, 1, 0); PG8_SCHED; PG8_LDA(At, 1, 0); PG8_STAGE(PG8_SA(0, 1), a2 + hstepA, voffA);
            PG8_WAIT_L(8); PG8_BAR; PG8_WAIT_L(0); PG8_MMA(0, 0, At, B0); PG8_BAR; PG8_SCHED;
            PG8_LDB(B1, 1, 1); PG8_STAGE(PG8_SB(1, 0), b3, voffB);
            PG8_BAR; PG8_WAIT_L(0); PG8_MMA(0, 1, At, B1); PG8_BAR;
            PG8_LDA(At, 1, 1); PG8_STAGE(PG8_SA(1, 0), a3, voffA);
            PG8_BAR; PG8_WAIT_L(0); PG8_MMA(1, 0, At, B0); PG8_BAR; PG8_SCHED;
            PG8_STAGE(PG8_SB(1, 1), b3 + hstep, voffB);
            PG8_WAIT_V(6); PG8_BAR; PG8_MMA(1, 1, At, B1); PG8_BAR;
            }
        }
        if constexpr (ALIGN_EPI) { if (wr == 0) PG8_BAR; }
        if constexpr (!Epi::AFTER_DRAIN) { E(acc, cur, wr, wc, fr, fq); S.done(cur); }
        if (!has_next) break;
#pragma unroll
        for (int a = 0; a < 2; ++a)
#pragma unroll
            for (int b = 0; b < 2; ++b)
#pragma unroll
                for (int m = 0; m < 4; ++m)
#pragma unroll
                    for (int n = 0; n < 2; ++n) acc[a][b][m][n] = (f32x4){0.f, 0.f, 0.f, 0.f};
        cur = nxt; cA = nA; cB = nB; ++ui;
        if constexpr (ALIGN_EPI) { if (wr == 1) PG8_BAR; }
    }
    PG8_WAIT_V(0);
    if constexpr (!ALIGN_EPI) { if (wr == 0) PG8_BAR; }
    PG8_BAR;
    if constexpr (Epi::AFTER_DRAIN) { E.fused(acc, cur, wr, wc, fr, fq, lds, wid, lane); S.done(cur); }
#undef PG8_SA
#undef PG8_SB
#undef PG8_STAGE
#undef PG8_LDA
#undef PG8_LDB
#undef PG8_MMA
#undef PG8_WAIT_V
#undef PG8_WAIT_L
#undef PG8_BAR
#undef PG8_SCHED
}
}

template <class E> struct EpiAdapt { static constexpr bool PERM = false, AFTER_DRAIN = false; E e;
    __device__ __forceinline__ void operator()(const pg8::f32x4 (&acc)[2][2][4][2], const pg8::Unit& u, int wr, int wc, int fr, int fq) const { e(acc, 0, u.pm, u.pn, wr, wc, fr, fq); } };
template <class Epi>
__device__ __forceinline__ void gemm_stream(LAS unsigned char* lds, const bf16_t* A, const bf16_t* Bt, int N, int K, const Epi& E, int bid, int nb) {
    pg8::Gemm g{A, Bt, MTOK, N, K, K}; pg8::StaticOrder S; S.init(MTOK, N, nb, bid);
    EpiAdapt<Epi> ea{E};
    pg8::gemm_phase<EpiAdapt<Epi>, pg8::StaticOrder, true, true>(lds, g, S, ea);
}

#define EPI_LOOP(...) \
    _Pragma("unroll") for (int ai = 0; ai < 2; ++ai) _Pragma("unroll") for (int m = 0; m < 4; ++m) { asm volatile("" ::: "memory"); const int row = pm * 256 + ai * 128 + wr * 64 + m * 16 + fr; \
    _Pragma("unroll") for (int bj = 0; bj < 2; ++bj) _Pragma("unroll") for (int n = 0; n < 2; ++n) { const int ct = bj * 128 + wc * 32 + n * 16 + fq * 4; const f32x4 v = acc[ai][bj][m][n]; __VA_ARGS__ } }

struct EpiWin {
    bf16_t* UX; bf16_t* QKV;
    __device__ __forceinline__ void operator()(const f32x4 (&acc)[2][2][4][2], int gb, int pm, int pn, int wr, int wc, int fr, int fq) const {
        if (pn < 2) {
            bf16_t* base = UX + ((size_t)(pn * 16 + wc * 2) * 512 + (pm >> 4) * 128 + (pm & 15) * 8 + wr * 2) * 640 + fr * 16 + fq * 4;
#pragma unroll
            for (int ai = 0; ai < 2; ++ai)
#pragma unroll
                for (int m = 0; m < 4; ++m) { bf16_t* rp = base + (ai * 4 + (m >> 1)) * 640 + (m & 1) * 256;
#pragma unroll
                    for (int bj = 0; bj < 2; ++bj)
#pragma unroll
                        for (int n = 0; n < 2; ++n) { const f32x4 v = acc[ai][bj][m][n]; u32x2 w; w.x = pk2(v[0], v[1]); w.y = pk2(v[2], v[3]);
                            *(u32x2*)(rp + (size_t)(bj * 8 + n) * (512 * 640)) = w; }
                    asm volatile("" ::: "memory"); }
        } else { bf16_t* base = QKV + (size_t)((pn - 2) >> 1) * ((size_t)MTOK * 512) + (pn & 1) * 256 + (size_t)(pm * 256 + wr * 64 + fr) * 512 + wc * 32 + fq * 4;
#pragma unroll
            for (int ai = 0; ai < 2; ++ai)
#pragma unroll
                for (int m = 0; m < 4; ++m) { bf16_t* rp = base + (size_t)(ai * 128 + m * 16) * 512;
#pragma unroll
                    for (int bj = 0; bj < 2; ++bj)
#pragma unroll
                        for (int n = 0; n < 2; ++n) { const f32x4 v = acc[ai][bj][m][n]; u32x2 w; w.x = pk2(v[0], v[1]); w.y = pk2(v[2], v[3]);
                            *(u32x2*)(rp + bj * 128 + n * 16) = w; }
                    asm volatile("" ::: "memory"); }
        }
    }
};
struct EpiS5Z {
    float* Z;
    __device__ __forceinline__ void operator()(const f32x4 (&acc)[2][2][4][2], int gb, int pm, int pn, int wr, int wc, int fr, int fq) const {
        EPI_LOOP({ if (bj == 0) *(f32x4*)(Z + ((size_t)gb * 512 + row) * 128 + ct) = v; })
    }
};
struct EpiS5Y {
    const bf16_t* UX; bf16_t* YG; const float* dsk;
    __device__ __forceinline__ void operator()(const f32x4 (&acc)[2][2][4][2], int gb, int pm, int pn, int wr, int wc, int fr, int fq) const {
        EPI_LOOP({ const int col = pn * 256 + ct, t = col >> 4, h = col & 15, bb = row >> 7, cc = row & 127;
            const u32x2 uu = *(const u32x2*)(UX + ((size_t)gb * 512 + row) * 640 + col); const f32x4 dd = *(const f32x4*)(dsk + gb * 16 + h);
            u32x2 w; w.x = pk2(gelu_tanh(v[0] + dd[0] * bflo(uu.x)), gelu_tanh(v[1] + dd[1] * bfhi(uu.x))); w.y = pk2(gelu_tanh(v[2] + dd[2] * bflo(uu.y)), gelu_tanh(v[3] + dd[3] * bfhi(uu.y)));
            *(u32x2*)(YG + ((size_t)bb * SEQ + cc * 32 + t) * 512 + gb * 16 + h) = w; })
    }
};
struct PreS5Y {   static constexpr bool NOP = false;
    const float* Z; bf16_t* UX; const float* lam_re; const float* lam_im; const float* log_dt;
    __device__ __forceinline__ void operator()(int gb, int pm, int pn) const {
        const int tid = threadIdx.x;
        if (tid < 128) { const int pp = tid & 63, bb = 2 * pm + (tid >> 6);
            const float lr = lam_re[gb * 64 + pp], li = lam_im[gb * 64 + pp], dt = expf(log_dt[gb]);
            const float mag = expf(lr * dt * 32.f), ar = mag * cosf(li * dt * 32.f), ai = mag * sinf(li * dt * 32.f);
            const float* zp = Z + ((size_t)gb * 512 + bb * 128) * 128 + pp; bf16_t* xp = UX + ((size_t)gb * 512 + bb * 128) * 640 + 512 + pp;
            float xr = 0.f, xi = 0.f;
            for (int c0 = 0; c0 < 128; c0 += 16) { float zr[16], zi[16];
#pragma unroll
                for (int i = 0; i < 16; ++i) { zr[i] = zp[(size_t)(c0 + i) * 128]; zi[i] = zp[(size_t)(c0 + i) * 128 + 64]; }
#pragma unroll
                for (int i = 0; i < 16; ++i) { xp[(size_t)(c0 + i) * 640] = (bf16_t)f2bf(xr); xp[(size_t)(c0 + i) * 640 + 64] = (bf16_t)f2bf(xi);
                    const float nr = ar * xr - ai * xi + zr[i], ni = ar * xi + ai * xr + zi[i]; xr = nr; xi = ni; } } }
        __threadfence();
        asm volatile("s_waitcnt vmcnt(0)" ::: "memory");
        __syncthreads();
    }
};
struct EpiGlu {
    const bf16_t* YG; bf16_t* CAT;
    __device__ __forceinline__ void operator()(const f32x4 (&acc)[2][2][4][2], int gb, int pm, int pn, int wr, int wc, int fr, int fq) const {
        EPI_LOOP({ const int col = pn * 256 + ct; const u32x2 y = *(const u32x2*)(YG + (size_t)row * 512 + col);
            u32x2 w; w.x = pk2(bflo(y.x) * sigmoidf_(v[0]), bfhi(y.x) * sigmoidf_(v[1])); w.y = pk2(bflo(y.y) * sigmoidf_(v[2]), bfhi(y.y) * sigmoidf_(v[3]));
            *(u32x2*)(CAT + (size_t)row * 1024 + col) = w; })
    }
};
struct EpiRes {
    const float* res; float* out; const float* gate;
    __device__ __forceinline__ void operator()(const f32x4 (&acc)[2][2][4][2], int gb, int pm, int pn, int wr, int wc, int fr, int fq) const {
        const float* gatep = gate + (size_t)(pm >> 4) * 6144;
        EPI_LOOP({ const int col = pn * 256 + ct; const f32x4 g = *(const f32x4*)(gatep + col); const f32x4 r = *(const f32x4*)(res + (size_t)row * 1024 + col);
            *(f32x4*)(out + (size_t)row * 1024 + col) = r + g * v; })
    }
};
struct EpiSwiglu {
    bf16_t* HID;
    __device__ __forceinline__ void operator()(const f32x4 (&acc)[2][2][4][2], int gb, int pm, int pn, int wr, int wc, int fr, int fq) const {
#pragma unroll
        for (int ai = 0; ai < 2; ++ai)
#pragma unroll
            for (int m = 0; m < 4; ++m) { const int row = pm * 256 + ai * 128 + wr * 64 + m * 16 + fr;
#pragma unroll
                for (int n = 0; n < 2; ++n) { const f32x4 g = acc[ai][0][m][n], u = acc[ai][1][m][n]; float o[4];
#pragma unroll
                    for (int j = 0; j < 4; ++j) o[j] = g[j] * sigmoidf_(g[j]) * u[j];
                    u32x2 w; w.x = pk2(o[0], o[1]); w.y = pk2(o[2], o[3]);
                    *(u32x2*)(HID + (size_t)row * FF + pn * 128 + wc * 32 + n * 16 + fq * 4) = w; } }
    }
};
struct EpiRKV {
    bf16_t* RKV; int row0;
    __device__ __forceinline__ void operator()(const f32x4 (&acc)[2][2][4][2], int gb, int pm, int pn, int wr, int wc, int fr, int fq) const {
        bf16_t* base = RKV + (size_t)gb * ((size_t)MTOK * 1024) + (size_t)row0 * 1024 + pn * 256;
        EPI_LOOP({ u32x2 w; w.x = pk2(v[0], v[1]); w.y = pk2(v[2], v[3]); *(u32x2*)(base + (size_t)row * 1024 + ct) = w; })
    }
};
struct EpiL1 {
    bf16_t* L1; int row0;
    __device__ __forceinline__ void operator()(const f32x4 (&acc)[2][2][4][2], int gb, int pm, int pn, int wr, int wc, int fr, int fq) const {
        bf16_t* base = L1 + (size_t)(row0 + pm * 256 + wr * 64 + fr) * 256 + wc * 32 + fq * 4;
        const bool ident = (wc >= 2);
#pragma unroll
        for (int ai = 0; ai < 2; ++ai)
#pragma unroll
            for (int m = 0; m < 4; ++m) { bf16_t* rp = base + (size_t)(ai * 128 + m * 16) * 256;
#pragma unroll
                for (int bj = 0; bj < 2; ++bj) { const float sc = bj ? 1.f : 2.f, of = bj ? 0.f : -1.f;
#pragma unroll
                    for (int n = 0; n < 2; ++n) { const f32x4 v = acc[ai][bj][m][n]; float o[4];
#pragma unroll
                        for (int j = 0; j < 4; ++j) { const float sg = sc * __builtin_amdgcn_rcpf(1.f + __expf(-sc * v[j])) + of; o[j] = (bj == 0 && ident) ? v[j] : sg; }
                        u32x2 w; w.x = pk2(o[0], o[1]); w.y = pk2(o[2], o[3]); *(u32x2*)(rp + bj * 128 + n * 16) = w; } }
                asm volatile("" ::: "memory"); }
    }
};
struct EpiL2 {
    _Float16* DEC; bf16_t* AA; bf16_t* G; const float* w0; const float* a0;
    __device__ __forceinline__ void operator()(const f32x4 (&acc)[2][2][4][2], int gb, int pm, int pn, int wr, int wc, int fr, int fq) const {
        const int sel = pn >> 2, cb = (pn & 3) * 256;
        if (sel == 0) { EPI_LOOP({ const int col = cb + ct; const f32x4 w0v = *(const f32x4*)(w0 + col);
                _Pragma("unroll") for (int j = 0; j < 4; ++j) { const float z = w0v[j] + v[j]; const float sp = fmaxf(-z, 0.f) + __logf(1.f + __expf(-fabsf(z))); const float e = __expf(-sp - 0.5f);
                    const float omd = (e < 0.125f) ? e * (1.f - e * (0.5f - e * (0.16666667f - e * (0.041666668f - e * 0.0083333338f)))) : 1.f - __expf(-e);
                    DEC[(size_t)row * 1024 + col + j] = (_Float16)omd; } }) }
        else if (sel == 1) { EPI_LOOP({ const int col = cb + ct; const f32x4 a0v = *(const f32x4*)(a0 + col);
                u32x2 w; w.x = pk2(sigmoidf_(a0v[0] + v[0]), sigmoidf_(a0v[1] + v[1])); w.y = pk2(sigmoidf_(a0v[2] + v[2]), sigmoidf_(a0v[3] + v[3]));
                *(u32x2*)(AA + (size_t)row * 1024 + col) = w; }) }
        else { EPI_LOOP({ const int col = cb + ct; u32x2 w; w.x = pk2(v[0], v[1]); w.y = pk2(v[2], v[3]); *(u32x2*)(G + (size_t)row * 1024 + col) = w; }) }
    }
};


struct SchedRKV { int vb, vn;
    __device__ bool next(int i, pg8::Unit& u) const { const int t = vb + i * vn; if (vb < 0 || t >= 384) return false; u.pm = t & 31; u.pn = t >> 5; u.ao = (u.pn >> 2) * 2048; return true; }
    __device__ __forceinline__ void a_ready(const pg8::Unit&) const {}
    __device__ __forceinline__ void done(const pg8::Unit&) const {} };
struct SchedOne { int pm;
    __device__ bool next(int i, pg8::Unit& u) const { if (i > 0 || pm < 0) return false; u.pm = pm; u.pn = 0; u.ao = 0; return true; }
    __device__ __forceinline__ void a_ready(const pg8::Unit&) const {}
    __device__ __forceinline__ void done(const pg8::Unit&) const {} };
struct EpiAdaptRKV { static constexpr bool PERM = false, AFTER_DRAIN = false; EpiRKV e;
    __device__ __forceinline__ void operator()(const pg8::f32x4 (&acc)[2][2][4][2], const pg8::Unit& u, int wr, int wc, int fr, int fq) const { e(acc, u.pn >> 2, u.pm, u.pn & 3, wr, wc, fr, fq); } };
__device__ __forceinline__ void s5_gen(const Params& p, bf16_t* BtY, bf16_t* BtZ, float* lds, int bid, int nb) {
    float* PWr = lds; float* PWi = lds + 33 * 64; float* BBr = lds + 66 * 64; float* BBi = BBr + 1024; float* Cr = BBi + 1024; float* Ci = Cr + 1024; float* Kt = Ci + 1024;
    const int tid = threadIdx.x;
    for (int unit = bid; unit < 256; unit += nb) {
        const int g = unit >> 3, part = unit & 7;
        __syncthreads();
        { const float dt = expf(p.in[13][g]);
          for (int e = tid; e < 33 * 64; e += NTHR) { const int tau = e >> 6, pp = e & 63; const float lr = p.in[11][g * 64 + pp], li = p.in[12][g * 64 + pp];
              const float mag = expf(lr * dt * (float)tau), ang = li * dt * (float)tau; PWr[e] = mag * cosf(ang); PWi[e] = mag * sinf(ang); }
          __syncthreads();
          if (tid < 64) { const int pp = tid; const float lr = p.in[11][g * 64 + pp], li = p.in[12][g * 64 + pp];
              const float ar = PWr[64 + pp], ai = PWi[64 + pp], den = lr * lr + li * li, nr = ar - 1.f;
              const float qr = (nr * lr + ai * li) / den, qi = (ai * lr - nr * li) / den;
              for (int h = 0; h < 16; ++h) { const float br = p.in[14][(size_t)(g * 64 + pp) * 16 + h], bi = p.in[15][(size_t)(g * 64 + pp) * 16 + h]; BBr[pp * 16 + h] = qr * br - qi * bi; BBi[pp * 16 + h] = qr * bi + qi * br; } } }
        for (int i = tid; i < 1024; i += NTHR) { Cr[i] = p.in[16][(size_t)g * 1024 + i]; Ci[i] = p.in[17][(size_t)g * 1024 + i]; }
        __syncthreads();
        { const int tau = tid >> 4, h = tid & 15;
          float acc[16];
#pragma unroll
          for (int i = 0; i < 16; ++i) acc[i] = 0.f;
          for (int pp = 0; pp < 64; ++pp) { const float cr = Cr[h * 64 + pp], ci = Ci[h * 64 + pp], wr = PWr[tau * 64 + pp], wi = PWi[tau * 64 + pp];
              const float er = cr * wr - ci * wi, ei = cr * wi + ci * wr;
#pragma unroll
              for (int q = 0; q < 4; ++q) { const f32x4 br = *(const f32x4*)(BBr + pp * 16 + q * 4), bi = *(const f32x4*)(BBi + pp * 16 + q * 4);
#pragma unroll
                  for (int j = 0; j < 4; ++j) acc[q * 4 + j] += er * br[j] - ei * bi[j]; } }
#pragma unroll
          for (int q = 0; q < 4; ++q) *(f32x4*)(Kt + tau * 256 + h * 16 + q * 4) = (f32x4){acc[q * 4], acc[q * 4 + 1], acc[q * 4 + 2], acc[q * 4 + 3]}; }
        __syncthreads();
        for (int ci_ = tid; ci_ < 5120; ci_ += NTHR) { const int nrow = part * 64 + ci_ / 80, kc = (ci_ % 80) * 8, t = nrow >> 4, h = nrow & 15; float v[8];
#pragma unroll
            for (int i = 0; i < 8; ++i) { const int k = kc + i;
                if (k < 512) { const int sidx = k >> 4, h2 = k & 15; v[i] = (sidx <= t) ? Kt[(t - sidx) * 256 + h * 16 + h2] : 0.f; }
                else { const int jj = k - 512, pp = jj & 63; const float cr = Cr[h * 64 + pp], ci = Ci[h * 64 + pp], wr = PWr[(t + 1) * 64 + pp], wi = PWi[(t + 1) * 64 + pp];
                    v[i] = (jj >> 6) ? -(cr * wi + ci * wr) : (cr * wr - ci * wi); } }
            *(u32x4*)(BtY + ((size_t)g * 512 + nrow) * 640 + kc) = (u32x4){pk2(v[0], v[1]), pk2(v[2], v[3]), pk2(v[4], v[5]), pk2(v[6], v[7])}; }
        for (int ci_ = tid; ci_ < 1024; ci_ += NTHR) { const int n = part * 16 + (ci_ >> 6), kc = (ci_ & 63) * 8, pp = n & 63, im = n >> 6; float v[8];
#pragma unroll
            for (int i = 0; i < 8; ++i) { const int k = kc + i, sidx = k >> 4, h2 = k & 15, tau = 31 - sidx; const float wr = PWr[tau * 64 + pp], wi = PWi[tau * 64 + pp], br = BBr[pp * 16 + h2], bi = BBi[pp * 16 + h2];
                v[i] = im ? (wr * bi + wi * br) : (wr * br - wi * bi); }
            *(u32x4*)(BtZ + ((size_t)g * 256 + n) * 512 + kc) = (u32x4){pk2(v[0], v[1]), pk2(v[2], v[3]), pk2(v[4], v[5]), pk2(v[6], v[7])}; }
    }
    __syncthreads();
}

template <int MODE>
__device__ __forceinline__ void tr_job(const float* src, int K, int N, bf16_t* dst, int ldd, int row_off, int koff, const float* scale, float* lds, int bid, int nb, const float* scale2 = nullptr) {
    const int tk = K / 64, tn = N / 64, tid = threadIdx.x, nt_ = tk * tn;
    const int r = tid >> 3, c = (tid & 7) * 8;
    float4 a = {0.f, 0.f, 0.f, 0.f}, b = a; float sc = 1.f;
    if (bid < nt_) { const int k0 = (bid / tn) * 64, n0 = (bid % tn) * 64; const float* p = src + (size_t)(k0 + r) * N + n0 + c; a = *(const float4*)p; b = *(const float4*)(p + 4); sc = scale ? scale[k0 + r] - (scale2 ? scale2[k0 + r] : 0.f) : 1.f; }
    for (int t = bid; t < nt_; t += nb) {
        const int k0 = (t / tn) * 64, n0 = (t % tn) * 64;
        { float* l = lds + r * 65 + c; l[0] = a.x * sc; l[1] = a.y * sc; l[2] = a.z * sc; l[3] = a.w * sc; l[4] = b.x * sc; l[5] = b.y * sc; l[6] = b.z * sc; l[7] = b.w * sc; }
        if (t + nb < nt_) { const int t2 = t + nb, k2 = (t2 / tn) * 64, n2 = (t2 % tn) * 64; const float* p = src + (size_t)(k2 + r) * N + n2 + c; a = *(const float4*)p; b = *(const float4*)(p + 4); sc = scale ? scale[k2 + r] - (scale2 ? scale2[k2 + r] : 0.f) : 1.f; }
        __syncthreads();
        { const int nl = tid >> 3, kc = (tid & 7) * 8; float v[8];
#pragma unroll
          for (int i = 0; i < 8; ++i) v[i] = lds[(kc + i) * 65 + nl];
          int n = n0 + nl; int rowi = n;
          if (MODE == 1) rowi = (n >> 7) * 256 + (n & 127);
          if (MODE == 2) rowi = (n >> 7) * 256 + 128 + (n & 127);
          u32x4 w; w.x = pk2(v[0], v[1]); w.y = pk2(v[2], v[3]); w.z = pk2(v[4], v[5]); w.w = pk2(v[6], v[7]);
          *(u32x4*)(dst + (size_t)(row_off + rowi) * ldd + koff + k0 + kc) = w; }
        __syncthreads();
    }
}

__device__ __forceinline__ void prep_phase(const Params& p, float* lds, int bid, int nb) {
    unsigned char* ws = p.ws;
    s5_gen(p, (bf16_t*)(ws + OFF_BTY), (bf16_t*)(ws + OFF_BTZ), lds, bid, nb);
    tr_job<0>(p.in[10], 1024, 2048, (bf16_t*)(ws + OFF_WIN), 1024, 0, 0, nullptr, lds, bid, nb);
    tr_job<0>(p.in[19], 512, 512, (bf16_t*)(ws + OFF_WGLU), 512, 0, 0, nullptr, lds, bid, nb);
    tr_job<0>(p.in[27], 1024, 1024, (bf16_t*)(ws + OFF_WOUT), 1024, 0, 0, nullptr, lds, bid, nb);
    for (int l = 0; l < 2; ++l) {
        bf16_t* gu = (bf16_t*)(ws + (l ? OFF_WGU1 : OFF_WGU0)); bf16_t* dn = (bf16_t*)(ws + (l ? OFF_WDN1 : OFF_WDN0));
        tr_job<1>(p.in[7] + (size_t)l * 1024 * FF, 1024, FF, gu, 1024, 0, 0, nullptr, lds, bid, nb);
        tr_job<2>(p.in[8] + (size_t)l * 1024 * FF, 1024, FF, gu, 1024, 0, 0, nullptr, lds, bid, nb);
        tr_job<0>(p.in[9] + (size_t)l * FF * 1024, FF, 1024, dn, FF, 0, 0, nullptr, lds, bid, nb);
    }
    bf16_t* wrkv = (bf16_t*)(ws + OFF_WG1); bf16_t* wl1 = (bf16_t*)(ws + OFF_WL1); const float* mu = p.in[28];
    tr_job<0>(p.in[29], 1024, 1024, wrkv, 1024, 0, 0, nullptr, lds, bid, nb);
    tr_job<0>(p.in[30], 1024, 1024, wrkv, 1024, 1024, 0, nullptr, lds, bid, nb);
    tr_job<0>(p.in[31], 1024, 1024, wrkv, 1024, 2048, 0, nullptr, lds, bid, nb);
    tr_job<0>(p.in[34], 1024, 64, wl1, 2048, 0, 0, nullptr, lds, bid, nb);      tr_job<0>(p.in[34], 1024, 64, wl1, 2048, 0, 1024, mu + 1 * 1024, lds, bid, nb, mu + 3 * 1024);
    tr_job<0>(p.in[37], 1024, 64, wl1, 2048, 64, 0, nullptr, lds, bid, nb);     tr_job<0>(p.in[37], 1024, 64, wl1, 2048, 64, 1024, mu + 4 * 1024, lds, bid, nb, mu + 3 * 1024);
    tr_job<0>(p.in[39], 1024, 128, wl1, 2048, 128, 0, nullptr, lds, bid, nb);   tr_job<0>(p.in[39], 1024, 128, wl1, 2048, 128, 1024, mu + 5 * 1024, lds, bid, nb, mu + 3 * 1024);
    bf16_t* l2 = (bf16_t*)(ws + OFF_WL2);
    tr_job<0>(p.in[35], 64, 1024, l2, 256, 0, 0, nullptr, lds, bid, nb);
    tr_job<0>(p.in[38], 64, 1024, l2, 256, 1024, 64, nullptr, lds, bid, nb);
    tr_job<0>(p.in[40], 128, 1024, l2, 256, 2048, 128, nullptr, lds, bid, nb);
    for (int i = bid * NTHR + threadIdx.x; i < 3072 * 32; i += nb * NTHR) { const int n = i >> 5, kc = (i & 31) * 8; const int sel = n >> 10;
        const bool used = (sel == 0) ? (kc < 64) : (sel == 1) ? (kc >= 64 && kc < 128) : (kc >= 128);
        if (!used) *(u32x4*)(l2 + (size_t)n * 256 + kc) = (u32x4){0u, 0u, 0u, 0u}; }
    tr_job<0>(p.in[32], 1024, 1024, (bf16_t*)(ws + OFF_WO), 1024, 0, 0, nullptr, lds, bid, nb);
    {   const float* c = p.in[1]; const float* wada = p.in[3]; const float* bada = p.in[4]; float* mod = (float*)(ws + OFF_MOD);
        float* cact = lds;
        float* red = lds + 4096;
        for (int i = threadIdx.x; i < 4096; i += NTHR) { const float x = c[i]; cact[i] = x / (1.f + expf(-x)); }
        __syncthreads();
        const int col = threadIdx.x & 63, kg = threadIdx.x >> 6;
        for (int ch = bid; ch < 192; ch += nb) {
            const int l = ch / 96, n0 = (ch % 96) * 64;
            const float* wp = wada + (size_t)l * 1024 * 6144 + n0 + col;
            float a0 = 0.f, a1 = 0.f, a2 = 0.f, a3 = 0.f;
            for (int k = kg * 128; k < kg * 128 + 128; ++k) { const float w = wp[(size_t)k * 6144]; a0 += cact[k] * w; a1 += cact[1024 + k] * w; a2 += cact[2048 + k] * w; a3 += cact[3072 + k] * w; }
            red[(kg * 4 + 0) * 64 + col] = a0; red[(kg * 4 + 1) * 64 + col] = a1; red[(kg * 4 + 2) * 64 + col] = a2; red[(kg * 4 + 3) * 64 + col] = a3;
            __syncthreads();
            if (threadIdx.x < 256) { const int b = threadIdx.x >> 6; float s = 0.f;
#pragma unroll
                for (int g = 0; g < 8; ++g) s += red[(g * 4 + b) * 64 + col];
                mod[(size_t)(l * 4 + b) * 6144 + n0 + col] = s + bada[l * 6144 + n0 + col]; }
            __syncthreads();
        }
    }
}

template <bool RW>
__device__ __forceinline__ void norm_phase(const float* x, const float* g, const float* modl, int shift_off, int scale_off, bf16_t* out, int bid, int nb, int row0 = 0, int nrows = MTOK, const float* mu = nullptr) {
    const int wave = threadIdx.x >> 6, lane = threadIdx.x & 63;
    for (int row = row0 + bid * 8 + wave; row < row0 + nrows; row += nb * 8) {
        const int b = row >> 12; const float* xr = x + (size_t)row * 1024; const float* md = modl + (size_t)b * 6144;
        f32x4 v[4], vp[4]; float ss = 0.f, ssp = 0.f; const bool hasp = RW && ((row & 4095) != 0);
#pragma unroll
        for (int i = 0; i < 4; ++i) { v[i] = *(const f32x4*)(xr + i * 256 + lane * 4); ss += v[i][0] * v[i][0] + v[i][1] * v[i][1] + v[i][2] * v[i][2] + v[i][3] * v[i][3];
            if (RW) { vp[i] = hasp ? *(const f32x4*)(xr - 1024 + i * 256 + lane * 4) : (f32x4){0.f, 0.f, 0.f, 0.f}; ssp += vp[i][0] * vp[i][0] + vp[i][1] * vp[i][1] + vp[i][2] * vp[i][2] + vp[i][3] * vp[i][3]; } }
        ss = wave_sum(ss); const float rstd = rsqrtf(ss * (1.f / 1024.f) + 1e-6f);
        float rstdp = 0.f; if (RW) { ssp = wave_sum(ssp); rstdp = rsqrtf(ssp * (1.f / 1024.f) + 1e-6f); }
#pragma unroll
        for (int i = 0; i < 4; ++i) { const int c = i * 256 + lane * 4; const f32x4 gg = *(const f32x4*)(g + c), sc = *(const f32x4*)(md + scale_off + c), sh = *(const f32x4*)(md + shift_off + c);
            f32x4 h;
#pragma unroll
            for (int j = 0; j < 4; ++j) h[j] = v[i][j] * rstd * gg[j] * (1.f + sc[j]) + sh[j];
            if (!RW) { u32x2 w; w.x = pk2(h[0], h[1]); w.y = pk2(h[2], h[3]); *(u32x2*)(out + (size_t)row * 1024 + c) = w; }
            else { f32x4 d;
#pragma unroll
                for (int j = 0; j < 4; ++j) { const float hp = hasp ? (vp[i][j] * rstdp * gg[j] * (1.f + sc[j]) + sh[j]) : 0.f; d[j] = hp - h[j]; }
                const f32x4 mr = *(const f32x4*)(mu + c), mk = *(const f32x4*)(mu + 2048 + c), mv = *(const f32x4*)(mu + 3072 + c);
                const f32x4 xr_ = h + d * mr, xk_ = h + d * mk, xv_ = h + d * mv;
                bf16_t* o = out + (size_t)(row - row0) * 4096 + c;
                u32x2 w; w.x = pk2(xr_[0], xr_[1]); w.y = pk2(xr_[2], xr_[3]); *(u32x2*)(o) = w;
                w.x = pk2(xk_[0], xk_[1]); w.y = pk2(xk_[2], xk_[3]); *(u32x2*)(o + 1024) = w;
                w.x = pk2(xv_[0], xv_[1]); w.y = pk2(xv_[2], xv_[3]); *(u32x2*)(o + 2048) = w;
                w.x = pk2(d[0], d[1]); w.y = pk2(d[2], d[3]); *(u32x2*)(o + 3072) = w; } }
    }
}

__device__ __forceinline__ void qknorm_phase(bf16_t* Q, bf16_t* Kb, const int* pos, const float* qn, const float* kn, int bid, int nb) {
    const int wave = threadIdx.x >> 6, lane = threadIdx.x & 63, l16 = lane & 15, d0 = l16 * 4;
    float invf[4];
#pragma unroll
    for (int j = 0; j < 4; ++j) invf[j] = powf(500000.f, -(float)((l16 & 1) * 4 + j) / 8.f);
    const f32x4 qw = *(const f32x4*)(qn + d0), kw = *(const f32x4*)(kn + d0);
    for (int tok = bid * 8 + wave; tok < MTOK; tok += nb * 8) {
        const float ps = (float)pos[tok];
        float cs[4], sn[4];
#pragma unroll
        for (int j = 0; j < 4; ++j) { const float ang = ps * invf[j]; float rv = ang * 0.15915494309189535f; rv -= floorf(rv); cs[j] = __builtin_amdgcn_cosf(rv); sn[j] = __builtin_amdgcn_sinf(rv); }
#pragma unroll
        for (int bsel = 0; bsel < 2; ++bsel) { bf16_t* buf = bsel ? Kb : Q; const f32x4 w = bsel ? kw : qw;
#pragma unroll
            for (int it = 0; it < 2; ++it) { const int vec = it * 4 + (lane >> 4); bf16_t* ptr = buf + (size_t)tok * 512 + vec * 64 + d0;
                const u32x2 raw = *(const u32x2*)ptr; float y[4] = {bflo(raw.x), bfhi(raw.x), bflo(raw.y), bfhi(raw.y)};
                float ss = y[0] * y[0] + y[1] * y[1] + y[2] * y[2] + y[3] * y[3];
                ss = dpp_sum16(ss);
                const float rstd = rsqrtf(ss * (1.f / 64.f) + 1e-6f);
#pragma unroll
                for (int j = 0; j < 4; ++j) y[j] = y[j] * rstd * w[j];
                float pr[4];
#pragma unroll
                for (int j = 0; j < 4; ++j) pr[j] = __int_as_float(__builtin_amdgcn_update_dpp(0, __float_as_int(y[j]), 0x4E, 0xf, 0xf, true));
                if (l16 < 2) {
#pragma unroll
                    for (int j = 0; j < 4; ++j) y[j] = y[j] * cs[j] - pr[j] * sn[j]; }
                else if (l16 < 4) {
#pragma unroll
                    for (int j = 0; j < 4; ++j) y[j] = y[j] * cs[j] + pr[j] * sn[j]; }
                if (!bsel) {
#pragma unroll
                    for (int j = 0; j < 4; ++j) y[j] *= 0.125f * 1.4426950408889634f; }
                u32x2 o; o.x = pk2(y[0], y[1]); o.y = pk2(y[2], y[3]); *(u32x2*)ptr = o; } }
    }
}

__device__ __forceinline__ void vtrans_phase(const bf16_t* V, bf16_t* Vt, bf16_t* lds, int bid, int nb) {
    const int tid = threadIdx.x;
    for (int unit = bid; unit < 1024; unit += nb) {
        const int head = unit & 3, ch = unit >> 2; const int b = ch >> 6, t0 = (ch & 63) * 64;
#pragma unroll
        for (int i = 0; i < 2; ++i) { const int idx = tid + i * 512, t = idx >> 4, cc = (idx & 15) * 8;
            const u32x4 w = *(const u32x4*)(V + ((size_t)b * SEQ + t0 + t) * 512 + head * 128 + cc);
            unsigned* d = (unsigned*)(lds + t * 130 + cc); d[0] = w.x; d[1] = w.y; d[2] = w.z; d[3] = w.w; }
        __syncthreads();
        { const int e = tid >> 2, tc = (tid & 3) * 16; unsigned o[8];
#pragma unroll
          for (int i = 0; i < 8; ++i) o[i] = (unsigned)lds[(tc + 2 * i) * 130 + e] | ((unsigned)lds[(tc + 2 * i + 1) * 130 + e] << 16);
          u32x4* dst = (u32x4*)(Vt + ((size_t)(b * 4 + head) * 128 + e) * SEQ + t0 + tc);
          dst[0] = (u32x4){o[0], o[1], o[2], o[3]}; dst[1] = (u32x4){o[4], o[5], o[6], o[7]}; }
        __syncthreads();
    }
}

typedef float f32x16 __attribute__((ext_vector_type(16)));
__device__ __forceinline__ void attn_phase(const bf16_t* Q, const bf16_t* Kb, const bf16_t* Vt, bf16_t* CAT, const Params& p, LAS unsigned char* lds, int bid, int nb) {
    const int tid = threadIdx.x, wave = __builtin_amdgcn_readfirstlane(tid >> 6), lane = tid & 63, c = wave >> 2, wq = wave & 3, l32 = lane & 31, hh = lane >> 5;
    constexpr int KROW = 272, VROW = 144, KBUF = 64 * KROW, VBUF = 128 * VROW, VOFF = 2 * KBUF;
    const int lkey = tid >> 4, lkc = tid & 15, lve = tid >> 3, lvc = tid & 7;
    for (int unit = bid; unit < 256; unit += nb) {
        const int b = unit & 3, head = (unit >> 2) & 3, pr = unit >> 4;
        const bf16_t* kg = Kb + ((size_t)b * SEQ + lkey) * 512 + head * 128 + lkc * 8;
        const bf16_t* vg = Vt + ((size_t)(b * 4 + head) * 128 + lve) * SEQ + lvc * 8;
        for (int half = 0; half < 2; ++half) {
            const int qb = half ? (31 - pr) : pr; const int q0 = qb * 128 + wq * 32; const int nst = (qb + 1) * 2;
            bf16x8 qf[4];
            { const bf16_t* qp = Q + ((size_t)b * SEQ + q0 + l32) * 512 + head * 128 + c * 64 + hh * 8;
#pragma unroll
              for (int ks = 0; ks < 4; ++ks) qf[ks] = *(const bf16x8*)(qp + ks * 16); }
            f32x16 o[4];
#pragma unroll
            for (int blk = 0; blk < 4; ++blk)
#pragma unroll
                for (int r = 0; r < 16; ++r) o[blk][r] = 0.f;
            float mrow = -INFINITY, lsum = 0.f;
            u32x4 kreg[2][2], vreg[2][2];
#define AT_ISSUE(set, st) do { const int st_ = ((st) < nst) ? (st) : nst - 1; kreg[set][0] = *(const u32x4*)(kg + (size_t)(st_ * 64) * 512); kreg[set][1] = *(const u32x4*)(kg + (size_t)(st_ * 64 + 32) * 512); \
                               vreg[set][0] = *(const u32x4*)(vg + st_ * 64); vreg[set][1] = *(const u32x4*)(vg + (size_t)64 * SEQ + st_ * 64); } while (0)
#define AT_WRITE(set, slot) do { *(LAS u32x4*)(lds + (slot) * KBUF + lkey * KROW + lkc * 16) = kreg[set][0]; *(LAS u32x4*)(lds + (slot) * KBUF + (lkey + 32) * KROW + lkc * 16) = kreg[set][1]; \
                                 LAS u32x2* vd0 = (LAS u32x2*)(lds + VOFF + (slot) * VBUF + lve * VROW + (lvc >> 1) * 32 + (lvc & 1) * 8); vd0[0] = (u32x2){vreg[set][0].x, vreg[set][0].y}; vd0[2] = (u32x2){vreg[set][0].z, vreg[set][0].w}; \
                                 LAS u32x2* vd1 = (LAS u32x2*)(lds + VOFF + (slot) * VBUF + (lve + 64) * VROW + (lvc >> 1) * 32 + (lvc & 1) * 8); vd1[0] = (u32x2){vreg[set][1].x, vreg[set][1].y}; vd1[2] = (u32x2){vreg[set][1].z, vreg[set][1].w}; } while (0)
#define AT_PACK(dst, sv, base) do { u32x4 pw_; pw_.x = cvt_pk_bf16(sv[(base) + 0], sv[(base) + 1]); pw_.y = cvt_pk_bf16(sv[(base) + 2], sv[(base) + 3]); pw_.z = cvt_pk_bf16(sv[(base) + 4], sv[(base) + 5]); pw_.w = cvt_pk_bf16(sv[(base) + 6], sv[(base) + 7]); dst = __builtin_bit_cast(bf16x8, pw_); } while (0)
#define AT_COMPUTE(slot, st, kfa, kfb, vfa, vfb) do { const int key0 = (st) * 64; \
                if (key0 <= q0 + 31) { \
                    LAS unsigned char* kb = lds + (slot) * KBUF + l32 * KROW + c * 128 + hh * 16; \
                    LAS unsigned char* vb = lds + VOFF + (slot) * VBUF + l32 * VROW + hh * 16; \
                    f32x16 s0, s1; _Pragma("unroll") for (int r = 0; r < 16; ++r) { s0[r] = 0.f; s1[r] = 0.f; } \
                    kfa[0] = *(const LAS bf16x8*)(kb); kfa[1] = *(const LAS bf16x8*)(kb + 32 * KROW); kfa[2] = *(const LAS bf16x8*)(kb + 32); kfa[3] = *(const LAS bf16x8*)(kb + 32 * KROW + 32); \
                    kfb[0] = *(const LAS bf16x8*)(kb + 64); kfb[1] = *(const LAS bf16x8*)(kb + 32 * KROW + 64); kfb[2] = *(const LAS bf16x8*)(kb + 96); kfb[3] = *(const LAS bf16x8*)(kb + 32 * KROW + 96); \
                    __builtin_amdgcn_sched_barrier(0); \
                    s0 = __builtin_amdgcn_mfma_f32_32x32x16_bf16(kfa[0], qf[0], s0, 0, 0, 0); s1 = __builtin_amdgcn_mfma_f32_32x32x16_bf16(kfa[1], qf[0], s1, 0, 0, 0); \
                    s0 = __builtin_amdgcn_mfma_f32_32x32x16_bf16(kfa[2], qf[1], s0, 0, 0, 0); s1 = __builtin_amdgcn_mfma_f32_32x32x16_bf16(kfa[3], qf[1], s1, 0, 0, 0); \
                    s0 = __builtin_amdgcn_mfma_f32_32x32x16_bf16(kfb[0], qf[2], s0, 0, 0, 0); s1 = __builtin_amdgcn_mfma_f32_32x32x16_bf16(kfb[1], qf[2], s1, 0, 0, 0); \
                    s0 = __builtin_amdgcn_mfma_f32_32x32x16_bf16(kfb[2], qf[3], s0, 0, 0, 0); s1 = __builtin_amdgcn_mfma_f32_32x32x16_bf16(kfb[3], qf[3], s1, 0, 0, 0); \
                    _Pragma("unroll") for (int blk = 0; blk < 4; ++blk) vfa[blk] = *(const LAS bf16x8*)(vb + blk * 32 * VROW); \
                    _Pragma("unroll") for (int blk = 0; blk < 4; ++blk) vfb[blk] = *(const LAS bf16x8*)(vb + blk * 32 * VROW + 32); \
                    __builtin_amdgcn_sched_barrier(0); \
                    if (key0 + 63 > q0) { const int qrel = q0 + l32 - key0; \
                        _Pragma("unroll") for (int r = 0; r < 16; ++r) { const int kl = (r & 3) + 8 * (r >> 2) + 4 * hh; if (kl > qrel) s0[r] = -INFINITY; if (kl + 32 > qrel) s1[r] = -INFINITY; } } \
                    float tm = fmaxf(s0[0], s1[0]); _Pragma("unroll") for (int r = 1; r < 16; ++r) tm = fmaxf(tm, fmaxf(s0[r], s1[r])); \
                    tm = fmaxf(tm, __shfl_xor(tm, 32)); \
                    const float mnew = fmaxf(mrow, tm); \
                    if (__any(mnew > mrow + 6.f)) { const float al = __builtin_amdgcn_exp2f(mrow - mnew); lsum *= al; \
                        _Pragma("unroll") for (int blk = 0; blk < 4; ++blk) _Pragma("unroll") for (int r = 0; r < 16; ++r) o[blk][r] *= al; \
                        mrow = mnew; } \
                    float ps = 0.f; _Pragma("unroll") for (int r = 0; r < 16; ++r) { s0[r] = __builtin_amdgcn_exp2f(s0[r] - mrow); s1[r] = __builtin_amdgcn_exp2f(s1[r] - mrow); ps += s0[r] + s1[r]; } \
                    lsum += ps; \
                    bf16x8 pb0, pb1, pb2, pb3; AT_PACK(pb0, s0, 0); AT_PACK(pb1, s0, 8); AT_PACK(pb2, s1, 0); AT_PACK(pb3, s1, 8); \
                    __builtin_amdgcn_sched_barrier(0); \
                    _Pragma("unroll") for (int blk = 0; blk < 4; ++blk) o[blk] = __builtin_amdgcn_mfma_f32_32x32x16_bf16(vfa[blk], pb0, o[blk], 0, 0, 0); \
                    _Pragma("unroll") for (int blk = 0; blk < 4; ++blk) o[blk] = __builtin_amdgcn_mfma_f32_32x32x16_bf16(vfb[blk], pb1, o[blk], 0, 0, 0); \
                    __builtin_amdgcn_sched_barrier(0); \
                    _Pragma("unroll") for (int blk = 0; blk < 4; ++blk) kfa[blk] = *(const LAS bf16x8*)(vb + blk * 32 * VROW + 64); \
                    _Pragma("unroll") for (int blk = 0; blk < 4; ++blk) kfb[blk] = *(const LAS bf16x8*)(vb + blk * 32 * VROW + 96); \
                    __builtin_amdgcn_sched_barrier(0); \
                    _Pragma("unroll") for (int blk = 0; blk < 4; ++blk) o[blk] = __builtin_amdgcn_mfma_f32_32x32x16_bf16(kfa[blk], pb2, o[blk], 0, 0, 0); \
                    _Pragma("unroll") for (int blk = 0; blk < 4; ++blk) o[blk] = __builtin_amdgcn_mfma_f32_32x32x16_bf16(kfb[blk], pb3, o[blk], 0, 0, 0); \
                } } while (0)
            bf16x8 fr0[4], fr1[4], fr2[4], fr3[4];
            AT_ISSUE(0, 0); AT_ISSUE(1, 1);
            __syncthreads();
            AT_WRITE(0, 0);
            __syncthreads();
            for (int st = 0; st < nst; st += 2) {
                AT_ISSUE(0, st + 2);
                AT_COMPUTE(0, st, fr0, fr1, fr2, fr3);
                AT_WRITE(1, 1);
                __syncthreads();
                AT_ISSUE(1, st + 3);
                AT_COMPUTE(1, st + 1, fr2, fr3, fr0, fr1);
                AT_WRITE(0, 0);
                __syncthreads();
            }
            lsum += __shfl_xor(lsum, 32);
            const float inv = 1.f / lsum;
            LAS float* xo = (LAS float*)lds + (wq * 128 + 4 * hh) * 32 + l32;
            if (c == 1) {
#pragma unroll
                for (int blk = 0; blk < 4; ++blk)
#pragma unroll
                    for (int r = 0; r < 16; ++r) xo[(blk * 32 + (r & 3) + 8 * (r >> 2)) * 32] = o[blk][r] * inv; }
            __syncthreads();
            if (c == 0) { float ss = 0.f; float lam; { float s1 = 0.f, s2 = 0.f; for (int d = 0; d < 64; ++d) { s1 += p.in[22][d] * p.in[23][d]; s2 += p.in[24][d] * p.in[25][d]; } lam = expf(s1) - expf(s2) + 0.2f; }
                const float* subln = p.in[26];
#pragma unroll
                for (int blk = 0; blk < 4; ++blk)
#pragma unroll
                    for (int r = 0; r < 16; ++r) { const float v = o[blk][r] * inv - lam * xo[(blk * 32 + (r & 3) + 8 * (r >> 2)) * 32]; o[blk][r] = v; ss += v * v; }
                ss += __shfl_xor(ss, 32);
                const float rstd = rsqrtf(ss * (1.f / 128.f) + 1e-6f) * 0.8f;
                bf16_t* op = CAT + ((size_t)b * SEQ + q0 + l32) * 1024 + 512 + head * 128 + 4 * hh;
#pragma unroll
                for (int blk = 0; blk < 4; ++blk)
#pragma unroll
                    for (int g4 = 0; g4 < 4; ++g4) { const f32x4 sg = *(const f32x4*)(subln + blk * 32 + g4 * 8 + 4 * hh);
                        u32x2 w; w.x = pk2(o[blk][g4 * 4 + 0] * rstd * sg[0], o[blk][g4 * 4 + 1] * rstd * sg[1]); w.y = pk2(o[blk][g4 * 4 + 2] * rstd * sg[2], o[blk][g4 * 4 + 3] * rstd * sg[3]);
                        *(u32x2*)(op + blk * 32 + g4 * 8) = w; } }
        }
    }
}

__device__ __forceinline__ void attn_combine(const bf16_t* OC, bf16_t* CAT, const Params& p, int bid, int nb) {
    const int wave = threadIdx.x >> 6, lane = threadIdx.x & 63, head = lane >> 4, e0 = (lane & 15) * 8;
    float lam;
    { float s1 = 0.f, s2 = 0.f; for (int d = 0; d < 64; ++d) { s1 += p.in[22][d] * p.in[23][d]; s2 += p.in[24][d] * p.in[25][d]; } lam = expf(s1) - expf(s2) + 0.2f; }
    float sub[8];
#pragma unroll
    for (int i = 0; i < 8; ++i) sub[i] = p.in[26][e0 + i] * 0.8f;
    for (int tok = bid * 8 + wave; tok < MTOK; tok += nb * 8) {
        const u32x4 a = *(const u32x4*)(OC + (size_t)tok * 1024 + (head * 2) * 128 + e0), bb = *(const u32x4*)(OC + (size_t)tok * 1024 + (head * 2 + 1) * 128 + e0);
        float o[8] = {bflo(a.x) - lam * bflo(bb.x), bfhi(a.x) - lam * bfhi(bb.x), bflo(a.y) - lam * bflo(bb.y), bfhi(a.y) - lam * bfhi(bb.y),
                      bflo(a.z) - lam * bflo(bb.z), bfhi(a.z) - lam * bfhi(bb.z), bflo(a.w) - lam * bflo(bb.w), bfhi(a.w) - lam * bfhi(bb.w)};
        float ss = 0.f;
#pragma unroll
        for (int i = 0; i < 8; ++i) ss += o[i] * o[i];
        ss = dpp_sum16(ss);
        const float rstd = rsqrtf(ss * (1.f / 128.f) + 1e-6f);
        u32x4 w; w.x = pk2(o[0] * rstd * sub[0], o[1] * rstd * sub[1]); w.y = pk2(o[2] * rstd * sub[2], o[3] * rstd * sub[3]); w.z = pk2(o[4] * rstd * sub[4], o[5] * rstd * sub[5]); w.w = pk2(o[6] * rstd * sub[6], o[7] * rstd * sub[7]);
        *(u32x4*)(CAT + (size_t)tok * 1024 + 512 + head * 128 + e0) = w;
    }
}

typedef float f32x2 __attribute__((ext_vector_type(2)));
__device__ __forceinline__ float h2f_(unsigned bits) { return (float)__builtin_bit_cast(_Float16, (unsigned short)bits); }
__device__ __forceinline__ void rwkv_phase(const Params& p, const bf16_t* R, const bf16_t* Kk, const bf16_t* Vv, const _Float16* DEC, const bf16_t* AA, bf16_t* Y, float* lds, int bid, int nb) {
    const int tid = threadIdx.x, wave = __builtin_amdgcn_readfirstlane(tid >> 6), lane = tid & 63;
    constexpr int TCH = 16, BUFF = 5 * TCH * 64 + TCH * 16;
    constexpr int OBUF = TCH * 16 * 16;
    float* Lout = lds + 2 * BUFF;
    for (int unit = bid; unit < 256; unit += nb) {
        const int b = unit >> 6, h = (unit >> 2) & 15, rq = unit & 3;
        __syncthreads();
        if (wave >= 4) {
            const int pw = wave - 4, tl = lane >> 4, c4 = (lane & 15) * 4;
            const f32x4 kkw = *(const f32x4*)(p.in[41] + h * 64 + c4), kaw = *(const f32x4*)(p.in[42] + h * 64 + c4);
            u32x2 rr[4], kr[4], ar[4], dr[4], vr[4];
            const unsigned lofs = (unsigned)((pw * 4 + tl) * 1024 + h * 64 + c4), vofs = (unsigned)((pw * 4 + tl) * 1024 + h * 64 + rq * 16 + (lane & 3) * 4);
            const bf16_t* Rb = R + (size_t)b * SEQ * 1024; const bf16_t* Kb_ = Kk + (size_t)b * SEQ * 1024; const bf16_t* Vb = Vv + (size_t)b * SEQ * 1024;
            const bf16_t* Ab = AA + (size_t)b * SEQ * 1024; const _Float16* Db = DEC + (size_t)b * SEQ * 1024;
#define RW_ISSUE(set, ch) do { const unsigned o_ = (unsigned)(ch) * (TCH * 1024) + lofs; rr[set] = *(const u32x2*)(Rb + o_); kr[set] = *(const u32x2*)(Kb_ + o_); dr[set] = *(const u32x2*)(Db + o_); ar[set] = *(const u32x2*)(Ab + o_); \
                    vr[set] = *(const u32x2*)(Vb + (unsigned)(ch) * (TCH * 1024) + vofs); } while (0)
#define RW_STAGE(set, buf) do { float* L = lds + (buf) * BUFF + (pw * 4 + tl) * 64 + c4; \
                    const f32x4 k = {bflo(kr[set].x), bfhi(kr[set].x), bflo(kr[set].y), bfhi(kr[set].y)}, a = {bflo(ar[set].x), bfhi(ar[set].x), bflo(ar[set].y), bfhi(ar[set].y)}; \
                    const f32x4 r = {bflo(rr[set].x), bfhi(rr[set].x), bflo(rr[set].y), bfhi(rr[set].y)}; \
                    const f32x4 w = {1.f - h2f_(dr[set].x & 0xffffu), 1.f - h2f_(dr[set].x >> 16), 1.f - h2f_(dr[set].y & 0xffffu), 1.f - h2f_(dr[set].y >> 16)}; \
                    f32x4 kk = k * kkw; const float n2 = dpp_sum16((kk[0] * kk[0] + kk[1] * kk[1]) + (kk[2] * kk[2] + kk[3] * kk[3])); kk = kk * __frsqrt_rn(fmaxf(n2, 1e-24f)); \
                    *(f32x4*)(L) = w; *(f32x4*)(L + 1 * TCH * 64) = -kk; *(f32x4*)(L + 2 * TCH * 64) = kk * a; *(f32x4*)(L + 3 * TCH * 64) = k * (1.f + (a - 1.f) * kaw); *(f32x4*)(L + 4 * TCH * 64) = r; \
                    if ((lane & 15) < 4) *(f32x4*)(lds + (buf) * BUFF + 5 * TCH * 64 + (pw * 4 + tl) * 16 + (lane & 3) * 4) = (f32x4){bflo(vr[set].x), bfhi(vr[set].x), bflo(vr[set].y), bfhi(vr[set].y)}; } while (0)
            auto flush = [&](int ch) { const int i = tid - 256, tt = i >> 4, row = i & 15; const f32x4* pp = (const f32x4*)(Lout + (ch & 1) * OBUF + i * 16);
                const f32x4 s4 = pp[0] + pp[1] + pp[2] + pp[3];
                Y[((size_t)b * SEQ + ch * TCH + tt) * 1024 + h * 64 + rq * 16 + row] = (bf16_t)f2bf((s4[0] + s4[1]) + (s4[2] + s4[3])); };
            constexpr int NCH = SEQ / TCH;
            RW_ISSUE(0, 0); RW_ISSUE(1, 1); RW_ISSUE(2, 2); RW_ISSUE(3, 3);
            RW_STAGE(0, 0);
            __syncthreads();
            for (int c4_ = 0; c4_ < NCH; c4_ += 4) {
#define RW_ITER(q) do { const int ch = c4_ + (q); RW_STAGE(((q) + 1) & 3, (ch + 1) & 1); { const int chn = (ch + 4 < NCH) ? ch + 4 : NCH - 1; RW_ISSUE((q), chn); } flush(ch > 0 ? ch - 1 : 0); __syncthreads(); } while (0)
                RW_ITER(0); RW_ITER(1); RW_ITER(2); RW_ITER(3);
            }
            flush(NCH - 1);
        } else {
            const int j = lane & 15, rowl = wave * 4 + (lane >> 4);
            f32x2 S01 = {0.f, 0.f}, S23 = {0.f, 0.f};
            __syncthreads();
            for (int ch = 0; ch < SEQ / TCH; ++ch) {
                const float* L = lds + (ch & 1) * BUFF + j * 4; const float* Lv = lds + (ch & 1) * BUFF + 5 * TCH * 64 + rowl; float* Lo = Lout + (ch & 1) * OBUF + rowl * 16 + j;
                f32x4 w4 = *(const f32x4*)(L), a4 = *(const f32x4*)(L + 1 * TCH * 64), b4 = *(const f32x4*)(L + 2 * TCH * 64), k4 = *(const f32x4*)(L + 3 * TCH * 64), r4 = *(const f32x4*)(L + 4 * TCH * 64);
                float vv = Lv[0];
#pragma unroll
                for (int tt = 0; tt < TCH; ++tt) {
                    f32x4 nw4 = w4, na4 = a4, nb4 = b4, nk4 = k4, nr4 = r4; float nvv = vv;
                    if (tt + 1 < TCH) { const float* Ln = L + (tt + 1) * 64; nw4 = *(const f32x4*)(Ln); na4 = *(const f32x4*)(Ln + 1 * TCH * 64); nb4 = *(const f32x4*)(Ln + 2 * TCH * 64); nk4 = *(const f32x4*)(Ln + 3 * TCH * 64); nr4 = *(const f32x4*)(Ln + 4 * TCH * 64); nvv = Lv[(tt + 1) * 16]; }
                    f32x2 d = S01 * (f32x2){a4[0], a4[1]}; d = S23 * (f32x2){a4[2], a4[3]} + d;
                    const float sa = dpp_sum16(d[0] + d[1]);
                    const f32x2 sa2 = {sa, sa}, v2 = {vv, vv};
                    const f32x2 t01 = sa2 * (f32x2){b4[0], b4[1]} + v2 * (f32x2){k4[0], k4[1]}, t23 = sa2 * (f32x2){b4[2], b4[3]} + v2 * (f32x2){k4[2], k4[3]};
                    S01 = S01 * (f32x2){w4[0], w4[1]} + t01; S23 = S23 * (f32x2){w4[2], w4[3]} + t23;
                    f32x2 y = S01 * (f32x2){r4[0], r4[1]}; y = S23 * (f32x2){r4[2], r4[3]} + y;
                    Lo[tt * 256] = y[0] + y[1];
                    w4 = nw4; a4 = na4; b4 = nb4; k4 = nk4; r4 = nr4; vv = nvv;
                }
                __syncthreads();
            }
        }
    }
}

__device__ __forceinline__ void rwkv_post(const Params& p, bf16_t* R, const bf16_t* Kk, const bf16_t* Vv, const bf16_t* AA, const bf16_t* G, const bf16_t* Y, int bid, int nb) {
    const int wave = threadIdx.x >> 6, lane = threadIdx.x & 63;
    for (int it = bid * 8 + wave; it < MTOK * 16; it += nb * 8) {
        const int h = it & 15; const size_t off = (size_t)(it >> 4) * 1024 + h * 64 + lane;
        const float y = bf2f(Y[off]), r = bf2f(R[off]), k = bf2f(Kk[off]), v = bf2f(Vv[off]), a = bf2f(AA[off]), g = bf2f(G[off]);
        const float mean = wave_sum(y) * (1.f / 64.f); const float d = y - mean; const float var = wave_sum(d * d) * (1.f / 64.f);
        const float k2 = k * (1.f + (a - 1.f) * p.in[42][h * 64 + lane]);
        const float sb = wave_sum(r * k2 * p.in[43][h * 64 + lane]);
        const float yn = d * rsqrtf(var + 64e-5f) * p.in[44][h * 64 + lane] + p.in[45][h * 64 + lane] + sb * v;
        R[off] = (bf16_t)f2bf(yn * g);
    }
}

#define XB_TMO      128
#define XB_XCNT(j)  (256  + 64 * (j))
#define XB_XSUB(j)  (1280 + 64 * (j))
#define XB_XGEN(j)  (2304 + 64 * (j))
#define XB_TOP      3328
#define XB_TOPGEN   3392
#define XCD_BAR_WORDS 3456
#define XB_SPIN_CAP (1u << 18)
__device__ __forceinline__ unsigned xb_ld(unsigned* p)              { return __hip_atomic_load(p, __ATOMIC_RELAXED, __HIP_MEMORY_SCOPE_AGENT); }
__device__ __forceinline__ unsigned xb_add(unsigned* p, unsigned v) { return __hip_atomic_fetch_add(p, v, __ATOMIC_RELAXED, __HIP_MEMORY_SCOPE_AGENT); }
__device__ __forceinline__ unsigned xb_xcc_id() { return (unsigned)__builtin_amdgcn_s_getreg((3 << 11) | 20) & 0xFu; }
#define XB_SPIN(cond, bar) do { unsigned _sp = 0; while (cond) { __builtin_amdgcn_s_sleep(1); \
    if ((++_sp & 255u) == 0u) { if (xb_ld(&(bar)[XB_TMO])) break; if (_sp > XB_SPIN_CAP) { atomicAdd(&(bar)[XB_TMO], 1u); break; } } } } while (0)
struct XcdBarrier { unsigned* bar; unsigned x; volatile LAS unsigned* st; };
__device__ __forceinline__ XcdBarrier xcd_barrier_post(unsigned* bar, volatile LAS unsigned* st) {
    XcdBarrier b; b.bar = bar; b.x = xb_xcc_id(); b.st = st;
    if (threadIdx.x == 0) (void)xb_add(&bar[XB_XCNT(b.x)], 1u);
    return b;
}
__device__ __forceinline__ void xcd_barrier_complete(unsigned* bar, unsigned x, unsigned& nloc, unsigned& nx) {
    const unsigned G = gridDim.x * gridDim.y * gridDim.z;
    unsigned sum, cnt, mine, sp = 0u;
    for (;;) {
        sum = 0u; cnt = 0u; mine = 0u;
#pragma unroll
        for (unsigned j = 0; j < 16; ++j) { const unsigned c = xb_ld(&bar[XB_XCNT(j)]); sum += c; cnt += (c > 0u) ? 1u : 0u; mine = (j == x) ? c : mine; }
        if (sum == G) break;
        __builtin_amdgcn_s_sleep(1);
        if ((++sp & 255u) == 0u) { if (xb_ld(&bar[XB_TMO])) break; if (sp > XB_SPIN_CAP) { atomicAdd(&bar[XB_TMO], 1u); break; } }
    }
    nloc = mine > 0u ? mine : 1u; nx = cnt > 0u ? cnt : 1u;
}
__device__ __forceinline__ void xcd_barrier(const XcdBarrier& b) {
    asm volatile("s_waitcnt vmcnt(0)" ::: "memory");
    __syncthreads();
    if (threadIdx.x == 0) {
        unsigned* bar = b.bar;
        __builtin_amdgcn_s_waitcnt(0);
        unsigned nloc = b.st[0], nx = b.st[1];
        if (nloc == 0u) { xcd_barrier_complete(bar, b.x, nloc, nx); b.st[0] = nloc; b.st[1] = nx; }
        const unsigned old = xb_add(&bar[XB_XSUB(b.x)], 1u);
        const unsigned gen = old / nloc;
        if (old + 1u == (gen + 1u) * nloc) {
            __builtin_amdgcn_fence(__ATOMIC_RELEASE, "agent");
            asm volatile("s_waitcnt vmcnt(0)" ::: "memory");
            const unsigned og = xb_add(&bar[XB_TOP], 1u);
            const unsigned tg = og / nx;
            if (og + 1u == (tg + 1u) * nx) xb_add(&bar[XB_TOPGEN], 1u);
            else XB_SPIN(xb_ld(&bar[XB_TOPGEN]) == tg, bar);
            __builtin_amdgcn_fence(__ATOMIC_ACQUIRE, "agent");
            xb_add(&bar[XB_XGEN(b.x)], 1u);
            asm volatile("s_waitcnt vmcnt(0)" ::: "memory");
        } else {
            XB_SPIN(xb_ld(&bar[XB_XGEN(b.x)]) == gen, bar);
            __builtin_amdgcn_fence(__ATOMIC_ACQUIRE, "agent");
            asm volatile("s_waitcnt vmcnt(0)" ::: "memory");
        }
    }
    __syncthreads();
}

__global__ void __launch_bounds__(NTHR) fwd_kernel(Params p) {
    extern __shared__ __attribute__((aligned(16))) unsigned char lds_raw[];
    LAS unsigned char* lds = (LAS unsigned char*)lds_raw;
    float* ldsf = (float*)lds_raw;
    const int bid = blockIdx.x, nb = gridDim.x;
    unsigned char* ws = p.ws;
    float* mod = (float*)(ws + OFF_MOD);
    const bool multi = (p.ph_hi - p.ph_lo) > 1;
    __shared__ unsigned xb_st[4];
    if (threadIdx.x < 4) xb_st[threadIdx.x] = 0u;
    __syncthreads();
    XcdBarrier xbar; xbar.bar = (unsigned*)(ws + OFF_BAR); xbar.x = 0; xbar.st = (volatile LAS unsigned*)xb_st;
    if (multi) xbar = xcd_barrier_post((unsigned*)(ws + OFF_BAR), (volatile LAS unsigned*)xb_st);
#ifndef TESTPH
#define TESTPH -1
#endif
#ifndef REPEAT_A
#define REPEAT_A -1
#endif
#ifndef REPEAT_B
#define REPEAT_B -1
#endif
#ifndef EXTRA_SYNCS
#define EXTRA_SYNCS 0
#endif
#define PH(k) if ((TESTPH < 0 || TESTPH == (k)) && p.ph_lo <= (k) && (k) < p.ph_hi) for (int rep_ = 0; rep_ < (((k) == REPEAT_A || (k) == REPEAT_B) ? 2 : 1); ++rep_)
#define SYNC(k) if (multi) { xcd_barrier(xbar); }
    for (int es_ = 0; es_ < EXTRA_SYNCS; ++es_) cg::this_grid().sync();
    if (p.ph_lo < -1000) cg::this_grid().sync();
    PH(0) { prep_phase(p, ldsf, bid, nb); SYNC(0) }
    PH(1) { norm_phase<false>(p.in[0], p.in[5], mod, 0, 1024, (bf16_t*)(ws + OFF_HA), bid, nb); SYNC(1) }
    PH(2) { EpiWin e{(bf16_t*)(ws + OFF_UX), (bf16_t*)(ws + OFF_QKV)}; gemm_stream(lds, (const bf16_t*)(ws + OFF_HA), (const bf16_t*)(ws + OFF_WIN), 2048, 1024, e, bid, nb); SYNC(2) }
    PH(3) { { EpiS5Z e{(float*)(ws + OFF_Z)}; gemm_batched(lds, (const bf16_t*)(ws + OFF_UX), 640, (size_t)512 * 640, (const bf16_t*)(ws + OFF_BTZ), (size_t)256 * 512, 2, 1, 32, 512, e, NoPre{}, bid, nb); }
            bf16_t* q = (bf16_t*)(ws + OFF_QKV); qknorm_phase(q, q + (size_t)MTOK * 512, (const int*)p.in[2], p.in[20], p.in[21], bid, nb);
            vtrans_phase(q + (size_t)MTOK * 1024, (bf16_t*)(ws + OFF_VT), (bf16_t*)lds_raw, bid, nb); SYNC(3) }
    PH(5) { { EpiS5Y e{(const bf16_t*)(ws + OFF_UX), (bf16_t*)(ws + OFF_YG), p.in[18]}; PreS5Y pre{(const float*)(ws + OFF_Z), (bf16_t*)(ws + OFF_UX), p.in[11], p.in[12], p.in[13]};
              gemm_batched(lds, (const bf16_t*)(ws + OFF_UX), 640, (size_t)512 * 640, (const bf16_t*)(ws + OFF_BTY), (size_t)512 * 640, 2, 2, 32, 640, e, pre, bid, nb); }
            bf16_t* q = (bf16_t*)(ws + OFF_QKV); attn_phase(q, q + (size_t)MTOK * 512, (const bf16_t*)(ws + OFF_VT), (bf16_t*)(ws + OFF_CAT), p, lds, bid, nb); SYNC(5) }
    PH(6) {
            EpiGlu e{(const bf16_t*)(ws + OFF_YG), (bf16_t*)(ws + OFF_CAT)}; gemm_phase(lds, (const bf16_t*)(ws + OFF_YG), (const bf16_t*)(ws + OFF_WGLU), 512, 512, e, bid, nb); SYNC(6) }
    PH(7) { EpiRes e{p.in[0], p.out, mod + 2048}; gemm_stream(lds, (const bf16_t*)(ws + OFF_CAT), (const bf16_t*)(ws + OFF_WOUT), 1024, 1024, e, bid, nb); SYNC(7) }
    PH(8) { norm_phase<false>(p.out, p.in[6], mod, 3072, 4096, (bf16_t*)(ws + OFF_HA), bid, nb); SYNC(8) }
    PH(9) { EpiSwiglu e{(bf16_t*)(ws + OFF_HID)}; gemm_stream(lds, (const bf16_t*)(ws + OFF_HA), (const bf16_t*)(ws + OFF_WGU0), 5632, 1024, e, bid, nb); SYNC(9) }
    PH(10) { EpiRes e{p.out, p.out, mod + 5120}; gemm_stream(lds, (const bf16_t*)(ws + OFF_HID), (const bf16_t*)(ws + OFF_WDN0), 1024, FF, e, bid, nb); SYNC(10) }
    const float* mod1 = mod + 4 * 6144;
#define RWKV_FRONT(PA, PB, ROW0) \
    PH(PA) { norm_phase<true>(p.out, p.in[5] + 1024, mod1, 0, 1024, (bf16_t*)(ws + OFF_HD), bid, nb, (ROW0), 8192, p.in[28]); SYNC(PA) } \
    PH(PB) { const bf16_t* xall = (const bf16_t*)(ws + OFF_HD); const bool split = (nb == 256); \
               \
             { pg8::Gemm g{xall + 2048, (const bf16_t*)(ws + OFF_WL1), 8192, 256, 2048, 4096}; SchedOne S{(bid < 32) ? bid : -1}; EpiAdapt<EpiL1> ea{EpiL1{(bf16_t*)(ws + OFF_L1), (ROW0)}}; \
               pg8::gemm_phase<EpiAdapt<EpiL1>, SchedOne, false, true>(lds, g, S, ea); } \
             { pg8::Gemm g{xall, (const bf16_t*)(ws + OFF_WG1), 8192, 3072, 1024, 4096}; SchedRKV S{split ? bid - 32 : bid, split ? 224 : nb}; EpiAdaptRKV ea{EpiRKV{(bf16_t*)(ws + OFF_RKV), (ROW0)}}; \
               pg8::gemm_phase<EpiAdaptRKV, SchedRKV, true, true>(lds, g, S, ea); } \
             SYNC(PB) }
    RWKV_FRONT(11, 12, 0)
    RWKV_FRONT(20, 21, 8192)
    PH(13) { EpiL2 e{(_Float16*)(ws + OFF_DEC), (bf16_t*)(ws + OFF_AA), (bf16_t*)(ws + OFF_G), p.in[33], p.in[36]}; gemm_phase(lds, (const bf16_t*)(ws + OFF_L1), (const bf16_t*)(ws + OFF_WL2), 3072, 256, e, bid, nb); SYNC(13) }
    PH(14) { const bf16_t* r = (const bf16_t*)(ws + OFF_RKV); rwkv_phase(p, r, r + (size_t)MTOK * 1024, r + (size_t)MTOK * 2048, (const _Float16*)(ws + OFF_DEC), (const bf16_t*)(ws + OFF_AA), (bf16_t*)(ws + OFF_Y), ldsf, bid, nb); SYNC(14) }
    PH(15) { bf16_t* r = (bf16_t*)(ws + OFF_RKV); rwkv_post(p, r, r + (size_t)MTOK * 1024, r + (size_t)MTOK * 2048, (const bf16_t*)(ws + OFF_AA), (const bf16_t*)(ws + OFF_G), (const bf16_t*)(ws + OFF_Y), bid, nb); SYNC(15) }
    PH(16) { EpiRes e{p.out, p.out, mod1 + 2048}; gemm_stream(lds, (const bf16_t*)(ws + OFF_RKV), (const bf16_t*)(ws + OFF_WO), 1024, 1024, e, bid, nb); SYNC(16) }
    PH(17) { norm_phase<false>(p.out, p.in[6] + 1024, mod1, 3072, 4096, (bf16_t*)(ws + OFF_HA), bid, nb); SYNC(17) }
    PH(18) { EpiSwiglu e{(bf16_t*)(ws + OFF_HID)}; gemm_stream(lds, (const bf16_t*)(ws + OFF_HA), (const bf16_t*)(ws + OFF_WGU1), 5632, 1024, e, bid, nb); SYNC(18) }
    PH(19) { EpiRes e{p.out, p.out, mod1 + 5120}; gemm_stream(lds, (const bf16_t*)(ws + OFF_HID), (const bf16_t*)(ws + OFF_WDN1), 1024, FF, e, bid, nb); }
}

constexpr int NPHASE = 22;
#ifndef ONE_LAUNCH
#define ONE_LAUNCH 1
#endif

extern "C" void kernel_launch(void* const* d_in, const int* in_sizes, int n_in, void* d_out, int out_size, void* d_ws, size_t ws_size, hipStream_t stream) {
    static int grid = 0;
    if (grid == 0) {
        if (n_in != 46 || ws_size < WS_NEED) { fprintf(stderr, "kernel_launch: unexpected n_in %d / ws_size %zu (need %zu)\n", n_in, ws_size, (size_t)WS_NEED); grid = -1; return; }
        if (hipFuncSetAttribute((const void*)fwd_kernel, hipFuncAttributeMaxDynamicSharedMemorySize, LDS_BYTES) != hipSuccess) { fprintf(stderr, "hipFuncSetAttribute failed\n"); grid = -1; return; }
        int dev = 0, cus = 0, per_cu = 0;
        (void)hipGetDevice(&dev); (void)hipDeviceGetAttribute(&cus, hipDeviceAttributeMultiprocessorCount, dev);
        (void)hipOccupancyMaxActiveBlocksPerMultiprocessor(&per_cu, (const void*)fwd_kernel, NTHR, LDS_BYTES);
        if (per_cu < 1) per_cu = 1;
        grid = cus;
    }
    if (grid < 0) return;
    Params p{};
    for (int i = 0; i < 46; ++i) p.in[i] = (const float*)d_in[i];
    p.out = (float*)d_out; p.ws = (unsigned char*)d_ws;
#if ONE_LAUNCH
    p.ph_lo = 0; p.ph_hi = NPHASE;
    if (hipMemsetAsync((char*)d_ws + OFF_BAR, 0, XCD_BAR_WORDS * 4, stream) != hipSuccess) { fprintf(stderr, "memset failed\n"); return; }
    void* args[] = {&p};
    hipError_t e = hipLaunchCooperativeKernel((const void*)fwd_kernel, dim3(grid), dim3(NTHR), args, LDS_BYTES, stream);
    if (e != hipSuccess) fprintf(stderr, "cooperative launch failed: %s (grid %d)\n", hipGetErrorString(e), grid);
#else
    for (int ph = 0; ph < NPHASE; ++ph) { p.ph_lo = ph; p.ph_hi = ph + 1; hipLaunchKernelGGL(fwd_kernel, dim3(grid), dim3(NTHR), LDS_BYTES, stream, p); }
#endif
}
```

```cpp
#include <hip/hip_runtime.h>
#include <hip/hip_cooperative_groups.h>
#include <cstdio>
#include <cstdint>
namespace cg = cooperative_groups;

#define LAS __attribute__((address_space(3)))
typedef unsigned short bf16_t;
typedef short bf16x8 __attribute__((ext_vector_type(8)));
typedef float f32x4 __attribute__((ext_vector_type(4)));
typedef unsigned u32x2 __attribute__((ext_vector_type(2)));
typedef unsigned u32x4 __attribute__((ext_vector_type(4)));

constexpr int MTOK = 16384, DM = 1024, SEQ = 4096, FF = 2816;
constexpr int NTHR = 512;
constexpr int LDS_BYTES = 131072;
constexpr size_t MiB = 1048576;
constexpr size_t OFF_WIN = 0;
constexpr size_t OFF_WGLU = 4194304;
constexpr size_t OFF_WOUT = 4718592;
constexpr size_t OFF_WGU0 = 6815744;
constexpr size_t OFF_WDN0 = 18350080;
constexpr size_t OFF_WGU1 = 39321600;
constexpr size_t OFF_WDN1 = 50855936;
constexpr size_t OFF_WG1 = 24117248;
constexpr size_t OFF_WL1 = 24117248 + 6291456;
constexpr size_t OFF_WL2 = 37748736;
constexpr size_t OFF_WO = 56623104;
constexpr size_t OFF_MOD = 58720256;
constexpr size_t OFF_BAR = 58916864;
constexpr size_t ACT = 57 * MiB;
constexpr size_t OFF_HA = ACT;
constexpr size_t OFF_UX = ACT + 32 * MiB;
constexpr size_t OFF_Z = ACT + 52 * MiB;
constexpr size_t OFF_BTZ = ACT + 112 * MiB;
constexpr size_t OFF_BTY = ACT + 176 * MiB;
constexpr size_t OFF_QKV = ACT + 64 * MiB;
constexpr size_t OFF_CAT = ACT + 112 * MiB;
constexpr size_t OFF_YG = ACT + 144 * MiB;
constexpr size_t OFF_VT = ACT + 160 * MiB;
constexpr size_t OFF_OC = ACT;
constexpr size_t OFF_HID = ACT + 32 * MiB;
constexpr size_t OFF_HD = ACT;
constexpr size_t OFF_RKV = ACT + 64 * MiB;
constexpr size_t OFF_G = ACT + 160 * MiB;
constexpr size_t OFF_Y = 0;
constexpr size_t OFF_L1 = 0;
constexpr size_t OFF_DEC = ACT;
constexpr size_t OFF_AA = ACT + 32 * MiB;
constexpr size_t WS_NEED = ACT + 196 * MiB;

struct Params {
    const float* in[46];
    float* out;
    unsigned char* ws;
    int ph_lo, ph_hi;
};

__device__ __forceinline__ unsigned f2bf(float f) { unsigned u = __float_as_uint(f); return (u + 0x7fffu + ((u >> 16) & 1u)) >> 16; }
__device__ __forceinline__ float bf2f(unsigned h) { return __uint_as_float(h << 16); }
__device__ __forceinline__ unsigned cvt_pk_bf16(float lo, float hi) { unsigned r; asm("v_cvt_pk_bf16_f32 %0, %1, %2" : "=v"(r) : "v"(lo), "v"(hi)); return r; }
__device__ __forceinline__ unsigned pk2(float lo, float hi) { return cvt_pk_bf16(lo, hi); }
__device__ __forceinline__ float bflo(unsigned w) { return __uint_as_float(w << 16); }
__device__ __forceinline__ float bfhi(unsigned w) { return __uint_as_float(w & 0xffff0000u); }
__device__ __forceinline__ float dpp_sum16(float x) {
    x += __int_as_float(__builtin_amdgcn_update_dpp(0, __float_as_int(x), 0xB1, 0xf, 0xf, true));
    x += __int_as_float(__builtin_amdgcn_update_dpp(0, __float_as_int(x), 0x4E, 0xf, 0xf, true));
    x += __int_as_float(__builtin_amdgcn_update_dpp(0, __float_as_int(x), 0x141, 0xf, 0xf, true));
    x += __int_as_float(__builtin_amdgcn_update_dpp(0, __float_as_int(x), 0x140, 0xf, 0xf, true));
    return x;
}
__device__ __forceinline__ float wave_sum(float v) {
    v = dpp_sum16(v);
    const float s0 = __int_as_float(__builtin_amdgcn_readlane(__float_as_int(v), 0)), s1 = __int_as_float(__builtin_amdgcn_readlane(__float_as_int(v), 16));
    const float s2 = __int_as_float(__builtin_amdgcn_readlane(__float_as_int(v), 32)), s3 = __int_as_float(__builtin_amdgcn_readlane(__float_as_int(v), 48));
    return (s0 + s1) + (s2 + s3);
}
__device__ __forceinline__ float sigmoidf_(float x) { return __fdividef(1.f, 1.f + __expf(-x)); }
__device__ __forceinline__ float tanh_fast(float x) { const float t = __expf(2.f * fminf(fmaxf(x, -15.f), 15.f)); return __fdividef(t - 1.f, t + 1.f); }
#define LWAIT() asm volatile("s_waitcnt lgkmcnt(0)" ::: "memory")
__device__ __forceinline__ float gelu_tanh(float x) { const float u = 0.7978845608028654f * (x + 0.044715f * x * x * x); const float t = __expf(2.f * fminf(fmaxf(u, -15.f), 15.f)); return __fdividef(x * t, t + 1.f); }

constexpr int HTB = 128 * 64 * 2;
__device__ __forceinline__ int lds_byte(int r, int c) { int st = (r >> 4) * 2 + (c >> 5), rr = r & 15, cc = c & 31, ob = rr * 64 + cc * 2; return st * 1024 + (ob ^ (((ob >> 9) & 1) << 5)); }
__device__ __forceinline__ void stage_rc(int b, int& R, int& C) { int st = b / 1024, sb = b % 1024, swz = sb ^ (((sb >> 9) & 1) << 5); R = (st >> 1) * 16 + swz / 64; C = (st & 1) * 32 + (swz % 64) / 2; }

struct NoPre { static constexpr bool NOP = true; __device__ __forceinline__ void operator()(int, int, int) const {} };
template <class Epi, class Pre, bool PF = true>
__device__ __forceinline__ void gemm_batched(LAS unsigned char* lds, const bf16_t* A, int lda, size_t strideA, const bf16_t* Bt, size_t strideB, int nMt, int nNt, int nbatch, int K, const Epi& E, const Pre& PRE, int bid, int nb) {
    const int tid = threadIdx.x, wid = __builtin_amdgcn_readfirstlane(tid >> 6), lane = tid & 63, wr = wid >> 2, wc = wid & 3, fr = lane & 15, fq = lane >> 4;
    unsigned voffA[2], voffB[2];
#pragma unroll
    for (int i = 0; i < 2; ++i) { int R, C; stage_rc(tid * 16 + i * 8192, R, C); voffA[i] = (unsigned)(R * lda + C) * 2u; voffB[i] = (unsigned)(R * K + C) * 2u; }
    const int aoff = lds_byte(wr * 64 + fr, fq * 8), boff = lds_byte(wc * 32 + fr, fq * 8);
    const unsigned ldsw = (unsigned)wid * 1024u;
    const size_t kstep = 128, hstepA = (size_t)128 * lda * 2, hstepB = (size_t)128 * K * 2;
    const int nt = K / 64;
    const int ntiles = nMt * nNt * nbatch;
#define G_SA(b, h) (((b) * 2 + (h)) * HTB)
#define G_SB(b, h) ((4 + (b) * 2 + (h)) * HTB)
#define G_STAGEX(bufoff, gptr, vo) do { _Pragma("unroll") for (int _i = 0; _i < 2; ++_i) \
        __builtin_amdgcn_global_load_lds((const unsigned*)((gptr) + vo[_i]), (LAS unsigned*)(lds + (bufoff) + ldsw + _i * 8192), 16, 0, 0); } while (0)
#define G_STA(bufoff, gptr) G_STAGEX(bufoff, gptr, voffA)
#define G_STB(bufoff, gptr) G_STAGEX(bufoff, gptr, voffB)
#define G_LDA(dst, b, h) do { _Pragma("unroll") for (int m = 0; m < 4; ++m) _Pragma("unroll") for (int k = 0; k < 2; ++k) dst[m][k] = *(const LAS bf16x8*)(lds + G_SA(b, h) + aoff + m * 2048 + k * 1024); } while (0)
#define G_LDB(dst, b, h) do { _Pragma("unroll") for (int n = 0; n < 2; ++n) _Pragma("unroll") for (int k = 0; k < 2; ++k) dst[n][k] = *(const LAS bf16x8*)(lds + G_SB(b, h) + boff + n * 2048 + k * 1024); } while (0)
#define G_MMA(ai, bj, At, Bx) do { __builtin_amdgcn_s_setprio(1); _Pragma("unroll") for (int m = 0; m < 4; ++m) _Pragma("unroll") for (int n = 0; n < 2; ++n) _Pragma("unroll") for (int k = 0; k < 2; ++k) \
        acc[ai][bj][m][n] = __builtin_amdgcn_mfma_f32_16x16x32_bf16(Bx[n][k], At[m][k], acc[ai][bj][m][n], 0, 0, 0); __builtin_amdgcn_s_setprio(0); } while (0)
#define G_WV(n) asm volatile("s_waitcnt vmcnt(" #n ")" ::: "memory")
#define G_WL(n) asm volatile("s_waitcnt lgkmcnt(" #n ")" ::: "memory")
#define G_BAR __builtin_amdgcn_s_barrier()
#define G_SCHED __builtin_amdgcn_sched_barrier(0)
    bool prefetched = false;
    for (int tile = bid; tile < ntiles; tile += nb) {
        const int pm = tile % nMt, tq = tile / nMt, pn = tq % nNt, gb = tq / nNt;
        PRE(gb, pm, pn);
        const char* cA = (const char*)(A + (size_t)gb * strideA) + (size_t)pm * 256 * lda * 2;
        const char* cB = (const char*)(Bt + (size_t)gb * strideB) + (size_t)pn * 256 * K * 2;
        f32x4 acc[2][2][4][2];
#pragma unroll
        for (int a = 0; a < 2; ++a)
#pragma unroll
            for (int b = 0; b < 2; ++b)
#pragma unroll
                for (int m = 0; m < 4; ++m)
#pragma unroll
                    for (int n = 0; n < 2; ++n) acc[a][b][m][n] = (f32x4){0.f, 0.f, 0.f, 0.f};
        bf16x8 At[4][2], B0[2][2], B1[2][2];
        if (!prefetched) { G_WV(0); G_STB(G_SB(0, 0), cB); G_STA(G_SA(0, 0), cA); G_STB(G_SB(0, 1), cB + hstepB); G_STA(G_SA(0, 1), cA + hstepA); }
        if (wr == 1) G_BAR;
        if (prefetched) G_WV(0); else G_WV(4);
        G_BAR;
        G_STB(G_SB(1, 0), cB + kstep); G_STA(G_SA(1, 0), cA + kstep); G_STB(G_SB(1, 1), cB + hstepB + kstep);
        G_WV(6); G_BAR;
        for (int t = 0; t < nt - 2; t += 2) {
            const char* a1 = cA + (size_t)(t + 1) * kstep; const char* a2 = cA + (size_t)(t + 2) * kstep; const char* a3 = a2 + kstep;
            const char* b2 = cB + (size_t)(t + 2) * kstep; const char* b3 = b2 + kstep;
            G_LDB(B0, 0, 0); G_SCHED; G_LDA(At, 0, 0); G_STA(G_SA(1, 1), a1 + hstepA);
            G_WL(8); G_BAR; G_WL(0); G_MMA(0, 0, At, B0); G_BAR; G_SCHED;
            G_LDB(B1, 0, 1); G_STB(G_SB(0, 0), b2);
            G_BAR; G_WL(0); G_MMA(0, 1, At, B1); G_BAR;
            G_LDA(At, 0, 1); G_STA(G_SA(0, 0), a2);
            G_BAR; G_WL(0); G_MMA(1, 0, At, B0); G_BAR; G_SCHED;
            G_STB(G_SB(0, 1), b2 + hstepB);
            G_WV(6); G_BAR; G_MMA(1, 1, At, B1); G_BAR;
            G_LDB(B0, 1, 0); G_SCHED; G_LDA(At, 1, 0); G_STA(G_SA(0, 1), a2 + hstepA);
            G_WL(8); G_BAR; G_WL(0); G_MMA(0, 0, At, B0); G_BAR; G_SCHED;
            G_LDB(B1, 1, 1); G_STB(G_SB(1, 0), b3);
            G_BAR; G_WL(0); G_MMA(0, 1, At, B1); G_BAR;
            G_LDA(At, 1, 1); G_STA(G_SA(1, 0), a3);
            G_BAR; G_WL(0); G_MMA(1, 0, At, B0); G_BAR; G_SCHED;
            G_STB(G_SB(1, 1), b3 + hstepB);
            G_WV(6); G_BAR; G_MMA(1, 1, At, B1); G_BAR;
        }
        {
            const char* a1 = cA + (size_t)(nt - 1) * kstep;
            G_LDB(B0, 0, 0); G_LDA(At, 0, 0); G_STA(G_SA(1, 1), a1 + hstepA);
            G_BAR; G_WL(0); G_MMA(0, 0, At, B0); G_BAR;
            G_LDB(B1, 0, 1); G_BAR; G_WL(0); G_MMA(0, 1, At, B1); G_BAR;
            G_LDA(At, 0, 1); G_WV(4); G_BAR; G_WL(0); G_MMA(1, 0, At, B0); G_MMA(1, 1, At, B1); G_BAR;
        }
        {
            G_LDB(B0, 1, 0); G_LDA(At, 1, 0); G_WV(2); G_BAR; G_WL(0); G_MMA(0, 0, At, B0); G_BAR;
            G_LDB(B1, 1, 1); G_WV(0); G_BAR; G_WL(0); G_MMA(0, 1, At, B1); G_BAR;
            G_LDA(At, 1, 1); G_BAR; G_WL(0); G_MMA(1, 0, At, B0); G_MMA(1, 1, At, B1); G_BAR;
        }
        if (wr == 0) G_BAR;
        prefetched = false;
        if (PF && Pre::NOP && tile + nb < ntiles) {
            const int t2 = tile + nb, pm2 = t2 % nMt, tq2 = t2 / nMt, pn2 = tq2 % nNt, gb2 = tq2 / nNt;
            const char* nA = (const char*)(A + (size_t)gb2 * strideA) + (size_t)pm2 * 256 * lda * 2;
            const char* nB = (const char*)(Bt + (size_t)gb2 * strideB) + (size_t)pn2 * 256 * K * 2;
            G_STB(G_SB(0, 0), nB); G_STA(G_SA(0, 0), nA); G_STB(G_SB(0, 1), nB + hstepB); G_STA(G_SA(0, 1), nA + hstepA);
            prefetched = true; }
        E(acc, gb, pm, pn, wr, wc, fr, fq);
    }
    G_WV(0);
    __syncthreads();
}

template <class Epi>
__device__ __forceinline__ void gemm_phase(LAS unsigned char* lds, const bf16_t* A, const bf16_t* Bt, int N, int K, const Epi& E, int bid, int nb) {
    gemm_batched(lds, A, K, 0, Bt, 0, 64, N / 256, 1, K, E, NoPre{}, bid, nb);
}

namespace pg8 {
#define PG8_LAS __attribute__((address_space(3)))
typedef unsigned short bf16_t;
typedef short bf16x8 __attribute__((ext_vector_type(8)));
typedef float f32x4 __attribute__((ext_vector_type(4)));
typedef unsigned u32x4 __attribute__((ext_vector_type(4)));
constexpr int BM = 256, BK = 64, HALF = 128, HTB = HALF * BK * 2  , STAGE_BYTES = 8 * HTB, NXCD = 8, WGM = 8;

__host__ __device__ __forceinline__ int lds_byte(int r, int c) { const int st = (r >> 4) * 2 + (c >> 5), rr = r & 15, cc = c & 31, ob = rr * 64 + cc * 2; return st * 1024 + (ob ^ (((ob >> 9) & 1) << 5)); }
__host__ __device__ __forceinline__ void stage_rc(int b, int& R, int& C) { const int st = b / 1024, sb = b % 1024, swz = sb ^ (((sb >> 9) & 1) << 5); R = (st >> 1) * 16 + swz / 64; C = (st & 1) * 32 + (swz % 64) / 2; }
__host__ __device__ __forceinline__ int perm32(int rho) { const int n = rho >> 4, i = rho & 15; return 8 * (i >> 2) + 4 * n + (i & 3); }

struct Unit { int pm, pn; int ao = 0; };
struct Gemm { const bf16_t* A; const bf16_t* Bt; int M, N, K; int lda; };

struct StaticOrder {
    int nM, nN, nwg, G, c;
    __host__ __device__ void init(int M, int N, int G_, int c_) { nM = M / BM; nN = N / BM; nwg = nM * nN; G = G_; c = c_; }
    __host__ __device__ bool next(int i, Unit& u) const {
        const long L = (long)i * G + c; if (L >= nwg) return false;
        int wgid = (int)L; { const int q = nwg / NXCD, r = nwg % NXCD, xcd = wgid % NXCD, off = wgid / NXCD; wgid = (xcd < r ? xcd * (q + 1) : r * (q + 1) + (xcd - r) * q) + off; }
        const int nig = WGM * nN, gid = wgid / nig, fm = gid * WGM, gsz = (nM - fm) < WGM ? (nM - fm) : WGM;
        u.pm = fm + ((wgid % nig) % gsz); u.pn = (wgid % nig) / gsz; return true;
    }
    __device__ __forceinline__ void a_ready(const Unit&) const {}
    __device__ __forceinline__ void done(const Unit&) const {}
};
template <class Epi, class Sched, bool ALIGN_EPI = false, bool SP2 = false>
__device__ __forceinline__ void gemm_phase(PG8_LAS unsigned char* lds, const Gemm g, const Sched& S, const Epi& E) {
    const int tid = threadIdx.x, wid = __builtin_amdgcn_readfirstlane(tid >> 6), lane = tid & 63, wr = wid >> 2, wc = wid & 3, fr = lane & 15, fq = lane >> 4;
    const int K = g.K, nt = K / BK;
    unsigned voffA[2], voffB[2];
#pragma unroll
    for (int i = 0; i < 2; ++i) { int R, C; stage_rc(tid * 16 + i * 8192, R, C); const int Rb = Epi::PERM ? ((R & ~31) + perm32(R & 31)) : R;
        voffA[i] = (unsigned)(R * g.lda + C) * 2u; voffB[i] = (unsigned)(Rb * K + C) * 2u; }
    const size_t kstep = (size_t)(BK * 2);
    const size_t hstep = (size_t)HALF * K * 2;
    const size_t tstep = 2 * hstep;
    const size_t hstepA = (size_t)HALF * g.lda * 2, tstepA = 2 * hstepA;
    const unsigned ldsw = (unsigned)wid * 1024u;
    const int aoff = lds_byte(wr * 64 + fr, fq * 8), boff = lds_byte(wc * 32 + fr, fq * 8);
#define PG8_SA(b, h) (((b) * 2 + (h)) * HTB)
#define PG8_SB(b, h) ((4 + (b) * 2 + (h)) * HTB)
#define PG8_STAGE(bufoff, gbase, voff) do { _Pragma("unroll") for (int _i = 0; _i < 2; ++_i) \
        __builtin_amdgcn_global_load_lds((const unsigned*)((const char*)(gbase) + (voff)[_i]), (PG8_LAS unsigned*)(lds + (bufoff) + ldsw + _i * 8192), 16, 0, 0); } while (0)
#define PG8_LDA(dst, b, h) do { _Pragma("unroll") for (int m = 0; m < 4; ++m) _Pragma("unroll") for (int k = 0; k < 2; ++k) dst[m][k] = *(const PG8_LAS bf16x8*)(lds + PG8_SA(b, h) + aoff + m * 2048 + k * 1024); } while (0)
#define PG8_LDB(dst, b, h) do { _Pragma("unroll") for (int n = 0; n < 2; ++n) _Pragma("unroll") for (int k = 0; k < 2; ++k) dst[n][k] = *(const PG8_LAS bf16x8*)(lds + PG8_SB(b, h) + boff + n * 2048 + k * 1024); } while (0)
#define PG8_MMA(ai, bj, At, Bt) do { __builtin_amdgcn_s_setprio(1); _Pragma("unroll") for (int m = 0; m < 4; ++m) _Pragma("unroll") for (int n = 0; n < 2; ++n) _Pragma("unroll") for (int k = 0; k < 2; ++k) \
        acc[ai][bj][m][n] = __builtin_amdgcn_mfma_f32_16x16x32_bf16(Bt[n][k], At[m][k], acc[ai][bj][m][n], 0, 0, 0); __builtin_amdgcn_s_setprio(0); } while (0)
#define PG8_WAIT_V(n) asm volatile("s_waitcnt vmcnt(" #n ")" ::: "memory")
#define PG8_WAIT_L(n) asm volatile("s_waitcnt lgkmcnt(" #n ")" ::: "memory")
#define PG8_BAR __builtin_amdgcn_s_barrier()
#define PG8_SCHED __builtin_amdgcn_sched_barrier(0)
    Unit cur, nxt; int ui = 0;
    if (!S.next(0, cur)) return;
    f32x4 acc[2][2][4][2];
#pragma unroll
    for (int a = 0; a < 2; ++a)
#pragma unroll
        for (int b = 0; b < 2; ++b)
#pragma unroll
            for (int m = 0; m < 4; ++m)
#pragma unroll
                for (int n = 0; n < 2; ++n) acc[a][b][m][n] = (f32x4){0.f, 0.f, 0.f, 0.f};
    bf16x8 At[4][2], B0[2][2], B1[2][2];
    const char* cA = (const char*)g.A + (size_t)cur.pm * tstepA + cur.ao; const char* cB = (const char*)g.Bt + (size_t)cur.pn * tstep;
    S.a_ready(cur);
    if constexpr (SP2) {
        PG8_STAGE(PG8_SB(0, 0), cB, voffB); PG8_STAGE(PG8_SB(0, 1), cB + hstep, voffB); PG8_STAGE(PG8_SA(0, 0), cA, voffA); PG8_STAGE(PG8_SA(0, 1), cA + hstepA, voffA);
        if (wr == 1) PG8_BAR;
        PG8_WAIT_V(2); PG8_BAR;
        PG8_STAGE(PG8_SB(1, 0), cB + kstep, voffB); PG8_STAGE(PG8_SA(1, 0), cA + kstep, voffA); PG8_STAGE(PG8_SB(1, 1), cB + hstep + kstep, voffB);
        PG8_WAIT_V(6); PG8_BAR;
    } else {
        PG8_STAGE(PG8_SB(0, 0), cB, voffB); PG8_STAGE(PG8_SA(0, 0), cA, voffA); PG8_STAGE(PG8_SB(0, 1), cB + hstep, voffB); PG8_STAGE(PG8_SA(0, 1), cA + hstepA, voffA);
        if (wr == 1) PG8_BAR;
        PG8_WAIT_V(4); PG8_BAR;
        PG8_STAGE(PG8_SB(1, 0), cB + kstep, voffB); PG8_STAGE(PG8_SA(1, 0), cA + kstep, voffA); PG8_STAGE(PG8_SB(1, 1), cB + hstep + kstep, voffB);
        PG8_WAIT_V(6); PG8_BAR;
    }
    for (;;) {
        const bool has_next = S.next(ui + 1, nxt);
        const char* nA = has_next ? (const char*)g.A + (size_t)nxt.pm * tstepA + nxt.ao : cA; const char* nB = has_next ? (const char*)g.Bt + (size_t)nxt.pn * tstep : cB;
        for (int t = 0; t < nt; t += 2) {
            const bool last = (t == nt - 2);
            const char* a1 = cA + (size_t)(t + 1) * kstep;
            const char* a2 = last ? nA : cA + (size_t)(t + 2) * kstep; const char* b2 = last ? nB : cB + (size_t)(t + 2) * kstep;
            const char* a3 = a2 + kstep; const char* b3 = b2 + kstep;
            if (last && has_next) S.a_ready(nxt);
            if constexpr (SP2) {
            PG8_LDB(B0, 0, 0); PG8_LDB(B1, 0, 1); PG8_SCHED; PG8_LDA(At, 0, 0); PG8_STAGE(PG8_SA(1, 1), a1 + hstepA, voffA);
            PG8_WAIT_V(8); PG8_WAIT_L(0); PG8_BAR; PG8_MMA(0, 0, At, B0); PG8_MMA(0, 1, At, B1); PG8_BAR; PG8_SCHED;
            PG8_LDA(At, 0, 1); PG8_STAGE(PG8_SB(0, 0), b2, voffB); PG8_STAGE(PG8_SB(0, 1), b2 + hstep, voffB); PG8_STAGE(PG8_SA(0, 0), a2, voffA);
            PG8_WAIT_V(8); PG8_WAIT_L(0); PG8_BAR; PG8_MMA(1, 0, At, B0); PG8_MMA(1, 1, At, B1); PG8_BAR; PG8_SCHED;
            PG8_LDB(B0, 1, 0); PG8_LDB(B1, 1, 1); PG8_SCHED; PG8_LDA(At, 1, 0); PG8_STAGE(PG8_SA(0, 1), a2 + hstepA, voffA);
            PG8_WAIT_V(8); PG8_WAIT_L(0); PG8_BAR; PG8_MMA(0, 0, At, B0); PG8_MMA(0, 1, At, B1); PG8_BAR; PG8_SCHED;
            PG8_LDA(At, 1, 1); PG8_STAGE(PG8_SB(1, 0), b3, voffB); PG8_STAGE(PG8_SB(1, 1), b3 + hstep, voffB); PG8_STAGE(PG8_SA(1, 0), a3, voffA);
            PG8_WAIT_V(8); PG8_WAIT_L(0); PG8_BAR; PG8_MMA(1, 0, At, B0); PG8_MMA(1, 1, At, B1); PG8_BAR; PG8_SCHED;
            } else {
            PG8_LDB(B0, 0, 0); PG8_SCHED; PG8_LDA(At, 0, 0); PG8_STAGE(PG8_SA(1, 1), a1 + hstepA, voffA);
            PG8_WAIT_L(8); PG8_BAR; PG8_WAIT_L(0); PG8_MMA(0, 0, At, B0); PG8_BAR; PG8_SCHED;
            PG8_LDB(B1, 0, 1); PG8_STAGE(PG8_SB(0, 0), b2, voffB);
            PG8_BAR; PG8_WAIT_L(0); PG8_MMA(0, 1, At, B1); PG8_BAR;
            PG8_LDA(At, 0, 1); PG8_STAGE(PG8_SA(0, 0), a2, voffA);
            PG8_BAR; PG8_WAIT_L(0); PG8_MMA(1, 0, At, B0); PG8_BAR; PG8_SCHED;
            PG8_STAGE(PG8_SB(0, 1), b2 + hstep, voffB);
            PG8_WAIT_V(6); PG8_BAR; PG8_MMA(1, 1, At, B1); PG8_BAR;
            PG8_LDB(B0, 1, 0); PG8_SCHED; PG8_LDA(At, 1, 0); PG8_STAGE(PG8_SA(0, 1), a2 + hstepA, voffA);
            PG8_WAIT_L(8); PG8_BAR; PG8_WAIT_L(0); PG8_MMA(0, 0, At, B0); PG8_BAR; PG8_SCHED;
            PG8_LDB(B1, 1, 1); PG8_STAGE(PG8_SB(1, 0), b3, voffB);
            PG8_BAR; PG8_WAIT_L(0); PG8_MMA(0, 1, At, B1); PG8_BAR;
            PG8_LDA(At, 1, 1); PG8_STAGE(PG8_SA(1, 0), a3, voffA);
            PG8_BAR; PG8_WAIT_L(0); PG8_MMA(1, 0, At, B0); PG8_BAR; PG8_SCHED;
            PG8_STAGE(PG8_SB(1, 1), b3 + hstep, voffB);
            PG8_WAIT_V(6); PG8_BAR; PG8_MMA(1, 1, At, B1); PG8_BAR;
            }
        }
        if constexpr (ALIGN_EPI) { if (wr == 0) PG8_BAR; }
        if constexpr (!Epi::AFTER_DRAIN) { E(acc, cur, wr, wc, fr, fq); S.done(cur); }
        if (!has_next) break;
#pragma unroll
        for (int a = 0; a < 2; ++a)
#pragma unroll
            for (int b = 0; b < 2; ++b)
#pragma unroll
                for (int m = 0; m < 4; ++m)
#pragma unroll
                    for (int n = 0; n < 2; ++n) acc[a][b][m][n] = (f32x4){0.f, 0.f, 0.f, 0.f};
        cur = nxt; cA = nA; cB = nB; ++ui;
        if constexpr (ALIGN_EPI) { if (wr == 1) PG8_BAR; }
    }
    PG8_WAIT_V(0);
    if constexpr (!ALIGN_EPI) { if (wr == 0) PG8_BAR; }
    PG8_BAR;
    if constexpr (Epi::AFTER_DRAIN) { E.fused(acc, cur, wr, wc, fr, fq, lds, wid, lane); S.done(cur); }
#undef PG8_SA
#undef PG8_SB
#undef PG8_STAGE
#undef PG8_LDA
#undef PG8_LDB
#undef PG8_MMA
#undef PG8_WAIT_V
#undef PG8_WAIT_L
#undef PG8_BAR
#undef PG8_SCHED
}
}

template <class E> struct EpiAdapt { static constexpr bool PERM = false, AFTER_DRAIN = false; E e;
    __device__ __forceinline__ void operator()(const pg8::f32x4 (&acc)[2][2][4][2], const pg8::Unit& u, int wr, int wc, int fr, int fq) const { e(acc, 0, u.pm, u.pn, wr, wc, fr, fq); } };
template <class Epi>
__device__ __forceinline__ void gemm_stream(LAS unsigned char* lds, const bf16_t* A, const bf16_t* Bt, int N, int K, const Epi& E, int bid, int nb) {
    pg8::Gemm g{A, Bt, MTOK, N, K, K}; pg8::StaticOrder S; S.init(MTOK, N, nb, bid);
    EpiAdapt<Epi> ea{E};
    pg8::gemm_phase<EpiAdapt<Epi>, pg8::StaticOrder, true, true>(lds, g, S, ea);
}

#define EPI_LOOP(...) \
    _Pragma("unroll") for (int ai = 0; ai < 2; ++ai) _Pragma("unroll") for (int m = 0; m < 4; ++m) { asm volatile("" ::: "memory"); const int row = pm * 256 + ai * 128 + wr * 64 + m * 16 + fr; \
    _Pragma("unroll") for (int bj = 0; bj < 2; ++bj) _Pragma("unroll") for (int n = 0; n < 2; ++n) { const int ct = bj * 128 + wc * 32 + n * 16 + fq * 4; const f32x4 v = acc[ai][bj][m][n]; __VA_ARGS__ } }

struct EpiWin {
    bf16_t* UX; bf16_t* QKV;
    __device__ __forceinline__ void operator()(const f32x4 (&acc)[2][2][4][2], int gb, int pm, int pn, int wr, int wc, int fr, int fq) const {
        if (pn < 2) {
            bf16_t* base = UX + ((size_t)(pn * 16 + wc * 2) * 512 + (pm >> 4) * 128 + (pm & 15) * 8 + wr * 2) * 640 + fr * 16 + fq * 4;
#pragma unroll
            for (int ai = 0; ai < 2; ++ai)
#pragma unroll
                for (int m = 0; m < 4; ++m) { bf16_t* rp = base + (ai * 4 + (m >> 1)) * 640 + (m & 1) * 256;
#pragma unroll
                    for (int bj = 0; bj < 2; ++bj)
#pragma unroll
                        for (int n = 0; n < 2; ++n) { const f32x4 v = acc[ai][bj][m][n]; u32x2 w; w.x = pk2(v[0], v[1]); w.y = pk2(v[2], v[3]);
                            *(u32x2*)(rp + (size_t)(bj * 8 + n) * (512 * 640)) = w; }
                    asm volatile("" ::: "memory"); }
        } else { bf16_t* base = QKV + (size_t)((pn - 2) >> 1) * ((size_t)MTOK * 512) + (pn & 1) * 256 + (size_t)(pm * 256 + wr * 64 + fr) * 512 + wc * 32 + fq * 4;
#pragma unroll
            for (int ai = 0; ai < 2; ++ai)
#pragma unroll
                for (int m = 0; m < 4; ++m) { bf16_t* rp = base + (size_t)(ai * 128 + m * 16) * 512;
#pragma unroll
                    for (int bj = 0; bj < 2; ++bj)
#pragma unroll
                        for (int n = 0; n < 2; ++n) { const f32x4 v = acc[ai][bj][m][n]; u32x2 w; w.x = pk2(v[0], v[1]); w.y = pk2(v[2], v[3]);
                            *(u32x2*)(rp + bj * 128 + n * 16) = w; }
                    asm volatile("" ::: "memory"); }
        }
    }
};
struct EpiS5Z {
    float* Z;
    __device__ __forceinline__ void operator()(const f32x4 (&acc)[2][2][4][2], int gb, int pm, int pn, int wr, int wc, int fr, int fq) const {
        EPI_LOOP({ if (bj == 0) *(f32x4*)(Z + ((size_t)gb * 512 + row) * 128 + ct) = v; })
    }
};
struct EpiS5Y {
    const bf16_t* UX; bf16_t* YG; const float* dsk;
    __device__ __forceinline__ void operator()(const f32x4 (&acc)[2][2][4][2], int gb, int pm, int pn, int wr, int wc, int fr, int fq) const {
        EPI_LOOP({ const int col = pn * 256 + ct, t = col >> 4, h = col & 15, bb = row >> 7, cc = row & 127;
            const u32x2 uu = *(const u32x2*)(UX + ((size_t)gb * 512 + row) * 640 + col); const f32x4 dd = *(const f32x4*)(dsk + gb * 16 + h);
            u32x2 w; w.x = pk2(gelu_tanh(v[0] + dd[0] * bflo(uu.x)), gelu_tanh(v[1] + dd[1] * bfhi(uu.x))); w.y = pk2(gelu_tanh(v[2] + dd[2] * bflo(uu.y)), gelu_tanh(v[3] + dd[3] * bfhi(uu.y)));
            *(u32x2*)(YG + ((size_t)bb * SEQ + cc * 32 + t) * 512 + gb * 16 + h) = w; })
    }
};
struct PreS5Y {   static constexpr bool NOP = false;
    const float* Z; bf16_t* UX; const float* lam_re; const float* lam_im; const float* log_dt;
    __device__ __forceinline__ void operator()(int gb, int pm, int pn) const {
        const int tid = threadIdx.x;
        if (tid < 128) { const int pp = tid & 63, bb = 2 * pm + (tid >> 6);
            const float lr = lam_re[gb * 64 + pp], li = lam_im[gb * 64 + pp], dt = expf(log_dt[gb]);
            const float mag = expf(lr * dt * 32.f), ar = mag * cosf(li * dt * 32.f), ai = mag * sinf(li * dt * 32.f);
            const float* zp = Z + ((size_t)gb * 512 + bb * 128) * 128 + pp; bf16_t* xp = UX + ((size_t)gb * 512 + bb * 128) * 640 + 512 + pp;
            float xr = 0.f, xi = 0.f;
            for (int c0 = 0; c0 < 128; c0 += 16) { float zr[16], zi[16];
#pragma unroll
                for (int i = 0; i < 16; ++i) { zr[i] = zp[(size_t)(c0 + i) * 128]; zi[i] = zp[(size_t)(c0 + i) * 128 + 64]; }
#pragma unroll
                for (int i = 0; i < 16; ++i) { xp[(size_t)(c0 + i) * 640] = (bf16_t)f2bf(xr); xp[(size_t)(c0 + i) * 640 + 64] = (bf16_t)f2bf(xi);
                    const float nr = ar * xr - ai * xi + zr[i], ni = ar * xi + ai * xr + zi[i]; xr = nr; xi = ni; } } }
        __threadfence();
        asm volatile("s_waitcnt vmcnt(0)" ::: "memory");
        __syncthreads();
    }
};
struct EpiGlu {
    const bf16_t* YG; bf16_t* CAT;
    __device__ __forceinline__ void operator()(const f32x4 (&acc)[2][2][4][2], int gb, int pm, int pn, int wr, int wc, int fr, int fq) const {
        EPI_LOOP({ const int col = pn * 256 + ct; const u32x2 y = *(const u32x2*)(YG + (size_t)row * 512 + col);
            u32x2 w; w.x = pk2(bflo(y.x) * sigmoidf_(v[0]), bfhi(y.x) * sigmoidf_(v[1])); w.y = pk2(bflo(y.y) * sigmoidf_(v[2]), bfhi(y.y) * sigmoidf_(v[3]));
            *(u32x2*)(CAT + (size_t)row * 1024 + col) = w; })
    }
};
struct EpiRes {
    const float* res; float* out; const float* gate;
    __device__ __forceinline__ void operator()(const f32x4 (&acc)[2][2][4][2], int gb, int pm, int pn, int wr, int wc, int fr, int fq) const {
        const float* gatep = gate + (size_t)(pm >> 4) * 6144;
        EPI_LOOP({ const int col = pn * 256 + ct; const f32x4 g = *(const f32x4*)(gatep + col); const f32x4 r = *(const f32x4*)(res + (size_t)row * 1024 + col);
            *(f32x4*)(out + (size_t)row * 1024 + col) = r + g * v; })
    }
};
struct EpiSwiglu {
    bf16_t* HID;
    __device__ __forceinline__ void operator()(const f32x4 (&acc)[2][2][4][2], int gb, int pm, int pn, int wr, int wc, int fr, int fq) const {
#pragma unroll
        for (int ai = 0; ai < 2; ++ai)
#pragma unroll
            for (int m = 0; m < 4; ++m) { const int row = pm * 256 + ai * 128 + wr * 64 + m * 16 + fr;
#pragma unroll
                for (int n = 0; n < 2; ++n) { const f32x4 g = acc[ai][0][m][n], u = acc[ai][1][m][n]; float o[4];
#pragma unroll
                    for (int j = 0; j < 4; ++j) o[j] = g[j] * sigmoidf_(g[j]) * u[j];
                    u32x2 w; w.x = pk2(o[0], o[1]); w.y = pk2(o[2], o[3]);
                    *(u32x2*)(HID + (size_t)row * FF + pn * 128 + wc * 32 + n * 16 + fq * 4) = w; } }
    }
};
struct EpiRKV {
    bf16_t* RKV; int row0;
    __device__ __forceinline__ void operator()(const f32x4 (&acc)[2][2][4][2], int gb, int pm, int pn, int wr, int wc, int fr, int fq) const {
        bf16_t* base = RKV + (size_t)gb * ((size_t)MTOK * 1024) + (size_t)row0 * 1024 + pn * 256;
        EPI_LOOP({ u32x2 w; w.x = pk2(v[0], v[1]); w.y = pk2(v[2], v[3]); *(u32x2*)(base + (size_t)row * 1024 + ct) = w; })
    }
};
struct EpiL1 {
    bf16_t* L1; int row0;
    __device__ __forceinline__ void operator()(const f32x4 (&acc)[2][2][4][2], int gb, int pm, int pn, int wr, int wc, int fr, int fq) const {
        bf16_t* base = L1 + (size_t)(row0 + pm * 256 + wr * 64 + fr) * 256 + wc * 32 + fq * 4;
        const bool ident = (wc >= 2);
#pragma unroll
        for (int ai = 0; ai < 2; ++ai)
#pragma unroll
            for (int m = 0; m < 4; ++m) { bf16_t* rp = base + (size_t)(ai * 128 + m * 16) * 256;
#pragma unroll
                for (int bj = 0; bj < 2; ++bj) { const float sc = bj ? 1.f : 2.f, of = bj ? 0.f : -1.f;
#pragma unroll
                    for (int n = 0; n < 2; ++n) { const f32x4 v = acc[ai][bj][m][n]; float o[4];
#pragma unroll
                        for (int j = 0; j < 4; ++j) { const float sg = sc * __builtin_amdgcn_rcpf(1.f + __expf(-sc * v[j])) + of; o[j] = (bj == 0 && ident) ? v[j] : sg; }
                        u32x2 w; w.x = pk2(o[0], o[1]); w.y = pk2(o[2], o[3]); *(u32x2*)(rp + bj * 128 + n * 16) = w; } }
                asm volatile("" ::: "memory"); }
    }
};
struct EpiL2 {
    _Float16* DEC; bf16_t* AA; bf16_t* G; const float* w0; const float* a0;
    __device__ __forceinline__ void operator()(const f32x4 (&acc)[2][2][4][2], int gb, int pm, int pn, int wr, int wc, int fr, int fq) const {
        const int sel = pn >> 2, cb = (pn & 3) * 256;
        if (sel == 0) { EPI_LOOP({ const int col = cb + ct; const f32x4 w0v = *(const f32x4*)(w0 + col);
                _Pragma("unroll") for (int j = 0; j < 4; ++j) { const float z = w0v[j] + v[j]; const float sp = fmaxf(-z, 0.f) + __logf(1.f + __expf(-fabsf(z))); const float e = __expf(-sp - 0.5f);
                    const float omd = (e < 0.125f) ? e * (1.f - e * (0.5f - e * (0.16666667f - e * (0.041666668f - e * 0.0083333338f)))) : 1.f - __expf(-e);
                    DEC[(size_t)row * 1024 + col + j] = (_Float16)omd; } }) }
        else if (sel == 1) { EPI_LOOP({ const int col = cb + ct; const f32x4 a0v = *(const f32x4*)(a0 + col);
                u32x2 w; w.x = pk2(sigmoidf_(a0v[0] + v[0]), sigmoidf_(a0v[1] + v[1])); w.y = pk2(sigmoidf_(a0v[2] + v[2]), sigmoidf_(a0v[3] + v[3]));
                *(u32x2*)(AA + (size_t)row * 1024 + col) = w; }) }
        else { EPI_LOOP({ const int col = cb + ct; u32x2 w; w.x = pk2(v[0], v[1]); w.y = pk2(v[2], v[3]); *(u32x2*)(G + (size_t)row * 1024 + col) = w; }) }
    }
};


struct SchedRKV { int vb, vn;
    __device__ bool next(int i, pg8::Unit& u) const { const int t = vb + i * vn; if (vb < 0 || t >= 384) return false; u.pm = t & 31; u.pn = t >> 5; u.ao = (u.pn >> 2) * 2048; return true; }
    __device__ __forceinline__ void a_ready(const pg8::Unit&) const {}
    __device__ __forceinline__ void done(const pg8::Unit&) const {} };
struct SchedOne { int pm;
    __device__ bool next(int i, pg8::Unit& u) const { if (i > 0 || pm < 0) return false; u.pm = pm; u.pn = 0; u.ao = 0; return true; }
    __device__ __forceinline__ void a_ready(const pg8::Unit&) const {}
    __device__ __forceinline__ void done(const pg8::Unit&) const {} };
struct EpiAdaptRKV { static constexpr bool PERM = false, AFTER_DRAIN = false; EpiRKV e;
    __device__ __forceinline__ void operator()(const pg8::f32x4 (&acc)[2][2][4][2], const pg8::Unit& u, int wr, int wc, int fr, int fq) const { e(acc, u.pn >> 2, u.pm, u.pn & 3, wr, wc, fr, fq); } };
__device__ __forceinline__ void s5_gen(const Params& p, bf16_t* BtY, bf16_t* BtZ, float* lds, int bid, int nb) {
    float* PWr = lds; float* PWi = lds + 33 * 64; float* BBr = lds + 66 * 64; float* BBi = BBr + 1024; float* Cr = BBi + 1024; float* Ci = Cr + 1024; float* Kt = Ci + 1024;
    const int tid = threadIdx.x;
    for (int unit = bid; unit < 256; unit += nb) {
        const int g = unit >> 3, part = unit & 7;
        __syncthreads();
        { const float dt = expf(p.in[13][g]);
          for (int e = tid; e < 33 * 64; e += NTHR) { const int tau = e >> 6, pp = e & 63; const float lr = p.in[11][g * 64 + pp], li = p.in[12][g * 64 + pp];
              const float mag = expf(lr * dt * (float)tau), ang = li * dt * (float)tau; PWr[e] = mag * cosf(ang); PWi[e] = mag * sinf(ang); }
          __syncthreads();
          if (tid < 64) { const int pp = tid; const float lr = p.in[11][g * 64 + pp], li = p.in[12][g * 64 + pp];
              const float ar = PWr[64 + pp], ai = PWi[64 + pp], den = lr * lr + li * li, nr = ar - 1.f;
              const float qr = (nr * lr + ai * li) / den, qi = (ai * lr - nr * li) / den;
              for (int h = 0; h < 16; ++h) { const float br = p.in[14][(size_t)(g * 64 + pp) * 16 + h], bi = p.in[15][(size_t)(g * 64 + pp) * 16 + h]; BBr[pp * 16 + h] = qr * br - qi * bi; BBi[pp * 16 + h] = qr * bi + qi * br; } } }
        for (int i = tid; i < 1024; i += NTHR) { Cr[i] = p.in[16][(size_t)g * 1024 + i]; Ci[i] = p.in[17][(size_t)g * 1024 + i]; }
        __syncthreads();
        { const int tau = tid >> 4, h = tid & 15;
          float acc[16];
#pragma unroll
          for (int i = 0; i < 16; ++i) acc[i] = 0.f;
          for (int pp = 0; pp < 64; ++pp) { const float cr = Cr[h * 64 + pp], ci = Ci[h * 64 + pp], wr = PWr[tau * 64 + pp], wi = PWi[tau * 64 + pp];
              const float er = cr * wr - ci * wi, ei = cr * wi + ci * wr;
#pragma unroll
              for (int q = 0; q < 4; ++q) { const f32x4 br = *(const f32x4*)(BBr + pp * 16 + q * 4), bi = *(const f32x4*)(BBi + pp * 16 + q * 4);
#pragma unroll
                  for (int j = 0; j < 4; ++j) acc[q * 4 + j] += er * br[j] - ei * bi[j]; } }
#pragma unroll
          for (int q = 0; q < 4; ++q) *(f32x4*)(Kt + tau * 256 + h * 16 + q * 4) = (f32x4){acc[q * 4], acc[q * 4 + 1], acc[q * 4 + 2], acc[q * 4 + 3]}; }
        __syncthreads();
        for (int ci_ = tid; ci_ < 5120; ci_ += NTHR) { const int nrow = part * 64 + ci_ / 80, kc = (ci_ % 80) * 8, t = nrow >> 4, h = nrow & 15; float v[8];
#pragma unroll
            for (int i = 0; i < 8; ++i) { const int k = kc + i;
                if (k < 512) { const int sidx = k >> 4, h2 = k & 15; v[i] = (sidx <= t) ? Kt[(t - sidx) * 256 + h * 16 + h2] : 0.f; }
                else { const int jj = k - 512, pp = jj & 63; const float cr = Cr[h * 64 + pp], ci = Ci[h * 64 + pp], wr = PWr[(t + 1) * 64 + pp], wi = PWi[(t + 1) * 64 + pp];
                    v[i] = (jj >> 6) ? -(cr * wi + ci * wr) : (cr * wr - ci * wi); } }
            *(u32x4*)(BtY + ((size_t)g * 512 + nrow) * 640 + kc) = (u32x4){pk2(v[0], v[1]), pk2(v[2], v[3]), pk2(v[4], v[5]), pk2(v[6], v[7])}; }
        for (int ci_ = tid; ci_ < 1024; ci_ += NTHR) { const int n = part * 16 + (ci_ >> 6), kc = (ci_ & 63) * 8, pp = n & 63, im = n >> 6; float v[8];
#pragma unroll
            for (int i = 0; i < 8; ++i) { const int k = kc + i, sidx = k >> 4, h2 = k & 15, tau = 31 - sidx; const float wr = PWr[tau * 64 + pp], wi = PWi[tau * 64 + pp], br = BBr[pp * 16 + h2], bi = BBi[pp * 16 + h2];
                v[i] = im ? (wr * bi + wi * br) : (wr * br - wi * bi); }
            *(u32x4*)(BtZ + ((size_t)g * 256 + n) * 512 + kc) = (u32x4){pk2(v[0], v[1]), pk2(v[2], v[3]), pk2(v[4], v[5]), pk2(v[6], v[7])}; }
    }
    __syncthreads();
}

template <int MODE>
__device__ __forceinline__ void tr_job(const float* src, int K, int N, bf16_t* dst, int ldd, int row_off, int koff, const float* scale, float* lds, int bid, int nb, const float* scale2 = nullptr) {
    const int tk = K / 64, tn = N / 64, tid = threadIdx.x, nt_ = tk * tn;
    const int r = tid >> 3, c = (tid & 7) * 8;
    float4 a = {0.f, 0.f, 0.f, 0.f}, b = a; float sc = 1.f;
    if (bid < nt_) { const int k0 = (bid / tn) * 64, n0 = (bid % tn) * 64; const float* p = src + (size_t)(k0 + r) * N + n0 + c; a = *(const float4*)p; b = *(const float4*)(p + 4); sc = scale ? scale[k0 + r] - (scale2 ? scale2[k0 + r] : 0.f) : 1.f; }
    for (int t = bid; t < nt_; t += nb) {
        const int k0 = (t / tn) * 64, n0 = (t % tn) * 64;
        { float* l = lds + r * 65 + c; l[0] = a.x * sc; l[1] = a.y * sc; l[2] = a.z * sc; l[3] = a.w * sc; l[4] = b.x * sc; l[5] = b.y * sc; l[6] = b.z * sc; l[7] = b.w * sc; }
        if (t + nb < nt_) { const int t2 = t + nb, k2 = (t2 / tn) * 64, n2 = (t2 % tn) * 64; const float* p = src + (size_t)(k2 + r) * N + n2 + c; a = *(const float4*)p; b = *(const float4*)(p + 4); sc = scale ? scale[k2 + r] - (scale2 ? scale2[k2 + r] : 0.f) : 1.f; }
        __syncthreads();
        { const int nl = tid >> 3, kc = (tid & 7) * 8; float v[8];
#pragma unroll
          for (int i = 0; i < 8; ++i) v[i] = lds[(kc + i) * 65 + nl];
          int n = n0 + nl; int rowi = n;
          if (MODE == 1) rowi = (n >> 7) * 256 + (n & 127);
          if (MODE == 2) rowi = (n >> 7) * 256 + 128 + (n & 127);
          u32x4 w; w.x = pk2(v[0], v[1]); w.y = pk2(v[2], v[3]); w.z = pk2(v[4], v[5]); w.w = pk2(v[6], v[7]);
          *(u32x4*)(dst + (size_t)(row_off + rowi) * ldd + koff + k0 + kc) = w; }
        __syncthreads();
    }
}

__device__ __forceinline__ void prep_phase(const Params& p, float* lds, int bid, int nb) {
    unsigned char* ws = p.ws;
    s5_gen(p, (bf16_t*)(ws + OFF_BTY), (bf16_t*)(ws + OFF_BTZ), lds, bid, nb);
    tr_job<0>(p.in[10], 1024, 2048, (bf16_t*)(ws + OFF_WIN), 1024, 0, 0, nullptr, lds, bid, nb);
    tr_job<0>(p.in[19], 512, 512, (bf16_t*)(ws + OFF_WGLU), 512, 0, 0, nullptr, lds, bid, nb);
    tr_job<0>(p.in[27], 1024, 1024, (bf16_t*)(ws + OFF_WOUT), 1024, 0, 0, nullptr, lds, bid, nb);
    for (int l = 0; l < 2; ++l) {
        bf16_t* gu = (bf16_t*)(ws + (l ? OFF_WGU1 : OFF_WGU0)); bf16_t* dn = (bf16_t*)(ws + (l ? OFF_WDN1 : OFF_WDN0));
        tr_job<1>(p.in[7] + (size_t)l * 1024 * FF, 1024, FF, gu, 1024, 0, 0, nullptr, lds, bid, nb);
        tr_job<2>(p.in[8] + (size_t)l * 1024 * FF, 1024, FF, gu, 1024, 0, 0, nullptr, lds, bid, nb);
        tr_job<0>(p.in[9] + (size_t)l * FF * 1024, FF, 1024, dn, FF, 0, 0, nullptr, lds, bid, nb);
    }
    bf16_t* wrkv = (bf16_t*)(ws + OFF_WG1); bf16_t* wl1 = (bf16_t*)(ws + OFF_WL1); const float* mu = p.in[28];
    tr_job<0>(p.in[29], 1024, 1024, wrkv, 1024, 0, 0, nullptr, lds, bid, nb);
    tr_job<0>(p.in[30], 1024, 1024, wrkv, 1024, 1024, 0, nullptr, lds, bid, nb);
    tr_job<0>(p.in[31], 1024, 1024, wrkv, 1024, 2048, 0, nullptr, lds, bid, nb);
    tr_job<0>(p.in[34], 1024, 64, wl1, 2048, 0, 0, nullptr, lds, bid, nb);      tr_job<0>(p.in[34], 1024, 64, wl1, 2048, 0, 1024, mu + 1 * 1024, lds, bid, nb, mu + 3 * 1024);
    tr_job<0>(p.in[37], 1024, 64, wl1, 2048, 64, 0, nullptr, lds, bid, nb);     tr_job<0>(p.in[37], 1024, 64, wl1, 2048, 64, 1024, mu + 4 * 1024, lds, bid, nb, mu + 3 * 1024);
    tr_job<0>(p.in[39], 1024, 128, wl1, 2048, 128, 0, nullptr, lds, bid, nb);   tr_job<0>(p.in[39], 1024, 128, wl1, 2048, 128, 1024, mu + 5 * 1024, lds, bid, nb, mu + 3 * 1024);
    bf16_t* l2 = (bf16_t*)(ws + OFF_WL2);
    tr_job<0>(p.in[35], 64, 1024, l2, 256, 0, 0, nullptr, lds, bid, nb);
    tr_job<0>(p.in[38], 64, 1024, l2, 256, 1024, 64, nullptr, lds, bid, nb);
    tr_job<0>(p.in[40], 128, 1024, l2, 256, 2048, 128, nullptr, lds, bid, nb);
    for (int i = bid * NTHR + threadIdx.x; i < 3072 * 32; i += nb * NTHR) { const int n = i >> 5, kc = (i & 31) * 8; const int sel = n >> 10;
        const bool used = (sel == 0) ? (kc < 64) : (sel == 1) ? (kc >= 64 && kc < 128) : (kc >= 128);
        if (!used) *(u32x4*)(l2 + (size_t)n * 256 + kc) = (u32x4){0u, 0u, 0u, 0u}; }
    tr_job<0>(p.in[32], 1024, 1024, (bf16_t*)(ws + OFF_WO), 1024, 0, 0, nullptr, lds, bid, nb);
    {   const float* c = p.in[1]; const float* wada = p.in[3]; const float* bada = p.in[4]; float* mod = (float*)(ws + OFF_MOD);
        float* cact = lds;
        float* red = lds + 4096;
        for (int i = threadIdx.x; i < 4096; i += NTHR) { const float x = c[i]; cact[i] = x / (1.f + expf(-x)); }
        __syncthreads();
        const int col = threadIdx.x & 63, kg = threadIdx.x >> 6;
        for (int ch = bid; ch < 192; ch += nb) {
            const int l = ch / 96, n0 = (ch % 96) * 64;
            const float* wp = wada + (size_t)l * 1024 * 6144 + n0 + col;
            float a0 = 0.f, a1 = 0.f, a2 = 0.f, a3 = 0.f;
            for (int k = kg * 128; k < kg * 128 + 128; ++k) { const float w = wp[(size_t)k * 6144]; a0 += cact[k] * w; a1 += cact[1024 + k] * w; a2 += cact[2048 + k] * w; a3 += cact[3072 + k] * w; }
            red[(kg * 4 + 0) * 64 + col] = a0; red[(kg * 4 + 1) * 64 + col] = a1; red[(kg * 4 + 2) * 64 + col] = a2; red[(kg * 4 + 3) * 64 + col] = a3;
            __syncthreads();
            if (threadIdx.x < 256) { const int b = threadIdx.x >> 6; float s = 0.f;
#pragma unroll
                for (int g = 0; g < 8; ++g) s += red[(g * 4 + b) * 64 + col];
                mod[(size_t)(l * 4 + b) * 6144 + n0 + col] = s + bada[l * 6144 + n0 + col]; }
            __syncthreads();
        }
    }
}

template <bool RW>
__device__ __forceinline__ void norm_phase(const float* x, const float* g, const float* modl, int shift_off, int scale_off, bf16_t* out, int bid, int nb, int row0 = 0, int nrows = MTOK, const float* mu = nullptr) {
    const int wave = threadIdx.x >> 6, lane = threadIdx.x & 63;
    for (int row = row0 + bid * 8 + wave; row < row0 + nrows; row += nb * 8) {
        const int b = row >> 12; const float* xr = x + (size_t)row * 1024; const float* md = modl + (size_t)b * 6144;
        f32x4 v[4], vp[4]; float ss = 0.f, ssp = 0.f; const bool hasp = RW && ((row & 4095) != 0);
#pragma unroll
        for (int i = 0; i < 4; ++i) { v[i] = *(const f32x4*)(xr + i * 256 + lane * 4); ss += v[i][0] * v[i][0] + v[i][1] * v[i][1] + v[i][2] * v[i][2] + v[i][3] * v[i][3];
            if (RW) { vp[i] = hasp ? *(const f32x4*)(xr - 1024 + i * 256 + lane * 4) : (f32x4){0.f, 0.f, 0.f, 0.f}; ssp += vp[i][0] * vp[i][0] + vp[i][1] * vp[i][1] + vp[i][2] * vp[i][2] + vp[i][3] * vp[i][3]; } }
        ss = wave_sum(ss); const float rstd = rsqrtf(ss * (1.f / 1024.f) + 1e-6f);
        float rstdp = 0.f; if (RW) { ssp = wave_sum(ssp); rstdp = rsqrtf(ssp * (1.f / 1024.f) + 1e-6f); }
#pragma unroll
        for (int i = 0; i < 4; ++i) { const int c = i * 256 + lane * 4; const f32x4 gg = *(const f32x4*)(g + c), sc = *(const f32x4*)(md + scale_off + c), sh = *(const f32x4*)(md + shift_off + c);
            f32x4 h;
#pragma unroll
            for (int j = 0; j < 4; ++j) h[j] = v[i][j] * rstd * gg[j] * (1.f + sc[j]) + sh[j];
            if (!RW) { u32x2 w; w.x = pk2(h[0], h[1]); w.y = pk2(h[2], h[3]); *(u32x2*)(out + (size_t)row * 1024 + c) = w; }
            else { f32x4 d;
#pragma unroll
                for (int j = 0; j < 4; ++j) { const float hp = hasp ? (vp[i][j] * rstdp * gg[j] * (1.f + sc[j]) + sh[j]) : 0.f; d[j] = hp - h[j]; }
                const f32x4 mr = *(const f32x4*)(mu + c), mk = *(const f32x4*)(mu + 2048 + c), mv = *(const f32x4*)(mu + 3072 + c);
                const f32x4 xr_ = h + d * mr, xk_ = h + d * mk, xv_ = h + d * mv;
                bf16_t* o = out + (size_t)(row - row0) * 4096 + c;
                u32x2 w; w.x = pk2(xr_[0], xr_[1]); w.y = pk2(xr_[2], xr_[3]); *(u32x2*)(o) = w;
                w.x = pk2(xk_[0], xk_[1]); w.y = pk2(xk_[2], xk_[3]); *(u32x2*)(o + 1024) = w;
                w.x = pk2(xv_[0], xv_[1]); w.y = pk2(xv_[2], xv_[3]); *(u32x2*)(o + 2048) = w;
                w.x = pk2(d[0], d[1]); w.y = pk2(d[2], d[3]); *(u32x2*)(o + 3072) = w; } }
    }
}

__device__ __forceinline__ void qknorm_phase(bf16_t* Q, bf16_t* Kb, const int* pos, const float* qn, const float* kn, int bid, int nb) {
    const int wave = threadIdx.x >> 6, lane = threadIdx.x & 63, l16 = lane & 15, d0 = l16 * 4;
    float invf[4];
#pragma unroll
    for (int j = 0; j < 4; ++j) invf[j] = powf(500000.f, -(float)((l16 & 1) * 4 + j) / 8.f);
    const f32x4 qw = *(const f32x4*)(qn + d0), kw = *(const f32x4*)(kn + d0);
    for (int tok = bid * 8 + wave; tok < MTOK; tok += nb * 8) {
        const float ps = (float)pos[tok];
        float cs[4], sn[4];
#pragma unroll
        for (int j = 0; j < 4; ++j) { const float ang = ps * invf[j]; float rv = ang * 0.15915494309189535f; rv -= floorf(rv); cs[j] = __builtin_amdgcn_cosf(rv); sn[j] = __builtin_amdgcn_sinf(rv); }
#pragma unroll
        for (int bsel = 0; bsel < 2; ++bsel) { bf16_t* buf = bsel ? Kb : Q; const f32x4 w = bsel ? kw : qw;
#pragma unroll
            for (int it = 0; it < 2; ++it) { const int vec = it * 4 + (lane >> 4); bf16_t* ptr = buf + (size_t)tok * 512 + vec * 64 + d0;
                const u32x2 raw = *(const u32x2*)ptr; float y[4] = {bflo(raw.x), bfhi(raw.x), bflo(raw.y), bfhi(raw.y)};
                float ss = y[0] * y[0] + y[1] * y[1] + y[2] * y[2] + y[3] * y[3];
                ss = dpp_sum16(ss);
                const float rstd = rsqrtf(ss * (1.f / 64.f) + 1e-6f);
#pragma unroll
                for (int j = 0; j < 4; ++j) y[j] = y[j] * rstd * w[j];
                float pr[4];
#pragma unroll
                for (int j = 0; j < 4; ++j) pr[j] = __int_as_float(__builtin_amdgcn_update_dpp(0, __float_as_int(y[j]), 0x4E, 0xf, 0xf, true));
                if (l16 < 2) {
#pragma unroll
                    for (int j = 0; j < 4; ++j) y[j] = y[j] * cs[j] - pr[j] * sn[j]; }
                else if (l16 < 4) {
#pragma unroll
                    for (int j = 0; j < 4; ++j) y[j] = y[j] * cs[j] + pr[j] * sn[j]; }
                if (!bsel) {
#pragma unroll
                    for (int j = 0; j < 4; ++j) y[j] *= 0.125f * 1.4426950408889634f; }
                u32x2 o; o.x = pk2(y[0], y[1]); o.y = pk2(y[2], y[3]); *(u32x2*)ptr = o; } }
    }
}

__device__ __forceinline__ void vtrans_phase(const bf16_t* V, bf16_t* Vt, bf16_t* lds, int bid, int nb) {
    const int tid = threadIdx.x;
    for (int unit = bid; unit < 1024; unit += nb) {
        const int head = unit & 3, ch = unit >> 2; const int b = ch >> 6, t0 = (ch & 63) * 64;
#pragma unroll
        for (int i = 0; i < 2; ++i) { const int idx = tid + i * 512, t = idx >> 4, cc = (idx & 15) * 8;
            const u32x4 w = *(const u32x4*)(V + ((size_t)b * SEQ + t0 + t) * 512 + head * 128 + cc);
            unsigned* d = (unsigned*)(lds + t * 130 + cc); d[0] = w.x; d[1] = w.y; d[2] = w.z; d[3] = w.w; }
        __syncthreads();
        { const int e = tid >> 2, tc = (tid & 3) * 16; unsigned o[8];
#pragma unroll
          for (int i = 0; i < 8; ++i) o[i] = (unsigned)lds[(tc + 2 * i) * 130 + e] | ((unsigned)lds[(tc + 2 * i + 1) * 130 + e] << 16);
          u32x4* dst = (u32x4*)(Vt + ((size_t)(b * 4 + head) * 128 + e) * SEQ + t0 + tc);
          dst[0] = (u32x4){o[0], o[1], o[2], o[3]}; dst[1] = (u32x4){o[4], o[5], o[6], o[7]}; }
        __syncthreads();
    }
}

typedef float f32x16 __attribute__((ext_vector_type(16)));
__device__ __forceinline__ void attn_phase(const bf16_t* Q, const bf16_t* Kb, const bf16_t* Vt, bf16_t* CAT, const Params& p, LAS unsigned char* lds, int bid, int nb) {
    const int tid = threadIdx.x, wave = __builtin_amdgcn_readfirstlane(tid >> 6), lane = tid & 63, c = wave >> 2, wq = wave & 3, l32 = lane & 31, hh = lane >> 5;
    constexpr int KROW = 272, VROW = 144, KBUF = 64 * KROW, VBUF = 128 * VROW, VOFF = 2 * KBUF;
    const int lkey = tid >> 4, lkc = tid & 15, lve = tid >> 3, lvc = tid & 7;
    for (int unit = bid; unit < 256; unit += nb) {
        const int b = unit & 3, head = (unit >> 2) & 3, pr = unit >> 4;
        const bf16_t* kg = Kb + ((size_t)b * SEQ + lkey) * 512 + head * 128 + lkc * 8;
        const bf16_t* vg = Vt + ((size_t)(b * 4 + head) * 128 + lve) * SEQ + lvc * 8;
        for (int half = 0; half < 2; ++half) {
            const int qb = half ? (31 - pr) : pr; const int q0 = qb * 128 + wq * 32; const int nst = (qb + 1) * 2;
            bf16x8 qf[4];
            { const bf16_t* qp = Q + ((size_t)b * SEQ + q0 + l32) * 512 + head * 128 + c * 64 + hh * 8;
#pragma unroll
              for (int ks = 0; ks < 4; ++ks) qf[ks] = *(const bf16x8*)(qp + ks * 16); }
            f32x16 o[4];
#pragma unroll
            for (int blk = 0; blk < 4; ++blk)
#pragma unroll
                for (int r = 0; r < 16; ++r) o[blk][r] = 0.f;
            float mrow = -INFINITY, lsum = 0.f;
            u32x4 kreg[2][2], vreg[2][2];
#define AT_ISSUE(set, st) do { const int st_ = ((st) < nst) ? (st) : nst - 1; kreg[set][0] = *(const u32x4*)(kg + (size_t)(st_ * 64) * 512); kreg[set][1] = *(const u32x4*)(kg + (size_t)(st_ * 64 + 32) * 512); \
                               vreg[set][0] = *(const u32x4*)(vg + st_ * 64); vreg[set][1] = *(const u32x4*)(vg + (size_t)64 * SEQ + st_ * 64); } while (0)
#define AT_WRITE(set, slot) do { *(LAS u32x4*)(lds + (slot) * KBUF + lkey * KROW + lkc * 16) = kreg[set][0]; *(LAS u32x4*)(lds + (slot) * KBUF + (lkey + 32) * KROW + lkc * 16) = kreg[set][1]; \
                                 LAS u32x2* vd0 = (LAS u32x2*)(lds + VOFF + (slot) * VBUF + lve * VROW + (lvc >> 1) * 32 + (lvc & 1) * 8); vd0[0] = (u32x2){vreg[set][0].x, vreg[set][0].y}; vd0[2] = (u32x2){vreg[set][0].z, vreg[set][0].w}; \
                                 LAS u32x2* vd1 = (LAS u32x2*)(lds + VOFF + (slot) * VBUF + (lve + 64) * VROW + (lvc >> 1) * 32 + (lvc & 1) * 8); vd1[0] = (u32x2){vreg[set][1].x, vreg[set][1].y}; vd1[2] = (u32x2){vreg[set][1].z, vreg[set][1].w}; } while (0)
#define AT_PACK(dst, sv, base) do { u32x4 pw_; pw_.x = cvt_pk_bf16(sv[(base) + 0], sv[(base) + 1]); pw_.y = cvt_pk_bf16(sv[(base) + 2], sv[(base) + 3]); pw_.z = cvt_pk_bf16(sv[(base) + 4], sv[(base) + 5]); pw_.w = cvt_pk_bf16(sv[(base) + 6], sv[(base) + 7]); dst = __builtin_bit_cast(bf16x8, pw_); } while (0)
#define AT_COMPUTE(slot, st, kfa, kfb, vfa, vfb) do { const int key0 = (st) * 64; \
                if (key0 <= q0 + 31) { \
                    LAS unsigned char* kb = lds + (slot) * KBUF + l32 * KROW + c * 128 + hh * 16; \
                    LAS unsigned char* vb = lds + VOFF + (slot) * VBUF + l32 * VROW + hh * 16; \
                    f32x16 s0, s1; _Pragma("unroll") for (int r = 0; r < 16; ++r) { s0[r] = 0.f; s1[r] = 0.f; } \
                    kfa[0] = *(const LAS bf16x8*)(kb); kfa[1] = *(const LAS bf16x8*)(kb + 32 * KROW); kfa[2] = *(const LAS bf16x8*)(kb + 32); kfa[3] = *(const LAS bf16x8*)(kb + 32 * KROW + 32); \
                    kfb[0] = *(const LAS bf16x8*)(kb + 64); kfb[1] = *(const LAS bf16x8*)(kb + 32 * KROW + 64); kfb[2] = *(const LAS bf16x8*)(kb + 96); kfb[3] = *(const LAS bf16x8*)(kb + 32 * KROW + 96); \
                    __builtin_amdgcn_sched_barrier(0); \
                    s0 = __builtin_amdgcn_mfma_f32_32x32x16_bf16(kfa[0], qf[0], s0, 0, 0, 0); s1 = __builtin_amdgcn_mfma_f32_32x32x16_bf16(kfa[1], qf[0], s1, 0, 0, 0); \
                    s0 = __builtin_amdgcn_mfma_f32_32x32x16_bf16(kfa[2], qf[1], s0, 0, 0, 0); s1 = __builtin_amdgcn_mfma_f32_32x32x16_bf16(kfa[3], qf[1], s1, 0, 0, 0); \
                    s0 = __builtin_amdgcn_mfma_f32_32x32x16_bf16(kfb[0], qf[2], s0, 0, 0, 0); s1 = __builtin_amdgcn_mfma_f32_32x32x16_bf16(kfb[1], qf[2], s1, 0, 0, 0); \
                    s0 = __builtin_amdgcn_mfma_f32_32x32x16_bf16(kfb[2], qf[3], s0, 0, 0, 0); s1 = __builtin_amdgcn_mfma_f32_32x32x16_bf16(kfb[3], qf[3], s1, 0, 0, 0); \
                    _Pragma("unroll") for (int blk = 0; blk < 4; ++blk) vfa[blk] = *(const LAS bf16x8*)(vb + blk * 32 * VROW); \
                    _Pragma("unroll") for (int blk = 0; blk < 4; ++blk) vfb[blk] = *(const LAS bf16x8*)(vb + blk * 32 * VROW + 32); \
                    __builtin_amdgcn_sched_barrier(0); \
                    if (key0 + 63 > q0) { const int qrel = q0 + l32 - key0; \
                        _Pragma("unroll") for (int r = 0; r < 16; ++r) { const int kl = (r & 3) + 8 * (r >> 2) + 4 * hh; if (kl > qrel) s0[r] = -INFINITY; if (kl + 32 > qrel) s1[r] = -INFINITY; } } \
                    float tm = fmaxf(s0[0], s1[0]); _Pragma("unroll") for (int r = 1; r < 16; ++r) tm = fmaxf(tm, fmaxf(s0[r], s1[r])); \
                    tm = fmaxf(tm, __shfl_xor(tm, 32)); \
                    const float mnew = fmaxf(mrow, tm); \
                    if (__any(mnew > mrow + 6.f)) { const float al = __builtin_amdgcn_exp2f(mrow - mnew); lsum *= al; \
                        _Pragma("unroll") for (int blk = 0; blk < 4; ++blk) _Pragma("unroll") for (int r = 0; r < 16; ++r) o[blk][r] *= al; \
                        mrow = mnew; } \
                    float ps = 0.f; _Pragma("unroll") for (int r = 0; r < 16; ++r) { s0[r] = __builtin_amdgcn_exp2f(s0[r] - mrow); s1[r] = __builtin_amdgcn_exp2f(s1[r] - mrow); ps += s0[r] + s1[r]; } \
                    lsum += ps; \
                    bf16x8 pb0, pb1, pb2, pb3; AT_PACK(pb0, s0, 0); AT_PACK(pb1, s0, 8); AT_PACK(pb2, s1, 0); AT_PACK(pb3, s1, 8); \
                    __builtin_amdgcn_sched_barrier(0); \
                    _Pragma("unroll") for (int blk = 0; blk < 4; ++blk) o[blk] = __builtin_amdgcn_mfma_f32_32x32x16_bf16(vfa[blk], pb0, o[blk], 0, 0, 0); \
                    _Pragma("unroll") for (int blk = 0; blk < 4; ++blk) o[blk] = __builtin_amdgcn_mfma_f32_32x32x16_bf16(vfb[blk], pb1, o[blk], 0, 0, 0); \
                    __builtin_amdgcn_sched_barrier(0); \
                    _Pragma("unroll") for (int blk = 0; blk < 4; ++blk) kfa[blk] = *(const LAS bf16x8*)(vb + blk * 32 * VROW + 64); \
                    _Pragma("unroll") for (int blk = 0; blk < 4; ++blk) kfb[blk] = *(const LAS bf16x8*)(vb + blk * 32 * VROW + 96); \
                    __builtin_amdgcn_sched_barrier(0); \
                    _Pragma("unroll") for (int blk = 0; blk < 4; ++blk) o[blk] = __builtin_amdgcn_mfma_f32_32x32x16_bf16(kfa[blk], pb2, o[blk], 0, 0, 0); \
                    _Pragma("unroll") for (int blk = 0; blk < 4; ++blk) o[blk] = __builtin_amdgcn_mfma_f32_32x32x16_bf16(kfb[blk], pb3, o[blk], 0, 0, 0); \
                } } while (0)
            bf16x8 fr0[4], fr1[4], fr2[4], fr3[4];
            AT_ISSUE(0, 0); AT_ISSUE(1, 1);
            __syncthreads();
            AT_WRITE(0, 0);
            __syncthreads();
            for (int st = 0; st < nst; st += 2) {
                AT_ISSUE(0, st + 2);
                AT_COMPUTE(0, st, fr0, fr1, fr2, fr3);
                AT_WRITE(1, 1);
                __syncthreads();
                AT_ISSUE(1, st + 3);
                AT_COMPUTE(1, st + 1, fr2, fr3, fr0, fr1);
                AT_WRITE(0, 0);
                __syncthreads();
            }
            lsum += __shfl_xor(lsum, 32);
            const float inv = 1.f / lsum;
            LAS float* xo = (LAS float*)lds + (wq * 128 + 4 * hh) * 32 + l32;
            if (c == 1) {
#pragma unroll
                for (int blk = 0; blk < 4; ++blk)
#pragma unroll
                    for (int r = 0; r < 16; ++r) xo[(blk * 32 + (r & 3) + 8 * (r >> 2)) * 32] = o[blk][r] * inv; }
            __syncthreads();
            if (c == 0) { float ss = 0.f; float lam; { float s1 = 0.f, s2 = 0.f; for (int d = 0; d < 64; ++d) { s1 += p.in[22][d] * p.in[23][d]; s2 += p.in[24][d] * p.in[25][d]; } lam = expf(s1) - expf(s2) + 0.2f; }
                const float* subln = p.in[26];
#pragma unroll
                for (int blk = 0; blk < 4; ++blk)
#pragma unroll
                    for (int r = 0; r < 16; ++r) { const float v = o[blk][r] * inv - lam * xo[(blk * 32 + (r & 3) + 8 * (r >> 2)) * 32]; o[blk][r] = v; ss += v * v; }
                ss += __shfl_xor(ss, 32);
                const float rstd = rsqrtf(ss * (1.f / 128.f) + 1e-6f) * 0.8f;
                bf16_t* op = CAT + ((size_t)b * SEQ + q0 + l32) * 1024 + 512 + head * 128 + 4 * hh;
#pragma unroll
                for (int blk = 0; blk < 4; ++blk)
#pragma unroll
                    for (int g4 = 0; g4 < 4; ++g4) { const f32x4 sg = *(const f32x4*)(subln + blk * 32 + g4 * 8 + 4 * hh);
                        u32x2 w; w.x = pk2(o[blk][g4 * 4 + 0] * rstd * sg[0], o[blk][g4 * 4 + 1] * rstd * sg[1]); w.y = pk2(o[blk][g4 * 4 + 2] * rstd * sg[2], o[blk][g4 * 4 + 3] * rstd * sg[3]);
                        *(u32x2*)(op + blk * 32 + g4 * 8) = w; } }
        }
    }
}

__device__ __forceinline__ void attn_combine(const bf16_t* OC, bf16_t* CAT, const Params& p, int bid, int nb) {
    const int wave = threadIdx.x >> 6, lane = threadIdx.x & 63, head = lane >> 4, e0 = (lane & 15) * 8;
    float lam;
    { float s1 = 0.f, s2 = 0.f; for (int d = 0; d < 64; ++d) { s1 += p.in[22][d] * p.in[23][d]; s2 += p.in[24][d] * p.in[25][d]; } lam = expf(s1) - expf(s2) + 0.2f; }
    float sub[8];
#pragma unroll
    for (int i = 0; i < 8; ++i) sub[i] = p.in[26][e0 + i] * 0.8f;
    for (int tok = bid * 8 + wave; tok < MTOK; tok += nb * 8) {
        const u32x4 a = *(const u32x4*)(OC + (size_t)tok * 1024 + (head * 2) * 128 + e0), bb = *(const u32x4*)(OC + (size_t)tok * 1024 + (head * 2 + 1) * 128 + e0);
        float o[8] = {bflo(a.x) - lam * bflo(bb.x), bfhi(a.x) - lam * bfhi(bb.x), bflo(a.y) - lam * bflo(bb.y), bfhi(a.y) - lam * bfhi(bb.y),
                      bflo(a.z) - lam * bflo(bb.z), bfhi(a.z) - lam * bfhi(bb.z), bflo(a.w) - lam * bflo(bb.w), bfhi(a.w) - lam * bfhi(bb.w)};
        float ss = 0.f;
#pragma unroll
        for (int i = 0; i < 8; ++i) ss += o[i] * o[i];
        ss = dpp_sum16(ss);
        const float rstd = rsqrtf(ss * (1.f / 128.f) + 1e-6f);
        u32x4 w; w.x = pk2(o[0] * rstd * sub[0], o[1] * rstd * sub[1]); w.y = pk2(o[2] * rstd * sub[2], o[3] * rstd * sub[3]); w.z = pk2(o[4] * rstd * sub[4], o[5] * rstd * sub[5]); w.w = pk2(o[6] * rstd * sub[6], o[7] * rstd * sub[7]);
        *(u32x4*)(CAT + (size_t)tok * 1024 + 512 + head * 128 + e0) = w;
    }
}

typedef float f32x2 __attribute__((ext_vector_type(2)));
__device__ __forceinline__ float h2f_(unsigned bits) { return (float)__builtin_bit_cast(_Float16, (unsigned short)bits); }
__device__ __forceinline__ void rwkv_phase(const Params& p, const bf16_t* R, const bf16_t* Kk, const bf16_t* Vv, const _Float16* DEC, const bf16_t* AA, bf16_t* Y, float* lds, int bid, int nb) {
    const int tid = threadIdx.x, wave = __builtin_amdgcn_readfirstlane(tid >> 6), lane = tid & 63;
    constexpr int TCH = 16, BUFF = 5 * TCH * 64 + TCH * 16;
    constexpr int OBUF = TCH * 16 * 16;
    float* Lout = lds + 2 * BUFF;
    for (int unit = bid; unit < 256; unit += nb) {
        const int b = unit >> 6, h = (unit >> 2) & 15, rq = unit & 3;
        __syncthreads();
        if (wave >= 4) {
            const int pw = wave - 4, tl = lane >> 4, c4 = (lane & 15) * 4;
            const f32x4 kkw = *(const f32x4*)(p.in[41] + h * 64 + c4), kaw = *(const f32x4*)(p.in[42] + h * 64 + c4);
            u32x2 rr[4], kr[4], ar[4], dr[4], vr[4];
            const unsigned lofs = (unsigned)((pw * 4 + tl) * 1024 + h * 64 + c4), vofs = (unsigned)((pw * 4 + tl) * 1024 + h * 64 + rq * 16 + (lane & 3) * 4);
            const bf16_t* Rb = R + (size_t)b * SEQ * 1024; const bf16_t* Kb_ = Kk + (size_t)b * SEQ * 1024; const bf16_t* Vb = Vv + (size_t)b * SEQ * 1024;
            const bf16_t* Ab = AA + (size_t)b * SEQ * 1024; const _Float16* Db = DEC + (size_t)b * SEQ * 1024;
#define RW_ISSUE(set, ch) do { const unsigned o_ = (unsigned)(ch) * (TCH * 1024) + lofs; rr[set] = *(const u32x2*)(Rb + o_); kr[set] = *(const u32x2*)(Kb_ + o_); dr[set] = *(const u32x2*)(Db + o_); ar[set] = *(const u32x2*)(Ab + o_); \
                    vr[set] = *(const u32x2*)(Vb + (unsigned)(ch) * (TCH * 1024) + vofs); } while (0)
#define RW_STAGE(set, buf) do { float* L = lds + (buf) * BUFF + (pw * 4 + tl) * 64 + c4; \
                    const f32x4 k = {bflo(kr[set].x), bfhi(kr[set].x), bflo(kr[set].y), bfhi(kr[set].y)}, a = {bflo(ar[set].x), bfhi(ar[set].x), bflo(ar[set].y), bfhi(ar[set].y)}; \
                    const f32x4 r = {bflo(rr[set].x), bfhi(rr[set].x), bflo(rr[set].y), bfhi(rr[set].y)}; \
                    const f32x4 w = {1.f - h2f_(dr[set].x & 0xffffu), 1.f - h2f_(dr[set].x >> 16), 1.f - h2f_(dr[set].y & 0xffffu), 1.f - h2f_(dr[set].y >> 16)}; \
                    f32x4 kk = k * kkw; const float n2 = dpp_sum16((kk[0] * kk[0] + kk[1] * kk[1]) + (kk[2] * kk[2] + kk[3] * kk[3])); kk = kk * __frsqrt_rn(fmaxf(n2, 1e-24f)); \
                    *(f32x4*)(L) = w; *(f32x4*)(L + 1 * TCH * 64) = -kk; *(f32x4*)(L + 2 * TCH * 64) = kk * a; *(f32x4*)(L + 3 * TCH * 64) = k * (1.f + (a - 1.f) * kaw); *(f32x4*)(L + 4 * TCH * 64) = r; \
                    if ((lane & 15) < 4) *(f32x4*)(lds + (buf) * BUFF + 5 * TCH * 64 + (pw * 4 + tl) * 16 + (lane & 3) * 4) = (f32x4){bflo(vr[set].x), bfhi(vr[set].x), bflo(vr[set].y), bfhi(vr[set].y)}; } while (0)
            auto flush = [&](int ch) { const int i = tid - 256, tt = i >> 4, row = i & 15; const f32x4* pp = (const f32x4*)(Lout + (ch & 1) * OBUF + i * 16);
                const f32x4 s4 = pp[0] + pp[1] + pp[2] + pp[3];
                Y[((size_t)b * SEQ + ch * TCH + tt) * 1024 + h * 64 + rq * 16 + row] = (bf16_t)f2bf((s4[0] + s4[1]) + (s4[2] + s4[3])); };
            constexpr int NCH = SEQ / TCH;
            RW_ISSUE(0, 0); RW_ISSUE(1, 1); RW_ISSUE(2, 2); RW_ISSUE(3, 3);
            RW_STAGE(0, 0);
            __syncthreads();
            for (int c4_ = 0; c4_ < NCH; c4_ += 4) {
#define RW_ITER(q) do { const int ch = c4_ + (q); RW_STAGE(((q) + 1) & 3, (ch + 1) & 1); { const int chn = (ch + 4 < NCH) ? ch + 4 : NCH - 1; RW_ISSUE((q), chn); } flush(ch > 0 ? ch - 1 : 0); __syncthreads(); } while (0)
                RW_ITER(0); RW_ITER(1); RW_ITER(2); RW_ITER(3);
            }
            flush(NCH - 1);
        } else {
            const int j = lane & 15, rowl = wave * 4 + (lane >> 4);
            f32x2 S01 = {0.f, 0.f}, S23 = {0.f, 0.f};
            __syncthreads();
            for (int ch = 0; ch < SEQ / TCH; ++ch) {
                const float* L = lds + (ch & 1) * BUFF + j * 4; const float* Lv = lds + (ch & 1) * BUFF + 5 * TCH * 64 + rowl; float* Lo = Lout + (ch & 1) * OBUF + rowl * 16 + j;
                f32x4 w4 = *(const f32x4*)(L), a4 = *(const f32x4*)(L + 1 * TCH * 64), b4 = *(const f32x4*)(L + 2 * TCH * 64), k4 = *(const f32x4*)(L + 3 * TCH * 64), r4 = *(const f32x4*)(L + 4 * TCH * 64);
                float vv = Lv[0];
#pragma unroll
                for (int tt = 0; tt < TCH; ++tt) {
                    f32x4 nw4 = w4, na4 = a4, nb4 = b4, nk4 = k4, nr4 = r4; float nvv = vv;
                    if (tt + 1 < TCH) { const float* Ln = L + (tt + 1) * 64; nw4 = *(const f32x4*)(Ln); na4 = *(const f32x4*)(Ln + 1 * TCH * 64); nb4 = *(const f32x4*)(Ln + 2 * TCH * 64); nk4 = *(const f32x4*)(Ln + 3 * TCH * 64); nr4 = *(const f32x4*)(Ln + 4 * TCH * 64); nvv = Lv[(tt + 1) * 16]; }
                    f32x2 d = S01 * (f32x2){a4[0], a4[1]}; d = S23 * (f32x2){a4[2], a4[3]} + d;
                    const float sa = dpp_sum16(d[0] + d[1]);
                    const f32x2 sa2 = {sa, sa}, v2 = {vv, vv};
                    const f32x2 t01 = sa2 * (f32x2){b4[0], b4[1]} + v2 * (f32x2){k4[0], k4[1]}, t23 = sa2 * (f32x2){b4[2], b4[3]} + v2 * (f32x2){k4[2], k4[3]};
                    S01 = S01 * (f32x2){w4[0], w4[1]} + t01; S23 = S23 * (f32x2){w4[2], w4[3]} + t23;
                    f32x2 y = S01 * (f32x2){r4[0], r4[1]}; y = S23 * (f32x2){r4[2], r4[3]} + y;
                    Lo[tt * 256] = y[0] + y[1];
                    w4 = nw4; a4 = na4; b4 = nb4; k4 = nk4; r4 = nr4; vv = nvv;
                }
                __syncthreads();
            }
        }
    }
}

__device__ __forceinline__ void rwkv_post(const Params& p, bf16_t* R, const bf16_t* Kk, const bf16_t* Vv, const bf16_t* AA, const bf16_t* G, const bf16_t* Y, int bid, int nb) {
    const int wave = threadIdx.x >> 6, lane = threadIdx.x & 63;
    for (int it = bid * 8 + wave; it < MTOK * 16; it += nb * 8) {
        const int h = it & 15; const size_t off = (size_t)(it >> 4) * 1024 + h * 64 + lane;
        const float y = bf2f(Y[off]), r = bf2f(R[off]), k = bf2f(Kk[off]), v = bf2f(Vv[off]), a = bf2f(AA[off]), g = bf2f(G[off]);
        const float mean = wave_sum(y) * (1.f / 64.f); const float d = y - mean; const float var = wave_sum(d * d) * (1.f / 64.f);
        const float k2 = k * (1.f + (a - 1.f) * p.in[42][h * 64 + lane]);
        const float sb = wave_sum(r * k2 * p.in[43][h * 64 + lane]);
        const float yn = d * rsqrtf(var + 64e-5f) * p.in[44][h * 64 + lane] + p.in[45][h * 64 + lane] + sb * v;
        R[off] = (bf16_t)f2bf(yn * g);
    }
}

#define XB_TMO      128
#define XB_XCNT(j)  (256  + 64 * (j))
#define XB_XSUB(j)  (1280 + 64 * (j))
#define XB_XGEN(j)  (2304 + 64 * (j))
#define XB_TOP      3328
#define XB_TOPGEN   3392
#define XCD_BAR_WORDS 3456
#define XB_SPIN_CAP (1u << 18)
__device__ __forceinline__ unsigned xb_ld(unsigned* p)              { return __hip_atomic_load(p, __ATOMIC_RELAXED, __HIP_MEMORY_SCOPE_AGENT); }
__device__ __forceinline__ unsigned xb_add(unsigned* p, unsigned v) { return __hip_atomic_fetch_add(p, v, __ATOMIC_RELAXED, __HIP_MEMORY_SCOPE_AGENT); }
__device__ __forceinline__ unsigned xb_xcc_id() { return (unsigned)__builtin_amdgcn_s_getreg((3 << 11) | 20) & 0xFu; }
#define XB_SPIN(cond, bar) do { unsigned _sp = 0; while (cond) { __builtin_amdgcn_s_sleep(1); \
    if ((++_sp & 255u) == 0u) { if (xb_ld(&(bar)[XB_TMO])) break; if (_sp > XB_SPIN_CAP) { atomicAdd(&(bar)[XB_TMO], 1u); break; } } } } while (0)
struct XcdBarrier { unsigned* bar; unsigned x; volatile LAS unsigned* st; };
__device__ __forceinline__ XcdBarrier xcd_barrier_post(unsigned* bar, volatile LAS unsigned* st) {
    XcdBarrier b; b.bar = bar; b.x = xb_xcc_id(); b.st = st;
    if (threadIdx.x == 0) (void)xb_add(&bar[XB_XCNT(b.x)], 1u);
    return b;
}
__device__ __forceinline__ void xcd_barrier_complete(unsigned* bar, unsigned x, unsigned& nloc, unsigned& nx) {
    const unsigned G = gridDim.x * gridDim.y * gridDim.z;
    unsigned sum, cnt, mine, sp = 0u;
    for (;;) {
        sum = 0u; cnt = 0u; mine = 0u;
#pragma unroll
        for (unsigned j = 0; j < 16; ++j) { const unsigned c = xb_ld(&bar[XB_XCNT(j)]); sum += c; cnt += (c > 0u) ? 1u : 0u; mine = (j == x) ? c : mine; }
        if (sum == G) break;
        __builtin_amdgcn_s_sleep(1);
        if ((++sp & 255u) == 0u) { if (xb_ld(&bar[XB_TMO])) break; if (sp > XB_SPIN_CAP) { atomicAdd(&bar[XB_TMO], 1u); break; } }
    }
    nloc = mine > 0u ? mine : 1u; nx = cnt > 0u ? cnt : 1u;
}
__device__ __forceinline__ void xcd_barrier(const XcdBarrier& b) {
    asm volatile("s_waitcnt vmcnt(0)" ::: "memory");
    __syncthreads();
    if (threadIdx.x == 0) {
        unsigned* bar = b.bar;
        __builtin_amdgcn_s_waitcnt(0);
        unsigned nloc = b.st[0], nx = b.st[1];
        if (nloc == 0u) { xcd_barrier_complete(bar, b.x, nloc, nx); b.st[0] = nloc; b.st[1] = nx; }
        const unsigned old = xb_add(&bar[XB_XSUB(b.x)], 1u);
        const unsigned gen = old / nloc;
        if (old + 1u == (gen + 1u) * nloc) {
            __builtin_amdgcn_fence(__ATOMIC_RELEASE, "agent");
            asm volatile("s_waitcnt vmcnt(0)" ::: "memory");
            const unsigned og = xb_add(&bar[XB_TOP], 1u);
            const unsigned tg = og / nx;
            if (og + 1u == (tg + 1u) * nx) xb_add(&bar[XB_TOPGEN], 1u);
            else XB_SPIN(xb_ld(&bar[XB_TOPGEN]) == tg, bar);
            __builtin_amdgcn_fence(__ATOMIC_ACQUIRE, "agent");
            xb_add(&bar[XB_XGEN(b.x)], 1u);
            asm volatile("s_waitcnt vmcnt(0)" ::: "memory");
        } else {
            XB_SPIN(xb_ld(&bar[XB_XGEN(b.x)]) == gen, bar);
            __builtin_amdgcn_fence(__ATOMIC_ACQUIRE, "agent");
            asm volatile("s_waitcnt vmcnt(0)" ::: "memory");
        }
    }
    __syncthreads();
}

__global__ void __launch_bounds__(NTHR) fwd_kernel(Params p) {
    extern __shared__ __attribute__((aligned(16))) unsigned char lds_raw[];
    LAS unsigned char* lds = (LAS unsigned char*)lds_raw;
    float* ldsf = (float*)lds_raw;
    const int bid = blockIdx.x, nb = gridDim.x;
    unsigned char* ws = p.ws;
    float* mod = (float*)(ws + OFF_MOD);
    const bool multi = (p.ph_hi - p.ph_lo) > 1;
    __shared__ unsigned xb_st[4];
    if (threadIdx.x < 4) xb_st[threadIdx.x] = 0u;
    __syncthreads();
    XcdBarrier xbar; xbar.bar = (unsigned*)(ws + OFF_BAR); xbar.x = 0; xbar.st = (volatile LAS unsigned*)xb_st;
    if (multi) xbar = xcd_barrier_post((unsigned*)(ws + OFF_BAR), (volatile LAS unsigned*)xb_st);
#ifndef TESTPH
#define TESTPH -1
#endif
#ifndef REPEAT_A
#define REPEAT_A -1
#endif
#ifndef REPEAT_B
#define REPEAT_B -1
#endif
#ifndef EXTRA_SYNCS
#define EXTRA_SYNCS 0
#endif
#define PH(k) if ((TESTPH < 0 || TESTPH == (k)) && p.ph_lo <= (k) && (k) < p.ph_hi) for (int rep_ = 0; rep_ < (((k) == REPEAT_A || (k) == REPEAT_B) ? 2 : 1); ++rep_)
#define SYNC(k) if (multi) { xcd_barrier(xbar); }
    for (int es_ = 0; es_ < EXTRA_SYNCS; ++es_) cg::this_grid().sync();
    if (p.ph_lo < -1000) cg::this_grid().sync();
    PH(0) { prep_phase(p, ldsf, bid, nb); SYNC(0) }
    PH(1) { norm_phase<false>(p.in[0], p.in[5], mod, 0, 1024, (bf16_t*)(ws + OFF_HA), bid, nb); SYNC(1) }
    PH(2) { EpiWin e{(bf16_t*)(ws + OFF_UX), (bf16_t*)(ws + OFF_QKV)}; gemm_stream(lds, (const bf16_t*)(ws + OFF_HA), (const bf16_t*)(ws + OFF_WIN), 2048, 1024, e, bid, nb); SYNC(2) }
    PH(3) { { EpiS5Z e{(float*)(ws + OFF_Z)}; gemm_batched(lds, (const bf16_t*)(ws + OFF_UX), 640, (size_t)512 * 640, (const bf16_t*)(ws + OFF_BTZ), (size_t)256 * 512, 2, 1, 32, 512, e, NoPre{}, bid, nb); }
            bf16_t* q = (bf16_t*)(ws + OFF_QKV); qknorm_phase(q, q + (size_t)MTOK * 512, (const int*)p.in[2], p.in[20], p.in[21], bid, nb);
            vtrans_phase(q + (size_t)MTOK * 1024, (bf16_t*)(ws + OFF_VT), (bf16_t*)lds_raw, bid, nb); SYNC(3) }
    PH(5) { { EpiS5Y e{(const bf16_t*)(ws + OFF_UX), (bf16_t*)(ws + OFF_YG), p.in[18]}; PreS5Y pre{(const float*)(ws + OFF_Z), (bf16_t*)(ws + OFF_UX), p.in[11], p.in[12], p.in[13]};
              gemm_batched(lds, (const bf16_t*)(ws + OFF_UX), 640, (size_t)512 * 640, (const bf16_t*)(ws + OFF_BTY), (size_t)512 * 640, 2, 2, 32, 640, e, pre, bid, nb); }
            bf16_t* q = (bf16_t*)(ws + OFF_QKV); attn_phase(q, q + (size_t)MTOK * 512, (const bf16_t*)(ws + OFF_VT), (bf16_t*)(ws + OFF_CAT), p, lds, bid, nb); SYNC(5) }
    PH(6) {
            EpiGlu e{(const bf16_t*)(ws + OFF_YG), (bf16_t*)(ws + OFF_CAT)}; gemm_phase(lds, (const bf16_t*)(ws + OFF_YG), (const bf16_t*)(ws + OFF_WGLU), 512, 512, e, bid, nb); SYNC(6) }
    PH(7) { EpiRes e{p.in[0], p.out, mod + 2048}; gemm_stream(lds, (const bf16_t*)(ws + OFF_CAT), (const bf16_t*)(ws + OFF_WOUT), 1024, 1024, e, bid, nb); SYNC(7) }
    PH(8) { norm_phase<false>(p.out, p.in[6], mod, 3072, 4096, (bf16_t*)(ws + OFF_HA), bid, nb); SYNC(8) }
    PH(9) { EpiSwiglu e{(bf16_t*)(ws + OFF_HID)}; gemm_stream(lds, (const bf16_t*)(ws + OFF_HA), (const bf16_t*)(ws + OFF_WGU0), 5632, 1024, e, bid, nb); SYNC(9) }
    PH(10) { EpiRes e{p.out, p.out, mod + 5120}; gemm_stream(lds, (const bf16_t*)(ws + OFF_HID), (const bf16_t*)(ws + OFF_WDN0), 1024, FF, e, bid, nb); SYNC(10) }
    const float* mod1 = mod + 4 * 6144;
#define RWKV_FRONT(PA, PB, ROW0) \
    PH(PA) { norm_phase<true>(p.out, p.in[5] + 1024, mod1, 0, 1024, (bf16_t*)(ws + OFF_HD), bid, nb, (ROW0), 8192, p.in[28]); SYNC(PA) } \
    PH(PB) { const bf16_t* xall = (const bf16_t*)(ws + OFF_HD); const bool split = (nb == 256); \
               \
             { pg8::Gemm g{xall + 2048, (const bf16_t*)(ws + OFF_WL1), 8192, 256, 2048, 4096}; SchedOne S{(bid < 32) ? bid : -1}; EpiAdapt<EpiL1> ea{EpiL1{(bf16_t*)(ws + OFF_L1), (ROW0)}}; \
               pg8::gemm_phase<EpiAdapt<EpiL1>, SchedOne, false, true>(lds, g, S, ea); } \
             { pg8::Gemm g{xall, (const bf16_t*)(ws + OFF_WG1), 8192, 3072, 1024, 4096}; SchedRKV S{split ? bid - 32 : bid, split ? 224 : nb}; EpiAdaptRKV ea{EpiRKV{(bf16_t*)(ws + OFF_RKV), (ROW0)}}; \
               pg8::gemm_phase<EpiAdaptRKV, SchedRKV, true, true>(lds, g, S, ea); } \
             SYNC(PB) }
    RWKV_FRONT(11, 12, 0)
    RWKV_FRONT(20, 21, 8192)
    PH(13) { EpiL2 e{(_Float16*)(ws + OFF_DEC), (bf16_t*)(ws + OFF_AA), (bf16_t*)(ws + OFF_G), p.in[33], p.in[36]}; gemm_stream(lds, (const bf16_t*)(ws + OFF_L1), (const bf16_t*)(ws + OFF_WL2), 3072, 256, e, bid, nb); SYNC(13) }
    PH(14) { const bf16_t* r = (const bf16_t*)(ws + OFF_RKV); rwkv_phase(p, r, r + (size_t)MTOK * 1024, r + (size_t)MTOK * 2048, (const _Float16*)(ws + OFF_DEC), (const bf16_t*)(ws + OFF_AA), (bf16_t*)(ws + OFF_Y), ldsf, bid, nb); SYNC(14) }
    PH(15) { bf16_t* r = (bf16_t*)(ws + OFF_RKV); rwkv_post(p, r, r + (size_t)MTOK * 1024, r + (size_t)MTOK * 2048, (const bf16_t*)(ws + OFF_AA), (const bf16_t*)(ws + OFF_G), (const bf16_t*)(ws + OFF_Y), bid, nb); SYNC(15) }
    PH(16) { EpiRes e{p.out, p.out, mod1 + 2048}; gemm_stream(lds, (const bf16_t*)(ws + OFF_RKV), (const bf16_t*)(ws + OFF_WO), 1024, 1024, e, bid, nb); SYNC(16) }
    PH(17) { norm_phase<false>(p.out, p.in[6] + 1024, mod1, 3072, 4096, (bf16_t*)(ws + OFF_HA), bid, nb); SYNC(17) }
    PH(18) { EpiSwiglu e{(bf16_t*)(ws + OFF_HID)}; gemm_stream(lds, (const bf16_t*)(ws + OFF_HA), (const bf16_t*)(ws + OFF_WGU1), 5632, 1024, e, bid, nb); SYNC(18) }
    PH(19) { EpiRes e{p.out, p.out, mod1 + 5120}; gemm_stream(lds, (const bf16_t*)(ws + OFF_HID), (const bf16_t*)(ws + OFF_WDN1), 1024, FF, e, bid, nb); }
}

constexpr int NPHASE = 22;
#ifndef ONE_LAUNCH
#define ONE_LAUNCH 1
#endif

extern "C" void kernel_launch(void* const* d_in, const int* in_sizes, int n_in, void* d_out, int out_size, void* d_ws, size_t ws_size, hipStream_t stream) {
    static int grid = 0;
    if (grid == 0) {
        if (n_in != 46 || ws_size < WS_NEED) { fprintf(stderr, "kernel_launch: unexpected n_in %d / ws_size %zu (need %zu)\n", n_in, ws_size, (size_t)WS_NEED); grid = -1; return; }
        if (hipFuncSetAttribute((const void*)fwd_kernel, hipFuncAttributeMaxDynamicSharedMemorySize, LDS_BYTES) != hipSuccess) { fprintf(stderr, "hipFuncSetAttribute failed\n"); grid = -1; return; }
        int dev = 0, cus = 0, per_cu = 0;
        (void)hipGetDevice(&dev); (void)hipDeviceGetAttribute(&cus, hipDeviceAttributeMultiprocessorCount, dev);
        (void)hipOccupancyMaxActiveBlocksPerMultiprocessor(&per_cu, (const void*)fwd_kernel, NTHR, LDS_BYTES);
        if (per_cu < 1) per_cu = 1;
        grid = cus;
    }
    if (grid < 0) return;
    Params p{};
    for (int i = 0; i < 46; ++i) p.in[i] = (const float*)d_in[i];
    p.out = (float*)d_out; p.ws = (unsigned char*)d_ws;
#if ONE_LAUNCH
    p.ph_lo = 0; p.ph_hi = NPHASE;
    if (hipMemsetAsync((char*)d_ws + OFF_BAR, 0, XCD_BAR_WORDS * 4, stream) != hipSuccess) { fprintf(stderr, "memset failed\n"); return; }
    void* args[] = {&p};
    hipError_t e = hipLaunchCooperativeKernel((const void*)fwd_kernel, dim3(grid), dim3(NTHR), args, LDS_BYTES, stream);
    if (e != hipSuccess) fprintf(stderr, "cooperative launch failed: %s (grid %d)\n", hipGetErrorString(e), grid);
#else
    for (int ph = 0; ph < NPHASE; ++ph) { p.ph_lo = ph; p.ph_hi = ph + 1; hipLaunchKernelGGL(fwd_kernel, dim3(grid), dim3(NTHR), LDS_BYTES, stream, p); }
#endif
}
```

```cpp
#include <hip/hip_runtime.h>
#include <hip/hip_cooperative_groups.h>
#include <cstdio>
#include <cstdint>
namespace cg = cooperative_groups;

#define LAS __attribute__((address_space(3)))
typedef unsigned short bf16_t;
typedef short bf16x8 __attribute__((ext_vector_type(8)));
typedef float f32x4 __attribute__((ext_vector_type(4)));
typedef unsigned u32x2 __attribute__((ext_vector_type(2)));
typedef unsigned u32x4 __attribute__((ext_vector_type(4)));

constexpr int MTOK = 16384, DM = 1024, SEQ = 4096, FF = 2816;
constexpr int NTHR = 512;
constexpr int LDS_BYTES = 131072;
constexpr size_t MiB = 1048576;
constexpr size_t OFF_WIN = 0;
constexpr size_t OFF_WGLU = 4194304;
constexpr size_t OFF_WOUT = 4718592;
constexpr size_t OFF_WGU0 = 6815744;
constexpr size_t OFF_WDN0 = 18350080;
constexpr size_t OFF_WGU1 = 39321600;
constexpr size_t OFF_WDN1 = 50855936;
constexpr size_t OFF_WG1 = 24117248;
constexpr size_t OFF_WL1 = 24117248 + 6291456;
constexpr size_t OFF_WL2 = 37748736;
constexpr size_t OFF_WO = 56623104;
constexpr size_t OFF_MOD = 58720256;
constexpr size_t OFF_BAR = 58916864;
constexpr size_t ACT = 57 * MiB;
constexpr size_t OFF_HA = ACT;
constexpr size_t OFF_UX = ACT + 32 * MiB;
constexpr size_t OFF_Z = ACT + 52 * MiB;
constexpr size_t OFF_BTZ = ACT + 112 * MiB;
constexpr size_t OFF_BTY = ACT + 176 * MiB;
constexpr size_t OFF_QKV = ACT + 64 * MiB;
constexpr size_t OFF_CAT = ACT + 112 * MiB;
constexpr size_t OFF_YG = ACT + 144 * MiB;
constexpr size_t OFF_VT = ACT + 160 * MiB;
constexpr size_t OFF_OC = ACT;
constexpr size_t OFF_HID = ACT + 32 * MiB;
constexpr size_t OFF_HD = ACT;
constexpr size_t OFF_RKV = ACT + 64 * MiB;
constexpr size_t OFF_G = ACT + 160 * MiB;
constexpr size_t OFF_Y = 0;
constexpr size_t OFF_L1 = 0;
constexpr size_t OFF_DEC = ACT;
constexpr size_t OFF_AA = ACT + 32 * MiB;
constexpr size_t WS_NEED = ACT + 196 * MiB;

struct Params {
    const float* in[46];
    float* out;
    unsigned char* ws;
    int ph_lo, ph_hi;
};

__device__ __forceinline__ unsigned f2bf(float f) { unsigned u = __float_as_uint(f); return (u + 0x7fffu + ((u >> 16) & 1u)) >> 16; }
__device__ __forceinline__ float bf2f(unsigned h) { return __uint_as_float(h << 16); }
__device__ __forceinline__ unsigned cvt_pk_bf16(float lo, float hi) { unsigned r; asm("v_cvt_pk_bf16_f32 %0, %1, %2" : "=v"(r) : "v"(lo), "v"(hi)); return r; }
__device__ __forceinline__ unsigned pk2(float lo, float hi) { return cvt_pk_bf16(lo, hi); }
__device__ __forceinline__ float bflo(unsigned w) { return __uint_as_float(w << 16); }
__device__ __forceinline__ float bfhi(unsigned w) { return __uint_as_float(w & 0xffff0000u); }
__device__ __forceinline__ float dpp_sum16(float x) {
    x += __int_as_float(__builtin_amdgcn_update_dpp(0, __float_as_int(x), 0xB1, 0xf, 0xf, true));
    x += __int_as_float(__builtin_amdgcn_update_dpp(0, __float_as_int(x), 0x4E, 0xf, 0xf, true));
    x += __int_as_float(__builtin_amdgcn_update_dpp(0, __float_as_int(x), 0x141, 0xf, 0xf, true));
    x += __int_as_float(__builtin_amdgcn_update_dpp(0, __float_as_int(x), 0x140, 0xf, 0xf, true));
    return x;
}
__device__ __forceinline__ float wave_sum(float v) {
    v = dpp_sum16(v);
    const float s0 = __int_as_float(__builtin_amdgcn_readlane(__float_as_int(v), 0)), s1 = __int_as_float(__builtin_amdgcn_readlane(__float_as_int(v), 16));
    const float s2 = __int_as_float(__builtin_amdgcn_readlane(__float_as_int(v), 32)), s3 = __int_as_float(__builtin_amdgcn_readlane(__float_as_int(v), 48));
    return (s0 + s1) + (s2 + s3);
}
__device__ __forceinline__ float sigmoidf_(float x) { return __fdividef(1.f, 1.f + __expf(-x)); }
__device__ __forceinline__ float tanh_fast(float x) { const float t = __expf(2.f * fminf(fmaxf(x, -15.f), 15.f)); return __fdividef(t - 1.f, t + 1.f); }
#define LWAIT() asm volatile("s_waitcnt lgkmcnt(0)" ::: "memory")
__device__ __forceinline__ float gelu_tanh(float x) { const float u = 0.7978845608028654f * (x + 0.044715f * x * x * x); const float t = __expf(2.f * fminf(fmaxf(u, -15.f), 15.f)); return __fdividef(x * t, t + 1.f); }

constexpr int HTB = 128 * 64 * 2;
__device__ __forceinline__ int lds_byte(int r, int c) { int st = (r >> 4) * 2 + (c >> 5), rr = r & 15, cc = c & 31, ob = rr * 64 + cc * 2; return st * 1024 + (ob ^ (((ob >> 9) & 1) << 5)); }
__device__ __forceinline__ void stage_rc(int b, int& R, int& C) { int st = b / 1024, sb = b % 1024, swz = sb ^ (((sb >> 9) & 1) << 5); R = (st >> 1) * 16 + swz / 64; C = (st & 1) * 32 + (swz % 64) / 2; }

struct NoPre { static constexpr bool NOP = true; __device__ __forceinline__ void operator()(int, int, int) const {} };
template <class Epi, class Pre, bool PF = true>
__device__ __forceinline__ void gemm_batched(LAS unsigned char* lds, const bf16_t* A, int lda, size_t strideA, const bf16_t* Bt, size_t strideB, int nMt, int nNt, int nbatch, int K, const Epi& E, const Pre& PRE, int bid, int nb) {
    const int tid = threadIdx.x, wid = __builtin_amdgcn_readfirstlane(tid >> 6), lane = tid & 63, wr = wid >> 2, wc = wid & 3, fr = lane & 15, fq = lane >> 4;
    unsigned voffA[2], voffB[2];
#pragma unroll
    for (int i = 0; i < 2; ++i) { int R, C; stage_rc(tid * 16 + i * 8192, R, C); voffA[i] = (unsigned)(R * lda + C) * 2u; voffB[i] = (unsigned)(R * K + C) * 2u; }
    const int aoff = lds_byte(wr * 64 + fr, fq * 8), boff = lds_byte(wc * 32 + fr, fq * 8);
    const unsigned ldsw = (unsigned)wid * 1024u;
    const size_t kstep = 128, hstepA = (size_t)128 * lda * 2, hstepB = (size_t)128 * K * 2;
    const int nt = K / 64;
    const int ntiles = nMt * nNt * nbatch;
#define G_SA(b, h) (((b) * 2 + (h)) * HTB)
#define G_SB(b, h) ((4 + (b) * 2 + (h)) * HTB)
#define G_STAGEX(bufoff, gptr, vo) do { _Pragma("unroll") for (int _i = 0; _i < 2; ++_i) \
        __builtin_amdgcn_global_load_lds((const unsigned*)((gptr) + vo[_i]), (LAS unsigned*)(lds + (bufoff) + ldsw + _i * 8192), 16, 0, 0); } while (0)
#define G_STA(bufoff, gptr) G_STAGEX(bufoff, gptr, voffA)
#define G_STB(bufoff, gptr) G_STAGEX(bufoff, gptr, voffB)
#define G_LDA(dst, b, h) do { _Pragma("unroll") for (int m = 0; m < 4; ++m) _Pragma("unroll") for (int k = 0; k < 2; ++k) dst[m][k] = *(const LAS bf16x8*)(lds + G_SA(b, h) + aoff + m * 2048 + k * 1024); } while (0)
#define G_LDB(dst, b, h) do { _Pragma("unroll") for (int n = 0; n < 2; ++n) _Pragma("unroll") for (int k = 0; k < 2; ++k) dst[n][k] = *(const LAS bf16x8*)(lds + G_SB(b, h) + boff + n * 2048 + k * 1024); } while (0)
#define G_MMA(ai, bj, At, Bx) do { __builtin_amdgcn_s_setprio(1); _Pragma("unroll") for (int m = 0; m < 4; ++m) _Pragma("unroll") for (int n = 0; n < 2; ++n) _Pragma("unroll") for (int k = 0; k < 2; ++k) \
        acc[ai][bj][m][n] = __builtin_amdgcn_mfma_f32_16x16x32_bf16(Bx[n][k], At[m][k], acc[ai][bj][m][n], 0, 0, 0); __builtin_amdgcn_s_setprio(0); } while (0)
#define G_WV(n) asm volatile("s_waitcnt vmcnt(" #n ")" ::: "memory")
#define G_WL(n) asm volatile("s_waitcnt lgkmcnt(" #n ")" ::: "memory")
#define G_BAR __builtin_amdgcn_s_barrier()
#define G_SCHED __builtin_amdgcn_sched_barrier(0)
    bool prefetched = false;
    for (int tile = bid; tile < ntiles; tile += nb) {
        const int pm = tile % nMt, tq = tile / nMt, pn = tq % nNt, gb = tq / nNt;
        PRE(gb, pm, pn);
        const char* cA = (const char*)(A + (size_t)gb * strideA) + (size_t)pm * 256 * lda * 2;
        const char* cB = (const char*)(Bt + (size_t)gb * strideB) + (size_t)pn * 256 * K * 2;
        f32x4 acc[2][2][4][2];
#pragma unroll
        for (int a = 0; a < 2; ++a)
#pragma unroll
            for (int b = 0; b < 2; ++b)
#pragma unroll
                for (int m = 0; m < 4; ++m)
#pragma unroll
                    for (int n = 0; n < 2; ++n) acc[a][b][m][n] = (f32x4){0.f, 0.f, 0.f, 0.f};
        bf16x8 At[4][2], B0[2][2], B1[2][2];
        if (!prefetched) { G_WV(0); G_STB(G_SB(0, 0), cB); G_STA(G_SA(0, 0), cA); G_STB(G_SB(0, 1), cB + hstepB); G_STA(G_SA(0, 1), cA + hstepA); }
        if (wr == 1) G_BAR;
        if (prefetched) G_WV(0); else G_WV(4);
        G_BAR;
        G_STB(G_SB(1, 0), cB + kstep); G_STA(G_SA(1, 0), cA + kstep); G_STB(G_SB(1, 1), cB + hstepB + kstep);
        G_WV(6); G_BAR;
        for (int t = 0; t < nt - 2; t += 2) {
            const char* a1 = cA + (size_t)(t + 1) * kstep; const char* a2 = cA + (size_t)(t + 2) * kstep; const char* a3 = a2 + kstep;
            const char* b2 = cB + (size_t)(t + 2) * kstep; const char* b3 = b2 + kstep;
            G_LDB(B0, 0, 0); G_SCHED; G_LDA(At, 0, 0); G_STA(G_SA(1, 1), a1 + hstepA);
            G_WL(8); G_BAR; G_WL(0); G_MMA(0, 0, At, B0); G_BAR; G_SCHED;
            G_LDB(B1, 0, 1); G_STB(G_SB(0, 0), b2);
            G_BAR; G_WL(0); G_MMA(0, 1, At, B1); G_BAR;
            G_LDA(At, 0, 1); G_STA(G_SA(0, 0), a2);
            G_BAR; G_WL(0); G_MMA(1, 0, At, B0); G_BAR; G_SCHED;
            G_STB(G_SB(0, 1), b2 + hstepB);
            G_WV(6); G_BAR; G_MMA(1, 1, At, B1); G_BAR;
            G_LDB(B0, 1, 0); G_SCHED; G_LDA(At, 1, 0); G_STA(G_SA(0, 1), a2 + hstepA);
            G_WL(8); G_BAR; G_WL(0); G_MMA(0, 0, At, B0); G_BAR; G_SCHED;
            G_LDB(B1, 1, 1); G_STB(G_SB(1, 0), b3);
            G_BAR; G_WL(0); G_MMA(0, 1, At, B1); G_BAR;
            G_LDA(At, 1, 1); G_STA(G_SA(1, 0), a3);
            G_BAR; G_WL(0); G_MMA(1, 0, At, B0); G_BAR; G_SCHED;
            G_STB(G_SB(1, 1), b3 + hstepB);
            G_WV(6); G_BAR; G_MMA(1, 1, At, B1); G_BAR;
        }
        {
            const char* a1 = cA + (size_t)(nt - 1) * kstep;
            G_LDB(B0, 0, 0); G_LDA(At, 0, 0); G_STA(G_SA(1, 1), a1 + hstepA);
            G_BAR; G_WL(0); G_MMA(0, 0, At, B0); G_BAR;
            G_LDB(B1, 0, 1); G_BAR; G_WL(0); G_MMA(0, 1, At, B1); G_BAR;
            G_LDA(At, 0, 1); G_WV(4); G_BAR; G_WL(0); G_MMA(1, 0, At, B0); G_MMA(1, 1, At, B1); G_BAR;
        }
        {
            G_LDB(B0, 1, 0); G_LDA(At, 1, 0); G_WV(2); G_BAR; G_WL(0); G_MMA(0, 0, At, B0); G_BAR;
            G_LDB(B1, 1, 1); G_WV(0); G_BAR; G_WL(0); G_MMA(0, 1, At, B1); G_BAR;
            G_LDA(At, 1, 1); G_BAR; G_WL(0); G_MMA(1, 0, At, B0); G_MMA(1, 1, At, B1); G_BAR;
        }
        if (wr == 0) G_BAR;
        prefetched = false;
        if (PF && Pre::NOP && tile + nb < ntiles) {
            const int t2 = tile + nb, pm2 = t2 % nMt, tq2 = t2 / nMt, pn2 = tq2 % nNt, gb2 = tq2 / nNt;
            const char* nA = (const char*)(A + (size_t)gb2 * strideA) + (size_t)pm2 * 256 * lda * 2;
            const char* nB = (const char*)(Bt + (size_t)gb2 * strideB) + (size_t)pn2 * 256 * K * 2;
            G_STB(G_SB(0, 0), nB); G_STA(G_SA(0, 0), nA); G_STB(G_SB(0, 1), nB + hstepB); G_STA(G_SA(0, 1), nA + hstepA);
            prefetched = true; }
        E(acc, gb, pm, pn, wr, wc, fr, fq);
    }
    G_WV(0);
    __syncthreads();
}

template <class Epi>
__device__ __forceinline__ void gemm_phase(LAS unsigned char* lds, const bf16_t* A, const bf16_t* Bt, int N, int K, const Epi& E, int bid, int nb) {
    gemm_batched(lds, A, K, 0, Bt, 0, 64, N / 256, 1, K, E, NoPre{}, bid, nb);
}

namespace pg8 {
#define PG8_LAS __attribute__((address_space(3)))
typedef unsigned short bf16_t;
typedef short bf16x8 __attribute__((ext_vector_type(8)));
typedef float f32x4 __attribute__((ext_vector_type(4)));
typedef unsigned u32x4 __attribute__((ext_vector_type(4)));
constexpr int BM = 256, BK = 64, HALF = 128, HTB = HALF * BK * 2  , STAGE_BYTES = 8 * HTB, NXCD = 8, WGM = 8;

__host__ __device__ __forceinline__ int lds_byte(int r, int c) { const int st = (r >> 4) * 2 + (c >> 5), rr = r & 15, cc = c & 31, ob = rr * 64 + cc * 2; return st * 1024 + (ob ^ (((ob >> 9) & 1) << 5)); }
__host__ __device__ __forceinline__ void stage_rc(int b, int& R, int& C) { const int st = b / 1024, sb = b % 1024, swz = sb ^ (((sb >> 9) & 1) << 5); R = (st >> 1) * 16 + swz / 64; C = (st & 1) * 32 + (swz % 64) / 2; }
__host__ __device__ __forceinline__ int perm32(int rho) { const int n = rho >> 4, i = rho & 15; return 8 * (i >> 2) + 4 * n + (i & 3); }

struct Unit { int pm, pn; int ao = 0; };
struct Gemm { const bf16_t* A; const bf16_t* Bt; int M, N, K; int lda; };

struct StaticOrder {
    int nM, nN, nwg, G, c;
    __host__ __device__ void init(int M, int N, int G_, int c_) { nM = M / BM; nN = N / BM; nwg = nM * nN; G = G_; c = c_; }
    __host__ __device__ bool next(int i, Unit& u) const {
        const long L = (long)i * G + c; if (L >= nwg) return false;
        int wgid = (int)L; { const int q = nwg / NXCD, r = nwg % NXCD, xcd = wgid % NXCD, off = wgid / NXCD; wgid = (xcd < r ? xcd * (q + 1) : r * (q + 1) + (xcd - r) * q) + off; }
        const int nig = WGM * nN, gid = wgid / nig, fm = gid * WGM, gsz = (nM - fm) < WGM ? (nM - fm) : WGM;
        u.pm = fm + ((wgid % nig) % gsz); u.pn = (wgid % nig) / gsz; return true;
    }
    __device__ __forceinline__ void a_ready(const Unit&) const {}
    __device__ __forceinline__ void done(const Unit&) const {}
};
template <class Epi, class Sched, bool ALIGN_EPI = false, bool SP2 = false>
__device__ __forceinline__ void gemm_phase(PG8_LAS unsigned char* lds, const Gemm g, const Sched& S, const Epi& E) {
    const int tid = threadIdx.x, wid = __builtin_amdgcn_readfirstlane(tid >> 6), lane = tid & 63, wr = wid >> 2, wc = wid & 3, fr = lane & 15, fq = lane >> 4;
    const int K = g.K, nt = K / BK;
    unsigned voffA[2], voffB[2];
#pragma unroll
    for (int i = 0; i < 2; ++i) { int R, C; stage_rc(tid * 16 + i * 8192, R, C); const int Rb = Epi::PERM ? ((R & ~31) + perm32(R & 31)) : R;
        voffA[i] = (unsigned)(R * g.lda + C) * 2u; voffB[i] = (unsigned)(Rb * K + C) * 2u; }
    const size_t kstep = (size_t)(BK * 2);
    const size_t hstep = (size_t)HALF * K * 2;
    const size_t tstep = 2 * hstep;
    const size_t hstepA = (size_t)HALF * g.lda * 2, tstepA = 2 * hstepA;
    const unsigned ldsw = (unsigned)wid * 1024u;
    const int aoff = lds_byte(wr * 64 + fr, fq * 8), boff = lds_byte(wc * 32 + fr, fq * 8);
#define PG8_SA(b, h) (((b) * 2 + (h)) * HTB)
#define PG8_SB(b, h) ((4 + (b) * 2 + (h)) * HTB)
#define PG8_STAGE(bufoff, gbase, voff) do { _Pragma("unroll") for (int _i = 0; _i < 2; ++_i) \
        __builtin_amdgcn_global_load_lds((const unsigned*)((const char*)(gbase) + (voff)[_i]), (PG8_LAS unsigned*)(lds + (bufoff) + ldsw + _i * 8192), 16, 0, 0); } while (0)
#define PG8_LDA(dst, b, h) do { _Pragma("unroll") for (int m = 0; m < 4; ++m) _Pragma("unroll") for (int k = 0; k < 2; ++k) dst[m][k] = *(const PG8_LAS bf16x8*)(lds + PG8_SA(b, h) + aoff + m * 2048 + k * 1024); } while (0)
#define PG8_LDB(dst, b, h) do { _Pragma("unroll") for (int n = 0; n < 2; ++n) _Pragma("unroll") for (int k = 0; k < 2; ++k) dst[n][k] = *(const PG8_LAS bf16x8*)(lds + PG8_SB(b, h) + boff + n * 2048 + k * 1024); } while (0)
#define PG8_MMA(ai, bj, At, Bt) do { __builtin_amdgcn_s_setprio(1); _Pragma("unroll") for (int m = 0; m < 4; ++m) _Pragma("unroll") for (int n = 0; n < 2; ++n) _Pragma("unroll") for (int k = 0; k < 2; ++k) \
        acc[ai][bj][m][n] = __builtin_amdgcn_mfma_f32_16x16x32_bf16(Bt[n][k], At[m][k], acc[ai][bj][m][n], 0, 0, 0); __builtin_amdgcn_s_setprio(0); } while (0)
#define PG8_WAIT_V(n) asm volatile("s_waitcnt vmcnt(" #n ")" ::: "memory")
#define PG8_WAIT_L(n) asm volatile("s_waitcnt lgkmcnt(" #n ")" ::: "memory")
#define PG8_BAR __builtin_amdgcn_s_barrier()
#define PG8_SCHED __builtin_amdgcn_sched_barrier(0)
    Unit cur, nxt; int ui = 0;
    if (!S.next(0, cur)) return;
    f32x4 acc[2][2][4][2];
#pragma unroll
    for (int a = 0; a < 2; ++a)
#pragma unroll
        for (int b = 0; b < 2; ++b)
#pragma unroll
            for (int m = 0; m < 4; ++m)
#pragma unroll
                for (int n = 0; n < 2; ++n) acc[a][b][m][n] = (f32x4){0.f, 0.f, 0.f, 0.f};
    bf16x8 At[4][2], B0[2][2], B1[2][2];
    const char* cA = (const char*)g.A + (size_t)cur.pm * tstepA + cur.ao; const char* cB = (const char*)g.Bt + (size_t)cur.pn * tstep;
    S.a_ready(cur);
    if constexpr (SP2) {
        PG8_STAGE(PG8_SB(0, 0), cB, voffB); PG8_STAGE(PG8_SB(0, 1), cB + hstep, voffB); PG8_STAGE(PG8_SA(0, 0), cA, voffA); PG8_STAGE(PG8_SA(0, 1), cA + hstepA, voffA);
        if (wr == 1) PG8_BAR;
        PG8_WAIT_V(2); PG8_BAR;
        PG8_STAGE(PG8_SB(1, 0), cB + kstep, voffB); PG8_STAGE(PG8_SA(1, 0), cA + kstep, voffA); PG8_STAGE(PG8_SB(1, 1), cB + hstep + kstep, voffB);
        PG8_WAIT_V(6); PG8_BAR;
    } else {
        PG8_STAGE(PG8_SB(0, 0), cB, voffB); PG8_STAGE(PG8_SA(0, 0), cA, voffA); PG8_STAGE(PG8_SB(0, 1), cB + hstep, voffB); PG8_STAGE(PG8_SA(0, 1), cA + hstepA, voffA);
        if (wr == 1) PG8_BAR;
        PG8_WAIT_V(4); PG8_BAR;
        PG8_STAGE(PG8_SB(1, 0), cB + kstep, voffB); PG8_STAGE(PG8_SA(1, 0), cA + kstep, voffA); PG8_STAGE(PG8_SB(1, 1), cB + hstep + kstep, voffB);
        PG8_WAIT_V(6); PG8_BAR;
    }
    for (;;) {
        const bool has_next = S.next(ui + 1, nxt);
        const char* nA = has_next ? (const char*)g.A + (size_t)nxt.pm * tstepA + nxt.ao : cA; const char* nB = has_next ? (const char*)g.Bt + (size_t)nxt.pn * tstep : cB;
        for (int t = 0; t < nt; t += 2) {
            const bool last = (t == nt - 2);
            const char* a1 = cA + (size_t)(t + 1) * kstep;
            const char* a2 = last ? nA : cA + (size_t)(t + 2) * kstep; const char* b2 = last ? nB : cB + (size_t)(t + 2) * kstep;
            const char* a3 = a2 + kstep; const char* b3 = b2 + kstep;
            if (last && has_next) S.a_ready(nxt);
            if constexpr (SP2) {
            PG8_LDB(B0, 0, 0); PG8_LDB(B1, 0, 1); PG8_SCHED; PG8_LDA(At, 0, 0); PG8_STAGE(PG8_SA(1, 1), a1 + hstepA, voffA);
            PG8_WAIT_V(8); PG8_WAIT_L(0); PG8_BAR; PG8_MMA(0, 0, At, B0); PG8_MMA(0, 1, At, B1); PG8_BAR; PG8_SCHED;
            PG8_LDA(At, 0, 1); PG8_STAGE(PG8_SB(0, 0), b2, voffB); PG8_STAGE(PG8_SB(0, 1), b2 + hstep, voffB); PG8_STAGE(PG8_SA(0, 0), a2, voffA);
            PG8_WAIT_V(8); PG8_WAIT_L(0); PG8_BAR; PG8_MMA(1, 0, At, B0); PG8_MMA(1, 1, At, B1); PG8_BAR; PG8_SCHED;
            PG8_LDB(B0, 1, 0); PG8_LDB(B1, 1, 1); PG8_SCHED; PG8_LDA(At, 1, 0); PG8_STAGE(PG8_SA(0, 1), a2 + hstepA, voffA);
            PG8_WAIT_V(8); PG8_WAIT_L(0); PG8_BAR; PG8_MMA(0, 0, At, B0); PG8_MMA(0, 1, At, B1); PG8_BAR; PG8_SCHED;
            PG8_LDA(At, 1, 1); PG8_STAGE(PG8_SB(1, 0), b3, voffB); PG8_STAGE(PG8_SB(1, 1), b3 + hstep, voffB); PG8_STAGE(PG8_SA(1, 0), a3, voffA);
            PG8_WAIT_V(8); PG8_WAIT_L(0); PG8_BAR; PG8_MMA(1, 0, At, B0); PG8_MMA(1, 1, At, B1); PG8_BAR; PG8_SCHED;
            } else {
            PG8_LDB(B0, 0, 0); PG8_SCHED; PG8_LDA(At, 0, 0); PG8_STAGE(PG8_SA(1, 1), a1 + hstepA, voffA);
            PG8_WAIT_L(8); PG8_BAR; PG8_WAIT_L(0); PG8_MMA(0, 0, At, B0); PG8_BAR; PG8_SCHED;
            PG8_LDB(B1, 0, 1); PG8_STAGE(PG8_SB(0, 0), b2, voffB);
            PG8_BAR; PG8_WAIT_L(0); PG8_MMA(0, 1, At, B1); PG8_BAR;
            PG8_LDA(At, 0, 1); PG8_STAGE(PG8_SA(0, 0), a2, voffA);
            PG8_BAR; PG8_WAIT_L(0); PG8_MMA(1, 0, At, B0); PG8_BAR; PG8_SCHED;
            PG8_STAGE(PG8_SB(0, 1), b2 + hstep, voffB);
            PG8_WAIT_V(6); PG8_BAR; PG8_MMA(1, 1, At, B1); PG8_BAR;
            PG8_LDB(B0, 1, 0); PG8_SCHED; PG8_LDA(At, 1, 0); PG8_STAGE(PG8_SA(0, 1), a2 + hstepA, voffA);
            PG8_WAIT_L(8); PG8_BAR; PG8_WAIT_L(0); PG8_MMA(0, 0, At, B0); PG8_BAR; PG8_SCHED;
            PG8_LDB(B1, 1, 1); PG8_STAGE(PG8_SB(1, 0), b3, voffB);
            PG8_BAR; PG8_WAIT_L(0); PG8_MMA(0, 1, At, B1); PG8_BAR;
            PG8_LDA(At, 1, 1); PG8_STAGE(PG8_SA(1, 0), a3, voffA);
            PG8_BAR; PG8_WAIT_L(0); PG8_MMA(1, 0, At, B0); PG8_BAR; PG8_SCHED;
            PG8_STAGE(PG8_SB(1, 1), b3 + hstep, voffB);
            PG8_WAIT_V(6); PG8_BAR; PG8_MMA(1, 1, At, B1); PG8_BAR;
            }
        }
        if constexpr (ALIGN_EPI) { if (wr == 0) PG8_BAR; }
        if constexpr (!Epi::AFTER_DRAIN) { E(acc, cur, wr, wc, fr, fq); S.done(cur); }
        if (!has_next) break;
#pragma unroll
        for (int a = 0; a < 2; ++a)
#pragma unroll
            for (int b = 0; b < 2; ++b)
#pragma unroll
                for (int m = 0; m < 4; ++m)
#pragma unroll
                    for (int n = 0; n < 2; ++n) acc[a][b][m][n] = (f32x4){0.f, 0.f, 0.f, 0.f};
        cur = nxt; cA = nA; cB = nB; ++ui;
        if constexpr (ALIGN_EPI) { if (wr == 1) PG8_BAR; }
    }
    PG8_WAIT_V(0);
    if constexpr (!ALIGN_EPI) { if (wr == 0) PG8_BAR; }
    PG8_BAR;
    if constexpr (Epi::AFTER_DRAIN) { E.fused(acc, cur, wr, wc, fr, fq, lds, wid, lane); S.done(cur); }
#undef PG8_SA
#undef PG8_SB
#undef PG8_STAGE
#undef PG8_LDA
#undef PG8_LDB
#undef PG8_MMA
#undef PG8_WAIT_V
#undef PG8_WAIT_L
#undef PG8_BAR
#undef PG8_SCHED
}
}

template <class E> struct EpiAdapt { static constexpr bool PERM = false, AFTER_DRAIN = false; E e;
    __device__ __forceinline__ void operator()(const pg8::f32x4 (&acc)[2][2][4][2], const pg8::Unit& u, int wr, int wc, int fr, int fq) const { e(acc, 0, u.pm, u.pn, wr, wc, fr, fq); } };
template <class Epi>
__device__ __forceinline__ void gemm_stream(LAS unsigned char* lds, const bf16_t* A, const bf16_t* Bt, int N, int K, const Epi& E, int bid, int nb) {
    pg8::Gemm g{A, Bt, MTOK, N, K, K}; pg8::StaticOrder S; S.init(MTOK, N, nb, bid);
    EpiAdapt<Epi> ea{E};
    pg8::gemm_phase<EpiAdapt<Epi>, pg8::StaticOrder, true, true>(lds, g, S, ea);
}

#define EPI_LOOP(...) \
    _Pragma("unroll") for (int ai = 0; ai < 2; ++ai) _Pragma("unroll") for (int m = 0; m < 4; ++m) { asm volatile("" ::: "memory"); const int row = pm * 256 + ai * 128 + wr * 64 + m * 16 + fr; \
    _Pragma("unroll") for (int bj = 0; bj < 2; ++bj) _Pragma("unroll") for (int n = 0; n < 2; ++n) { const int ct = bj * 128 + wc * 32 + n * 16 + fq * 4; const f32x4 v = acc[ai][bj][m][n]; __VA_ARGS__ } }

struct EpiWin {
    bf16_t* UX; bf16_t* QKV;
    __device__ __forceinline__ void operator()(const f32x4 (&acc)[2][2][4][2], int gb, int pm, int pn, int wr, int wc, int fr, int fq) const {
        if (pn < 2) {
            bf16_t* base = UX + ((size_t)(pn * 16 + wc * 2) * 512 + (pm >> 4) * 128 + (pm & 15) * 8 + wr * 2) * 640 + fr * 16 + fq * 4;
#pragma unroll
            for (int ai = 0; ai < 2; ++ai)
#pragma unroll
                for (int m = 0; m < 4; ++m) { bf16_t* rp = base + (ai * 4 + (m >> 1)) * 640 + (m & 1) * 256;
#pragma unroll
                    for (int bj = 0; bj < 2; ++bj)
#pragma unroll
                        for (int n = 0; n < 2; ++n) { const f32x4 v = acc[ai][bj][m][n]; u32x2 w; w.x = pk2(v[0], v[1]); w.y = pk2(v[2], v[3]);
                            *(u32x2*)(rp + (size_t)(bj * 8 + n) * (512 * 640)) = w; }
                    asm volatile("" ::: "memory"); }
        } else { bf16_t* base = QKV + (size_t)((pn - 2) >> 1) * ((size_t)MTOK * 512) + (pn & 1) * 256 + (size_t)(pm * 256 + wr * 64 + fr) * 512 + wc * 32 + fq * 4;
#pragma unroll
            for (int ai = 0; ai < 2; ++ai)
#pragma unroll
                for (int m = 0; m < 4; ++m) { bf16_t* rp = base + (size_t)(ai * 128 + m * 16) * 512;
#pragma unroll
                    for (int bj = 0; bj < 2; ++bj)
#pragma unroll
                        for (int n = 0; n < 2; ++n) { const f32x4 v = acc[ai][bj][m][n]; u32x2 w; w.x = pk2(v[0], v[1]); w.y = pk2(v[2], v[3]);
                            *(u32x2*)(rp + bj * 128 + n * 16) = w; }
                    asm volatile("" ::: "memory"); }
        }
    }
};
struct EpiS5Z {
    float* Z;
    __device__ __forceinline__ void operator()(const f32x4 (&acc)[2][2][4][2], int gb, int pm, int pn, int wr, int wc, int fr, int fq) const {
        EPI_LOOP({ if (bj == 0) *(f32x4*)(Z + ((size_t)gb * 512 + row) * 128 + ct) = v; })
    }
};
struct EpiS5Y {
    const bf16_t* UX; bf16_t* YG; const float* dsk;
    __device__ __forceinline__ void operator()(const f32x4 (&acc)[2][2][4][2], int gb, int pm, int pn, int wr, int wc, int fr, int fq) const {
        EPI_LOOP({ const int col = pn * 256 + ct, t = col >> 4, h = col & 15, bb = row >> 7, cc = row & 127;
            const u32x2 uu = *(const u32x2*)(UX + ((size_t)gb * 512 + row) * 640 + col); const f32x4 dd = *(const f32x4*)(dsk + gb * 16 + h);
            u32x2 w; w.x = pk2(gelu_tanh(v[0] + dd[0] * bflo(uu.x)), gelu_tanh(v[1] + dd[1] * bfhi(uu.x))); w.y = pk2(gelu_tanh(v[2] + dd[2] * bflo(uu.y)), gelu_tanh(v[3] + dd[3] * bfhi(uu.y)));
            *(u32x2*)(YG + ((size_t)bb * SEQ + cc * 32 + t) * 512 + gb * 16 + h) = w; })
    }
};
struct PreS5Y {   static constexpr bool NOP = false;
    const float* Z; bf16_t* UX; const float* lam_re; const float* lam_im; const float* log_dt;
    __device__ __forceinline__ void operator()(int gb, int pm, int pn) const {
        const int tid = threadIdx.x;
        if (tid < 128) { const int pp = tid & 63, bb = 2 * pm + (tid >> 6);
            const float lr = lam_re[gb * 64 + pp], li = lam_im[gb * 64 + pp], dt = expf(log_dt[gb]);
            const float mag = expf(lr * dt * 32.f), ar = mag * cosf(li * dt * 32.f), ai = mag * sinf(li * dt * 32.f);
            const float* zp = Z + ((size_t)gb * 512 + bb * 128) * 128 + pp; bf16_t* xp = UX + ((size_t)gb * 512 + bb * 128) * 640 + 512 + pp;
            float xr = 0.f, xi = 0.f;
            for (int c0 = 0; c0 < 128; c0 += 16) { float zr[16], zi[16];
#pragma unroll
                for (int i = 0; i < 16; ++i) { zr[i] = zp[(size_t)(c0 + i) * 128]; zi[i] = zp[(size_t)(c0 + i) * 128 + 64]; }
#pragma unroll
                for (int i = 0; i < 16; ++i) { xp[(size_t)(c0 + i) * 640] = (bf16_t)f2bf(xr); xp[(size_t)(c0 + i) * 640 + 64] = (bf16_t)f2bf(xi);
                    const float nr = ar * xr - ai * xi + zr[i], ni = ar * xi + ai * xr + zi[i]; xr = nr; xi = ni; } } }
        __threadfence();
        asm volatile("s_waitcnt vmcnt(0)" ::: "memory");
        __syncthreads();
    }
};
struct EpiGlu {
    const bf16_t* YG; bf16_t* CAT;
    __device__ __forceinline__ void operator()(const f32x4 (&acc)[2][2][4][2], int gb, int pm, int pn, int wr, int wc, int fr, int fq) const {
        EPI_LOOP({ const int col = pn * 256 + ct; const u32x2 y = *(const u32x2*)(YG + (size_t)row * 512 + col);
            u32x2 w; w.x = pk2(bflo(y.x) * sigmoidf_(v[0]), bfhi(y.x) * sigmoidf_(v[1])); w.y = pk2(bflo(y.y) * sigmoidf_(v[2]), bfhi(y.y) * sigmoidf_(v[3]));
            *(u32x2*)(CAT + (size_t)row * 1024 + col) = w; })
    }
};
struct EpiRes {
    const float* res; float* out; const float* gate;
    __device__ __forceinline__ void operator()(const f32x4 (&acc)[2][2][4][2], int gb, int pm, int pn, int wr, int wc, int fr, int fq) const {
        const float* gatep = gate + (size_t)(pm >> 4) * 6144;
        EPI_LOOP({ const int col = pn * 256 + ct; const f32x4 g = *(const f32x4*)(gatep + col); const f32x4 r = *(const f32x4*)(res + (size_t)row * 1024 + col);
            *(f32x4*)(out + (size_t)row * 1024 + col) = r + g * v; })
    }
};
struct EpiSwiglu {
    bf16_t* HID;
    __device__ __forceinline__ void operator()(const f32x4 (&acc)[2][2][4][2], int gb, int pm, int pn, int wr, int wc, int fr, int fq) const {
#pragma unroll
        for (int ai = 0; ai < 2; ++ai)
#pragma unroll
            for (int m = 0; m < 4; ++m) { const int row = pm * 256 + ai * 128 + wr * 64 + m * 16 + fr;
#pragma unroll
                for (int n = 0; n < 2; ++n) { const f32x4 g = acc[ai][0][m][n], u = acc[ai][1][m][n]; float o[4];
#pragma unroll
                    for (int j = 0; j < 4; ++j) o[j] = g[j] * sigmoidf_(g[j]) * u[j];
                    u32x2 w; w.x = pk2(o[0], o[1]); w.y = pk2(o[2], o[3]);
                    *(u32x2*)(HID + (size_t)row * FF + pn * 128 + wc * 32 + n * 16 + fq * 4) = w; } }
    }
};
struct EpiRKV {
    bf16_t* RKV; int row0;
    __device__ __forceinline__ void operator()(const f32x4 (&acc)[2][2][4][2], int gb, int pm, int pn, int wr, int wc, int fr, int fq) const {
        bf16_t* base = RKV + (size_t)gb * ((size_t)MTOK * 1024) + (size_t)row0 * 1024 + pn * 256;
        EPI_LOOP({ u32x2 w; w.x = pk2(v[0], v[1]); w.y = pk2(v[2], v[3]); *(u32x2*)(base + (size_t)row * 1024 + ct) = w; })
    }
};
struct EpiL1 {
    bf16_t* L1; int row0;
    __device__ __forceinline__ void operator()(const f32x4 (&acc)[2][2][4][2], int gb, int pm, int pn, int wr, int wc, int fr, int fq) const {
        bf16_t* base = L1 + (size_t)(row0 + pm * 256 + wr * 64 + fr) * 256 + wc * 32 + fq * 4;
        const bool ident = (wc >= 2);
#pragma unroll
        for (int ai = 0; ai < 2; ++ai)
#pragma unroll
            for (int m = 0; m < 4; ++m) { bf16_t* rp = base + (size_t)(ai * 128 + m * 16) * 256;
#pragma unroll
                for (int bj = 0; bj < 2; ++bj) { const float sc = bj ? 1.f : 2.f, of = bj ? 0.f : -1.f;
#pragma unroll
                    for (int n = 0; n < 2; ++n) { const f32x4 v = acc[ai][bj][m][n]; float o[4];
#pragma unroll
                        for (int j = 0; j < 4; ++j) { const float sg = sc * __builtin_amdgcn_rcpf(1.f + __expf(-sc * v[j])) + of; o[j] = (bj == 0 && ident) ? v[j] : sg; }
                        u32x2 w; w.x = pk2(o[0], o[1]); w.y = pk2(o[2], o[3]); *(u32x2*)(rp + bj * 128 + n * 16) = w; } }
                asm volatile("" ::: "memory"); }
    }
};
struct EpiL2 {
    _Float16* DEC; bf16_t* AA; bf16_t* G; const float* w0; const float* a0;
    __device__ __forceinline__ void operator()(const f32x4 (&acc)[2][2][4][2], int gb, int pm, int pn, int wr, int wc, int fr, int fq) const {
        const int sel = pn >> 2, cb = (pn & 3) * 256;
        if (sel == 0) { EPI_LOOP({ const int col = cb + ct; const f32x4 w0v = *(const f32x4*)(w0 + col);
                _Pragma("unroll") for (int j = 0; j < 4; ++j) { const float z = w0v[j] + v[j]; const float sp = fmaxf(-z, 0.f) + __logf(1.f + __expf(-fabsf(z))); const float e = __expf(-sp - 0.5f);
                    const float omd = (e < 0.125f) ? e * (1.f - e * (0.5f - e * (0.16666667f - e * (0.041666668f - e * 0.0083333338f)))) : 1.f - __expf(-e);
                    DEC[(size_t)row * 1024 + col + j] = (_Float16)omd; } }) }
        else if (sel == 1) { EPI_LOOP({ const int col = cb + ct; const f32x4 a0v = *(const f32x4*)(a0 + col);
                u32x2 w; w.x = pk2(sigmoidf_(a0v[0] + v[0]), sigmoidf_(a0v[1] + v[1])); w.y = pk2(sigmoidf_(a0v[2] + v[2]), sigmoidf_(a0v[3] + v[3]));
                *(u32x2*)(AA + (size_t)row * 1024 + col) = w; }) }
        else { EPI_LOOP({ const int col = cb + ct; u32x2 w; w.x = pk2(v[0], v[1]); w.y = pk2(v[2], v[3]); *(u32x2*)(G + (size_t)row * 1024 + col) = w; }) }
    }
};


struct SchedRKV { int vb, vn;
    __device__ bool next(int i, pg8::Unit& u) const { const int t = vb + i * vn; if (vb < 0 || t >= 384) return false; u.pm = t & 31; u.pn = t >> 5; u.ao = (u.pn >> 2) * 2048; return true; }
    __device__ __forceinline__ void a_ready(const pg8::Unit&) const {}
    __device__ __forceinline__ void done(const pg8::Unit&) const {} };
struct SchedOne { int pm;
    __device__ bool next(int i, pg8::Unit& u) const { if (i > 0 || pm < 0) return false; u.pm = pm; u.pn = 0; u.ao = 0; return true; }
    __device__ __forceinline__ void a_ready(const pg8::Unit&) const {}
    __device__ __forceinline__ void done(const pg8::Unit&) const {} };
struct EpiAdaptRKV { static constexpr bool PERM = false, AFTER_DRAIN = false; EpiRKV e;
    __device__ __forceinline__ void operator()(const pg8::f32x4 (&acc)[2][2][4][2], const pg8::Unit& u, int wr, int wc, int fr, int fq) const { e(acc, u.pn >> 2, u.pm, u.pn & 3, wr, wc, fr, fq); } };
__device__ __forceinline__ void s5_gen(const Params& p, bf16_t* BtY, bf16_t* BtZ, float* lds, int bid, int nb) {
    float* PWr = lds; float* PWi = lds + 33 * 64; float* BBr = lds + 66 * 64; float* BBi = BBr + 1024; float* Cr = BBi + 1024; float* Ci = Cr + 1024; float* Kt = Ci + 1024;
    const int tid = threadIdx.x;
    for (int unit = bid; unit < 256; unit += nb) {
        const int g = unit >> 3, part = unit & 7;
        __syncthreads();
        { const float dt = expf(p.in[13][g]);
          for (int e = tid; e < 33 * 64; e += NTHR) { const int tau = e >> 6, pp = e & 63; const float lr = p.in[11][g * 64 + pp], li = p.in[12][g * 64 + pp];
              const float mag = expf(lr * dt * (float)tau), ang = li * dt * (float)tau; PWr[e] = mag * cosf(ang); PWi[e] = mag * sinf(ang); }
          __syncthreads();
          if (tid < 64) { const int pp = tid; const float lr = p.in[11][g * 64 + pp], li = p.in[12][g * 64 + pp];
              const float ar = PWr[64 + pp], ai = PWi[64 + pp], den = lr * lr + li * li, nr = ar - 1.f;
              const float qr = (nr * lr + ai * li) / den, qi = (ai * lr - nr * li) / den;
              for (int h = 0; h < 16; ++h) { const float br = p.in[14][(size_t)(g * 64 + pp) * 16 + h], bi = p.in[15][(size_t)(g * 64 + pp) * 16 + h]; BBr[pp * 16 + h] = qr * br - qi * bi; BBi[pp * 16 + h] = qr * bi + qi * br; } } }
        for (int i = tid; i < 1024; i += NTHR) { Cr[i] = p.in[16][(size_t)g * 1024 + i]; Ci[i] = p.in[17][(size_t)g * 1024 + i]; }
        __syncthreads();
        { const int tau = tid >> 4, h = tid & 15;
          float acc[16];
#pragma unroll
          for (int i = 0; i < 16; ++i) acc[i] = 0.f;
          for (int pp = 0; pp < 64; ++pp) { const float cr = Cr[h * 64 + pp], ci = Ci[h * 64 + pp], wr = PWr[tau * 64 + pp], wi = PWi[tau * 64 + pp];
              const float er = cr * wr - ci * wi, ei = cr * wi + ci * wr;
#pragma unroll
              for (int q = 0; q < 4; ++q) { const f32x4 br = *(const f32x4*)(BBr + pp * 16 + q * 4), bi = *(const f32x4*)(BBi + pp * 16 + q * 4);
#pragma unroll
                  for (int j = 0; j < 4; ++j) acc[q * 4 + j] += er * br[j] - ei * bi[j]; } }
#pragma unroll
          for (int q = 0; q < 4; ++q) *(f32x4*)(Kt + tau * 256 + h * 16 + q * 4) = (f32x4){acc[q * 4], acc[q * 4 + 1], acc[q * 4 + 2], acc[q * 4 + 3]}; }
        __syncthreads();
        for (int ci_ = tid; ci_ < 5120; ci_ += NTHR) { const int nrow = part * 64 + ci_ / 80, kc = (ci_ % 80) * 8, t = nrow >> 4, h = nrow & 15; float v[8];
#pragma unroll
            for (int i = 0; i < 8; ++i) { const int k = kc + i;
                if (k < 512) { const int sidx = k >> 4, h2 = k & 15; v[i] = (sidx <= t) ? Kt[(t - sidx) * 256 + h * 16 + h2] : 0.f; }
                else { const int jj = k - 512, pp = jj & 63; const float cr = Cr[h * 64 + pp], ci = Ci[h * 64 + pp], wr = PWr[(t + 1) * 64 + pp], wi = PWi[(t + 1) * 64 + pp];
                    v[i] = (jj >> 6) ? -(cr * wi + ci * wr) : (cr * wr - ci * wi); } }
            *(u32x4*)(BtY + ((size_t)g * 512 + nrow) * 640 + kc) = (u32x4){pk2(v[0], v[1]), pk2(v[2], v[3]), pk2(v[4], v[5]), pk2(v[6], v[7])}; }
        for (int ci_ = tid; ci_ < 1024; ci_ += NTHR) { const int n = part * 16 + (ci_ >> 6), kc = (ci_ & 63) * 8, pp = n & 63, im = n >> 6; float v[8];
#pragma unroll
            for (int i = 0; i < 8; ++i) { const int k = kc + i, sidx = k >> 4, h2 = k & 15, tau = 31 - sidx; const float wr = PWr[tau * 64 + pp], wi = PWi[tau * 64 + pp], br = BBr[pp * 16 + h2], bi = BBi[pp * 16 + h2];
                v[i] = im ? (wr * bi + wi * br) : (wr * br - wi * bi); }
            *(u32x4*)(BtZ + ((size_t)g * 256 + n) * 512 + kc) = (u32x4){pk2(v[0], v[1]), pk2(v[2], v[3]), pk2(v[4], v[5]), pk2(v[6], v[7])}; }
    }
    __syncthreads();
}

template <int MODE>
__device__ __forceinline__ void tr_job(const float* src, int K, int N, bf16_t* dst, int ldd, int row_off, int koff, const float* scale, float* lds, int bid, int nb, const float* scale2 = nullptr) {
    const int tk = K / 64, tn = N / 64, tid = threadIdx.x, nt_ = tk * tn;
    const int r = tid >> 3, c = (tid & 7) * 8;
    float4 a = {0.f, 0.f, 0.f, 0.f}, b = a; float sc = 1.f;
    if (bid < nt_) { const int k0 = (bid / tn) * 64, n0 = (bid % tn) * 64; const float* p = src + (size_t)(k0 + r) * N + n0 + c; a = *(const float4*)p; b = *(const float4*)(p + 4); sc = scale ? scale[k0 + r] - (scale2 ? scale2[k0 + r] : 0.f) : 1.f; }
    for (int t = bid; t < nt_; t += nb) {
        const int k0 = (t / tn) * 64, n0 = (t % tn) * 64;
        { float* l = lds + r * 65 + c; l[0] = a.x * sc; l[1] = a.y * sc; l[2] = a.z * sc; l[3] = a.w * sc; l[4] = b.x * sc; l[5] = b.y * sc; l[6] = b.z * sc; l[7] = b.w * sc; }
        if (t + nb < nt_) { const int t2 = t + nb, k2 = (t2 / tn) * 64, n2 = (t2 % tn) * 64; const float* p = src + (size_t)(k2 + r) * N + n2 + c; a = *(const float4*)p; b = *(const float4*)(p + 4); sc = scale ? scale[k2 + r] - (scale2 ? scale2[k2 + r] : 0.f) : 1.f; }
        __syncthreads();
        { const int nl = tid >> 3, kc = (tid & 7) * 8; float v[8];
#pragma unroll
          for (int i = 0; i < 8; ++i) v[i] = lds[(kc + i) * 65 + nl];
          int n = n0 + nl; int rowi = n;
          if (MODE == 1) rowi = (n >> 7) * 256 + (n & 127);
          if (MODE == 2) rowi = (n >> 7) * 256 + 128 + (n & 127);
          u32x4 w; w.x = pk2(v[0], v[1]); w.y = pk2(v[2], v[3]); w.z = pk2(v[4], v[5]); w.w = pk2(v[6], v[7]);
          *(u32x4*)(dst + (size_t)(row_off + rowi) * ldd + koff + k0 + kc) = w; }
        __syncthreads();
    }
}

__device__ __forceinline__ void prep_phase(const Params& p, float* lds, int bid, int nb) {
    unsigned char* ws = p.ws;
    s5_gen(p, (bf16_t*)(ws + OFF_BTY), (bf16_t*)(ws + OFF_BTZ), lds, bid, nb);
    tr_job<0>(p.in[10], 1024, 2048, (bf16_t*)(ws + OFF_WIN), 1024, 0, 0, nullptr, lds, bid, nb);
    tr_job<0>(p.in[19], 512, 512, (bf16_t*)(ws + OFF_WGLU), 512, 0, 0, nullptr, lds, bid, nb);
    tr_job<0>(p.in[27], 1024, 1024, (bf16_t*)(ws + OFF_WOUT), 1024, 0, 0, nullptr, lds, bid, nb);
    for (int l = 0; l < 2; ++l) {
        bf16_t* gu = (bf16_t*)(ws + (l ? OFF_WGU1 : OFF_WGU0)); bf16_t* dn = (bf16_t*)(ws + (l ? OFF_WDN1 : OFF_WDN0));
        tr_job<1>(p.in[7] + (size_t)l * 1024 * FF, 1024, FF, gu, 1024, 0, 0, nullptr, lds, bid, nb);
        tr_job<2>(p.in[8] + (size_t)l * 1024 * FF, 1024, FF, gu, 1024, 0, 0, nullptr, lds, bid, nb);
        tr_job<0>(p.in[9] + (size_t)l * FF * 1024, FF, 1024, dn, FF, 0, 0, nullptr, lds, bid, nb);
    }
    bf16_t* wrkv = (bf16_t*)(ws + OFF_WG1); bf16_t* wl1 = (bf16_t*)(ws + OFF_WL1); const float* mu = p.in[28];
    tr_job<0>(p.in[29], 1024, 1024, wrkv, 1024, 0, 0, nullptr, lds, bid, nb);
    tr_job<0>(p.in[30], 1024, 1024, wrkv, 1024, 1024, 0, nullptr, lds, bid, nb);
    tr_job<0>(p.in[31], 1024, 1024, wrkv, 1024, 2048, 0, nullptr, lds, bid, nb);
    tr_job<0>(p.in[34], 1024, 64, wl1, 2048, 0, 0, nullptr, lds, bid, nb);      tr_job<0>(p.in[34], 1024, 64, wl1, 2048, 0, 1024, mu + 1 * 1024, lds, bid, nb, mu + 3 * 1024);
    tr_job<0>(p.in[37], 1024, 64, wl1, 2048, 64, 0, nullptr, lds, bid, nb);     tr_job<0>(p.in[37], 1024, 64, wl1, 2048, 64, 1024, mu + 4 * 1024, lds, bid, nb, mu + 3 * 1024);
    tr_job<0>(p.in[39], 1024, 128, wl1, 2048, 128, 0, nullptr, lds, bid, nb);   tr_job<0>(p.in[39], 1024, 128, wl1, 2048, 128, 1024, mu + 5 * 1024, lds, bid, nb, mu + 3 * 1024);
    bf16_t* l2 = (bf16_t*)(ws + OFF_WL2);
    tr_job<0>(p.in[35], 64, 1024, l2, 256, 0, 0, nullptr, lds, bid, nb);
    tr_job<0>(p.in[38], 64, 1024, l2, 256, 1024, 64, nullptr, lds, bid, nb);
    tr_job<0>(p.in[40], 128, 1024, l2, 256, 2048, 128, nullptr, lds, bid, nb);
    for (int i = bid * NTHR + threadIdx.x; i < 3072 * 32; i += nb * NTHR) { const int n = i >> 5, kc = (i & 31) * 8; const int sel = n >> 10;
        const bool used = (sel == 0) ? (kc < 64) : (sel == 1) ? (kc >= 64 && kc < 128) : (kc >= 128);
        if (!used) *(u32x4*)(l2 + (size_t)n * 256 + kc) = (u32x4){0u, 0u, 0u, 0u}; }
    tr_job<0>(p.in[32], 1024, 1024, (bf16_t*)(ws + OFF_WO), 1024, 0, 0, nullptr, lds, bid, nb);
    {   const float* c = p.in[1]; const float* wada = p.in[3]; const float* bada = p.in[4]; float* mod = (float*)(ws + OFF_MOD);
        float* cact = lds;
        float* red = lds + 4096;
        for (int i = threadIdx.x; i < 4096; i += NTHR) { const float x = c[i]; cact[i] = x / (1.f + expf(-x)); }
        __syncthreads();
        const int col = threadIdx.x & 63, kg = threadIdx.x >> 6;
        for (int ch = bid; ch < 192; ch += nb) {
            const int l = ch / 96, n0 = (ch % 96) * 64;
            const float* wp = wada + (size_t)l * 1024 * 6144 + n0 + col;
            float a0 = 0.f, a1 = 0.f, a2 = 0.f, a3 = 0.f;
            for (int k = kg * 128; k < kg * 128 + 128; ++k) { const float w = wp[(size_t)k * 6144]; a0 += cact[k] * w; a1 += cact[1024 + k] * w; a2 += cact[2048 + k] * w; a3 += cact[3072 + k] * w; }
            red[(kg * 4 + 0) * 64 + col] = a0; red[(kg * 4 + 1) * 64 + col] = a1; red[(kg * 4 + 2) * 64 + col] = a2; red[(kg * 4 + 3) * 64 + col] = a3;
            __syncthreads();
            if (threadIdx.x < 256) { const int b = threadIdx.x >> 6; float s = 0.f;
#pragma unroll
                for (int g = 0; g < 8; ++g) s += red[(g * 4 + b) * 64 + col];
                mod[(size_t)(l * 4 + b) * 6144 + n0 + col] = s + bada[l * 6144 + n0 + col]; }
            __syncthreads();
        }
    }
}

template <bool RW>
__device__ __forceinline__ void norm_phase(const float* x, const float* g, const float* modl, int shift_off, int scale_off, bf16_t* out, int bid, int nb, int row0 = 0, int nrows = MTOK, const float* mu = nullptr) {
    const int wave = threadIdx.x >> 6, lane = threadIdx.x & 63;
    for (int row = row0 + bid * 8 + wave; row < row0 + nrows; row += nb * 8) {
        const int b = row >> 12; const float* xr = x + (size_t)row * 1024; const float* md = modl + (size_t)b * 6144;
        f32x4 v[4], vp[4]; float ss = 0.f, ssp = 0.f; const bool hasp = RW && ((row & 4095) != 0);
#pragma unroll
        for (int i = 0; i < 4; ++i) { v[i] = *(const f32x4*)(xr + i * 256 + lane * 4); ss += v[i][0] * v[i][0] + v[i][1] * v[i][1] + v[i][2] * v[i][2] + v[i][3] * v[i][3];
            if (RW) { vp[i] = hasp ? *(const f32x4*)(xr - 1024 + i * 256 + lane * 4) : (f32x4){0.f, 0.f, 0.f, 0.f}; ssp += vp[i][0] * vp[i][0] + vp[i][1] * vp[i][1] + vp[i][2] * vp[i][2] + vp[i][3] * vp[i][3]; } }
        ss = wave_sum(ss); const float rstd = rsqrtf(ss * (1.f / 1024.f) + 1e-6f);
        float rstdp = 0.f; if (RW) { ssp = wave_sum(ssp); rstdp = rsqrtf(ssp * (1.f / 1024.f) + 1e-6f); }
#pragma unroll
        for (int i = 0; i < 4; ++i) { const int c = i * 256 + lane * 4; const f32x4 gg = *(const f32x4*)(g + c), sc = *(const f32x4*)(md + scale_off + c), sh = *(const f32x4*)(md + shift_off + c);
            f32x4 h;
#pragma unroll
            for (int j = 0; j < 4; ++j) h[j] = v[i][j] * rstd * gg[j] * (1.f + sc[j]) + sh[j];
            if (!RW) { u32x2 w; w.x = pk2(h[0], h[1]); w.y = pk2(h[2], h[3]); *(u32x2*)(out + (size_t)row * 1024 + c) = w; }
            else { f32x4 d;
#pragma unroll
                for (int j = 0; j < 4; ++j) { const float hp = hasp ? (vp[i][j] * rstdp * gg[j] * (1.f + sc[j]) + sh[j]) : 0.f; d[j] = hp - h[j]; }
                const f32x4 mr = *(const f32x4*)(mu + c), mk = *(const f32x4*)(mu + 2048 + c), mv = *(const f32x4*)(mu + 3072 + c);
                const f32x4 xr_ = h + d * mr, xk_ = h + d * mk, xv_ = h + d * mv;
                bf16_t* o = out + (size_t)(row - row0) * 4096 + c;
                u32x2 w; w.x = pk2(xr_[0], xr_[1]); w.y = pk2(xr_[2], xr_[3]); *(u32x2*)(o) = w;
                w.x = pk2(xk_[0], xk_[1]); w.y = pk2(xk_[2], xk_[3]); *(u32x2*)(o + 1024) = w;
                w.x = pk2(xv_[0], xv_[1]); w.y = pk2(xv_[2], xv_[3]); *(u32x2*)(o + 2048) = w;
                w.x = pk2(d[0], d[1]); w.y = pk2(d[2], d[3]); *(u32x2*)(o + 3072) = w; } }
    }
}

__device__ __forceinline__ void qknorm_phase(bf16_t* Q, bf16_t* Kb, const int* pos, const float* qn, const float* kn, int bid, int nb) {
    const int wave = threadIdx.x >> 6, lane = threadIdx.x & 63, l16 = lane & 15, d0 = l16 * 4;
    float invf[4];
#pragma unroll
    for (int j = 0; j < 4; ++j) invf[j] = powf(500000.f, -(float)((l16 & 1) * 4 + j) / 8.f);
    const f32x4 qw = *(const f32x4*)(qn + d0), kw = *(const f32x4*)(kn + d0);
    for (int tok = bid * 8 + wave; tok < MTOK; tok += nb * 8) {
        const float ps = (float)pos[tok];
        float cs[4], sn[4];
#pragma unroll
        for (int j = 0; j < 4; ++j) { const float ang = ps * invf[j]; float rv = ang * 0.15915494309189535f; rv -= floorf(rv); cs[j] = __builtin_amdgcn_cosf(rv); sn[j] = __builtin_amdgcn_sinf(rv); }
#pragma unroll
        for (int bsel = 0; bsel < 2; ++bsel) { bf16_t* buf = bsel ? Kb : Q; const f32x4 w = bsel ? kw : qw;
#pragma unroll
            for (int it = 0; it < 2; ++it) { const int vec = it * 4 + (lane >> 4); bf16_t* ptr = buf + (size_t)tok * 512 + vec * 64 + d0;
                const u32x2 raw = *(const u32x2*)ptr; float y[4] = {bflo(raw.x), bfhi(raw.x), bflo(raw.y), bfhi(raw.y)};
                float ss = y[0] * y[0] + y[1] * y[1] + y[2] * y[2] + y[3] * y[3];
                ss = dpp_sum16(ss);
                const float rstd = rsqrtf(ss * (1.f / 64.f) + 1e-6f);
#pragma unroll
                for (int j = 0; j < 4; ++j) y[j] = y[j] * rstd * w[j];
                float pr[4];
#pragma unroll
                for (int j = 0; j < 4; ++j) pr[j] = __int_as_float(__builtin_amdgcn_update_dpp(0, __float_as_int(y[j]), 0x4E, 0xf, 0xf, true));
                if (l16 < 2) {
#pragma unroll
                    for (int j = 0; j < 4; ++j) y[j] = y[j] * cs[j] - pr[j] * sn[j]; }
                else if (l16 < 4) {
#pragma unroll
                    for (int j = 0; j < 4; ++j) y[j] = y[j] * cs[j] + pr[j] * sn[j]; }
                if (!bsel) {
#pragma unroll
                    for (int j = 0; j < 4; ++j) y[j] *= 0.125f * 1.4426950408889634f; }
                u32x2 o; o.x = pk2(y[0], y[1]); o.y = pk2(y[2], y[3]); *(u32x2*)ptr = o; } }
    }
}

__device__ __forceinline__ void vtrans_phase(const bf16_t* V, bf16_t* Vt, bf16_t* lds, int bid, int nb) {
    const int tid = threadIdx.x;
    for (int unit = bid; unit < 1024; unit += nb) {
        const int head = unit & 3, ch = unit >> 2; const int b = ch >> 6, t0 = (ch & 63) * 64;
#pragma unroll
        for (int i = 0; i < 2; ++i) { const int idx = tid + i * 512, t = idx >> 4, cc = (idx & 15) * 8;
            const u32x4 w = *(const u32x4*)(V + ((size_t)b * SEQ + t0 + t) * 512 + head * 128 + cc);
            unsigned* d = (unsigned*)(lds + t * 130 + cc); d[0] = w.x; d[1] = w.y; d[2] = w.z; d[3] = w.w; }
        __syncthreads();
        { const int e = tid >> 2, tc = (tid & 3) * 16; unsigned o[8];
#pragma unroll
          for (int i = 0; i < 8; ++i) o[i] = (unsigned)lds[(tc + 2 * i) * 130 + e] | ((unsigned)lds[(tc + 2 * i + 1) * 130 + e] << 16);
          u32x4* dst = (u32x4*)(Vt + ((size_t)(b * 4 + head) * 128 + e) * SEQ + t0 + tc);
          dst[0] = (u32x4){o[0], o[1], o[2], o[3]}; dst[1] = (u32x4){o[4], o[5], o[6], o[7]}; }
        __syncthreads();
    }
}

typedef float f32x16 __attribute__((ext_vector_type(16)));
__device__ __forceinline__ void attn_phase(const bf16_t* Q, const bf16_t* Kb, const bf16_t* Vt, bf16_t* CAT, const Params& p, LAS unsigned char* lds, int bid, int nb) {
    const int tid = threadIdx.x, wave = __builtin_amdgcn_readfirstlane(tid >> 6), lane = tid & 63, c = wave >> 2, wq = wave & 3, l32 = lane & 31, hh = lane >> 5;
    constexpr int KROW = 272, VROW = 144, KBUF = 64 * KROW, VBUF = 128 * VROW, VOFF = 2 * KBUF;
    const int lkey = tid >> 4, lkc = tid & 15, lve = tid >> 3, lvc = tid & 7;
    for (int unit = bid; unit < 256; unit += nb) {
        const int b = unit & 3, head = (unit >> 2) & 3, pr = unit >> 4;
        const bf16_t* kg = Kb + ((size_t)b * SEQ + lkey) * 512 + head * 128 + lkc * 8;
        const bf16_t* vg = Vt + ((size_t)(b * 4 + head) * 128 + lve) * SEQ + lvc * 8;
        for (int half = 0; half < 2; ++half) {
            const int qb = half ? (31 - pr) : pr; const int q0 = qb * 128 + wq * 32; const int nst = (qb + 1) * 2;
            bf16x8 qf[4];
            { const bf16_t* qp = Q + ((size_t)b * SEQ + q0 + l32) * 512 + head * 128 + c * 64 + hh * 8;
#pragma unroll
              for (int ks = 0; ks < 4; ++ks) qf[ks] = *(const bf16x8*)(qp + ks * 16); }
            f32x16 o[4];
#pragma unroll
            for (int blk = 0; blk < 4; ++blk)
#pragma unroll
                for (int r = 0; r < 16; ++r) o[blk][r] = 0.f;
            float mrow = -INFINITY, lsum = 0.f;
            u32x4 kreg[2][2], vreg[2][2];
#define AT_ISSUE(set, st) do { const int st_ = ((st) < nst) ? (st) : nst - 1; kreg[set][0] = *(const u32x4*)(kg + (size_t)(st_ * 64) * 512); kreg[set][1] = *(const u32x4*)(kg + (size_t)(st_ * 64 + 32) * 512); \
                               vreg[set][0] = *(const u32x4*)(vg + st_ * 64); vreg[set][1] = *(const u32x4*)(vg + (size_t)64 * SEQ + st_ * 64); } while (0)
#define AT_WRITE(set, slot) do { *(LAS u32x4*)(lds + (slot) * KBUF + lkey * KROW + lkc * 16) = kreg[set][0]; *(LAS u32x4*)(lds + (slot) * KBUF + (lkey + 32) * KROW + lkc * 16) = kreg[set][1]; \
                                 LAS u32x2* vd0 = (LAS u32x2*)(lds + VOFF + (slot) * VBUF + lve * VROW + (lvc >> 1) * 32 + (lvc & 1) * 8); vd0[0] = (u32x2){vreg[set][0].x, vreg[set][0].y}; vd0[2] = (u32x2){vreg[set][0].z, vreg[set][0].w}; \
                                 LAS u32x2* vd1 = (LAS u32x2*)(lds + VOFF + (slot) * VBUF + (lve + 64) * VROW + (lvc >> 1) * 32 + (lvc & 1) * 8); vd1[0] = (u32x2){vreg[set][1].x, vreg[set][1].y}; vd1[2] = (u32x2){vreg[set][1].z, vreg[set][1].w}; } while (0)
#define AT_PACK(dst, sv, base) do { u32x4 pw_; pw_.x = cvt_pk_bf16(sv[(base) + 0], sv[(base) + 1]); pw_.y = cvt_pk_bf16(sv[(base) + 2], sv[(base) + 3]); pw_.z = cvt_pk_bf16(sv[(base) + 4], sv[(base) + 5]); pw_.w = cvt_pk_bf16(sv[(base) + 6], sv[(base) + 7]); dst = __builtin_bit_cast(bf16x8, pw_); } while (0)
#define AT_COMPUTE(slot, st, kfa, kfb, vfa, vfb) do { const int key0 = (st) * 64; \
                if (key0 <= q0 + 31) { \
                    LAS unsigned char* kb = lds + (slot) * KBUF + l32 * KROW + c * 128 + hh * 16; \
                    LAS unsigned char* vb = lds + VOFF + (slot) * VBUF + l32 * VROW + hh * 16; \
                    f32x16 s0, s1; _Pragma("unroll") for (int r = 0; r < 16; ++r) { s0[r] = 0.f; s1[r] = 0.f; } \
                    kfa[0] = *(const LAS bf16x8*)(kb); kfa[1] = *(const LAS bf16x8*)(kb + 32 * KROW); kfa[2] = *(const LAS bf16x8*)(kb + 32); kfa[3] = *(const LAS bf16x8*)(kb + 32 * KROW + 32); \
                    kfb[0] = *(const LAS bf16x8*)(kb + 64); kfb[1] = *(const LAS bf16x8*)(kb + 32 * KROW + 64); kfb[2] = *(const LAS bf16x8*)(kb + 96); kfb[3] = *(const LAS bf16x8*)(kb + 32 * KROW + 96); \
                    __builtin_amdgcn_sched_barrier(0); \
                    s0 = __builtin_amdgcn_mfma_f32_32x32x16_bf16(kfa[0], qf[0], s0, 0, 0, 0); s1 = __builtin_amdgcn_mfma_f32_32x32x16_bf16(kfa[1], qf[0], s1, 0, 0, 0); \
                    s0 = __builtin_amdgcn_mfma_f32_32x32x16_bf16(kfa[2], qf[1], s0, 0, 0, 0); s1 = __builtin_amdgcn_mfma_f32_32x32x16_bf16(kfa[3], qf[1], s1, 0, 0, 0); \
                    s0 = __builtin_amdgcn_mfma_f32_32x32x16_bf16(kfb[0], qf[2], s0, 0, 0, 0); s1 = __builtin_amdgcn_mfma_f32_32x32x16_bf16(kfb[1], qf[2], s1, 0, 0, 0); \
                    s0 = __builtin_amdgcn_mfma_f32_32x32x16_bf16(kfb[2], qf[3], s0, 0, 0, 0); s1 = __builtin_amdgcn_mfma_f32_32x32x16_bf16(kfb[3], qf[3], s1, 0, 0, 0); \
                    _Pragma("unroll") for (int blk = 0; blk < 4; ++blk) vfa[blk] = *(const LAS bf16x8*)(vb + blk * 32 * VROW); \
                    _Pragma("unroll") for (int blk = 0; blk < 4; ++blk) vfb[blk] = *(const LAS bf16x8*)(vb + blk * 32 * VROW + 32); \
                    __builtin_amdgcn_sched_barrier(0); \
                    if (key0 + 63 > q0) { const int qrel = q0 + l32 - key0; \
                        _Pragma("unroll") for (int r = 0; r < 16; ++r) { const int kl = (r & 3) + 8 * (r >> 2) + 4 * hh; if (kl > qrel) s0[r] = -INFINITY; if (kl + 32 > qrel) s1[r] = -INFINITY; } } \
                    float tm = fmaxf(s0[0], s1[0]); _Pragma("unroll") for (int r = 1; r < 16; ++r) tm = fmaxf(tm, fmaxf(s0[r], s1[r])); \
                    tm = fmaxf(tm, __shfl_xor(tm, 32)); \
                    const float mnew = fmaxf(mrow, tm); \
                    if (__any(mnew > mrow + 6.f)) { const float al = __builtin_amdgcn_exp2f(mrow - mnew); lsum *= al; \
                        _Pragma("unroll") for (int blk = 0; blk < 4; ++blk) _Pragma("unroll") for (int r = 0; r < 16; ++r) o[blk][r] *= al; \
                        mrow = mnew; } \
                    float ps = 0.f; _Pragma("unroll") for (int r = 0; r < 16; ++r) { s0[r] = __builtin_amdgcn_exp2f(s0[r] - mrow); s1[r] = __builtin_amdgcn_exp2f(s1[r] - mrow); ps += s0[r] + s1[r]; } \
                    lsum += ps; \
                    bf16x8 pb0, pb1, pb2, pb3; AT_PACK(pb0, s0, 0); AT_PACK(pb1, s0, 8); AT_PACK(pb2, s1, 0); AT_PACK(pb3, s1, 8); \
                    __builtin_amdgcn_sched_barrier(0); \
                    _Pragma("unroll") for (int blk = 0; blk < 4; ++blk) o[blk] = __builtin_amdgcn_mfma_f32_32x32x16_bf16(vfa[blk], pb0, o[blk], 0, 0, 0); \
                    _Pragma("unroll") for (int blk = 0; blk < 4; ++blk) o[blk] = __builtin_amdgcn_mfma_f32_32x32x16_bf16(vfb[blk], pb1, o[blk], 0, 0, 0); \
                    __builtin_amdgcn_sched_barrier(0); \
                    _Pragma("unroll") for (int blk = 0; blk < 4; ++blk) kfa[blk] = *(const LAS bf16x8*)(vb + blk * 32 * VROW + 64); \
                    _Pragma("unroll") for (int blk = 0; blk < 4; ++blk) kfb[blk] = *(const LAS bf16x8*)(vb + blk * 32 * VROW + 96); \
                    __builtin_amdgcn_sched_barrier(0); \
                    _Pragma("unroll") for (int blk = 0; blk < 4; ++blk) o[blk] = __builtin_amdgcn_mfma_f32_32x32x16_bf16(kfa[blk], pb2, o[blk], 0, 0, 0); \
                    _Pragma("unroll") for (int blk = 0; blk < 4; ++blk) o[blk] = __builtin_amdgcn_mfma_f32_32x32x16_bf16(kfb[blk], pb3, o[blk], 0, 0, 0); \
                } } while (0)
            bf16x8 fr0[4], fr1[4], fr2[4], fr3[4];
            AT_ISSUE(0, 0); AT_ISSUE(1, 1);
            __syncthreads();
            AT_WRITE(0, 0);
            __syncthreads();
            for (int st = 0; st < nst; st += 2) {
                AT_ISSUE(0, st + 2);
                AT_COMPUTE(0, st, fr0, fr1, fr2, fr3);
                AT_WRITE(1, 1);
                __syncthreads();
                AT_ISSUE(1, st + 3);
                AT_COMPUTE(1, st + 1, fr2, fr3, fr0, fr1);
                AT_WRITE(0, 0);
                __syncthreads();
            }
            lsum += __shfl_xor(lsum, 32);
            const float inv = 1.f / lsum;
            LAS float* xo = (LAS float*)lds + (wq * 128 + 4 * hh) * 32 + l32;
            if (c == 1) {
#pragma unroll
                for (int blk = 0; blk < 4; ++blk)
#pragma unroll
                    for (int r = 0; r < 16; ++r) xo[(blk * 32 + (r & 3) + 8 * (r >> 2)) * 32] = o[blk][r] * inv; }
            __syncthreads();
            if (c == 0) { float ss = 0.f; float lam; { float s1 = 0.f, s2 = 0.f; for (int d = 0; d < 64; ++d) { s1 += p.in[22][d] * p.in[23][d]; s2 += p.in[24][d] * p.in[25][d]; } lam = expf(s1) - expf(s2) + 0.2f; }
                const float* subln = p.in[26];
#pragma unroll
                for (int blk = 0; blk < 4; ++blk)
#pragma unroll
                    for (int r = 0; r < 16; ++r) { const float v = o[blk][r] * inv - lam * xo[(blk * 32 + (r & 3) + 8 * (r >> 2)) * 32]; o[blk][r] = v; ss += v * v; }
                ss += __shfl_xor(ss, 32);
                const float rstd = rsqrtf(ss * (1.f / 128.f) + 1e-6f) * 0.8f;
                bf16_t* op = CAT + ((size_t)b * SEQ + q0 + l32) * 1024 + 512 + head * 128 + 4 * hh;
#pragma unroll
                for (int blk = 0; blk < 4; ++blk)
#pragma unroll
                    for (int g4 = 0; g4 < 4; ++g4) { const f32x4 sg = *(const f32x4*)(subln + blk * 32 + g4 * 8 + 4 * hh);
                        u32x2 w; w.x = pk2(o[blk][g4 * 4 + 0] * rstd * sg[0], o[blk][g4 * 4 + 1] * rstd * sg[1]); w.y = pk2(o[blk][g4 * 4 + 2] * rstd * sg[2], o[blk][g4 * 4 + 3] * rstd * sg[3]);
                        *(u32x2*)(op + blk * 32 + g4 * 8) = w; } }
        }
    }
}

__device__ __forceinline__ void attn_combine(const bf16_t* OC, bf16_t* CAT, const Params& p, int bid, int nb) {
    const int wave = threadIdx.x >> 6, lane = threadIdx.x & 63, head = lane >> 4, e0 = (lane & 15) * 8;
    float lam;
    { float s1 = 0.f, s2 = 0.f; for (int d = 0; d < 64; ++d) { s1 += p.in[22][d] * p.in[23][d]; s2 += p.in[24][d] * p.in[25][d]; } lam = expf(s1) - expf(s2) + 0.2f; }
    float sub[8];
#pragma unroll
    for (int i = 0; i < 8; ++i) sub[i] = p.in[26][e0 + i] * 0.8f;
    for (int tok = bid * 8 + wave; tok < MTOK; tok += nb * 8) {
        const u32x4 a = *(const u32x4*)(OC + (size_t)tok * 1024 + (head * 2) * 128 + e0), bb = *(const u32x4*)(OC + (size_t)tok * 1024 + (head * 2 + 1) * 128 + e0);
        float o[8] = {bflo(a.x) - lam * bflo(bb.x), bfhi(a.x) - lam * bfhi(bb.x), bflo(a.y) - lam * bflo(bb.y), bfhi(a.y) - lam * bfhi(bb.y),
                      bflo(a.z) - lam * bflo(bb.z), bfhi(a.z) - lam * bfhi(bb.z), bflo(a.w) - lam * bflo(bb.w), bfhi(a.w) - lam * bfhi(bb.w)};
        float ss = 0.f;
#pragma unroll
        for (int i = 0; i < 8; ++i) ss += o[i] * o[i];
        ss = dpp_sum16(ss);
        const float rstd = rsqrtf(ss * (1.f / 128.f) + 1e-6f);
        u32x4 w; w.x = pk2(o[0] * rstd * sub[0], o[1] * rstd * sub[1]); w.y = pk2(o[2] * rstd * sub[2], o[3] * rstd * sub[3]); w.z = pk2(o[4] * rstd * sub[4], o[5] * rstd * sub[5]); w.w = pk2(o[6] * rstd * sub[6], o[7] * rstd * sub[7]);
        *(u32x4*)(CAT + (size_t)tok * 1024 + 512 + head * 128 + e0) = w;
    }
}

typedef float f32x2 __attribute__((ext_vector_type(2)));
__device__ __forceinline__ float h2f_(unsigned bits) { return (float)__builtin_bit_cast(_Float16, (unsigned short)bits); }
__device__ __forceinline__ void rwkv_phase(const Params& p, const bf16_t* R, const bf16_t* Kk, const bf16_t* Vv, const _Float16* DEC, const bf16_t* AA, bf16_t* Y, float* lds, int bid, int nb) {
    const int tid = threadIdx.x, wave = __builtin_amdgcn_readfirstlane(tid >> 6), lane = tid & 63;
    constexpr int TCH = 16, BUFF = 5 * TCH * 64 + TCH * 16;
    constexpr int OBUF = TCH * 16 * 16;
    float* Lout = lds + 2 * BUFF;
    for (int unit = bid; unit < 256; unit += nb) {
        const int b = unit >> 6, h = (unit >> 2) & 15, rq = unit & 3;
        __syncthreads();
        if (wave >= 4) {
            const int pw = wave - 4, tl = lane >> 4, c4 = (lane & 15) * 4;
            const f32x4 kkw = *(const f32x4*)(p.in[41] + h * 64 + c4), kaw = *(const f32x4*)(p.in[42] + h * 64 + c4);
            u32x2 rr[4], kr[4], ar[4], dr[4], vr[4];
            const unsigned lofs = (unsigned)((pw * 4 + tl) * 1024 + h * 64 + c4), vofs = (unsigned)((pw * 4 + tl) * 1024 + h * 64 + rq * 16 + (lane & 3) * 4);
            const bf16_t* Rb = R + (size_t)b * SEQ * 1024; const bf16_t* Kb_ = Kk + (size_t)b * SEQ * 1024; const bf16_t* Vb = Vv + (size_t)b * SEQ * 1024;
            const bf16_t* Ab = AA + (size_t)b * SEQ * 1024; const _Float16* Db = DEC + (size_t)b * SEQ * 1024;
#define RW_ISSUE(set, ch) do { const unsigned o_ = (unsigned)(ch) * (TCH * 1024) + lofs; rr[set] = *(const u32x2*)(Rb + o_); kr[set] = *(const u32x2*)(Kb_ + o_); dr[set] = *(const u32x2*)(Db + o_); ar[set] = *(const u32x2*)(Ab + o_); \
                    vr[set] = *(const u32x2*)(Vb + (unsigned)(ch) * (TCH * 1024) + vofs); } while (0)
#define RW_STAGE(set, buf) do { float* L = lds + (buf) * BUFF + (pw * 4 + tl) * 64 + c4; \
                    const f32x4 k = {bflo(kr[set].x), bfhi(kr[set].x), bflo(kr[set].y), bfhi(kr[set].y)}, a = {bflo(ar[set].x), bfhi(ar[set].x), bflo(ar[set].y), bfhi(ar[set].y)}; \
                    const f32x4 r = {bflo(rr[set].x), bfhi(rr[set].x), bflo(rr[set].y), bfhi(rr[set].y)}; \
                    const f32x4 w = {1.f - h2f_(dr[set].x & 0xffffu), 1.f - h2f_(dr[set].x >> 16), 1.f - h2f_(dr[set].y & 0xffffu), 1.f - h2f_(dr[set].y >> 16)}; \
                    f32x4 kk = k * kkw; const float n2 = dpp_sum16((kk[0] * kk[0] + kk[1] * kk[1]) + (kk[2] * kk[2] + kk[3] * kk[3])); kk = kk * __frsqrt_rn(fmaxf(n2, 1e-24f)); \
                    *(f32x4*)(L) = w; *(f32x4*)(L + 1 * TCH * 64) = -kk; *(f32x4*)(L + 2 * TCH * 64) = kk * a; *(f32x4*)(L + 3 * TCH * 64) = k * (1.f + (a - 1.f) * kaw); *(f32x4*)(L + 4 * TCH * 64) = r; \
                    if ((lane & 15) < 4) *(f32x4*)(lds + (buf) * BUFF + 5 * TCH * 64 + (pw * 4 + tl) * 16 + (lane & 3) * 4) = (f32x4){bflo(vr[set].x), bfhi(vr[set].x), bflo(vr[set].y), bfhi(vr[set].y)}; } while (0)
            auto flush = [&](int ch) { const int i = tid - 256, tt = i >> 4, row = i & 15; const f32x4* pp = (const f32x4*)(Lout + (ch & 1) * OBUF + i * 16);
                const f32x4 s4 = pp[0] + pp[1] + pp[2] + pp[3];
                Y[((size_t)b * SEQ + ch * TCH + tt) * 1024 + h * 64 + rq * 16 + row] = (bf16_t)f2bf((s4[0] + s4[1]) + (s4[2] + s4[3])); };
            constexpr int NCH = SEQ / TCH;
            RW_ISSUE(0, 0); RW_ISSUE(1, 1); RW_ISSUE(2, 2); RW_ISSUE(3, 3);
            RW_STAGE(0, 0);
            __syncthreads();
            for (int c4_ = 0; c4_ < NCH; c4_ += 4) {
#define RW_ITER(q) do { const int ch = c4_ + (q); RW_STAGE(((q) + 1) & 3, (ch + 1) & 1); { const int chn = (ch + 4 < NCH) ? ch + 4 : NCH - 1; RW_ISSUE((q), chn); } flush(ch > 0 ? ch - 1 : 0); __syncthreads(); } while (0)
                RW_ITER(0); RW_ITER(1); RW_ITER(2); RW_ITER(3);
            }
            flush(NCH - 1);
        } else {
            const int j = lane & 15, rowl = wave * 4 + (lane >> 4);
            f32x2 S01 = {0.f, 0.f}, S23 = {0.f, 0.f};
            __syncthreads();
            for (int ch = 0; ch < SEQ / TCH; ++ch) {
                const float* L = lds + (ch & 1) * BUFF + j * 4; const float* Lv = lds + (ch & 1) * BUFF + 5 * TCH * 64 + rowl; float* Lo = Lout + (ch & 1) * OBUF + rowl * 16 + j;
                f32x4 w4 = *(const f32x4*)(L), a4 = *(const f32x4*)(L + 1 * TCH * 64), b4 = *(const f32x4*)(L + 2 * TCH * 64), k4 = *(const f32x4*)(L + 3 * TCH * 64), r4 = *(const f32x4*)(L + 4 * TCH * 64);
                float vv = Lv[0];
#pragma unroll
                for (int tt = 0; tt < TCH; ++tt) {
                    f32x4 nw4 = w4, na4 = a4, nb4 = b4, nk4 = k4, nr4 = r4; float nvv = vv;
                    if (tt + 1 < TCH) { const float* Ln = L + (tt + 1) * 64; nw4 = *(const f32x4*)(Ln); na4 = *(const f32x4*)(Ln + 1 * TCH * 64); nb4 = *(const f32x4*)(Ln + 2 * TCH * 64); nk4 = *(const f32x4*)(Ln + 3 * TCH * 64); nr4 = *(const f32x4*)(Ln + 4 * TCH * 64); nvv = Lv[(tt + 1) * 16]; }
                    f32x2 d = S01 * (f32x2){a4[0], a4[1]}; d = S23 * (f32x2){a4[2], a4[3]} + d;
                    const float sa = dpp_sum16(d[0] + d[1]);
                    const f32x2 sa2 = {sa, sa}, v2 = {vv, vv};
                    const f32x2 t01 = sa2 * (f32x2){b4[0], b4[1]} + v2 * (f32x2){k4[0], k4[1]}, t23 = sa2 * (f32x2){b4[2], b4[3]} + v2 * (f32x2){k4[2], k4[3]};
                    S01 = S01 * (f32x2){w4[0], w4[1]} + t01; S23 = S23 * (f32x2){w4[2], w4[3]} + t23;
                    f32x2 y = S01 * (f32x2){r4[0], r4[1]}; y = S23 * (f32x2){r4[2], r4[3]} + y;
                    Lo[tt * 256] = y[0] + y[1];
                    w4 = nw4; a4 = na4; b4 = nb4; k4 = nk4; r4 = nr4; vv = nvv;
                }
                __syncthreads();
            }
        }
    }
}

__device__ __forceinline__ void rwkv_post(const Params& p, bf16_t* R, const bf16_t* Kk, const bf16_t* Vv, const bf16_t* AA, const bf16_t* G, const bf16_t* Y, int bid, int nb) {
    const int wave = threadIdx.x >> 6, lane = threadIdx.x & 63;
    for (int it = bid * 8 + wave; it < MTOK * 16; it += nb * 8) {
        const int h = it & 15; const size_t off = (size_t)(it >> 4) * 1024 + h * 64 + lane;
        const float y = bf2f(Y[off]), r = bf2f(R[off]), k = bf2f(Kk[off]), v = bf2f(Vv[off]), a = bf2f(AA[off]), g = bf2f(G[off]);
        const float mean = wave_sum(y) * (1.f / 64.f); const float d = y - mean; const float var = wave_sum(d * d) * (1.f / 64.f);
        const float k2 = k * (1.f + (a - 1.f) * p.in[42][h * 64 + lane]);
        const float sb = wave_sum(r * k2 * p.in[43][h * 64 + lane]);
        const float yn = d * rsqrtf(var + 64e-5f) * p.in[44][h * 64 + lane] + p.in[45][h * 64 + lane] + sb * v;
        R[off] = (bf16_t)f2bf(yn * g);
    }
}

#define XB_TMO      128
#define XB_XCNT(j)  (256  + 64 * (j))
#define XB_XSUB(j)  (1280 + 64 * (j))
#define XB_XGEN(j)  (2304 + 64 * (j))
#define XB_TOP      3328
#define XB_TOPGEN   3392
#define XCD_BAR_WORDS 3456
#define XB_SPIN_CAP (1u << 18)
__device__ __forceinline__ unsigned xb_ld(unsigned* p)              { return __hip_atomic_load(p, __ATOMIC_RELAXED, __HIP_MEMORY_SCOPE_AGENT); }
__device__ __forceinline__ unsigned xb_add(unsigned* p, unsigned v) { return __hip_atomic_fetch_add(p, v, __ATOMIC_RELAXED, __HIP_MEMORY_SCOPE_AGENT); }
__device__ __forceinline__ unsigned xb_xcc_id() { return (unsigned)__builtin_amdgcn_s_getreg((3 << 11) | 20) & 0xFu; }
#define XB_SPIN(cond, bar) do { unsigned _sp = 0; while (cond) { __builtin_amdgcn_s_sleep(1); \
    if ((++_sp & 255u) == 0u) { if (xb_ld(&(bar)[XB_TMO])) break; if (_sp > XB_SPIN_CAP) { atomicAdd(&(bar)[XB_TMO], 1u); break; } } } } while (0)
struct XcdBarrier { unsigned* bar; unsigned x; volatile LAS unsigned* st; };
__device__ __forceinline__ XcdBarrier xcd_barrier_post(unsigned* bar, volatile LAS unsigned* st) {
    XcdBarrier b; b.bar = bar; b.x = xb_xcc_id(); b.st = st;
    if (threadIdx.x == 0) (void)xb_add(&bar[XB_XCNT(b.x)], 1u);
    return b;
}
__device__ __forceinline__ void xcd_barrier_complete(unsigned* bar, unsigned x, unsigned& nloc, unsigned& nx) {
    const unsigned G = gridDim.x * gridDim.y * gridDim.z;
    unsigned sum, cnt, mine, sp = 0u;
    for (;;) {
        sum = 0u; cnt = 0u; mine = 0u;
#pragma unroll
        for (unsigned j = 0; j < 16; ++j) { const unsigned c = xb_ld(&bar[XB_XCNT(j)]); sum += c; cnt += (c > 0u) ? 1u : 0u; mine = (j == x) ? c : mine; }
        if (sum == G) break;
        __builtin_amdgcn_s_sleep(1);
        if ((++sp & 255u) == 0u) { if (xb_ld(&bar[XB_TMO])) break; if (sp > XB_SPIN_CAP) { atomicAdd(&bar[XB_TMO], 1u); break; } }
    }
    nloc = mine > 0u ? mine : 1u; nx = cnt > 0u ? cnt : 1u;
}
__device__ __forceinline__ void xcd_barrier(const XcdBarrier& b) {
    asm volatile("s_waitcnt vmcnt(0)" ::: "memory");
    __syncthreads();
    if (threadIdx.x == 0) {
        unsigned* bar = b.bar;
        __builtin_amdgcn_s_waitcnt(0);
        unsigned nloc = b.st[0], nx = b.st[1];
        if (nloc == 0u) { xcd_barrier_complete(bar, b.x, nloc, nx); b.st[0] = nloc; b.st[1] = nx; }
        const unsigned old = xb_add(&bar[XB_XSUB(b.x)], 1u);
        const unsigned gen = old / nloc;
        if (old + 1u == (gen + 1u) * nloc) {
            __builtin_amdgcn_fence(__ATOMIC_RELEASE, "agent");
            asm volatile("s_waitcnt vmcnt(0)" ::: "memory");
            const unsigned og = xb_add(&bar[XB_TOP], 1u);
            const unsigned tg = og / nx;
            if (og + 1u == (tg + 1u) * nx) xb_add(&bar[XB_TOPGEN], 1u);
            else XB_SPIN(xb_ld(&bar[XB_TOPGEN]) == tg, bar);
            __builtin_amdgcn_fence(__ATOMIC_ACQUIRE, "agent");
            xb_add(&bar[XB_XGEN(b.x)], 1u);
            asm volatile("s_waitcnt vmcnt(0)" ::: "memory");
        } else {
            XB_SPIN(xb_ld(&bar[XB_XGEN(b.x)]) == gen, bar);
            __builtin_amdgcn_fence(__ATOMIC_ACQUIRE, "agent");
            asm volatile("s_waitcnt vmcnt(0)" ::: "memory");
        }
    }
    __syncthreads();
}

__global__ void __launch_bounds__(NTHR) fwd_kernel(Params p) {
    extern __shared__ __attribute__((aligned(16))) unsigned char lds_raw[];
    LAS unsigned char* lds = (LAS unsigned char*)lds_raw;
    float* ldsf = (float*)lds_raw;
    const int bid = blockIdx.x, nb = gridDim.x;
    unsigned char* ws = p.ws;
    float* mod = (float*)(ws + OFF_MOD);
    const bool multi = (p.ph_hi - p.ph_lo) > 1;
    __shared__ unsigned xb_st[4];
    if (threadIdx.x < 4) xb_st[threadIdx.x] = 0u;
    __syncthreads();
    XcdBarrier xbar; xbar.bar = (unsigned*)(ws + OFF_BAR); xbar.x = 0; xbar.st = (volatile LAS unsigned*)xb_st;
    if (multi) xbar = xcd_barrier_post((unsigned*)(ws + OFF_BAR), (volatile LAS unsigned*)xb_st);
#ifndef TESTPH
#define TESTPH -1
#endif
#ifndef REPEAT_A
#define REPEAT_A -1
#endif
#ifndef REPEAT_B
#define REPEAT_B -1
#endif
#ifndef EXTRA_SYNCS
#define EXTRA_SYNCS 0
#endif
#define PH(k) if ((TESTPH < 0 || TESTPH == (k)) && p.ph_lo <= (k) && (k) < p.ph_hi) for (int rep_ = 0; rep_ < (((k) == REPEAT_A || (k) == REPEAT_B) ? 2 : 1); ++rep_)
#define SYNC(k) if (multi) { xcd_barrier(xbar); }
    for (int es_ = 0; es_ < EXTRA_SYNCS; ++es_) cg::this_grid().sync();
    if (p.ph_lo < -1000) cg::this_grid().sync();
    PH(0) { prep_phase(p, ldsf, bid, nb); SYNC(0) }
    PH(1) { norm_phase<false>(p.in[0], p.in[5], mod, 0, 1024, (bf16_t*)(ws + OFF_HA), bid, nb); SYNC(1) }
    PH(2) { EpiWin e{(bf16_t*)(ws + OFF_UX), (bf16_t*)(ws + OFF_QKV)}; gemm_stream(lds, (const bf16_t*)(ws + OFF_HA), (const bf16_t*)(ws + OFF_WIN), 2048, 1024, e, bid, nb); SYNC(2) }
    PH(3) { { EpiS5Z e{(float*)(ws + OFF_Z)}; gemm_batched(lds, (const bf16_t*)(ws + OFF_UX), 640, (size_t)512 * 640, (const bf16_t*)(ws + OFF_BTZ), (size_t)256 * 512, 2, 1, 32, 512, e, NoPre{}, bid, nb); }
            bf16_t* q = (bf16_t*)(ws + OFF_QKV);
            if (nb > 128) { if (bid >= 64) qknorm_phase(q, q + (size_t)MTOK * 512, (const int*)p.in[2], p.in[20], p.in[21], bid - 64, nb - 64); }
            else qknorm_phase(q, q + (size_t)MTOK * 512, (const int*)p.in[2], p.in[20], p.in[21], bid, nb);
            vtrans_phase(q + (size_t)MTOK * 1024, (bf16_t*)(ws + OFF_VT), (bf16_t*)lds_raw, bid, nb); SYNC(3) }
    PH(5) { { EpiS5Y e{(const bf16_t*)(ws + OFF_UX), (bf16_t*)(ws + OFF_YG), p.in[18]}; PreS5Y pre{(const float*)(ws + OFF_Z), (bf16_t*)(ws + OFF_UX), p.in[11], p.in[12], p.in[13]};
              gemm_batched(lds, (const bf16_t*)(ws + OFF_UX), 640, (size_t)512 * 640, (const bf16_t*)(ws + OFF_BTY), (size_t)512 * 640, 2, 2, 32, 640, e, pre, bid, nb); }
            bf16_t* q = (bf16_t*)(ws + OFF_QKV); attn_phase(q, q + (size_t)MTOK * 512, (const bf16_t*)(ws + OFF_VT), (bf16_t*)(ws + OFF_CAT), p, lds, bid, nb); SYNC(5) }
    PH(6) {
            EpiGlu e{(const bf16_t*)(ws + OFF_YG), (bf16_t*)(ws + OFF_CAT)}; gemm_phase(lds, (const bf16_t*)(ws + OFF_YG), (const bf16_t*)(ws + OFF_WGLU), 512, 512, e, bid, nb); SYNC(6) }
    PH(7) { EpiRes e{p.in[0], p.out, mod + 2048}; gemm_stream(lds, (const bf16_t*)(ws + OFF_CAT), (const bf16_t*)(ws + OFF_WOUT), 1024, 1024, e, bid, nb); SYNC(7) }
    PH(8) { norm_phase<false>(p.out, p.in[6], mod, 3072, 4096, (bf16_t*)(ws + OFF_HA), bid, nb); SYNC(8) }
    PH(9) { EpiSwiglu e{(bf16_t*)(ws + OFF_HID)}; gemm_stream(lds, (const bf16_t*)(ws + OFF_HA), (const bf16_t*)(ws + OFF_WGU0), 5632, 1024, e, bid, nb); SYNC(9) }
    PH(10) { EpiRes e{p.out, p.out, mod + 5120}; gemm_stream(lds, (const bf16_t*)(ws + OFF_HID), (const bf16_t*)(ws + OFF_WDN0), 1024, FF, e, bid, nb); SYNC(10) }
    const float* mod1 = mod + 4 * 6144;
#define RWKV_FRONT(PA, PB, ROW0) \
    PH(PA) { norm_phase<true>(p.out, p.in[5] + 1024, mod1, 0, 1024, (bf16_t*)(ws + OFF_HD), bid, nb, (ROW0), 8192, p.in[28]); SYNC(PA) } \
    PH(PB) { const bf16_t* xall = (const bf16_t*)(ws + OFF_HD); const bool split = (nb == 256); \
               \
             { pg8::Gemm g{xall + 2048, (const bf16_t*)(ws + OFF_WL1), 8192, 256, 2048, 4096}; SchedOne S{(bid < 32) ? bid : -1}; EpiAdapt<EpiL1> ea{EpiL1{(bf16_t*)(ws + OFF_L1), (ROW0)}}; \
               pg8::gemm_phase<EpiAdapt<EpiL1>, SchedOne, false, true>(lds, g, S, ea); } \
             { pg8::Gemm g{xall, (const bf16_t*)(ws + OFF_WG1), 8192, 3072, 1024, 4096}; SchedRKV S{split ? bid - 32 : bid, split ? 224 : nb}; EpiAdaptRKV ea{EpiRKV{(bf16_t*)(ws + OFF_RKV), (ROW0)}}; \
               pg8::gemm_phase<EpiAdaptRKV, SchedRKV, true, true>(lds, g, S, ea); } \
             SYNC(PB) }
    RWKV_FRONT(11, 12, 0)
    RWKV_FRONT(20, 21, 8192)
    PH(13) { EpiL2 e{(_Float16*)(ws + OFF_DEC), (bf16_t*)(ws + OFF_AA), (bf16_t*)(ws + OFF_G), p.in[33], p.in[36]}; gemm_stream(lds, (const bf16_t*)(ws + OFF_L1), (const bf16_t*)(ws + OFF_WL2), 3072, 256, e, bid, nb); SYNC(13) }
    PH(14) { const bf16_t* r = (const bf16_t*)(ws + OFF_RKV); rwkv_phase(p, r, r + (size_t)MTOK * 1024, r + (size_t)MTOK * 2048, (const _Float16*)(ws + OFF_DEC), (const bf16_t*)(ws + OFF_AA), (bf16_t*)(ws + OFF_Y), ldsf, bid, nb); SYNC(14) }
    PH(15) { bf16_t* r = (bf16_t*)(ws + OFF_RKV); rwkv_post(p, r, r + (size_t)MTOK * 1024, r + (size_t)MTOK * 2048, (const bf16_t*)(ws + OFF_AA), (const bf16_t*)(ws + OFF_G), (const bf16_t*)(ws + OFF_Y), bid, nb); SYNC(15) }
    PH(16) { EpiRes e{p.out, p.out, mod1 + 2048}; gemm_stream(lds, (const bf16_t*)(ws + OFF_RKV), (const bf16_t*)(ws + OFF_WO), 1024, 1024, e, bid, nb); SYNC(16) }
    PH(17) { norm_phase<false>(p.out, p.in[6] + 1024, mod1, 3072, 4096, (bf16_t*)(ws + OFF_HA), bid, nb); SYNC(17) }
    PH(18) { EpiSwiglu e{(bf16_t*)(ws + OFF_HID)}; gemm_stream(lds, (const bf16_t*)(ws + OFF_HA), (const bf16_t*)(ws + OFF_WGU1), 5632, 1024, e, bid, nb); SYNC(18) }
    PH(19) { EpiRes e{p.out, p.out, mod1 + 5120}; gemm_stream(lds, (const bf16_t*)(ws + OFF_HID), (const bf16_t*)(ws + OFF_WDN1), 1024, FF, e, bid, nb); }
}

constexpr int NPHASE = 22;
#ifndef ONE_LAUNCH
#define ONE_LAUNCH 1
#endif

extern "C" void kernel_launch(void* const* d_in, const int* in_sizes, int n_in, void* d_out, int out_size, void* d_ws, size_t ws_size, hipStream_t stream) {
    static int grid = 0;
    if (grid == 0) {
        if (n_in != 46 || ws_size < WS_NEED) { fprintf(stderr, "kernel_launch: unexpected n_in %d / ws_size %zu (need %zu)\n", n_in, ws_size, (size_t)WS_NEED); grid = -1; return; }
        if (hipFuncSetAttribute((const void*)fwd_kernel, hipFuncAttributeMaxDynamicSharedMemorySize, LDS_BYTES) != hipSuccess) { fprintf(stderr, "hipFuncSetAttribute failed\n"); grid = -1; return; }
        int dev = 0, cus = 0, per_cu = 0;
        (void)hipGetDevice(&dev); (void)hipDeviceGetAttribute(&cus, hipDeviceAttributeMultiprocessorCount, dev);
        (void)hipOccupancyMaxActiveBlocksPerMultiprocessor(&per_cu, (const void*)fwd_kernel, NTHR, LDS_BYTES);
        if (per_cu < 1) per_cu = 1;
        grid = cus;
    }
    if (grid < 0) return;
    Params p{};
    for (int i = 0; i < 46; ++i) p.in[i] = (const float*)d_in[i];
    p.out = (float*)d_out; p.ws = (unsigned char*)d_ws;
#if ONE_LAUNCH
    p.ph_lo = 0; p.ph_hi = NPHASE;
    if (hipMemsetAsync((char*)d_ws + OFF_BAR, 0, XCD_BAR_WORDS * 4, stream) != hipSuccess) { fprintf(stderr, "memset failed\n"); return; }
    void* args[] = {&p};
    hipError_t e = hipLaunchCooperativeKernel((const void*)fwd_kernel, dim3(grid), dim3(NTHR), args, LDS_BYTES, stream);
    if (e != hipSuccess) fprintf(stderr, "cooperative launch failed: %s (grid %d)\n", hipGetErrorString(e), grid);
#else
    for (int ph = 0; ph < NPHASE; ++ph) { p.ph_lo = ph; p.ph_hi = ph + 1; hipLaunchKernelGGL(fwd_kernel, dim3(grid), dim3(NTHR), LDS_BYTES, stream, p); }
#endif
}
```

```cpp
#include <hip/hip_runtime.h>
#include <hip/hip_cooperative_groups.h>
#include <cstdio>
#include <cstdint>
namespace cg = cooperative_groups;

#define LAS __attribute__((address_space(3)))
typedef unsigned short bf16_t;
typedef short bf16x8 __attribute__((ext_vector_type(8)));
typedef float f32x4 __attribute__((ext_vector_type(4)));
typedef unsigned u32x2 __attribute__((ext_vector_type(2)));
typedef unsigned u32x4 __attribute__((ext_vector_type(4)));

constexpr int MTOK = 16384, DM = 1024, SEQ = 4096, FF = 2816;
constexpr int NTHR = 512;
constexpr int LDS_BYTES = 131072;
constexpr size_t MiB = 1048576;
constexpr size_t OFF_WIN = 0;
constexpr size_t OFF_WGLU = 4194304;
constexpr size_t OFF_WOUT = 4718592;
constexpr size_t OFF_WGU0 = 6815744;
constexpr size_t OFF_WDN0 = 18350080;
constexpr size_t OFF_WGU1 = 39321600;
constexpr size_t OFF_WDN1 = 50855936;
constexpr size_t OFF_WG1 = 24117248;
constexpr size_t OFF_WL1 = 24117248 + 6291456;
constexpr size_t OFF_WL2 = 37748736;
constexpr size_t OFF_WO = 56623104;
constexpr size_t OFF_MOD = 58720256;
constexpr size_t OFF_BAR = 58916864;
constexpr size_t ACT = 57 * MiB;
constexpr size_t OFF_HA = ACT;
constexpr size_t OFF_UX = ACT + 32 * MiB;
constexpr size_t OFF_Z = ACT + 52 * MiB;
constexpr size_t OFF_BTZ = ACT + 112 * MiB;
constexpr size_t OFF_BTY = ACT + 176 * MiB;
constexpr size_t OFF_QKV = ACT + 64 * MiB;
constexpr size_t OFF_CAT = ACT + 112 * MiB;
constexpr size_t OFF_YG = ACT + 144 * MiB;
constexpr size_t OFF_VT = ACT + 160 * MiB;
constexpr size_t OFF_OC = ACT;
constexpr size_t OFF_HID = ACT + 32 * MiB;
constexpr size_t OFF_HD = ACT;
constexpr size_t OFF_RKV = ACT + 64 * MiB;
constexpr size_t OFF_G = ACT + 160 * MiB;
constexpr size_t OFF_Y = 0;
constexpr size_t OFF_L1 = 0;
constexpr size_t OFF_DEC = ACT;
constexpr size_t OFF_AA = ACT + 32 * MiB;
constexpr size_t WS_NEED = ACT + 196 * MiB;

struct Params {
    const float* in[46];
    float* out;
    unsigned char* ws;
    int ph_lo, ph_hi;
};

__device__ __forceinline__ unsigned f2bf(float f) { unsigned u = __float_as_uint(f); return (u + 0x7fffu + ((u >> 16) & 1u)) >> 16; }
__device__ __forceinline__ float bf2f(unsigned h) { return __uint_as_float(h << 16); }
__device__ __forceinline__ unsigned cvt_pk_bf16(float lo, float hi) { unsigned r; asm("v_cvt_pk_bf16_f32 %0, %1, %2" : "=v"(r) : "v"(lo), "v"(hi)); return r; }
__device__ __forceinline__ unsigned pk2(float lo, float hi) { return cvt_pk_bf16(lo, hi); }
__device__ __forceinline__ float bflo(unsigned w) { return __uint_as_float(w << 16); }
__device__ __forceinline__ float bfhi(unsigned w) { return __uint_as_float(w & 0xffff0000u); }
__device__ __forceinline__ float dpp_sum16(float x) {
    x += __int_as_float(__builtin_amdgcn_update_dpp(0, __float_as_int(x), 0xB1, 0xf, 0xf, true));
    x += __int_as_float(__builtin_amdgcn_update_dpp(0, __float_as_int(x), 0x4E, 0xf, 0xf, true));
    x += __int_as_float(__builtin_amdgcn_update_dpp(0, __float_as_int(x), 0x141, 0xf, 0xf, true));
    x += __int_as_float(__builtin_amdgcn_update_dpp(0, __float_as_int(x), 0x140, 0xf, 0xf, true));
    return x;
}
__device__ __forceinline__ float wave_sum(float v) {
    v = dpp_sum16(v);
    const float s0 = __int_as_float(__builtin_amdgcn_readlane(__float_as_int(v), 0)), s1 = __int_as_float(__builtin_amdgcn_readlane(__float_as_int(v), 16));
    const float s2 = __int_as_float(__builtin_amdgcn_readlane(__float_as_int(v), 32)), s3 = __int_as_float(__builtin_amdgcn_readlane(__float_as_int(v), 48));
    return (s0 + s1) + (s2 + s3);
}
__device__ __forceinline__ float sigmoidf_(float x) { return __fdividef(1.f, 1.f + __expf(-x)); }
__device__ __forceinline__ float tanh_fast(float x) { const float t = __expf(2.f * fminf(fmaxf(x, -15.f), 15.f)); return __fdividef(t - 1.f, t + 1.f); }
#define LWAIT() asm volatile("s_waitcnt lgkmcnt(0)" ::: "memory")
__device__ __forceinline__ float gelu_tanh(float x) { const float u = 0.7978845608028654f * (x + 0.044715f * x * x * x); const float t = __expf(2.f * fminf(fmaxf(u, -15.f), 15.f)); return __fdividef(x * t, t + 1.f); }

constexpr int HTB = 128 * 64 * 2;
__device__ __forceinline__ int lds_byte(int r, int c) { int st = (r >> 4) * 2 + (c >> 5), rr = r & 15, cc = c & 31, ob = rr * 64 + cc * 2; return st * 1024 + (ob ^ (((ob >> 9) & 1) << 5)); }
__device__ __forceinline__ void stage_rc(int b, int& R, int& C) { int st = b / 1024, sb = b % 1024, swz = sb ^ (((sb >> 9) & 1) << 5); R = (st >> 1) * 16 + swz / 64; C = (st & 1) * 32 + (swz % 64) / 2; }

struct NoPre { static constexpr bool NOP = true; __device__ __forceinline__ void operator()(int, int, int) const {} };
template <class Epi, class Pre, bool PF = true>
__device__ __forceinline__ void gemm_batched(LAS unsigned char* lds, const bf16_t* A, int lda, size_t strideA, const bf16_t* Bt, size_t strideB, int nMt, int nNt, int nbatch, int K, const Epi& E, const Pre& PRE, int bid, int nb) {
    const int tid = threadIdx.x, wid = __builtin_amdgcn_readfirstlane(tid >> 6), lane = tid & 63, wr = wid >> 2, wc = wid & 3, fr = lane & 15, fq = lane >> 4;
    unsigned voffA[2], voffB[2];
#pragma unroll
    for (int i = 0; i < 2; ++i) { int R, C; stage_rc(tid * 16 + i * 8192, R, C); voffA[i] = (unsigned)(R * lda + C) * 2u; voffB[i] = (unsigned)(R * K + C) * 2u; }
    const int aoff = lds_byte(wr * 64 + fr, fq * 8), boff = lds_byte(wc * 32 + fr, fq * 8);
    const unsigned ldsw = (unsigned)wid * 1024u;
    const size_t kstep = 128, hstepA = (size_t)128 * lda * 2, hstepB = (size_t)128 * K * 2;
    const int nt = K / 64;
    const int ntiles = nMt * nNt * nbatch;
#define G_SA(b, h) (((b) * 2 + (h)) * HTB)
#define G_SB(b, h) ((4 + (b) * 2 + (h)) * HTB)
#define G_STAGEX(bufoff, gptr, vo) do { _Pragma("unroll") for (int _i = 0; _i < 2; ++_i) \
        __builtin_amdgcn_global_load_lds((const unsigned*)((gptr) + vo[_i]), (LAS unsigned*)(lds + (bufoff) + ldsw + _i * 8192), 16, 0, 0); } while (0)
#define G_STA(bufoff, gptr) G_STAGEX(bufoff, gptr, voffA)
#define G_STB(bufoff, gptr) G_STAGEX(bufoff, gptr, voffB)
#define G_LDA(dst, b, h) do { _Pragma("unroll") for (int m = 0; m < 4; ++m) _Pragma("unroll") for (int k = 0; k < 2; ++k) dst[m][k] = *(const LAS bf16x8*)(lds + G_SA(b, h) + aoff + m * 2048 + k * 1024); } while (0)
#define G_LDB(dst, b, h) do { _Pragma("unroll") for (int n = 0; n < 2; ++n) _Pragma("unroll") for (int k = 0; k < 2; ++k) dst[n][k] = *(const LAS bf16x8*)(lds + G_SB(b, h) + boff + n * 2048 + k * 1024); } while (0)
#define G_MMA(ai, bj, At, Bx) do { __builtin_amdgcn_s_setprio(1); _Pragma("unroll") for (int m = 0; m < 4; ++m) _Pragma("unroll") for (int n = 0; n < 2; ++n) _Pragma("unroll") for (int k = 0; k < 2; ++k) \
        acc[ai][bj][m][n] = __builtin_amdgcn_mfma_f32_16x16x32_bf16(Bx[n][k], At[m][k], acc[ai][bj][m][n], 0, 0, 0); __builtin_amdgcn_s_setprio(0); } while (0)
#define G_WV(n) asm volatile("s_waitcnt vmcnt(" #n ")" ::: "memory")
#define G_WL(n) asm volatile("s_waitcnt lgkmcnt(" #n ")" ::: "memory")
#define G_BAR __builtin_amdgcn_s_barrier()
#define G_SCHED __builtin_amdgcn_sched_barrier(0)
    bool prefetched = false;
    for (int tile = bid; tile < ntiles; tile += nb) {
        const int pm = tile % nMt, tq = tile / nMt, pn = tq % nNt, gb = tq / nNt;
        PRE(gb, pm, pn);
        const char* cA = (const char*)(A + (size_t)gb * strideA) + (size_t)pm * 256 * lda * 2;
        const char* cB = (const char*)(Bt + (size_t)gb * strideB) + (size_t)pn * 256 * K * 2;
        f32x4 acc[2][2][4][2];
#pragma unroll
        for (int a = 0; a < 2; ++a)
#pragma unroll
            for (int b = 0; b < 2; ++b)
#pragma unroll
                for (int m = 0; m < 4; ++m)
#pragma unroll
                    for (int n = 0; n < 2; ++n) acc[a][b][m][n] = (f32x4){0.f, 0.f, 0.f, 0.f};
        bf16x8 At[4][2], B0[2][2], B1[2][2];
        if (!prefetched) { G_WV(0); G_STB(G_SB(0, 0), cB); G_STA(G_SA(0, 0), cA); G_STB(G_SB(0, 1), cB + hstepB); G_STA(G_SA(0, 1), cA + hstepA); }
        if (wr == 1) G_BAR;
        if (prefetched) G_WV(0); else G_WV(4);
        G_BAR;
        G_STB(G_SB(1, 0), cB + kstep); G_STA(G_SA(1, 0), cA + kstep); G_STB(G_SB(1, 1), cB + hstepB + kstep);
        G_WV(6); G_BAR;
        for (int t = 0; t < nt - 2; t += 2) {
            const char* a1 = cA + (size_t)(t + 1) * kstep; const char* a2 = cA + (size_t)(t + 2) * kstep; const char* a3 = a2 + kstep;
            const char* b2 = cB + (size_t)(t + 2) * kstep; const char* b3 = b2 + kstep;
            G_LDB(B0, 0, 0); G_SCHED; G_LDA(At, 0, 0); G_STA(G_SA(1, 1), a1 + hstepA);
            G_WL(8); G_BAR; G_WL(0); G_MMA(0, 0, At, B0); G_BAR; G_SCHED;
            G_LDB(B1, 0, 1); G_STB(G_SB(0, 0), b2);
            G_BAR; G_WL(0); G_MMA(0, 1, At, B1); G_BAR;
            G_LDA(At, 0, 1); G_STA(G_SA(0, 0), a2);
            G_BAR; G_WL(0); G_MMA(1, 0, At, B0); G_BAR; G_SCHED;
            G_STB(G_SB(0, 1), b2 + hstepB);
            G_WV(6); G_BAR; G_MMA(1, 1, At, B1); G_BAR;
            G_LDB(B0, 1, 0); G_SCHED; G_LDA(At, 1, 0); G_STA(G_SA(0, 1), a2 + hstepA);
            G_WL(8); G_BAR; G_WL(0); G_MMA(0, 0, At, B0); G_BAR; G_SCHED;
            G_LDB(B1, 1, 1); G_STB(G_SB(1, 0), b3);
            G_BAR; G_WL(0); G_MMA(0, 1, At, B1); G_BAR;
            G_LDA(At, 1, 1); G_STA(G_SA(1, 0), a3);
            G_BAR; G_WL(0); G_MMA(1, 0, At, B0); G_BAR; G_SCHED;
            G_STB(G_SB(1, 1), b3 + hstepB);
            G_WV(6); G_BAR; G_MMA(1, 1, At, B1); G_BAR;
        }
        {
            const char* a1 = cA + (size_t)(nt - 1) * kstep;
            G_LDB(B0, 0, 0); G_LDA(At, 0, 0); G_STA(G_SA(1, 1), a1 + hstepA);
            G_BAR; G_WL(0); G_MMA(0, 0, At, B0); G_BAR;
            G_LDB(B1, 0, 1); G_BAR; G_WL(0); G_MMA(0, 1, At, B1); G_BAR;
            G_LDA(At, 0, 1); G_WV(4); G_BAR; G_WL(0); G_MMA(1, 0, At, B0); G_MMA(1, 1, At, B1); G_BAR;
        }
        {
            G_LDB(B0, 1, 0); G_LDA(At, 1, 0); G_WV(2); G_BAR; G_WL(0); G_MMA(0, 0, At, B0); G_BAR;
            G_LDB(B1, 1, 1); G_WV(0); G_BAR; G_WL(0); G_MMA(0, 1, At, B1); G_BAR;
            G_LDA(At, 1, 1); G_BAR; G_WL(0); G_MMA(1, 0, At, B0); G_MMA(1, 1, At, B1); G_BAR;
        }
        if (wr == 0) G_BAR;
        prefetched = false;
        if (PF && Pre::NOP && tile + nb < ntiles) {
            const int t2 = tile + nb, pm2 = t2 % nMt, tq2 = t2 / nMt, pn2 = tq2 % nNt, gb2 = tq2 / nNt;
            const char* nA = (const char*)(A + (size_t)gb2 * strideA) + (size_t)pm2 * 256 * lda * 2;
            const char* nB = (const char*)(Bt + (size_t)gb2 * strideB) + (size_t)pn2 * 256 * K * 2;
            G_STB(G_SB(0, 0), nB); G_STA(G_SA(0, 0), nA); G_STB(G_SB(0, 1), nB + hstepB); G_STA(G_SA(0, 1), nA + hstepA);
            prefetched = true; }
        E(acc, gb, pm, pn, wr, wc, fr, fq);
    }
    G_WV(0);
    __syncthreads();
}

template <class Epi>
__device__ __forceinline__ void gemm_phase(LAS unsigned char* lds, const bf16_t* A, const bf16_t* Bt, int N, int K, const Epi& E, int bid, int nb) {
    gemm_batched(lds, A, K, 0, Bt, 0, 64, N / 256, 1, K, E, NoPre{}, bid, nb);
}

namespace pg8 {
#define PG8_LAS __attribute__((address_space(3)))
typedef unsigned short bf16_t;
typedef short bf16x8 __attribute__((ext_vector_type(8)));
typedef float f32x4 __attribute__((ext_vector_type(4)));
typedef unsigned u32x4 __attribute__((ext_vector_type(4)));
constexpr int BM = 256, BK = 64, HALF = 128, HTB = HALF * BK * 2  , STAGE_BYTES = 8 * HTB, NXCD = 8, WGM = 8;

__host__ __device__ __forceinline__ int lds_byte(int r, int c) { const int st = (r >> 4) * 2 + (c >> 5), rr = r & 15, cc = c & 31, ob = rr * 64 + cc * 2; return st * 1024 + (ob ^ (((ob >> 9) & 1) << 5)); }
__host__ __device__ __forceinline__ void stage_rc(int b, int& R, int& C) { const int st = b / 1024, sb = b % 1024, swz = sb ^ (((sb >> 9) & 1) << 5); R = (st >> 1) * 16 + swz / 64; C = (st & 1) * 32 + (swz % 64) / 2; }
__host__ __device__ __forceinline__ int perm32(int rho) { const int n = rho >> 4, i = rho & 15; return 8 * (i >> 2) + 4 * n + (i & 3); }

struct Unit { int pm, pn; int ao = 0; };
struct Gemm { const bf16_t* A; const bf16_t* Bt; int M, N, K; int lda; };

struct StaticOrder {
    int nM, nN, nwg, G, c;
    __host__ __device__ void init(int M, int N, int G_, int c_) { nM = M / BM; nN = N / BM; nwg = nM * nN; G = G_; c = c_; }
    __host__ __device__ bool next(int i, Unit& u) const {
        const long L = (long)i * G + c; if (L >= nwg) return false;
        int wgid = (int)L; { const int q = nwg / NXCD, r = nwg % NXCD, xcd = wgid % NXCD, off = wgid / NXCD; wgid = (xcd < r ? xcd * (q + 1) : r * (q + 1) + (xcd - r) * q) + off; }
        const int nig = WGM * nN, gid = wgid / nig, fm = gid * WGM, gsz = (nM - fm) < WGM ? (nM - fm) : WGM;
        u.pm = fm + ((wgid % nig) % gsz); u.pn = (wgid % nig) / gsz; return true;
    }
    __device__ __forceinline__ void a_ready(const Unit&) const {}
    __device__ __forceinline__ void done(const Unit&) const {}
};
template <class Epi, class Sched, bool ALIGN_EPI = false, bool SP2 = false>
__device__ __forceinline__ void gemm_phase(PG8_LAS unsigned char* lds, const Gemm g, const Sched& S, const Epi& E) {
    const int tid = threadIdx.x, wid = __builtin_amdgcn_readfirstlane(tid >> 6), lane = tid & 63, wr = wid >> 2, wc = wid & 3, fr = lane & 15, fq = lane >> 4;
    const int K = g.K, nt = K / BK;
    unsigned voffA[2], voffB[2];
#pragma unroll
    for (int i = 0; i < 2; ++i) { int R, C; stage_rc(tid * 16 + i * 8192, R, C); const int Rb = Epi::PERM ? ((R & ~31) + perm32(R & 31)) : R;
        voffA[i] = (unsigned)(R * g.lda + C) * 2u; voffB[i] = (unsigned)(Rb * K + C) * 2u; }
    const size_t kstep = (size_t)(BK * 2);
    const size_t hstep = (size_t)HALF * K * 2;
    const size_t tstep = 2 * hstep;
    const size_t hstepA = (size_t)HALF * g.lda * 2, tstepA = 2 * hstepA;
    const unsigned ldsw = (unsigned)wid * 1024u;
    const int aoff = lds_byte(wr * 64 + fr, fq * 8), boff = lds_byte(wc * 32 + fr, fq * 8);
#define PG8_SA(b, h) (((b) * 2 + (h)) * HTB)
#define PG8_SB(b, h) ((4 + (b) * 2 + (h)) * HTB)
#define PG8_STAGE(bufoff, gbase, voff) do { _Pragma("unroll") for (int _i = 0; _i < 2; ++_i) \
        __builtin_amdgcn_global_load_lds((const unsigned*)((const char*)(gbase) + (voff)[_i]), (PG8_LAS unsigned*)(lds + (bufoff) + ldsw + _i * 8192), 16, 0, 0); } while (0)
#define PG8_LDA(dst, b, h) do { _Pragma("unroll") for (int m = 0; m < 4; ++m) _Pragma("unroll") for (int k = 0; k < 2; ++k) dst[m][k] = *(const PG8_LAS bf16x8*)(lds + PG8_SA(b, h) + aoff + m * 2048 + k * 1024); } while (0)
#define PG8_LDB(dst, b, h) do { _Pragma("unroll") for (int n = 0; n < 2; ++n) _Pragma("unroll") for (int k = 0; k < 2; ++k) dst[n][k] = *(const PG8_LAS bf16x8*)(lds + PG8_SB(b, h) + boff + n * 2048 + k * 1024); } while (0)
#define PG8_MMA(ai, bj, At, Bt) do { __builtin_amdgcn_s_setprio(1); _Pragma("unroll") for (int m = 0; m < 4; ++m) _Pragma("unroll") for (int n = 0; n < 2; ++n) _Pragma("unroll") for (int k = 0; k < 2; ++k) \
        acc[ai][bj][m][n] = __builtin_amdgcn_mfma_f32_16x16x32_bf16(Bt[n][k], At[m][k], acc[ai][bj][m][n], 0, 0, 0); __builtin_amdgcn_s_setprio(0); } while (0)
#define PG8_WAIT_V(n) asm volatile("s_waitcnt vmcnt(" #n ")" ::: "memory")
#define PG8_WAIT_L(n) asm volatile("s_waitcnt lgkmcnt(" #n ")" ::: "memory")
#define PG8_BAR __builtin_amdgcn_s_barrier()
#define PG8_SCHED __builtin_amdgcn_sched_barrier(0)
    Unit cur, nxt; int ui = 0;
    if (!S.next(0, cur)) return;
    f32x4 acc[2][2][4][2];
#pragma unroll
    for (int a = 0; a < 2; ++a)
#pragma unroll
        for (int b = 0; b < 2; ++b)
#pragma unroll
            for (int m = 0; m < 4; ++m)
#pragma unroll
                for (int n = 0; n < 2; ++n) acc[a][b][m][n] = (f32x4){0.f, 0.f, 0.f, 0.f};
    bf16x8 At[4][2], B0[2][2], B1[2][2];
    const char* cA = (const char*)g.A + (size_t)cur.pm * tstepA + cur.ao; const char* cB = (const char*)g.Bt + (size_t)cur.pn * tstep;
    S.a_ready(cur);
    if constexpr (SP2) {
        PG8_STAGE(PG8_SB(0, 0), cB, voffB); PG8_STAGE(PG8_SB(0, 1), cB + hstep, voffB); PG8_STAGE(PG8_SA(0, 0), cA, voffA); PG8_STAGE(PG8_SA(0, 1), cA + hstepA, voffA);
        if (wr == 1) PG8_BAR;
        PG8_WAIT_V(2); PG8_BAR;
        PG8_STAGE(PG8_SB(1, 0), cB + kstep, voffB); PG8_STAGE(PG8_SA(1, 0), cA + kstep, voffA); PG8_STAGE(PG8_SB(1, 1), cB + hstep + kstep, voffB);
        PG8_WAIT_V(6); PG8_BAR;
    } else {
        PG8_STAGE(PG8_SB(0, 0), cB, voffB); PG8_STAGE(PG8_SA(0, 0), cA, voffA); PG8_STAGE(PG8_SB(0, 1), cB + hstep, voffB); PG8_STAGE(PG8_SA(0, 1), cA + hstepA, voffA);
        if (wr == 1) PG8_BAR;
        PG8_WAIT_V(4); PG8_BAR;
        PG8_STAGE(PG8_SB(1, 0), cB + kstep, voffB); PG8_STAGE(PG8_SA(1, 0), cA + kstep, voffA); PG8_STAGE(PG8_SB(1, 1), cB + hstep + kstep, voffB);
        PG8_WAIT_V(6); PG8_BAR;
    }
    for (;;) {
        const bool has_next = S.next(ui + 1, nxt);
        const char* nA = has_next ? (const char*)g.A + (size_t)nxt.pm * tstepA + nxt.ao : cA; const char* nB = has_next ? (const char*)g.Bt + (size_t)nxt.pn * tstep : cB;
        for (int t = 0; t < nt; t += 2) {
            const bool last = (t == nt - 2);
            const char* a1 = cA + (size_t)(t + 1) * kstep;
            const char* a2 = last ? nA : cA + (size_t)(t + 2) * kstep; const char* b2 = last ? nB : cB + (size_t)(t + 2) * kstep;
            const char* a3 = a2 + kstep; const char* b3 = b2 + kstep;
            if (last && has_next) S.a_ready(nxt);
            if constexpr (SP2) {
            PG8_LDB(B0, 0, 0); PG8_LDB(B1, 0, 1); PG8_SCHED; PG8_LDA(At, 0, 0); PG8_STAGE(PG8_SA(1, 1), a1 + hstepA, voffA);
            PG8_WAIT_V(8); PG8_WAIT_L(0); PG8_BAR; PG8_MMA(0, 0, At, B0); PG8_MMA(0, 1, At, B1); PG8_BAR; PG8_SCHED;
            PG8_LDA(At, 0, 1); PG8_STAGE(PG8_SB(0, 0), b2, voffB); PG8_STAGE(PG8_SB(0, 1), b2 + hstep, voffB); PG8_STAGE(PG8_SA(0, 0), a2, voffA);
            PG8_WAIT_V(8); PG8_WAIT_L(0); PG8_BAR; PG8_MMA(1, 0, At, B0); PG8_MMA(1, 1, At, B1); PG8_BAR; PG8_SCHED;
            PG8_LDB(B0, 1, 0); PG8_LDB(B1, 1, 1); PG8_SCHED; PG8_LDA(At, 1, 0); PG8_STAGE(PG8_SA(0, 1), a2 + hstepA, voffA);
            PG8_WAIT_V(8); PG8_WAIT_L(0); PG8_BAR; PG8_MMA(0, 0, At, B0); PG8_MMA(0, 1, At, B1); PG8_BAR; PG8_SCHED;
            PG8_LDA(At, 1, 1); PG8_STAGE(PG8_SB(1, 0), b3, voffB); PG8_STAGE(PG8_SB(1, 1), b3 + hstep, voffB); PG8_STAGE(PG8_SA(1, 0), a3, voffA);
            PG8_WAIT_V(8); PG8_WAIT_L(0); PG8_BAR; PG8_MMA(1, 0, At, B0); PG8_MMA(1, 1, At, B1); PG8_BAR; PG8_SCHED;
            } else {
            PG8_LDB(B0, 0, 0); PG8_SCHED; PG8_LDA(At, 0, 0); PG8_STAGE(PG8_SA(1, 1), a1 + hstepA, voffA);
            PG8_WAIT_L(8); PG8_BAR; PG8_WAIT_L(0); PG8_MMA(0, 0, At, B0); PG8_BAR; PG8_SCHED;
            PG8_LDB(B1, 0, 1); PG8_STAGE(PG8_SB(0, 0), b2, voffB);
            PG8_BAR; PG8_WAIT_L(0); PG8_MMA(0, 1, At, B1); PG8_BAR;
            PG8_LDA(At, 0, 1); PG8_STAGE(PG8_SA(0, 0), a2, voffA);
            PG8_BAR; PG8_WAIT_L(0); PG8_MMA(1, 0, At, B0); PG8_BAR; PG8_SCHED;
            PG8_STAGE(PG8_SB(0, 1), b2 + hstep, voffB);
            PG8_WAIT_V(6); PG8_BAR; PG8_MMA(1, 1, At, B1); PG8_BAR;
            PG8_LDB(B0, 1, 0); PG8_SCHED; PG8_LDA(At, 1, 0); PG8_STAGE(PG8_SA(0, 1), a2 + hstepA, voffA);
            PG8_WAIT_L(8); PG8_BAR; PG8_WAIT_L(0); PG8_MMA(0, 0, At, B0); PG8_BAR; PG8_SCHED;
            PG8_LDB(B1, 1, 1); PG8_STAGE(PG8_SB(1, 0), b3, voffB);
            PG8_BAR; PG8_WAIT_L(0); PG8_MMA(0, 1, At, B1); PG8_BAR;
            PG8_LDA(At, 1, 1); PG8_STAGE(PG8_SA(1, 0), a3, voffA);
            PG8_BAR; PG8_WAIT_L(0); PG8_MMA(1, 0, At, B0); PG8_BAR; PG8_SCHED;
            PG8_STAGE(PG8_SB(1, 1), b3 + hstep, voffB);
            PG8_WAIT_V(6); PG8_BAR; PG8_MMA(1, 1, At, B1); PG8_BAR;
            }
        }
        if constexpr (ALIGN_EPI) { if (wr == 0) PG8_BAR; }
        if constexpr (!Epi::AFTER_DRAIN) { E(acc, cur, wr, wc, fr, fq); S.done(cur); }
        if (!has_next) break;
#pragma unroll
        for (int a = 0; a < 2; ++a)
#pragma unroll
            for (int b = 0; b < 2; ++b)
#pragma unroll
                for (int m = 0; m < 4; ++m)
#pragma unroll
                    for (int n = 0; n < 2; ++n) acc[a][b][m][n] = (f32x4){0.f, 0.f, 0.f, 0.f};
        cur = nxt; cA = nA; cB = nB; ++ui;
        if constexpr (ALIGN_EPI) { if (wr == 1) PG8_BAR; }
    }
    PG8_WAIT_V(0);
    if constexpr (!ALIGN_EPI) { if (wr == 0) PG8_BAR; }
    PG8_BAR;
    if constexpr (Epi::AFTER_DRAIN) { E.fused(acc, cur, wr, wc, fr, fq, lds, wid, lane); S.done(cur); }
#undef PG8_SA
#undef PG8_SB
#undef PG8_STAGE
#undef PG8_LDA
#undef PG8_LDB
#undef PG8_MMA
#undef PG8_WAIT_V
#undef PG8_WAIT_L
#undef PG8_BAR
#undef PG8_SCHED
}
}

template <class E> struct EpiAdapt { static constexpr bool PERM = false, AFTER_DRAIN = false; E e;
    __device__ __forceinline__ void operator()(const pg8::f32x4 (&acc)[2][2][4][2], const pg8::Unit& u, int wr, int wc, int fr, int fq) const { e(acc, 0, u.pm, u.pn, wr, wc, fr, fq); } };
template <class Epi>
__device__ __forceinline__ void gemm_stream(LAS unsigned char* lds, const bf16_t* A, const bf16_t* Bt, int N, int K, const Epi& E, int bid, int nb) {
    pg8::Gemm g{A, Bt, MTOK, N, K, K}; pg8::StaticOrder S; S.init(MTOK, N, nb, bid);
    EpiAdapt<Epi> ea{E};
    pg8::gemm_phase<EpiAdapt<Epi>, pg8::StaticOrder, true, true>(lds, g, S, ea);
}

#define EPI_LOOP(...) \
    _Pragma("unroll") for (int ai = 0; ai < 2; ++ai) _Pragma("unroll") for (int m = 0; m < 4; ++m) { asm volatile("" ::: "memory"); const int row = pm * 256 + ai * 128 + wr * 64 + m * 16 + fr; \
    _Pragma("unroll") for (int bj = 0; bj < 2; ++bj) _Pragma("unroll") for (int n = 0; n < 2; ++n) { const int ct = bj * 128 + wc * 32 + n * 16 + fq * 4; const f32x4 v = acc[ai][bj][m][n]; __VA_ARGS__ } }

struct EpiWin {
    bf16_t* UX; bf16_t* QKV;
    __device__ __forceinline__ void operator()(const f32x4 (&acc)[2][2][4][2], int gb, int pm, int pn, int wr, int wc, int fr, int fq) const {
        if (pn < 2) {
            bf16_t* base = UX + ((size_t)(pn * 16 + wc * 2) * 512 + (pm >> 4) * 128 + (pm & 15) * 8 + wr * 2) * 640 + fr * 16 + fq * 4;
#pragma unroll
            for (int ai = 0; ai < 2; ++ai)
#pragma unroll
                for (int m = 0; m < 4; ++m) { bf16_t* rp = base + (ai * 4 + (m >> 1)) * 640 + (m & 1) * 256;
#pragma unroll
                    for (int bj = 0; bj < 2; ++bj)
#pragma unroll
                        for (int n = 0; n < 2; ++n) { const f32x4 v = acc[ai][bj][m][n]; u32x2 w; w.x = pk2(v[0], v[1]); w.y = pk2(v[2], v[3]);
                            *(u32x2*)(rp + (size_t)(bj * 8 + n) * (512 * 640)) = w; }
                    asm volatile("" ::: "memory"); }
        } else { bf16_t* base = QKV + (size_t)((pn - 2) >> 1) * ((size_t)MTOK * 512) + (pn & 1) * 256 + (size_t)(pm * 256 + wr * 64 + fr) * 512 + wc * 32 + fq * 4;
#pragma unroll
            for (int ai = 0; ai < 2; ++ai)
#pragma unroll
                for (int m = 0; m < 4; ++m) { bf16_t* rp = base + (size_t)(ai * 128 + m * 16) * 512;
#pragma unroll
                    for (int bj = 0; bj < 2; ++bj)
#pragma unroll
                        for (int n = 0; n < 2; ++n) { const f32x4 v = acc[ai][bj][m][n]; u32x2 w; w.x = pk2(v[0], v[1]); w.y = pk2(v[2], v[3]);
                            *(u32x2*)(rp + bj * 128 + n * 16) = w; }
                    asm volatile("" ::: "memory"); }
        }
    }
};
struct EpiS5Z {
    float* Z;
    __device__ __forceinline__ void operator()(const f32x4 (&acc)[2][2][4][2], int gb, int pm, int pn, int wr, int wc, int fr, int fq) const {
        EPI_LOOP({ if (bj == 0) *(f32x4*)(Z + ((size_t)gb * 512 + row) * 128 + ct) = v; })
    }
};
struct EpiS5Y {
    const bf16_t* UX; bf16_t* YG; const float* dsk;
    __device__ __forceinline__ void operator()(const f32x4 (&acc)[2][2][4][2], int gb, int pm, int pn, int wr, int wc, int fr, int fq) const {
        EPI_LOOP({ const int col = pn * 256 + ct, t = col >> 4, h = col & 15, bb = row >> 7, cc = row & 127;
            const u32x2 uu = *(const u32x2*)(UX + ((size_t)gb * 512 + row) * 640 + col); const f32x4 dd = *(const f32x4*)(dsk + gb * 16 + h);
            u32x2 w; w.x = pk2(gelu_tanh(v[0] + dd[0] * bflo(uu.x)), gelu_tanh(v[1] + dd[1] * bfhi(uu.x))); w.y = pk2(gelu_tanh(v[2] + dd[2] * bflo(uu.y)), gelu_tanh(v[3] + dd[3] * bfhi(uu.y)));
            *(u32x2*)(YG + ((size_t)bb * SEQ + cc * 32 + t) * 512 + gb * 16 + h) = w; })
    }
};
struct PreS5Y {   static constexpr bool NOP = false;
    const float* Z; bf16_t* UX; const float* lam_re; const float* lam_im; const float* log_dt;
    __device__ __forceinline__ void operator()(int gb, int pm, int pn) const {
        const int tid = threadIdx.x;
        if (tid < 128) { const int pp = tid & 63, bb = 2 * pm + (tid >> 6);
            const float lr = lam_re[gb * 64 + pp], li = lam_im[gb * 64 + pp], dt = expf(log_dt[gb]);
            const float mag = expf(lr * dt * 32.f), ar = mag * cosf(li * dt * 32.f), ai = mag * sinf(li * dt * 32.f);
            const float* zp = Z + ((size_t)gb * 512 + bb * 128) * 128 + pp; bf16_t* xp = UX + ((size_t)gb * 512 + bb * 128) * 640 + 512 + pp;
            float xr = 0.f, xi = 0.f;
            for (int c0 = 0; c0 < 128; c0 += 16) { float zr[16], zi[16];
#pragma unroll
                for (int i = 0; i < 16; ++i) { zr[i] = zp[(size_t)(c0 + i) * 128]; zi[i] = zp[(size_t)(c0 + i) * 128 + 64]; }
#pragma unroll
                for (int i = 0; i < 16; ++i) { xp[(size_t)(c0 + i) * 640] = (bf16_t)f2bf(xr); xp[(size_t)(c0 + i) * 640 + 64] = (bf16_t)f2bf(xi);
                    const float nr = ar * xr - ai * xi + zr[i], ni = ar * xi + ai * xr + zi[i]; xr = nr; xi = ni; } } }
        __threadfence();
        asm volatile("s_waitcnt vmcnt(0)" ::: "memory");
        __syncthreads();
    }
};
struct EpiGlu {
    const bf16_t* YG; bf16_t* CAT;
    __device__ __forceinline__ void operator()(const f32x4 (&acc)[2][2][4][2], int gb, int pm, int pn, int wr, int wc, int fr, int fq) const {
        EPI_LOOP({ const int col = pn * 256 + ct; const u32x2 y = *(const u32x2*)(YG + (size_t)row * 512 + col);
            u32x2 w; w.x = pk2(bflo(y.x) * sigmoidf_(v[0]), bfhi(y.x) * sigmoidf_(v[1])); w.y = pk2(bflo(y.y) * sigmoidf_(v[2]), bfhi(y.y) * sigmoidf_(v[3]));
            *(u32x2*)(CAT + (size_t)row * 1024 + col) = w; })
    }
};
struct EpiRes {
    const float* res; float* out; const float* gate;
    __device__ __forceinline__ void operator()(const f32x4 (&acc)[2][2][4][2], int gb, int pm, int pn, int wr, int wc, int fr, int fq) const {
        const float* gatep = gate + (size_t)(pm >> 4) * 6144;
        EPI_LOOP({ const int col = pn * 256 + ct; const f32x4 g = *(const f32x4*)(gatep + col); const f32x4 r = *(const f32x4*)(res + (size_t)row * 1024 + col);
            *(f32x4*)(out + (size_t)row * 1024 + col) = r + g * v; })
    }
};
struct EpiSwiglu {
    bf16_t* HID;
    __device__ __forceinline__ void operator()(const f32x4 (&acc)[2][2][4][2], int gb, int pm, int pn, int wr, int wc, int fr, int fq) const {
#pragma unroll
        for (int ai = 0; ai < 2; ++ai)
#pragma unroll
            for (int m = 0; m < 4; ++m) { const int row = pm * 256 + ai * 128 + wr * 64 + m * 16 + fr;
#pragma unroll
                for (int n = 0; n < 2; ++n) { const f32x4 g = acc[ai][0][m][n], u = acc[ai][1][m][n]; float o[4];
#pragma unroll
                    for (int j = 0; j < 4; ++j) o[j] = g[j] * sigmoidf_(g[j]) * u[j];
                    u32x2 w; w.x = pk2(o[0], o[1]); w.y = pk2(o[2], o[3]);
                    *(u32x2*)(HID + (size_t)row * FF + pn * 128 + wc * 32 + n * 16 + fq * 4) = w; } }
    }
};
struct EpiRKV {
    bf16_t* RKV; int row0;
    __device__ __forceinline__ void operator()(const f32x4 (&acc)[2][2][4][2], int gb, int pm, int pn, int wr, int wc, int fr, int fq) const {
        bf16_t* base = RKV + (size_t)gb * ((size_t)MTOK * 1024) + (size_t)row0 * 1024 + pn * 256;
        EPI_LOOP({ u32x2 w; w.x = pk2(v[0], v[1]); w.y = pk2(v[2], v[3]); *(u32x2*)(base + (size_t)row * 1024 + ct) = w; })
    }
};
struct EpiL1 {
    bf16_t* L1; int row0;
    __device__ __forceinline__ void operator()(const f32x4 (&acc)[2][2][4][2], int gb, int pm, int pn, int wr, int wc, int fr, int fq) const {
        bf16_t* base = L1 + (size_t)(row0 + pm * 256 + wr * 64 + fr) * 256 + wc * 32 + fq * 4;
        const bool ident = (wc >= 2);
#pragma unroll
        for (int ai = 0; ai < 2; ++ai)
#pragma unroll
            for (int m = 0; m < 4; ++m) { bf16_t* rp = base + (size_t)(ai * 128 + m * 16) * 256;
#pragma unroll
                for (int bj = 0; bj < 2; ++bj) { const float sc = bj ? 1.f : 2.f, of = bj ? 0.f : -1.f;
#pragma unroll
                    for (int n = 0; n < 2; ++n) { const f32x4 v = acc[ai][bj][m][n]; float o[4];
#pragma unroll
                        for (int j = 0; j < 4; ++j) { const float sg = sc * __builtin_amdgcn_rcpf(1.f + __expf(-sc * v[j])) + of; o[j] = (bj == 0 && ident) ? v[j] : sg; }
                        u32x2 w; w.x = pk2(o[0], o[1]); w.y = pk2(o[2], o[3]); *(u32x2*)(rp + bj * 128 + n * 16) = w; } }
                asm volatile("" ::: "memory"); }
    }
};
struct EpiL2 {
    _Float16* DEC; bf16_t* AA; bf16_t* G; const float* w0; const float* a0;
    __device__ __forceinline__ void operator()(const f32x4 (&acc)[2][2][4][2], int gb, int pm, int pn, int wr, int wc, int fr, int fq) const {
        const int sel = pn >> 2, cb = (pn & 3) * 256;
        if (sel == 0) { EPI_LOOP({ const int col = cb + ct; const f32x4 w0v = *(const f32x4*)(w0 + col);
                _Pragma("unroll") for (int j = 0; j < 4; ++j) { const float z = w0v[j] + v[j]; const float sp = fmaxf(-z, 0.f) + __logf(1.f + __expf(-fabsf(z))); const float e = __expf(-sp - 0.5f);
                    const float omd = (e < 0.125f) ? e * (1.f - e * (0.5f - e * (0.16666667f - e * (0.041666668f - e * 0.0083333338f)))) : 1.f - __expf(-e);
                    DEC[(size_t)row * 1024 + col + j] = (_Float16)omd; } }) }
        else if (sel == 1) { EPI_LOOP({ const int col = cb + ct; const f32x4 a0v = *(const f32x4*)(a0 + col);
                u32x2 w; w.x = pk2(sigmoidf_(a0v[0] + v[0]), sigmoidf_(a0v[1] + v[1])); w.y = pk2(sigmoidf_(a0v[2] + v[2]), sigmoidf_(a0v[3] + v[3]));
                *(u32x2*)(AA + (size_t)row * 1024 + col) = w; }) }
        else { EPI_LOOP({ const int col = cb + ct; u32x2 w; w.x = pk2(v[0], v[1]); w.y = pk2(v[2], v[3]); *(u32x2*)(G + (size_t)row * 1024 + col) = w; }) }
    }
};


struct SchedRKV { int vb, vn;
    __device__ bool next(int i, pg8::Unit& u) const { const int t = vb + i * vn; if (vb < 0 || t >= 384) return false; u.pm = t & 31; u.pn = t >> 5; u.ao = (u.pn >> 2) * 2048; return true; }
    __device__ __forceinline__ void a_ready(const pg8::Unit&) const {}
    __device__ __forceinline__ void done(const pg8::Unit&) const {} };
struct SchedOne { int pm;
    __device__ bool next(int i, pg8::Unit& u) const { if (i > 0 || pm < 0) return false; u.pm = pm; u.pn = 0; u.ao = 0; return true; }
    __device__ __forceinline__ void a_ready(const pg8::Unit&) const {}
    __device__ __forceinline__ void done(const pg8::Unit&) const {} };
struct EpiAdaptRKV { static constexpr bool PERM = false, AFTER_DRAIN = false; EpiRKV e;
    __device__ __forceinline__ void operator()(const pg8::f32x4 (&acc)[2][2][4][2], const pg8::Unit& u, int wr, int wc, int fr, int fq) const { e(acc, u.pn >> 2, u.pm, u.pn & 3, wr, wc, fr, fq); } };
__device__ __forceinline__ void s5_gen(const Params& p, bf16_t* BtY, bf16_t* BtZ, float* lds, int bid, int nb) {
    float* PWr = lds; float* PWi = lds + 33 * 64; float* BBr = lds + 66 * 64; float* BBi = BBr + 1024; float* Cr = BBi + 1024; float* Ci = Cr + 1024; float* Kt = Ci + 1024;
    const int tid = threadIdx.x;
    for (int unit = bid; unit < 256; unit += nb) {
        const int g = unit >> 3, part = unit & 7;
        __syncthreads();
        { const float dt = expf(p.in[13][g]);
          for (int e = tid; e < 33 * 64; e += NTHR) { const int tau = e >> 6, pp = e & 63; const float lr = p.in[11][g * 64 + pp], li = p.in[12][g * 64 + pp];
              const float mag = expf(lr * dt * (float)tau), ang = li * dt * (float)tau; PWr[e] = mag * cosf(ang); PWi[e] = mag * sinf(ang); }
          __syncthreads();
          if (tid < 64) { const int pp = tid; const float lr = p.in[11][g * 64 + pp], li = p.in[12][g * 64 + pp];
              const float ar = PWr[64 + pp], ai = PWi[64 + pp], den = lr * lr + li * li, nr = ar - 1.f;
              const float qr = (nr * lr + ai * li) / den, qi = (ai * lr - nr * li) / den;
              for (int h = 0; h < 16; ++h) { const float br = p.in[14][(size_t)(g * 64 + pp) * 16 + h], bi = p.in[15][(size_t)(g * 64 + pp) * 16 + h]; BBr[pp * 16 + h] = qr * br - qi * bi; BBi[pp * 16 + h] = qr * bi + qi * br; } } }
        for (int i = tid; i < 1024; i += NTHR) { Cr[i] = p.in[16][(size_t)g * 1024 + i]; Ci[i] = p.in[17][(size_t)g * 1024 + i]; }
        __syncthreads();
        { const int tau = tid >> 4, h = tid & 15;
          float acc[16];
#pragma unroll
          for (int i = 0; i < 16; ++i) acc[i] = 0.f;
          for (int pp = 0; pp < 64; ++pp) { const float cr = Cr[h * 64 + pp], ci = Ci[h * 64 + pp], wr = PWr[tau * 64 + pp], wi = PWi[tau * 64 + pp];
              const float er = cr * wr - ci * wi, ei = cr * wi + ci * wr;
#pragma unroll
              for (int q = 0; q < 4; ++q) { const f32x4 br = *(const f32x4*)(BBr + pp * 16 + q * 4), bi = *(const f32x4*)(BBi + pp * 16 + q * 4);
#pragma unroll
                  for (int j = 0; j < 4; ++j) acc[q * 4 + j] += er * br[j] - ei * bi[j]; } }
#pragma unroll
          for (int q = 0; q < 4; ++q) *(f32x4*)(Kt + tau * 256 + h * 16 + q * 4) = (f32x4){acc[q * 4], acc[q * 4 + 1], acc[q * 4 + 2], acc[q * 4 + 3]}; }
        __syncthreads();
        for (int ci_ = tid; ci_ < 5120; ci_ += NTHR) { const int nrow = part * 64 + ci_ / 80, kc = (ci_ % 80) * 8, t = nrow >> 4, h = nrow & 15; float v[8];
#pragma unroll
            for (int i = 0; i < 8; ++i) { const int k = kc + i;
                if (k < 512) { const int sidx = k >> 4, h2 = k & 15; v[i] = (sidx <= t) ? Kt[(t - sidx) * 256 + h * 16 + h2] : 0.f; }
                else { const int jj = k - 512, pp = jj & 63; const float cr = Cr[h * 64 + pp], ci = Ci[h * 64 + pp], wr = PWr[(t + 1) * 64 + pp], wi = PWi[(t + 1) * 64 + pp];
                    v[i] = (jj >> 6) ? -(cr * wi + ci * wr) : (cr * wr - ci * wi); } }
            *(u32x4*)(BtY + ((size_t)g * 512 + nrow) * 640 + kc) = (u32x4){pk2(v[0], v[1]), pk2(v[2], v[3]), pk2(v[4], v[5]), pk2(v[6], v[7])}; }
        for (int ci_ = tid; ci_ < 1024; ci_ += NTHR) { const int n = part * 16 + (ci_ >> 6), kc = (ci_ & 63) * 8, pp = n & 63, im = n >> 6; float v[8];
#pragma unroll
            for (int i = 0; i < 8; ++i) { const int k = kc + i, sidx = k >> 4, h2 = k & 15, tau = 31 - sidx; const float wr = PWr[tau * 64 + pp], wi = PWi[tau * 64 + pp], br = BBr[pp * 16 + h2], bi = BBi[pp * 16 + h2];
                v[i] = im ? (wr * bi + wi * br) : (wr * br - wi * bi); }
            *(u32x4*)(BtZ + ((size_t)g * 256 + n) * 512 + kc) = (u32x4){pk2(v[0], v[1]), pk2(v[2], v[3]), pk2(v[4], v[5]), pk2(v[6], v[7])}; }
    }
    __syncthreads();
}

template <int MODE>
__device__ __forceinline__ void tr_job(const float* src, int K, int N, bf16_t* dst, int ldd, int row_off, int koff, const float* scale, float* lds, int bid, int nb, const float* scale2 = nullptr) {
    const int tk = K / 64, tn = N / 64, tid = threadIdx.x, nt_ = tk * tn;
    const int r = tid >> 3, c = (tid & 7) * 8;
    float4 a = {0.f, 0.f, 0.f, 0.f}, b = a; float sc = 1.f;
    if (bid < nt_) { const int k0 = (bid / tn) * 64, n0 = (bid % tn) * 64; const float* p = src + (size_t)(k0 + r) * N + n0 + c; a = *(const float4*)p; b = *(const float4*)(p + 4); sc = scale ? scale[k0 + r] - (scale2 ? scale2[k0 + r] : 0.f) : 1.f; }
    for (int t = bid; t < nt_; t += nb) {
        const int k0 = (t / tn) * 64, n0 = (t % tn) * 64;
        { float* l = lds + r * 65 + c; l[0] = a.x * sc; l[1] = a.y * sc; l[2] = a.z * sc; l[3] = a.w * sc; l[4] = b.x * sc; l[5] = b.y * sc; l[6] = b.z * sc; l[7] = b.w * sc; }
        if (t + nb < nt_) { const int t2 = t + nb, k2 = (t2 / tn) * 64, n2 = (t2 % tn) * 64; const float* p = src + (size_t)(k2 + r) * N + n2 + c; a = *(const float4*)p; b = *(const float4*)(p + 4); sc = scale ? scale[k2 + r] - (scale2 ? scale2[k2 + r] : 0.f) : 1.f; }
        __syncthreads();
        { const int nl = tid >> 3, kc = (tid & 7) * 8; float v[8];
#pragma unroll
          for (int i = 0; i < 8; ++i) v[i] = lds[(kc + i) * 65 + nl];
          int n = n0 + nl; int rowi = n;
          if (MODE == 1) rowi = (n >> 7) * 256 + (n & 127);
          if (MODE == 2) rowi = (n >> 7) * 256 + 128 + (n & 127);
          u32x4 w; w.x = pk2(v[0], v[1]); w.y = pk2(v[2], v[3]); w.z = pk2(v[4], v[5]); w.w = pk2(v[6], v[7]);
          *(u32x4*)(dst + (size_t)(row_off + rowi) * ldd + koff + k0 + kc) = w; }
        __syncthreads();
    }
}

__device__ __forceinline__ void prep_phase(const Params& p, float* lds, int bid, int nb) {
    unsigned char* ws = p.ws;
    s5_gen(p, (bf16_t*)(ws + OFF_BTY), (bf16_t*)(ws + OFF_BTZ), lds, bid, nb);
    tr_job<0>(p.in[10], 1024, 2048, (bf16_t*)(ws + OFF_WIN), 1024, 0, 0, nullptr, lds, bid, nb);
    tr_job<0>(p.in[19], 512, 512, (bf16_t*)(ws + OFF_WGLU), 512, 0, 0, nullptr, lds, bid, nb);
    tr_job<0>(p.in[27], 1024, 1024, (bf16_t*)(ws + OFF_WOUT), 1024, 0, 0, nullptr, lds, bid, nb);
    for (int l = 0; l < 2; ++l) {
        bf16_t* gu = (bf16_t*)(ws + (l ? OFF_WGU1 : OFF_WGU0)); bf16_t* dn = (bf16_t*)(ws + (l ? OFF_WDN1 : OFF_WDN0));
        tr_job<1>(p.in[7] + (size_t)l * 1024 * FF, 1024, FF, gu, 1024, 0, 0, nullptr, lds, bid, nb);
        tr_job<2>(p.in[8] + (size_t)l * 1024 * FF, 1024, FF, gu, 1024, 0, 0, nullptr, lds, bid, nb);
        tr_job<0>(p.in[9] + (size_t)l * FF * 1024, FF, 1024, dn, FF, 0, 0, nullptr, lds, bid, nb);
    }
    bf16_t* wrkv = (bf16_t*)(ws + OFF_WG1); bf16_t* wl1 = (bf16_t*)(ws + OFF_WL1); const float* mu = p.in[28];
    tr_job<0>(p.in[29], 1024, 1024, wrkv, 1024, 0, 0, nullptr, lds, bid, nb);
    tr_job<0>(p.in[30], 1024, 1024, wrkv, 1024, 1024, 0, nullptr, lds, bid, nb);
    tr_job<0>(p.in[31], 1024, 1024, wrkv, 1024, 2048, 0, nullptr, lds, bid, nb);
    tr_job<0>(p.in[34], 1024, 64, wl1, 2048, 0, 0, nullptr, lds, bid, nb);      tr_job<0>(p.in[34], 1024, 64, wl1, 2048, 0, 1024, mu + 1 * 1024, lds, bid, nb, mu + 3 * 1024);
    tr_job<0>(p.in[37], 1024, 64, wl1, 2048, 64, 0, nullptr, lds, bid, nb);     tr_job<0>(p.in[37], 1024, 64, wl1, 2048, 64, 1024, mu + 4 * 1024, lds, bid, nb, mu + 3 * 1024);
    tr_job<0>(p.in[39], 1024, 128, wl1, 2048, 128, 0, nullptr, lds, bid, nb);   tr_job<0>(p.in[39], 1024, 128, wl1, 2048, 128, 1024, mu + 5 * 1024, lds, bid, nb, mu + 3 * 1024);
    bf16_t* l2 = (bf16_t*)(ws + OFF_WL2);
    tr_job<0>(p.in[35], 64, 1024, l2, 256, 0, 0, nullptr, lds, bid, nb);
    tr_job<0>(p.in[38], 64, 1024, l2, 256, 1024, 64, nullptr, lds, bid, nb);
    tr_job<0>(p.in[40], 128, 1024, l2, 256, 2048, 128, nullptr, lds, bid, nb);
    for (int i = bid * NTHR + threadIdx.x; i < 3072 * 32; i += nb * NTHR) { const int n = i >> 5, kc = (i & 31) * 8; const int sel = n >> 10;
        const bool used = (sel == 0) ? (kc < 64) : (sel == 1) ? (kc >= 64 && kc < 128) : (kc >= 128);
        if (!used) *(u32x4*)(l2 + (size_t)n * 256 + kc) = (u32x4){0u, 0u, 0u, 0u}; }
    tr_job<0>(p.in[32], 1024, 1024, (bf16_t*)(ws + OFF_WO), 1024, 0, 0, nullptr, lds, bid, nb);
    {   const float* c = p.in[1]; const float* wada = p.in[3]; const float* bada = p.in[4]; float* mod = (float*)(ws + OFF_MOD);
        float* cact = lds;
        float* red = lds + 4096;
        for (int i = threadIdx.x; i < 4096; i += NTHR) { const float x = c[i]; cact[i] = x / (1.f + expf(-x)); }
        __syncthreads();
        const int col = threadIdx.x & 63, kg = threadIdx.x >> 6;
        for (int ch = bid; ch < 192; ch += nb) {
            const int l = ch / 96, n0 = (ch % 96) * 64;
            const float* wp = wada + (size_t)l * 1024 * 6144 + n0 + col;
            float a0 = 0.f, a1 = 0.f, a2 = 0.f, a3 = 0.f;
            for (int k = kg * 128; k < kg * 128 + 128; ++k) { const float w = wp[(size_t)k * 6144]; a0 += cact[k] * w; a1 += cact[1024 + k] * w; a2 += cact[2048 + k] * w; a3 += cact[3072 + k] * w; }
            red[(kg * 4 + 0) * 64 + col] = a0; red[(kg * 4 + 1) * 64 + col] = a1; red[(kg * 4 + 2) * 64 + col] = a2; red[(kg * 4 + 3) * 64 + col] = a3;
            __syncthreads();
            if (threadIdx.x < 256) { const int b = threadIdx.x >> 6; float s = 0.f;
#pragma unroll
                for (int g = 0; g < 8; ++g) s += red[(g * 4 + b) * 64 + col];
                mod[(size_t)(l * 4 + b) * 6144 + n0 + col] = s + bada[l * 6144 + n0 + col]; }
            __syncthreads();
        }
    }
}

template <bool RW>
__device__ __forceinline__ void norm_phase(const float* x, const float* g, const float* modl, int shift_off, int scale_off, bf16_t* out, int bid, int nb, int row0 = 0, int nrows = MTOK, const float* mu = nullptr) {
    const int wave = threadIdx.x >> 6, lane = threadIdx.x & 63;
    for (int row = row0 + bid * 8 + wave; row < row0 + nrows; row += nb * 8) {
        const int b = row >> 12; const float* xr = x + (size_t)row * 1024; const float* md = modl + (size_t)b * 6144;
        f32x4 v[4], vp[4]; float ss = 0.f, ssp = 0.f; const bool hasp = RW && ((row & 4095) != 0);
#pragma unroll
        for (int i = 0; i < 4; ++i) { v[i] = *(const f32x4*)(xr + i * 256 + lane * 4); ss += v[i][0] * v[i][0] + v[i][1] * v[i][1] + v[i][2] * v[i][2] + v[i][3] * v[i][3];
            if (RW) { vp[i] = hasp ? *(const f32x4*)(xr - 1024 + i * 256 + lane * 4) : (f32x4){0.f, 0.f, 0.f, 0.f}; ssp += vp[i][0] * vp[i][0] + vp[i][1] * vp[i][1] + vp[i][2] * vp[i][2] + vp[i][3] * vp[i][3]; } }
        ss = wave_sum(ss); const float rstd = rsqrtf(ss * (1.f / 1024.f) + 1e-6f);
        float rstdp = 0.f; if (RW) { ssp = wave_sum(ssp); rstdp = rsqrtf(ssp * (1.f / 1024.f) + 1e-6f); }
#pragma unroll
        for (int i = 0; i < 4; ++i) { const int c = i * 256 + lane * 4; const f32x4 gg = *(const f32x4*)(g + c), sc = *(const f32x4*)(md + scale_off + c), sh = *(const f32x4*)(md + shift_off + c);
            f32x4 h;
#pragma unroll
            for (int j = 0; j < 4; ++j) h[j] = v[i][j] * rstd * gg[j] * (1.f + sc[j]) + sh[j];
            if (!RW) { u32x2 w; w.x = pk2(h[0], h[1]); w.y = pk2(h[2], h[3]); *(u32x2*)(out + (size_t)row * 1024 + c) = w; }
            else { f32x4 d;
#pragma unroll
                for (int j = 0; j < 4; ++j) { const float hp = hasp ? (vp[i][j] * rstdp * gg[j] * (1.f + sc[j]) + sh[j]) : 0.f; d[j] = hp - h[j]; }
                const f32x4 mr = *(const f32x4*)(mu + c), mk = *(const f32x4*)(mu + 2048 + c), mv = *(const f32x4*)(mu + 3072 + c);
                const f32x4 xr_ = h + d * mr, xk_ = h + d * mk, xv_ = h + d * mv;
                bf16_t* o = out + (size_t)(row - row0) * 4096 + c;
                u32x2 w; w.x = pk2(xr_[0], xr_[1]); w.y = pk2(xr_[2], xr_[3]); *(u32x2*)(o) = w;
                w.x = pk2(xk_[0], xk_[1]); w.y = pk2(xk_[2], xk_[3]); *(u32x2*)(o + 1024) = w;
                w.x = pk2(xv_[0], xv_[1]); w.y = pk2(xv_[2], xv_[3]); *(u32x2*)(o + 2048) = w;
                w.x = pk2(d[0], d[1]); w.y = pk2(d[2], d[3]); *(u32x2*)(o + 3072) = w; } }
    }
}

__device__ __forceinline__ void qknorm_phase(bf16_t* Q, bf16_t* Kb, const int* pos, const float* qn, const float* kn, int bid, int nb) {
    const int wave = threadIdx.x >> 6, lane = threadIdx.x & 63, l16 = lane & 15, d0 = l16 * 4;
    float invf[4];
#pragma unroll
    for (int j = 0; j < 4; ++j) invf[j] = powf(500000.f, -(float)((l16 & 1) * 4 + j) / 8.f);
    const f32x4 qw = *(const f32x4*)(qn + d0), kw = *(const f32x4*)(kn + d0);
    for (int tok = bid * 8 + wave; tok < MTOK; tok += nb * 8) {
        const float ps = (float)pos[tok];
        float cs[4], sn[4];
#pragma unroll
        for (int j = 0; j < 4; ++j) { const float ang = ps * invf[j]; float rv = ang * 0.15915494309189535f; rv -= floorf(rv); cs[j] = __builtin_amdgcn_cosf(rv); sn[j] = __builtin_amdgcn_sinf(rv); }
#pragma unroll
        for (int bsel = 0; bsel < 2; ++bsel) { bf16_t* buf = bsel ? Kb : Q; const f32x4 w = bsel ? kw : qw;
#pragma unroll
            for (int it = 0; it < 2; ++it) { const int vec = it * 4 + (lane >> 4); bf16_t* ptr = buf + (size_t)tok * 512 + vec * 64 + d0;
                const u32x2 raw = *(const u32x2*)ptr; float y[4] = {bflo(raw.x), bfhi(raw.x), bflo(raw.y), bfhi(raw.y)};
                float ss = y[0] * y[0] + y[1] * y[1] + y[2] * y[2] + y[3] * y[3];
                ss = dpp_sum16(ss);
                const float rstd = rsqrtf(ss * (1.f / 64.f) + 1e-6f);
#pragma unroll
                for (int j = 0; j < 4; ++j) y[j] = y[j] * rstd * w[j];
                float pr[4];
#pragma unroll
                for (int j = 0; j < 4; ++j) pr[j] = __int_as_float(__builtin_amdgcn_update_dpp(0, __float_as_int(y[j]), 0x4E, 0xf, 0xf, true));
                if (l16 < 2) {
#pragma unroll
                    for (int j = 0; j < 4; ++j) y[j] = y[j] * cs[j] - pr[j] * sn[j]; }
                else if (l16 < 4) {
#pragma unroll
                    for (int j = 0; j < 4; ++j) y[j] = y[j] * cs[j] + pr[j] * sn[j]; }
                if (!bsel) {
#pragma unroll
                    for (int j = 0; j < 4; ++j) y[j] *= 0.125f * 1.4426950408889634f; }
                u32x2 o; o.x = pk2(y[0], y[1]); o.y = pk2(y[2], y[3]); *(u32x2*)ptr = o; } }
    }
}

__device__ __forceinline__ void vtrans_phase(const bf16_t* V, bf16_t* Vt, bf16_t* lds, int bid, int nb) {
    const int tid = threadIdx.x;
    for (int unit = bid; unit < 1024; unit += nb) {
        const int head = unit & 3, ch = unit >> 2; const int b = ch >> 6, t0 = (ch & 63) * 64;
#pragma unroll
        for (int i = 0; i < 2; ++i) { const int idx = tid + i * 512, t = idx >> 4, cc = (idx & 15) * 8;
            const u32x4 w = *(const u32x4*)(V + ((size_t)b * SEQ + t0 + t) * 512 + head * 128 + cc);
            unsigned* d = (unsigned*)(lds + t * 130 + cc); d[0] = w.x; d[1] = w.y; d[2] = w.z; d[3] = w.w; }
        __syncthreads();
        { const int e = tid >> 2, tc = (tid & 3) * 16; unsigned o[8];
#pragma unroll
          for (int i = 0; i < 8; ++i) o[i] = (unsigned)lds[(tc + 2 * i) * 130 + e] | ((unsigned)lds[(tc + 2 * i + 1) * 130 + e] << 16);
          u32x4* dst = (u32x4*)(Vt + ((size_t)(b * 4 + head) * 128 + e) * SEQ + t0 + tc);
          dst[0] = (u32x4){o[0], o[1], o[2], o[3]}; dst[1] = (u32x4){o[4], o[5], o[6], o[7]}; }
        __syncthreads();
    }
}

typedef float f32x16 __attribute__((ext_vector_type(16)));
__device__ __forceinline__ float xhalf_max(float x) { auto r = __builtin_amdgcn_permlane32_swap(__float_as_uint(x), __float_as_uint(x), false, false); return fmaxf(__uint_as_float(r[0]), __uint_as_float(r[1])); }
__device__ __forceinline__ float xhalf_sum(float x) { auto r = __builtin_amdgcn_permlane32_swap(__float_as_uint(x), __float_as_uint(x), false, false); return __uint_as_float(r[0]) + __uint_as_float(r[1]); }
__device__ __forceinline__ void attn_phase(const bf16_t* Q, const bf16_t* Kb, const bf16_t* Vt, bf16_t* CAT, const Params& p, LAS unsigned char* lds, int bid, int nb) {
    const int tid = threadIdx.x, wave = __builtin_amdgcn_readfirstlane(tid >> 6), lane = tid & 63, c = wave >> 2, wq = wave & 3, l32 = lane & 31, hh = lane >> 5;
    constexpr int KROW = 272, VROW = 144, KBUF = 64 * KROW, VBUF = 128 * VROW, VOFF = 2 * KBUF;
    const int lkey = tid >> 4, lkc = tid & 15, lve = tid >> 3, lvc = tid & 7;
    for (int unit = bid; unit < 256; unit += nb) {
        const int b = unit & 3, head = (unit >> 2) & 3, pr = unit >> 4;
        const bf16_t* kg = Kb + ((size_t)b * SEQ + lkey) * 512 + head * 128 + lkc * 8;
        const bf16_t* vg = Vt + ((size_t)(b * 4 + head) * 128 + lve) * SEQ + lvc * 8;
        for (int half = 0; half < 2; ++half) {
            const int qb = half ? (31 - pr) : pr; const int q0 = qb * 128 + wq * 32; const int nst = (qb + 1) * 2;
            bf16x8 qf[4];
            { const bf16_t* qp = Q + ((size_t)b * SEQ + q0 + l32) * 512 + head * 128 + c * 64 + hh * 8;
#pragma unroll
              for (int ks = 0; ks < 4; ++ks) qf[ks] = *(const bf16x8*)(qp + ks * 16); }
            f32x16 o[4];
#pragma unroll
            for (int blk = 0; blk < 4; ++blk)
#pragma unroll
                for (int r = 0; r < 16; ++r) o[blk][r] = 0.f;
            float mrow = -INFINITY, lsum = 0.f;
            u32x4 kreg[2][2], vreg[2][2];
#define AT_ISSUE(set, st) do { const int st_ = ((st) < nst) ? (st) : nst - 1; kreg[set][0] = *(const u32x4*)(kg + (size_t)(st_ * 64) * 512); kreg[set][1] = *(const u32x4*)(kg + (size_t)(st_ * 64 + 32) * 512); \
                               vreg[set][0] = *(const u32x4*)(vg + st_ * 64); vreg[set][1] = *(const u32x4*)(vg + (size_t)64 * SEQ + st_ * 64); } while (0)
#define AT_WRITE(set, slot) do { *(LAS u32x4*)(lds + (slot) * KBUF + lkey * KROW + lkc * 16) = kreg[set][0]; *(LAS u32x4*)(lds + (slot) * KBUF + (lkey + 32) * KROW + lkc * 16) = kreg[set][1]; \
                                 LAS u32x2* vd0 = (LAS u32x2*)(lds + VOFF + (slot) * VBUF + lve * VROW + (lvc >> 1) * 32 + (lvc & 1) * 8); vd0[0] = (u32x2){vreg[set][0].x, vreg[set][0].y}; vd0[2] = (u32x2){vreg[set][0].z, vreg[set][0].w}; \
                                 LAS u32x2* vd1 = (LAS u32x2*)(lds + VOFF + (slot) * VBUF + (lve + 64) * VROW + (lvc >> 1) * 32 + (lvc & 1) * 8); vd1[0] = (u32x2){vreg[set][1].x, vreg[set][1].y}; vd1[2] = (u32x2){vreg[set][1].z, vreg[set][1].w}; } while (0)
#define AT_PACK(dst, sv, base) do { u32x4 pw_; pw_.x = cvt_pk_bf16(sv[(base) + 0], sv[(base) + 1]); pw_.y = cvt_pk_bf16(sv[(base) + 2], sv[(base) + 3]); pw_.z = cvt_pk_bf16(sv[(base) + 4], sv[(base) + 5]); pw_.w = cvt_pk_bf16(sv[(base) + 6], sv[(base) + 7]); dst = __builtin_bit_cast(bf16x8, pw_); } while (0)
#define AT_COMPUTE(slot, st, kfa, kfb, vfa, vfb) do { const int key0 = (st) * 64; \
                if (key0 <= q0 + 31) { \
                    LAS unsigned char* kb = lds + (slot) * KBUF + l32 * KROW + c * 128 + hh * 16; \
                    LAS unsigned char* vb = lds + VOFF + (slot) * VBUF + l32 * VROW + hh * 16; \
                    f32x16 s0, s1; _Pragma("unroll") for (int r = 0; r < 16; ++r) { s0[r] = 0.f; s1[r] = 0.f; } \
                    kfa[0] = *(const LAS bf16x8*)(kb); kfa[1] = *(const LAS bf16x8*)(kb + 32 * KROW); kfa[2] = *(const LAS bf16x8*)(kb + 32); kfa[3] = *(const LAS bf16x8*)(kb + 32 * KROW + 32); \
                    kfb[0] = *(const LAS bf16x8*)(kb + 64); kfb[1] = *(const LAS bf16x8*)(kb + 32 * KROW + 64); kfb[2] = *(const LAS bf16x8*)(kb + 96); kfb[3] = *(const LAS bf16x8*)(kb + 32 * KROW + 96); \
                    __builtin_amdgcn_sched_barrier(0); \
                    __builtin_amdgcn_s_setprio(1); \
                    s0 = __builtin_amdgcn_mfma_f32_32x32x16_bf16(kfa[0], qf[0], s0, 0, 0, 0); s1 = __builtin_amdgcn_mfma_f32_32x32x16_bf16(kfa[1], qf[0], s1, 0, 0, 0); \
                    s0 = __builtin_amdgcn_mfma_f32_32x32x16_bf16(kfa[2], qf[1], s0, 0, 0, 0); s1 = __builtin_amdgcn_mfma_f32_32x32x16_bf16(kfa[3], qf[1], s1, 0, 0, 0); \
                    s0 = __builtin_amdgcn_mfma_f32_32x32x16_bf16(kfb[0], qf[2], s0, 0, 0, 0); s1 = __builtin_amdgcn_mfma_f32_32x32x16_bf16(kfb[1], qf[2], s1, 0, 0, 0); \
                    s0 = __builtin_amdgcn_mfma_f32_32x32x16_bf16(kfb[2], qf[3], s0, 0, 0, 0); s1 = __builtin_amdgcn_mfma_f32_32x32x16_bf16(kfb[3], qf[3], s1, 0, 0, 0); \
                    __builtin_amdgcn_s_setprio(0); \
                    _Pragma("unroll") for (int blk = 0; blk < 4; ++blk) vfa[blk] = *(const LAS bf16x8*)(vb + blk * 32 * VROW); \
                    _Pragma("unroll") for (int blk = 0; blk < 4; ++blk) vfb[blk] = *(const LAS bf16x8*)(vb + blk * 32 * VROW + 32); \
                    __builtin_amdgcn_sched_barrier(0); \
                    if (key0 + 63 > q0) { const int qrel = q0 + l32 - key0; \
                        _Pragma("unroll") for (int r = 0; r < 16; ++r) { const int kl = (r & 3) + 8 * (r >> 2) + 4 * hh; if (kl > qrel) s0[r] = -INFINITY; if (kl + 32 > qrel) s1[r] = -INFINITY; } } \
                    float tm = fmaxf(s0[0], s1[0]); _Pragma("unroll") for (int r = 1; r < 16; ++r) tm = fmaxf(tm, fmaxf(s0[r], s1[r])); \
                    tm = xhalf_max(tm); \
                    const float mnew = fmaxf(mrow, tm); \
                    if (__any(mnew > mrow + 6.f)) { const float al = __builtin_amdgcn_exp2f(mrow - mnew); lsum *= al; \
                        _Pragma("unroll") for (int blk = 0; blk < 4; ++blk) _Pragma("unroll") for (int r = 0; r < 16; ++r) o[blk][r] *= al; \
                        mrow = mnew; } \
                    float ps = 0.f; _Pragma("unroll") for (int r = 0; r < 16; ++r) { s0[r] = __builtin_amdgcn_exp2f(s0[r] - mrow); s1[r] = __builtin_amdgcn_exp2f(s1[r] - mrow); ps += s0[r] + s1[r]; } \
                    lsum += ps; \
                    bf16x8 pb0, pb1, pb2, pb3; AT_PACK(pb0, s0, 0); AT_PACK(pb1, s0, 8); AT_PACK(pb2, s1, 0); AT_PACK(pb3, s1, 8); \
                    __builtin_amdgcn_sched_barrier(0); \
                    __builtin_amdgcn_s_setprio(1); \
                    _Pragma("unroll") for (int blk = 0; blk < 4; ++blk) o[blk] = __builtin_amdgcn_mfma_f32_32x32x16_bf16(vfa[blk], pb0, o[blk], 0, 0, 0); \
                    _Pragma("unroll") for (int blk = 0; blk < 4; ++blk) o[blk] = __builtin_amdgcn_mfma_f32_32x32x16_bf16(vfb[blk], pb1, o[blk], 0, 0, 0); \
                    __builtin_amdgcn_sched_barrier(0); \
                    _Pragma("unroll") for (int blk = 0; blk < 4; ++blk) kfa[blk] = *(const LAS bf16x8*)(vb + blk * 32 * VROW + 64); \
                    _Pragma("unroll") for (int blk = 0; blk < 4; ++blk) kfb[blk] = *(const LAS bf16x8*)(vb + blk * 32 * VROW + 96); \
                    __builtin_amdgcn_sched_barrier(0); \
                    _Pragma("unroll") for (int blk = 0; blk < 4; ++blk) o[blk] = __builtin_amdgcn_mfma_f32_32x32x16_bf16(kfa[blk], pb2, o[blk], 0, 0, 0); \
                    _Pragma("unroll") for (int blk = 0; blk < 4; ++blk) o[blk] = __builtin_amdgcn_mfma_f32_32x32x16_bf16(kfb[blk], pb3, o[blk], 0, 0, 0); \
                    __builtin_amdgcn_s_setprio(0); \
                } } while (0)
            bf16x8 fr0[4], fr1[4], fr2[4], fr3[4];
            AT_ISSUE(0, 0); AT_ISSUE(1, 1);
            __syncthreads();
            AT_WRITE(0, 0);
            __syncthreads();
            for (int st = 0; st < nst; st += 2) {
                AT_ISSUE(0, st + 2);
                AT_COMPUTE(0, st, fr0, fr1, fr2, fr3);
                AT_WRITE(1, 1);
                __syncthreads();
                AT_ISSUE(1, st + 3);
                AT_COMPUTE(1, st + 1, fr2, fr3, fr0, fr1);
                AT_WRITE(0, 0);
                __syncthreads();
            }
            lsum = xhalf_sum(lsum);
            const float inv = 1.f / lsum;
            LAS float* xo = (LAS float*)lds + (wq * 128 + 4 * hh) * 32 + l32;
            if (c == 1) {
#pragma unroll
                for (int blk = 0; blk < 4; ++blk)
#pragma unroll
                    for (int r = 0; r < 16; ++r) xo[(blk * 32 + (r & 3) + 8 * (r >> 2)) * 32] = o[blk][r] * inv; }
            __syncthreads();
            if (c == 0) { float ss = 0.f; float lam; { float s1 = 0.f, s2 = 0.f; for (int d = 0; d < 64; ++d) { s1 += p.in[22][d] * p.in[23][d]; s2 += p.in[24][d] * p.in[25][d]; } lam = expf(s1) - expf(s2) + 0.2f; }
                const float* subln = p.in[26];
#pragma unroll
                for (int blk = 0; blk < 4; ++blk)
#pragma unroll
                    for (int r = 0; r < 16; ++r) { const float v = o[blk][r] * inv - lam * xo[(blk * 32 + (r & 3) + 8 * (r >> 2)) * 32]; o[blk][r] = v; ss += v * v; }
                ss = xhalf_sum(ss);
                const float rstd = rsqrtf(ss * (1.f / 128.f) + 1e-6f) * 0.8f;
                bf16_t* op = CAT + ((size_t)b * SEQ + q0 + l32) * 1024 + 512 + head * 128 + 4 * hh;
#pragma unroll
                for (int blk = 0; blk < 4; ++blk)
#pragma unroll
                    for (int g4 = 0; g4 < 4; ++g4) { const f32x4 sg = *(const f32x4*)(subln + blk * 32 + g4 * 8 + 4 * hh);
                        u32x2 w; w.x = pk2(o[blk][g4 * 4 + 0] * rstd * sg[0], o[blk][g4 * 4 + 1] * rstd * sg[1]); w.y = pk2(o[blk][g4 * 4 + 2] * rstd * sg[2], o[blk][g4 * 4 + 3] * rstd * sg[3]);
                        *(u32x2*)(op + blk * 32 + g4 * 8) = w; } }
        }
    }
}

__device__ __forceinline__ void attn_combine(const bf16_t* OC, bf16_t* CAT, const Params& p, int bid, int nb) {
    const int wave = threadIdx.x >> 6, lane = threadIdx.x & 63, head = lane >> 4, e0 = (lane & 15) * 8;
    float lam;
    { float s1 = 0.f, s2 = 0.f; for (int d = 0; d < 64; ++d) { s1 += p.in[22][d] * p.in[23][d]; s2 += p.in[24][d] * p.in[25][d]; } lam = expf(s1) - expf(s2) + 0.2f; }
    float sub[8];
#pragma unroll
    for (int i = 0; i < 8; ++i) sub[i] = p.in[26][e0 + i] * 0.8f;
    for (int tok = bid * 8 + wave; tok < MTOK; tok += nb * 8) {
        const u32x4 a = *(const u32x4*)(OC + (size_t)tok * 1024 + (head * 2) * 128 + e0), bb = *(const u32x4*)(OC + (size_t)tok * 1024 + (head * 2 + 1) * 128 + e0);
        float o[8] = {bflo(a.x) - lam * bflo(bb.x), bfhi(a.x) - lam * bfhi(bb.x), bflo(a.y) - lam * bflo(bb.y), bfhi(a.y) - lam * bfhi(bb.y),
                      bflo(a.z) - lam * bflo(bb.z), bfhi(a.z) - lam * bfhi(bb.z), bflo(a.w) - lam * bflo(bb.w), bfhi(a.w) - lam * bfhi(bb.w)};
        float ss = 0.f;
#pragma unroll
        for (int i = 0; i < 8; ++i) ss += o[i] * o[i];
        ss = dpp_sum16(ss);
        const float rstd = rsqrtf(ss * (1.f / 128.f) + 1e-6f);
        u32x4 w; w.x = pk2(o[0] * rstd * sub[0], o[1] * rstd * sub[1]); w.y = pk2(o[2] * rstd * sub[2], o[3] * rstd * sub[3]); w.z = pk2(o[4] * rstd * sub[4], o[5] * rstd * sub[5]); w.w = pk2(o[6] * rstd * sub[6], o[7] * rstd * sub[7]);
        *(u32x4*)(CAT + (size_t)tok * 1024 + 512 + head * 128 + e0) = w;
    }
}

typedef float f32x2 __attribute__((ext_vector_type(2)));
__device__ __forceinline__ float h2f_(unsigned bits) { return (float)__builtin_bit_cast(_Float16, (unsigned short)bits); }
__device__ __forceinline__ void rwkv_phase(const Params& p, const bf16_t* R, const bf16_t* Kk, const bf16_t* Vv, const _Float16* DEC, const bf16_t* AA, bf16_t* Y, float* lds, int bid, int nb) {
    const int tid = threadIdx.x, wave = __builtin_amdgcn_readfirstlane(tid >> 6), lane = tid & 63;
    constexpr int TCH = 16, BUFF = 5 * TCH * 64 + TCH * 16;
    constexpr int OBUF = TCH * 16 * 16;
    float* Lout = lds + 2 * BUFF;
    for (int unit = bid; unit < 256; unit += nb) {
        const int b = unit >> 6, h = (unit >> 2) & 15, rq = unit & 3;
        __syncthreads();
        if (wave >= 4) {
            const int pw = wave - 4, tl = lane >> 4, c4 = (lane & 15) * 4;
            const f32x4 kkw = *(const f32x4*)(p.in[41] + h * 64 + c4), kaw = *(const f32x4*)(p.in[42] + h * 64 + c4);
            u32x2 rr[4], kr[4], ar[4], dr[4], vr[4];
            const unsigned lofs = (unsigned)((pw * 4 + tl) * 1024 + h * 64 + c4), vofs = (unsigned)((pw * 4 + tl) * 1024 + h * 64 + rq * 16 + (lane & 3) * 4);
            const bf16_t* Rb = R + (size_t)b * SEQ * 1024; const bf16_t* Kb_ = Kk + (size_t)b * SEQ * 1024; const bf16_t* Vb = Vv + (size_t)b * SEQ * 1024;
            const bf16_t* Ab = AA + (size_t)b * SEQ * 1024; const _Float16* Db = DEC + (size_t)b * SEQ * 1024;
#define RW_ISSUE(set, ch) do { const unsigned o_ = (unsigned)(ch) * (TCH * 1024) + lofs; rr[set] = *(const u32x2*)(Rb + o_); kr[set] = *(const u32x2*)(Kb_ + o_); dr[set] = *(const u32x2*)(Db + o_); ar[set] = *(const u32x2*)(Ab + o_); \
                    vr[set] = *(const u32x2*)(Vb + (unsigned)(ch) * (TCH * 1024) + vofs); } while (0)
#define RW_STAGE(set, buf) do { float* L = lds + (buf) * BUFF + (pw * 4 + tl) * 64 + c4; \
                    const f32x4 k = {bflo(kr[set].x), bfhi(kr[set].x), bflo(kr[set].y), bfhi(kr[set].y)}, a = {bflo(ar[set].x), bfhi(ar[set].x), bflo(ar[set].y), bfhi(ar[set].y)}; \
                    const f32x4 r = {bflo(rr[set].x), bfhi(rr[set].x), bflo(rr[set].y), bfhi(rr[set].y)}; \
                    const f32x4 w = {1.f - h2f_(dr[set].x & 0xffffu), 1.f - h2f_(dr[set].x >> 16), 1.f - h2f_(dr[set].y & 0xffffu), 1.f - h2f_(dr[set].y >> 16)}; \
                    f32x4 kk = k * kkw; const float n2 = dpp_sum16((kk[0] * kk[0] + kk[1] * kk[1]) + (kk[2] * kk[2] + kk[3] * kk[3])); kk = kk * __frsqrt_rn(fmaxf(n2, 1e-24f)); \
                    *(f32x4*)(L) = w; *(f32x4*)(L + 1 * TCH * 64) = -kk; *(f32x4*)(L + 2 * TCH * 64) = kk * a; *(f32x4*)(L + 3 * TCH * 64) = k * (1.f + (a - 1.f) * kaw); *(f32x4*)(L + 4 * TCH * 64) = r; \
                    if ((lane & 15) < 4) *(f32x4*)(lds + (buf) * BUFF + 5 * TCH * 64 + (pw * 4 + tl) * 16 + (lane & 3) * 4) = (f32x4){bflo(vr[set].x), bfhi(vr[set].x), bflo(vr[set].y), bfhi(vr[set].y)}; } while (0)
            auto flush = [&](int ch) { const int i = tid - 256, tt = i >> 4, row = i & 15; const f32x4* pp = (const f32x4*)(Lout + (ch & 1) * OBUF + i * 16);
                const f32x4 s4 = pp[0] + pp[1] + pp[2] + pp[3];
                Y[((size_t)b * SEQ + ch * TCH + tt) * 1024 + h * 64 + rq * 16 + row] = (bf16_t)f2bf((s4[0] + s4[1]) + (s4[2] + s4[3])); };
            constexpr int NCH = SEQ / TCH;
            RW_ISSUE(0, 0); RW_ISSUE(1, 1); RW_ISSUE(2, 2); RW_ISSUE(3, 3);
            RW_STAGE(0, 0);
            __syncthreads();
            for (int c4_ = 0; c4_ < NCH; c4_ += 4) {
#define RW_ITER(q) do { const int ch = c4_ + (q); RW_STAGE(((q) + 1) & 3, (ch + 1) & 1); { const int chn = (ch + 4 < NCH) ? ch + 4 : NCH - 1; RW_ISSUE((q), chn); } flush(ch > 0 ? ch - 1 : 0); __syncthreads(); } while (0)
                RW_ITER(0); RW_ITER(1); RW_ITER(2); RW_ITER(3);
            }
            flush(NCH - 1);
        } else {
            const int j = lane & 15, rowl = wave * 4 + (lane >> 4);
            f32x2 S01 = {0.f, 0.f}, S23 = {0.f, 0.f};
            __syncthreads();
            for (int ch = 0; ch < SEQ / TCH; ++ch) {
                const float* L = lds + (ch & 1) * BUFF + j * 4; const float* Lv = lds + (ch & 1) * BUFF + 5 * TCH * 64 + rowl; float* Lo = Lout + (ch & 1) * OBUF + rowl * 16 + j;
                f32x4 w4 = *(const f32x4*)(L), a4 = *(const f32x4*)(L + 1 * TCH * 64), b4 = *(const f32x4*)(L + 2 * TCH * 64), k4 = *(const f32x4*)(L + 3 * TCH * 64), r4 = *(const f32x4*)(L + 4 * TCH * 64);
                float vv = Lv[0];
#pragma unroll
                for (int tt = 0; tt < TCH; ++tt) {
                    f32x4 nw4 = w4, na4 = a4, nb4 = b4, nk4 = k4, nr4 = r4; float nvv = vv;
                    if (tt + 1 < TCH) { const float* Ln = L + (tt + 1) * 64; nw4 = *(const f32x4*)(Ln); na4 = *(const f32x4*)(Ln + 1 * TCH * 64); nb4 = *(const f32x4*)(Ln + 2 * TCH * 64); nk4 = *(const f32x4*)(Ln + 3 * TCH * 64); nr4 = *(const f32x4*)(Ln + 4 * TCH * 64); nvv = Lv[(tt + 1) * 16]; }
                    f32x2 d = S01 * (f32x2){a4[0], a4[1]}; d = S23 * (f32x2){a4[2], a4[3]} + d;
                    const float sa = dpp_sum16(d[0] + d[1]);
                    const f32x2 sa2 = {sa, sa}, v2 = {vv, vv};
                    const f32x2 t01 = sa2 * (f32x2){b4[0], b4[1]} + v2 * (f32x2){k4[0], k4[1]}, t23 = sa2 * (f32x2){b4[2], b4[3]} + v2 * (f32x2){k4[2], k4[3]};
                    S01 = S01 * (f32x2){w4[0], w4[1]} + t01; S23 = S23 * (f32x2){w4[2], w4[3]} + t23;
                    f32x2 y = S01 * (f32x2){r4[0], r4[1]}; y = S23 * (f32x2){r4[2], r4[3]} + y;
                    Lo[tt * 256] = y[0] + y[1];
                    w4 = nw4; a4 = na4; b4 = nb4; k4 = nk4; r4 = nr4; vv = nvv;
                }
                __syncthreads();
            }
        }
    }
}

__device__ __forceinline__ void rwkv_post(const Params& p, bf16_t* R, const bf16_t* Kk, const bf16_t* Vv, const bf16_t* AA, const bf16_t* G, const bf16_t* Y, int bid, int nb) {
    const int wave = threadIdx.x >> 6, lane = threadIdx.x & 63;
    for (int it = bid * 8 + wave; it < MTOK * 16; it += nb * 8) {
        const int h = it & 15; const size_t off = (size_t)(it >> 4) * 1024 + h * 64 + lane;
        const float y = bf2f(Y[off]), r = bf2f(R[off]), k = bf2f(Kk[off]), v = bf2f(Vv[off]), a = bf2f(AA[off]), g = bf2f(G[off]);
        const float mean = wave_sum(y) * (1.f / 64.f); const float d = y - mean; const float var = wave_sum(d * d) * (1.f / 64.f);
        const float k2 = k * (1.f + (a - 1.f) * p.in[42][h * 64 + lane]);
        const float sb = wave_sum(r * k2 * p.in[43][h * 64 + lane]);
        const float yn = d * rsqrtf(var + 64e-5f) * p.in[44][h * 64 + lane] + p.in[45][h * 64 + lane] + sb * v;
        R[off] = (bf16_t)f2bf(yn * g);
    }
}

#define XB_TMO      128
#define XB_XCNT(j)  (256  + 64 * (j))
#define XB_XSUB(j)  (1280 + 64 * (j))
#define XB_XGEN(j)  (2304 + 64 * (j))
#define XB_TOP      3328
#define XB_TOPGEN   3392
#define XCD_BAR_WORDS 3456
#define XB_SPIN_CAP (1u << 18)
__device__ __forceinline__ unsigned xb_ld(unsigned* p)              { return __hip_atomic_load(p, __ATOMIC_RELAXED, __HIP_MEMORY_SCOPE_AGENT); }
__device__ __forceinline__ unsigned xb_add(unsigned* p, unsigned v) { return __hip_atomic_fetch_add(p, v, __ATOMIC_RELAXED, __HIP_MEMORY_SCOPE_AGENT); }
__device__ __forceinline__ unsigned xb_xcc_id() { return (unsigned)__builtin_amdgcn_s_getreg((3 << 11) | 20) & 0xFu; }
#define XB_SPIN(cond, bar) do { unsigned _sp = 0; while (cond) { __builtin_amdgcn_s_sleep(1); \
    if ((++_sp & 255u) == 0u) { if (xb_ld(&(bar)[XB_TMO])) break; if (_sp > XB_SPIN_CAP) { atomicAdd(&(bar)[XB_TMO], 1u); break; } } } } while (0)
struct XcdBarrier { unsigned* bar; unsigned x; volatile LAS unsigned* st; };
__device__ __forceinline__ XcdBarrier xcd_barrier_post(unsigned* bar, volatile LAS unsigned* st) {
    XcdBarrier b; b.bar = bar; b.x = xb_xcc_id(); b.st = st;
    if (threadIdx.x == 0) (void)xb_add(&bar[XB_XCNT(b.x)], 1u);
    return b;
}
__device__ __forceinline__ void xcd_barrier_complete(unsigned* bar, unsigned x, unsigned& nloc, unsigned& nx) {
    const unsigned G = gridDim.x * gridDim.y * gridDim.z;
    unsigned sum, cnt, mine, sp = 0u;
    for (;;) {
        sum = 0u; cnt = 0u; mine = 0u;
#pragma unroll
        for (unsigned j = 0; j < 16; ++j) { const unsigned c = xb_ld(&bar[XB_XCNT(j)]); sum += c; cnt += (c > 0u) ? 1u : 0u; mine = (j == x) ? c : mine; }
        if (sum == G) break;
        __builtin_amdgcn_s_sleep(1);
        if ((++sp & 255u) == 0u) { if (xb_ld(&bar[XB_TMO])) break; if (sp > XB_SPIN_CAP) { atomicAdd(&bar[XB_TMO], 1u); break; } }
    }
    nloc = mine > 0u ? mine : 1u; nx = cnt > 0u ? cnt : 1u;
}
__device__ __forceinline__ void xcd_barrier(const XcdBarrier& b) {
    asm volatile("s_waitcnt vmcnt(0)" ::: "memory");
    __syncthreads();
    if (threadIdx.x == 0) {
        unsigned* bar = b.bar;
        __builtin_amdgcn_s_waitcnt(0);
        unsigned nloc = b.st[0], nx = b.st[1];
        if (nloc == 0u) { xcd_barrier_complete(bar, b.x, nloc, nx); b.st[0] = nloc; b.st[1] = nx; }
        const unsigned old = xb_add(&bar[XB_XSUB(b.x)], 1u);
        const unsigned gen = old / nloc;
        if (old + 1u == (gen + 1u) * nloc) {
            __builtin_amdgcn_fence(__ATOMIC_RELEASE, "agent");
            asm volatile("s_waitcnt vmcnt(0)" ::: "memory");
            const unsigned og = xb_add(&bar[XB_TOP], 1u);
            const unsigned tg = og / nx;
            if (og + 1u == (tg + 1u) * nx) xb_add(&bar[XB_TOPGEN], 1u);
            else XB_SPIN(xb_ld(&bar[XB_TOPGEN]) == tg, bar);
            __builtin_amdgcn_fence(__ATOMIC_ACQUIRE, "agent");
            xb_add(&bar[XB_XGEN(b.x)], 1u);
            asm volatile("s_waitcnt vmcnt(0)" ::: "memory");
        } else {
            XB_SPIN(xb_ld(&bar[XB_XGEN(b.x)]) == gen, bar);
            __builtin_amdgcn_fence(__ATOMIC_ACQUIRE, "agent");
            asm volatile("s_waitcnt vmcnt(0)" ::: "memory");
        }
    }
    __syncthreads();
}

__global__ void __launch_bounds__(NTHR) fwd_kernel(Params p) {
    extern __shared__ __attribute__((aligned(16))) unsigned char lds_raw[];
    LAS unsigned char* lds = (LAS unsigned char*)lds_raw;
    float* ldsf = (float*)lds_raw;
    const int bid = blockIdx.x, nb = gridDim.x;
    unsigned char* ws = p.ws;
    float* mod = (float*)(ws + OFF_MOD);
    const bool multi = (p.ph_hi - p.ph_lo) > 1;
    __shared__ unsigned xb_st[4];
    if (threadIdx.x < 4) xb_st[threadIdx.x] = 0u;
    __syncthreads();
    XcdBarrier xbar; xbar.bar = (unsigned*)(ws + OFF_BAR); xbar.x = 0; xbar.st = (volatile LAS unsigned*)xb_st;
    if (multi) xbar = xcd_barrier_post((unsigned*)(ws + OFF_BAR), (volatile LAS unsigned*)xb_st);
#ifndef TESTPH
#define TESTPH -1
#endif
#ifndef REPEAT_A
#define REPEAT_A -1
#endif
#ifndef REPEAT_B
#define REPEAT_B -1
#endif
#ifndef EXTRA_SYNCS
#define EXTRA_SYNCS 0
#endif
#define PH(k) if ((TESTPH < 0 || TESTPH == (k)) && p.ph_lo <= (k) && (k) < p.ph_hi) for (int rep_ = 0; rep_ < (((k) == REPEAT_A || (k) == REPEAT_B) ? 2 : 1); ++rep_)
#define SYNC(k) if (multi) { xcd_barrier(xbar); }
    for (int es_ = 0; es_ < EXTRA_SYNCS; ++es_) cg::this_grid().sync();
    if (p.ph_lo < -1000) cg::this_grid().sync();
    PH(0) { prep_phase(p, ldsf, bid, nb); SYNC(0) }
    PH(1) { norm_phase<false>(p.in[0], p.in[5], mod, 0, 1024, (bf16_t*)(ws + OFF_HA), bid, nb); SYNC(1) }
    PH(2) { EpiWin e{(bf16_t*)(ws + OFF_UX), (bf16_t*)(ws + OFF_QKV)}; gemm_stream(lds, (const bf16_t*)(ws + OFF_HA), (const bf16_t*)(ws + OFF_WIN), 2048, 1024, e, bid, nb); SYNC(2) }
    PH(3) { { EpiS5Z e{(float*)(ws + OFF_Z)}; gemm_batched(lds, (const bf16_t*)(ws + OFF_UX), 640, (size_t)512 * 640, (const bf16_t*)(ws + OFF_BTZ), (size_t)256 * 512, 2, 1, 32, 512, e, NoPre{}, bid, nb); }
            bf16_t* q = (bf16_t*)(ws + OFF_QKV);
            if (nb > 128) { if (bid >= 64) qknorm_phase(q, q + (size_t)MTOK * 512, (const int*)p.in[2], p.in[20], p.in[21], bid - 64, nb - 64); }
            else qknorm_phase(q, q + (size_t)MTOK * 512, (const int*)p.in[2], p.in[20], p.in[21], bid, nb);
            vtrans_phase(q + (size_t)MTOK * 1024, (bf16_t*)(ws + OFF_VT), (bf16_t*)lds_raw, bid, nb); SYNC(3) }
    PH(5) { { EpiS5Y e{(const bf16_t*)(ws + OFF_UX), (bf16_t*)(ws + OFF_YG), p.in[18]}; PreS5Y pre{(const float*)(ws + OFF_Z), (bf16_t*)(ws + OFF_UX), p.in[11], p.in[12], p.in[13]};
              gemm_batched(lds, (const bf16_t*)(ws + OFF_UX), 640, (size_t)512 * 640, (const bf16_t*)(ws + OFF_BTY), (size_t)512 * 640, 2, 2, 32, 640, e, pre, bid, nb); }
            bf16_t* q = (bf16_t*)(ws + OFF_QKV); attn_phase(q, q + (size_t)MTOK * 512, (const bf16_t*)(ws + OFF_VT), (bf16_t*)(ws + OFF_CAT), p, lds, bid, nb); SYNC(5) }
    PH(6) {
            EpiGlu e{(const bf16_t*)(ws + OFF_YG), (bf16_t*)(ws + OFF_CAT)}; gemm_phase(lds, (const bf16_t*)(ws + OFF_YG), (const bf16_t*)(ws + OFF_WGLU), 512, 512, e, bid, nb); SYNC(6) }
    PH(7) { EpiRes e{p.in[0], p.out, mod + 2048}; gemm_stream(lds, (const bf16_t*)(ws + OFF_CAT), (const bf16_t*)(ws + OFF_WOUT), 1024, 1024, e, bid, nb); SYNC(7) }
    PH(8) { norm_phase<false>(p.out, p.in[6], mod, 3072, 4096, (bf16_t*)(ws + OFF_HA), bid, nb); SYNC(8) }
    PH(9) { EpiSwiglu e{(bf16_t*)(ws + OFF_HID)}; gemm_stream(lds, (const bf16_t*)(ws + OFF_HA), (const bf16_t*)(ws + OFF_WGU0), 5632, 1024, e, bid, nb); SYNC(9) }
    PH(10) { EpiRes e{p.out, p.out, mod + 5120}; gemm_stream(lds, (const bf16_t*)(ws + OFF_HID), (const bf16_t*)(ws + OFF_WDN0), 1024, FF, e, bid, nb); SYNC(10) }
    const float* mod1 = mod + 4 * 6144;
#define RWKV_FRONT(PA, PB, ROW0) \
    PH(PA) { norm_phase<true>(p.out, p.in[5] + 1024, mod1, 0, 1024, (bf16_t*)(ws + OFF_HD), bid, nb, (ROW0), 8192, p.in[28]); SYNC(PA) } \
    PH(PB) { const bf16_t* xall = (const bf16_t*)(ws + OFF_HD); const bool split = (nb == 256); \
               \
             { pg8::Gemm g{xall + 2048, (const bf16_t*)(ws + OFF_WL1), 8192, 256, 2048, 4096}; SchedOne S{(bid < 32) ? bid : -1}; EpiAdapt<EpiL1> ea{EpiL1{(bf16_t*)(ws + OFF_L1), (ROW0)}}; \
               pg8::gemm_phase<EpiAdapt<EpiL1>, SchedOne, false, true>(lds, g, S, ea); } \
             { pg8::Gemm g{xall, (const bf16_t*)(ws + OFF_WG1), 8192, 3072, 1024, 4096}; SchedRKV S{split ? bid - 32 : bid, split ? 224 : nb}; EpiAdaptRKV ea{EpiRKV{(bf16_t*)(ws + OFF_RKV), (ROW0)}}; \
               pg8::gemm_phase<EpiAdaptRKV, SchedRKV, true, true>(lds, g, S, ea); } \
             SYNC(PB) }
    RWKV_FRONT(11, 12, 0)
    RWKV_FRONT(20, 21, 8192)
    PH(13) { EpiL2 e{(_Float16*)(ws + OFF_DEC), (bf16_t*)(ws + OFF_AA), (bf16_t*)(ws + OFF_G), p.in[33], p.in[36]}; gemm_stream(lds, (const bf16_t*)(ws + OFF_L1), (const bf16_t*)(ws + OFF_WL2), 3072, 256, e, bid, nb); SYNC(13) }
    PH(14) { const bf16_t* r = (const bf16_t*)(ws + OFF_RKV); rwkv_phase(p, r, r + (size_t)MTOK * 1024, r + (size_t)MTOK * 2048, (const _Float16*)(ws + OFF_DEC), (const bf16_t*)(ws + OFF_AA), (bf16_t*)(ws + OFF_Y), ldsf, bid, nb); SYNC(14) }
    PH(15) { bf16_t* r = (bf16_t*)(ws + OFF_RKV); rwkv_post(p, r, r + (size_t)MTOK * 1024, r + (size_t)MTOK * 2048, (const bf16_t*)(ws + OFF_AA), (const bf16_t*)(ws + OFF_G), (const bf16_t*)(ws + OFF_Y), bid, nb); SYNC(15) }
    PH(16) { EpiRes e{p.out, p.out, mod1 + 2048}; gemm_stream(lds, (const bf16_t*)(ws + OFF_RKV), (const bf16_t*)(ws + OFF_WO), 1024, 1024, e, bid, nb); SYNC(16) }
    PH(17) { norm_phase<false>(p.out, p.in[6] + 1024, mod1, 3072, 4096, (bf16_t*)(ws + OFF_HA), bid, nb); SYNC(17) }
    PH(18) { EpiSwiglu e{(bf16_t*)(ws + OFF_HID)}; gemm_stream(lds, (const bf16_t*)(ws + OFF_HA), (const bf16_t*)(ws + OFF_WGU1), 5632, 1024, e, bid, nb); SYNC(18) }
    PH(19) { EpiRes e{p.out, p.out, mod1 + 5120}; gemm_stream(lds, (const bf16_t*)(ws + OFF_HID), (const bf16_t*)(ws + OFF_WDN1), 1024, FF, e, bid, nb); }
}

constexpr int NPHASE = 22;
#ifndef ONE_LAUNCH
#define ONE_LAUNCH 1
#endif

extern "C" void kernel_launch(void* const* d_in, const int* in_sizes, int n_in, void* d_out, int out_size, void* d_ws, size_t ws_size, hipStream_t stream) {
    static int grid = 0;
    if (grid == 0) {
        if (n_in != 46 || ws_size < WS_NEED) { fprintf(stderr, "kernel_launch: unexpected n_in %d / ws_size %zu (need %zu)\n", n_in, ws_size, (size_t)WS_NEED); grid = -1; return; }
        if (hipFuncSetAttribute((const void*)fwd_kernel, hipFuncAttributeMaxDynamicSharedMemorySize, LDS_BYTES) != hipSuccess) { fprintf(stderr, "hipFuncSetAttribute failed\n"); grid = -1; return; }
        int dev = 0, cus = 0, per_cu = 0;
        (void)hipGetDevice(&dev); (void)hipDeviceGetAttribute(&cus, hipDeviceAttributeMultiprocessorCount, dev);
        (void)hipOccupancyMaxActiveBlocksPerMultiprocessor(&per_cu, (const void*)fwd_kernel, NTHR, LDS_BYTES);
        if (per_cu < 1) per_cu = 1;
        grid = cus;
    }
    if (grid < 0) return;
    Params p{};
    for (int i = 0; i < 46; ++i) p.in[i] = (const float*)d_in[i];
    p.out = (float*)d_out; p.ws = (unsigned char*)d_ws;
#if ONE_LAUNCH
    p.ph_lo = 0; p.ph_hi = NPHASE;
    if (hipMemsetAsync((char*)d_ws + OFF_BAR, 0, XCD_BAR_WORDS * 4, stream) != hipSuccess) { fprintf(stderr, "memset failed\n"); return; }
    void* args[] = {&p};
    hipError_t e = hipLaunchCooperativeKernel((const void*)fwd_kernel, dim3(grid), dim3(NTHR), args, LDS_BYTES, stream);
    if (e != hipSuccess) fprintf(stderr, "cooperative launch failed: %s (grid %d)\n", hipGetErrorString(e), grid);
#else
    for (int ph = 0; ph < NPHASE; ++ph) { p.ph_lo = ph; p.ph_hi = ph + 1; hipLaunchKernelGGL(fwd_kernel, dim3(grid), dim3(NTHR), LDS_BYTES, stream, p); }
#endif
}
```

```cpp
#include <hip/hip_runtime.h>
#include <hip/hip_cooperative_groups.h>
#include <cstdio>
#include <cstdint>
namespace cg = cooperative_groups;

#define LAS __attribute__((address_space(3)))
typedef unsigned short bf16_t;
typedef short bf16x8 __attribute__((ext_vector_type(8)));
typedef float f32x4 __attribute__((ext_vector_type(4)));
typedef unsigned u32x2 __attribute__((ext_vector_type(2)));
typedef unsigned u32x4 __attribute__((ext_vector_type(4)));

constexpr int MTOK = 16384, DM = 1024, SEQ = 4096, FF = 2816;
constexpr int NTHR = 512;
constexpr int LDS_BYTES = 131072;
constexpr size_t MiB = 1048576;
constexpr size_t OFF_WIN = 0;
constexpr size_t OFF_WGLU = 4194304;
constexpr size_t OFF_WOUT = 4718592;
constexpr size_t OFF_WGU0 = 6815744;
constexpr size_t OFF_WDN0 = 18350080;
constexpr size_t OFF_WGU1 = 39321600;
constexpr size_t OFF_WDN1 = 50855936;
constexpr size_t OFF_WG1 = 24117248;
constexpr size_t OFF_WL1 = 24117248 + 6291456;
constexpr size_t OFF_WL2 = 37748736;
constexpr size_t OFF_WO = 56623104;
constexpr size_t OFF_MOD = 58720256;
constexpr size_t OFF_BAR = 58916864;
constexpr size_t ACT = 57 * MiB;
constexpr size_t OFF_HA = ACT;
constexpr size_t OFF_UX = ACT + 32 * MiB;
constexpr size_t OFF_Z = ACT + 52 * MiB;
constexpr size_t OFF_BTZ = ACT + 112 * MiB;
constexpr size_t OFF_BTY = ACT + 176 * MiB;
constexpr size_t OFF_QKV = ACT + 64 * MiB;
constexpr size_t OFF_CAT = ACT + 112 * MiB;
constexpr size_t OFF_YG = ACT + 144 * MiB;
constexpr size_t OFF_VT = ACT + 160 * MiB;
constexpr size_t OFF_OC = ACT;
constexpr size_t OFF_HID = ACT + 32 * MiB;
constexpr size_t OFF_HD = ACT;
constexpr size_t OFF_RKV = ACT + 64 * MiB;
constexpr size_t OFF_G = ACT + 160 * MiB;
constexpr size_t OFF_Y = 0;
constexpr size_t OFF_L1 = 0;
constexpr size_t OFF_DEC = ACT;
constexpr size_t OFF_AA = ACT + 32 * MiB;
constexpr size_t WS_NEED = ACT + 196 * MiB;

struct Params {
    const float* in[46];
    float* out;
    unsigned char* ws;
    int ph_lo, ph_hi;
};

__device__ __forceinline__ unsigned f2bf(float f) { unsigned u = __float_as_uint(f); return (u + 0x7fffu + ((u >> 16) & 1u)) >> 16; }
__device__ __forceinline__ float bf2f(unsigned h) { return __uint_as_float(h << 16); }
__device__ __forceinline__ unsigned cvt_pk_bf16(float lo, float hi) { unsigned r; asm("v_cvt_pk_bf16_f32 %0, %1, %2" : "=v"(r) : "v"(lo), "v"(hi)); return r; }
__device__ __forceinline__ unsigned pk2(float lo, float hi) { return cvt_pk_bf16(lo, hi); }
__device__ __forceinline__ float bflo(unsigned w) { return __uint_as_float(w << 16); }
__device__ __forceinline__ float bfhi(unsigned w) { return __uint_as_float(w & 0xffff0000u); }
__device__ __forceinline__ float dpp_sum16(float x) {
    x += __int_as_float(__builtin_amdgcn_update_dpp(0, __float_as_int(x), 0xB1, 0xf, 0xf, true));
    x += __int_as_float(__builtin_amdgcn_update_dpp(0, __float_as_int(x), 0x4E, 0xf, 0xf, true));
    x += __int_as_float(__builtin_amdgcn_update_dpp(0, __float_as_int(x), 0x141, 0xf, 0xf, true));
    x += __int_as_float(__builtin_amdgcn_update_dpp(0, __float_as_int(x), 0x140, 0xf, 0xf, true));
    return x;
}
__device__ __forceinline__ float wave_sum(float v) {
    v = dpp_sum16(v);
    const float s0 = __int_as_float(__builtin_amdgcn_readlane(__float_as_int(v), 0)), s1 = __int_as_float(__builtin_amdgcn_readlane(__float_as_int(v), 16));
    const float s2 = __int_as_float(__builtin_amdgcn_readlane(__float_as_int(v), 32)), s3 = __int_as_float(__builtin_amdgcn_readlane(__float_as_int(v), 48));
    return (s0 + s1) + (s2 + s3);
}
__device__ __forceinline__ float sigmoidf_(float x) { return __fdividef(1.f, 1.f + __expf(-x)); }
__device__ __forceinline__ float tanh_fast(float x) { const float t = __expf(2.f * fminf(fmaxf(x, -15.f), 15.f)); return __fdividef(t - 1.f, t + 1.f); }
#define LWAIT() asm volatile("s_waitcnt lgkmcnt(0)" ::: "memory")
__device__ __forceinline__ float gelu_tanh(float x) { const float u = 0.7978845608028654f * (x + 0.044715f * x * x * x); const float t = __expf(2.f * fminf(fmaxf(u, -15.f), 15.f)); return __fdividef(x * t, t + 1.f); }

constexpr int HTB = 128 * 64 * 2;
__device__ __forceinline__ int lds_byte(int r, int c) { int st = (r >> 4) * 2 + (c >> 5), rr = r & 15, cc = c & 31, ob = rr * 64 + cc * 2; return st * 1024 + (ob ^ (((ob >> 9) & 1) << 5)); }
__device__ __forceinline__ void stage_rc(int b, int& R, int& C) { int st = b / 1024, sb = b % 1024, swz = sb ^ (((sb >> 9) & 1) << 5); R = (st >> 1) * 16 + swz / 64; C = (st & 1) * 32 + (swz % 64) / 2; }

struct NoPre { static constexpr bool NOP = true; __device__ __forceinline__ void operator()(int, int, int) const {} };
template <class Epi, class Pre, bool PF = true>
__device__ __forceinline__ void gemm_batched(LAS unsigned char* lds, const bf16_t* A, int lda, size_t strideA, const bf16_t* Bt, size_t strideB, int nMt, int nNt, int nbatch, int K, const Epi& E, const Pre& PRE, int bid, int nb) {
    const int tid = threadIdx.x, wid = __builtin_amdgcn_readfirstlane(tid >> 6), lane = tid & 63, wr = wid >> 2, wc = wid & 3, fr = lane & 15, fq = lane >> 4;
    unsigned voffA[2], voffB[2];
#pragma unroll
    for (int i = 0; i < 2; ++i) { int R, C; stage_rc(tid * 16 + i * 8192, R, C); voffA[i] = (unsigned)(R * lda + C) * 2u; voffB[i] = (unsigned)(R * K + C) * 2u; }
    const int aoff = lds_byte(wr * 64 + fr, fq * 8), boff = lds_byte(wc * 32 + fr, fq * 8);
    const unsigned ldsw = (unsigned)wid * 1024u;
    const size_t kstep = 128, hstepA = (size_t)128 * lda * 2, hstepB = (size_t)128 * K * 2;
    const int nt = K / 64;
    const int ntiles = nMt * nNt * nbatch;
#define G_SA(b, h) (((b) * 2 + (h)) * HTB)
#define G_SB(b, h) ((4 + (b) * 2 + (h)) * HTB)
#define G_STAGEX(bufoff, gptr, vo) do { _Pragma("unroll") for (int _i = 0; _i < 2; ++_i) \
        __builtin_amdgcn_global_load_lds((const unsigned*)((gptr) + vo[_i]), (LAS unsigned*)(lds + (bufoff) + ldsw + _i * 8192), 16, 0, 0); } while (0)
#define G_STA(bufoff, gptr) G_STAGEX(bufoff, gptr, voffA)
#define G_STB(bufoff, gptr) G_STAGEX(bufoff, gptr, voffB)
#define G_LDA(dst, b, h) do { _Pragma("unroll") for (int m = 0; m < 4; ++m) _Pragma("unroll") for (int k = 0; k < 2; ++k) dst[m][k] = *(const LAS bf16x8*)(lds + G_SA(b, h) + aoff + m * 2048 + k * 1024); } while (0)
#define G_LDB(dst, b, h) do { _Pragma("unroll") for (int n = 0; n < 2; ++n) _Pragma("unroll") for (int k = 0; k < 2; ++k) dst[n][k] = *(const LAS bf16x8*)(lds + G_SB(b, h) + boff + n * 2048 + k * 1024); } while (0)
#define G_MMA(ai, bj, At, Bx) do { __builtin_amdgcn_s_setprio(1); _Pragma("unroll") for (int m = 0; m < 4; ++m) _Pragma("unroll") for (int n = 0; n < 2; ++n) _Pragma("unroll") for (int k = 0; k < 2; ++k) \
        acc[ai][bj][m][n] = __builtin_amdgcn_mfma_f32_16x16x32_bf16(Bx[n][k], At[m][k], acc[ai][bj][m][n], 0, 0, 0); __builtin_amdgcn_s_setprio(0); } while (0)
#define G_WV(n) asm volatile("s_waitcnt vmcnt(" #n ")" ::: "memory")
#define G_WL(n) asm volatile("s_waitcnt lgkmcnt(" #n ")" ::: "memory")
#define G_BAR __builtin_amdgcn_s_barrier()
#define G_SCHED __builtin_amdgcn_sched_barrier(0)
    bool prefetched = false;
    for (int tile = bid; tile < ntiles; tile += nb) {
        const int pm = tile % nMt, tq = tile / nMt, pn = tq % nNt, gb = tq / nNt;
        PRE(gb, pm, pn);
        const char* cA = (const char*)(A + (size_t)gb * strideA) + (size_t)pm * 256 * lda * 2;
        const char* cB = (const char*)(Bt + (size_t)gb * strideB) + (size_t)pn * 256 * K * 2;
        f32x4 acc[2][2][4][2];
#pragma unroll
        for (int a = 0; a < 2; ++a)
#pragma unroll
            for (int b = 0; b < 2; ++b)
#pragma unroll
                for (int m = 0; m < 4; ++m)
#pragma unroll
                    for (int n = 0; n < 2; ++n) acc[a][b][m][n] = (f32x4){0.f, 0.f, 0.f, 0.f};
        bf16x8 At[4][2], B0[2][2], B1[2][2];
        if (!prefetched) { G_WV(0); G_STB(G_SB(0, 0), cB); G_STA(G_SA(0, 0), cA); G_STB(G_SB(0, 1), cB + hstepB); G_STA(G_SA(0, 1), cA + hstepA); }
        if (wr == 1) G_BAR;
        if (prefetched) G_WV(0); else G_WV(4);
        G_BAR;
        G_STB(G_SB(1, 0), cB + kstep); G_STA(G_SA(1, 0), cA + kstep); G_STB(G_SB(1, 1), cB + hstepB + kstep);
        G_WV(6); G_BAR;
        for (int t = 0; t < nt - 2; t += 2) {
            const char* a1 = cA + (size_t)(t + 1) * kstep; const char* a2 = cA + (size_t)(t + 2) * kstep; const char* a3 = a2 + kstep;
            const char* b2 = cB + (size_t)(t + 2) * kstep; const char* b3 = b2 + kstep;
            G_LDB(B0, 0, 0); G_SCHED; G_LDA(At, 0, 0); G_STA(G_SA(1, 1), a1 + hstepA);
            G_WL(8); G_BAR; G_WL(0); G_MMA(0, 0, At, B0); G_BAR; G_SCHED;
            G_LDB(B1, 0, 1); G_STB(G_SB(0, 0), b2);
            G_BAR; G_WL(0); G_MMA(0, 1, At, B1); G_BAR;
            G_LDA(At, 0, 1); G_STA(G_SA(0, 0), a2);
            G_BAR; G_WL(0); G_MMA(1, 0, At, B0); G_BAR; G_SCHED;
            G_STB(G_SB(0, 1), b2 + hstepB);
            G_WV(6); G_BAR; G_MMA(1, 1, At, B1); G_BAR;
            G_LDB(B0, 1, 0); G_SCHED; G_LDA(At, 1, 0); G_STA(G_SA(0, 1), a2 + hstepA);
            G_WL(8); G_BAR; G_WL(0); G_MMA(0, 0, At, B0); G_BAR; G_SCHED;
            G_LDB(B1, 1, 1); G_STB(G_SB(1, 0), b3);
            G_BAR; G_WL(0); G_MMA(0, 1, At, B1); G_BAR;
            G_LDA(At, 1, 1); G_STA(G_SA(1, 0), a3);
            G_BAR; G_WL(0); G_MMA(1, 0, At, B0); G_BAR; G_SCHED;
            G_STB(G_SB(1, 1), b3 + hstepB);
            G_WV(6); G_BAR; G_MMA(1, 1, At, B1); G_BAR;
        }
        {
            const char* a1 = cA + (size_t)(nt - 1) * kstep;
            G_LDB(B0, 0, 0); G_LDA(At, 0, 0); G_STA(G_SA(1, 1), a1 + hstepA);
            G_BAR; G_WL(0); G_MMA(0, 0, At, B0); G_BAR;
            G_LDB(B1, 0, 1); G_BAR; G_WL(0); G_MMA(0, 1, At, B1); G_BAR;
            G_LDA(At, 0, 1); G_WV(4); G_BAR; G_WL(0); G_MMA(1, 0, At, B0); G_MMA(1, 1, At, B1); G_BAR;
        }
        {
            G_LDB(B0, 1, 0); G_LDA(At, 1, 0); G_WV(2); G_BAR; G_WL(0); G_MMA(0, 0, At, B0); G_BAR;
            G_LDB(B1, 1, 1); G_WV(0); G_BAR; G_WL(0); G_MMA(0, 1, At, B1); G_BAR;
            G_LDA(At, 1, 1); G_BAR; G_WL(0); G_MMA(1, 0, At, B0); G_MMA(1, 1, At, B1); G_BAR;
        }
        if (wr == 0) G_BAR;
        prefetched = false;
        if (PF && Pre::NOP && tile + nb < ntiles) {
            const int t2 = tile + nb, pm2 = t2 % nMt, tq2 = t2 / nMt, pn2 = tq2 % nNt, gb2 = tq2 / nNt;
            const char* nA = (const char*)(A + (size_t)gb2 * strideA) + (size_t)pm2 * 256 * lda * 2;
            const char* nB = (const char*)(Bt + (size_t)gb2 * strideB) + (size_t)pn2 * 256 * K * 2;
            G_STB(G_SB(0, 0), nB); G_STA(G_SA(0, 0), nA); G_STB(G_SB(0, 1), nB + hstepB); G_STA(G_SA(0, 1), nA + hstepA);
            prefetched = true; }
        E(acc, gb, pm, pn, wr, wc, fr, fq);
    }
    G_WV(0);
    __syncthreads();
}

template <class Epi>
__device__ __forceinline__ void gemm_phase(LAS unsigned char* lds, const bf16_t* A, const bf16_t* Bt, int N, int K, const Epi& E, int bid, int nb) {
    gemm_batched(lds, A, K, 0, Bt, 0, 64, N / 256, 1, K, E, NoPre{}, bid, nb);
}

namespace pg8 {
#define PG8_LAS __attribute__((address_space(3)))
typedef unsigned short bf16_t;
typedef short bf16x8 __attribute__((ext_vector_type(8)));
typedef float f32x4 __attribute__((ext_vector_type(4)));
typedef unsigned u32x4 __attribute__((ext_vector_type(4)));
constexpr int BM = 256, BK = 64, HALF = 128, HTB = HALF * BK * 2  , STAGE_BYTES = 8 * HTB, NXCD = 8, WGM = 8;

__host__ __device__ __forceinline__ int lds_byte(int r, int c) { const int st = (r >> 4) * 2 + (c >> 5), rr = r & 15, cc = c & 31, ob = rr * 64 + cc * 2; return st * 1024 + (ob ^ (((ob >> 9) & 1) << 5)); }
__host__ __device__ __forceinline__ void stage_rc(int b, int& R, int& C) { const int st = b / 1024, sb = b % 1024, swz = sb ^ (((sb >> 9) & 1) << 5); R = (st >> 1) * 16 + swz / 64; C = (st & 1) * 32 + (swz % 64) / 2; }
__host__ __device__ __forceinline__ int perm32(int rho) { const int n = rho >> 4, i = rho & 15; return 8 * (i >> 2) + 4 * n + (i & 3); }

struct Unit { int pm, pn; int ao = 0; };
struct Gemm { const bf16_t* A; const bf16_t* Bt; int M, N, K; int lda; };

struct StaticOrder {
    int nM, nN, nwg, G, c;
    __host__ __device__ void init(int M, int N, int G_, int c_) { nM = M / BM; nN = N / BM; nwg = nM * nN; G = G_; c = c_; }
    __host__ __device__ bool next(int i, Unit& u) const {
        const long L = (long)i * G + c; if (L >= nwg) return false;
        int wgid = (int)L; { const int q = nwg / NXCD, r = nwg % NXCD, xcd = wgid % NXCD, off = wgid / NXCD; wgid = (xcd < r ? xcd * (q + 1) : r * (q + 1) + (xcd - r) * q) + off; }
        const int nig = WGM * nN, gid = wgid / nig, fm = gid * WGM, gsz = (nM - fm) < WGM ? (nM - fm) : WGM;
        u.pm = fm + ((wgid % nig) % gsz); u.pn = (wgid % nig) / gsz; return true;
    }
    __device__ __forceinline__ void a_ready(const Unit&) const {}
    __device__ __forceinline__ void done(const Unit&) const {}
};
template <class Epi, class Sched, bool ALIGN_EPI = false, bool SP2 = false>
__device__ __forceinline__ void gemm_phase(PG8_LAS unsigned char* lds, const Gemm g, const Sched& S, const Epi& E) {
    const int tid = threadIdx.x, wid = __builtin_amdgcn_readfirstlane(tid >> 6), lane = tid & 63, wr = wid >> 2, wc = wid & 3, fr = lane & 15, fq = lane >> 4;
    const int K = g.K, nt = K / BK;
    unsigned voffA[2], voffB[2];
#pragma unroll
    for (int i = 0; i < 2; ++i) { int R, C; stage_rc(tid * 16 + i * 8192, R, C); const int Rb = Epi::PERM ? ((R & ~31) + perm32(R & 31)) : R;
        voffA[i] = (unsigned)(R * g.lda + C) * 2u; voffB[i] = (unsigned)(Rb * K + C) * 2u; }
    const size_t kstep = (size_t)(BK * 2);
    const size_t hstep = (size_t)HALF * K * 2;
    const size_t tstep = 2 * hstep;
    const size_t hstepA = (size_t)HALF * g.lda * 2, tstepA = 2 * hstepA;
    const unsigned ldsw = (unsigned)wid * 1024u;
    const int aoff = lds_byte(wr * 64 + fr, fq * 8), boff = lds_byte(wc * 32 + fr, fq * 8);
#define PG8_SA(b, h) (((b) * 2 + (h)) * HTB)
#define PG8_SB(b, h) ((4 + (b) * 2 + (h)) * HTB)
#define PG8_STAGE(bufoff, gbase, voff) do { _Pragma("unroll") for (int _i = 0; _i < 2; ++_i) \
        __builtin_amdgcn_global_load_lds((const unsigned*)((const char*)(gbase) + (voff)[_i]), (PG8_LAS unsigned*)(lds + (bufoff) + ldsw + _i * 8192), 16, 0, 0); } while (0)
#define PG8_LDA(dst, b, h) do { _Pragma("unroll") for (int m = 0; m < 4; ++m) _Pragma("unroll") for (int k = 0; k < 2; ++k) dst[m][k] = *(const PG8_LAS bf16x8*)(lds + PG8_SA(b, h) + aoff + m * 2048 + k * 1024); } while (0)
#define PG8_LDB(dst, b, h) do { _Pragma("unroll") for (int n = 0; n < 2; ++n) _Pragma("unroll") for (int k = 0; k < 2; ++k) dst[n][k] = *(const PG8_LAS bf16x8*)(lds + PG8_SB(b, h) + boff + n * 2048 + k * 1024); } while (0)
#define PG8_MMA(ai, bj, At, Bt) do { __builtin_amdgcn_s_setprio(1); _Pragma("unroll") for (int m = 0; m < 4; ++m) _Pragma("unroll") for (int n = 0; n < 2; ++n) _Pragma("unroll") for (int k = 0; k < 2; ++k) \
        acc[ai][bj][m][n] = __builtin_amdgcn_mfma_f32_16x16x32_bf16(Bt[n][k], At[m][k], acc[ai][bj][m][n], 0, 0, 0); __builtin_amdgcn_s_setprio(0); } while (0)
#define PG8_WAIT_V(n) asm volatile("s_waitcnt vmcnt(" #n ")" ::: "memory")
#define PG8_WAIT_L(n) asm volatile("s_waitcnt lgkmcnt(" #n ")" ::: "memory")
#define PG8_BAR __builtin_amdgcn_s_barrier()
#define PG8_SCHED __builtin_amdgcn_sched_barrier(0)
    Unit cur, nxt; int ui = 0;
    if (!S.next(0, cur)) return;
    f32x4 acc[2][2][4][2];
#pragma unroll
    for (int a = 0; a < 2; ++a)
#pragma unroll
        for (int b = 0; b < 2; ++b)
#pragma unroll
            for (int m = 0; m < 4; ++m)
#pragma unroll
                for (int n = 0; n < 2; ++n) acc[a][b][m][n] = (f32x4){0.f, 0.f, 0.f, 0.f};
    bf16x8 At[4][2], B0[2][2], B1[2][2];
    const char* cA = (const char*)g.A + (size_t)cur.pm * tstepA + cur.ao; const char* cB = (const char*)g.Bt + (size_t)cur.pn * tstep;
    S.a_ready(cur);
    if constexpr (SP2) {
        PG8_STAGE(PG8_SB(0, 0), cB, voffB); PG8_STAGE(PG8_SB(0, 1), cB + hstep, voffB); PG8_STAGE(PG8_SA(0, 0), cA, voffA); PG8_STAGE(PG8_SA(0, 1), cA + hstepA, voffA);
        if (wr == 1) PG8_BAR;
        PG8_WAIT_V(2); PG8_BAR;
        PG8_STAGE(PG8_SB(1, 0), cB + kstep, voffB); PG8_STAGE(PG8_SA(1, 0), cA + kstep, voffA); PG8_STAGE(PG8_SB(1, 1), cB + hstep + kstep, voffB);
        PG8_WAIT_V(6); PG8_BAR;
    } else {
        PG8_STAGE(PG8_SB(0, 0), cB, voffB); PG8_STAGE(PG8_SA(0, 0), cA, voffA); PG8_STAGE(PG8_SB(0, 1), cB + hstep, voffB); PG8_STAGE(PG8_SA(0, 1), cA + hstepA, voffA);
        if (wr == 1) PG8_BAR;
        PG8_WAIT_V(4); PG8_BAR;
        PG8_STAGE(PG8_SB(1, 0), cB + kstep, voffB); PG8_STAGE(PG8_SA(1, 0), cA + kstep, voffA); PG8_STAGE(PG8_SB(1, 1), cB + hstep + kstep, voffB);
        PG8_WAIT_V(6); PG8_BAR;
    }
    for (;;) {
        const bool has_next = S.next(ui + 1, nxt);
        const char* nA = has_next ? (const char*)g.A + (size_t)nxt.pm * tstepA + nxt.ao : cA; const char* nB = has_next ? (const char*)g.Bt + (size_t)nxt.pn * tstep : cB;
        for (int t = 0; t < nt; t += 2) {
            const bool last = (t == nt - 2);
            const char* a1 = cA + (size_t)(t + 1) * kstep;
            const char* a2 = last ? nA : cA + (size_t)(t + 2) * kstep; const char* b2 = last ? nB : cB + (size_t)(t + 2) * kstep;
            const char* a3 = a2 + kstep; const char* b3 = b2 + kstep;
            if (last && has_next) S.a_ready(nxt);
            if constexpr (SP2) {
            PG8_LDB(B0, 0, 0); PG8_LDB(B1, 0, 1); PG8_SCHED; PG8_LDA(At, 0, 0); PG8_STAGE(PG8_SA(1, 1), a1 + hstepA, voffA);
            PG8_WAIT_V(8); PG8_WAIT_L(0); PG8_BAR; PG8_MMA(0, 0, At, B0); PG8_MMA(0, 1, At, B1); PG8_BAR; PG8_SCHED;
            PG8_LDA(At, 0, 1); PG8_STAGE(PG8_SB(0, 0), b2, voffB); PG8_STAGE(PG8_SB(0, 1), b2 + hstep, voffB); PG8_STAGE(PG8_SA(0, 0), a2, voffA);
            PG8_WAIT_V(8); PG8_WAIT_L(0); PG8_BAR; PG8_MMA(1, 0, At, B0); PG8_MMA(1, 1, At, B1); PG8_BAR; PG8_SCHED;
            PG8_LDB(B0, 1, 0); PG8_LDB(B1, 1, 1); PG8_SCHED; PG8_LDA(At, 1, 0); PG8_STAGE(PG8_SA(0, 1), a2 + hstepA, voffA);
            PG8_WAIT_V(8); PG8_WAIT_L(0); PG8_BAR; PG8_MMA(0, 0, At, B0); PG8_MMA(0, 1, At, B1); PG8_BAR; PG8_SCHED;
            PG8_LDA(At, 1, 1); PG8_STAGE(PG8_SB(1, 0), b3, voffB); PG8_STAGE(PG8_SB(1, 1), b3 + hstep, voffB); PG8_STAGE(PG8_SA(1, 0), a3, voffA);
            PG8_WAIT_V(8); PG8_WAIT_L(0); PG8_BAR; PG8_MMA(1, 0, At, B0); PG8_MMA(1, 1, At, B1); PG8_BAR; PG8_SCHED;
            } else {
            PG8_LDB(B0, 0, 0); PG8_SCHED; PG8_LDA(At, 0, 0); PG8_STAGE(PG8_SA(1, 1), a1 + hstepA, voffA);
            PG8_WAIT_L(8); PG8_BAR; PG8_WAIT_L(0); PG8_MMA(0, 0, At, B0); PG8_BAR; PG8_SCHED;
            PG8_LDB(B1, 0, 1); PG8_STAGE(PG8_SB(0, 0), b2, voffB);
            PG8_BAR; PG8_WAIT_L(0); PG8_MMA(0, 1, At, B1); PG8_BAR;
            PG8_LDA(At, 0, 1); PG8_STAGE(PG8_SA(0, 0), a2, voffA);
            PG8_BAR; PG8_WAIT_L(0); PG8_MMA(1, 0, At, B0); PG8_BAR; PG8_SCHED;
            PG8_STAGE(PG8_SB(0, 1), b2 + hstep, voffB);
            PG8_WAIT_V(6); PG8_BAR; PG8_MMA(1, 1, At, B1); PG8_BAR;
            PG8_LDB(B0, 1, 0); PG8_SCHED; PG8_LDA(At, 1, 0); PG8_STAGE(PG8_SA(0, 1), a2 + hstepA, voffA);
            PG8_WAIT_L(8); PG8_BAR; PG8_WAIT_L(0); PG8_MMA(0, 0, At, B0); PG8_BAR; PG8_SCHED;
            PG8_LDB(B1, 1, 1); PG8_STAGE(PG8_SB(1, 0), b3, voffB);
            PG8_BAR; PG8_WAIT_L(0); PG8_MMA(0, 1, At, B1); PG8_BAR;
            PG8_LDA(At, 1, 1); PG8_STAGE(PG8_SA(1, 0), a3, voffA);
            PG8_BAR; PG8_WAIT_L(0); PG8_MMA(1, 0, At, B0); PG8_BAR; PG8_SCHED;
            PG8_STAGE(PG8_SB(1, 1), b3 + hstep, voffB);
            PG8_WAIT_V(6); PG8_BAR; PG8_MMA(1, 1, At, B1); PG8_BAR;
            }
        }
        if constexpr (ALIGN_EPI) { if (wr == 0) PG8_BAR; }
        if constexpr (!Epi::AFTER_DRAIN) { E(acc, cur, wr, wc, fr, fq); S.done(cur); }
        if (!has_next) break;
#pragma unroll
        for (int a = 0; a < 2; ++a)
#pragma unroll
            for (int b = 0; b < 2; ++b)
#pragma unroll
                for (int m = 0; m < 4; ++m)
#pragma unroll
                    for (int n = 0; n < 2; ++n) acc[a][b][m][n] = (f32x4){0.f, 0.f, 0.f, 0.f};
        cur = nxt; cA = nA; cB = nB; ++ui;
        if constexpr (ALIGN_EPI) { if (wr == 1) PG8_BAR; }
    }
    PG8_WAIT_V(0);
    if constexpr (!ALIGN_EPI) { if (wr == 0) PG8_BAR; }
    PG8_BAR;
    if constexpr (Epi::AFTER_DRAIN) { E.fused(acc, cur, wr, wc, fr, fq, lds, wid, lane); S.done(cur); }
#undef PG8_SA
#undef PG8_SB
#undef PG8_STAGE
#undef PG8_LDA
#undef PG8_LDB
#undef PG8_MMA
#undef PG8_WAIT_V
#undef PG8_WAIT_L
#undef PG8_BAR
#undef PG8_SCHED
}
}

template <class E> struct EpiAdapt { static constexpr bool PERM = false, AFTER_DRAIN = false; E e;
    __device__ __forceinline__ void operator()(const pg8::f32x4 (&acc)[2][2][4][2], const pg8::Unit& u, int wr, int wc, int fr, int fq) const { e(acc, 0, u.pm, u.pn, wr, wc, fr, fq); } };
template <class Epi>
__device__ __forceinline__ void gemm_stream(LAS unsigned char* lds, const bf16_t* A, const bf16_t* Bt, int N, int K, const Epi& E, int bid, int nb) {
    pg8::Gemm g{A, Bt, MTOK, N, K, K}; pg8::StaticOrder S; S.init(MTOK, N, nb, bid);
    EpiAdapt<Epi> ea{E};
    pg8::gemm_phase<EpiAdapt<Epi>, pg8::StaticOrder, true, true>(lds, g, S, ea);
}

#define EPI_LOOP(...) \
    _Pragma("unroll") for (int ai = 0; ai < 2; ++ai) _Pragma("unroll") for (int m = 0; m < 4; ++m) { asm volatile("" ::: "memory"); const int row = pm * 256 + ai * 128 + wr * 64 + m * 16 + fr; \
    _Pragma("unroll") for (int bj = 0; bj < 2; ++bj) _Pragma("unroll") for (int n = 0; n < 2; ++n) { const int ct = bj * 128 + wc * 32 + n * 16 + fq * 4; const f32x4 v = acc[ai][bj][m][n]; __VA_ARGS__ } }

struct EpiWin {
    bf16_t* UX; bf16_t* QKV;
    __device__ __forceinline__ void operator()(const f32x4 (&acc)[2][2][4][2], int gb, int pm, int pn, int wr, int wc, int fr, int fq) const {
        if (pn < 2) {
            bf16_t* base = UX + ((size_t)(pn * 16 + wc * 2) * 512 + (pm >> 4) * 128 + (pm & 15) * 8 + wr * 2) * 640 + fr * 16 + fq * 4;
#pragma unroll
            for (int ai = 0; ai < 2; ++ai)
#pragma unroll
                for (int m = 0; m < 4; ++m) { bf16_t* rp = base + (ai * 4 + (m >> 1)) * 640 + (m & 1) * 256;
#pragma unroll
                    for (int bj = 0; bj < 2; ++bj)
#pragma unroll
                        for (int n = 0; n < 2; ++n) { const f32x4 v = acc[ai][bj][m][n]; u32x2 w; w.x = pk2(v[0], v[1]); w.y = pk2(v[2], v[3]);
                            *(u32x2*)(rp + (size_t)(bj * 8 + n) * (512 * 640)) = w; }
                    asm volatile("" ::: "memory"); }
        } else { bf16_t* base = QKV + (size_t)((pn - 2) >> 1) * ((size_t)MTOK * 512) + (pn & 1) * 256 + (size_t)(pm * 256 + wr * 64 + fr) * 512 + wc * 32 + fq * 4;
#pragma unroll
            for (int ai = 0; ai < 2; ++ai)
#pragma unroll
                for (int m = 0; m < 4; ++m) { bf16_t* rp = base + (size_t)(ai * 128 + m * 16) * 512;
#pragma unroll
                    for (int bj = 0; bj < 2; ++bj)
#pragma unroll
                        for (int n = 0; n < 2; ++n) { const f32x4 v = acc[ai][bj][m][n]; u32x2 w; w.x = pk2(v[0], v[1]); w.y = pk2(v[2], v[3]);
                            *(u32x2*)(rp + bj * 128 + n * 16) = w; }
                    asm volatile("" ::: "memory"); }
        }
    }
};
struct EpiS5Z {
    float* Z;
    __device__ __forceinline__ void operator()(const f32x4 (&acc)[2][2][4][2], int gb, int pm, int pn, int wr, int wc, int fr, int fq) const {
        EPI_LOOP({ if (bj == 0) *(f32x4*)(Z + ((size_t)gb * 512 + row) * 128 + ct) = v; })
    }
};
struct EpiS5Y {
    const bf16_t* UX; bf16_t* YG; const float* dsk;
    __device__ __forceinline__ void operator()(const f32x4 (&acc)[2][2][4][2], int gb, int pm, int pn, int wr, int wc, int fr, int fq) const {
        EPI_LOOP({ const int col = pn * 256 + ct, t = col >> 4, h = col & 15, bb = row >> 7, cc = row & 127;
            const u32x2 uu = *(const u32x2*)(UX + ((size_t)gb * 512 + row) * 640 + col); const f32x4 dd = *(const f32x4*)(dsk + gb * 16 + h);
            u32x2 w; w.x = pk2(gelu_tanh(v[0] + dd[0] * bflo(uu.x)), gelu_tanh(v[1] + dd[1] * bfhi(uu.x))); w.y = pk2(gelu_tanh(v[2] + dd[2] * bflo(uu.y)), gelu_tanh(v[3] + dd[3] * bfhi(uu.y)));
            *(u32x2*)(YG + ((size_t)bb * SEQ + cc * 32 + t) * 512 + gb * 16 + h) = w; })
    }
};
struct PreS5Y {   static constexpr bool NOP = false;
    const float* Z; bf16_t* UX; const float* lam_re; const float* lam_im; const float* log_dt;
    __device__ __forceinline__ void operator()(int gb, int pm, int pn) const {
        const int tid = threadIdx.x;
        if (tid < 128) { const int pp = tid & 63, bb = 2 * pm + (tid >> 6);
            const float lr = lam_re[gb * 64 + pp], li = lam_im[gb * 64 + pp], dt = expf(log_dt[gb]);
            const float mag = expf(lr * dt * 32.f), ar = mag * cosf(li * dt * 32.f), ai = mag * sinf(li * dt * 32.f);
            const float* zp = Z + ((size_t)gb * 512 + bb * 128) * 128 + pp; bf16_t* xp = UX + ((size_t)gb * 512 + bb * 128) * 640 + 512 + pp;
            float xr = 0.f, xi = 0.f;
            for (int c0 = 0; c0 < 128; c0 += 16) { float zr[16], zi[16];
#pragma unroll
                for (int i = 0; i < 16; ++i) { zr[i] = zp[(size_t)(c0 + i) * 128]; zi[i] = zp[(size_t)(c0 + i) * 128 + 64]; }
#pragma unroll
                for (int i = 0; i < 16; ++i) { xp[(size_t)(c0 + i) * 640] = (bf16_t)f2bf(xr); xp[(size_t)(c0 + i) * 640 + 64] = (bf16_t)f2bf(xi);
                    const float nr = ar * xr - ai * xi + zr[i], ni = ar * xi + ai * xr + zi[i]; xr = nr; xi = ni; } } }
        __threadfence();
        asm volatile("s_waitcnt vmcnt(0)" ::: "memory");
        __syncthreads();
    }
};
struct EpiGlu {
    const bf16_t* YG; bf16_t* CAT;
    __device__ __forceinline__ void operator()(const f32x4 (&acc)[2][2][4][2], int gb, int pm, int pn, int wr, int wc, int fr, int fq) const {
        EPI_LOOP({ const int col = pn * 256 + ct; const u32x2 y = *(const u32x2*)(YG + (size_t)row * 512 + col);
            u32x2 w; w.x = pk2(bflo(y.x) * sigmoidf_(v[0]), bfhi(y.x) * sigmoidf_(v[1])); w.y = pk2(bflo(y.y) * sigmoidf_(v[2]), bfhi(y.y) * sigmoidf_(v[3]));
            *(u32x2*)(CAT + (size_t)row * 1024 + col) = w; })
    }
};
struct EpiRes {
    const float* res; float* out; const float* gate;
    __device__ __forceinline__ void operator()(const f32x4 (&acc)[2][2][4][2], int gb, int pm, int pn, int wr, int wc, int fr, int fq) const {
        const float* gatep = gate + (size_t)(pm >> 4) * 6144;
        EPI_LOOP({ const int col = pn * 256 + ct; const f32x4 g = *(const f32x4*)(gatep + col); const f32x4 r = *(const f32x4*)(res + (size_t)row * 1024 + col);
            *(f32x4*)(out + (size_t)row * 1024 + col) = r + g * v; })
    }
};
struct EpiSwiglu {
    bf16_t* HID;
    __device__ __forceinline__ void operator()(const f32x4 (&acc)[2][2][4][2], int gb, int pm, int pn, int wr, int wc, int fr, int fq) const {
#pragma unroll
        for (int ai = 0; ai < 2; ++ai)
#pragma unroll
            for (int m = 0; m < 4; ++m) { const int row = pm * 256 + ai * 128 + wr * 64 + m * 16 + fr;
#pragma unroll
                for (int n = 0; n < 2; ++n) { const f32x4 g = acc[ai][0][m][n], u = acc[ai][1][m][n]; float o[4];
#pragma unroll
                    for (int j = 0; j < 4; ++j) o[j] = g[j] * sigmoidf_(g[j]) * u[j];
                    u32x2 w; w.x = pk2(o[0], o[1]); w.y = pk2(o[2], o[3]);
                    *(u32x2*)(HID + (size_t)row * FF + pn * 128 + wc * 32 + n * 16 + fq * 4) = w; } }
    }
};
struct EpiRKV {
    bf16_t* RKV; int row0;
    __device__ __forceinline__ void operator()(const f32x4 (&acc)[2][2][4][2], int gb, int pm, int pn, int wr, int wc, int fr, int fq) const {
        bf16_t* base = RKV + (size_t)gb * ((size_t)MTOK * 1024) + (size_t)row0 * 1024 + pn * 256;
        EPI_LOOP({ u32x2 w; w.x = pk2(v[0], v[1]); w.y = pk2(v[2], v[3]); *(u32x2*)(base + (size_t)row * 1024 + ct) = w; })
    }
};
struct EpiL1 {
    bf16_t* L1; int row0;
    __device__ __forceinline__ void operator()(const f32x4 (&acc)[2][2][4][2], int gb, int pm, int pn, int wr, int wc, int fr, int fq) const {
        bf16_t* base = L1 + (size_t)(row0 + pm * 256 + wr * 64 + fr) * 256 + wc * 32 + fq * 4;
        const bool ident = (wc >= 2);
#pragma unroll
        for (int ai = 0; ai < 2; ++ai)
#pragma unroll
            for (int m = 0; m < 4; ++m) { bf16_t* rp = base + (size_t)(ai * 128 + m * 16) * 256;
#pragma unroll
                for (int bj = 0; bj < 2; ++bj) { const float sc = bj ? 1.f : 2.f, of = bj ? 0.f : -1.f;
#pragma unroll
                    for (int n = 0; n < 2; ++n) { const f32x4 v = acc[ai][bj][m][n]; float o[4];
#pragma unroll
                        for (int j = 0; j < 4; ++j) { const float sg = sc * __builtin_amdgcn_rcpf(1.f + __expf(-sc * v[j])) + of; o[j] = (bj == 0 && ident) ? v[j] : sg; }
                        u32x2 w; w.x = pk2(o[0], o[1]); w.y = pk2(o[2], o[3]); *(u32x2*)(rp + bj * 128 + n * 16) = w; } }
                asm volatile("" ::: "memory"); }
    }
};
struct EpiL2 {
    _Float16* DEC; bf16_t* AA; bf16_t* G; const float* w0; const float* a0;
    __device__ __forceinline__ void operator()(const f32x4 (&acc)[2][2][4][2], int gb, int pm, int pn, int wr, int wc, int fr, int fq) const {
        const int sel = pn >> 2, cb = (pn & 3) * 256;
        if (sel == 0) { EPI_LOOP({ const int col = cb + ct; const f32x4 w0v = *(const f32x4*)(w0 + col);
                _Pragma("unroll") for (int j = 0; j < 4; ++j) { const float z = w0v[j] + v[j]; const float sp = fmaxf(-z, 0.f) + __logf(1.f + __expf(-fabsf(z))); const float e = __expf(-sp - 0.5f);
                    const float omd = (e < 0.125f) ? e * (1.f - e * (0.5f - e * (0.16666667f - e * (0.041666668f - e * 0.0083333338f)))) : 1.f - __expf(-e);
                    DEC[(size_t)row * 1024 + col + j] = (_Float16)omd; } }) }
        else if (sel == 1) { EPI_LOOP({ const int col = cb + ct; const f32x4 a0v = *(const f32x4*)(a0 + col);
                u32x2 w; w.x = pk2(sigmoidf_(a0v[0] + v[0]), sigmoidf_(a0v[1] + v[1])); w.y = pk2(sigmoidf_(a0v[2] + v[2]), sigmoidf_(a0v[3] + v[3]));
                *(u32x2*)(AA + (size_t)row * 1024 + col) = w; }) }
        else { EPI_LOOP({ const int col = cb + ct; u32x2 w; w.x = pk2(v[0], v[1]); w.y = pk2(v[2], v[3]); *(u32x2*)(G + (size_t)row * 1024 + col) = w; }) }
    }
};


struct SchedRKV { int vb, vn;
    __device__ bool next(int i, pg8::Unit& u) const { const int t = vb + i * vn; if (vb < 0 || t >= 384) return false; u.pm = t & 31; u.pn = t >> 5; u.ao = (u.pn >> 2) * 2048; return true; }
    __device__ __forceinline__ void a_ready(const pg8::Unit&) const {}
    __device__ __forceinline__ void done(const pg8::Unit&) const {} };
struct SchedOne { int pm;
    __device__ bool next(int i, pg8::Unit& u) const { if (i > 0 || pm < 0) return false; u.pm = pm; u.pn = 0; u.ao = 0; return true; }
    __device__ __forceinline__ void a_ready(const pg8::Unit&) const {}
    __device__ __forceinline__ void done(const pg8::Unit&) const {} };
struct EpiAdaptRKV { static constexpr bool PERM = false, AFTER_DRAIN = false; EpiRKV e;
    __device__ __forceinline__ void operator()(const pg8::f32x4 (&acc)[2][2][4][2], const pg8::Unit& u, int wr, int wc, int fr, int fq) const { e(acc, u.pn >> 2, u.pm, u.pn & 3, wr, wc, fr, fq); } };
__device__ __forceinline__ void s5_gen(const Params& p, bf16_t* BtY, bf16_t* BtZ, float* lds, int bid, int nb) {
    float* PWr = lds; float* PWi = lds + 33 * 64; float* BBr = lds + 66 * 64; float* BBi = BBr + 1024; float* Cr = BBi + 1024; float* Ci = Cr + 1024; float* Kt = Ci + 1024;
    const int tid = threadIdx.x;
    for (int unit = bid; unit < 256; unit += nb) {
        const int g = unit >> 3, part = unit & 7;
        __syncthreads();
        { const float dt = expf(p.in[13][g]);
          for (int e = tid; e < 33 * 64; e += NTHR) { const int tau = e >> 6, pp = e & 63; const float lr = p.in[11][g * 64 + pp], li = p.in[12][g * 64 + pp];
              const float mag = expf(lr * dt * (float)tau), ang = li * dt * (float)tau; PWr[e] = mag * cosf(ang); PWi[e] = mag * sinf(ang); }
          __syncthreads();
          if (tid < 64) { const int pp = tid; const float lr = p.in[11][g * 64 + pp], li = p.in[12][g * 64 + pp];
              const float ar = PWr[64 + pp], ai = PWi[64 + pp], den = lr * lr + li * li, nr = ar - 1.f;
              const float qr = (nr * lr + ai * li) / den, qi = (ai * lr - nr * li) / den;
              for (int h = 0; h < 16; ++h) { const float br = p.in[14][(size_t)(g * 64 + pp) * 16 + h], bi = p.in[15][(size_t)(g * 64 + pp) * 16 + h]; BBr[pp * 16 + h] = qr * br - qi * bi; BBi[pp * 16 + h] = qr * bi + qi * br; } } }
        for (int i = tid; i < 1024; i += NTHR) { Cr[i] = p.in[16][(size_t)g * 1024 + i]; Ci[i] = p.in[17][(size_t)g * 1024 + i]; }
        __syncthreads();
        { const int tau = tid >> 4, h = tid & 15;
          float acc[16];
#pragma unroll
          for (int i = 0; i < 16; ++i) acc[i] = 0.f;
          for (int pp = 0; pp < 64; ++pp) { const float cr = Cr[h * 64 + pp], ci = Ci[h * 64 + pp], wr = PWr[tau * 64 + pp], wi = PWi[tau * 64 + pp];
              const float er = cr * wr - ci * wi, ei = cr * wi + ci * wr;
#pragma unroll
              for (int q = 0; q < 4; ++q) { const f32x4 br = *(const f32x4*)(BBr + pp * 16 + q * 4), bi = *(const f32x4*)(BBi + pp * 16 + q * 4);
#pragma unroll
                  for (int j = 0; j < 4; ++j) acc[q * 4 + j] += er * br[j] - ei * bi[j]; } }
#pragma unroll
          for (int q = 0; q < 4; ++q) *(f32x4*)(Kt + tau * 256 + h * 16 + q * 4) = (f32x4){acc[q * 4], acc[q * 4 + 1], acc[q * 4 + 2], acc[q * 4 + 3]}; }
        __syncthreads();
        for (int ci_ = tid; ci_ < 5120; ci_ += NTHR) { const int nrow = part * 64 + ci_ / 80, kc = (ci_ % 80) * 8, t = nrow >> 4, h = nrow & 15; float v[8];
#pragma unroll
            for (int i = 0; i < 8; ++i) { const int k = kc + i;
                if (k < 512) { const int sidx = k >> 4, h2 = k & 15; v[i] = (sidx <= t) ? Kt[(t - sidx) * 256 + h * 16 + h2] : 0.f; }
                else { const int jj = k - 512, pp = jj & 63; const float cr = Cr[h * 64 + pp], ci = Ci[h * 64 + pp], wr = PWr[(t + 1) * 64 + pp], wi = PWi[(t + 1) * 64 + pp];
                    v[i] = (jj >> 6) ? -(cr * wi + ci * wr) : (cr * wr - ci * wi); } }
            *(u32x4*)(BtY + ((size_t)g * 512 + nrow) * 640 + kc) = (u32x4){pk2(v[0], v[1]), pk2(v[2], v[3]), pk2(v[4], v[5]), pk2(v[6], v[7])}; }
        for (int ci_ = tid; ci_ < 1024; ci_ += NTHR) { const int n = part * 16 + (ci_ >> 6), kc = (ci_ & 63) * 8, pp = n & 63, im = n >> 6; float v[8];
#pragma unroll
            for (int i = 0; i < 8; ++i) { const int k = kc + i, sidx = k >> 4, h2 = k & 15, tau = 31 - sidx; const float wr = PWr[tau * 64 + pp], wi = PWi[tau * 64 + pp], br = BBr[pp * 16 + h2], bi = BBi[pp * 16 + h2];
                v[i] = im ? (wr * bi + wi * br) : (wr * br - wi * bi); }
            *(u32x4*)(BtZ + ((size_t)g * 256 + n) * 512 + kc) = (u32x4){pk2(v[0], v[1]), pk2(v[2], v[3]), pk2(v[4], v[5]), pk2(v[6], v[7])}; }
    }
    __syncthreads();
}

template <int MODE>
__device__ __forceinline__ void tr_job(const float* src, int K, int N, bf16_t* dst, int ldd, int row_off, int koff, const float* scale, float* lds, int bid, int nb, const float* scale2 = nullptr) {
    const int tk = K / 64, tn = N / 64, tid = threadIdx.x, nt_ = tk * tn;
    const int r = tid >> 3, c = (tid & 7) * 8;
    float4 a = {0.f, 0.f, 0.f, 0.f}, b = a; float sc = 1.f;
    if (bid < nt_) { const int k0 = (bid / tn) * 64, n0 = (bid % tn) * 64; const float* p = src + (size_t)(k0 + r) * N + n0 + c; a = *(const float4*)p; b = *(const float4*)(p + 4); sc = scale ? scale[k0 + r] - (scale2 ? scale2[k0 + r] : 0.f) : 1.f; }
    for (int t = bid; t < nt_; t += nb) {
        const int k0 = (t / tn) * 64, n0 = (t % tn) * 64;
        { float* l = lds + r * 65 + c; l[0] = a.x * sc; l[1] = a.y * sc; l[2] = a.z * sc; l[3] = a.w * sc; l[4] = b.x * sc; l[5] = b.y * sc; l[6] = b.z * sc; l[7] = b.w * sc; }
        if (t + nb < nt_) { const int t2 = t + nb, k2 = (t2 / tn) * 64, n2 = (t2 % tn) * 64; const float* p = src + (size_t)(k2 + r) * N + n2 + c; a = *(const float4*)p; b = *(const float4*)(p + 4); sc = scale ? scale[k2 + r] - (scale2 ? scale2[k2 + r] : 0.f) : 1.f; }
        __syncthreads();
        { const int nl = tid >> 3, kc = (tid & 7) * 8; float v[8];
#pragma unroll
          for (int i = 0; i < 8; ++i) v[i] = lds[(kc + i) * 65 + nl];
          int n = n0 + nl; int rowi = n;
          if (MODE == 1) rowi = (n >> 7) * 256 + (n & 127);
          if (MODE == 2) rowi = (n >> 7) * 256 + 128 + (n & 127);
          u32x4 w; w.x = pk2(v[0], v[1]); w.y = pk2(v[2], v[3]); w.z = pk2(v[4], v[5]); w.w = pk2(v[6], v[7]);
          *(u32x4*)(dst + (size_t)(row_off + rowi) * ldd + koff + k0 + kc) = w; }
        __syncthreads();
    }
}

__device__ __forceinline__ void prep_phase(const Params& p, float* lds, int bid, int nb) {
    unsigned char* ws = p.ws;
    s5_gen(p, (bf16_t*)(ws + OFF_BTY), (bf16_t*)(ws + OFF_BTZ), lds, bid, nb);
    tr_job<0>(p.in[10], 1024, 2048, (bf16_t*)(ws + OFF_WIN), 1024, 0, 0, nullptr, lds, bid, nb);
    tr_job<0>(p.in[19], 512, 512, (bf16_t*)(ws + OFF_WGLU), 512, 0, 0, nullptr, lds, bid, nb);
    tr_job<0>(p.in[27], 1024, 1024, (bf16_t*)(ws + OFF_WOUT), 1024, 0, 0, nullptr, lds, bid, nb);
    for (int l = 0; l < 2; ++l) {
        bf16_t* gu = (bf16_t*)(ws + (l ? OFF_WGU1 : OFF_WGU0)); bf16_t* dn = (bf16_t*)(ws + (l ? OFF_WDN1 : OFF_WDN0));
        tr_job<1>(p.in[7] + (size_t)l * 1024 * FF, 1024, FF, gu, 1024, 0, 0, nullptr, lds, bid, nb);
        tr_job<2>(p.in[8] + (size_t)l * 1024 * FF, 1024, FF, gu, 1024, 0, 0, nullptr, lds, bid, nb);
        tr_job<0>(p.in[9] + (size_t)l * FF * 1024, FF, 1024, dn, FF, 0, 0, nullptr, lds, bid, nb);
    }
    bf16_t* wrkv = (bf16_t*)(ws + OFF_WG1); bf16_t* wl1 = (bf16_t*)(ws + OFF_WL1); const float* mu = p.in[28];
    tr_job<0>(p.in[29], 1024, 1024, wrkv, 1024, 0, 0, nullptr, lds, bid, nb);
    tr_job<0>(p.in[30], 1024, 1024, wrkv, 1024, 1024, 0, nullptr, lds, bid, nb);
    tr_job<0>(p.in[31], 1024, 1024, wrkv, 1024, 2048, 0, nullptr, lds, bid, nb);
    tr_job<0>(p.in[34], 1024, 64, wl1, 2048, 0, 0, nullptr, lds, bid, nb);      tr_job<0>(p.in[34], 1024, 64, wl1, 2048, 0, 1024, mu + 1 * 1024, lds, bid, nb, mu + 3 * 1024);
    tr_job<0>(p.in[37], 1024, 64, wl1, 2048, 64, 0, nullptr, lds, bid, nb);     tr_job<0>(p.in[37], 1024, 64, wl1, 2048, 64, 1024, mu + 4 * 1024, lds, bid, nb, mu + 3 * 1024);
    tr_job<0>(p.in[39], 1024, 128, wl1, 2048, 128, 0, nullptr, lds, bid, nb);   tr_job<0>(p.in[39], 1024, 128, wl1, 2048, 128, 1024, mu + 5 * 1024, lds, bid, nb, mu + 3 * 1024);
    bf16_t* l2 = (bf16_t*)(ws + OFF_WL2);
    tr_job<0>(p.in[35], 64, 1024, l2, 256, 0, 0, nullptr, lds, bid, nb);
    tr_job<0>(p.in[38], 64, 1024, l2, 256, 1024, 64, nullptr, lds, bid, nb);
    tr_job<0>(p.in[40], 128, 1024, l2, 256, 2048, 128, nullptr, lds, bid, nb);
    for (int i = bid * NTHR + threadIdx.x; i < 3072 * 32; i += nb * NTHR) { const int n = i >> 5, kc = (i & 31) * 8; const int sel = n >> 10;
        const bool used = (sel == 0) ? (kc < 64) : (sel == 1) ? (kc >= 64 && kc < 128) : (kc >= 128);
        if (!used) *(u32x4*)(l2 + (size_t)n * 256 + kc) = (u32x4){0u, 0u, 0u, 0u}; }
    tr_job<0>(p.in[32], 1024, 1024, (bf16_t*)(ws + OFF_WO), 1024, 0, 0, nullptr, lds, bid, nb);
    {   const float* c = p.in[1]; const float* wada = p.in[3]; const float* bada = p.in[4]; float* mod = (float*)(ws + OFF_MOD);
        float* cact = lds;
        float* red = lds + 4096;
        for (int i = threadIdx.x; i < 4096; i += NTHR) { const float x = c[i]; cact[i] = x / (1.f + expf(-x)); }
        __syncthreads();
        const int col = threadIdx.x & 63, kg = threadIdx.x >> 6;
        for (int ch = bid; ch < 192; ch += nb) {
            const int l = ch / 96, n0 = (ch % 96) * 64;
            const float* wp = wada + (size_t)l * 1024 * 6144 + n0 + col;
            float a0 = 0.f, a1 = 0.f, a2 = 0.f, a3 = 0.f;
            for (int k = kg * 128; k < kg * 128 + 128; ++k) { const float w = wp[(size_t)k * 6144]; a0 += cact[k] * w; a1 += cact[1024 + k] * w; a2 += cact[2048 + k] * w; a3 += cact[3072 + k] * w; }
            red[(kg * 4 + 0) * 64 + col] = a0; red[(kg * 4 + 1) * 64 + col] = a1; red[(kg * 4 + 2) * 64 + col] = a2; red[(kg * 4 + 3) * 64 + col] = a3;
            __syncthreads();
            if (threadIdx.x < 256) { const int b = threadIdx.x >> 6; float s = 0.f;
#pragma unroll
                for (int g = 0; g < 8; ++g) s += red[(g * 4 + b) * 64 + col];
                mod[(size_t)(l * 4 + b) * 6144 + n0 + col] = s + bada[l * 6144 + n0 + col]; }
            __syncthreads();
        }
    }
}

template <bool RW>
__device__ __forceinline__ void norm_phase(const float* x, const float* g, const float* modl, int shift_off, int scale_off, bf16_t* out, int bid, int nb, int row0 = 0, int nrows = MTOK, const float* mu = nullptr) {
    const int wave = threadIdx.x >> 6, lane = threadIdx.x & 63;
    for (int row = row0 + bid * 8 + wave; row < row0 + nrows; row += nb * 8) {
        const int b = row >> 12; const float* xr = x + (size_t)row * 1024; const float* md = modl + (size_t)b * 6144;
        f32x4 v[4], vp[4]; float ss = 0.f, ssp = 0.f; const bool hasp = RW && ((row & 4095) != 0);
#pragma unroll
        for (int i = 0; i < 4; ++i) { v[i] = *(const f32x4*)(xr + i * 256 + lane * 4); ss += v[i][0] * v[i][0] + v[i][1] * v[i][1] + v[i][2] * v[i][2] + v[i][3] * v[i][3];
            if (RW) { vp[i] = hasp ? *(const f32x4*)(xr - 1024 + i * 256 + lane * 4) : (f32x4){0.f, 0.f, 0.f, 0.f}; ssp += vp[i][0] * vp[i][0] + vp[i][1] * vp[i][1] + vp[i][2] * vp[i][2] + vp[i][3] * vp[i][3]; } }
        ss = wave_sum(ss); const float rstd = rsqrtf(ss * (1.f / 1024.f) + 1e-6f);
        float rstdp = 0.f; if (RW) { ssp = wave_sum(ssp); rstdp = rsqrtf(ssp * (1.f / 1024.f) + 1e-6f); }
#pragma unroll
        for (int i = 0; i < 4; ++i) { const int c = i * 256 + lane * 4; const f32x4 gg = *(const f32x4*)(g + c), sc = *(const f32x4*)(md + scale_off + c), sh = *(const f32x4*)(md + shift_off + c);
            f32x4 h;
#pragma unroll
            for (int j = 0; j < 4; ++j) h[j] = v[i][j] * rstd * gg[j] * (1.f + sc[j]) + sh[j];
            if (!RW) { u32x2 w; w.x = pk2(h[0], h[1]); w.y = pk2(h[2], h[3]); *(u32x2*)(out + (size_t)row * 1024 + c) = w; }
            else { f32x4 d;
#pragma unroll
                for (int j = 0; j < 4; ++j) { const float hp = hasp ? (vp[i][j] * rstdp * gg[j] * (1.f + sc[j]) + sh[j]) : 0.f; d[j] = hp - h[j]; }
                const f32x4 mr = *(const f32x4*)(mu + c), mk = *(const f32x4*)(mu + 2048 + c), mv = *(const f32x4*)(mu + 3072 + c);
                const f32x4 xr_ = h + d * mr, xk_ = h + d * mk, xv_ = h + d * mv;
                bf16_t* o = out + (size_t)(row - row0) * 4096 + c;
                u32x2 w; w.x = pk2(xr_[0], xr_[1]); w.y = pk2(xr_[2], xr_[3]); *(u32x2*)(o) = w;
                w.x = pk2(xk_[0], xk_[1]); w.y = pk2(xk_[2], xk_[3]); *(u32x2*)(o + 1024) = w;
                w.x = pk2(xv_[0], xv_[1]); w.y = pk2(xv_[2], xv_[3]); *(u32x2*)(o + 2048) = w;
                w.x = pk2(d[0], d[1]); w.y = pk2(d[2], d[3]); *(u32x2*)(o + 3072) = w; } }
    }
}

__device__ __forceinline__ void qknorm_phase(bf16_t* Q, bf16_t* Kb, const int* pos, const float* qn, const float* kn, int bid, int nb) {
    const int wave = threadIdx.x >> 6, lane = threadIdx.x & 63, l16 = lane & 15, d0 = l16 * 4;
    float invf[4];
#pragma unroll
    for (int j = 0; j < 4; ++j) invf[j] = powf(500000.f, -(float)((l16 & 1) * 4 + j) / 8.f);
    const f32x4 qw = *(const f32x4*)(qn + d0), kw = *(const f32x4*)(kn + d0);
    for (int tok = bid * 8 + wave; tok < MTOK; tok += nb * 8) {
        const float ps = (float)pos[tok];
        float cs[4], sn[4];
#pragma unroll
        for (int j = 0; j < 4; ++j) { const float ang = ps * invf[j]; float rv = ang * 0.15915494309189535f; rv -= floorf(rv); cs[j] = __builtin_amdgcn_cosf(rv); sn[j] = __builtin_amdgcn_sinf(rv); }
#pragma unroll
        for (int bsel = 0; bsel < 2; ++bsel) { bf16_t* buf = bsel ? Kb : Q; const f32x4 w = bsel ? kw : qw;
#pragma unroll
            for (int it = 0; it < 2; ++it) { const int vec = it * 4 + (lane >> 4); bf16_t* ptr = buf + (size_t)tok * 512 + vec * 64 + d0;
                const u32x2 raw = *(const u32x2*)ptr; float y[4] = {bflo(raw.x), bfhi(raw.x), bflo(raw.y), bfhi(raw.y)};
                float ss = y[0] * y[0] + y[1] * y[1] + y[2] * y[2] + y[3] * y[3];
                ss = dpp_sum16(ss);
                const float rstd = rsqrtf(ss * (1.f / 64.f) + 1e-6f);
#pragma unroll
                for (int j = 0; j < 4; ++j) y[j] = y[j] * rstd * w[j];
                float pr[4];
#pragma unroll
                for (int j = 0; j < 4; ++j) pr[j] = __int_as_float(__builtin_amdgcn_update_dpp(0, __float_as_int(y[j]), 0x4E, 0xf, 0xf, true));
                if (l16 < 2) {
#pragma unroll
                    for (int j = 0; j < 4; ++j) y[j] = y[j] * cs[j] - pr[j] * sn[j]; }
                else if (l16 < 4) {
#pragma unroll
                    for (int j = 0; j < 4; ++j) y[j] = y[j] * cs[j] + pr[j] * sn[j]; }
                if (!bsel) {
#pragma unroll
                    for (int j = 0; j < 4; ++j) y[j] *= 0.125f * 1.4426950408889634f; }
                u32x2 o; o.x = pk2(y[0], y[1]); o.y = pk2(y[2], y[3]); *(u32x2*)ptr = o; } }
    }
}

__device__ __forceinline__ void vtrans_phase(const bf16_t* V, bf16_t* Vt, bf16_t* lds, int bid, int nb) {
    const int tid = threadIdx.x;
    for (int unit = bid; unit < 1024; unit += nb) {
        const int head = unit & 3, ch = unit >> 2; const int b = ch >> 6, t0 = (ch & 63) * 64;
#pragma unroll
        for (int i = 0; i < 2; ++i) { const int idx = tid + i * 512, t = idx >> 4, cc = (idx & 15) * 8;
            const u32x4 w = *(const u32x4*)(V + ((size_t)b * SEQ + t0 + t) * 512 + head * 128 + cc);
            unsigned* d = (unsigned*)(lds + t * 130 + cc); d[0] = w.x; d[1] = w.y; d[2] = w.z; d[3] = w.w; }
        __syncthreads();
        { const int e = tid >> 2, tc = (tid & 3) * 16; unsigned o[8];
#pragma unroll
          for (int i = 0; i < 8; ++i) o[i] = (unsigned)lds[(tc + 2 * i) * 130 + e] | ((unsigned)lds[(tc + 2 * i + 1) * 130 + e] << 16);
          u32x4* dst = (u32x4*)(Vt + ((size_t)(b * 4 + head) * 128 + e) * SEQ + t0 + tc);
          dst[0] = (u32x4){o[0], o[1], o[2], o[3]}; dst[1] = (u32x4){o[4], o[5], o[6], o[7]}; }
        __syncthreads();
    }
}

typedef float f32x16 __attribute__((ext_vector_type(16)));
__device__ __forceinline__ float xhalf_max(float x) { auto r = __builtin_amdgcn_permlane32_swap(__float_as_uint(x), __float_as_uint(x), false, false); return fmaxf(__uint_as_float(r[0]), __uint_as_float(r[1])); }
__device__ __forceinline__ float xhalf_sum(float x) { auto r = __builtin_amdgcn_permlane32_swap(__float_as_uint(x), __float_as_uint(x), false, false); return __uint_as_float(r[0]) + __uint_as_float(r[1]); }
__device__ __forceinline__ void attn_phase(const bf16_t* Q, const bf16_t* Kb, const bf16_t* Vt, bf16_t* CAT, const Params& p, LAS unsigned char* lds, int bid, int nb) {
    const int tid = threadIdx.x, wave = __builtin_amdgcn_readfirstlane(tid >> 6), lane = tid & 63, c = wave >> 2, wq = wave & 3, l32 = lane & 31, hh = lane >> 5;
    constexpr int KROW = 272, VROW = 144, KBUF = 64 * KROW, VBUF = 128 * VROW, VOFF = 2 * KBUF;
    const int lkey = tid >> 4, lkc = tid & 15, lve = tid >> 3, lvc = tid & 7;
    for (int unit = bid; unit < 256; unit += nb) {
        const int b = unit & 3, head = (unit >> 2) & 3, pr = unit >> 4;
        const bf16_t* kg = Kb + ((size_t)b * SEQ + lkey) * 512 + head * 128 + lkc * 8;
        const bf16_t* vg = Vt + ((size_t)(b * 4 + head) * 128 + lve) * SEQ + lvc * 8;
        for (int half = 0; half < 2; ++half) {
            const int qb = half ? (31 - pr) : pr; const int q0 = qb * 128 + wq * 32; const int nst = (qb + 1) * 2;
            bf16x8 qf[4];
            { const bf16_t* qp = Q + ((size_t)b * SEQ + q0 + l32) * 512 + head * 128 + c * 64 + hh * 8;
#pragma unroll
              for (int ks = 0; ks < 4; ++ks) qf[ks] = *(const bf16x8*)(qp + ks * 16); }
            f32x16 o[4];
#pragma unroll
            for (int blk = 0; blk < 4; ++blk)
#pragma unroll
                for (int r = 0; r < 16; ++r) o[blk][r] = 0.f;
            float mrow = -INFINITY, lsum = 0.f;
            u32x4 kreg[2][2], vreg[2][2];
#define AT_ISSUE(set, st) do { const int st_ = ((st) < nst) ? (st) : nst - 1; kreg[set][0] = *(const u32x4*)(kg + (size_t)(st_ * 64) * 512); kreg[set][1] = *(const u32x4*)(kg + (size_t)(st_ * 64 + 32) * 512); \
                               vreg[set][0] = *(const u32x4*)(vg + st_ * 64); vreg[set][1] = *(const u32x4*)(vg + (size_t)64 * SEQ + st_ * 64); } while (0)
#define AT_WRITE(set, slot) do { *(LAS u32x4*)(lds + (slot) * KBUF + lkey * KROW + lkc * 16) = kreg[set][0]; *(LAS u32x4*)(lds + (slot) * KBUF + (lkey + 32) * KROW + lkc * 16) = kreg[set][1]; \
                                 LAS u32x2* vd0 = (LAS u32x2*)(lds + VOFF + (slot) * VBUF + lve * VROW + (lvc >> 1) * 32 + (lvc & 1) * 8); vd0[0] = (u32x2){vreg[set][0].x, vreg[set][0].y}; vd0[2] = (u32x2){vreg[set][0].z, vreg[set][0].w}; \
                                 LAS u32x2* vd1 = (LAS u32x2*)(lds + VOFF + (slot) * VBUF + (lve + 64) * VROW + (lvc >> 1) * 32 + (lvc & 1) * 8); vd1[0] = (u32x2){vreg[set][1].x, vreg[set][1].y}; vd1[2] = (u32x2){vreg[set][1].z, vreg[set][1].w}; } while (0)
#define AT_PACK(dst, sv, base) do { u32x4 pw_; pw_.x = cvt_pk_bf16(sv[(base) + 0], sv[(base) + 1]); pw_.y = cvt_pk_bf16(sv[(base) + 2], sv[(base) + 3]); pw_.z = cvt_pk_bf16(sv[(base) + 4], sv[(base) + 5]); pw_.w = cvt_pk_bf16(sv[(base) + 6], sv[(base) + 7]); dst = __builtin_bit_cast(bf16x8, pw_); } while (0)
#define AT_COMPUTE(slot, st, kfa, kfb, vfa, vfb) do { const int key0 = (st) * 64; \
                if (key0 <= q0 + 31) { \
                    LAS unsigned char* kb = lds + (slot) * KBUF + l32 * KROW + c * 128 + hh * 16; \
                    LAS unsigned char* vb = lds + VOFF + (slot) * VBUF + l32 * VROW + hh * 16; \
                    f32x16 s0, s1; _Pragma("unroll") for (int r = 0; r < 16; ++r) { s0[r] = 0.f; s1[r] = 0.f; } \
                    kfa[0] = *(const LAS bf16x8*)(kb); kfa[1] = *(const LAS bf16x8*)(kb + 32 * KROW); kfa[2] = *(const LAS bf16x8*)(kb + 32); kfa[3] = *(const LAS bf16x8*)(kb + 32 * KROW + 32); \
                    kfb[0] = *(const LAS bf16x8*)(kb + 64); kfb[1] = *(const LAS bf16x8*)(kb + 32 * KROW + 64); kfb[2] = *(const LAS bf16x8*)(kb + 96); kfb[3] = *(const LAS bf16x8*)(kb + 32 * KROW + 96); \
                    __builtin_amdgcn_sched_barrier(0); \
                    __builtin_amdgcn_s_setprio(1); \
                    s0 = __builtin_amdgcn_mfma_f32_32x32x16_bf16(kfa[0], qf[0], s0, 0, 0, 0); s1 = __builtin_amdgcn_mfma_f32_32x32x16_bf16(kfa[1], qf[0], s1, 0, 0, 0); \
                    s0 = __builtin_amdgcn_mfma_f32_32x32x16_bf16(kfa[2], qf[1], s0, 0, 0, 0); s1 = __builtin_amdgcn_mfma_f32_32x32x16_bf16(kfa[3], qf[1], s1, 0, 0, 0); \
                    s0 = __builtin_amdgcn_mfma_f32_32x32x16_bf16(kfb[0], qf[2], s0, 0, 0, 0); s1 = __builtin_amdgcn_mfma_f32_32x32x16_bf16(kfb[1], qf[2], s1, 0, 0, 0); \
                    s0 = __builtin_amdgcn_mfma_f32_32x32x16_bf16(kfb[2], qf[3], s0, 0, 0, 0); s1 = __builtin_amdgcn_mfma_f32_32x32x16_bf16(kfb[3], qf[3], s1, 0, 0, 0); \
                    __builtin_amdgcn_s_setprio(0); \
                    _Pragma("unroll") for (int blk = 0; blk < 4; ++blk) vfa[blk] = *(const LAS bf16x8*)(vb + blk * 32 * VROW); \
                    _Pragma("unroll") for (int blk = 0; blk < 4; ++blk) vfb[blk] = *(const LAS bf16x8*)(vb + blk * 32 * VROW + 32); \
                    __builtin_amdgcn_sched_barrier(0); \
                    if (key0 + 63 > q0) { const int qrel = q0 + l32 - key0; \
                        _Pragma("unroll") for (int r = 0; r < 16; ++r) { const int kl = (r & 3) + 8 * (r >> 2) + 4 * hh; if (kl > qrel) s0[r] = -INFINITY; if (kl + 32 > qrel) s1[r] = -INFINITY; } } \
                    float tm = fmaxf(s0[0], s1[0]); _Pragma("unroll") for (int r = 1; r < 16; ++r) tm = fmaxf(tm, fmaxf(s0[r], s1[r])); \
                    tm = xhalf_max(tm); \
                    const float mnew = fmaxf(mrow, tm); \
                    if (__any(mnew > mrow + 6.f)) { const float al = __builtin_amdgcn_exp2f(mrow - mnew); lsum *= al; \
                        _Pragma("unroll") for (int blk = 0; blk < 4; ++blk) _Pragma("unroll") for (int r = 0; r < 16; ++r) o[blk][r] *= al; \
                        mrow = mnew; } \
                    float ps = 0.f; _Pragma("unroll") for (int r = 0; r < 16; ++r) { s0[r] = __builtin_amdgcn_exp2f(s0[r] - mrow); s1[r] = __builtin_amdgcn_exp2f(s1[r] - mrow); ps += s0[r] + s1[r]; } \
                    lsum += ps; \
                    bf16x8 pb0, pb1, pb2, pb3; AT_PACK(pb0, s0, 0); AT_PACK(pb1, s0, 8); AT_PACK(pb2, s1, 0); AT_PACK(pb3, s1, 8); \
                    __builtin_amdgcn_sched_barrier(0); \
                    __builtin_amdgcn_s_setprio(1); \
                    _Pragma("unroll") for (int blk = 0; blk < 4; ++blk) o[blk] = __builtin_amdgcn_mfma_f32_32x32x16_bf16(vfa[blk], pb0, o[blk], 0, 0, 0); \
                    _Pragma("unroll") for (int blk = 0; blk < 4; ++blk) o[blk] = __builtin_amdgcn_mfma_f32_32x32x16_bf16(vfb[blk], pb1, o[blk], 0, 0, 0); \
                    __builtin_amdgcn_sched_barrier(0); \
                    _Pragma("unroll") for (int blk = 0; blk < 4; ++blk) kfa[blk] = *(const LAS bf16x8*)(vb + blk * 32 * VROW + 64); \
                    _Pragma("unroll") for (int blk = 0; blk < 4; ++blk) kfb[blk] = *(const LAS bf16x8*)(vb + blk * 32 * VROW + 96); \
                    __builtin_amdgcn_sched_barrier(0); \
                    _Pragma("unroll") for (int blk = 0; blk < 4; ++blk) o[blk] = __builtin_amdgcn_mfma_f32_32x32x16_bf16(kfa[blk], pb2, o[blk], 0, 0, 0); \
                    _Pragma("unroll") for (int blk = 0; blk < 4; ++blk) o[blk] = __builtin_amdgcn_mfma_f32_32x32x16_bf16(kfb[blk], pb3, o[blk], 0, 0, 0); \
                    __builtin_amdgcn_s_setprio(0); \
                } } while (0)
            bf16x8 fr0[4], fr1[4], fr2[4], fr3[4];
            AT_ISSUE(0, 0); AT_ISSUE(1, 1);
            __syncthreads();
            AT_WRITE(0, 0);
            __syncthreads();
            for (int st = 0; st < nst; st += 2) {
                AT_ISSUE(0, st + 2);
                AT_COMPUTE(0, st, fr0, fr1, fr2, fr3);
                AT_WRITE(1, 1);
                __syncthreads();
                AT_ISSUE(1, st + 3);
                AT_COMPUTE(1, st + 1, fr2, fr3, fr0, fr1);
                AT_WRITE(0, 0);
                __syncthreads();
            }
            lsum = xhalf_sum(lsum);
            const float inv = 1.f / lsum;
            LAS float* xo = (LAS float*)lds + (wq * 128 + 4 * hh) * 32 + l32;
            if (c == 1) {
#pragma unroll
                for (int blk = 0; blk < 4; ++blk)
#pragma unroll
                    for (int r = 0; r < 16; ++r) xo[(blk * 32 + (r & 3) + 8 * (r >> 2)) * 32] = o[blk][r] * inv; }
            __syncthreads();
            if (c == 0) { float ss = 0.f; float lam; { float s1 = 0.f, s2 = 0.f; for (int d = 0; d < 64; ++d) { s1 += p.in[22][d] * p.in[23][d]; s2 += p.in[24][d] * p.in[25][d]; } lam = expf(s1) - expf(s2) + 0.2f; }
                const float* subln = p.in[26];
#pragma unroll
                for (int blk = 0; blk < 4; ++blk)
#pragma unroll
                    for (int r = 0; r < 16; ++r) { const float v = o[blk][r] * inv - lam * xo[(blk * 32 + (r & 3) + 8 * (r >> 2)) * 32]; o[blk][r] = v; ss += v * v; }
                ss = xhalf_sum(ss);
                const float rstd = rsqrtf(ss * (1.f / 128.f) + 1e-6f) * 0.8f;
                bf16_t* op = CAT + ((size_t)b * SEQ + q0 + l32) * 1024 + 512 + head * 128 + 4 * hh;
#pragma unroll
                for (int blk = 0; blk < 4; ++blk)
#pragma unroll
                    for (int g4 = 0; g4 < 4; ++g4) { const f32x4 sg = *(const f32x4*)(subln + blk * 32 + g4 * 8 + 4 * hh);
                        u32x2 w; w.x = pk2(o[blk][g4 * 4 + 0] * rstd * sg[0], o[blk][g4 * 4 + 1] * rstd * sg[1]); w.y = pk2(o[blk][g4 * 4 + 2] * rstd * sg[2], o[blk][g4 * 4 + 3] * rstd * sg[3]);
                        *(u32x2*)(op + blk * 32 + g4 * 8) = w; } }
        }
    }
}

__device__ __forceinline__ void attn_combine(const bf16_t* OC, bf16_t* CAT, const Params& p, int bid, int nb) {
    const int wave = threadIdx.x >> 6, lane = threadIdx.x & 63, head = lane >> 4, e0 = (lane & 15) * 8;
    float lam;
    { float s1 = 0.f, s2 = 0.f; for (int d = 0; d < 64; ++d) { s1 += p.in[22][d] * p.in[23][d]; s2 += p.in[24][d] * p.in[25][d]; } lam = expf(s1) - expf(s2) + 0.2f; }
    float sub[8];
#pragma unroll
    for (int i = 0; i < 8; ++i) sub[i] = p.in[26][e0 + i] * 0.8f;
    for (int tok = bid * 8 + wave; tok < MTOK; tok += nb * 8) {
        const u32x4 a = *(const u32x4*)(OC + (size_t)tok * 1024 + (head * 2) * 128 + e0), bb = *(const u32x4*)(OC + (size_t)tok * 1024 + (head * 2 + 1) * 128 + e0);
        float o[8] = {bflo(a.x) - lam * bflo(bb.x), bfhi(a.x) - lam * bfhi(bb.x), bflo(a.y) - lam * bflo(bb.y), bfhi(a.y) - lam * bfhi(bb.y),
                      bflo(a.z) - lam * bflo(bb.z), bfhi(a.z) - lam * bfhi(bb.z), bflo(a.w) - lam * bflo(bb.w), bfhi(a.w) - lam * bfhi(bb.w)};
        float ss = 0.f;
#pragma unroll
        for (int i = 0; i < 8; ++i) ss += o[i] * o[i];
        ss = dpp_sum16(ss);
        const float rstd = rsqrtf(ss * (1.f / 128.f) + 1e-6f);
        u32x4 w; w.x = pk2(o[0] * rstd * sub[0], o[1] * rstd * sub[1]); w.y = pk2(o[2] * rstd * sub[2], o[3] * rstd * sub[3]); w.z = pk2(o[4] * rstd * sub[4], o[5] * rstd * sub[5]); w.w = pk2(o[6] * rstd * sub[6], o[7] * rstd * sub[7]);
        *(u32x4*)(CAT + (size_t)tok * 1024 + 512 + head * 128 + e0) = w;
    }
}

typedef float f32x2 __attribute__((ext_vector_type(2)));
__device__ __forceinline__ float h2f_(unsigned bits) { return (float)__builtin_bit_cast(_Float16, (unsigned short)bits); }
__device__ __forceinline__ void rwkv_phase(const Params& p, const bf16_t* R, const bf16_t* Kk, const bf16_t* Vv, const _Float16* DEC, const bf16_t* AA, bf16_t* Y, float* lds, int bid, int nb) {
    const int tid = threadIdx.x, wave = __builtin_amdgcn_readfirstlane(tid >> 6), lane = tid & 63;
    constexpr int TCH = 16, BUFF = 5 * TCH * 64 + TCH * 16;
    constexpr int OBUF = TCH * 16 * 16;
    float* Lout = lds + 2 * BUFF;
    for (int unit = bid; unit < 256; unit += nb) {
        const int b = unit >> 6, h = (unit >> 2) & 15, rq = unit & 3;
        __syncthreads();
        if (wave >= 4) {
            const int pw = wave - 4, tl = lane >> 4, c4 = (lane & 15) * 4;
            const f32x4 kkw = *(const f32x4*)(p.in[41] + h * 64 + c4), kaw = *(const f32x4*)(p.in[42] + h * 64 + c4);
            u32x2 rr[4], kr[4], ar[4], dr[4], vr[4];
            const unsigned lofs = (unsigned)((pw * 4 + tl) * 1024 + h * 64 + c4), vofs = (unsigned)((pw * 4 + tl) * 1024 + h * 64 + rq * 16 + (lane & 3) * 4);
            const bf16_t* Rb = R + (size_t)b * SEQ * 1024; const bf16_t* Kb_ = Kk + (size_t)b * SEQ * 1024; const bf16_t* Vb = Vv + (size_t)b * SEQ * 1024;
            const bf16_t* Ab = AA + (size_t)b * SEQ * 1024; const _Float16* Db = DEC + (size_t)b * SEQ * 1024;
#define RW_ISSUE(set, ch) do { const unsigned o_ = (unsigned)(ch) * (TCH * 1024) + lofs; rr[set] = *(const u32x2*)(Rb + o_); kr[set] = *(const u32x2*)(Kb_ + o_); dr[set] = *(const u32x2*)(Db + o_); ar[set] = *(const u32x2*)(Ab + o_); \
                    vr[set] = *(const u32x2*)(Vb + (unsigned)(ch) * (TCH * 1024) + vofs); } while (0)
#define RW_STAGE(set, buf) do { float* L = lds + (buf) * BUFF + (pw * 4 + tl) * 64 + c4; \
                    const f32x4 k = {bflo(kr[set].x), bfhi(kr[set].x), bflo(kr[set].y), bfhi(kr[set].y)}, a = {bflo(ar[set].x), bfhi(ar[set].x), bflo(ar[set].y), bfhi(ar[set].y)}; \
                    const f32x4 r = {bflo(rr[set].x), bfhi(rr[set].x), bflo(rr[set].y), bfhi(rr[set].y)}; \
                    const f32x4 w = {1.f - h2f_(dr[set].x & 0xffffu), 1.f - h2f_(dr[set].x >> 16), 1.f - h2f_(dr[set].y & 0xffffu), 1.f - h2f_(dr[set].y >> 16)}; \
                    f32x4 kk = k * kkw; const float n2 = dpp_sum16((kk[0] * kk[0] + kk[1] * kk[1]) + (kk[2] * kk[2] + kk[3] * kk[3])); kk = kk * __frsqrt_rn(fmaxf(n2, 1e-24f)); \
                    *(f32x4*)(L) = w; *(f32x4*)(L + 1 * TCH * 64) = -kk; *(f32x4*)(L + 2 * TCH * 64) = kk * a; *(f32x4*)(L + 3 * TCH * 64) = k * (1.f + (a - 1.f) * kaw); *(f32x4*)(L + 4 * TCH * 64) = r; \
                    if ((lane & 15) < 4) *(f32x4*)(lds + (buf) * BUFF + 5 * TCH * 64 + (pw * 4 + tl) * 16 + (lane & 3) * 4) = (f32x4){bflo(vr[set].x), bfhi(vr[set].x), bflo(vr[set].y), bfhi(vr[set].y)}; } while (0)
            auto flush = [&](int ch) { const int i = tid - 256, tt = i >> 4, row = i & 15; const f32x4* pp = (const f32x4*)(Lout + (ch & 1) * OBUF + i * 16);
                const f32x4 s4 = pp[0] + pp[1] + pp[2] + pp[3];
                Y[((size_t)b * SEQ + ch * TCH + tt) * 1024 + h * 64 + rq * 16 + row] = (bf16_t)f2bf((s4[0] + s4[1]) + (s4[2] + s4[3])); };
            constexpr int NCH = SEQ / TCH;
            RW_ISSUE(0, 0); RW_ISSUE(1, 1); RW_ISSUE(2, 2); RW_ISSUE(3, 3);
            RW_STAGE(0, 0);
            __syncthreads();
            for (int c4_ = 0; c4_ < NCH; c4_ += 4) {
#define RW_ITER(q) do { const int ch = c4_ + (q); RW_STAGE(((q) + 1) & 3, (ch + 1) & 1); { const int chn = (ch + 4 < NCH) ? ch + 4 : NCH - 1; RW_ISSUE((q), chn); } flush(ch > 0 ? ch - 1 : 0); __syncthreads(); } while (0)
                RW_ITER(0); RW_ITER(1); RW_ITER(2); RW_ITER(3);
            }
            flush(NCH - 1);
        } else {
            const int j = lane & 15, rowl = wave * 4 + (lane >> 4);
            f32x2 S01 = {0.f, 0.f}, S23 = {0.f, 0.f};
            __syncthreads();
            for (int ch = 0; ch < SEQ / TCH; ++ch) {
                const float* L = lds + (ch & 1) * BUFF + j * 4; const float* Lv = lds + (ch & 1) * BUFF + 5 * TCH * 64 + rowl; float* Lo = Lout + (ch & 1) * OBUF + rowl * 16 + j;
                f32x4 w4 = *(const f32x4*)(L), a4 = *(const f32x4*)(L + 1 * TCH * 64), b4 = *(const f32x4*)(L + 2 * TCH * 64), k4 = *(const f32x4*)(L + 3 * TCH * 64), r4 = *(const f32x4*)(L + 4 * TCH * 64);
                float vv = Lv[0];
#pragma unroll
                for (int tt = 0; tt < TCH; ++tt) {
                    f32x4 nw4 = w4, na4 = a4, nb4 = b4, nk4 = k4, nr4 = r4; float nvv = vv;
                    if (tt + 1 < TCH) { const float* Ln = L + (tt + 1) * 64; nw4 = *(const f32x4*)(Ln); na4 = *(const f32x4*)(Ln + 1 * TCH * 64); nb4 = *(const f32x4*)(Ln + 2 * TCH * 64); nk4 = *(const f32x4*)(Ln + 3 * TCH * 64); nr4 = *(const f32x4*)(Ln + 4 * TCH * 64); nvv = Lv[(tt + 1) * 16]; }
                    f32x2 d = S01 * (f32x2){a4[0], a4[1]}; d = S23 * (f32x2){a4[2], a4[3]} + d;
                    const float sa = dpp_sum16(d[0] + d[1]);
                    const f32x2 sa2 = {sa, sa}, v2 = {vv, vv};
                    const f32x2 t01 = sa2 * (f32x2){b4[0], b4[1]} + v2 * (f32x2){k4[0], k4[1]}, t23 = sa2 * (f32x2){b4[2], b4[3]} + v2 * (f32x2){k4[2], k4[3]};
                    S01 = S01 * (f32x2){w4[0], w4[1]} + t01; S23 = S23 * (f32x2){w4[2], w4[3]} + t23;
                    f32x2 y = S01 * (f32x2){r4[0], r4[1]}; y = S23 * (f32x2){r4[2], r4[3]} + y;
                    Lo[tt * 256] = y[0] + y[1];
                    w4 = nw4; a4 = na4; b4 = nb4; k4 = nk4; r4 = nr4; vv = nvv;
                }
                __syncthreads();
            }
        }
    }
}

__device__ __forceinline__ float quad_sum(float x) {
    x += __int_as_float(__builtin_amdgcn_update_dpp(0, __float_as_int(x), 0xB1, 0xf, 0xf, true));
    x += __int_as_float(__builtin_amdgcn_update_dpp(0, __float_as_int(x), 0x4E, 0xf, 0xf, true));
    return x;
}
__device__ __forceinline__ void unpack16(const bf16_t* ptr, float (&o)[16]) {
    const u32x4 a = *(const u32x4*)ptr, b = *(const u32x4*)(ptr + 8);
    o[0] = bflo(a.x); o[1] = bfhi(a.x); o[2] = bflo(a.y); o[3] = bfhi(a.y); o[4] = bflo(a.z); o[5] = bfhi(a.z); o[6] = bflo(a.w); o[7] = bfhi(a.w);
    o[8] = bflo(b.x); o[9] = bfhi(b.x); o[10] = bflo(b.y); o[11] = bfhi(b.y); o[12] = bflo(b.z); o[13] = bfhi(b.z); o[14] = bflo(b.w); o[15] = bfhi(b.w);
}
__device__ __forceinline__ void rwkv_post(const Params& p, bf16_t* R, const bf16_t* Kk, const bf16_t* Vv, const bf16_t* AA, const bf16_t* G, const bf16_t* Y, int bid, int nb) {
    const int wave = threadIdx.x >> 6, lane = threadIdx.x & 63, c0 = lane * 16;
    float ka[16], rk[16], lg[16], lb[16];
#pragma unroll
    for (int i = 0; i < 16; ++i) { ka[i] = p.in[42][c0 + i]; rk[i] = p.in[43][c0 + i]; lg[i] = p.in[44][c0 + i]; lb[i] = p.in[45][c0 + i]; }
    for (int tok = bid * 8 + wave; tok < MTOK; tok += nb * 8) {
        const size_t off = (size_t)tok * 1024 + c0;
        float y[16], r[16], k[16], v[16], a[16], g[16];
        unpack16(Y + off, y); unpack16(R + off, r); unpack16(Kk + off, k); unpack16(Vv + off, v); unpack16(AA + off, a); unpack16(G + off, g);
        float s = 0.f, sb = 0.f;
#pragma unroll
        for (int i = 0; i < 16; ++i) { s += y[i]; sb += r[i] * (k[i] * (1.f + (a[i] - 1.f) * ka[i])) * rk[i]; }
        s = quad_sum(s); sb = quad_sum(sb);
        const float mean = s * (1.f / 64.f); float q = 0.f;
#pragma unroll
        for (int i = 0; i < 16; ++i) { y[i] -= mean; q += y[i] * y[i]; }
        q = quad_sum(q);
        const float rstd = rsqrtf(q * (1.f / 64.f) + 64e-5f);
        float o[16];
#pragma unroll
        for (int i = 0; i < 16; ++i) o[i] = (y[i] * rstd * lg[i] + lb[i] + sb * v[i]) * g[i];
        u32x4 w0, w1; w0.x = pk2(o[0], o[1]); w0.y = pk2(o[2], o[3]); w0.z = pk2(o[4], o[5]); w0.w = pk2(o[6], o[7]); w1.x = pk2(o[8], o[9]); w1.y = pk2(o[10], o[11]); w1.z = pk2(o[12], o[13]); w1.w = pk2(o[14], o[15]);
        *(u32x4*)(R + off) = w0; *(u32x4*)(R + off + 8) = w1;
    }
}

#define XB_TMO      128
#define XB_XCNT(j)  (256  + 64 * (j))
#define XB_XSUB(j)  (1280 + 64 * (j))
#define XB_XGEN(j)  (2304 + 64 * (j))
#define XB_TOP      3328
#define XB_TOPGEN   3392
#define XCD_BAR_WORDS 3456
#define XB_SPIN_CAP (1u << 18)
__device__ __forceinline__ unsigned xb_ld(unsigned* p)              { return __hip_atomic_load(p, __ATOMIC_RELAXED, __HIP_MEMORY_SCOPE_AGENT); }
__device__ __forceinline__ unsigned xb_add(unsigned* p, unsigned v) { return __hip_atomic_fetch_add(p, v, __ATOMIC_RELAXED, __HIP_MEMORY_SCOPE_AGENT); }
__device__ __forceinline__ unsigned xb_xcc_id() { return (unsigned)__builtin_amdgcn_s_getreg((3 << 11) | 20) & 0xFu; }
#define XB_SPIN(cond, bar) do { unsigned _sp = 0; while (cond) { __builtin_amdgcn_s_sleep(1); \
    if ((++_sp & 255u) == 0u) { if (xb_ld(&(bar)[XB_TMO])) break; if (_sp > XB_SPIN_CAP) { atomicAdd(&(bar)[XB_TMO], 1u); break; } } } } while (0)
struct XcdBarrier { unsigned* bar; unsigned x; volatile LAS unsigned* st; };
__device__ __forceinline__ XcdBarrier xcd_barrier_post(unsigned* bar, volatile LAS unsigned* st) {
    XcdBarrier b; b.bar = bar; b.x = xb_xcc_id(); b.st = st;
    if (threadIdx.x == 0) (void)xb_add(&bar[XB_XCNT(b.x)], 1u);
    return b;
}
__device__ __forceinline__ void xcd_barrier_complete(unsigned* bar, unsigned x, unsigned& nloc, unsigned& nx) {
    const unsigned G = gridDim.x * gridDim.y * gridDim.z;
    unsigned sum, cnt, mine, sp = 0u;
    for (;;) {
        sum = 0u; cnt = 0u; mine = 0u;
#pragma unroll
        for (unsigned j = 0; j < 16; ++j) { const unsigned c = xb_ld(&bar[XB_XCNT(j)]); sum += c; cnt += (c > 0u) ? 1u : 0u; mine = (j == x) ? c : mine; }
        if (sum == G) break;
        __builtin_amdgcn_s_sleep(1);
        if ((++sp & 255u) == 0u) { if (xb_ld(&bar[XB_TMO])) break; if (sp > XB_SPIN_CAP) { atomicAdd(&bar[XB_TMO], 1u); break; } }
    }
    nloc = mine > 0u ? mine : 1u; nx = cnt > 0u ? cnt : 1u;
}
__device__ __forceinline__ void xcd_barrier(const XcdBarrier& b) {
    asm volatile("s_waitcnt vmcnt(0)" ::: "memory");
    __syncthreads();
    if (threadIdx.x == 0) {
        unsigned* bar = b.bar;
        __builtin_amdgcn_s_waitcnt(0);
        unsigned nloc = b.st[0], nx = b.st[1];
        if (nloc == 0u) { xcd_barrier_complete(bar, b.x, nloc, nx); b.st[0] = nloc; b.st[1] = nx; }
        const unsigned old = xb_add(&bar[XB_XSUB(b.x)], 1u);
        const unsigned gen = old / nloc;
        if (old + 1u == (gen + 1u) * nloc) {
            __builtin_amdgcn_fence(__ATOMIC_RELEASE, "agent");
            asm volatile("s_waitcnt vmcnt(0)" ::: "memory");
            const unsigned og = xb_add(&bar[XB_TOP], 1u);
            const unsigned tg = og / nx;
            if (og + 1u == (tg + 1u) * nx) xb_add(&bar[XB_TOPGEN], 1u);
            else XB_SPIN(xb_ld(&bar[XB_TOPGEN]) == tg, bar);
            __builtin_amdgcn_fence(__ATOMIC_ACQUIRE, "agent");
            xb_add(&bar[XB_XGEN(b.x)], 1u);
            asm volatile("s_waitcnt vmcnt(0)" ::: "memory");
        } else {
            XB_SPIN(xb_ld(&bar[XB_XGEN(b.x)]) == gen, bar);
            __builtin_amdgcn_fence(__ATOMIC_ACQUIRE, "agent");
            asm volatile("s_waitcnt vmcnt(0)" ::: "memory");
        }
    }
    __syncthreads();
}

__global__ void __launch_bounds__(NTHR) fwd_kernel(Params p) {
    extern __shared__ __attribute__((aligned(16))) unsigned char lds_raw[];
    LAS unsigned char* lds = (LAS unsigned char*)lds_raw;
    float* ldsf = (float*)lds_raw;
    const int bid = blockIdx.x, nb = gridDim.x;
    unsigned char* ws = p.ws;
    float* mod = (float*)(ws + OFF_MOD);
    const bool multi = (p.ph_hi - p.ph_lo) > 1;
    __shared__ unsigned xb_st[4];
    if (threadIdx.x < 4) xb_st[threadIdx.x] = 0u;
    __syncthreads();
    XcdBarrier xbar; xbar.bar = (unsigned*)(ws + OFF_BAR); xbar.x = 0; xbar.st = (volatile LAS unsigned*)xb_st;
    if (multi) xbar = xcd_barrier_post((unsigned*)(ws + OFF_BAR), (volatile LAS unsigned*)xb_st);
#ifndef TESTPH
#define TESTPH -1
#endif
#ifndef REPEAT_A
#define REPEAT_A -1
#endif
#ifndef REPEAT_B
#define REPEAT_B -1
#endif
#ifndef EXTRA_SYNCS
#define EXTRA_SYNCS 0
#endif
#define PH(k) if ((TESTPH < 0 || TESTPH == (k)) && p.ph_lo <= (k) && (k) < p.ph_hi) for (int rep_ = 0; rep_ < (((k) == REPEAT_A || (k) == REPEAT_B) ? 2 : 1); ++rep_)
#define SYNC(k) if (multi) { xcd_barrier(xbar); }
    for (int es_ = 0; es_ < EXTRA_SYNCS; ++es_) cg::this_grid().sync();
    if (p.ph_lo < -1000) cg::this_grid().sync();
    PH(0) { prep_phase(p, ldsf, bid, nb); SYNC(0) }
    PH(1) { norm_phase<false>(p.in[0], p.in[5], mod, 0, 1024, (bf16_t*)(ws + OFF_HA), bid, nb); SYNC(1) }
    PH(2) { EpiWin e{(bf16_t*)(ws + OFF_UX), (bf16_t*)(ws + OFF_QKV)}; gemm_stream(lds, (const bf16_t*)(ws + OFF_HA), (const bf16_t*)(ws + OFF_WIN), 2048, 1024, e, bid, nb); SYNC(2) }
    PH(3) { { EpiS5Z e{(float*)(ws + OFF_Z)}; gemm_batched(lds, (const bf16_t*)(ws + OFF_UX), 640, (size_t)512 * 640, (const bf16_t*)(ws + OFF_BTZ), (size_t)256 * 512, 2, 1, 32, 512, e, NoPre{}, bid, nb); }
            bf16_t* q = (bf16_t*)(ws + OFF_QKV);
            if (nb > 128) { if (bid >= 64) qknorm_phase(q, q + (size_t)MTOK * 512, (const int*)p.in[2], p.in[20], p.in[21], bid - 64, nb - 64); }
            else qknorm_phase(q, q + (size_t)MTOK * 512, (const int*)p.in[2], p.in[20], p.in[21], bid, nb);
            vtrans_phase(q + (size_t)MTOK * 1024, (bf16_t*)(ws + OFF_VT), (bf16_t*)lds_raw, bid, nb); SYNC(3) }
    PH(5) { { EpiS5Y e{(const bf16_t*)(ws + OFF_UX), (bf16_t*)(ws + OFF_YG), p.in[18]}; PreS5Y pre{(const float*)(ws + OFF_Z), (bf16_t*)(ws + OFF_UX), p.in[11], p.in[12], p.in[13]};
              gemm_batched(lds, (const bf16_t*)(ws + OFF_UX), 640, (size_t)512 * 640, (const bf16_t*)(ws + OFF_BTY), (size_t)512 * 640, 2, 2, 32, 640, e, pre, bid, nb); }
            bf16_t* q = (bf16_t*)(ws + OFF_QKV); attn_phase(q, q + (size_t)MTOK * 512, (const bf16_t*)(ws + OFF_VT), (bf16_t*)(ws + OFF_CAT), p, lds, bid, nb); SYNC(5) }
    PH(6) {
            EpiGlu e{(const bf16_t*)(ws + OFF_YG), (bf16_t*)(ws + OFF_CAT)}; gemm_phase(lds, (const bf16_t*)(ws + OFF_YG), (const bf16_t*)(ws + OFF_WGLU), 512, 512, e, bid, nb); SYNC(6) }
    PH(7) { EpiRes e{p.in[0], p.out, mod + 2048}; gemm_stream(lds, (const bf16_t*)(ws + OFF_CAT), (const bf16_t*)(ws + OFF_WOUT), 1024, 1024, e, bid, nb); SYNC(7) }
    PH(8) { norm_phase<false>(p.out, p.in[6], mod, 3072, 4096, (bf16_t*)(ws + OFF_HA), bid, nb); SYNC(8) }
    PH(9) { EpiSwiglu e{(bf16_t*)(ws + OFF_HID)}; gemm_stream(lds, (const bf16_t*)(ws + OFF_HA), (const bf16_t*)(ws + OFF_WGU0), 5632, 1024, e, bid, nb); SYNC(9) }
    PH(10) { EpiRes e{p.out, p.out, mod + 5120}; gemm_stream(lds, (const bf16_t*)(ws + OFF_HID), (const bf16_t*)(ws + OFF_WDN0), 1024, FF, e, bid, nb); SYNC(10) }
    const float* mod1 = mod + 4 * 6144;
#define RWKV_FRONT(PA, PB, ROW0) \
    PH(PA) { norm_phase<true>(p.out, p.in[5] + 1024, mod1, 0, 1024, (bf16_t*)(ws + OFF_HD), bid, nb, (ROW0), 8192, p.in[28]); SYNC(PA) } \
    PH(PB) { const bf16_t* xall = (const bf16_t*)(ws + OFF_HD); const bool split = (nb == 256); \
               \
             { pg8::Gemm g{xall + 2048, (const bf16_t*)(ws + OFF_WL1), 8192, 256, 2048, 4096}; SchedOne S{(bid < 32) ? bid : -1}; EpiAdapt<EpiL1> ea{EpiL1{(bf16_t*)(ws + OFF_L1), (ROW0)}}; \
               pg8::gemm_phase<EpiAdapt<EpiL1>, SchedOne, false, true>(lds, g, S, ea); } \
             { pg8::Gemm g{xall, (const bf16_t*)(ws + OFF_WG1), 8192, 3072, 1024, 4096}; SchedRKV S{split ? bid - 32 : bid, split ? 224 : nb}; EpiAdaptRKV ea{EpiRKV{(bf16_t*)(ws + OFF_RKV), (ROW0)}}; \
               pg8::gemm_phase<EpiAdaptRKV, SchedRKV, true, true>(lds, g, S, ea); } \
             SYNC(PB) }
    RWKV_FRONT(11, 12, 0)
    RWKV_FRONT(20, 21, 8192)
    PH(13) { EpiL2 e{(_Float16*)(ws + OFF_DEC), (bf16_t*)(ws + OFF_AA), (bf16_t*)(ws + OFF_G), p.in[33], p.in[36]}; gemm_stream(lds, (const bf16_t*)(ws + OFF_L1), (const bf16_t*)(ws + OFF_WL2), 3072, 256, e, bid, nb); SYNC(13) }
    PH(14) { const bf16_t* r = (const bf16_t*)(ws + OFF_RKV); rwkv_phase(p, r, r + (size_t)MTOK * 1024, r + (size_t)MTOK * 2048, (const _Float16*)(ws + OFF_DEC), (const bf16_t*)(ws + OFF_AA), (bf16_t*)(ws + OFF_Y), ldsf, bid, nb); SYNC(14) }
    PH(15) { bf16_t* r = (bf16_t*)(ws + OFF_RKV); rwkv_post(p, r, r + (size_t)MTOK * 1024, r + (size_t)MTOK * 2048, (const bf16_t*)(ws + OFF_AA), (const bf16_t*)(ws + OFF_G), (const bf16_t*)(ws + OFF_Y), bid, nb); SYNC(15) }
    PH(16) { EpiRes e{p.out, p.out, mod1 + 2048}; gemm_stream(lds, (const bf16_t*)(ws + OFF_RKV), (const bf16_t*)(ws + OFF_WO), 1024, 1024, e, bid, nb); SYNC(16) }
    PH(17) { norm_phase<false>(p.out, p.in[6] + 1024, mod1, 3072, 4096, (bf16_t*)(ws + OFF_HA), bid, nb); SYNC(17) }
    PH(18) { EpiSwiglu e{(bf16_t*)(ws + OFF_HID)}; gemm_stream(lds, (const bf16_t*)(ws + OFF_HA), (const bf16_t*)(ws + OFF_WGU1), 5632, 1024, e, bid, nb); SYNC(18) }
    PH(19) { EpiRes e{p.out, p.out, mod1 + 5120}; gemm_stream(lds, (const bf16_t*)(ws + OFF_HID), (const bf16_t*)(ws + OFF_WDN1), 1024, FF, e, bid, nb); }
}

constexpr int NPHASE = 22;
#ifndef ONE_LAUNCH
#define ONE_LAUNCH 1
#endif

extern "C" void kernel_launch(void* const* d_in, const int* in_sizes, int n_in, void* d_out, int out_size, void* d_ws, size_t ws_size, hipStream_t stream) {
    static int grid = 0;
    if (grid == 0) {
        if (n_in != 46 || ws_size < WS_NEED) { fprintf(stderr, "kernel_launch: unexpected n_in %d / ws_size %zu (need %zu)\n", n_in, ws_size, (size_t)WS_NEED); grid = -1; return; }
        if (hipFuncSetAttribute((const void*)fwd_kernel, hipFuncAttributeMaxDynamicSharedMemorySize, LDS_BYTES) != hipSuccess) { fprintf(stderr, "hipFuncSetAttribute failed\n"); grid = -1; return; }
        int dev = 0, cus = 0, per_cu = 0;
        (void)hipGetDevice(&dev); (void)hipDeviceGetAttribute(&cus, hipDeviceAttributeMultiprocessorCount, dev);
        (void)hipOccupancyMaxActiveBlocksPerMultiprocessor(&per_cu, (const void*)fwd_kernel, NTHR, LDS_BYTES);
        if (per_cu < 1) per_cu = 1;
        grid = cus;
    }
    if (grid < 0) return;
    Params p{};
    for (int i = 0; i < 46; ++i) p.in[i] = (const float*)d_in[i];
    p.out = (float*)d_out; p.ws = (unsigned char*)d_ws;
#if ONE_LAUNCH
    p.ph_lo = 0; p.ph_hi = NPHASE;
    if (hipMemsetAsync((char*)d_ws + OFF_BAR, 0, XCD_BAR_WORDS * 4, stream) != hipSuccess) { fprintf(stderr, "memset failed\n"); return; }
    void* args[] = {&p};
    hipError_t e = hipLaunchCooperativeKernel((const void*)fwd_kernel, dim3(grid), dim3(NTHR), args, LDS_BYTES, stream);
    if (e != hipSuccess) fprintf(stderr, "cooperative launch failed: %s (grid %d)\n", hipGetErrorString(e), grid);
#else
    for (int ph = 0; ph < NPHASE; ++ph) { p.ph_lo = ph; p.ph_hi = ph + 1; hipLaunchKernelGGL(fwd_kernel, dim3(grid), dim3(NTHR), LDS_BYTES, stream, p); }
#endif
}
```
